# Optimizing an MI355X kernel written in HIP

```python
import jax, jax.numpy as jnp
from jax import lax
import numpy as np

D_MODEL = 1024
BATCH = 2
SEQ = 8192
DEPTH = 4

CHUNK = 64
Q_BLOCK = 128
HEAD_DIM = 64
NORM_EPS = 1e-6

SB_HEADS = D_MODEL // (2 * HEAD_DIM)
SB_WIDTH = SB_HEADS * HEAD_DIM
POOL_WINDOWS = (2, 4, 8, 16)
N_POOL = len(POOL_WINDOWS)
POOL_WIDTH = D_MODEL - SB_WIDTH
POOL_GROUP = POOL_WIDTH // N_POOL
EVEN_IN = 3 * SB_WIDTH + POOL_WIDTH

FOX_HEADS = D_MODEL // (2 * HEAD_DIM)
FOX_WIDTH = FOX_HEADS * HEAD_DIM
FOX_IN = 4 * FOX_WIDTH + FOX_HEADS
RWKV_HEADS = D_MODEL // (2 * HEAD_DIM)
RWKV_WIDTH = RWKV_HEADS * HEAD_DIM
DECAY_LORA = 64
ICLR_LORA = 64
GATE_LORA = 128
RWKV_IN = 3 * RWKV_WIDTH + DECAY_LORA + ICLR_LORA + GATE_LORA
ODD_IN = FOX_IN + RWKV_IN
RWKV_GN_EPS = 64e-5

PEER_HEADS = 8
PEER_NKEYS = 128
PEER_EXPERTS = PEER_NKEYS * PEER_NKEYS
PEER_TOPK = 16
PEER_DKEY = 256
PEER_TOKEN_BLOCK = 128

N_EVEN = (DEPTH + 1) // 2
N_ODD = DEPTH // 2

kernel_name = 'hybrid_sb_pool_fox_rwkv7_peer_encoder'


def rms_norm(x, gain, eps=NORM_EPS):
    xf = x.astype(jnp.float32)
    y = xf * lax.rsqrt(jnp.mean(xf * xf, axis=-1, keepdims=True) + eps)
    return (y * gain.astype(jnp.float32)).astype(x.dtype)


def modulate(h, shift, scale):
    return h * (1.0 + scale[:, None, :]) + shift[:, None, :]


def split_heads(t, n_heads):
    b, s, _ = t.shape
    return t.reshape(b, s, n_heads, -1).transpose(0, 2, 1, 3)


def merge_heads(t):
    b, h, s, d = t.shape
    return t.transpose(0, 2, 1, 3).reshape(b, s, h * d)


def stick_breaking_attention(q, k, v):
    b, h, s, dh = q.shape
    nb = s // Q_BLOCK
    scale = dh ** -0.5
    qb = q.reshape(b, h, nb, Q_BLOCK, dh).transpose(2, 0, 1, 3, 4)
    key_pos = jnp.arange(s)

    def block(args):
        qi, i = args
        q_pos = i * Q_BLOCK + jnp.arange(Q_BLOCK)
        strict = key_pos[None, :] < q_pos[:, None]
        z = jnp.einsum('bhqd,bhkd->bhqk', qi, k).astype(jnp.float32) * scale
        log_beta = jax.nn.log_sigmoid(z)
        log_1m = jnp.where(strict, jax.nn.log_sigmoid(-z), 0.0)
        stick = lax.cumsum(log_1m, axis=3, reverse=True) - log_1m
        w = jnp.where(strict, jnp.exp(log_beta + stick), 0.0)
        return jnp.einsum('bhqk,bhkd->bhqd', w.astype(v.dtype), v)

    out = lax.map(block, (qb, jnp.arange(nb)))
    return out.transpose(1, 2, 0, 3, 4).reshape(b, h, s, dh)


def forgetting_attention(q, k, v, log_f):
    b, h, s, dh = q.shape
    nb = s // Q_BLOCK
    scale = dh ** -0.5
    dcum = jnp.cumsum(log_f.astype(jnp.float32), axis=-1)
    qb = q.reshape(b, h, nb, Q_BLOCK, dh).transpose(2, 0, 1, 3, 4)
    db = dcum.reshape(b, h, nb, Q_BLOCK).transpose(2, 0, 1, 3)
    key_pos = jnp.arange(s)

    def block(args):
        qi, di, i = args
        q_pos = i * Q_BLOCK + jnp.arange(Q_BLOCK)
        logits = (jnp.einsum('bhqd,bhkd->bhqk', qi, k).astype(jnp.float32) * scale
                  + di[..., :, None] - dcum[:, :, None, :])
        logits = jnp.where(key_pos[None, :] <= q_pos[:, None], logits, -jnp.inf)
        p = jax.nn.softmax(logits, axis=-1)
        return jnp.einsum('bhqk,bhkd->bhqd', p.astype(v.dtype), v)

    out = lax.map(block, (qb, db, jnp.arange(nb)))
    return out.transpose(1, 2, 0, 3, 4).reshape(b, h, s, dh)


def multiscale_pool(xp, pool_w, pool_scale):
    b, s, _ = xp.shape
    t = jnp.arange(s)
    chunk_end = jnp.minimum((t // CHUNK + 1) * CHUNK, s)
    xg = xp.reshape(b, s, N_POOL, POOL_GROUP).astype(jnp.float32)
    cs = jnp.pad(jnp.cumsum(xg, axis=1), ((0, 0), (1, 0), (0, 0), (0, 0)))
    outs = []
    for g, w in enumerate(POOL_WINDOWS):
        lo = jnp.maximum(t - w // 2, 0)
        hi = jnp.minimum(t + (w - w // 2), chunk_end)
        window_sum = jnp.take(cs[:, :, g], hi, axis=1) - jnp.take(cs[:, :, g], lo, axis=1)
        count = (hi - lo).astype(jnp.float32)[None, :, None]
        outs.append(window_sum / count - xg[:, :, g])
    pooled = jnp.stack(outs, axis=2)
    y = jnp.einsum('bsgc,gcd->bsgd', pooled, pool_w) * pool_scale.reshape(N_POOL, POOL_GROUP)
    return y.reshape(b, s, POOL_WIDTH)


def rwkv7_recurrence(r, w, k, v, kk, a):
    b, s, h, n = r.shape
    xs = tuple(jnp.moveaxis(t.astype(jnp.float32), 1, 0) for t in (r, w, k, v, kk, a))

    def step(state, inp):
        r_t, w_t, k_t, v_t, kk_t, a_t = inp
        sa = jnp.einsum('bhvk,bhk->bhv', state, kk_t)
        state = (state * w_t[:, :, None, :]
                 - sa[..., None] * (kk_t * a_t)[:, :, None, :]
                 + v_t[..., None] * k_t[:, :, None, :])
        y = jnp.einsum('bhvk,bhk->bhv', state, r_t)
        return state, y

    state0 = jnp.zeros((b, h, n, n), jnp.float32)
    _, ys = lax.scan(step, state0, xs)
    return jnp.moveaxis(ys, 0, 1)


def even_mixer(h, w_in, w_out, pool_w, pool_scale):
    proj = h @ w_in
    q = split_heads(proj[..., :SB_WIDTH], SB_HEADS)
    k = split_heads(proj[..., SB_WIDTH:2 * SB_WIDTH], SB_HEADS)
    v = split_heads(proj[..., 2 * SB_WIDTH:3 * SB_WIDTH], SB_HEADS)
    sb = merge_heads(stick_breaking_attention(q, k, v))
    pool = multiscale_pool(proj[..., 3 * SB_WIDTH:], pool_w, pool_scale)
    return jnp.concatenate([sb, pool.astype(sb.dtype)], axis=-1) @ w_out


def odd_mixer(h, w_in, w_out, fox_qnorm, fox_knorm, fox_fbias, rwkv_mix, rwkv_w0, rwkv_w2,
              rwkv_a0, rwkv_a2, rwkv_g2, rwkv_kk, rwkv_ka, rwkv_rk, rwkv_ln_w, rwkv_ln_b):
    b, s, _ = h.shape
    proj = h @ w_in
    pc, pd = proj[..., :FOX_IN], proj[..., FOX_IN:]

    q = rms_norm(split_heads(pc[..., :FOX_WIDTH], FOX_HEADS), fox_qnorm)
    k = rms_norm(split_heads(pc[..., FOX_WIDTH:2 * FOX_WIDTH], FOX_HEADS), fox_knorm)
    v = split_heads(pc[..., 2 * FOX_WIDTH:3 * FOX_WIDTH], FOX_HEADS)
    out_gate = pc[..., 3 * FOX_WIDTH:4 * FOX_WIDTH]
    log_f = jax.nn.log_sigmoid((pc[..., 4 * FOX_WIDTH:] + fox_fbias).astype(jnp.float32))
    att = forgetting_attention(q, k, v, log_f.transpose(0, 2, 1))
    fox_out = merge_heads(att) * jax.nn.sigmoid(out_gate)

    prev = jnp.pad(pd, ((0, 0), (1, 0), (0, 0)))[:, :s]
    pd = pd + (prev - pd) * rwkv_mix
    sizes = (RWKV_WIDTH, RWKV_WIDTH, RWKV_WIDTH, DECAY_LORA, ICLR_LORA, GATE_LORA)
    offs = [0]
    for n in sizes:
        offs.append(offs[-1] + n)
    r, kr, vr, xw, xa, xg = [pd[..., offs[i]:offs[i + 1]] for i in range(6)]
    w_log = -jax.nn.softplus(-(rwkv_w0 + jnp.tanh(xw) @ rwkv_w2)) - 0.5
    decay = jnp.exp(-jnp.exp(w_log.astype(jnp.float32)))
    a = jax.nn.sigmoid(rwkv_a0 + xa @ rwkv_a2)
    g = jax.nn.sigmoid(xg) @ rwkv_g2
    kk = (kr * rwkv_kk).reshape(b, s, RWKV_HEADS, HEAD_DIM).astype(jnp.float32)
    kk = kk / jnp.maximum(jnp.sqrt(jnp.sum(kk * kk, axis=-1, keepdims=True)), 1e-12)
    kr = kr * (1.0 + (a - 1.0) * rwkv_ka)
    hs = (b, s, RWKV_HEADS, HEAD_DIM)
    rh, kh, vh = r.reshape(hs), kr.reshape(hs), vr.reshape(hs)
    y = rwkv7_recurrence(rh, decay.reshape(hs), kh, vh, kk, a.reshape(hs))
    mu = jnp.mean(y, axis=-1, keepdims=True)
    var = jnp.mean(jnp.square(y - mu), axis=-1, keepdims=True)
    y = ((y - mu) * lax.rsqrt(var + RWKV_GN_EPS)).reshape(b, s, RWKV_WIDTH) * rwkv_ln_w + rwkv_ln_b
    bonus = jnp.sum(rh * kh * rwkv_rk, axis=-1, keepdims=True) * vh
    rwkv_out = (y + bonus.reshape(b, s, RWKV_WIDTH)) * g

    return jnp.concatenate([fox_out, rwkv_out.astype(fox_out.dtype)], axis=-1) @ w_out


def peer_ffn(h, w_query, sub_k1, sub_k2, expert_u, expert_v):
    b, s, d = h.shape
    n_tok = b * s
    xt = h.reshape(n_tok, d)
    q = (xt @ w_query).reshape(n_tok, PEER_HEADS, 2, PEER_DKEY // 2)
    s1 = jnp.einsum('thd,nd->thn', q[:, :, 0], sub_k1)
    s2 = jnp.einsum('thd,nd->thn', q[:, :, 1], sub_k2)
    v1, i1 = lax.top_k(s1, PEER_TOPK)
    v2, i2 = lax.top_k(s2, PEER_TOPK)
    cand = (v1[..., :, None] + v2[..., None, :]).reshape(n_tok, PEER_HEADS, PEER_TOPK * PEER_TOPK)
    cand_idx = (i1[..., :, None] * PEER_NKEYS + i2[..., None, :]).reshape(n_tok, PEER_HEADS, PEER_TOPK * PEER_TOPK)
    top_s, pos = lax.top_k(cand.astype(jnp.float32), PEER_TOPK)
    idx = jnp.take_along_axis(cand_idx, pos, axis=-1)
    gate = jax.nn.softmax(top_s, axis=-1)
    nb = n_tok // PEER_TOKEN_BLOCK

    def block(args):
        xb, ib, gb = args
        u = expert_u[ib]
        act = jax.nn.gelu(jnp.einsum('thkd,td->thk', u, xb), approximate=False)
        ve = expert_v[ib]
        return jnp.einsum('thk,thkd->td', (gb * act).astype(ve.dtype), ve)

    out = lax.map(block, (xt.reshape(nb, PEER_TOKEN_BLOCK, d),
                          idx.reshape(nb, PEER_TOKEN_BLOCK, PEER_HEADS, PEER_TOPK),
                          gate.reshape(nb, PEER_TOKEN_BLOCK, PEER_HEADS, PEER_TOPK)))
    return out.reshape(b, s, d)


def setup_inputs(seed: int = 0) -> dict:
    key = jax.random.key(seed)
    ks = iter(jax.random.split(key, 40))

    def nrm(shape, scale):
        return jax.random.normal(next(ks), shape, jnp.float32) * scale

    def gain(shape):
        return 1.0 + nrm(shape, 0.02)

    W = RWKV_WIDTH
    return {
        'x': nrm((BATCH, SEQ, D_MODEL), 1.0),
        'c': nrm((BATCH, D_MODEL), 1.0),
        'ada_w': nrm((DEPTH, D_MODEL, 6 * D_MODEL), 0.5 * D_MODEL ** -0.5),
        'ada_b': nrm((DEPTH, 6 * D_MODEL), 0.01),
        'norm_mix': gain((DEPTH, D_MODEL)),
        'norm_ffn': gain((DEPTH, D_MODEL)),
        'ev_w_in': nrm((N_EVEN, D_MODEL, EVEN_IN), D_MODEL ** -0.5),
        'ev_w_out': nrm((N_EVEN, D_MODEL, D_MODEL), D_MODEL ** -0.5),
        'pool_w': nrm((N_EVEN, N_POOL, POOL_GROUP, POOL_GROUP), POOL_GROUP ** -0.5),
        'pool_scale': gain((N_EVEN, POOL_WIDTH)),
        'od_w_in': nrm((N_ODD, D_MODEL, ODD_IN), D_MODEL ** -0.5),
        'od_w_out': nrm((N_ODD, D_MODEL, D_MODEL), D_MODEL ** -0.5),
        'fox_qnorm': gain((N_ODD, HEAD_DIM)),
        'fox_knorm': gain((N_ODD, HEAD_DIM)),
        'fox_fbias': jnp.linspace(1.0, 6.0, FOX_HEADS)[None, :] + nrm((N_ODD, FOX_HEADS), 0.1),
        'rwkv_mix': jax.random.uniform(next(ks), (N_ODD, RWKV_IN), jnp.float32),
        'rwkv_w0': jax.random.uniform(next(ks), (N_ODD, W), jnp.float32, minval=-6.0, maxval=1.0),
        'rwkv_w2': nrm((N_ODD, DECAY_LORA, W), 0.1 * DECAY_LORA ** -0.5),
        'rwkv_a0': nrm((N_ODD, W), 0.1),
        'rwkv_a2': nrm((N_ODD, ICLR_LORA, W), 0.5 * ICLR_LORA ** -0.5),
        'rwkv_g2': nrm((N_ODD, GATE_LORA, W), GATE_LORA ** -0.5),
        'rwkv_kk': 0.85 + nrm((N_ODD, W), 0.02),
        'rwkv_ka': gain((N_ODD, W)),
        'rwkv_rk': nrm((N_ODD, RWKV_HEADS, HEAD_DIM), 0.1),
        'rwkv_ln_w': gain((N_ODD, W)),
        'rwkv_ln_b': nrm((N_ODD, W), 0.01),
        'peer_wq': nrm((DEPTH, D_MODEL, PEER_HEADS * PEER_DKEY), D_MODEL ** -0.5),
        'peer_k1': nrm((DEPTH, PEER_NKEYS, PEER_DKEY // 2), (PEER_DKEY // 2) ** -0.5),
        'peer_k2': nrm((DEPTH, PEER_NKEYS, PEER_DKEY // 2), (PEER_DKEY // 2) ** -0.5),
        'peer_u': nrm((DEPTH, PEER_EXPERTS, D_MODEL), D_MODEL ** -0.5),
        'peer_v': nrm((DEPTH, PEER_EXPERTS, D_MODEL), PEER_HEADS ** -0.5),
        'final_norm': gain((D_MODEL,)),
    }


def reference(x, c, ada_w, ada_b, norm_mix, norm_ffn, ev_w_in, ev_w_out, pool_w, pool_scale,
              od_w_in, od_w_out, fox_qnorm, fox_knorm, fox_fbias, rwkv_mix, rwkv_w0, rwkv_w2,
              rwkv_a0, rwkv_a2, rwkv_g2, rwkv_kk, rwkv_ka, rwkv_rk, rwkv_ln_w, rwkv_ln_b,
              peer_wq, peer_k1, peer_k2, peer_u, peer_v, final_norm):
    c_act = jax.nn.silu(c)
    for layer in range(DEPTH):
        mod = c_act @ ada_w[layer] + ada_b[layer]
        sh1, sc1, g1, sh2, sc2, g2 = jnp.split(mod, 6, axis=-1)
        h = modulate(rms_norm(x, norm_mix[layer]), sh1, sc1)
        j = layer // 2
        if layer % 2 == 0:
            y = even_mixer(h, ev_w_in[j], ev_w_out[j], pool_w[j], pool_scale[j])
        else:
            y = odd_mixer(h, od_w_in[j], od_w_out[j], fox_qnorm[j], fox_knorm[j], fox_fbias[j],
                          rwkv_mix[j], rwkv_w0[j], rwkv_w2[j], rwkv_a0[j], rwkv_a2[j], rwkv_g2[j],
                          rwkv_kk[j], rwkv_ka[j], rwkv_rk[j], rwkv_ln_w[j], rwkv_ln_b[j])
        x = x + g1[:, None, :] * y
        h = modulate(rms_norm(x, norm_ffn[layer]), sh2, sc2)
        x = x + g2[:, None, :] * peer_ffn(h, peer_wq[layer], peer_k1[layer], peer_k2[layer],
                                          peer_u[layer], peer_v[layer])
    return rms_norm(x, final_norm)
```

```cpp
#include <hip/hip_runtime.h>
#include <cstdio>
#include <cstdint>
namespace pg8 {
#define PG8_LAS __attribute__((address_space(3)))
typedef unsigned short bf16_t;
typedef short bf16x8 __attribute__((ext_vector_type(8)));
typedef float f32x4 __attribute__((ext_vector_type(4)));
typedef unsigned u32x4 __attribute__((ext_vector_type(4)));
constexpr int BM = 256, BK = 64, HALF = 128, HTB = HALF * BK * 2  , STAGE_BYTES = 8 * HTB, NXCD = 8, WGM = 8;

__host__ __device__ __forceinline__ int lds_byte(int r, int c) { const int st = (r >> 4) * 2 + (c >> 5), rr = r & 15, cc = c & 31, ob = rr * 64 + cc * 2; return st * 1024 + (ob ^ (((ob >> 9) & 1) << 5)); }
__host__ __device__ __forceinline__ void stage_rc(int b, int& R, int& C) { const int st = b / 1024, sb = b % 1024, swz = sb ^ (((sb >> 9) & 1) << 5); R = (st >> 1) * 16 + swz / 64; C = (st & 1) * 32 + (swz % 64) / 2; }
__host__ __device__ __forceinline__ int perm32(int rho) { const int n = rho >> 4, i = rho & 15; return 8 * (i >> 2) + 4 * n + (i & 3); }

struct Unit { int pm, pn; };
struct Gemm { const bf16_t* A; const bf16_t* Bt; int M, N, K; };

struct StaticOrder {
    int nM, nN, nwg, G, c;
    __host__ __device__ void init(int M, int N, int G_, int c_) { nM = M / BM; nN = N / BM; nwg = nM * nN; G = G_; c = c_; }
    __host__ __device__ bool next(int i, Unit& u) const {
        const long L = (long)i * G + c; if (L >= nwg) return false;
        int wgid = (int)L; { const int q = nwg / NXCD, r = nwg % NXCD, xcd = wgid % NXCD, off = wgid / NXCD; wgid = (xcd < r ? xcd * (q + 1) : r * (q + 1) + (xcd - r) * q) + off; }
        const int nig = WGM * nN, gid = wgid / nig, fm = gid * WGM, gsz = (nM - fm) < WGM ? (nM - fm) : WGM;
        u.pm = fm + ((wgid % nig) % gsz); u.pn = (wgid % nig) / gsz; return true;
    }
    __device__ __forceinline__ void a_ready(const Unit&) const {}
    __device__ __forceinline__ void done(const Unit&) const {}
};

__device__ __forceinline__ unsigned cvt_pk_bf16(float lo, float hi) { unsigned r; asm volatile("v_cvt_pk_bf16_f32 %0, %1, %2" : "=v"(r) : "v"(lo), "v"(hi)); return r; }
typedef float f32x2 __attribute__((ext_vector_type(2)));
__device__ __forceinline__ f32x2 gelu_pk(f32x2 v) {
    const f32x2 av = __builtin_elementwise_abs(v), d = av * 0.2316418882f + 1.0f;
    f32x2 t; t.x = __builtin_amdgcn_rcpf(d.x); t.y = __builtin_amdgcn_rcpf(d.y);
    f32x2 q = t * 0.5307027145f + (-0.7265760135f); q = q * t + 0.7107068705f; q = q * t + (-0.142248368f); q = q * t + 0.127414796f; q = q * t;
    const f32x2 s = (v * v) * (-0.72134752044f);
    f32x2 e; e.x = __builtin_amdgcn_exp2f(s.x); e.y = __builtin_amdgcn_exp2f(s.y);
    const f32x2 m = v * (q * e), r = v - m;
    f32x2 o; o.x = v.x < 0.f ? m.x : r.x; o.y = v.y < 0.f ? m.y : r.y; return o;
}

template <int ACT  > struct EpiBf16 {
    static constexpr bool PERM = true, AFTER_DRAIN = false; static_assert(ACT == 0 || ACT == 1, "EpiBf16: ACT is 0 (none) or 1 (gelu_pk)");
    bf16_t* O; int ldc; const float* bias; int split_cols; size_t split_stride; float scale0;
    __device__ __forceinline__ void operator()(const f32x4 (&acc)[2][2][4][2], const Unit& u, int wr, int wc, int fr, int fq) const {
        const int row0 = u.pm * BM + wr * 64 + fr; int colt = u.pn * BM; bf16_t* base = O;
        float sc = 1.f; if (split_cols) { const int t = colt / split_cols; base += (size_t)t * split_stride; colt -= t * split_cols; if (t == 0) sc = scale0; }
        const int col0 = colt + wc * 32 + 8 * fq, bcol0 = u.pn * BM + wc * 32 + 8 * fq;
        f32x4 bv[2][2];
#pragma unroll
        for (int bj = 0; bj < 2; ++bj)
#pragma unroll
            for (int n = 0; n < 2; ++n) bv[bj][n] = bias ? *(const f32x4*)(bias + bcol0 + bj * HALF + 4 * n) : (f32x4){0.f, 0.f, 0.f, 0.f};
#pragma unroll
        for (int ai = 0; ai < 2; ++ai)
#pragma unroll
            for (int m = 0; m < 4; ++m) { bf16_t* rowp = base + (size_t)(row0 + ai * HALF + m * 16) * ldc + col0;
#pragma unroll
                for (int bj = 0; bj < 2; ++bj) { f32x4 v0 = acc[ai][bj][m][0] + bv[bj][0], v1 = acc[ai][bj][m][1] + bv[bj][1];
                    if (ACT == 1) { f32x2 a = gelu_pk((f32x2){v0[0], v0[1]}), b = gelu_pk((f32x2){v0[2], v0[3]}), c = gelu_pk((f32x2){v1[0], v1[1]}), d = gelu_pk((f32x2){v1[2], v1[3]});
                        v0 = (f32x4){a.x, a.y, b.x, b.y}; v1 = (f32x4){c.x, c.y, d.x, d.y}; }
                    v0 = v0 * sc; v1 = v1 * sc; u32x4 w; w.x = cvt_pk_bf16(v0[0], v0[1]); w.y = cvt_pk_bf16(v0[2], v0[3]); w.z = cvt_pk_bf16(v1[0], v1[1]); w.w = cvt_pk_bf16(v1[2], v1[3]);
                    *(u32x4*)(rowp + bj * HALF) = w; } }
    }
};
struct EpiResid {
    static constexpr bool PERM = false, AFTER_DRAIN = false;
    const float* base; float* out; const float* gate; int gstride;
    __device__ __forceinline__ void operator()(const f32x4 (&acc)[2][2][4][2], const Unit& u, int wr, int wc, int fr, int fq) const {
        const int row0 = u.pm * BM + wr * 64 + fr; const int col0 = u.pn * BM + wc * 32 + 4 * fq;
        const float* gp = gate + ((u.pm * BM) >= 8192 ? gstride : 0);
        f32x4 gv[2][2];
#pragma unroll
        for (int bj = 0; bj < 2; ++bj)
#pragma unroll
            for (int n = 0; n < 2; ++n) gv[bj][n] = *(const f32x4*)(gp + col0 + bj * HALF + n * 16);
#pragma unroll
        for (int ai = 0; ai < 2; ++ai)
#pragma unroll
            for (int m = 0; m < 4; ++m) { const size_t off = (size_t)(row0 + ai * HALF + m * 16) * 1024 + col0;
#pragma unroll
                for (int bj = 0; bj < 2; ++bj)
#pragma unroll
                    for (int n = 0; n < 2; ++n) { const f32x4 bs = *(const f32x4*)(base + off + bj * HALF + n * 16);
                        *(f32x4*)(out + off + bj * HALF + n * 16) = bs + gv[bj][n] * acc[ai][bj][m][n]; } }
    }
};
template <class Epi, class Sched, bool ALIGN_EPI = false, bool SP2 = false>
__device__ __forceinline__ void gemm_phase(PG8_LAS unsigned char* lds, const Gemm g, const Sched& S, const Epi& E) {
    int tid_l = threadIdx.x; asm volatile("" : "+v"(tid_l));
    const int tid = tid_l, wid = __builtin_amdgcn_readfirstlane(tid >> 6), lane = tid & 63, wr = wid >> 2, wc = wid & 3, fr = lane & 15, fq = lane >> 4;
    const int K = g.K, nt = K / BK;
    unsigned voffA[2], voffB[2];
#pragma unroll
    for (int i = 0; i < 2; ++i) { int R, C; stage_rc(tid * 16 + i * 8192, R, C); const int Rb = Epi::PERM ? ((R & ~31) + perm32(R & 31)) : R;
        voffA[i] = (unsigned)(R * K + C) * 2u; voffB[i] = (unsigned)(Rb * K + C) * 2u; }
    const size_t kstep = (size_t)(BK * 2);
    const size_t hstep = (size_t)HALF * K * 2;
    const size_t tstep = 2 * hstep;
    const unsigned ldsw = (unsigned)wid * 1024u;
    const int aoff = lds_byte(wr * 64 + fr, fq * 8), boff = lds_byte(wc * 32 + fr, fq * 8);
#define PG8_SA(b, h) (((b) * 2 + (h)) * HTB)
#define PG8_SB(b, h) ((4 + (b) * 2 + (h)) * HTB)
#define PG8_STAGE(bufoff, gbase, voff) do { _Pragma("unroll") for (int _i = 0; _i < 2; ++_i) \
        __builtin_amdgcn_global_load_lds((const unsigned*)((const char*)(gbase) + (voff)[_i]), (PG8_LAS unsigned*)(lds + (bufoff) + ldsw + _i * 8192), 16, 0, 0); } while (0)
#define PG8_LDA(dst, b, h) do { _Pragma("unroll") for (int m = 0; m < 4; ++m) _Pragma("unroll") for (int k = 0; k < 2; ++k) dst[m][k] = *(const PG8_LAS bf16x8*)(lds + PG8_SA(b, h) + aoff + m * 2048 + k * 1024); } while (0)
#define PG8_LDB(dst, b, h) do { _Pragma("unroll") for (int n = 0; n < 2; ++n) _Pragma("unroll") for (int k = 0; k < 2; ++k) dst[n][k] = *(const PG8_LAS bf16x8*)(lds + PG8_SB(b, h) + boff + n * 2048 + k * 1024); } while (0)
#define PG8_MMA(ai, bj, At, Bt) do { __builtin_amdgcn_s_setprio(1); _Pragma("unroll") for (int m = 0; m < 4; ++m) _Pragma("unroll") for (int n = 0; n < 2; ++n) _Pragma("unroll") for (int k = 0; k < 2; ++k) \
        acc[ai][bj][m][n] = __builtin_amdgcn_mfma_f32_16x16x32_bf16(Bt[n][k], At[m][k], acc[ai][bj][m][n], 0, 0, 0); __builtin_amdgcn_s_setprio(0); } while (0)
#define PG8_WAIT_V(n) asm volatile("s_waitcnt vmcnt(" #n ")" ::: "memory")
#define PG8_WAIT_L(n) asm volatile("s_waitcnt lgkmcnt(" #n ")" ::: "memory")
#define PG8_BAR __builtin_amdgcn_s_barrier()
#define PG8_SCHED __builtin_amdgcn_sched_barrier(0)
    Unit cur, nxt; int ui = 0;
    if (!S.next(0, cur)) return;
    f32x4 acc[2][2][4][2];
#pragma unroll
    for (int a = 0; a < 2; ++a)
#pragma unroll
        for (int b = 0; b < 2; ++b)
#pragma unroll
            for (int m = 0; m < 4; ++m)
#pragma unroll
                for (int n = 0; n < 2; ++n) acc[a][b][m][n] = (f32x4){0.f, 0.f, 0.f, 0.f};
    bf16x8 At[4][2], B0[2][2], B1[2][2];
    const char* cA = (const char*)g.A + (size_t)cur.pm * tstep; const char* cB = (const char*)g.Bt + (size_t)cur.pn * tstep;
    S.a_ready(cur);
    if constexpr (SP2) {
        PG8_STAGE(PG8_SB(0, 0), cB, voffB); PG8_STAGE(PG8_SB(0, 1), cB + hstep, voffB); PG8_STAGE(PG8_SA(0, 0), cA, voffA); PG8_STAGE(PG8_SA(0, 1), cA + hstep, voffA);
        if (wr == 1) PG8_BAR;
        PG8_WAIT_V(2); PG8_BAR;
        PG8_STAGE(PG8_SB(1, 0), cB + kstep, voffB); PG8_STAGE(PG8_SA(1, 0), cA + kstep, voffA); PG8_STAGE(PG8_SB(1, 1), cB + hstep + kstep, voffB);
        PG8_WAIT_V(6); PG8_BAR;
    } else {
        PG8_STAGE(PG8_SB(0, 0), cB, voffB); PG8_STAGE(PG8_SA(0, 0), cA, voffA); PG8_STAGE(PG8_SB(0, 1), cB + hstep, voffB); PG8_STAGE(PG8_SA(0, 1), cA + hstep, voffA);
        if (wr == 1) PG8_BAR;
        PG8_WAIT_V(4); PG8_BAR;
        PG8_STAGE(PG8_SB(1, 0), cB + kstep, voffB); PG8_STAGE(PG8_SA(1, 0), cA + kstep, voffA); PG8_STAGE(PG8_SB(1, 1), cB + hstep + kstep, voffB);
        PG8_WAIT_V(6); PG8_BAR;
    }
    for (;;) {
        const bool has_next = S.next(ui + 1, nxt);
        const char* nA = has_next ? (const char*)g.A + (size_t)nxt.pm * tstep : cA; const char* nB = has_next ? (const char*)g.Bt + (size_t)nxt.pn * tstep : cB;
        for (int t = 0; t < nt; t += 2) {
            const bool last = (t == nt - 2);
            const char* a1 = cA + (size_t)(t + 1) * kstep;
            const char* a2 = last ? nA : cA + (size_t)(t + 2) * kstep; const char* b2 = last ? nB : cB + (size_t)(t + 2) * kstep;
            const char* a3 = a2 + kstep; const char* b3 = b2 + kstep;
            if (last && has_next) S.a_ready(nxt);
            if constexpr (SP2) {
            PG8_LDB(B0, 0, 0); PG8_LDB(B1, 0, 1); PG8_SCHED; PG8_LDA(At, 0, 0); PG8_STAGE(PG8_SA(1, 1), a1 + hstep, voffA);
            PG8_WAIT_V(8); PG8_WAIT_L(0); PG8_BAR; PG8_MMA(0, 0, At, B0); PG8_MMA(0, 1, At, B1); PG8_BAR; PG8_SCHED;
            PG8_LDA(At, 0, 1); PG8_STAGE(PG8_SB(0, 0), b2, voffB); PG8_STAGE(PG8_SB(0, 1), b2 + hstep, voffB); PG8_STAGE(PG8_SA(0, 0), a2, voffA);
            PG8_WAIT_V(8); PG8_WAIT_L(0); PG8_BAR; PG8_MMA(1, 0, At, B0); PG8_MMA(1, 1, At, B1); PG8_BAR; PG8_SCHED;
            PG8_LDB(B0, 1, 0); PG8_LDB(B1, 1, 1); PG8_SCHED; PG8_LDA(At, 1, 0); PG8_STAGE(PG8_SA(0, 1), a2 + hstep, voffA);
            PG8_WAIT_V(8); PG8_WAIT_L(0); PG8_BAR; PG8_MMA(0, 0, At, B0); PG8_MMA(0, 1, At, B1); PG8_BAR; PG8_SCHED;
            PG8_LDA(At, 1, 1); PG8_STAGE(PG8_SB(1, 0), b3, voffB); PG8_STAGE(PG8_SB(1, 1), b3 + hstep, voffB); PG8_STAGE(PG8_SA(1, 0), a3, voffA);
            PG8_WAIT_V(8); PG8_WAIT_L(0); PG8_BAR; PG8_MMA(1, 0, At, B0); PG8_MMA(1, 1, At, B1); PG8_BAR; PG8_SCHED;
            } else {
            PG8_LDB(B0, 0, 0); PG8_SCHED; PG8_LDA(At, 0, 0); PG8_STAGE(PG8_SA(1, 1), a1 + hstep, voffA);
            PG8_WAIT_L(8); PG8_BAR; PG8_WAIT_L(0); PG8_MMA(0, 0, At, B0); PG8_BAR; PG8_SCHED;
            PG8_LDB(B1, 0, 1); PG8_STAGE(PG8_SB(0, 0), b2, voffB);
            PG8_BAR; PG8_WAIT_L(0); PG8_MMA(0, 1, At, B1); PG8_BAR;
            PG8_LDA(At, 0, 1); PG8_STAGE(PG8_SA(0, 0), a2, voffA);
            PG8_BAR; PG8_WAIT_L(0); PG8_MMA(1, 0, At, B0); PG8_BAR; PG8_SCHED;
            PG8_STAGE(PG8_SB(0, 1), b2 + hstep, voffB);
            PG8_WAIT_V(6); PG8_BAR; PG8_MMA(1, 1, At, B1); PG8_BAR;
            PG8_LDB(B0, 1, 0); PG8_SCHED; PG8_LDA(At, 1, 0); PG8_STAGE(PG8_SA(0, 1), a2 + hstep, voffA);
            PG8_WAIT_L(8); PG8_BAR; PG8_WAIT_L(0); PG8_MMA(0, 0, At, B0); PG8_BAR; PG8_SCHED;
            PG8_LDB(B1, 1, 1); PG8_STAGE(PG8_SB(1, 0), b3, voffB);
            PG8_BAR; PG8_WAIT_L(0); PG8_MMA(0, 1, At, B1); PG8_BAR;
            PG8_LDA(At, 1, 1); PG8_STAGE(PG8_SA(1, 0), a3, voffA);
            PG8_BAR; PG8_WAIT_L(0); PG8_MMA(1, 0, At, B0); PG8_BAR; PG8_SCHED;
            PG8_STAGE(PG8_SB(1, 1), b3 + hstep, voffB);
            PG8_WAIT_V(6); PG8_BAR; PG8_MMA(1, 1, At, B1); PG8_BAR;
            }
        }
        if constexpr (ALIGN_EPI) { if (wr == 0) PG8_BAR; }
        if constexpr (!Epi::AFTER_DRAIN) { E(acc, cur, wr, wc, fr, fq); S.done(cur); }
        if (!has_next) break;
#pragma unroll
        for (int a = 0; a < 2; ++a)
#pragma unroll
            for (int b = 0; b < 2; ++b)
#pragma unroll
                for (int m = 0; m < 4; ++m)
#pragma unroll
                    for (int n = 0; n < 2; ++n) acc[a][b][m][n] = (f32x4){0.f, 0.f, 0.f, 0.f};
        cur = nxt; cA = nA; cB = nB; ++ui;
        if constexpr (ALIGN_EPI) { if (wr == 1) PG8_BAR; }
    }
    PG8_WAIT_V(0);
    if constexpr (!ALIGN_EPI) { if (wr == 0) PG8_BAR; }
    PG8_BAR;
    if constexpr (Epi::AFTER_DRAIN) { E.fused(acc, cur, wr, wc, fr, fq, lds, wid, lane); S.done(cur); }
#undef PG8_SA
#undef PG8_SB
#undef PG8_STAGE
#undef PG8_LDA
#undef PG8_LDB
#undef PG8_MMA
#undef PG8_WAIT_V
#undef PG8_WAIT_L
#undef PG8_BAR
#undef PG8_SCHED
}
}
#ifndef PG8_SP2
#define PG8_SP2 true
#endif
#ifndef PG8_ALIGN
#define PG8_ALIGN true
#endif
#ifndef MK_ONE_LAUNCH
#define MK_ONE_LAUNCH 1
#endif

constexpr int NWAVES = 8, NTHR = NWAVES * 64;
constexpr int BATCH = 2, SEQ = 8192, D = 1024, T = BATCH * SEQ, DEPTH = 4;
constexpr int EVEN_IN = 2048, ODD_LD = 3848, ODD_N = 3840;
constexpr int NEXP = 16384;
constexpr float NORM_EPS = 1e-6f, GN_EPS = 64e-5f;

constexpr size_t MiB = 1u << 20;
constexpr size_t WS_CTL = 0, CTL_ZERO_BYTES = 1 * MiB;
constexpr size_t WS_MOD = 1 * MiB;
constexpr size_t WS_WF = WS_MOD + 256 * 1024;
constexpr size_t WS_KEYS = WS_MOD + 512 * 1024;
constexpr size_t WS_LOGF = 2 * MiB;
constexpr size_t WS_DCUM = 2 * MiB + 512 * 1024;
constexpr size_t WS_WIN = 4 * MiB;
constexpr size_t WS_WOUT = 36 * MiB;
constexpr size_t WS_WQ = 44 * MiB;
constexpr size_t WS_H = 64 * MiB;
constexpr size_t WS_MIX = 96 * MiB;
constexpr size_t WS_PROJ = 128 * MiB;
constexpr size_t WS_Q = 256 * MiB;
constexpr size_t WS_IDX = 320 * MiB;
constexpr size_t WS_GATE = 328 * MiB;
constexpr size_t WS_RW = 336 * MiB;
constexpr size_t RW_SLOT = 32 * MiB;
constexpr size_t WS_END = WS_RW + 8 * RW_SLOT;
constexpr int CW_WORK = 64;
constexpr int CW_BAR = 4096;

constexpr int RING_OFF = 0, RING_BYTES = 131072;
constexpr int MISC_OFF = 143360;
constexpr int LDS_BYTES = 147456;

#define GAS __attribute__((address_space(1)))
#define LAS __attribute__((address_space(3)))
typedef unsigned short bf16;
typedef unsigned v4u __attribute__((ext_vector_type(4)));
typedef unsigned v2u __attribute__((ext_vector_type(2)));
typedef float f32x4 __attribute__((ext_vector_type(4)));
typedef short bf16x8 __attribute__((ext_vector_type(8)));
typedef GAS unsigned gu32;
#define LDS_WAIT() asm volatile("s_waitcnt lgkmcnt(0)" ::: "memory")
#define VM_WAIT() asm volatile("s_waitcnt vmcnt(0)" ::: "memory")
__device__ __forceinline__ unsigned f2bf(float f) { unsigned u = __builtin_bit_cast(unsigned, f); return (u + 0x7fffu + ((u >> 16) & 1u)) >> 16; }
__device__ __forceinline__ unsigned pk2(float lo, float hi) { return f2bf(lo) | (f2bf(hi) << 16); }
__device__ __forceinline__ float bf2f(bf16 v) { return __builtin_bit_cast(float, (unsigned)v << 16); }
__device__ __forceinline__ float bflo(unsigned w) { return __builtin_bit_cast(float, w << 16); }
__device__ __forceinline__ float bfhi(unsigned w) { return __builtin_bit_cast(float, w & 0xffff0000u); }
__device__ __forceinline__ float wave_sum(float v) {
#pragma unroll
    for (int o = 1; o < 64; o <<= 1) v += __shfl_xor(v, o);
    return v;
}
__device__ __forceinline__ float wave_max(float v) {
#pragma unroll
    for (int o = 1; o < 64; o <<= 1) v = fmaxf(v, __shfl_xor(v, o));
    return v;
}
__device__ __forceinline__ float rl(float x, int j) { return __builtin_bit_cast(float, __builtin_amdgcn_readlane(__builtin_bit_cast(int, x), j)); }
__device__ __forceinline__ float sigmoidf_(float x) { return 1.f / (1.f + expf(-x)); }
__device__ __forceinline__ float softplusf_(float x) { return fmaxf(x, 0.f) + log1pf(expf(-fabsf(x))); }
__device__ __forceinline__ float gelu_erf(float x) { return 0.5f * x * (1.f + erff(x * 0.70710678118654752f)); }

#define XB_TMO      128
#define XB_XCNT(j)  (256  + 64 * (j))
#define XB_XSUB(j)  (1280 + 64 * (j))
#define XB_XGEN(j)  (2304 + 64 * (j))
#define XB_TOP      3328
#define XB_TOPGEN   3392
#define XCD_BAR_WORDS 3456
#define XB_SPIN_CAP (1u << 18)

__device__ __forceinline__ unsigned xb_ld(unsigned* p)              { return __hip_atomic_load(p, __ATOMIC_RELAXED, __HIP_MEMORY_SCOPE_AGENT); }
__device__ __forceinline__ unsigned xb_add(unsigned* p, unsigned v) { return __hip_atomic_fetch_add(p, v, __ATOMIC_RELAXED, __HIP_MEMORY_SCOPE_AGENT); }
__device__ __forceinline__ unsigned xb_xcc_id() { return (unsigned)__builtin_amdgcn_s_getreg((3 << 11) | 20) & 0xFu; }
#define XB_SPIN(cond, bar) do { unsigned _sp = 0; while (cond) { __builtin_amdgcn_s_sleep(1); \
    if ((++_sp & 255u) == 0u) { if (xb_ld(&(bar)[XB_TMO])) break; if (_sp > XB_SPIN_CAP) { atomicAdd(&(bar)[XB_TMO], 1u); break; } } } } while (0)

struct XcdBarrier {
    unsigned* bar; unsigned x;
    volatile LAS unsigned* st;
};

__device__ __forceinline__ XcdBarrier xcd_barrier_post(unsigned* bar, volatile LAS unsigned* st) {
    XcdBarrier b; b.bar = bar; b.x = xb_xcc_id(); b.st = st;
    if (threadIdx.x == 0) (void)xb_add(&bar[XB_XCNT(b.x)], 1u);
    return b;
}
__device__ __forceinline__ void xcd_barrier_complete(unsigned* bar, unsigned x, unsigned& nloc, unsigned& nx) {
    const unsigned G = gridDim.x * gridDim.y * gridDim.z;
    unsigned sum, cnt, mine, sp = 0u;
    for (;;) {
        sum = 0u; cnt = 0u; mine = 0u;
#pragma unroll
        for (unsigned j = 0; j < 16; ++j) { const unsigned c = xb_ld(&bar[XB_XCNT(j)]); sum += c; cnt += (c > 0u) ? 1u : 0u; mine = (j == x) ? c : mine; }
        if (sum == G) break;
        __builtin_amdgcn_s_sleep(1);
        if ((++sp & 255u) == 0u) { if (xb_ld(&bar[XB_TMO])) break; if (sp > XB_SPIN_CAP) { atomicAdd(&bar[XB_TMO], 1u); break; } }
    }
    nloc = mine > 0u ? mine : 1u; nx = cnt > 0u ? cnt : 1u;
}

__device__ __forceinline__ void xcd_barrier(const XcdBarrier& b) {
    asm volatile("s_waitcnt vmcnt(0)" ::: "memory");
    __syncthreads();
    if (threadIdx.x == 0) {
        unsigned* bar = b.bar;
        __builtin_amdgcn_s_waitcnt(0);
        unsigned nloc = b.st[0], nx = b.st[1];
        if (nloc == 0u) { xcd_barrier_complete(bar, b.x, nloc, nx); b.st[0] = nloc; b.st[1] = nx; }
        const unsigned old = xb_add(&bar[XB_XSUB(b.x)], 1u);
        const unsigned gen = old / nloc;
        if (old + 1u == (gen + 1u) * nloc) {
            __builtin_amdgcn_fence(__ATOMIC_RELEASE, "agent");
            asm volatile("s_waitcnt vmcnt(0)" ::: "memory");
            const unsigned og = xb_add(&bar[XB_TOP], 1u);
            const unsigned tg = og / nx;
            if (og + 1u == (tg + 1u) * nx) xb_add(&bar[XB_TOPGEN], 1u);
            else XB_SPIN(xb_ld(&bar[XB_TOPGEN]) == tg, bar);
            __builtin_amdgcn_fence(__ATOMIC_ACQUIRE, "agent");
            xb_add(&bar[XB_XGEN(b.x)], 1u);
            asm volatile("s_waitcnt vmcnt(0)" ::: "memory");
        } else {
            XB_SPIN(xb_ld(&bar[XB_XGEN(b.x)]) == gen, bar);
            __builtin_amdgcn_fence(__ATOMIC_ACQUIRE, "agent");
            asm volatile("s_waitcnt vmcnt(0)" ::: "memory");
        }
    }
    __syncthreads();
}


struct Frame {
    LAS unsigned char* lds;
    volatile LAS unsigned* MISC;
    gu32* ctl;
    int tid, lane, wave, G, bid;
};
struct Args { const float* in[32]; float* out; unsigned char* ws; int ph_lo, ph_hi; };
#define CAS __attribute__((address_space(4)))
#define KARGS const CAS Args* ka_; { unsigned long long kp_ = (unsigned long long)__builtin_amdgcn_kernarg_segment_ptr(); asm volatile("" : "+s"(kp_)); ka_ = (const CAS Args*)kp_; } unsigned char* const ws_ = ka_->ws
#define IN(i) (ka_->in[i])
#define OUTP (ka_->out)
#define WSP(type, off) ((type*)(ws_ + (off)))

__device__ __forceinline__ void transpose_item(const float* W, int ldw, bf16* WT, int row_off, LAS float* scr, int item, int nblk, int lane) {
    const int kb = item / nblk, nb = item % nblk, k0 = 64 * kb, n0 = 32 * nb;
#pragma unroll 8
    for (int i = 0; i < 32; ++i) { const int kk = 2 * i + (lane >> 5); scr[kk * 33 + (lane & 31)] = W[(size_t)(k0 + kk) * ldw + n0 + (lane & 31)]; }
    LDS_WAIT(); asm volatile("" ::: "memory");
    const int c = lane & 7;
#pragma unroll
    for (int j = 0; j < 4; ++j) { const int n = (lane >> 3) + 8 * j; const LAS float* s = scr + (8 * c) * 33 + n;
        v4u o; o.x = pk2(s[0 * 33], s[1 * 33]); o.y = pk2(s[2 * 33], s[3 * 33]); o.z = pk2(s[4 * 33], s[5 * 33]); o.w = pk2(s[6 * 33], s[7 * 33]);
        *(v4u*)(WT + (size_t)(row_off + n0 + n) * 1024 + k0 + 8 * c) = o; }
    LDS_WAIT(); asm volatile("" ::: "memory");
}

__device__ __forceinline__ void phase_prologue(Frame& F) {
    KARGS;
    LAS float* cact = (LAS float*)F.lds;
    LAS float* part = cact + 2048;
    {   const float* c = IN(1);
        for (int i = F.tid; i < 2048; i += NTHR) { const float v = c[i]; cact[i] = v / (1.f + expf(-v)); } }
    __syncthreads();
    {
        const float* ada_w = IN(2); const float* ada_b = IN(3); float* MOD = WSP(float, WS_MOD);
        for (int it = F.bid; it < 384; it += F.G) {
            const int l = it / 96, j0 = (it % 96) * 64;
            const float* wp = ada_w + ((size_t)l * 1024 + F.wave * 128) * 6144 + j0 + F.lane;
            float a0 = 0.f, a1 = 0.f;
#pragma unroll 8
            for (int k = 0; k < 128; ++k) { const float w = wp[(size_t)k * 6144]; a0 += cact[F.wave * 128 + k] * w; a1 += cact[1024 + F.wave * 128 + k] * w; }
            part[(F.wave * 2 + 0) * 64 + F.lane] = a0; part[(F.wave * 2 + 1) * 64 + F.lane] = a1;
            __syncthreads();
            if (F.tid < 128) { const int b = F.tid >> 6, col = F.tid & 63; float s = 0.f;
#pragma unroll
                for (int w = 0; w < 8; ++w) s += part[(w * 2 + b) * 64 + col];
                MOD[(l * 2 + b) * 6144 + j0 + col] = s + ada_b[l * 6144 + j0 + col]; }
            __syncthreads();
        }
    }
    {
        LAS float* scr = (LAS float*)(F.lds + 16384 + F.wave * 8448);
        const int gw = F.bid * NWAVES + F.wave, NGW = F.G * NWAVES;
        constexpr int I_A = 16 * 64, I_B = 16 * 64, I_C = 16 * 56, I_D = 16 * 32, I_E = 16 * 64;
        constexpr int NITEMS = 2 * I_A + 2 * I_B + 2 * I_C + 4 * I_D + 4 * I_E;
        for (int it = gw; it < NITEMS; it += NGW) {
            int r = it;
            if (r < 2 * I_A) { const int j = r / I_A; transpose_item(IN(6) + (size_t)j * 1024 * 2048, 2048, WSP(bf16, WS_WIN + (size_t)(2 * j) * 8 * MiB), 0, scr, r % I_A, 64, F.lane); continue; } r -= 2 * I_A;
            if (r < 2 * I_B) { const int j = r / I_B; transpose_item(IN(10) + (size_t)j * 1024 * ODD_LD, ODD_LD, WSP(bf16, WS_WIN + (size_t)(2 * j + 1) * 8 * MiB), 0, scr, r % I_B, 64, F.lane); continue; } r -= 2 * I_B;
            if (r < 2 * I_C) { const int j = r / I_C; transpose_item(IN(10) + (size_t)j * 1024 * ODD_LD + 2056, ODD_LD, WSP(bf16, WS_WIN + (size_t)(2 * j + 1) * 8 * MiB), 2048, scr, r % I_C, 56, F.lane); continue; } r -= 2 * I_C;
            if (r < 4 * I_D) { const int l = r / I_D; const int j = l >> 1; const float* src = (l & 1) ? IN(11) : IN(7);
                transpose_item(src + (size_t)j * 1024 * 1024, 1024, WSP(bf16, WS_WOUT + (size_t)l * 2 * MiB), 0, scr, r % I_D, 32, F.lane); continue; } r -= 4 * I_D;
            { const int l = r / I_E; transpose_item(IN(26) + (size_t)l * 1024 * 2048, 2048, WSP(bf16, WS_WQ + (size_t)l * 4 * MiB), 0, scr, r % I_E, 64, F.lane); }
        }
    }
    {
        const int gt = F.bid * NTHR + F.tid, NGT = F.G * NTHR;
        float* WF = WSP(float, WS_WF);
        for (int i = gt; i < 2 * 8 * 1024; i += NGT) { const int j = i >> 13, h = (i >> 10) & 7, k = i & 1023; WF[i] = IN(10)[((size_t)j * 1024 + k) * ODD_LD + 2048 + h]; }
        bf16* KEYS = WSP(bf16, WS_KEYS);
        for (int i = gt; i < 4 * 16384; i += NGT) { const int l = i >> 14, r = i & 16383;
            KEYS[(size_t)(l * 2 + 0) * 16384 + r] = (bf16)f2bf(IN(27)[i]); KEYS[(size_t)(l * 2 + 1) * 16384 + r] = (bf16)f2bf(IN(28)[i]); }
    }
}

__device__ __forceinline__ void phase_norm(Frame& F, int layer, int which) {
    KARGS;
    const float* X = (layer == 0 && which == 0) ? IN(0) : OUTP;
    const float* gain = (which ? IN(5) : IN(4)) + layer * 1024;
    const float* mod = WSP(float, WS_MOD) + (size_t)layer * 2 * 6144 + (which ? 3072 : 0);
    bf16* H = WSP(bf16, WS_H);
    const bool do_f = (layer & 1) && which == 0;
    const int jj = layer >> 1;
    const float* WF = WSP(float, WS_WF) + (size_t)jj * 8 * 1024;
    float* LOGF = WSP(float, WS_LOGF);
    const int gw = F.bid * NWAVES + F.wave, NGW = F.G * NWAVES, lane = F.lane;
    f32x4 gn[4];
#pragma unroll
    for (int j = 0; j < 4; ++j) gn[j] = *(const f32x4*)(gain + 256 * j + 4 * lane);
    for (int row = gw; row < T; row += NGW) {
        const int b = row >= SEQ ? 1 : 0;
        const float* sh = mod + b * 6144; const float* sc = sh + 1024;
        const float* xr = X + (size_t)row * D + 4 * lane;
        f32x4 v[4]; float ss = 0.f;
#pragma unroll
        for (int j = 0; j < 4; ++j) { v[j] = *(const f32x4*)(xr + 256 * j); ss += (v[j].x * v[j].x + v[j].y * v[j].y) + (v[j].z * v[j].z + v[j].w * v[j].w); }
        const float rstd = rsqrtf(wave_sum(ss) * (1.f / D) + NORM_EPS);
        bf16* hr = H + (size_t)row * D + 4 * lane;
#pragma unroll
        for (int j = 0; j < 4; ++j) { const f32x4 s4 = *(const f32x4*)(sc + 256 * j + 4 * lane), h4 = *(const f32x4*)(sh + 256 * j + 4 * lane);
            v[j] = v[j] * rstd * gn[j] * (s4 + 1.f) + h4;
            v2u o; o.x = pk2(v[j].x, v[j].y); o.y = pk2(v[j].z, v[j].w); *(v2u*)(hr + 256 * j) = o; }
        if (do_f) {
            const float* fb = IN(14) + jj * 8;
            const int t = row - b * SEQ;
#pragma unroll
            for (int hh = 0; hh < 8; ++hh) { float d = 0.f;
#pragma unroll
                for (int j = 0; j < 4; ++j) { const f32x4 w4 = *(const f32x4*)(WF + hh * 1024 + 256 * j + 4 * lane); d += (v[j].x * w4.x + v[j].y * w4.y) + (v[j].z * w4.z + v[j].w * w4.w); }
                d = wave_sum(d) + fb[hh];
                const float lf = fminf(d, 0.f) - log1pf(expf(-fabsf(d)));
                if (lane == 0) LOGF[(size_t)(b * 8 + hh) * SEQ + t] = lf; }
        }
    }
}

__device__ __forceinline__ void load_q64(float (&q)[64], const bf16* p, float scale) {
#pragma unroll
    for (int c = 0; c < 8; ++c) { const v4u w = *(const v4u*)(p + 8 * c);
        q[8 * c + 0] = bflo(w.x) * scale; q[8 * c + 1] = bfhi(w.x) * scale; q[8 * c + 2] = bflo(w.y) * scale; q[8 * c + 3] = bfhi(w.y) * scale;
        q[8 * c + 4] = bflo(w.z) * scale; q[8 * c + 5] = bfhi(w.z) * scale; q[8 * c + 6] = bflo(w.w) * scale; q[8 * c + 7] = bfhi(w.w) * scale; }
}
__device__ __forceinline__ float dot_q64(const float (&q)[64], const bf16* p) {
    float z0 = 0.f, z1 = 0.f;
#pragma unroll
    for (int c = 0; c < 8; ++c) { const v4u w = *(const v4u*)(p + 8 * c);
        z0 += q[8 * c + 0] * bflo(w.x) + q[8 * c + 2] * bflo(w.y) + q[8 * c + 4] * bflo(w.z) + q[8 * c + 6] * bflo(w.w);
        z1 += q[8 * c + 1] * bfhi(w.x) + q[8 * c + 3] * bfhi(w.y) + q[8 * c + 5] * bfhi(w.z) + q[8 * c + 7] * bfhi(w.w); }
    return z0 + z1;
}
__device__ __forceinline__ void phase_even_mixer(Frame& F, int layer) {
    KARGS;
    const bf16* P = WSP(bf16, WS_PROJ); bf16* MIX = WSP(bf16, WS_MIX);
    const int lane = F.lane;
    {
        const int gw = F.bid * NWAVES + F.wave, NGW = F.G * NWAVES;
        for (int it = gw; it < BATCH * 8 * SEQ; it += NGW) {
            const int b = it >> 16, h = (it >> 13) & 7, t = it & 8191;
            const bf16* base = P + (size_t)b * SEQ * EVEN_IN;
            float q[64]; load_q64(q, base + (size_t)t * EVEN_IN + h * 64, 0.125f);
            float acc = 0.f, carry = 0.f;
            for (int s0 = t - 1; s0 >= 0; s0 -= 64) {
                const int s = s0 - lane; const bool valid = s >= 0; const int sc = valid ? s : 0;
                const float z = dot_q64(q, base + (size_t)sc * EVEN_IN + 512 + h * 64);
                const float sp = softplusf_(z);
                const float l1m = valid ? -sp : 0.f;
                const float lb = z - sp;
                float inc = l1m;
#pragma unroll
                for (int o = 1; o < 64; o <<= 1) { const float n = __shfl_up(inc, o); if (lane >= o) inc += n; }
                const float w = valid ? expf(lb + carry + (inc - l1m)) : 0.f;
                const float tot = __shfl(inc, 63);
#pragma unroll 16
                for (int j = 0; j < 64; ++j) { const float wj = rl(w, j); int sj = s0 - j; sj = sj < 0 ? 0 : sj;
                    acc += wj * bf2f(base[(size_t)sj * EVEN_IN + 1024 + h * 64 + lane]); }
                carry += tot;
                if (carry < -104.f) break;
            }
            MIX[((size_t)b * SEQ + t) * D + h * 64 + lane] = (bf16)f2bf(acc);
        }
    }
    {
        LAS float* pl = (LAS float*)F.lds;
        const int jj = layer >> 1;
        const float* pw = IN(8) + (size_t)jj * 4 * 128 * 128; const float* ps = IN(9) + jj * 512;
        const int c = F.tid, g = c >> 7, w = 2 << g, d = c & 127;
        for (int tile = F.bid; tile < T / 32; tile += F.G) {
            const int t0 = tile * 32, b = t0 / SEQ, tl0 = t0 % SEQ;
            const bf16* base = P + (size_t)b * SEQ * EVEN_IN + 1536 + c;
            for (int tt = 0; tt < 32; ++tt) { const int tl = tl0 + tt, cend = (tl / 64 + 1) * 64;
                int lo = tl - w / 2; lo = lo < 0 ? 0 : lo; int hi = tl + w / 2; hi = hi > cend ? cend : hi;
                float s = 0.f; for (int u = lo; u < hi; ++u) s += bf2f(base[(size_t)u * EVEN_IN]);
                pl[c * 33 + tt] = s / (float)(hi - lo) - bf2f(base[(size_t)tl * EVEN_IN]); }
            __syncthreads();
            float acc[32];
#pragma unroll
            for (int tt = 0; tt < 32; ++tt) acc[tt] = 0.f;
            for (int cc = 0; cc < 128; ++cc) { const float wv = pw[((size_t)g * 128 + cc) * 128 + d]; const LAS float* pr = pl + (g * 128 + cc) * 33;
#pragma unroll
                for (int tt = 0; tt < 32; ++tt) acc[tt] += pr[tt] * wv; }
            const float sc = ps[c];
#pragma unroll
            for (int tt = 0; tt < 32; ++tt) MIX[(size_t)(t0 + tt) * D + 512 + c] = (bf16)f2bf(acc[tt] * sc);
            __syncthreads();
        }
    }
}

__device__ __forceinline__ void phase_odd_prep(Frame& F, int layer) {
    KARGS;
    const int jj = layer >> 1, lane = F.lane;
    bf16* P = WSP(bf16, WS_PROJ);
    if (F.wave == 0 && F.bid < 16) {
        const float* lf = WSP(float, WS_LOGF) + (size_t)F.bid * SEQ; float* dc = WSP(float, WS_DCUM) + (size_t)F.bid * SEQ; double carry = 0.0;
        for (int t0 = 0; t0 < SEQ; t0 += 64) { float inc = lf[t0 + lane];
#pragma unroll
            for (int o = 1; o < 64; o <<= 1) { const float n = __shfl_up(inc, o); if (lane >= o) inc += n; }
            dc[t0 + lane] = (float)(carry + (double)inc); carry += (double)__shfl(inc, 63); }
    }
    LAS float* lx = (LAS float*)F.lds;
    const float* mix = IN(15) + jj * 1792;
    const float* w0 = IN(16) + jj * 512; const float* w2 = IN(17) + (size_t)jj * 64 * 512;
    const float* a0 = IN(18) + jj * 512; const float* a2 = IN(19) + (size_t)jj * 64 * 512;
    const float* g2 = IN(20) + (size_t)jj * 128 * 512;
    const float* kkp = IN(21) + jj * 512; const float* kap = IN(22) + jj * 512;
    const float* qn = IN(12) + jj * 64; const float* kn = IN(13) + jj * 64;
    float* R = WSP(float, WS_RW); float* Wd = WSP(float, WS_RW + RW_SLOT); float* K = WSP(float, WS_RW + 2 * RW_SLOT); float* V = WSP(float, WS_RW + 3 * RW_SLOT);
    float* KK = WSP(float, WS_RW + 4 * RW_SLOT); float* A = WSP(float, WS_RW + 5 * RW_SLOT); float* Gt = WSP(float, WS_RW + 6 * RW_SLOT);
    const int ch = F.tid;
    const float m_r = mix[ch], m_k = mix[512 + ch], m_v = mix[1024 + ch];
    const float w0c = w0[ch], a0c = a0[ch], kkc = kkp[ch], kac = kap[ch], qnc = qn[ch & 63], knc = kn[ch & 63];
    for (int item = F.bid; item < T / 16; item += F.G) {
        const int t0 = item * 16;
        for (int i = F.tid; i < 16 * 256; i += NTHR) { const int tt = i >> 8, j = i & 255, tg = t0 + tt, tl = tg % SEQ, col = 1536 + j;
            const float cur = bf2f(P[(size_t)tg * ODD_N + 2048 + col]); const float prev = tl > 0 ? bf2f(P[(size_t)(tg - 1) * ODD_N + 2048 + col]) : 0.f;
            const float x = cur + (prev - cur) * mix[col];
            lx[i] = j < 64 ? tanhf(x) : (j < 128 ? x : sigmoidf_(x)); }
        __syncthreads();
        float aw[16], aa[16], ag[16];
#pragma unroll
        for (int tt = 0; tt < 16; ++tt) { aw[tt] = 0.f; aa[tt] = 0.f; ag[tt] = 0.f; }
        for (int i = 0; i < 64; ++i) { const float w2v = w2[i * 512 + ch], a2v = a2[i * 512 + ch];
#pragma unroll
            for (int tt = 0; tt < 16; ++tt) { aw[tt] += lx[tt * 256 + i] * w2v; aa[tt] += lx[tt * 256 + 64 + i] * a2v; } }
        for (int i = 0; i < 128; ++i) { const float g2v = g2[i * 512 + ch];
#pragma unroll
            for (int tt = 0; tt < 16; ++tt) ag[tt] += lx[tt * 256 + 128 + i] * g2v; }
#pragma unroll
        for (int tt = 0; tt < 16; ++tt) { const int tg = t0 + tt, tl = tg % SEQ;
            const bf16* pc = P + (size_t)tg * ODD_N + 2048 + ch; const bf16* pp = pc - ODD_N;
            const float rc = bf2f(pc[0]), kc = bf2f(pc[512]), vc = bf2f(pc[1024]);
            const float rp = tl > 0 ? bf2f(pp[0]) : 0.f, kp = tl > 0 ? bf2f(pp[512]) : 0.f, vp = tl > 0 ? bf2f(pp[1024]) : 0.f;
            const float r = rc + (rp - rc) * m_r, kr = kc + (kp - kc) * m_k, vr = vc + (vp - vc) * m_v;
            const float wl = -softplusf_(-(w0c + aw[tt])) - 0.5f; const float decay = expf(-expf(wl));
            const float a = sigmoidf_(a0c + aa[tt]);
            const float kkv = kr * kkc; const float n2 = wave_sum(kkv * kkv); const float kkn = kkv / fmaxf(sqrtf(n2), 1e-12f);
            const float kmod = kr * (1.f + (a - 1.f) * kac);
            const size_t o = (size_t)tg * 512 + ch;
            R[o] = r; Wd[o] = decay; K[o] = kmod; V[o] = vr; KK[o] = kkn; A[o] = a; Gt[o] = ag[tt];
            bf16* pq = P + (size_t)tg * ODD_N + ch;
            const float qv = bf2f(pq[0]), kv = bf2f(pq[512]);
            const float qs = wave_sum(qv * qv) * (1.f / 64.f), ks = wave_sum(kv * kv) * (1.f / 64.f);
            pq[0] = (bf16)f2bf(qv * rsqrtf(qs + NORM_EPS) * qnc); pq[512] = (bf16)f2bf(kv * rsqrtf(ks + NORM_EPS) * knc); }
        __syncthreads();
    }
}

__device__ __forceinline__ void rwkv_scan_simple(Frame& F, int sid) {
    KARGS;
    const int b = sid >> 3, h = sid & 7, lane = F.lane;
    const size_t base = (size_t)b * SEQ * 512 + h * 64 + lane;
    const float* R = WSP(float, WS_RW); const float* Wd = WSP(float, WS_RW + RW_SLOT); const float* K = WSP(float, WS_RW + 2 * RW_SLOT); const float* V = WSP(float, WS_RW + 3 * RW_SLOT);
    const float* KK = WSP(float, WS_RW + 4 * RW_SLOT); const float* A = WSP(float, WS_RW + 5 * RW_SLOT); float* Y = WSP(float, WS_RW + 7 * RW_SLOT);
    float st[64];
#pragma unroll
    for (int j = 0; j < 64; ++j) st[j] = 0.f;
    float r_n = R[base], w_n = Wd[base], k_n = K[base], v_n = V[base], kk_n = KK[base], a_n = A[base];
    for (int t = 0; t < SEQ; ++t) {
        const float r = r_n, w = w_n, k = k_n, v = v_n, kk = kk_n, ka = kk_n * a_n;
        if (t + 1 < SEQ) { const size_t o = base + (size_t)(t + 1) * 512; r_n = R[o]; w_n = Wd[o]; k_n = K[o]; v_n = V[o]; kk_n = KK[o]; a_n = A[o]; }
        float sa = 0.f;
#pragma unroll
        for (int j = 0; j < 64; ++j) sa += st[j] * rl(kk, j);
        float y = 0.f;
#pragma unroll
        for (int j = 0; j < 64; ++j) { st[j] = st[j] * rl(w, j) - sa * rl(ka, j) + v * rl(k, j); y += st[j] * rl(r, j); }
        Y[base + (size_t)t * 512] = y;
    }
}
__device__ __forceinline__ void phase_odd_main(Frame& F, int layer) {
    KARGS;
    const int lane = F.lane;
    if (F.wave == 7 && F.bid < 16) rwkv_scan_simple(F, F.bid);
    const bf16* P = WSP(bf16, WS_PROJ); bf16* MIX = WSP(bf16, WS_MIX); const float* DC = WSP(float, WS_DCUM);
    unsigned* ctr = (unsigned*)F.ctl + CW_WORK + 64 * layer;
    for (;;) {
        unsigned g0 = 0; if (lane == 0) g0 = atomicAdd(ctr, 1u); g0 = (unsigned)__builtin_amdgcn_readfirstlane((int)g0);
        if (g0 >= (unsigned)(BATCH * 8 * SEQ / 16)) break;
        for (int ii = 0; ii < 16; ++ii) {
            const int it = (int)g0 * 16 + ii;
            const int b = it >> 16, h = (it >> 13) & 7, t = it & 8191;
            const bf16* base = P + (size_t)b * SEQ * ODD_N; const float* dc = DC + (size_t)(b * 8 + h) * SEQ;
            float q[64]; load_q64(q, base + (size_t)t * ODD_N + h * 64, 0.125f);
            const float dt = dc[t];
            float m = -INFINITY, l = 0.f, acc = 0.f;
            for (int s0 = t; s0 >= 0; s0 -= 64) {
                const int s = s0 - lane; const bool valid = s >= 0; const int sc = valid ? s : 0;
                float z = dot_q64(q, base + (size_t)sc * ODD_N + 512 + h * 64) + (dt - dc[sc]);
                z = valid ? z : -INFINITY;
                const float mn = fmaxf(m, wave_max(z));
                const float corr = expf(m - mn);
                const float p = valid ? expf(z - mn) : 0.f;
                l = l * corr + wave_sum(p); acc *= corr; m = mn;
#pragma unroll 16
                for (int j = 0; j < 64; ++j) { const float pj = rl(p, j); int sj = s0 - j; sj = sj < 0 ? 0 : sj;
                    acc += pj * bf2f(base[(size_t)sj * ODD_N + 1024 + h * 64 + lane]); }
            }
            const float gate = bf2f(base[(size_t)t * ODD_N + 1536 + h * 64 + lane]);
            MIX[((size_t)b * SEQ + t) * D + h * 64 + lane] = (bf16)f2bf(acc / l * sigmoidf_(gate));
        }
    }
}

__device__ __forceinline__ void phase_rwkv_post(Frame& F, int layer) {
    KARGS;
    const int jj = layer >> 1, ch = F.tid;
    const float* R = WSP(float, WS_RW); const float* K = WSP(float, WS_RW + 2 * RW_SLOT); const float* V = WSP(float, WS_RW + 3 * RW_SLOT);
    const float* Gt = WSP(float, WS_RW + 6 * RW_SLOT); const float* Y = WSP(float, WS_RW + 7 * RW_SLOT);
    bf16* MIX = WSP(bf16, WS_MIX);
    const float lw = IN(24)[jj * 512 + ch], lb = IN(25)[jj * 512 + ch], rk = IN(23)[jj * 512 + ch];
    for (int tg = F.bid; tg < T; tg += F.G) {
        const size_t o = (size_t)tg * 512 + ch;
        const float y = Y[o]; const float mu = wave_sum(y) * (1.f / 64.f); const float dlt = y - mu; const float var = wave_sum(dlt * dlt) * (1.f / 64.f);
        const float yn = dlt * rsqrtf(var + GN_EPS) * lw + lb;
        const float v = V[o]; const float bonus = wave_sum(R[o] * K[o] * rk) * v;
        MIX[(size_t)tg * D + 512 + ch] = (bf16)f2bf((yn + bonus) * Gt[o]);
    }
}

#define BUBBLE(x_, V_) do { float bx_ = (x_); _Pragma("unroll") for (int p_ = 0; p_ < 16; ++p_) { const float hi_ = fmaxf(bx_, V_[p_]); bx_ = fminf(bx_, V_[p_]); V_[p_] = hi_; } } while (0)
__device__ __forceinline__ float pack_low(float v, unsigned bits, unsigned mask) { return __builtin_bit_cast(float, (__builtin_bit_cast(unsigned, v) & ~mask) | bits); }
__device__ __forceinline__ void phase_peer_topk(Frame& F, int layer) {
    KARGS;
    const bf16* Q = WSP(bf16, WS_Q); const bf16* KEYS = WSP(bf16, WS_KEYS) + (size_t)layer * 2 * 16384;
    int* IDX = WSP(int, WS_IDX); float* GATE = WSP(float, WS_GATE);
    LAS float* sc = (LAS float*)(F.lds + F.wave * 16512);
    LAS unsigned* li = (LAS unsigned*)sc;
    const int lane = F.lane, fr = lane & 15, fq = lane >> 4;
    const int gw = F.bid * NWAVES + F.wave, NGW = F.G * NWAVES;
    for (int it = gw; it < (T / 32) * 8; it += NGW) {
        const int tile = it >> 3, h = it & 7, t0 = tile * 32;
        float v1[16], v2[16];
#pragma unroll
        for (int half = 0; half < 2; ++half) {
            f32x4 acc[2][8];
#pragma unroll
            for (int rt = 0; rt < 2; ++rt)
#pragma unroll
                for (int ct = 0; ct < 8; ++ct) acc[rt][ct] = (f32x4){0.f, 0.f, 0.f, 0.f};
            const bf16* kb = KEYS + (size_t)half * 16384;
#pragma unroll 1
            for (int ks = 0; ks < 4; ++ks) {
                bf16x8 a[2];
#pragma unroll
                for (int rt = 0; rt < 2; ++rt) a[rt] = *(const bf16x8*)(Q + (size_t)(t0 + rt * 16 + fr) * 2048 + h * 256 + half * 128 + ks * 32 + 8 * fq);
#pragma unroll
                for (int ct = 0; ct < 8; ++ct) { const bf16x8 bb = *(const bf16x8*)(kb + (size_t)(ct * 16 + fr) * 128 + ks * 32 + 8 * fq);
#pragma unroll
                    for (int rt = 0; rt < 2; ++rt) acc[rt][ct] = __builtin_amdgcn_mfma_f32_16x16x32_bf16(a[rt], bb, acc[rt][ct], 0, 0, 0); }
            }
#pragma unroll
            for (int rt = 0; rt < 2; ++rt)
#pragma unroll
                for (int ct = 0; ct < 8; ++ct)
#pragma unroll
                    for (int r = 0; r < 4; ++r) sc[(rt * 16 + 4 * fq + r) * 129 + ct * 16 + fr] = pack_low(acc[rt][ct][r], (unsigned)(ct * 16 + fr), 0x7Fu);
            LDS_WAIT(); asm volatile("" ::: "memory");
            float vv[16];
#pragma unroll
            for (int p = 0; p < 16; ++p) vv[p] = -INFINITY;
            if (lane < 32) { const LAS float* row = sc + lane * 129;
#pragma unroll 4
                for (int n = 0; n < 128; ++n) { const float x = row[n]; BUBBLE(x, vv); } }
            LDS_WAIT(); asm volatile("" ::: "memory");
#pragma unroll
            for (int p = 0; p < 16; ++p) { if (half == 0) v1[p] = vv[p]; else v2[p] = vv[p]; }
        }
        if (lane < 32) {
#pragma unroll
            for (int p = 0; p < 16; ++p) { li[lane * 33 + p] = __builtin_bit_cast(unsigned, v1[p]) & 0x7Fu; li[lane * 33 + 16 + p] = __builtin_bit_cast(unsigned, v2[p]) & 0x7Fu; }
            float ts[16];
#pragma unroll
            for (int p = 0; p < 16; ++p) ts[p] = -INFINITY;
#pragma unroll
            for (int a = 0; a < 16; ++a)
#pragma unroll
                for (int bq = 0; bq < 16; ++bq) if ((a + 1) * (bq + 1) <= 16) { const float x = pack_low(v1[a] + v2[bq], (unsigned)(a * 16 + bq), 0xFFu); BUBBLE(x, ts); }
            LDS_WAIT(); asm volatile("" ::: "memory");
            float e[16], sum = 0.f;
#pragma unroll
            for (int p = 0; p < 16; ++p) { e[p] = expf(ts[p] - ts[0]); sum += e[p]; }
            const float inv = 1.f / sum;
            int* ip = IDX + (size_t)(t0 + lane) * 128 + h * 16; float* gp = GATE + (size_t)(t0 + lane) * 128 + h * 16;
#pragma unroll
            for (int p = 0; p < 16; ++p) { const unsigned ab = __builtin_bit_cast(unsigned, ts[p]) & 0xFFu;
                ip[p] = (int)(li[lane * 33 + (ab >> 4)] * 128u + li[lane * 33 + 16 + (ab & 15u)]); gp[p] = e[p] * inv; }
        }
        LDS_WAIT(); asm volatile("" ::: "memory");
    }
}

__device__ __forceinline__ void phase_peer_gather(Frame& F, int layer) {
    KARGS;
    const bf16* H = WSP(bf16, WS_H); const int* IDX = WSP(int, WS_IDX); const float* GATE = WSP(float, WS_GATE);
    const float* U = IN(29) + (size_t)layer * NEXP * 1024; const float* Vt = IN(30) + (size_t)layer * NEXP * 1024;
    const float* g2 = WSP(float, WS_MOD) + (size_t)layer * 2 * 6144 + 5120;
    float* X = OUTP;
    const int lane = F.lane, gw = F.bid * NWAVES + F.wave, NGW = F.G * NWAVES;
    for (int tg = gw; tg < T; tg += NGW) {
        const int b = tg >= SEQ ? 1 : 0;
        f32x4 x[4];
#pragma unroll
        for (int j = 0; j < 4; ++j) { const v2u w = *(const v2u*)(H + (size_t)tg * D + 256 * j + 4 * lane); x[j] = (f32x4){bflo(w.x), bfhi(w.x), bflo(w.y), bfhi(w.y)}; }
        const int id0 = IDX[(size_t)tg * 128 + lane], id1 = IDX[(size_t)tg * 128 + 64 + lane];
        const float gt0 = GATE[(size_t)tg * 128 + lane], gt1 = GATE[(size_t)tg * 128 + 64 + lane];
        f32x4 acc[4];
#pragma unroll
        for (int j = 0; j < 4; ++j) acc[j] = (f32x4){0.f, 0.f, 0.f, 0.f};
#pragma unroll 4
        for (int e = 0; e < 128; ++e) {
            const int idx = __builtin_amdgcn_readlane(e < 64 ? id0 : id1, e & 63);
            const float gt = rl(e < 64 ? gt0 : gt1, e & 63);
            const float* up = U + (size_t)idx * 1024 + 4 * lane; const float* vp = Vt + (size_t)idx * 1024 + 4 * lane;
            float d = 0.f;
#pragma unroll
            for (int j = 0; j < 4; ++j) { const f32x4 u4 = *(const f32x4*)(up + 256 * j); d += (u4.x * x[j].x + u4.y * x[j].y) + (u4.z * x[j].z + u4.w * x[j].w); }
            d = wave_sum(d);
            const float act = gelu_erf(d) * gt;
#pragma unroll
            for (int j = 0; j < 4; ++j) { const f32x4 v4 = *(const f32x4*)(vp + 256 * j); acc[j] += v4 * act; }
        }
        float* xr = X + (size_t)tg * D + 4 * lane; const float* gg = g2 + b * 6144 + 4 * lane;
#pragma unroll
        for (int j = 0; j < 4; ++j) { const f32x4 g4 = *(const f32x4*)(gg + 256 * j); *(f32x4*)(xr + 256 * j) = *(const f32x4*)(xr + 256 * j) + g4 * acc[j]; }
    }
}

__device__ __forceinline__ void phase_final(Frame& F) {
    KARGS;
    float* X = OUTP; const float* gain = IN(31);
    const int lane = F.lane, gw = F.bid * NWAVES + F.wave, NGW = F.G * NWAVES;
    f32x4 gn[4];
#pragma unroll
    for (int j = 0; j < 4; ++j) gn[j] = *(const f32x4*)(gain + 256 * j + 4 * lane);
    for (int row = gw; row < T; row += NGW) {
        float* xr = X + (size_t)row * D + 4 * lane;
        f32x4 v[4]; float ss = 0.f;
#pragma unroll
        for (int j = 0; j < 4; ++j) { v[j] = *(const f32x4*)(xr + 256 * j); ss += (v[j].x * v[j].x + v[j].y * v[j].y) + (v[j].z * v[j].z + v[j].w * v[j].w); }
        const float rstd = rsqrtf(wave_sum(ss) * (1.f / D) + NORM_EPS);
#pragma unroll
        for (int j = 0; j < 4; ++j) *(f32x4*)(xr + 256 * j) = v[j] * rstd * gn[j];
    }
}

#ifndef PH_MASK
#define PH_MASK 0xFFFF
#endif
#define PH_EN(k) ((PH_MASK >> (k)) & 1)
constexpr int NPH = 42;
__host__ __device__ inline bool phase_skipped(int p) { if (p == 0 || p == NPH - 1) return false; const int layer = (p - 1) / 10, step = (p - 1) % 10; return (layer & 1) == 0 && (step == 3 || step == 4); }
__global__ void __launch_bounds__(NTHR, 2) mk_fwd(Args args) {
    extern __shared__ __attribute__((aligned(16))) unsigned char lds[];
    Frame F;
    F.lds = (LAS unsigned char*)lds;
    F.MISC = (volatile LAS unsigned*)(F.lds + MISC_OFF);
    F.tid = threadIdx.x; F.lane = F.tid & 63; F.wave = __builtin_amdgcn_readfirstlane(F.tid >> 6);
    F.G = gridDim.x; F.bid = blockIdx.x;
    F.ctl = (gu32*)(args.ws + WS_CTL);
    for (int u = F.tid; u < (LDS_BYTES - MISC_OFF) / 4; u += NTHR) ((LAS unsigned*)(F.lds + MISC_OFF))[u] = 0u;
    __syncthreads();
    XcdBarrier bar; bar.bar = (unsigned*)(F.ctl + CW_BAR); bar.x = 0; bar.st = nullptr;
    const int lo = args.ph_lo, hi = args.ph_hi;
    if (hi - lo > 1) bar = xcd_barrier_post((unsigned*)(F.ctl + CW_BAR), F.MISC + 8);
    bool ran = false;
    for (int p = lo; p < hi; ++p) {
        if (phase_skipped(p)) continue;
        if (ran) xcd_barrier(bar);
        ran = true;
        { int t_ = threadIdx.x; asm volatile("" : "+v"(t_)); F.tid = t_; F.lane = t_ & 63; F.wave = __builtin_amdgcn_readfirstlane(t_ >> 6);
          int b_ = blockIdx.x, g_ = gridDim.x; asm volatile("" : "+s"(b_), "+s"(g_)); F.bid = b_; F.G = g_; }
        if (p == 0) { if (PH_EN(0)) phase_prologue(F); continue; }
        if (p == NPH - 1) { if (PH_EN(1)) phase_final(F); continue; }
        const int layer = (p - 1) / 10, step = (p - 1) % 10; const bool odd = layer & 1;
        KARGS;
        if (step == 0 || step == 6) { if (PH_EN(2)) phase_norm(F, layer, step == 6 ? 1 : 0); }
        else if (step == 1 || step == 7) { if (PH_EN(3)) {
            const int N = step == 7 ? 2048 : (odd ? ODD_N : EVEN_IN);
            const bf16* Bt = step == 7 ? WSP(bf16, WS_WQ + (size_t)layer * 4 * MiB) : WSP(bf16, WS_WIN + (size_t)layer * 8 * MiB);
            bf16* O = step == 7 ? WSP(bf16, WS_Q) : WSP(bf16, WS_PROJ);
            pg8::Gemm g{WSP(bf16, WS_H), Bt, T, N, D}; pg8::StaticOrder S; S.init(T, N, F.G, F.bid);
            pg8::EpiBf16<0> E{O, N, nullptr, 0, 0, 1.f};
            pg8::gemm_phase<pg8::EpiBf16<0>, pg8::StaticOrder, PG8_ALIGN, PG8_SP2>(F.lds + RING_OFF, g, S, E);
        } }
        else if (step == 2) { if (odd) { if (PH_EN(4)) phase_odd_prep(F, layer); } else { if (PH_EN(5)) phase_even_mixer(F, layer); } }
        else if (step == 3) { if (PH_EN(6)) phase_odd_main(F, layer); }
        else if (step == 4) { if (PH_EN(7)) phase_rwkv_post(F, layer); }
        else if (step == 5) { if (PH_EN(8)) {
            pg8::Gemm g{WSP(bf16, WS_MIX), WSP(bf16, WS_WOUT + (size_t)layer * 2 * MiB), T, D, D}; pg8::StaticOrder S; S.init(T, D, F.G, F.bid);
            pg8::EpiResid E{layer == 0 ? IN(0) : OUTP, OUTP, WSP(float, WS_MOD) + (size_t)layer * 2 * 6144 + 2048, 6144};
            pg8::gemm_phase<pg8::EpiResid, pg8::StaticOrder, PG8_ALIGN, PG8_SP2>(F.lds + RING_OFF, g, S, E);
        } }
        else if (step == 8) { if (PH_EN(9)) phase_peer_topk(F, layer); }
        else { if (PH_EN(10)) phase_peer_gather(F, layer); }
    }
}

extern "C" void kernel_launch(void* const* d_in, const int* in_sizes, int n_in, void* d_out, int out_size, void* d_ws, size_t ws_size, hipStream_t stream) {
    static int grid = 0;
    if (grid == 0) {
        if (n_in != 32 || in_sizes[0] != T * D || out_size != T * D || ws_size < WS_END) { fprintf(stderr, "kernel_launch: unexpected shapes (n_in %d, in0 %d, out %d, ws %zu < %zu); nothing launched\n", n_in, n_in > 0 ? in_sizes[0] : -1, out_size, ws_size, (size_t)WS_END); grid = -1; return; }
        int dev = 0, cus = 0, per_cu = 0;
        if (hipGetDevice(&dev) != hipSuccess || hipDeviceGetAttribute(&cus, hipDeviceAttributeMultiprocessorCount, dev) != hipSuccess) { grid = -1; return; }
        if (hipFuncSetAttribute((const void*)mk_fwd, hipFuncAttributeMaxDynamicSharedMemorySize, LDS_BYTES) != hipSuccess) { fprintf(stderr, "kernel_launch: hipFuncSetAttribute failed\n"); grid = -1; return; }
        if (hipOccupancyMaxActiveBlocksPerMultiprocessor(&per_cu, (const void*)mk_fwd, NTHR, LDS_BYTES) != hipSuccess || per_cu < 1) fprintf(stderr, "kernel_launch: occupancy query reports %d workgroups per CU\n", per_cu);
        (void)hipGetLastError();
        grid = cus;
    }
    if (grid < 0) return;
    if (hipMemsetAsync((char*)d_ws + WS_CTL, 0, CTL_ZERO_BYTES, stream) != hipSuccess) { fprintf(stderr, "kernel_launch: hipMemsetAsync failed\n"); return; }
    Args a{};
    for (int i = 0; i < 32; ++i) a.in[i] = (const float*)d_in[i];
    a.out = (float*)d_out; a.ws = (unsigned char*)d_ws;
#if MK_ONE_LAUNCH
    a.ph_lo = 0; a.ph_hi = NPH;
    hipLaunchKernelGGL(mk_fwd, dim3(grid), dim3(NTHR), LDS_BYTES, stream, a);
#else
    for (int p = 0; p < NPH; ++p) { if (phase_skipped(p)) continue; a.ph_lo = p; a.ph_hi = p + 1;
        hipLaunchKernelGGL(mk_fwd, dim3(grid), dim3(NTHR), LDS_BYTES, stream, a); }
#endif
    const hipError_t le = hipPeekAtLastError();
    if (le != hipSuccess) fprintf(stderr, "kernel_launch: launch failed: %s\n", hipGetErrorName(le));
}
```

```cpp
#include <hip/hip_runtime.h>
#include <cstdio>
#include <cstdint>
namespace pg8 {
#define PG8_LAS __attribute__((address_space(3)))
typedef unsigned short bf16_t;
typedef short bf16x8 __attribute__((ext_vector_type(8)));
typedef float f32x4 __attribute__((ext_vector_type(4)));
typedef unsigned u32x4 __attribute__((ext_vector_type(4)));
constexpr int BM = 256, BK = 64, HALF = 128, HTB = HALF * BK * 2  , STAGE_BYTES = 8 * HTB, NXCD = 8, WGM = 8;

__host__ __device__ __forceinline__ int lds_byte(int r, int c) { const int st = (r >> 4) * 2 + (c >> 5), rr = r & 15, cc = c & 31, ob = rr * 64 + cc * 2; return st * 1024 + (ob ^ (((ob >> 9) & 1) << 5)); }
__host__ __device__ __forceinline__ void stage_rc(int b, int& R, int& C) { const int st = b / 1024, sb = b % 1024, swz = sb ^ (((sb >> 9) & 1) << 5); R = (st >> 1) * 16 + swz / 64; C = (st & 1) * 32 + (swz % 64) / 2; }
__host__ __device__ __forceinline__ int perm32(int rho) { const int n = rho >> 4, i = rho & 15; return 8 * (i >> 2) + 4 * n + (i & 3); }

struct Unit { int pm, pn; };
struct Gemm { const bf16_t* A; const bf16_t* Bt; int M, N, K; };

struct StaticOrder {
    int nM, nN, nwg, G, c;
    __host__ __device__ void init(int M, int N, int G_, int c_) { nM = M / BM; nN = N / BM; nwg = nM * nN; G = G_; c = c_; }
    __host__ __device__ bool next(int i, Unit& u) const {
        const long L = (long)i * G + c; if (L >= nwg) return false;
        int wgid = (int)L; { const int q = nwg / NXCD, r = nwg % NXCD, xcd = wgid % NXCD, off = wgid / NXCD; wgid = (xcd < r ? xcd * (q + 1) : r * (q + 1) + (xcd - r) * q) + off; }
        const int nig = WGM * nN, gid = wgid / nig, fm = gid * WGM, gsz = (nM - fm) < WGM ? (nM - fm) : WGM;
        u.pm = fm + ((wgid % nig) % gsz); u.pn = (wgid % nig) / gsz; return true;
    }
    __device__ __forceinline__ void a_ready(const Unit&) const {}
    __device__ __forceinline__ void done(const Unit&) const {}
};

__device__ __forceinline__ unsigned cvt_pk_bf16(float lo, float hi) { unsigned r; asm volatile("v_cvt_pk_bf16_f32 %0, %1, %2" : "=v"(r) : "v"(lo), "v"(hi)); return r; }
typedef float f32x2 __attribute__((ext_vector_type(2)));
__device__ __forceinline__ f32x2 gelu_pk(f32x2 v) {
    const f32x2 av = __builtin_elementwise_abs(v), d = av * 0.2316418882f + 1.0f;
    f32x2 t; t.x = __builtin_amdgcn_rcpf(d.x); t.y = __builtin_amdgcn_rcpf(d.y);
    f32x2 q = t * 0.5307027145f + (-0.7265760135f); q = q * t + 0.7107068705f; q = q * t + (-0.142248368f); q = q * t + 0.127414796f; q = q * t;
    const f32x2 s = (v * v) * (-0.72134752044f);
    f32x2 e; e.x = __builtin_amdgcn_exp2f(s.x); e.y = __builtin_amdgcn_exp2f(s.y);
    const f32x2 m = v * (q * e), r = v - m;
    f32x2 o; o.x = v.x < 0.f ? m.x : r.x; o.y = v.y < 0.f ? m.y : r.y; return o;
}

template <int ACT  > struct EpiBf16 {
    static constexpr bool PERM = true, AFTER_DRAIN = false; static_assert(ACT == 0 || ACT == 1, "EpiBf16: ACT is 0 (none) or 1 (gelu_pk)");
    bf16_t* O; int ldc; const float* bias; int split_cols; size_t split_stride; float scale0;
    __device__ __forceinline__ void operator()(const f32x4 (&acc)[2][2][4][2], const Unit& u, int wr, int wc, int fr, int fq) const {
        const int row0 = u.pm * BM + wr * 64 + fr; int colt = u.pn * BM; bf16_t* base = O;
        float sc = 1.f; if (split_cols) { const int t = colt / split_cols; base += (size_t)t * split_stride; colt -= t * split_cols; if (t == 0) sc = scale0; }
        const int col0 = colt + wc * 32 + 8 * fq, bcol0 = u.pn * BM + wc * 32 + 8 * fq;
        f32x4 bv[2][2];
#pragma unroll
        for (int bj = 0; bj < 2; ++bj)
#pragma unroll
            for (int n = 0; n < 2; ++n) bv[bj][n] = bias ? *(const f32x4*)(bias + bcol0 + bj * HALF + 4 * n) : (f32x4){0.f, 0.f, 0.f, 0.f};
#pragma unroll
        for (int ai = 0; ai < 2; ++ai)
#pragma unroll
            for (int m = 0; m < 4; ++m) { bf16_t* rowp = base + (size_t)(row0 + ai * HALF + m * 16) * ldc + col0;
#pragma unroll
                for (int bj = 0; bj < 2; ++bj) { f32x4 v0 = acc[ai][bj][m][0] + bv[bj][0], v1 = acc[ai][bj][m][1] + bv[bj][1];
                    if (ACT == 1) { f32x2 a = gelu_pk((f32x2){v0[0], v0[1]}), b = gelu_pk((f32x2){v0[2], v0[3]}), c = gelu_pk((f32x2){v1[0], v1[1]}), d = gelu_pk((f32x2){v1[2], v1[3]});
                        v0 = (f32x4){a.x, a.y, b.x, b.y}; v1 = (f32x4){c.x, c.y, d.x, d.y}; }
                    v0 = v0 * sc; v1 = v1 * sc; u32x4 w; w.x = cvt_pk_bf16(v0[0], v0[1]); w.y = cvt_pk_bf16(v0[2], v0[3]); w.z = cvt_pk_bf16(v1[0], v1[1]); w.w = cvt_pk_bf16(v1[2], v1[3]);
                    *(u32x4*)(rowp + bj * HALF) = w; } }
    }
};
struct EpiResid {
    static constexpr bool PERM = false, AFTER_DRAIN = false;
    const float* base; float* out; const float* gate; int gstride;
    __device__ __forceinline__ void operator()(const f32x4 (&acc)[2][2][4][2], const Unit& u, int wr, int wc, int fr, int fq) const {
        const int row0 = u.pm * BM + wr * 64 + fr; const int col0 = u.pn * BM + wc * 32 + 4 * fq;
        const float* gp = gate + ((u.pm * BM) >= 8192 ? gstride : 0);
        f32x4 gv[2][2];
#pragma unroll
        for (int bj = 0; bj < 2; ++bj)
#pragma unroll
            for (int n = 0; n < 2; ++n) gv[bj][n] = *(const f32x4*)(gp + col0 + bj * HALF + n * 16);
#pragma unroll
        for (int ai = 0; ai < 2; ++ai)
#pragma unroll
            for (int m = 0; m < 4; ++m) { const size_t off = (size_t)(row0 + ai * HALF + m * 16) * 1024 + col0;
#pragma unroll
                for (int bj = 0; bj < 2; ++bj)
#pragma unroll
                    for (int n = 0; n < 2; ++n) { const f32x4 bs = *(const f32x4*)(base + off + bj * HALF + n * 16);
                        *(f32x4*)(out + off + bj * HALF + n * 16) = bs + gv[bj][n] * acc[ai][bj][m][n]; } }
    }
};
template <class Epi, class Sched, bool ALIGN_EPI = false, bool SP2 = false>
__device__ __forceinline__ void gemm_phase(PG8_LAS unsigned char* lds, const Gemm g, const Sched& S, const Epi& E) {
    int tid_l = threadIdx.x; asm volatile("" : "+v"(tid_l));
    const int tid = tid_l, wid = __builtin_amdgcn_readfirstlane(tid >> 6), lane = tid & 63, wr = wid >> 2, wc = wid & 3, fr = lane & 15, fq = lane >> 4;
    const int K = g.K, nt = K / BK;
    unsigned voffA[2], voffB[2];
#pragma unroll
    for (int i = 0; i < 2; ++i) { int R, C; stage_rc(tid * 16 + i * 8192, R, C); const int Rb = Epi::PERM ? ((R & ~31) + perm32(R & 31)) : R;
        voffA[i] = (unsigned)(R * K + C) * 2u; voffB[i] = (unsigned)(Rb * K + C) * 2u; }
    const size_t kstep = (size_t)(BK * 2);
    const size_t hstep = (size_t)HALF * K * 2;
    const size_t tstep = 2 * hstep;
    const unsigned ldsw = (unsigned)wid * 1024u;
    const int aoff = lds_byte(wr * 64 + fr, fq * 8), boff = lds_byte(wc * 32 + fr, fq * 8);
#define PG8_SA(b, h) (((b) * 2 + (h)) * HTB)
#define PG8_SB(b, h) ((4 + (b) * 2 + (h)) * HTB)
#define PG8_STAGE(bufoff, gbase, voff) do { _Pragma("unroll") for (int _i = 0; _i < 2; ++_i) \
        __builtin_amdgcn_global_load_lds((const unsigned*)((const char*)(gbase) + (voff)[_i]), (PG8_LAS unsigned*)(lds + (bufoff) + ldsw + _i * 8192), 16, 0, 0); } while (0)
#define PG8_LDA(dst, b, h) do { _Pragma("unroll") for (int m = 0; m < 4; ++m) _Pragma("unroll") for (int k = 0; k < 2; ++k) dst[m][k] = *(const PG8_LAS bf16x8*)(lds + PG8_SA(b, h) + aoff + m * 2048 + k * 1024); } while (0)
#define PG8_LDB(dst, b, h) do { _Pragma("unroll") for (int n = 0; n < 2; ++n) _Pragma("unroll") for (int k = 0; k < 2; ++k) dst[n][k] = *(const PG8_LAS bf16x8*)(lds + PG8_SB(b, h) + boff + n * 2048 + k * 1024); } while (0)
#define PG8_MMA(ai, bj, At, Bt) do { __builtin_amdgcn_s_setprio(1); _Pragma("unroll") for (int m = 0; m < 4; ++m) _Pragma("unroll") for (int n = 0; n < 2; ++n) _Pragma("unroll") for (int k = 0; k < 2; ++k) \
        acc[ai][bj][m][n] = __builtin_amdgcn_mfma_f32_16x16x32_bf16(Bt[n][k], At[m][k], acc[ai][bj][m][n], 0, 0, 0); __builtin_amdgcn_s_setprio(0); } while (0)
#define PG8_WAIT_V(n) asm volatile("s_waitcnt vmcnt(" #n ")" ::: "memory")
#define PG8_WAIT_L(n) asm volatile("s_waitcnt lgkmcnt(" #n ")" ::: "memory")
#define PG8_BAR __builtin_amdgcn_s_barrier()
#define PG8_SCHED __builtin_amdgcn_sched_barrier(0)
    Unit cur, nxt; int ui = 0;
    if (!S.next(0, cur)) return;
    f32x4 acc[2][2][4][2];
#pragma unroll
    for (int a = 0; a < 2; ++a)
#pragma unroll
        for (int b = 0; b < 2; ++b)
#pragma unroll
            for (int m = 0; m < 4; ++m)
#pragma unroll
                for (int n = 0; n < 2; ++n) acc[a][b][m][n] = (f32x4){0.f, 0.f, 0.f, 0.f};
    bf16x8 At[4][2], B0[2][2], B1[2][2];
    const char* cA = (const char*)g.A + (size_t)cur.pm * tstep; const char* cB = (const char*)g.Bt + (size_t)cur.pn * tstep;
    S.a_ready(cur);
    if constexpr (SP2) {
        PG8_STAGE(PG8_SB(0, 0), cB, voffB); PG8_STAGE(PG8_SB(0, 1), cB + hstep, voffB); PG8_STAGE(PG8_SA(0, 0), cA, voffA); PG8_STAGE(PG8_SA(0, 1), cA + hstep, voffA);
        if (wr == 1) PG8_BAR;
        PG8_WAIT_V(2); PG8_BAR;
        PG8_STAGE(PG8_SB(1, 0), cB + kstep, voffB); PG8_STAGE(PG8_SA(1, 0), cA + kstep, voffA); PG8_STAGE(PG8_SB(1, 1), cB + hstep + kstep, voffB);
        PG8_WAIT_V(6); PG8_BAR;
    } else {
        PG8_STAGE(PG8_SB(0, 0), cB, voffB); PG8_STAGE(PG8_SA(0, 0), cA, voffA); PG8_STAGE(PG8_SB(0, 1), cB + hstep, voffB); PG8_STAGE(PG8_SA(0, 1), cA + hstep, voffA);
        if (wr == 1) PG8_BAR;
        PG8_WAIT_V(4); PG8_BAR;
        PG8_STAGE(PG8_SB(1, 0), cB + kstep, voffB); PG8_STAGE(PG8_SA(1, 0), cA + kstep, voffA); PG8_STAGE(PG8_SB(1, 1), cB + hstep + kstep, voffB);
        PG8_WAIT_V(6); PG8_BAR;
    }
    for (;;) {
        const bool has_next = S.next(ui + 1, nxt);
        const char* nA = has_next ? (const char*)g.A + (size_t)nxt.pm * tstep : cA; const char* nB = has_next ? (const char*)g.Bt + (size_t)nxt.pn * tstep : cB;
        for (int t = 0; t < nt; t += 2) {
            const bool last = (t == nt - 2);
            const char* a1 = cA + (size_t)(t + 1) * kstep;
            const char* a2 = last ? nA : cA + (size_t)(t + 2) * kstep; const char* b2 = last ? nB : cB + (size_t)(t + 2) * kstep;
            const char* a3 = a2 + kstep; const char* b3 = b2 + kstep;
            if (last && has_next) S.a_ready(nxt);
            if constexpr (SP2) {
            PG8_LDB(B0, 0, 0); PG8_LDB(B1, 0, 1); PG8_SCHED; PG8_LDA(At, 0, 0); PG8_STAGE(PG8_SA(1, 1), a1 + hstep, voffA);
            PG8_WAIT_V(8); PG8_WAIT_L(0); PG8_BAR; PG8_MMA(0, 0, At, B0); PG8_MMA(0, 1, At, B1); PG8_BAR; PG8_SCHED;
            PG8_LDA(At, 0, 1); PG8_STAGE(PG8_SB(0, 0), b2, voffB); PG8_STAGE(PG8_SB(0, 1), b2 + hstep, voffB); PG8_STAGE(PG8_SA(0, 0), a2, voffA);
            PG8_WAIT_V(8); PG8_WAIT_L(0); PG8_BAR; PG8_MMA(1, 0, At, B0); PG8_MMA(1, 1, At, B1); PG8_BAR; PG8_SCHED;
            PG8_LDB(B0, 1, 0); PG8_LDB(B1, 1, 1); PG8_SCHED; PG8_LDA(At, 1, 0); PG8_STAGE(PG8_SA(0, 1), a2 + hstep, voffA);
            PG8_WAIT_V(8); PG8_WAIT_L(0); PG8_BAR; PG8_MMA(0, 0, At, B0); PG8_MMA(0, 1, At, B1); PG8_BAR; PG8_SCHED;
            PG8_LDA(At, 1, 1); PG8_STAGE(PG8_SB(1, 0), b3, voffB); PG8_STAGE(PG8_SB(1, 1), b3 + hstep, voffB); PG8_STAGE(PG8_SA(1, 0), a3, voffA);
            PG8_WAIT_V(8); PG8_WAIT_L(0); PG8_BAR; PG8_MMA(1, 0, At, B0); PG8_MMA(1, 1, At, B1); PG8_BAR; PG8_SCHED;
            } else {
            PG8_LDB(B0, 0, 0); PG8_SCHED; PG8_LDA(At, 0, 0); PG8_STAGE(PG8_SA(1, 1), a1 + hstep, voffA);
            PG8_WAIT_L(8); PG8_BAR; PG8_WAIT_L(0); PG8_MMA(0, 0, At, B0); PG8_BAR; PG8_SCHED;
            PG8_LDB(B1, 0, 1); PG8_STAGE(PG8_SB(0, 0), b2, voffB);
            PG8_BAR; PG8_WAIT_L(0); PG8_MMA(0, 1, At, B1); PG8_BAR;
            PG8_LDA(At, 0, 1); PG8_STAGE(PG8_SA(0, 0), a2, voffA);
            PG8_BAR; PG8_WAIT_L(0); PG8_MMA(1, 0, At, B0); PG8_BAR; PG8_SCHED;
            PG8_STAGE(PG8_SB(0, 1), b2 + hstep, voffB);
            PG8_WAIT_V(6); PG8_BAR; PG8_MMA(1, 1, At, B1); PG8_BAR;
            PG8_LDB(B0, 1, 0); PG8_SCHED; PG8_LDA(At, 1, 0); PG8_STAGE(PG8_SA(0, 1), a2 + hstep, voffA);
            PG8_WAIT_L(8); PG8_BAR; PG8_WAIT_L(0); PG8_MMA(0, 0, At, B0); PG8_BAR; PG8_SCHED;
            PG8_LDB(B1, 1, 1); PG8_STAGE(PG8_SB(1, 0), b3, voffB);
            PG8_BAR; PG8_WAIT_L(0); PG8_MMA(0, 1, At, B1); PG8_BAR;
            PG8_LDA(At, 1, 1); PG8_STAGE(PG8_SA(1, 0), a3, voffA);
            PG8_BAR; PG8_WAIT_L(0); PG8_MMA(1, 0, At, B0); PG8_BAR; PG8_SCHED;
            PG8_STAGE(PG8_SB(1, 1), b3 + hstep, voffB);
            PG8_WAIT_V(6); PG8_BAR; PG8_MMA(1, 1, At, B1); PG8_BAR;
            }
        }
        if constexpr (ALIGN_EPI) { if (wr == 0) PG8_BAR; }
        if constexpr (!Epi::AFTER_DRAIN) { E(acc, cur, wr, wc, fr, fq); S.done(cur); }
        if (!has_next) break;
#pragma unroll
        for (int a = 0; a < 2; ++a)
#pragma unroll
            for (int b = 0; b < 2; ++b)
#pragma unroll
                for (int m = 0; m < 4; ++m)
#pragma unroll
                    for (int n = 0; n < 2; ++n) acc[a][b][m][n] = (f32x4){0.f, 0.f, 0.f, 0.f};
        cur = nxt; cA = nA; cB = nB; ++ui;
        if constexpr (ALIGN_EPI) { if (wr == 1) PG8_BAR; }
    }
    PG8_WAIT_V(0);
    if constexpr (!ALIGN_EPI) { if (wr == 0) PG8_BAR; }
    PG8_BAR;
    if constexpr (Epi::AFTER_DRAIN) { E.fused(acc, cur, wr, wc, fr, fq, lds, wid, lane); S.done(cur); }
#undef PG8_SA
#undef PG8_SB
#undef PG8_STAGE
#undef PG8_LDA
#undef PG8_LDB
#undef PG8_MMA
#undef PG8_WAIT_V
#undef PG8_WAIT_L
#undef PG8_BAR
#undef PG8_SCHED
}
}
#ifndef PG8_SP2
#define PG8_SP2 true
#endif
#ifndef PG8_ALIGN
#define PG8_ALIGN true
#endif
#ifndef MK_ONE_LAUNCH
#define MK_ONE_LAUNCH 1
#endif

constexpr int NWAVES = 8, NTHR = NWAVES * 64;
constexpr int BATCH = 2, SEQ = 8192, D = 1024, T = BATCH * SEQ, DEPTH = 4;
constexpr int EVEN_IN = 2048, ODD_LD = 3848, ODD_N = 3840;
constexpr int NEXP = 16384;
constexpr float NORM_EPS = 1e-6f, GN_EPS = 64e-5f;

constexpr size_t MiB = 1u << 20;
constexpr size_t WS_CTL = 0, CTL_ZERO_BYTES = 1 * MiB;
constexpr size_t WS_MOD = 1 * MiB;
constexpr size_t WS_WF = WS_MOD + 256 * 1024;
constexpr size_t WS_KEYS = WS_MOD + 512 * 1024;
constexpr size_t WS_LOGF = 2 * MiB;
constexpr size_t WS_DCUM = 2 * MiB + 512 * 1024;
constexpr size_t WS_WIN = 4 * MiB;
constexpr size_t WS_WOUT = 36 * MiB;
constexpr size_t WS_WQ = 44 * MiB;
constexpr size_t WS_H = 64 * MiB;
constexpr size_t WS_MIX = 96 * MiB;
constexpr size_t WS_PROJ = 128 * MiB;
constexpr size_t WS_Q = 256 * MiB;
constexpr size_t WS_IDX = 320 * MiB;
constexpr size_t WS_GATE = 328 * MiB;
constexpr size_t WS_RW = 336 * MiB;
constexpr size_t RW_SLOT = 32 * MiB;
constexpr size_t WS_PU = WS_RW + 8 * RW_SLOT;
constexpr size_t WS_PV = WS_PU + 128 * MiB;
constexpr size_t WS_END = WS_PV + 128 * MiB;
constexpr int CW_WORK = 64;
constexpr int CW_BAR = 4096;

constexpr int RING_OFF = 0, RING_BYTES = 131072;
constexpr int MISC_OFF = 143360;
constexpr int LDS_BYTES = 147456;

#define GAS __attribute__((address_space(1)))
#define LAS __attribute__((address_space(3)))
typedef unsigned short bf16;
typedef unsigned v4u __attribute__((ext_vector_type(4)));
typedef unsigned v2u __attribute__((ext_vector_type(2)));
typedef float f32x4 __attribute__((ext_vector_type(4)));
typedef short bf16x8 __attribute__((ext_vector_type(8)));
typedef GAS unsigned gu32;
#define LDS_WAIT() asm volatile("s_waitcnt lgkmcnt(0)" ::: "memory")
#define VM_WAIT() asm volatile("s_waitcnt vmcnt(0)" ::: "memory")
__device__ __forceinline__ unsigned f2bf(float f) { unsigned u = __builtin_bit_cast(unsigned, f); return (u + 0x7fffu + ((u >> 16) & 1u)) >> 16; }
__device__ __forceinline__ unsigned pk2(float lo, float hi) { return f2bf(lo) | (f2bf(hi) << 16); }
__device__ __forceinline__ float bf2f(bf16 v) { return __builtin_bit_cast(float, (unsigned)v << 16); }
__device__ __forceinline__ float bflo(unsigned w) { return __builtin_bit_cast(float, w << 16); }
__device__ __forceinline__ float bfhi(unsigned w) { return __builtin_bit_cast(float, w & 0xffff0000u); }
__device__ __forceinline__ float wave_sum(float v) {
#pragma unroll
    for (int o = 1; o < 64; o <<= 1) v += __shfl_xor(v, o);
    return v;
}
__device__ __forceinline__ float wave_max(float v) {
#pragma unroll
    for (int o = 1; o < 64; o <<= 1) v = fmaxf(v, __shfl_xor(v, o));
    return v;
}
__device__ __forceinline__ float rl(float x, int j) { return __builtin_bit_cast(float, __builtin_amdgcn_readlane(__builtin_bit_cast(int, x), j)); }
__device__ __forceinline__ float sigmoidf_(float x) { return 1.f / (1.f + expf(-x)); }
__device__ __forceinline__ float softplusf_(float x) { return fmaxf(x, 0.f) + log1pf(expf(-fabsf(x))); }
__device__ __forceinline__ float gelu_erf(float x) { return 0.5f * x * (1.f + erff(x * 0.70710678118654752f)); }

#define XB_TMO      128
#define XB_XCNT(j)  (256  + 64 * (j))
#define XB_XSUB(j)  (1280 + 64 * (j))
#define XB_XGEN(j)  (2304 + 64 * (j))
#define XB_TOP      3328
#define XB_TOPGEN   3392
#define XCD_BAR_WORDS 3456
#define XB_SPIN_CAP (1u << 18)

__device__ __forceinline__ unsigned xb_ld(unsigned* p)              { return __hip_atomic_load(p, __ATOMIC_RELAXED, __HIP_MEMORY_SCOPE_AGENT); }
__device__ __forceinline__ unsigned xb_add(unsigned* p, unsigned v) { return __hip_atomic_fetch_add(p, v, __ATOMIC_RELAXED, __HIP_MEMORY_SCOPE_AGENT); }
__device__ __forceinline__ unsigned xb_xcc_id() { return (unsigned)__builtin_amdgcn_s_getreg((3 << 11) | 20) & 0xFu; }
#define XB_SPIN(cond, bar) do { unsigned _sp = 0; while (cond) { __builtin_amdgcn_s_sleep(1); \
    if ((++_sp & 255u) == 0u) { if (xb_ld(&(bar)[XB_TMO])) break; if (_sp > XB_SPIN_CAP) { atomicAdd(&(bar)[XB_TMO], 1u); break; } } } } while (0)

struct XcdBarrier {
    unsigned* bar; unsigned x;
    volatile LAS unsigned* st;
};

__device__ __forceinline__ XcdBarrier xcd_barrier_post(unsigned* bar, volatile LAS unsigned* st) {
    XcdBarrier b; b.bar = bar; b.x = xb_xcc_id(); b.st = st;
    if (threadIdx.x == 0) (void)xb_add(&bar[XB_XCNT(b.x)], 1u);
    return b;
}
__device__ __forceinline__ void xcd_barrier_complete(unsigned* bar, unsigned x, unsigned& nloc, unsigned& nx) {
    const unsigned G = gridDim.x * gridDim.y * gridDim.z;
    unsigned sum, cnt, mine, sp = 0u;
    for (;;) {
        sum = 0u; cnt = 0u; mine = 0u;
#pragma unroll
        for (unsigned j = 0; j < 16; ++j) { const unsigned c = xb_ld(&bar[XB_XCNT(j)]); sum += c; cnt += (c > 0u) ? 1u : 0u; mine = (j == x) ? c : mine; }
        if (sum == G) break;
        __builtin_amdgcn_s_sleep(1);
        if ((++sp & 255u) == 0u) { if (xb_ld(&bar[XB_TMO])) break; if (sp > XB_SPIN_CAP) { atomicAdd(&bar[XB_TMO], 1u); break; } }
    }
    nloc = mine > 0u ? mine : 1u; nx = cnt > 0u ? cnt : 1u;
}

__device__ __forceinline__ void xcd_barrier(const XcdBarrier& b) {
    asm volatile("s_waitcnt vmcnt(0)" ::: "memory");
    __syncthreads();
    if (threadIdx.x == 0) {
        unsigned* bar = b.bar;
        __builtin_amdgcn_s_waitcnt(0);
        unsigned nloc = b.st[0], nx = b.st[1];
        if (nloc == 0u) { xcd_barrier_complete(bar, b.x, nloc, nx); b.st[0] = nloc; b.st[1] = nx; }
        const unsigned old = xb_add(&bar[XB_XSUB(b.x)], 1u);
        const unsigned gen = old / nloc;
        if (old + 1u == (gen + 1u) * nloc) {
            __builtin_amdgcn_fence(__ATOMIC_RELEASE, "agent");
            asm volatile("s_waitcnt vmcnt(0)" ::: "memory");
            const unsigned og = xb_add(&bar[XB_TOP], 1u);
            const unsigned tg = og / nx;
            if (og + 1u == (tg + 1u) * nx) xb_add(&bar[XB_TOPGEN], 1u);
            else XB_SPIN(xb_ld(&bar[XB_TOPGEN]) == tg, bar);
            __builtin_amdgcn_fence(__ATOMIC_ACQUIRE, "agent");
            xb_add(&bar[XB_XGEN(b.x)], 1u);
            asm volatile("s_waitcnt vmcnt(0)" ::: "memory");
        } else {
            XB_SPIN(xb_ld(&bar[XB_XGEN(b.x)]) == gen, bar);
            __builtin_amdgcn_fence(__ATOMIC_ACQUIRE, "agent");
            asm volatile("s_waitcnt vmcnt(0)" ::: "memory");
        }
    }
    __syncthreads();
}


struct Frame {
    LAS unsigned char* lds;
    volatile LAS unsigned* MISC;
    gu32* ctl;
    int tid, lane, wave, G, bid;
};
struct Args { const float* in[32]; float* out; unsigned char* ws; int ph_lo, ph_hi; };
#define CAS __attribute__((address_space(4)))
#define KARGS const CAS Args* ka_; { unsigned long long kp_ = (unsigned long long)__builtin_amdgcn_kernarg_segment_ptr(); asm volatile("" : "+s"(kp_)); ka_ = (const CAS Args*)kp_; } unsigned char* const ws_ = ka_->ws
#define IN(i) (ka_->in[i])
#define OUTP (ka_->out)
#define WSP(type, off) ((type*)(ws_ + (off)))

__device__ __forceinline__ void transpose_item(const float* W, int ldw, bf16* WT, int row_off, LAS float* scr, int item, int nblk, int lane) {
    const int kb = item / nblk, nb = item % nblk, k0 = 64 * kb, n0 = 32 * nb;
#pragma unroll 8
    for (int i = 0; i < 32; ++i) { const int kk = 2 * i + (lane >> 5); scr[kk * 33 + (lane & 31)] = W[(size_t)(k0 + kk) * ldw + n0 + (lane & 31)]; }
    LDS_WAIT(); asm volatile("" ::: "memory");
    const int c = lane & 7;
#pragma unroll
    for (int j = 0; j < 4; ++j) { const int n = (lane >> 3) + 8 * j; const LAS float* s = scr + (8 * c) * 33 + n;
        v4u o; o.x = pk2(s[0 * 33], s[1 * 33]); o.y = pk2(s[2 * 33], s[3 * 33]); o.z = pk2(s[4 * 33], s[5 * 33]); o.w = pk2(s[6 * 33], s[7 * 33]);
        *(v4u*)(WT + (size_t)(row_off + n0 + n) * 1024 + k0 + 8 * c) = o; }
    LDS_WAIT(); asm volatile("" ::: "memory");
}

__device__ __forceinline__ void phase_prologue(Frame& F) {
    KARGS;
    LAS float* cact = (LAS float*)F.lds;
    LAS float* part = cact + 2048;
    {   const float* c = IN(1);
        for (int i = F.tid; i < 2048; i += NTHR) { const float v = c[i]; cact[i] = v / (1.f + expf(-v)); } }
    __syncthreads();
    {
        const float* ada_w = IN(2); const float* ada_b = IN(3); float* MOD = WSP(float, WS_MOD);
        for (int it = F.bid; it < 384; it += F.G) {
            const int l = it / 96, j0 = (it % 96) * 64;
            const float* wp = ada_w + ((size_t)l * 1024 + F.wave * 128) * 6144 + j0 + F.lane;
            float a0 = 0.f, a1 = 0.f;
#pragma unroll 8
            for (int k = 0; k < 128; ++k) { const float w = wp[(size_t)k * 6144]; a0 += cact[F.wave * 128 + k] * w; a1 += cact[1024 + F.wave * 128 + k] * w; }
            part[(F.wave * 2 + 0) * 64 + F.lane] = a0; part[(F.wave * 2 + 1) * 64 + F.lane] = a1;
            __syncthreads();
            if (F.tid < 128) { const int b = F.tid >> 6, col = F.tid & 63; float s = 0.f;
#pragma unroll
                for (int w = 0; w < 8; ++w) s += part[(w * 2 + b) * 64 + col];
                MOD[(l * 2 + b) * 6144 + j0 + col] = s + ada_b[l * 6144 + j0 + col]; }
            __syncthreads();
        }
    }
    {
        LAS float* scr = (LAS float*)(F.lds + 16384 + F.wave * 8448);
        const int gw = F.bid * NWAVES + F.wave, NGW = F.G * NWAVES;
        constexpr int I_A = 16 * 64, I_B = 16 * 64, I_C = 16 * 56, I_D = 16 * 32, I_E = 16 * 64;
        constexpr int NITEMS = 2 * I_A + 2 * I_B + 2 * I_C + 4 * I_D + 4 * I_E;
        for (int it = gw; it < NITEMS; it += NGW) {
            int r = it;
            if (r < 2 * I_A) { const int j = r / I_A; transpose_item(IN(6) + (size_t)j * 1024 * 2048, 2048, WSP(bf16, WS_WIN + (size_t)(2 * j) * 8 * MiB), 0, scr, r % I_A, 64, F.lane); continue; } r -= 2 * I_A;
            if (r < 2 * I_B) { const int j = r / I_B; transpose_item(IN(10) + (size_t)j * 1024 * ODD_LD, ODD_LD, WSP(bf16, WS_WIN + (size_t)(2 * j + 1) * 8 * MiB), 0, scr, r % I_B, 64, F.lane); continue; } r -= 2 * I_B;
            if (r < 2 * I_C) { const int j = r / I_C; transpose_item(IN(10) + (size_t)j * 1024 * ODD_LD + 2056, ODD_LD, WSP(bf16, WS_WIN + (size_t)(2 * j + 1) * 8 * MiB), 2048, scr, r % I_C, 56, F.lane); continue; } r -= 2 * I_C;
            if (r < 4 * I_D) { const int l = r / I_D; const int j = l >> 1; const float* src = (l & 1) ? IN(11) : IN(7);
                transpose_item(src + (size_t)j * 1024 * 1024, 1024, WSP(bf16, WS_WOUT + (size_t)l * 2 * MiB), 0, scr, r % I_D, 32, F.lane); continue; } r -= 4 * I_D;
            { const int l = r / I_E; transpose_item(IN(26) + (size_t)l * 1024 * 2048, 2048, WSP(bf16, WS_WQ + (size_t)l * 4 * MiB), 0, scr, r % I_E, 64, F.lane); }
        }
    }
    {
        const int gt = F.bid * NTHR + F.tid, NGT = F.G * NTHR;
        float* WF = WSP(float, WS_WF);
        for (int i = gt; i < 2 * 8 * 1024; i += NGT) { const int j = i >> 13, h = (i >> 10) & 7, k = i & 1023; WF[i] = IN(10)[((size_t)j * 1024 + k) * ODD_LD + 2048 + h]; }
        bf16* KEYS = WSP(bf16, WS_KEYS);
        for (int i = gt; i < 4 * 16384; i += NGT) { const int l = i >> 14, r = i & 16383;
            KEYS[(size_t)(l * 2 + 0) * 16384 + r] = (bf16)f2bf(IN(27)[i]); KEYS[(size_t)(l * 2 + 1) * 16384 + r] = (bf16)f2bf(IN(28)[i]); }
        const f32x4* su = (const f32x4*)IN(29); const f32x4* sv = (const f32x4*)IN(30); v2u* du = WSP(v2u, WS_PU); v2u* dv = WSP(v2u, WS_PV);
        for (size_t i = gt; i < (size_t)4 * NEXP * 1024 / 4; i += NGT) { const f32x4 a = su[i], b = sv[i];
            v2u o; o.x = pk2(a.x, a.y); o.y = pk2(a.z, a.w); du[i] = o; o.x = pk2(b.x, b.y); o.y = pk2(b.z, b.w); dv[i] = o; }
    }
}

__device__ __forceinline__ void phase_norm(Frame& F, int layer, int which) {
    KARGS;
    const float* X = (layer == 0 && which == 0) ? IN(0) : OUTP;
    const float* gain = (which ? IN(5) : IN(4)) + layer * 1024;
    const float* mod = WSP(float, WS_MOD) + (size_t)layer * 2 * 6144 + (which ? 3072 : 0);
    bf16* H = WSP(bf16, WS_H);
    const bool do_f = (layer & 1) && which == 0;
    const int jj = layer >> 1;
    const float* WF = WSP(float, WS_WF) + (size_t)jj * 8 * 1024;
    float* LOGF = WSP(float, WS_LOGF);
    const int gw = F.bid * NWAVES + F.wave, NGW = F.G * NWAVES, lane = F.lane;
    f32x4 gn[4];
#pragma unroll
    for (int j = 0; j < 4; ++j) gn[j] = *(const f32x4*)(gain + 256 * j + 4 * lane);
    for (int row = gw; row < T; row += NGW) {
        const int b = row >= SEQ ? 1 : 0;
        const float* sh = mod + b * 6144; const float* sc = sh + 1024;
        const float* xr = X + (size_t)row * D + 4 * lane;
        f32x4 v[4]; float ss = 0.f;
#pragma unroll
        for (int j = 0; j < 4; ++j) { v[j] = *(const f32x4*)(xr + 256 * j); ss += (v[j].x * v[j].x + v[j].y * v[j].y) + (v[j].z * v[j].z + v[j].w * v[j].w); }
        const float rstd = rsqrtf(wave_sum(ss) * (1.f / D) + NORM_EPS);
        bf16* hr = H + (size_t)row * D + 4 * lane;
#pragma unroll
        for (int j = 0; j < 4; ++j) { const f32x4 s4 = *(const f32x4*)(sc + 256 * j + 4 * lane), h4 = *(const f32x4*)(sh + 256 * j + 4 * lane);
            v[j] = v[j] * rstd * gn[j] * (s4 + 1.f) + h4;
            v2u o; o.x = pk2(v[j].x, v[j].y); o.y = pk2(v[j].z, v[j].w); *(v2u*)(hr + 256 * j) = o; }
        if (do_f) {
            const float* fb = IN(14) + jj * 8;
            const int t = row - b * SEQ;
#pragma unroll
            for (int hh = 0; hh < 8; ++hh) { float d = 0.f;
#pragma unroll
                for (int j = 0; j < 4; ++j) { const f32x4 w4 = *(const f32x4*)(WF + hh * 1024 + 256 * j + 4 * lane); d += (v[j].x * w4.x + v[j].y * w4.y) + (v[j].z * w4.z + v[j].w * w4.w); }
                d = wave_sum(d) + fb[hh];
                const float lf = fminf(d, 0.f) - log1pf(expf(-fabsf(d)));
                if (lane == 0) LOGF[(size_t)(b * 8 + hh) * SEQ + t] = lf; }
        }
    }
}

__device__ __forceinline__ void load_q64(float (&q)[64], const bf16* p, float scale) {
#pragma unroll
    for (int c = 0; c < 8; ++c) { const v4u w = *(const v4u*)(p + 8 * c);
        q[8 * c + 0] = bflo(w.x) * scale; q[8 * c + 1] = bfhi(w.x) * scale; q[8 * c + 2] = bflo(w.y) * scale; q[8 * c + 3] = bfhi(w.y) * scale;
        q[8 * c + 4] = bflo(w.z) * scale; q[8 * c + 5] = bfhi(w.z) * scale; q[8 * c + 6] = bflo(w.w) * scale; q[8 * c + 7] = bfhi(w.w) * scale; }
}
__device__ __forceinline__ float dot_q64(const float (&q)[64], const bf16* p) {
    float z0 = 0.f, z1 = 0.f;
#pragma unroll
    for (int c = 0; c < 8; ++c) { const v4u w = *(const v4u*)(p + 8 * c);
        z0 += q[8 * c + 0] * bflo(w.x) + q[8 * c + 2] * bflo(w.y) + q[8 * c + 4] * bflo(w.z) + q[8 * c + 6] * bflo(w.w);
        z1 += q[8 * c + 1] * bfhi(w.x) + q[8 * c + 3] * bfhi(w.y) + q[8 * c + 5] * bfhi(w.z) + q[8 * c + 7] * bfhi(w.w); }
    return z0 + z1;
}
__device__ __forceinline__ void phase_even_mixer(Frame& F, int layer) {
    KARGS;
    const bf16* P = WSP(bf16, WS_PROJ); bf16* MIX = WSP(bf16, WS_MIX);
    const int lane = F.lane;
    {
        const int gw = F.bid * NWAVES + F.wave, NGW = F.G * NWAVES;
        for (int it = gw; it < BATCH * 8 * SEQ; it += NGW) {
            const int b = it >> 16, h = (it >> 13) & 7, t = it & 8191;
            const bf16* base = P + (size_t)b * SEQ * EVEN_IN;
            float q[64]; load_q64(q, base + (size_t)t * EVEN_IN + h * 64, 0.125f);
            float acc = 0.f, carry = 0.f;
            for (int s0 = t - 1; s0 >= 0; s0 -= 64) {
                const int s = s0 - lane; const bool valid = s >= 0; const int sc = valid ? s : 0;
                const float z = dot_q64(q, base + (size_t)sc * EVEN_IN + 512 + h * 64);
                const float sp = softplusf_(z);
                const float l1m = valid ? -sp : 0.f;
                const float lb = z - sp;
                float inc = l1m;
#pragma unroll
                for (int o = 1; o < 64; o <<= 1) { const float n = __shfl_up(inc, o); if (lane >= o) inc += n; }
                const float w = valid ? expf(lb + carry + (inc - l1m)) : 0.f;
                const float tot = __shfl(inc, 63);
#pragma unroll 16
                for (int j = 0; j < 64; ++j) { const float wj = rl(w, j); int sj = s0 - j; sj = sj < 0 ? 0 : sj;
                    acc += wj * bf2f(base[(size_t)sj * EVEN_IN + 1024 + h * 64 + lane]); }
                carry += tot;
                if (carry < -104.f) break;
            }
            MIX[((size_t)b * SEQ + t) * D + h * 64 + lane] = (bf16)f2bf(acc);
        }
    }
    {
        LAS float* pl = (LAS float*)F.lds;
        const int jj = layer >> 1;
        const float* pw = IN(8) + (size_t)jj * 4 * 128 * 128; const float* ps = IN(9) + jj * 512;
        const int c = F.tid, g = c >> 7, w = 2 << g, d = c & 127;
        for (int tile = F.bid; tile < T / 32; tile += F.G) {
            const int t0 = tile * 32, b = t0 / SEQ, tl0 = t0 % SEQ;
            const bf16* base = P + (size_t)b * SEQ * EVEN_IN + 1536 + c;
            for (int tt = 0; tt < 32; ++tt) { const int tl = tl0 + tt, cend = (tl / 64 + 1) * 64;
                int lo = tl - w / 2; lo = lo < 0 ? 0 : lo; int hi = tl + w / 2; hi = hi > cend ? cend : hi;
                float s = 0.f; for (int u = lo; u < hi; ++u) s += bf2f(base[(size_t)u * EVEN_IN]);
                pl[c * 33 + tt] = s / (float)(hi - lo) - bf2f(base[(size_t)tl * EVEN_IN]); }
            __syncthreads();
            float acc[32];
#pragma unroll
            for (int tt = 0; tt < 32; ++tt) acc[tt] = 0.f;
            for (int cc = 0; cc < 128; ++cc) { const float wv = pw[((size_t)g * 128 + cc) * 128 + d]; const LAS float* pr = pl + (g * 128 + cc) * 33;
#pragma unroll
                for (int tt = 0; tt < 32; ++tt) acc[tt] += pr[tt] * wv; }
            const float sc = ps[c];
#pragma unroll
            for (int tt = 0; tt < 32; ++tt) MIX[(size_t)(t0 + tt) * D + 512 + c] = (bf16)f2bf(acc[tt] * sc);
            __syncthreads();
        }
    }
}

__device__ __forceinline__ void phase_odd_prep(Frame& F, int layer) {
    KARGS;
    const int jj = layer >> 1, lane = F.lane;
    bf16* P = WSP(bf16, WS_PROJ);
    if (F.wave == 0 && F.bid < 16) {
        const float* lf = WSP(float, WS_LOGF) + (size_t)F.bid * SEQ; float* dc = WSP(float, WS_DCUM) + (size_t)F.bid * SEQ; double carry = 0.0;
        for (int t0 = 0; t0 < SEQ; t0 += 64) { float inc = lf[t0 + lane];
#pragma unroll
            for (int o = 1; o < 64; o <<= 1) { const float n = __shfl_up(inc, o); if (lane >= o) inc += n; }
            dc[t0 + lane] = (float)(carry + (double)inc); carry += (double)__shfl(inc, 63); }
    }
    LAS float* lx = (LAS float*)F.lds;
    const float* mix = IN(15) + jj * 1792;
    const float* w0 = IN(16) + jj * 512; const float* w2 = IN(17) + (size_t)jj * 64 * 512;
    const float* a0 = IN(18) + jj * 512; const float* a2 = IN(19) + (size_t)jj * 64 * 512;
    const float* g2 = IN(20) + (size_t)jj * 128 * 512;
    const float* kkp = IN(21) + jj * 512; const float* kap = IN(22) + jj * 512;
    const float* qn = IN(12) + jj * 64; const float* kn = IN(13) + jj * 64;
    float* R = WSP(float, WS_RW); float* Wd = WSP(float, WS_RW + RW_SLOT); float* K = WSP(float, WS_RW + 2 * RW_SLOT); float* V = WSP(float, WS_RW + 3 * RW_SLOT);
    float* KK = WSP(float, WS_RW + 4 * RW_SLOT); float* A = WSP(float, WS_RW + 5 * RW_SLOT); float* Gt = WSP(float, WS_RW + 6 * RW_SLOT);
    const int ch = F.tid;
    const float m_r = mix[ch], m_k = mix[512 + ch], m_v = mix[1024 + ch];
    const float w0c = w0[ch], a0c = a0[ch], kkc = kkp[ch], kac = kap[ch], qnc = qn[ch & 63], knc = kn[ch & 63];
    for (int item = F.bid; item < T / 16; item += F.G) {
        const int t0 = item * 16;
        for (int i = F.tid; i < 16 * 256; i += NTHR) { const int tt = i >> 8, j = i & 255, tg = t0 + tt, tl = tg % SEQ, col = 1536 + j;
            const float cur = bf2f(P[(size_t)tg * ODD_N + 2048 + col]); const float prev = tl > 0 ? bf2f(P[(size_t)(tg - 1) * ODD_N + 2048 + col]) : 0.f;
            const float x = cur + (prev - cur) * mix[col];
            lx[i] = j < 64 ? tanhf(x) : (j < 128 ? x : sigmoidf_(x)); }
        __syncthreads();
        float aw[16], aa[16], ag[16];
#pragma unroll
        for (int tt = 0; tt < 16; ++tt) { aw[tt] = 0.f; aa[tt] = 0.f; ag[tt] = 0.f; }
        for (int i = 0; i < 64; ++i) { const float w2v = w2[i * 512 + ch], a2v = a2[i * 512 + ch];
#pragma unroll
            for (int tt = 0; tt < 16; ++tt) { aw[tt] += lx[tt * 256 + i] * w2v; aa[tt] += lx[tt * 256 + 64 + i] * a2v; } }
        for (int i = 0; i < 128; ++i) { const float g2v = g2[i * 512 + ch];
#pragma unroll
            for (int tt = 0; tt < 16; ++tt) ag[tt] += lx[tt * 256 + 128 + i] * g2v; }
#pragma unroll
        for (int tt = 0; tt < 16; ++tt) { const int tg = t0 + tt, tl = tg % SEQ;
            const bf16* pc = P + (size_t)tg * ODD_N + 2048 + ch; const bf16* pp = pc - ODD_N;
            const float rc = bf2f(pc[0]), kc = bf2f(pc[512]), vc = bf2f(pc[1024]);
            const float rp = tl > 0 ? bf2f(pp[0]) : 0.f, kp = tl > 0 ? bf2f(pp[512]) : 0.f, vp = tl > 0 ? bf2f(pp[1024]) : 0.f;
            const float r = rc + (rp - rc) * m_r, kr = kc + (kp - kc) * m_k, vr = vc + (vp - vc) * m_v;
            const float wl = -softplusf_(-(w0c + aw[tt])) - 0.5f; const float decay = expf(-expf(wl));
            const float a = sigmoidf_(a0c + aa[tt]);
            const float kkv = kr * kkc; const float n2 = wave_sum(kkv * kkv); const float kkn = kkv / fmaxf(sqrtf(n2), 1e-12f);
            const float kmod = kr * (1.f + (a - 1.f) * kac);
            const size_t o = (size_t)tg * 512 + ch;
            R[o] = r; Wd[o] = decay; K[o] = kmod; V[o] = vr; KK[o] = kkn; A[o] = a; Gt[o] = ag[tt];
            bf16* pq = P + (size_t)tg * ODD_N + ch;
            const float qv = bf2f(pq[0]), kv = bf2f(pq[512]);
            const float qs = wave_sum(qv * qv) * (1.f / 64.f), ks = wave_sum(kv * kv) * (1.f / 64.f);
            pq[0] = (bf16)f2bf(qv * rsqrtf(qs + NORM_EPS) * qnc); pq[512] = (bf16)f2bf(kv * rsqrtf(ks + NORM_EPS) * knc); }
        __syncthreads();
    }
}

__device__ __forceinline__ void rwkv_scan_simple(Frame& F, int sid) {
    KARGS;
    const int b = sid >> 3, h = sid & 7, lane = F.lane;
    const size_t base = (size_t)b * SEQ * 512 + h * 64 + lane;
    const float* R = WSP(float, WS_RW); const float* Wd = WSP(float, WS_RW + RW_SLOT); const float* K = WSP(float, WS_RW + 2 * RW_SLOT); const float* V = WSP(float, WS_RW + 3 * RW_SLOT);
    const float* KK = WSP(float, WS_RW + 4 * RW_SLOT); const float* A = WSP(float, WS_RW + 5 * RW_SLOT); float* Y = WSP(float, WS_RW + 7 * RW_SLOT);
    float st[64];
#pragma unroll
    for (int j = 0; j < 64; ++j) st[j] = 0.f;
    float r_n = R[base], w_n = Wd[base], k_n = K[base], v_n = V[base], kk_n = KK[base], a_n = A[base];
    for (int t = 0; t < SEQ; ++t) {
        const float r = r_n, w = w_n, k = k_n, v = v_n, kk = kk_n, ka = kk_n * a_n;
        if (t + 1 < SEQ) { const size_t o = base + (size_t)(t + 1) * 512; r_n = R[o]; w_n = Wd[o]; k_n = K[o]; v_n = V[o]; kk_n = KK[o]; a_n = A[o]; }
        float sa = 0.f;
#pragma unroll
        for (int j = 0; j < 64; ++j) sa += st[j] * rl(kk, j);
        float y = 0.f;
#pragma unroll
        for (int j = 0; j < 64; ++j) { st[j] = st[j] * rl(w, j) - sa * rl(ka, j) + v * rl(k, j); y += st[j] * rl(r, j); }
        Y[base + (size_t)t * 512] = y;
    }
}
__device__ __forceinline__ void phase_odd_main(Frame& F, int layer) {
    KARGS;
    const int lane = F.lane;
    if (F.wave == 7 && F.bid < 16) rwkv_scan_simple(F, F.bid);
    const bf16* P = WSP(bf16, WS_PROJ); bf16* MIX = WSP(bf16, WS_MIX); const float* DC = WSP(float, WS_DCUM);
    unsigned* ctr = (unsigned*)F.ctl + CW_WORK + 64 * layer;
    for (;;) {
        unsigned g0 = 0; if (lane == 0) g0 = atomicAdd(ctr, 1u); g0 = (unsigned)__builtin_amdgcn_readfirstlane((int)g0);
        if (g0 >= (unsigned)(BATCH * 8 * SEQ / 16)) break;
        for (int ii = 0; ii < 16; ++ii) {
            const int it = (int)g0 * 16 + ii;
            const int b = it >> 16, h = (it >> 13) & 7, t = it & 8191;
            const bf16* base = P + (size_t)b * SEQ * ODD_N; const float* dc = DC + (size_t)(b * 8 + h) * SEQ;
            float q[64]; load_q64(q, base + (size_t)t * ODD_N + h * 64, 0.125f);
            const float dt = dc[t];
            float m = -INFINITY, l = 0.f, acc = 0.f;
            for (int s0 = t; s0 >= 0; s0 -= 64) {
                const int s = s0 - lane; const bool valid = s >= 0; const int sc = valid ? s : 0;
                float z = dot_q64(q, base + (size_t)sc * ODD_N + 512 + h * 64) + (dt - dc[sc]);
                z = valid ? z : -INFINITY;
                const float mn = fmaxf(m, wave_max(z));
                const float corr = expf(m - mn);
                const float p = valid ? expf(z - mn) : 0.f;
                l = l * corr + wave_sum(p); acc *= corr; m = mn;
#pragma unroll 16
                for (int j = 0; j < 64; ++j) { const float pj = rl(p, j); int sj = s0 - j; sj = sj < 0 ? 0 : sj;
                    acc += pj * bf2f(base[(size_t)sj * ODD_N + 1024 + h * 64 + lane]); }
            }
            const float gate = bf2f(base[(size_t)t * ODD_N + 1536 + h * 64 + lane]);
            MIX[((size_t)b * SEQ + t) * D + h * 64 + lane] = (bf16)f2bf(acc / l * sigmoidf_(gate));
        }
    }
}

__device__ __forceinline__ void phase_rwkv_post(Frame& F, int layer) {
    KARGS;
    const int jj = layer >> 1, ch = F.tid;
    const float* R = WSP(float, WS_RW); const float* K = WSP(float, WS_RW + 2 * RW_SLOT); const float* V = WSP(float, WS_RW + 3 * RW_SLOT);
    const float* Gt = WSP(float, WS_RW + 6 * RW_SLOT); const float* Y = WSP(float, WS_RW + 7 * RW_SLOT);
    bf16* MIX = WSP(bf16, WS_MIX);
    const float lw = IN(24)[jj * 512 + ch], lb = IN(25)[jj * 512 + ch], rk = IN(23)[jj * 512 + ch];
    for (int tg = F.bid; tg < T; tg += F.G) {
        const size_t o = (size_t)tg * 512 + ch;
        const float y = Y[o]; const float mu = wave_sum(y) * (1.f / 64.f); const float dlt = y - mu; const float var = wave_sum(dlt * dlt) * (1.f / 64.f);
        const float yn = dlt * rsqrtf(var + GN_EPS) * lw + lb;
        const float v = V[o]; const float bonus = wave_sum(R[o] * K[o] * rk) * v;
        MIX[(size_t)tg * D + 512 + ch] = (bf16)f2bf((yn + bonus) * Gt[o]);
    }
}

#define BUBBLE(x_, V_) do { float bx_ = (x_); _Pragma("unroll") for (int p_ = 0; p_ < 16; ++p_) { const float hi_ = fmaxf(bx_, V_[p_]); bx_ = fminf(bx_, V_[p_]); V_[p_] = hi_; } } while (0)
__device__ __forceinline__ float pack_low(float v, unsigned bits, unsigned mask) { return __builtin_bit_cast(float, (__builtin_bit_cast(unsigned, v) & ~mask) | bits); }
__device__ __forceinline__ void phase_peer_topk(Frame& F, int layer) {
    KARGS;
    const bf16* Q = WSP(bf16, WS_Q); const bf16* KEYS = WSP(bf16, WS_KEYS) + (size_t)layer * 2 * 16384;
    int* IDX = WSP(int, WS_IDX); float* GATE = WSP(float, WS_GATE);
    LAS float* sc = (LAS float*)(F.lds + F.wave * 16512);
    LAS unsigned* li = (LAS unsigned*)sc;
    const int lane = F.lane, fr = lane & 15, fq = lane >> 4;
    const int gw = F.bid * NWAVES + F.wave, NGW = F.G * NWAVES;
    for (int it = gw; it < (T / 32) * 8; it += NGW) {
        const int tile = it >> 3, h = it & 7, t0 = tile * 32;
        float v1[16], v2[16];
#pragma unroll
        for (int half = 0; half < 2; ++half) {
            f32x4 acc[2][8];
#pragma unroll
            for (int rt = 0; rt < 2; ++rt)
#pragma unroll
                for (int ct = 0; ct < 8; ++ct) acc[rt][ct] = (f32x4){0.f, 0.f, 0.f, 0.f};
            const bf16* kb = KEYS + (size_t)half * 16384;
#pragma unroll 1
            for (int ks = 0; ks < 4; ++ks) {
                bf16x8 a[2];
#pragma unroll
                for (int rt = 0; rt < 2; ++rt) a[rt] = *(const bf16x8*)(Q + (size_t)(t0 + rt * 16 + fr) * 2048 + h * 256 + half * 128 + ks * 32 + 8 * fq);
#pragma unroll
                for (int ct = 0; ct < 8; ++ct) { const bf16x8 bb = *(const bf16x8*)(kb + (size_t)(ct * 16 + fr) * 128 + ks * 32 + 8 * fq);
#pragma unroll
                    for (int rt = 0; rt < 2; ++rt) acc[rt][ct] = __builtin_amdgcn_mfma_f32_16x16x32_bf16(a[rt], bb, acc[rt][ct], 0, 0, 0); }
            }
#pragma unroll
            for (int rt = 0; rt < 2; ++rt)
#pragma unroll
                for (int ct = 0; ct < 8; ++ct)
#pragma unroll
                    for (int r = 0; r < 4; ++r) sc[(rt * 16 + 4 * fq + r) * 129 + ct * 16 + fr] = pack_low(acc[rt][ct][r], (unsigned)(ct * 16 + fr), 0x7Fu);
            LDS_WAIT(); asm volatile("" ::: "memory");
            float vv[16];
#pragma unroll
            for (int p = 0; p < 16; ++p) vv[p] = -INFINITY;
            if (lane < 32) { const LAS float* row = sc + lane * 129;
#pragma unroll 4
                for (int n = 0; n < 128; ++n) { const float x = row[n]; BUBBLE(x, vv); } }
            LDS_WAIT(); asm volatile("" ::: "memory");
#pragma unroll
            for (int p = 0; p < 16; ++p) { if (half == 0) v1[p] = vv[p]; else v2[p] = vv[p]; }
        }
        if (lane < 32) {
#pragma unroll
            for (int p = 0; p < 16; ++p) { li[lane * 33 + p] = __builtin_bit_cast(unsigned, v1[p]) & 0x7Fu; li[lane * 33 + 16 + p] = __builtin_bit_cast(unsigned, v2[p]) & 0x7Fu; }
            float ts[16];
#pragma unroll
            for (int p = 0; p < 16; ++p) ts[p] = -INFINITY;
#pragma unroll
            for (int a = 0; a < 16; ++a)
#pragma unroll
                for (int bq = 0; bq < 16; ++bq) if ((a + 1) * (bq + 1) <= 16) { const float x = pack_low(v1[a] + v2[bq], (unsigned)(a * 16 + bq), 0xFFu); BUBBLE(x, ts); }
            LDS_WAIT(); asm volatile("" ::: "memory");
            float e[16], sum = 0.f;
#pragma unroll
            for (int p = 0; p < 16; ++p) { e[p] = expf(ts[p] - ts[0]); sum += e[p]; }
            const float inv = 1.f / sum;
            int* ip = IDX + (size_t)(t0 + lane) * 128 + h * 16; float* gp = GATE + (size_t)(t0 + lane) * 128 + h * 16;
#pragma unroll
            for (int p = 0; p < 16; ++p) { const unsigned ab = __builtin_bit_cast(unsigned, ts[p]) & 0xFFu;
                ip[p] = (int)(li[lane * 33 + (ab >> 4)] * 128u + li[lane * 33 + 16 + (ab & 15u)]); gp[p] = e[p] * inv; }
        }
        LDS_WAIT(); asm volatile("" ::: "memory");
    }
}

__device__ __forceinline__ void unpack8(float (&o)[8], const v4u w) {
    o[0] = bflo(w.x); o[1] = bfhi(w.x); o[2] = bflo(w.y); o[3] = bfhi(w.y); o[4] = bflo(w.z); o[5] = bfhi(w.z); o[6] = bflo(w.w); o[7] = bfhi(w.w);
}
__device__ __forceinline__ void phase_peer_gather(Frame& F, int layer) {
    KARGS;
    const bf16* H = WSP(bf16, WS_H); const int* IDX = WSP(int, WS_IDX); const float* GATE = WSP(float, WS_GATE);
    const bf16* U = WSP(bf16, WS_PU) + (size_t)layer * NEXP * 1024; const bf16* Vt = WSP(bf16, WS_PV) + (size_t)layer * NEXP * 1024;
    const float* g2 = WSP(float, WS_MOD) + (size_t)layer * 2 * 6144 + 5120;
    float* X = OUTP;
    const int lane = F.lane, gw = F.bid * NWAVES + F.wave, NGW = F.G * NWAVES;
    for (int tg = gw; tg < T; tg += NGW) {
        const int b = tg >= SEQ ? 1 : 0;
        float x0[8], x1[8];
        unpack8(x0, *(const v4u*)(H + (size_t)tg * D + 8 * lane)); unpack8(x1, *(const v4u*)(H + (size_t)tg * D + 512 + 8 * lane));
        const int id0 = IDX[(size_t)tg * 128 + lane], id1 = IDX[(size_t)tg * 128 + 64 + lane];
        const float gt0 = GATE[(size_t)tg * 128 + lane], gt1 = GATE[(size_t)tg * 128 + 64 + lane];
        float a0[8], a1[8];
#pragma unroll
        for (int i = 0; i < 8; ++i) { a0[i] = 0.f; a1[i] = 0.f; }
        for (int e0 = 0; e0 < 128; e0 += 8) {
            int idx[8]; float d[8];
            v4u ua[8], ub[8];
#pragma unroll
            for (int q = 0; q < 8; ++q) { const int e = e0 + q; idx[q] = __builtin_amdgcn_readlane(e0 < 64 ? id0 : id1, e & 63);
                const bf16* up = U + (size_t)idx[q] * 1024 + 8 * lane; ua[q] = *(const v4u*)up; ub[q] = *(const v4u*)(up + 512); }
#pragma unroll
            for (int q = 0; q < 8; ++q) { float u0[8], u1[8]; unpack8(u0, ua[q]); unpack8(u1, ub[q]); float s = 0.f;
#pragma unroll
                for (int i = 0; i < 8; ++i) s += u0[i] * x0[i] + u1[i] * x1[i];
                d[q] = s; }
#pragma unroll
            for (int o = 1; o < 64; o <<= 1) {
#pragma unroll
                for (int q = 0; q < 8; ++q) d[q] += __shfl_xor(d[q], o); }
#pragma unroll
            for (int q = 0; q < 8; ++q) { const int e = e0 + q; const bf16* vp = Vt + (size_t)idx[q] * 1024 + 8 * lane; ua[q] = *(const v4u*)vp; ub[q] = *(const v4u*)(vp + 512);
                d[q] = gelu_erf(d[q]) * rl(e0 < 64 ? gt0 : gt1, e & 63); }
#pragma unroll
            for (int q = 0; q < 8; ++q) { float v0[8], v1[8]; unpack8(v0, ua[q]); unpack8(v1, ub[q]);
#pragma unroll
                for (int i = 0; i < 8; ++i) { a0[i] += v0[i] * d[q]; a1[i] += v1[i] * d[q]; } }
        }
        float* xr = X + (size_t)tg * D + 8 * lane; const float* gg = g2 + b * 6144 + 8 * lane;
#pragma unroll
        for (int hh = 0; hh < 2; ++hh) {
#pragma unroll
            for (int c = 0; c < 2; ++c) { const int off = hh * 512 + c * 4; const f32x4 g4 = *(const f32x4*)(gg + off); const f32x4 xv = *(const f32x4*)(xr + off);
                f32x4 av; if (hh == 0) av = (f32x4){a0[c * 4], a0[c * 4 + 1], a0[c * 4 + 2], a0[c * 4 + 3]}; else av = (f32x4){a1[c * 4], a1[c * 4 + 1], a1[c * 4 + 2], a1[c * 4 + 3]};
                *(f32x4*)(xr + off) = xv + g4 * av; } }
    }
}

__device__ __forceinline__ void phase_final(Frame& F) {
    KARGS;
    float* X = OUTP; const float* gain = IN(31);
    const int lane = F.lane, gw = F.bid * NWAVES + F.wave, NGW = F.G * NWAVES;
    f32x4 gn[4];
#pragma unroll
    for (int j = 0; j < 4; ++j) gn[j] = *(const f32x4*)(gain + 256 * j + 4 * lane);
    for (int row = gw; row < T; row += NGW) {
        float* xr = X + (size_t)row * D + 4 * lane;
        f32x4 v[4]; float ss = 0.f;
#pragma unroll
        for (int j = 0; j < 4; ++j) { v[j] = *(const f32x4*)(xr + 256 * j); ss += (v[j].x * v[j].x + v[j].y * v[j].y) + (v[j].z * v[j].z + v[j].w * v[j].w); }
        const float rstd = rsqrtf(wave_sum(ss) * (1.f / D) + NORM_EPS);
#pragma unroll
        for (int j = 0; j < 4; ++j) *(f32x4*)(xr + 256 * j) = v[j] * rstd * gn[j];
    }
}

#ifndef PH_MASK
#define PH_MASK 0xFFFF
#endif
#define PH_EN(k) ((PH_MASK >> (k)) & 1)
constexpr int NPH = 42;
__host__ __device__ inline bool phase_skipped(int p) { if (p == 0 || p == NPH - 1) return false; const int layer = (p - 1) / 10, step = (p - 1) % 10; return (layer & 1) == 0 && (step == 3 || step == 4); }
__global__ void __launch_bounds__(NTHR, 2) mk_fwd(Args args) {
    extern __shared__ __attribute__((aligned(16))) unsigned char lds[];
    Frame F;
    F.lds = (LAS unsigned char*)lds;
    F.MISC = (volatile LAS unsigned*)(F.lds + MISC_OFF);
    F.tid = threadIdx.x; F.lane = F.tid & 63; F.wave = __builtin_amdgcn_readfirstlane(F.tid >> 6);
    F.G = gridDim.x; F.bid = blockIdx.x;
    F.ctl = (gu32*)(args.ws + WS_CTL);
    for (int u = F.tid; u < (LDS_BYTES - MISC_OFF) / 4; u += NTHR) ((LAS unsigned*)(F.lds + MISC_OFF))[u] = 0u;
    __syncthreads();
    XcdBarrier bar; bar.bar = (unsigned*)(F.ctl + CW_BAR); bar.x = 0; bar.st = nullptr;
    const int lo = args.ph_lo, hi = args.ph_hi;
    if (hi - lo > 1) bar = xcd_barrier_post((unsigned*)(F.ctl + CW_BAR), F.MISC + 8);
    bool ran = false;
    for (int p = lo; p < hi; ++p) {
        if (phase_skipped(p)) continue;
        if (ran) xcd_barrier(bar);
        ran = true;
        { int t_ = threadIdx.x; asm volatile("" : "+v"(t_)); F.tid = t_; F.lane = t_ & 63; F.wave = __builtin_amdgcn_readfirstlane(t_ >> 6);
          int b_ = blockIdx.x, g_ = gridDim.x; asm volatile("" : "+s"(b_), "+s"(g_)); F.bid = b_; F.G = g_; }
        if (p == 0) { if (PH_EN(0)) phase_prologue(F); continue; }
        if (p == NPH - 1) { if (PH_EN(1)) phase_final(F); continue; }
        const int layer = (p - 1) / 10, step = (p - 1) % 10; const bool odd = layer & 1;
        KARGS;
        if (step == 0 || step == 6) { if (PH_EN(2)) phase_norm(F, layer, step == 6 ? 1 : 0); }
        else if (step == 1 || step == 7) { if (PH_EN(3)) {
            const int N = step == 7 ? 2048 : (odd ? ODD_N : EVEN_IN);
            const bf16* Bt = step == 7 ? WSP(bf16, WS_WQ + (size_t)layer * 4 * MiB) : WSP(bf16, WS_WIN + (size_t)layer * 8 * MiB);
            bf16* O = step == 7 ? WSP(bf16, WS_Q) : WSP(bf16, WS_PROJ);
            pg8::Gemm g{WSP(bf16, WS_H), Bt, T, N, D}; pg8::StaticOrder S; S.init(T, N, F.G, F.bid);
            pg8::EpiBf16<0> E{O, N, nullptr, 0, 0, 1.f};
            pg8::gemm_phase<pg8::EpiBf16<0>, pg8::StaticOrder, PG8_ALIGN, PG8_SP2>(F.lds + RING_OFF, g, S, E);
        } }
        else if (step == 2) { if (odd) { if (PH_EN(4)) phase_odd_prep(F, layer); } else { if (PH_EN(5)) phase_even_mixer(F, layer); } }
        else if (step == 3) { if (PH_EN(6)) phase_odd_main(F, layer); }
        else if (step == 4) { if (PH_EN(7)) phase_rwkv_post(F, layer); }
        else if (step == 5) { if (PH_EN(8)) {
            pg8::Gemm g{WSP(bf16, WS_MIX), WSP(bf16, WS_WOUT + (size_t)layer * 2 * MiB), T, D, D}; pg8::StaticOrder S; S.init(T, D, F.G, F.bid);
            pg8::EpiResid E{layer == 0 ? IN(0) : OUTP, OUTP, WSP(float, WS_MOD) + (size_t)layer * 2 * 6144 + 2048, 6144};
            pg8::gemm_phase<pg8::EpiResid, pg8::StaticOrder, PG8_ALIGN, PG8_SP2>(F.lds + RING_OFF, g, S, E);
        } }
        else if (step == 8) { if (PH_EN(9)) phase_peer_topk(F, layer); }
        else { if (PH_EN(10)) phase_peer_gather(F, layer); }
    }
}

extern "C" void kernel_launch(void* const* d_in, const int* in_sizes, int n_in, void* d_out, int out_size, void* d_ws, size_t ws_size, hipStream_t stream) {
    static int grid = 0;
    if (grid == 0) {
        if (n_in != 32 || in_sizes[0] != T * D || out_size != T * D || ws_size < WS_END) { fprintf(stderr, "kernel_launch: unexpected shapes (n_in %d, in0 %d, out %d, ws %zu < %zu); nothing launched\n", n_in, n_in > 0 ? in_sizes[0] : -1, out_size, ws_size, (size_t)WS_END); grid = -1; return; }
        int dev = 0, cus = 0, per_cu = 0;
        if (hipGetDevice(&dev) != hipSuccess || hipDeviceGetAttribute(&cus, hipDeviceAttributeMultiprocessorCount, dev) != hipSuccess) { grid = -1; return; }
        if (hipFuncSetAttribute((const void*)mk_fwd, hipFuncAttributeMaxDynamicSharedMemorySize, LDS_BYTES) != hipSuccess) { fprintf(stderr, "kernel_launch: hipFuncSetAttribute failed\n"); grid = -1; return; }
        if (hipOccupancyMaxActiveBlocksPerMultiprocessor(&per_cu, (const void*)mk_fwd, NTHR, LDS_BYTES) != hipSuccess || per_cu < 1) fprintf(stderr, "kernel_launch: occupancy query reports %d workgroups per CU\n", per_cu);
        (void)hipGetLastError();
        grid = cus;
    }
    if (grid < 0) return;
    if (hipMemsetAsync((char*)d_ws + WS_CTL, 0, CTL_ZERO_BYTES, stream) != hipSuccess) { fprintf(stderr, "kernel_launch: hipMemsetAsync failed\n"); return; }
    Args a{};
    for (int i = 0; i < 32; ++i) a.in[i] = (const float*)d_in[i];
    a.out = (float*)d_out; a.ws = (unsigned char*)d_ws;
#if MK_ONE_LAUNCH
    a.ph_lo = 0; a.ph_hi = NPH;
    hipLaunchKernelGGL(mk_fwd, dim3(grid), dim3(NTHR), LDS_BYTES, stream, a);
#else
    for (int p = 0; p < NPH; ++p) { if (phase_skipped(p)) continue; a.ph_lo = p; a.ph_hi = p + 1;
        hipLaunchKernelGGL(mk_fwd, dim3(grid), dim3(NTHR), LDS_BYTES, stream, a); }
#endif
    const hipError_t le = hipPeekAtLastError();
    if (le != hipSuccess) fprintf(stderr, "kernel_launch: launch failed: %s\n", hipGetErrorName(le));
}
```

```cpp
#include <hip/hip_runtime.h>
#include <cstdio>
#include <cstdint>
namespace pg8 {
#define PG8_LAS __attribute__((address_space(3)))
typedef unsigned short bf16_t;
typedef short bf16x8 __attribute__((ext_vector_type(8)));
typedef float f32x4 __attribute__((ext_vector_type(4)));
typedef unsigned u32x4 __attribute__((ext_vector_type(4)));
constexpr int BM = 256, BK = 64, HALF = 128, HTB = HALF * BK * 2  , STAGE_BYTES = 8 * HTB, NXCD = 8, WGM = 8;

__host__ __device__ __forceinline__ int lds_byte(int r, int c) { const int st = (r >> 4) * 2 + (c >> 5), rr = r & 15, cc = c & 31, ob = rr * 64 + cc * 2; return st * 1024 + (ob ^ (((ob >> 9) & 1) << 5)); }
__host__ __device__ __forceinline__ void stage_rc(int b, int& R, int& C) { const int st = b / 1024, sb = b % 1024, swz = sb ^ (((sb >> 9) & 1) << 5); R = (st >> 1) * 16 + swz / 64; C = (st & 1) * 32 + (swz % 64) / 2; }
__host__ __device__ __forceinline__ int perm32(int rho) { const int n = rho >> 4, i = rho & 15; return 8 * (i >> 2) + 4 * n + (i & 3); }

struct Unit { int pm, pn; };
struct Gemm { const bf16_t* A; const bf16_t* Bt; int M, N, K; };

struct StaticOrder {
    int nM, nN, nwg, G, c;
    __host__ __device__ void init(int M, int N, int G_, int c_) { nM = M / BM; nN = N / BM; nwg = nM * nN; G = G_; c = c_; }
    __host__ __device__ bool next(int i, Unit& u) const {
        const long L = (long)i * G + c; if (L >= nwg) return false;
        int wgid = (int)L; { const int q = nwg / NXCD, r = nwg % NXCD, xcd = wgid % NXCD, off = wgid / NXCD; wgid = (xcd < r ? xcd * (q + 1) : r * (q + 1) + (xcd - r) * q) + off; }
        const int nig = WGM * nN, gid = wgid / nig, fm = gid * WGM, gsz = (nM - fm) < WGM ? (nM - fm) : WGM;
        u.pm = fm + ((wgid % nig) % gsz); u.pn = (wgid % nig) / gsz; return true;
    }
    __device__ __forceinline__ void a_ready(const Unit&) const {}
    __device__ __forceinline__ void done(const Unit&) const {}
};

__device__ __forceinline__ unsigned cvt_pk_bf16(float lo, float hi) { unsigned r; asm volatile("v_cvt_pk_bf16_f32 %0, %1, %2" : "=v"(r) : "v"(lo), "v"(hi)); return r; }
typedef float f32x2 __attribute__((ext_vector_type(2)));
__device__ __forceinline__ f32x2 gelu_pk(f32x2 v) {
    const f32x2 av = __builtin_elementwise_abs(v), d = av * 0.2316418882f + 1.0f;
    f32x2 t; t.x = __builtin_amdgcn_rcpf(d.x); t.y = __builtin_amdgcn_rcpf(d.y);
    f32x2 q = t * 0.5307027145f + (-0.7265760135f); q = q * t + 0.7107068705f; q = q * t + (-0.142248368f); q = q * t + 0.127414796f; q = q * t;
    const f32x2 s = (v * v) * (-0.72134752044f);
    f32x2 e; e.x = __builtin_amdgcn_exp2f(s.x); e.y = __builtin_amdgcn_exp2f(s.y);
    const f32x2 m = v * (q * e), r = v - m;
    f32x2 o; o.x = v.x < 0.f ? m.x : r.x; o.y = v.y < 0.f ? m.y : r.y; return o;
}

template <int ACT  > struct EpiBf16 {
    static constexpr bool PERM = true, AFTER_DRAIN = false; static_assert(ACT == 0 || ACT == 1, "EpiBf16: ACT is 0 (none) or 1 (gelu_pk)");
    bf16_t* O; int ldc; const float* bias; int split_cols; size_t split_stride; float scale0;
    __device__ __forceinline__ void operator()(const f32x4 (&acc)[2][2][4][2], const Unit& u, int wr, int wc, int fr, int fq) const {
        const int row0 = u.pm * BM + wr * 64 + fr; int colt = u.pn * BM; bf16_t* base = O;
        float sc = 1.f; if (split_cols) { const int t = colt / split_cols; base += (size_t)t * split_stride; colt -= t * split_cols; if (t == 0) sc = scale0; }
        const int col0 = colt + wc * 32 + 8 * fq, bcol0 = u.pn * BM + wc * 32 + 8 * fq;
        f32x4 bv[2][2];
#pragma unroll
        for (int bj = 0; bj < 2; ++bj)
#pragma unroll
            for (int n = 0; n < 2; ++n) bv[bj][n] = bias ? *(const f32x4*)(bias + bcol0 + bj * HALF + 4 * n) : (f32x4){0.f, 0.f, 0.f, 0.f};
#pragma unroll
        for (int ai = 0; ai < 2; ++ai)
#pragma unroll
            for (int m = 0; m < 4; ++m) { bf16_t* rowp = base + (size_t)(row0 + ai * HALF + m * 16) * ldc + col0;
#pragma unroll
                for (int bj = 0; bj < 2; ++bj) { f32x4 v0 = acc[ai][bj][m][0] + bv[bj][0], v1 = acc[ai][bj][m][1] + bv[bj][1];
                    if (ACT == 1) { f32x2 a = gelu_pk((f32x2){v0[0], v0[1]}), b = gelu_pk((f32x2){v0[2], v0[3]}), c = gelu_pk((f32x2){v1[0], v1[1]}), d = gelu_pk((f32x2){v1[2], v1[3]});
                        v0 = (f32x4){a.x, a.y, b.x, b.y}; v1 = (f32x4){c.x, c.y, d.x, d.y}; }
                    v0 = v0 * sc; v1 = v1 * sc; u32x4 w; w.x = cvt_pk_bf16(v0[0], v0[1]); w.y = cvt_pk_bf16(v0[2], v0[3]); w.z = cvt_pk_bf16(v1[0], v1[1]); w.w = cvt_pk_bf16(v1[2], v1[3]);
                    *(u32x4*)(rowp + bj * HALF) = w; } }
    }
};
struct EpiResid {
    static constexpr bool PERM = false, AFTER_DRAIN = false;
    const float* base; float* out; const float* gate; int gstride;
    __device__ __forceinline__ void operator()(const f32x4 (&acc)[2][2][4][2], const Unit& u, int wr, int wc, int fr, int fq) const {
        const int row0 = u.pm * BM + wr * 64 + fr; const int col0 = u.pn * BM + wc * 32 + 4 * fq;
        const float* gp = gate + ((u.pm * BM) >= 8192 ? gstride : 0);
        f32x4 gv[2][2];
#pragma unroll
        for (int bj = 0; bj < 2; ++bj)
#pragma unroll
            for (int n = 0; n < 2; ++n) gv[bj][n] = *(const f32x4*)(gp + col0 + bj * HALF + n * 16);
#pragma unroll
        for (int ai = 0; ai < 2; ++ai)
#pragma unroll
            for (int m = 0; m < 4; ++m) { const size_t off = (size_t)(row0 + ai * HALF + m * 16) * 1024 + col0;
#pragma unroll
                for (int bj = 0; bj < 2; ++bj)
#pragma unroll
                    for (int n = 0; n < 2; ++n) { const f32x4 bs = *(const f32x4*)(base + off + bj * HALF + n * 16);
                        *(f32x4*)(out + off + bj * HALF + n * 16) = bs + gv[bj][n] * acc[ai][bj][m][n]; } }
    }
};
template <class Epi, class Sched, bool ALIGN_EPI = false, bool SP2 = false>
__device__ __forceinline__ void gemm_phase(PG8_LAS unsigned char* lds, const Gemm g, const Sched& S, const Epi& E) {
    int tid_l = threadIdx.x; asm volatile("" : "+v"(tid_l));
    const int tid = tid_l, wid = __builtin_amdgcn_readfirstlane(tid >> 6), lane = tid & 63, wr = wid >> 2, wc = wid & 3, fr = lane & 15, fq = lane >> 4;
    const int K = g.K, nt = K / BK;
    unsigned voffA[2], voffB[2];
#pragma unroll
    for (int i = 0; i < 2; ++i) { int R, C; stage_rc(tid * 16 + i * 8192, R, C); const int Rb = Epi::PERM ? ((R & ~31) + perm32(R & 31)) : R;
        voffA[i] = (unsigned)(R * K + C) * 2u; voffB[i] = (unsigned)(Rb * K + C) * 2u; }
    const size_t kstep = (size_t)(BK * 2);
    const size_t hstep = (size_t)HALF * K * 2;
    const size_t tstep = 2 * hstep;
    const unsigned ldsw = (unsigned)wid * 1024u;
    const int aoff = lds_byte(wr * 64 + fr, fq * 8), boff = lds_byte(wc * 32 + fr, fq * 8);
#define PG8_SA(b, h) (((b) * 2 + (h)) * HTB)
#define PG8_SB(b, h) ((4 + (b) * 2 + (h)) * HTB)
#define PG8_STAGE(bufoff, gbase, voff) do { _Pragma("unroll") for (int _i = 0; _i < 2; ++_i) \
        __builtin_amdgcn_global_load_lds((const unsigned*)((const char*)(gbase) + (voff)[_i]), (PG8_LAS unsigned*)(lds + (bufoff) + ldsw + _i * 8192), 16, 0, 0); } while (0)
#define PG8_LDA(dst, b, h) do { _Pragma("unroll") for (int m = 0; m < 4; ++m) _Pragma("unroll") for (int k = 0; k < 2; ++k) dst[m][k] = *(const PG8_LAS bf16x8*)(lds + PG8_SA(b, h) + aoff + m * 2048 + k * 1024); } while (0)
#define PG8_LDB(dst, b, h) do { _Pragma("unroll") for (int n = 0; n < 2; ++n) _Pragma("unroll") for (int k = 0; k < 2; ++k) dst[n][k] = *(const PG8_LAS bf16x8*)(lds + PG8_SB(b, h) + boff + n * 2048 + k * 1024); } while (0)
#define PG8_MMA(ai, bj, At, Bt) do { __builtin_amdgcn_s_setprio(1); _Pragma("unroll") for (int m = 0; m < 4; ++m) _Pragma("unroll") for (int n = 0; n < 2; ++n) _Pragma("unroll") for (int k = 0; k < 2; ++k) \
        acc[ai][bj][m][n] = __builtin_amdgcn_mfma_f32_16x16x32_bf16(Bt[n][k], At[m][k], acc[ai][bj][m][n], 0, 0, 0); __builtin_amdgcn_s_setprio(0); } while (0)
#define PG8_WAIT_V(n) asm volatile("s_waitcnt vmcnt(" #n ")" ::: "memory")
#define PG8_WAIT_L(n) asm volatile("s_waitcnt lgkmcnt(" #n ")" ::: "memory")
#define PG8_BAR __builtin_amdgcn_s_barrier()
#define PG8_SCHED __builtin_amdgcn_sched_barrier(0)
    Unit cur, nxt; int ui = 0;
    if (!S.next(0, cur)) return;
    f32x4 acc[2][2][4][2];
#pragma unroll
    for (int a = 0; a < 2; ++a)
#pragma unroll
        for (int b = 0; b < 2; ++b)
#pragma unroll
            for (int m = 0; m < 4; ++m)
#pragma unroll
                for (int n = 0; n < 2; ++n) acc[a][b][m][n] = (f32x4){0.f, 0.f, 0.f, 0.f};
    bf16x8 At[4][2], B0[2][2], B1[2][2];
    const char* cA = (const char*)g.A + (size_t)cur.pm * tstep; const char* cB = (const char*)g.Bt + (size_t)cur.pn * tstep;
    S.a_ready(cur);
    if constexpr (SP2) {
        PG8_STAGE(PG8_SB(0, 0), cB, voffB); PG8_STAGE(PG8_SB(0, 1), cB + hstep, voffB); PG8_STAGE(PG8_SA(0, 0), cA, voffA); PG8_STAGE(PG8_SA(0, 1), cA + hstep, voffA);
        if (wr == 1) PG8_BAR;
        PG8_WAIT_V(2); PG8_BAR;
        PG8_STAGE(PG8_SB(1, 0), cB + kstep, voffB); PG8_STAGE(PG8_SA(1, 0), cA + kstep, voffA); PG8_STAGE(PG8_SB(1, 1), cB + hstep + kstep, voffB);
        PG8_WAIT_V(6); PG8_BAR;
    } else {
        PG8_STAGE(PG8_SB(0, 0), cB, voffB); PG8_STAGE(PG8_SA(0, 0), cA, voffA); PG8_STAGE(PG8_SB(0, 1), cB + hstep, voffB); PG8_STAGE(PG8_SA(0, 1), cA + hstep, voffA);
        if (wr == 1) PG8_BAR;
        PG8_WAIT_V(4); PG8_BAR;
        PG8_STAGE(PG8_SB(1, 0), cB + kstep, voffB); PG8_STAGE(PG8_SA(1, 0), cA + kstep, voffA); PG8_STAGE(PG8_SB(1, 1), cB + hstep + kstep, voffB);
        PG8_WAIT_V(6); PG8_BAR;
    }
    for (;;) {
        const bool has_next = S.next(ui + 1, nxt);
        const char* nA = has_next ? (const char*)g.A + (size_t)nxt.pm * tstep : cA; const char* nB = has_next ? (const char*)g.Bt + (size_t)nxt.pn * tstep : cB;
        for (int t = 0; t < nt; t += 2) {
            const bool last = (t == nt - 2);
            const char* a1 = cA + (size_t)(t + 1) * kstep;
            const char* a2 = last ? nA : cA + (size_t)(t + 2) * kstep; const char* b2 = last ? nB : cB + (size_t)(t + 2) * kstep;
            const char* a3 = a2 + kstep; const char* b3 = b2 + kstep;
            if (last && has_next) S.a_ready(nxt);
            if constexpr (SP2) {
            PG8_LDB(B0, 0, 0); PG8_LDB(B1, 0, 1); PG8_SCHED; PG8_LDA(At, 0, 0); PG8_STAGE(PG8_SA(1, 1), a1 + hstep, voffA);
            PG8_WAIT_V(8); PG8_WAIT_L(0); PG8_BAR; PG8_MMA(0, 0, At, B0); PG8_MMA(0, 1, At, B1); PG8_BAR; PG8_SCHED;
            PG8_LDA(At, 0, 1); PG8_STAGE(PG8_SB(0, 0), b2, voffB); PG8_STAGE(PG8_SB(0, 1), b2 + hstep, voffB); PG8_STAGE(PG8_SA(0, 0), a2, voffA);
            PG8_WAIT_V(8); PG8_WAIT_L(0); PG8_BAR; PG8_MMA(1, 0, At, B0); PG8_MMA(1, 1, At, B1); PG8_BAR; PG8_SCHED;
            PG8_LDB(B0, 1, 0); PG8_LDB(B1, 1, 1); PG8_SCHED; PG8_LDA(At, 1, 0); PG8_STAGE(PG8_SA(0, 1), a2 + hstep, voffA);
            PG8_WAIT_V(8); PG8_WAIT_L(0); PG8_BAR; PG8_MMA(0, 0, At, B0); PG8_MMA(0, 1, At, B1); PG8_BAR; PG8_SCHED;
            PG8_LDA(At, 1, 1); PG8_STAGE(PG8_SB(1, 0), b3, voffB); PG8_STAGE(PG8_SB(1, 1), b3 + hstep, voffB); PG8_STAGE(PG8_SA(1, 0), a3, voffA);
            PG8_WAIT_V(8); PG8_WAIT_L(0); PG8_BAR; PG8_MMA(1, 0, At, B0); PG8_MMA(1, 1, At, B1); PG8_BAR; PG8_SCHED;
            } else {
            PG8_LDB(B0, 0, 0); PG8_SCHED; PG8_LDA(At, 0, 0); PG8_STAGE(PG8_SA(1, 1), a1 + hstep, voffA);
            PG8_WAIT_L(8); PG8_BAR; PG8_WAIT_L(0); PG8_MMA(0, 0, At, B0); PG8_BAR; PG8_SCHED;
            PG8_LDB(B1, 0, 1); PG8_STAGE(PG8_SB(0, 0), b2, voffB);
            PG8_BAR; PG8_WAIT_L(0); PG8_MMA(0, 1, At, B1); PG8_BAR;
            PG8_LDA(At, 0, 1); PG8_STAGE(PG8_SA(0, 0), a2, voffA);
            PG8_BAR; PG8_WAIT_L(0); PG8_MMA(1, 0, At, B0); PG8_BAR; PG8_SCHED;
            PG8_STAGE(PG8_SB(0, 1), b2 + hstep, voffB);
            PG8_WAIT_V(6); PG8_BAR; PG8_MMA(1, 1, At, B1); PG8_BAR;
            PG8_LDB(B0, 1, 0); PG8_SCHED; PG8_LDA(At, 1, 0); PG8_STAGE(PG8_SA(0, 1), a2 + hstep, voffA);
            PG8_WAIT_L(8); PG8_BAR; PG8_WAIT_L(0); PG8_MMA(0, 0, At, B0); PG8_BAR; PG8_SCHED;
            PG8_LDB(B1, 1, 1); PG8_STAGE(PG8_SB(1, 0), b3, voffB);
            PG8_BAR; PG8_WAIT_L(0); PG8_MMA(0, 1, At, B1); PG8_BAR;
            PG8_LDA(At, 1, 1); PG8_STAGE(PG8_SA(1, 0), a3, voffA);
            PG8_BAR; PG8_WAIT_L(0); PG8_MMA(1, 0, At, B0); PG8_BAR; PG8_SCHED;
            PG8_STAGE(PG8_SB(1, 1), b3 + hstep, voffB);
            PG8_WAIT_V(6); PG8_BAR; PG8_MMA(1, 1, At, B1); PG8_BAR;
            }
        }
        if constexpr (ALIGN_EPI) { if (wr == 0) PG8_BAR; }
        if constexpr (!Epi::AFTER_DRAIN) { E(acc, cur, wr, wc, fr, fq); S.done(cur); }
        if (!has_next) break;
#pragma unroll
        for (int a = 0; a < 2; ++a)
#pragma unroll
            for (int b = 0; b < 2; ++b)
#pragma unroll
                for (int m = 0; m < 4; ++m)
#pragma unroll
                    for (int n = 0; n < 2; ++n) acc[a][b][m][n] = (f32x4){0.f, 0.f, 0.f, 0.f};
        cur = nxt; cA = nA; cB = nB; ++ui;
        if constexpr (ALIGN_EPI) { if (wr == 1) PG8_BAR; }
    }
    PG8_WAIT_V(0);
    if constexpr (!ALIGN_EPI) { if (wr == 0) PG8_BAR; }
    PG8_BAR;
    if constexpr (Epi::AFTER_DRAIN) { E.fused(acc, cur, wr, wc, fr, fq, lds, wid, lane); S.done(cur); }
#undef PG8_SA
#undef PG8_SB
#undef PG8_STAGE
#undef PG8_LDA
#undef PG8_LDB
#undef PG8_MMA
#undef PG8_WAIT_V
#undef PG8_WAIT_L
#undef PG8_BAR
#undef PG8_SCHED
}
}
#ifndef PG8_SP2
#define PG8_SP2 true
#endif
#ifndef PG8_ALIGN
#define PG8_ALIGN true
#endif
#ifndef MK_ONE_LAUNCH
#define MK_ONE_LAUNCH 1
#endif

constexpr int NWAVES = 8, NTHR = NWAVES * 64;
constexpr int BATCH = 2, SEQ = 8192, D = 1024, T = BATCH * SEQ, DEPTH = 4;
constexpr int EVEN_IN = 2048, ODD_LD = 3848, ODD_N = 3840;
constexpr int NEXP = 16384;
constexpr float NORM_EPS = 1e-6f, GN_EPS = 64e-5f;

constexpr size_t MiB = 1u << 20;
constexpr size_t WS_CTL = 0, CTL_ZERO_BYTES = 1 * MiB;
constexpr size_t WS_MOD = 1 * MiB;
constexpr size_t WS_WF = WS_MOD + 256 * 1024;
constexpr size_t WS_KEYS = WS_MOD + 512 * 1024;
constexpr size_t WS_LOGF = 2 * MiB;
constexpr size_t WS_DCUM = 2 * MiB + 512 * 1024;
constexpr size_t WS_WIN = 4 * MiB;
constexpr size_t WS_WOUT = 36 * MiB;
constexpr size_t WS_WQ = 44 * MiB;
constexpr size_t WS_H = 64 * MiB;
constexpr size_t WS_MIX = 96 * MiB;
constexpr size_t WS_PROJ = 128 * MiB;
constexpr size_t WS_Q = 256 * MiB;
constexpr size_t WS_IDX = 320 * MiB;
constexpr size_t WS_GATE = 328 * MiB;
constexpr size_t WS_RW = 336 * MiB;
constexpr size_t RW_SLOT = 32 * MiB;
constexpr size_t WS_PU = WS_RW + 8 * RW_SLOT;
constexpr size_t WS_PV = WS_PU + 128 * MiB;
constexpr size_t WS_END = WS_PV + 128 * MiB;
constexpr int CW_WORK = 64;
constexpr int CW_BAR = 4096;

constexpr int RING_OFF = 0, RING_BYTES = 131072;
constexpr int MISC_OFF = 143360;
constexpr int LDS_BYTES = 147456;

#define GAS __attribute__((address_space(1)))
#define LAS __attribute__((address_space(3)))
typedef unsigned short bf16;
typedef unsigned v4u __attribute__((ext_vector_type(4)));
typedef unsigned v2u __attribute__((ext_vector_type(2)));
typedef float f32x4 __attribute__((ext_vector_type(4)));
typedef short bf16x8 __attribute__((ext_vector_type(8)));
typedef GAS unsigned gu32;
#define LDS_WAIT() asm volatile("s_waitcnt lgkmcnt(0)" ::: "memory")
#define VM_WAIT() asm volatile("s_waitcnt vmcnt(0)" ::: "memory")
__device__ __forceinline__ unsigned f2bf(float f) { unsigned u = __builtin_bit_cast(unsigned, f); return (u + 0x7fffu + ((u >> 16) & 1u)) >> 16; }
__device__ __forceinline__ unsigned pk2(float lo, float hi) { return f2bf(lo) | (f2bf(hi) << 16); }
__device__ __forceinline__ float bf2f(bf16 v) { return __builtin_bit_cast(float, (unsigned)v << 16); }
__device__ __forceinline__ float bflo(unsigned w) { return __builtin_bit_cast(float, w << 16); }
__device__ __forceinline__ float bfhi(unsigned w) { return __builtin_bit_cast(float, w & 0xffff0000u); }
__device__ __forceinline__ float wave_sum(float v) {
#pragma unroll
    for (int o = 1; o < 64; o <<= 1) v += __shfl_xor(v, o);
    return v;
}
__device__ __forceinline__ float wave_max(float v) {
#pragma unroll
    for (int o = 1; o < 64; o <<= 1) v = fmaxf(v, __shfl_xor(v, o));
    return v;
}
__device__ __forceinline__ float rl(float x, int j) { return __builtin_bit_cast(float, __builtin_amdgcn_readlane(__builtin_bit_cast(int, x), j)); }
__device__ __forceinline__ float sigmoidf_(float x) { return 1.f / (1.f + expf(-x)); }
__device__ __forceinline__ float softplusf_(float x) { return fmaxf(x, 0.f) + log1pf(expf(-fabsf(x))); }
__device__ __forceinline__ float gelu_erf(float x) { return 0.5f * x * (1.f + erff(x * 0.70710678118654752f)); }

#define XB_TMO      128
#define XB_XCNT(j)  (256  + 64 * (j))
#define XB_XSUB(j)  (1280 + 64 * (j))
#define XB_XGEN(j)  (2304 + 64 * (j))
#define XB_TOP      3328
#define XB_TOPGEN   3392
#define XCD_BAR_WORDS 3456
#define XB_SPIN_CAP (1u << 18)

__device__ __forceinline__ unsigned xb_ld(unsigned* p)              { return __hip_atomic_load(p, __ATOMIC_RELAXED, __HIP_MEMORY_SCOPE_AGENT); }
__device__ __forceinline__ unsigned xb_add(unsigned* p, unsigned v) { return __hip_atomic_fetch_add(p, v, __ATOMIC_RELAXED, __HIP_MEMORY_SCOPE_AGENT); }
__device__ __forceinline__ unsigned xb_xcc_id() { return (unsigned)__builtin_amdgcn_s_getreg((3 << 11) | 20) & 0xFu; }
#define XB_SPIN(cond, bar) do { unsigned _sp = 0; while (cond) { __builtin_amdgcn_s_sleep(1); \
    if ((++_sp & 255u) == 0u) { if (xb_ld(&(bar)[XB_TMO])) break; if (_sp > XB_SPIN_CAP) { atomicAdd(&(bar)[XB_TMO], 1u); break; } } } } while (0)

struct XcdBarrier {
    unsigned* bar; unsigned x;
    volatile LAS unsigned* st;
};

__device__ __forceinline__ XcdBarrier xcd_barrier_post(unsigned* bar, volatile LAS unsigned* st) {
    XcdBarrier b; b.bar = bar; b.x = xb_xcc_id(); b.st = st;
    if (threadIdx.x == 0) (void)xb_add(&bar[XB_XCNT(b.x)], 1u);
    return b;
}
__device__ __forceinline__ void xcd_barrier_complete(unsigned* bar, unsigned x, unsigned& nloc, unsigned& nx) {
    const unsigned G = gridDim.x * gridDim.y * gridDim.z;
    unsigned sum, cnt, mine, sp = 0u;
    for (;;) {
        sum = 0u; cnt = 0u; mine = 0u;
#pragma unroll
        for (unsigned j = 0; j < 16; ++j) { const unsigned c = xb_ld(&bar[XB_XCNT(j)]); sum += c; cnt += (c > 0u) ? 1u : 0u; mine = (j == x) ? c : mine; }
        if (sum == G) break;
        __builtin_amdgcn_s_sleep(1);
        if ((++sp & 255u) == 0u) { if (xb_ld(&bar[XB_TMO])) break; if (sp > XB_SPIN_CAP) { atomicAdd(&bar[XB_TMO], 1u); break; } }
    }
    nloc = mine > 0u ? mine : 1u; nx = cnt > 0u ? cnt : 1u;
}

__device__ __forceinline__ void xcd_barrier(const XcdBarrier& b) {
    asm volatile("s_waitcnt vmcnt(0)" ::: "memory");
    __syncthreads();
    if (threadIdx.x == 0) {
        unsigned* bar = b.bar;
        __builtin_amdgcn_s_waitcnt(0);
        unsigned nloc = b.st[0], nx = b.st[1];
        if (nloc == 0u) { xcd_barrier_complete(bar, b.x, nloc, nx); b.st[0] = nloc; b.st[1] = nx; }
        const unsigned old = xb_add(&bar[XB_XSUB(b.x)], 1u);
        const unsigned gen = old / nloc;
        if (old + 1u == (gen + 1u) * nloc) {
            __builtin_amdgcn_fence(__ATOMIC_RELEASE, "agent");
            asm volatile("s_waitcnt vmcnt(0)" ::: "memory");
            const unsigned og = xb_add(&bar[XB_TOP], 1u);
            const unsigned tg = og / nx;
            if (og + 1u == (tg + 1u) * nx) xb_add(&bar[XB_TOPGEN], 1u);
            else XB_SPIN(xb_ld(&bar[XB_TOPGEN]) == tg, bar);
            __builtin_amdgcn_fence(__ATOMIC_ACQUIRE, "agent");
            xb_add(&bar[XB_XGEN(b.x)], 1u);
            asm volatile("s_waitcnt vmcnt(0)" ::: "memory");
        } else {
            XB_SPIN(xb_ld(&bar[XB_XGEN(b.x)]) == gen, bar);
            __builtin_amdgcn_fence(__ATOMIC_ACQUIRE, "agent");
            asm volatile("s_waitcnt vmcnt(0)" ::: "memory");
        }
    }
    __syncthreads();
}


struct Frame {
    LAS unsigned char* lds;
    volatile LAS unsigned* MISC;
    gu32* ctl;
    int tid, lane, wave, G, bid;
};
struct Args { const float* in[32]; float* out; unsigned char* ws; int ph_lo, ph_hi; };
#define CAS __attribute__((address_space(4)))
#define KARGS const CAS Args* ka_; { unsigned long long kp_ = (unsigned long long)__builtin_amdgcn_kernarg_segment_ptr(); asm volatile("" : "+s"(kp_)); ka_ = (const CAS Args*)kp_; } unsigned char* const ws_ = ka_->ws
#define IN(i) (ka_->in[i])
#define OUTP (ka_->out)
#define WSP(type, off) ((type*)(ws_ + (off)))

__device__ __forceinline__ void transpose_item(const float* W, int ldw, bf16* WT, int row_off, LAS float* scr, int item, int nblk, int lane) {
    const int kb = item / nblk, nb = item % nblk, k0 = 64 * kb, n0 = 32 * nb;
#pragma unroll 8
    for (int i = 0; i < 32; ++i) { const int kk = 2 * i + (lane >> 5); scr[kk * 33 + (lane & 31)] = W[(size_t)(k0 + kk) * ldw + n0 + (lane & 31)]; }
    LDS_WAIT(); asm volatile("" ::: "memory");
    const int c = lane & 7;
#pragma unroll
    for (int j = 0; j < 4; ++j) { const int n = (lane >> 3) + 8 * j; const LAS float* s = scr + (8 * c) * 33 + n;
        v4u o; o.x = pk2(s[0 * 33], s[1 * 33]); o.y = pk2(s[2 * 33], s[3 * 33]); o.z = pk2(s[4 * 33], s[5 * 33]); o.w = pk2(s[6 * 33], s[7 * 33]);
        *(v4u*)(WT + (size_t)(row_off + n0 + n) * 1024 + k0 + 8 * c) = o; }
    LDS_WAIT(); asm volatile("" ::: "memory");
}

__device__ __forceinline__ void phase_prologue(Frame& F) {
    KARGS;
    LAS float* cact = (LAS float*)F.lds;
    LAS float* part = cact + 2048;
    {   const float* c = IN(1);
        for (int i = F.tid; i < 2048; i += NTHR) { const float v = c[i]; cact[i] = v / (1.f + expf(-v)); } }
    __syncthreads();
    {
        const float* ada_w = IN(2); const float* ada_b = IN(3); float* MOD = WSP(float, WS_MOD);
        for (int it = F.bid; it < 384; it += F.G) {
            const int l = it / 96, j0 = (it % 96) * 64;
            const float* wp = ada_w + ((size_t)l * 1024 + F.wave * 128) * 6144 + j0 + F.lane;
            float a0 = 0.f, a1 = 0.f;
#pragma unroll 8
            for (int k = 0; k < 128; ++k) { const float w = wp[(size_t)k * 6144]; a0 += cact[F.wave * 128 + k] * w; a1 += cact[1024 + F.wave * 128 + k] * w; }
            part[(F.wave * 2 + 0) * 64 + F.lane] = a0; part[(F.wave * 2 + 1) * 64 + F.lane] = a1;
            __syncthreads();
            if (F.tid < 128) { const int b = F.tid >> 6, col = F.tid & 63; float s = 0.f;
#pragma unroll
                for (int w = 0; w < 8; ++w) s += part[(w * 2 + b) * 64 + col];
                MOD[(l * 2 + b) * 6144 + j0 + col] = s + ada_b[l * 6144 + j0 + col]; }
            __syncthreads();
        }
    }
    {
        LAS float* scr = (LAS float*)(F.lds + 16384 + F.wave * 8448);
        const int gw = F.bid * NWAVES + F.wave, NGW = F.G * NWAVES;
        constexpr int I_A = 16 * 64, I_B = 16 * 64, I_C = 16 * 56, I_D = 16 * 32, I_E = 16 * 64;
        constexpr int NITEMS = 2 * I_A + 2 * I_B + 2 * I_C + 4 * I_D + 4 * I_E;
        for (int it = gw; it < NITEMS; it += NGW) {
            int r = it;
            if (r < 2 * I_A) { const int j = r / I_A; transpose_item(IN(6) + (size_t)j * 1024 * 2048, 2048, WSP(bf16, WS_WIN + (size_t)(2 * j) * 8 * MiB), 0, scr, r % I_A, 64, F.lane); continue; } r -= 2 * I_A;
            if (r < 2 * I_B) { const int j = r / I_B; transpose_item(IN(10) + (size_t)j * 1024 * ODD_LD, ODD_LD, WSP(bf16, WS_WIN + (size_t)(2 * j + 1) * 8 * MiB), 0, scr, r % I_B, 64, F.lane); continue; } r -= 2 * I_B;
            if (r < 2 * I_C) { const int j = r / I_C; transpose_item(IN(10) + (size_t)j * 1024 * ODD_LD + 2056, ODD_LD, WSP(bf16, WS_WIN + (size_t)(2 * j + 1) * 8 * MiB), 2048, scr, r % I_C, 56, F.lane); continue; } r -= 2 * I_C;
            if (r < 4 * I_D) { const int l = r / I_D; const int j = l >> 1; const float* src = (l & 1) ? IN(11) : IN(7);
                transpose_item(src + (size_t)j * 1024 * 1024, 1024, WSP(bf16, WS_WOUT + (size_t)l * 2 * MiB), 0, scr, r % I_D, 32, F.lane); continue; } r -= 4 * I_D;
            { const int l = r / I_E; transpose_item(IN(26) + (size_t)l * 1024 * 2048, 2048, WSP(bf16, WS_WQ + (size_t)l * 4 * MiB), 0, scr, r % I_E, 64, F.lane); }
        }
    }
    {
        const int gt = F.bid * NTHR + F.tid, NGT = F.G * NTHR;
        float* WF = WSP(float, WS_WF);
        for (int i = gt; i < 2 * 8 * 1024; i += NGT) { const int j = i >> 13, h = (i >> 10) & 7, k = i & 1023; WF[i] = IN(10)[((size_t)j * 1024 + k) * ODD_LD + 2048 + h]; }
        bf16* KEYS = WSP(bf16, WS_KEYS);
        for (int i = gt; i < 4 * 16384; i += NGT) { const int l = i >> 14, r = i & 16383;
            KEYS[(size_t)(l * 2 + 0) * 16384 + r] = (bf16)f2bf(IN(27)[i]); KEYS[(size_t)(l * 2 + 1) * 16384 + r] = (bf16)f2bf(IN(28)[i]); }
        const f32x4* su = (const f32x4*)IN(29); const f32x4* sv = (const f32x4*)IN(30); v2u* du = WSP(v2u, WS_PU); v2u* dv = WSP(v2u, WS_PV);
        for (size_t i = gt; i < (size_t)4 * NEXP * 1024 / 4; i += NGT) { const f32x4 a = su[i], b = sv[i];
            v2u o; o.x = pk2(a.x, a.y); o.y = pk2(a.z, a.w); du[i] = o; o.x = pk2(b.x, b.y); o.y = pk2(b.z, b.w); dv[i] = o; }
    }
}

__device__ __forceinline__ void phase_norm(Frame& F, int layer, int which) {
    KARGS;
    const float* X = (layer == 0 && which == 0) ? IN(0) : OUTP;
    const float* gain = (which ? IN(5) : IN(4)) + layer * 1024;
    const float* mod = WSP(float, WS_MOD) + (size_t)layer * 2 * 6144 + (which ? 3072 : 0);
    bf16* H = WSP(bf16, WS_H);
    const bool do_f = (layer & 1) && which == 0;
    const int jj = layer >> 1;
    const float* WF = WSP(float, WS_WF) + (size_t)jj * 8 * 1024;
    float* LOGF = WSP(float, WS_LOGF);
    const int gw = F.bid * NWAVES + F.wave, NGW = F.G * NWAVES, lane = F.lane;
    f32x4 gn[4];
#pragma unroll
    for (int j = 0; j < 4; ++j) gn[j] = *(const f32x4*)(gain + 256 * j + 4 * lane);
    for (int row = gw; row < T; row += NGW) {
        const int b = row >= SEQ ? 1 : 0;
        const float* sh = mod + b * 6144; const float* sc = sh + 1024;
        const float* xr = X + (size_t)row * D + 4 * lane;
        f32x4 v[4]; float ss = 0.f;
#pragma unroll
        for (int j = 0; j < 4; ++j) { v[j] = *(const f32x4*)(xr + 256 * j); ss += (v[j].x * v[j].x + v[j].y * v[j].y) + (v[j].z * v[j].z + v[j].w * v[j].w); }
        const float rstd = rsqrtf(wave_sum(ss) * (1.f / D) + NORM_EPS);
        bf16* hr = H + (size_t)row * D + 4 * lane;
#pragma unroll
        for (int j = 0; j < 4; ++j) { const f32x4 s4 = *(const f32x4*)(sc + 256 * j + 4 * lane), h4 = *(const f32x4*)(sh + 256 * j + 4 * lane);
            v[j] = v[j] * rstd * gn[j] * (s4 + 1.f) + h4;
            v2u o; o.x = pk2(v[j].x, v[j].y); o.y = pk2(v[j].z, v[j].w); *(v2u*)(hr + 256 * j) = o; }
        if (do_f) {
            const float* fb = IN(14) + jj * 8;
            const int t = row - b * SEQ;
#pragma unroll
            for (int hh = 0; hh < 8; ++hh) { float d = 0.f;
#pragma unroll
                for (int j = 0; j < 4; ++j) { const f32x4 w4 = *(const f32x4*)(WF + hh * 1024 + 256 * j + 4 * lane); d += (v[j].x * w4.x + v[j].y * w4.y) + (v[j].z * w4.z + v[j].w * w4.w); }
                d = wave_sum(d) + fb[hh];
                const float lf = fminf(d, 0.f) - log1pf(expf(-fabsf(d)));
                if (lane == 0) LOGF[(size_t)(b * 8 + hh) * SEQ + t] = lf; }
        }
    }
}

__device__ __forceinline__ void load_q64(float (&q)[64], const bf16* p, float scale) {
#pragma unroll
    for (int c = 0; c < 8; ++c) { const v4u w = *(const v4u*)(p + 8 * c);
        q[8 * c + 0] = bflo(w.x) * scale; q[8 * c + 1] = bfhi(w.x) * scale; q[8 * c + 2] = bflo(w.y) * scale; q[8 * c + 3] = bfhi(w.y) * scale;
        q[8 * c + 4] = bflo(w.z) * scale; q[8 * c + 5] = bfhi(w.z) * scale; q[8 * c + 6] = bflo(w.w) * scale; q[8 * c + 7] = bfhi(w.w) * scale; }
}
__device__ __forceinline__ float dot_q64(const float (&q)[64], const bf16* p) {
    float z0 = 0.f, z1 = 0.f;
#pragma unroll
    for (int c = 0; c < 8; ++c) { const v4u w = *(const v4u*)(p + 8 * c);
        z0 += q[8 * c + 0] * bflo(w.x) + q[8 * c + 2] * bflo(w.y) + q[8 * c + 4] * bflo(w.z) + q[8 * c + 6] * bflo(w.w);
        z1 += q[8 * c + 1] * bfhi(w.x) + q[8 * c + 3] * bfhi(w.y) + q[8 * c + 5] * bfhi(w.z) + q[8 * c + 7] * bfhi(w.w); }
    return z0 + z1;
}
__device__ __forceinline__ void phase_even_mixer(Frame& F, int layer) {
    KARGS;
    const bf16* P = WSP(bf16, WS_PROJ); bf16* MIX = WSP(bf16, WS_MIX);
    const int lane = F.lane;
    {
        const int gw = F.bid * NWAVES + F.wave, NGW = F.G * NWAVES;
        for (int it = gw; it < BATCH * 8 * SEQ; it += NGW) {
            const int b = it >> 16, h = (it >> 13) & 7, t = it & 8191;
            const bf16* base = P + (size_t)b * SEQ * EVEN_IN;
            float q[64]; load_q64(q, base + (size_t)t * EVEN_IN + h * 64, 0.125f);
            float acc = 0.f, carry = 0.f;
            for (int s0 = t - 1; s0 >= 0; s0 -= 64) {
                const int s = s0 - lane; const bool valid = s >= 0; const int sc = valid ? s : 0;
                const float z = dot_q64(q, base + (size_t)sc * EVEN_IN + 512 + h * 64);
                const float sp = softplusf_(z);
                const float l1m = valid ? -sp : 0.f;
                const float lb = z - sp;
                float inc = l1m;
#pragma unroll
                for (int o = 1; o < 64; o <<= 1) { const float n = __shfl_up(inc, o); if (lane >= o) inc += n; }
                const float w = valid ? expf(lb + carry + (inc - l1m)) : 0.f;
                const float tot = __shfl(inc, 63);
#pragma unroll 16
                for (int j = 0; j < 64; ++j) { const float wj = rl(w, j); int sj = s0 - j; sj = sj < 0 ? 0 : sj;
                    acc += wj * bf2f(base[(size_t)sj * EVEN_IN + 1024 + h * 64 + lane]); }
                carry += tot;
                if (carry < -104.f) break;
            }
            MIX[((size_t)b * SEQ + t) * D + h * 64 + lane] = (bf16)f2bf(acc);
        }
    }
    {
        LAS float* pl = (LAS float*)F.lds;
        const int jj = layer >> 1;
        const float* pw = IN(8) + (size_t)jj * 4 * 128 * 128; const float* ps = IN(9) + jj * 512;
        const int c = F.tid, g = c >> 7, w = 2 << g, d = c & 127;
        for (int tile = F.bid; tile < T / 32; tile += F.G) {
            const int t0 = tile * 32, b = t0 / SEQ, tl0 = t0 % SEQ;
            const bf16* base = P + (size_t)b * SEQ * EVEN_IN + 1536 + c;
            for (int tt = 0; tt < 32; ++tt) { const int tl = tl0 + tt, cend = (tl / 64 + 1) * 64;
                int lo = tl - w / 2; lo = lo < 0 ? 0 : lo; int hi = tl + w / 2; hi = hi > cend ? cend : hi;
                float s = 0.f; for (int u = lo; u < hi; ++u) s += bf2f(base[(size_t)u * EVEN_IN]);
                pl[c * 33 + tt] = s / (float)(hi - lo) - bf2f(base[(size_t)tl * EVEN_IN]); }
            __syncthreads();
            float acc[32];
#pragma unroll
            for (int tt = 0; tt < 32; ++tt) acc[tt] = 0.f;
            for (int cc = 0; cc < 128; ++cc) { const float wv = pw[((size_t)g * 128 + cc) * 128 + d]; const LAS float* pr = pl + (g * 128 + cc) * 33;
#pragma unroll
                for (int tt = 0; tt < 32; ++tt) acc[tt] += pr[tt] * wv; }
            const float sc = ps[c];
#pragma unroll
            for (int tt = 0; tt < 32; ++tt) MIX[(size_t)(t0 + tt) * D + 512 + c] = (bf16)f2bf(acc[tt] * sc);
            __syncthreads();
        }
    }
}

__device__ __forceinline__ void phase_odd_prep(Frame& F, int layer) {
    KARGS;
    const int jj = layer >> 1, lane = F.lane;
    bf16* P = WSP(bf16, WS_PROJ);
    if (F.wave == 0 && F.bid < 16) {
        const float* lf = WSP(float, WS_LOGF) + (size_t)F.bid * SEQ; float* dc = WSP(float, WS_DCUM) + (size_t)F.bid * SEQ; double carry = 0.0;
        for (int t0 = 0; t0 < SEQ; t0 += 64) { float inc = lf[t0 + lane];
#pragma unroll
            for (int o = 1; o < 64; o <<= 1) { const float n = __shfl_up(inc, o); if (lane >= o) inc += n; }
            dc[t0 + lane] = (float)(carry + (double)inc); carry += (double)__shfl(inc, 63); }
    }
    LAS float* lx = (LAS float*)F.lds;
    const float* mix = IN(15) + jj * 1792;
    const float* w0 = IN(16) + jj * 512; const float* w2 = IN(17) + (size_t)jj * 64 * 512;
    const float* a0 = IN(18) + jj * 512; const float* a2 = IN(19) + (size_t)jj * 64 * 512;
    const float* g2 = IN(20) + (size_t)jj * 128 * 512;
    const float* kkp = IN(21) + jj * 512; const float* kap = IN(22) + jj * 512;
    const float* qn = IN(12) + jj * 64; const float* kn = IN(13) + jj * 64;
    float* R = WSP(float, WS_RW); float* Wd = WSP(float, WS_RW + RW_SLOT); float* K = WSP(float, WS_RW + 2 * RW_SLOT); float* V = WSP(float, WS_RW + 3 * RW_SLOT);
    float* KK = WSP(float, WS_RW + 4 * RW_SLOT); float* A = WSP(float, WS_RW + 5 * RW_SLOT); float* Gt = WSP(float, WS_RW + 6 * RW_SLOT);
    const int ch = F.tid;
    const float m_r = mix[ch], m_k = mix[512 + ch], m_v = mix[1024 + ch];
    const float w0c = w0[ch], a0c = a0[ch], kkc = kkp[ch], kac = kap[ch], qnc = qn[ch & 63], knc = kn[ch & 63];
    for (int item = F.bid; item < T / 16; item += F.G) {
        const int t0 = item * 16;
        for (int i = F.tid; i < 16 * 256; i += NTHR) { const int tt = i >> 8, j = i & 255, tg = t0 + tt, tl = tg % SEQ, col = 1536 + j;
            const float cur = bf2f(P[(size_t)tg * ODD_N + 2048 + col]); const float prev = tl > 0 ? bf2f(P[(size_t)(tg - 1) * ODD_N + 2048 + col]) : 0.f;
            const float x = cur + (prev - cur) * mix[col];
            lx[i] = j < 64 ? tanhf(x) : (j < 128 ? x : sigmoidf_(x)); }
        __syncthreads();
        float aw[16], aa[16], ag[16];
#pragma unroll
        for (int tt = 0; tt < 16; ++tt) { aw[tt] = 0.f; aa[tt] = 0.f; ag[tt] = 0.f; }
        for (int i = 0; i < 64; ++i) { const float w2v = w2[i * 512 + ch], a2v = a2[i * 512 + ch];
#pragma unroll
            for (int tt = 0; tt < 16; ++tt) { aw[tt] += lx[tt * 256 + i] * w2v; aa[tt] += lx[tt * 256 + 64 + i] * a2v; } }
        for (int i = 0; i < 128; ++i) { const float g2v = g2[i * 512 + ch];
#pragma unroll
            for (int tt = 0; tt < 16; ++tt) ag[tt] += lx[tt * 256 + 128 + i] * g2v; }
#pragma unroll
        for (int tt = 0; tt < 16; ++tt) { const int tg = t0 + tt, tl = tg % SEQ;
            const bf16* pc = P + (size_t)tg * ODD_N + 2048 + ch; const bf16* pp = pc - ODD_N;
            const float rc = bf2f(pc[0]), kc = bf2f(pc[512]), vc = bf2f(pc[1024]);
            const float rp = tl > 0 ? bf2f(pp[0]) : 0.f, kp = tl > 0 ? bf2f(pp[512]) : 0.f, vp = tl > 0 ? bf2f(pp[1024]) : 0.f;
            const float r = rc + (rp - rc) * m_r, kr = kc + (kp - kc) * m_k, vr = vc + (vp - vc) * m_v;
            const float wl = -softplusf_(-(w0c + aw[tt])) - 0.5f; const float decay = expf(-expf(wl));
            const float a = sigmoidf_(a0c + aa[tt]);
            const float kkv = kr * kkc; const float n2 = wave_sum(kkv * kkv); const float kkn = kkv / fmaxf(sqrtf(n2), 1e-12f);
            const float kmod = kr * (1.f + (a - 1.f) * kac);
            const size_t o = (size_t)tg * 512 + ch;
            R[o] = r; Wd[o] = decay; K[o] = kmod; V[o] = vr; KK[o] = kkn; A[o] = a; Gt[o] = ag[tt];
            bf16* pq = P + (size_t)tg * ODD_N + ch;
            const float qv = bf2f(pq[0]), kv = bf2f(pq[512]);
            const float qs = wave_sum(qv * qv) * (1.f / 64.f), ks = wave_sum(kv * kv) * (1.f / 64.f);
            pq[0] = (bf16)f2bf(qv * rsqrtf(qs + NORM_EPS) * qnc); pq[512] = (bf16)f2bf(kv * rsqrtf(ks + NORM_EPS) * knc); }
        __syncthreads();
    }
}

__device__ __forceinline__ void rwkv_scan_simple(Frame& F, int sid) {
    KARGS;
    const int b = sid >> 3, h = sid & 7, lane = F.lane;
    const size_t base = (size_t)b * SEQ * 512 + h * 64 + lane;
    const float* R = WSP(float, WS_RW); const float* Wd = WSP(float, WS_RW + RW_SLOT); const float* K = WSP(float, WS_RW + 2 * RW_SLOT); const float* V = WSP(float, WS_RW + 3 * RW_SLOT);
    const float* KK = WSP(float, WS_RW + 4 * RW_SLOT); const float* A = WSP(float, WS_RW + 5 * RW_SLOT); float* Y = WSP(float, WS_RW + 7 * RW_SLOT);
    float st[64];
#pragma unroll
    for (int j = 0; j < 64; ++j) st[j] = 0.f;
    float r_n = R[base], w_n = Wd[base], k_n = K[base], v_n = V[base], kk_n = KK[base], a_n = A[base];
    for (int t = 0; t < SEQ; ++t) {
        const float r = r_n, w = w_n, k = k_n, v = v_n, kk = kk_n, ka = kk_n * a_n;
        if (t + 1 < SEQ) { const size_t o = base + (size_t)(t + 1) * 512; r_n = R[o]; w_n = Wd[o]; k_n = K[o]; v_n = V[o]; kk_n = KK[o]; a_n = A[o]; }
        float sa = 0.f;
#pragma unroll
        for (int j = 0; j < 64; ++j) sa += st[j] * rl(kk, j);
        float y = 0.f;
#pragma unroll
        for (int j = 0; j < 64; ++j) { st[j] = st[j] * rl(w, j) - sa * rl(ka, j) + v * rl(k, j); y += st[j] * rl(r, j); }
        Y[base + (size_t)t * 512] = y;
    }
}
__device__ __forceinline__ void phase_rwkv_scan(Frame& F, int layer) {
    if (F.wave == 7 && F.bid < 16) rwkv_scan_simple(F, F.bid);
}

typedef float f32x16 __attribute__((ext_vector_type(16)));
typedef short s16x4 __attribute__((ext_vector_type(4)));
constexpr int FX_KROW = 144, FX_VROW = 192;
constexpr int FX_KB = 64 * FX_KROW, FX_VB = 64 * FX_VROW, FX_BUF = FX_KB + FX_VB + 256;
__device__ __forceinline__ void phase_fox_attn(Frame& F, int layer) {
    KARGS;
    const bf16* P = WSP(bf16, WS_PROJ); bf16* MIX = WSP(bf16, WS_MIX); const float* DC = WSP(float, WS_DCUM);
    const int tid = F.tid, lane = F.lane, wave = F.wave, r32 = lane & 31, hh = lane >> 5;
    const float LOG2E = 1.4426950408889634f, CS = 0.125f * LOG2E;
    const int srow = tid >> 3, sch = tid & 7;
    for (int u = F.bid; u < 256; u += F.G) {
        for (int ui = 0; ui < 2; ++ui) {
            const int bh = u >> 4, ss = u & 15, qb = ui == 0 ? ss : 31 - ss, b = bh >> 3, h = bh & 7;
            const bf16* base = P + (size_t)b * SEQ * ODD_N; const float* dc = DC + (size_t)bh * SEQ;
            const int q0 = 256 * qb + 32 * wave, myq = q0 + r32;
            bf16x8 qf[4];
#pragma unroll
            for (int d0 = 0; d0 < 4; ++d0) qf[d0] = *(const bf16x8*)(base + (size_t)myq * ODD_N + h * 64 + 16 * d0 + 8 * hh);
            const float dq = dc[myq] * LOG2E;
            float m = -INFINITY, lsum = 0.f;
            f32x16 o[2];
#pragma unroll
            for (int r = 0; r < 16; ++r) { o[0][r] = 0.f; o[1][r] = 0.f; }
            const int NT = 4 * qb + 4;
            v4u kreg = *(const v4u*)(base + (size_t)srow * ODD_N + 512 + h * 64 + sch * 8);
            v4u vreg = *(const v4u*)(base + (size_t)srow * ODD_N + 1024 + h * 64 + sch * 8);
            float dreg = tid < 64 ? dc[tid] * LOG2E : 0.f;
            *(LAS v4u*)(F.lds + srow * FX_KROW + sch * 16) = kreg; *(LAS v4u*)(F.lds + FX_KB + srow * FX_VROW + sch * 16) = vreg;
            if (tid < 64) *(LAS float*)(F.lds + FX_KB + FX_VB + tid * 4) = dreg;
            __syncthreads();
            for (int j = 0; j < NT; ++j) {
                const int cur = (j & 1) * FX_BUF, nxt = ((j + 1) & 1) * FX_BUF;
                if (j + 1 < NT) { const size_t krow = (size_t)(64 * (j + 1) + srow) * ODD_N;
                    kreg = *(const v4u*)(base + krow + 512 + h * 64 + sch * 8); vreg = *(const v4u*)(base + krow + 1024 + h * 64 + sch * 8);
                    if (tid < 64) dreg = dc[64 * (j + 1) + tid] * LOG2E; }
                if (64 * j <= q0 + 31) {
                    const LAS unsigned char* Kb = F.lds + cur; const LAS unsigned char* Vb = F.lds + cur + FX_KB; const LAS float* dkb = (const LAS float*)(F.lds + cur + FX_KB + FX_VB);
                    f32x16 p0, p1;
#pragma unroll
                    for (int r = 0; r < 16; ++r) { p0[r] = 0.f; p1[r] = 0.f; }
#pragma unroll
                    for (int d0 = 0; d0 < 4; ++d0) {
                        const bf16x8 a0 = *(const LAS bf16x8*)(Kb + r32 * FX_KROW + 32 * d0 + 16 * hh);
                        const bf16x8 a1 = *(const LAS bf16x8*)(Kb + (r32 + 32) * FX_KROW + 32 * d0 + 16 * hh);
                        p0 = __builtin_amdgcn_mfma_f32_32x32x16_bf16(a0, qf[d0], p0, 0, 0, 0);
                        p1 = __builtin_amdgcn_mfma_f32_32x32x16_bf16(a1, qf[d0], p1, 0, 0, 0);
                    }
                    const bool diag = 64 * j + 63 > q0;
                    float tmax = -INFINITY;
#pragma unroll
                    for (int g = 0; g < 4; ++g) {
                        const f32x4 dk0 = *(const LAS f32x4*)(dkb + 8 * g + 4 * hh), dk1 = *(const LAS f32x4*)(dkb + 32 + 8 * g + 4 * hh);
#pragma unroll
                        for (int i = 0; i < 4; ++i) {
                            float z0 = p0[4 * g + i] * CS + (dq - dk0[i]), z1 = p1[4 * g + i] * CS + (dq - dk1[i]);
                            if (diag) { const int key = 64 * j + 8 * g + 4 * hh + i; if (key > myq) z0 = -INFINITY; if (key + 32 > myq) z1 = -INFINITY; }
                            p0[4 * g + i] = z0; p1[4 * g + i] = z1; tmax = fmaxf(tmax, fmaxf(z0, z1)); }
                    }
                    tmax = fmaxf(tmax, __shfl_xor(tmax, 32));
                    const float mn = fmaxf(m, tmax); const float corr = __builtin_amdgcn_exp2f(m - mn); m = mn;
                    float ps = 0.f;
#pragma unroll
                    for (int r = 0; r < 16; ++r) { p0[r] = __builtin_amdgcn_exp2f(p0[r] - mn); p1[r] = __builtin_amdgcn_exp2f(p1[r] - mn); ps += p0[r] + p1[r]; }
                    lsum = lsum * corr + ps;
#pragma unroll
                    for (int r = 0; r < 16; ++r) { o[0][r] *= corr; o[1][r] *= corr; }
                    bf16x8 pf[4];
#pragma unroll
                    for (int s4 = 0; s4 < 4; ++s4) {
                        v4u w;
                        if (s4 < 2) { w.x = pk2(p0[8 * s4 + 0], p0[8 * s4 + 1]); w.y = pk2(p0[8 * s4 + 2], p0[8 * s4 + 3]); w.z = pk2(p0[8 * s4 + 4], p0[8 * s4 + 5]); w.w = pk2(p0[8 * s4 + 6], p0[8 * s4 + 7]); }
                        else { const int sp = s4 - 2; w.x = pk2(p1[8 * sp + 0], p1[8 * sp + 1]); w.y = pk2(p1[8 * sp + 2], p1[8 * sp + 3]); w.z = pk2(p1[8 * sp + 4], p1[8 * sp + 5]); w.w = pk2(p1[8 * sp + 6], p1[8 * sp + 7]); }
                        pf[s4] = __builtin_bit_cast(bf16x8, w);
                    }
                    const int gi = lane >> 4, li = lane & 15;
                    const LAS unsigned char* vbase = Vb + (4 * (gi >> 1) + (li >> 2)) * FX_VROW + (16 * (gi & 1) + 4 * (li & 3)) * 2;
#pragma unroll
                    for (int d0 = 0; d0 < 2; ++d0)
#pragma unroll
                        for (int s4 = 0; s4 < 4; ++s4) {
                            const s16x4 lo = __builtin_bit_cast(s16x4, __builtin_amdgcn_ds_read_tr16_b64_v4i16((LAS s16x4*)(vbase + (16 * s4) * FX_VROW + 64 * d0)));
                            const s16x4 hi = __builtin_bit_cast(s16x4, __builtin_amdgcn_ds_read_tr16_b64_v4i16((LAS s16x4*)(vbase + (16 * s4 + 8) * FX_VROW + 64 * d0)));
                            const bf16x8 vf = (bf16x8){lo[0], lo[1], lo[2], lo[3], hi[0], hi[1], hi[2], hi[3]};
                            o[d0] = __builtin_amdgcn_mfma_f32_32x32x16_bf16(vf, pf[s4], o[d0], 0, 0, 0);
                        }
                }
                if (j + 1 < NT) {
                    *(LAS v4u*)(F.lds + nxt + srow * FX_KROW + sch * 16) = kreg; *(LAS v4u*)(F.lds + nxt + FX_KB + srow * FX_VROW + sch * 16) = vreg;
                    if (tid < 64) *(LAS float*)(F.lds + nxt + FX_KB + FX_VB + tid * 4) = dreg;
                }
                __syncthreads();
            }
            const float l = lsum + __shfl_xor(lsum, 32); const float inv = 1.f / l;
            const bf16* gp = base + (size_t)myq * ODD_N + 1536 + h * 64; bf16* op = MIX + ((size_t)b * SEQ + myq) * D + h * 64;
#pragma unroll
            for (int d0 = 0; d0 < 2; ++d0)
#pragma unroll
                for (int g = 0; g < 4; ++g) { const int db = 32 * d0 + 8 * g + 4 * hh; const v2u gw = *(const v2u*)(gp + db);
                    const float g0 = sigmoidf_(bflo(gw.x)), g1 = sigmoidf_(bfhi(gw.x)), g2 = sigmoidf_(bflo(gw.y)), g3 = sigmoidf_(bfhi(gw.y));
                    v2u ow; ow.x = pk2(o[d0][4 * g + 0] * inv * g0, o[d0][4 * g + 1] * inv * g1); ow.y = pk2(o[d0][4 * g + 2] * inv * g2, o[d0][4 * g + 3] * inv * g3);
                    *(v2u*)(op + db) = ow; }
        }
    }
}

__device__ __forceinline__ void phase_rwkv_post(Frame& F, int layer) {
    KARGS;
    const int jj = layer >> 1, ch = F.tid;
    const float* R = WSP(float, WS_RW); const float* K = WSP(float, WS_RW + 2 * RW_SLOT); const float* V = WSP(float, WS_RW + 3 * RW_SLOT);
    const float* Gt = WSP(float, WS_RW + 6 * RW_SLOT); const float* Y = WSP(float, WS_RW + 7 * RW_SLOT);
    bf16* MIX = WSP(bf16, WS_MIX);
    const float lw = IN(24)[jj * 512 + ch], lb = IN(25)[jj * 512 + ch], rk = IN(23)[jj * 512 + ch];
    for (int tg = F.bid; tg < T; tg += F.G) {
        const size_t o = (size_t)tg * 512 + ch;
        const float y = Y[o]; const float mu = wave_sum(y) * (1.f / 64.f); const float dlt = y - mu; const float var = wave_sum(dlt * dlt) * (1.f / 64.f);
        const float yn = dlt * rsqrtf(var + GN_EPS) * lw + lb;
        const float v = V[o]; const float bonus = wave_sum(R[o] * K[o] * rk) * v;
        MIX[(size_t)tg * D + 512 + ch] = (bf16)f2bf((yn + bonus) * Gt[o]);
    }
}

#define BUBBLE(x_, V_) do { float bx_ = (x_); _Pragma("unroll") for (int p_ = 0; p_ < 16; ++p_) { const float hi_ = fmaxf(bx_, V_[p_]); bx_ = fminf(bx_, V_[p_]); V_[p_] = hi_; } } while (0)
__device__ __forceinline__ float pack_low(float v, unsigned bits, unsigned mask) { return __builtin_bit_cast(float, (__builtin_bit_cast(unsigned, v) & ~mask) | bits); }
__device__ __forceinline__ void phase_peer_topk(Frame& F, int layer) {
    KARGS;
    const bf16* Q = WSP(bf16, WS_Q); const bf16* KEYS = WSP(bf16, WS_KEYS) + (size_t)layer * 2 * 16384;
    int* IDX = WSP(int, WS_IDX); float* GATE = WSP(float, WS_GATE);
    LAS float* sc = (LAS float*)(F.lds + F.wave * 16512);
    LAS unsigned* li = (LAS unsigned*)sc;
    const int lane = F.lane, fr = lane & 15, fq = lane >> 4;
    const int gw = F.bid * NWAVES + F.wave, NGW = F.G * NWAVES;
    for (int it = gw; it < (T / 32) * 8; it += NGW) {
        const int tile = it >> 3, h = it & 7, t0 = tile * 32;
        float v1[16], v2[16];
#pragma unroll
        for (int half = 0; half < 2; ++half) {
            f32x4 acc[2][8];
#pragma unroll
            for (int rt = 0; rt < 2; ++rt)
#pragma unroll
                for (int ct = 0; ct < 8; ++ct) acc[rt][ct] = (f32x4){0.f, 0.f, 0.f, 0.f};
            const bf16* kb = KEYS + (size_t)half * 16384;
#pragma unroll 1
            for (int ks = 0; ks < 4; ++ks) {
                bf16x8 a[2];
#pragma unroll
                for (int rt = 0; rt < 2; ++rt) a[rt] = *(const bf16x8*)(Q + (size_t)(t0 + rt * 16 + fr) * 2048 + h * 256 + half * 128 + ks * 32 + 8 * fq);
#pragma unroll
                for (int ct = 0; ct < 8; ++ct) { const bf16x8 bb = *(const bf16x8*)(kb + (size_t)(ct * 16 + fr) * 128 + ks * 32 + 8 * fq);
#pragma unroll
                    for (int rt = 0; rt < 2; ++rt) acc[rt][ct] = __builtin_amdgcn_mfma_f32_16x16x32_bf16(a[rt], bb, acc[rt][ct], 0, 0, 0); }
            }
#pragma unroll
            for (int rt = 0; rt < 2; ++rt)
#pragma unroll
                for (int ct = 0; ct < 8; ++ct)
#pragma unroll
                    for (int r = 0; r < 4; ++r) sc[(rt * 16 + 4 * fq + r) * 129 + ct * 16 + fr] = pack_low(acc[rt][ct][r], (unsigned)(ct * 16 + fr), 0x7Fu);
            LDS_WAIT(); asm volatile("" ::: "memory");
            float vv[16];
#pragma unroll
            for (int p = 0; p < 16; ++p) vv[p] = -INFINITY;
            if (lane < 32) { const LAS float* row = sc + lane * 129;
#pragma unroll 4
                for (int n = 0; n < 128; ++n) { const float x = row[n]; BUBBLE(x, vv); } }
            LDS_WAIT(); asm volatile("" ::: "memory");
#pragma unroll
            for (int p = 0; p < 16; ++p) { if (half == 0) v1[p] = vv[p]; else v2[p] = vv[p]; }
        }
        if (lane < 32) {
#pragma unroll
            for (int p = 0; p < 16; ++p) { li[lane * 33 + p] = __builtin_bit_cast(unsigned, v1[p]) & 0x7Fu; li[lane * 33 + 16 + p] = __builtin_bit_cast(unsigned, v2[p]) & 0x7Fu; }
            float ts[16];
#pragma unroll
            for (int p = 0; p < 16; ++p) ts[p] = -INFINITY;
#pragma unroll
            for (int a = 0; a < 16; ++a)
#pragma unroll
                for (int bq = 0; bq < 16; ++bq) if ((a + 1) * (bq + 1) <= 16) { const float x = pack_low(v1[a] + v2[bq], (unsigned)(a * 16 + bq), 0xFFu); BUBBLE(x, ts); }
            LDS_WAIT(); asm volatile("" ::: "memory");
            float e[16], sum = 0.f;
#pragma unroll
            for (int p = 0; p < 16; ++p) { e[p] = expf(ts[p] - ts[0]); sum += e[p]; }
            const float inv = 1.f / sum;
            int* ip = IDX + (size_t)(t0 + lane) * 128 + h * 16; float* gp = GATE + (size_t)(t0 + lane) * 128 + h * 16;
#pragma unroll
            for (int p = 0; p < 16; ++p) { const unsigned ab = __builtin_bit_cast(unsigned, ts[p]) & 0xFFu;
                ip[p] = (int)(li[lane * 33 + (ab >> 4)] * 128u + li[lane * 33 + 16 + (ab & 15u)]); gp[p] = e[p] * inv; }
        }
        LDS_WAIT(); asm volatile("" ::: "memory");
    }
}

__device__ __forceinline__ void unpack8(float (&o)[8], const v4u w) {
    o[0] = bflo(w.x); o[1] = bfhi(w.x); o[2] = bflo(w.y); o[3] = bfhi(w.y); o[4] = bflo(w.z); o[5] = bfhi(w.z); o[6] = bflo(w.w); o[7] = bfhi(w.w);
}
__device__ __forceinline__ void phase_peer_gather(Frame& F, int layer) {
    KARGS;
    const bf16* H = WSP(bf16, WS_H); const int* IDX = WSP(int, WS_IDX); const float* GATE = WSP(float, WS_GATE);
    const bf16* U = WSP(bf16, WS_PU) + (size_t)layer * NEXP * 1024; const bf16* Vt = WSP(bf16, WS_PV) + (size_t)layer * NEXP * 1024;
    const float* g2 = WSP(float, WS_MOD) + (size_t)layer * 2 * 6144 + 5120;
    float* X = OUTP;
    const int lane = F.lane, gw = F.bid * NWAVES + F.wave, NGW = F.G * NWAVES;
    for (int tg = gw; tg < T; tg += NGW) {
        const int b = tg >= SEQ ? 1 : 0;
        float x0[8], x1[8];
        unpack8(x0, *(const v4u*)(H + (size_t)tg * D + 8 * lane)); unpack8(x1, *(const v4u*)(H + (size_t)tg * D + 512 + 8 * lane));
        const int id0 = IDX[(size_t)tg * 128 + lane], id1 = IDX[(size_t)tg * 128 + 64 + lane];
        const float gt0 = GATE[(size_t)tg * 128 + lane], gt1 = GATE[(size_t)tg * 128 + 64 + lane];
        float a0[8], a1[8];
#pragma unroll
        for (int i = 0; i < 8; ++i) { a0[i] = 0.f; a1[i] = 0.f; }
        for (int e0 = 0; e0 < 128; e0 += 8) {
            int idx[8]; float d[8];
            v4u ua[8], ub[8];
#pragma unroll
            for (int q = 0; q < 8; ++q) { const int e = e0 + q; idx[q] = __builtin_amdgcn_readlane(e0 < 64 ? id0 : id1, e & 63);
                const bf16* up = U + (size_t)idx[q] * 1024 + 8 * lane; ua[q] = *(const v4u*)up; ub[q] = *(const v4u*)(up + 512); }
#pragma unroll
            for (int q = 0; q < 8; ++q) { float u0[8], u1[8]; unpack8(u0, ua[q]); unpack8(u1, ub[q]); float s = 0.f;
#pragma unroll
                for (int i = 0; i < 8; ++i) s += u0[i] * x0[i] + u1[i] * x1[i];
                d[q] = s; }
#pragma unroll
            for (int o = 1; o < 64; o <<= 1) {
#pragma unroll
                for (int q = 0; q < 8; ++q) d[q] += __shfl_xor(d[q], o); }
#pragma unroll
            for (int q = 0; q < 8; ++q) { const int e = e0 + q; const bf16* vp = Vt + (size_t)idx[q] * 1024 + 8 * lane; ua[q] = *(const v4u*)vp; ub[q] = *(const v4u*)(vp + 512);
                d[q] = gelu_erf(d[q]) * rl(e0 < 64 ? gt0 : gt1, e & 63); }
#pragma unroll
            for (int q = 0; q < 8; ++q) { float v0[8], v1[8]; unpack8(v0, ua[q]); unpack8(v1, ub[q]);
#pragma unroll
                for (int i = 0; i < 8; ++i) { a0[i] += v0[i] * d[q]; a1[i] += v1[i] * d[q]; } }
        }
        float* xr = X + (size_t)tg * D + 8 * lane; const float* gg = g2 + b * 6144 + 8 * lane;
#pragma unroll
        for (int hh = 0; hh < 2; ++hh) {
#pragma unroll
            for (int c = 0; c < 2; ++c) { const int off = hh * 512 + c * 4; const f32x4 g4 = *(const f32x4*)(gg + off); const f32x4 xv = *(const f32x4*)(xr + off);
                f32x4 av; if (hh == 0) av = (f32x4){a0[c * 4], a0[c * 4 + 1], a0[c * 4 + 2], a0[c * 4 + 3]}; else av = (f32x4){a1[c * 4], a1[c * 4 + 1], a1[c * 4 + 2], a1[c * 4 + 3]};
                *(f32x4*)(xr + off) = xv + g4 * av; } }
    }
}

__device__ __forceinline__ void phase_final(Frame& F) {
    KARGS;
    float* X = OUTP; const float* gain = IN(31);
    const int lane = F.lane, gw = F.bid * NWAVES + F.wave, NGW = F.G * NWAVES;
    f32x4 gn[4];
#pragma unroll
    for (int j = 0; j < 4; ++j) gn[j] = *(const f32x4*)(gain + 256 * j + 4 * lane);
    for (int row = gw; row < T; row += NGW) {
        float* xr = X + (size_t)row * D + 4 * lane;
        f32x4 v[4]; float ss = 0.f;
#pragma unroll
        for (int j = 0; j < 4; ++j) { v[j] = *(const f32x4*)(xr + 256 * j); ss += (v[j].x * v[j].x + v[j].y * v[j].y) + (v[j].z * v[j].z + v[j].w * v[j].w); }
        const float rstd = rsqrtf(wave_sum(ss) * (1.f / D) + NORM_EPS);
#pragma unroll
        for (int j = 0; j < 4; ++j) *(f32x4*)(xr + 256 * j) = v[j] * rstd * gn[j];
    }
}

#ifndef PH_MASK
#define PH_MASK 0xFFFF
#endif
#define PH_EN(k) ((PH_MASK >> (k)) & 1)
constexpr int NPH = 46;
__host__ __device__ inline bool phase_skipped(int p) { if (p == 0 || p == NPH - 1) return false; const int layer = (p - 1) / 11, step = (p - 1) % 11; return (layer & 1) == 0 && (step == 3 || step == 4 || step == 5); }
__global__ void __launch_bounds__(NTHR, 2) mk_fwd(Args args) {
    extern __shared__ __attribute__((aligned(16))) unsigned char lds[];
    Frame F;
    F.lds = (LAS unsigned char*)lds;
    F.MISC = (volatile LAS unsigned*)(F.lds + MISC_OFF);
    F.tid = threadIdx.x; F.lane = F.tid & 63; F.wave = __builtin_amdgcn_readfirstlane(F.tid >> 6);
    F.G = gridDim.x; F.bid = blockIdx.x;
    F.ctl = (gu32*)(args.ws + WS_CTL);
    for (int u = F.tid; u < (LDS_BYTES - MISC_OFF) / 4; u += NTHR) ((LAS unsigned*)(F.lds + MISC_OFF))[u] = 0u;
    __syncthreads();
    XcdBarrier bar; bar.bar = (unsigned*)(F.ctl + CW_BAR); bar.x = 0; bar.st = nullptr;
    const int lo = args.ph_lo, hi = args.ph_hi;
    if (hi - lo > 1) bar = xcd_barrier_post((unsigned*)(F.ctl + CW_BAR), F.MISC + 8);
    bool ran = false;
    for (int p = lo; p < hi; ++p) {
        if (phase_skipped(p)) continue;
        if (ran) xcd_barrier(bar);
        ran = true;
        { int t_ = threadIdx.x; asm volatile("" : "+v"(t_)); F.tid = t_; F.lane = t_ & 63; F.wave = __builtin_amdgcn_readfirstlane(t_ >> 6);
          int b_ = blockIdx.x, g_ = gridDim.x; asm volatile("" : "+s"(b_), "+s"(g_)); F.bid = b_; F.G = g_; }
        if (p == 0) { if (PH_EN(0)) phase_prologue(F); continue; }
        if (p == NPH - 1) { if (PH_EN(1)) phase_final(F); continue; }
        const int layer = (p - 1) / 11, step = (p - 1) % 11; const bool odd = layer & 1;
        KARGS;
        if (step == 0 || step == 7) { if (PH_EN(2)) phase_norm(F, layer, step == 7 ? 1 : 0); }
        else if (step == 1 || step == 8) { if (PH_EN(3)) {
            const int N = step == 8 ? 2048 : (odd ? ODD_N : EVEN_IN);
            const bf16* Bt = step == 8 ? WSP(bf16, WS_WQ + (size_t)layer * 4 * MiB) : WSP(bf16, WS_WIN + (size_t)layer * 8 * MiB);
            bf16* O = step == 8 ? WSP(bf16, WS_Q) : WSP(bf16, WS_PROJ);
            pg8::Gemm g{WSP(bf16, WS_H), Bt, T, N, D}; pg8::StaticOrder S; S.init(T, N, F.G, F.bid);
            pg8::EpiBf16<0> E{O, N, nullptr, 0, 0, 1.f};
            pg8::gemm_phase<pg8::EpiBf16<0>, pg8::StaticOrder, PG8_ALIGN, PG8_SP2>(F.lds + RING_OFF, g, S, E);
        } }
        else if (step == 2) { if (odd) { if (PH_EN(4)) phase_odd_prep(F, layer); } else { if (PH_EN(5)) phase_even_mixer(F, layer); } }
        else if (step == 3) { if (PH_EN(6)) phase_fox_attn(F, layer); }
        else if (step == 4) { if (PH_EN(11)) phase_rwkv_scan(F, layer); }
        else if (step == 5) { if (PH_EN(7)) phase_rwkv_post(F, layer); }
        else if (step == 6) { if (PH_EN(8)) {
            pg8::Gemm g{WSP(bf16, WS_MIX), WSP(bf16, WS_WOUT + (size_t)layer * 2 * MiB), T, D, D}; pg8::StaticOrder S; S.init(T, D, F.G, F.bid);
            pg8::EpiResid E{layer == 0 ? IN(0) : OUTP, OUTP, WSP(float, WS_MOD) + (size_t)layer * 2 * 6144 + 2048, 6144};
            pg8::gemm_phase<pg8::EpiResid, pg8::StaticOrder, PG8_ALIGN, PG8_SP2>(F.lds + RING_OFF, g, S, E);
        } }
        else if (step == 9) { if (PH_EN(9)) phase_peer_topk(F, layer); }
        else { if (PH_EN(10)) phase_peer_gather(F, layer); }
    }
}

extern "C" void kernel_launch(void* const* d_in, const int* in_sizes, int n_in, void* d_out, int out_size, void* d_ws, size_t ws_size, hipStream_t stream) {
    static int grid = 0;
    if (grid == 0) {
        if (n_in != 32 || in_sizes[0] != T * D || out_size != T * D || ws_size < WS_END) { fprintf(stderr, "kernel_launch: unexpected shapes (n_in %d, in0 %d, out %d, ws %zu < %zu); nothing launched\n", n_in, n_in > 0 ? in_sizes[0] : -1, out_size, ws_size, (size_t)WS_END); grid = -1; return; }
        int dev = 0, cus = 0, per_cu = 0;
        if (hipGetDevice(&dev) != hipSuccess || hipDeviceGetAttribute(&cus, hipDeviceAttributeMultiprocessorCount, dev) != hipSuccess) { grid = -1; return; }
        if (hipFuncSetAttribute((const void*)mk_fwd, hipFuncAttributeMaxDynamicSharedMemorySize, LDS_BYTES) != hipSuccess) { fprintf(stderr, "kernel_launch: hipFuncSetAttribute failed\n"); grid = -1; return; }
        if (hipOccupancyMaxActiveBlocksPerMultiprocessor(&per_cu, (const void*)mk_fwd, NTHR, LDS_BYTES) != hipSuccess || per_cu < 1) fprintf(stderr, "kernel_launch: occupancy query reports %d workgroups per CU\n", per_cu);
        (void)hipGetLastError();
        grid = cus;
    }
    if (grid < 0) return;
    if (hipMemsetAsync((char*)d_ws + WS_CTL, 0, CTL_ZERO_BYTES, stream) != hipSuccess) { fprintf(stderr, "kernel_launch: hipMemsetAsync failed\n"); return; }
    Args a{};
    for (int i = 0; i < 32; ++i) a.in[i] = (const float*)d_in[i];
    a.out = (float*)d_out; a.ws = (unsigned char*)d_ws;
#if MK_ONE_LAUNCH
    a.ph_lo = 0; a.ph_hi = NPH;
    hipLaunchKernelGGL(mk_fwd, dim3(grid), dim3(NTHR), LDS_BYTES, stream, a);
#else
    for (int p = 0; p < NPH; ++p) { if (phase_skipped(p)) continue; a.ph_lo = p; a.ph_hi = p + 1;
        hipLaunchKernelGGL(mk_fwd, dim3(grid), dim3(NTHR), LDS_BYTES, stream, a); }
#endif
    const hipError_t le = hipPeekAtLastError();
    if (le != hipSuccess) fprintf(stderr, "kernel_launch: launch failed: %s\n", hipGetErrorName(le));
}
```

```cpp
#include <hip/hip_runtime.h>
#include <cstdio>
#include <cstdint>
namespace pg8 {
#define PG8_LAS __attribute__((address_space(3)))
typedef unsigned short bf16_t;
typedef short bf16x8 __attribute__((ext_vector_type(8)));
typedef float f32x4 __attribute__((ext_vector_type(4)));
typedef unsigned u32x4 __attribute__((ext_vector_type(4)));
constexpr int BM = 256, BK = 64, HALF = 128, HTB = HALF * BK * 2  , STAGE_BYTES = 8 * HTB, NXCD = 8, WGM = 8;

__host__ __device__ __forceinline__ int lds_byte(int r, int c) { const int st = (r >> 4) * 2 + (c >> 5), rr = r & 15, cc = c & 31, ob = rr * 64 + cc * 2; return st * 1024 + (ob ^ (((ob >> 9) & 1) << 5)); }
__host__ __device__ __forceinline__ void stage_rc(int b, int& R, int& C) { const int st = b / 1024, sb = b % 1024, swz = sb ^ (((sb >> 9) & 1) << 5); R = (st >> 1) * 16 + swz / 64; C = (st & 1) * 32 + (swz % 64) / 2; }
__host__ __device__ __forceinline__ int perm32(int rho) { const int n = rho >> 4, i = rho & 15; return 8 * (i >> 2) + 4 * n + (i & 3); }

struct Unit { int pm, pn; };
struct Gemm { const bf16_t* A; const bf16_t* Bt; int M, N, K; };

struct StaticOrder {
    int nM, nN, nwg, G, c;
    __host__ __device__ void init(int M, int N, int G_, int c_) { nM = M / BM; nN = N / BM; nwg = nM * nN; G = G_; c = c_; }
    __host__ __device__ bool next(int i, Unit& u) const {
        const long L = (long)i * G + c; if (L >= nwg) return false;
        int wgid = (int)L; { const int q = nwg / NXCD, r = nwg % NXCD, xcd = wgid % NXCD, off = wgid / NXCD; wgid = (xcd < r ? xcd * (q + 1) : r * (q + 1) + (xcd - r) * q) + off; }
        const int nig = WGM * nN, gid = wgid / nig, fm = gid * WGM, gsz = (nM - fm) < WGM ? (nM - fm) : WGM;
        u.pm = fm + ((wgid % nig) % gsz); u.pn = (wgid % nig) / gsz; return true;
    }
    __device__ __forceinline__ void a_ready(const Unit&) const {}
    __device__ __forceinline__ void done(const Unit&) const {}
};

__device__ __forceinline__ unsigned cvt_pk_bf16(float lo, float hi) { unsigned r; asm volatile("v_cvt_pk_bf16_f32 %0, %1, %2" : "=v"(r) : "v"(lo), "v"(hi)); return r; }
typedef float f32x2 __attribute__((ext_vector_type(2)));
__device__ __forceinline__ f32x2 gelu_pk(f32x2 v) {
    const f32x2 av = __builtin_elementwise_abs(v), d = av * 0.2316418882f + 1.0f;
    f32x2 t; t.x = __builtin_amdgcn_rcpf(d.x); t.y = __builtin_amdgcn_rcpf(d.y);
    f32x2 q = t * 0.5307027145f + (-0.7265760135f); q = q * t + 0.7107068705f; q = q * t + (-0.142248368f); q = q * t + 0.127414796f; q = q * t;
    const f32x2 s = (v * v) * (-0.72134752044f);
    f32x2 e; e.x = __builtin_amdgcn_exp2f(s.x); e.y = __builtin_amdgcn_exp2f(s.y);
    const f32x2 m = v * (q * e), r = v - m;
    f32x2 o; o.x = v.x < 0.f ? m.x : r.x; o.y = v.y < 0.f ? m.y : r.y; return o;
}

template <int ACT  > struct EpiBf16 {
    static constexpr bool PERM = true, AFTER_DRAIN = false; static_assert(ACT == 0 || ACT == 1, "EpiBf16: ACT is 0 (none) or 1 (gelu_pk)");
    bf16_t* O; int ldc; const float* bias; int split_cols; size_t split_stride; float scale0;
    __device__ __forceinline__ void operator()(const f32x4 (&acc)[2][2][4][2], const Unit& u, int wr, int wc, int fr, int fq) const {
        const int row0 = u.pm * BM + wr * 64 + fr; int colt = u.pn * BM; bf16_t* base = O;
        float sc = 1.f; if (split_cols) { const int t = colt / split_cols; base += (size_t)t * split_stride; colt -= t * split_cols; if (t == 0) sc = scale0; }
        const int col0 = colt + wc * 32 + 8 * fq, bcol0 = u.pn * BM + wc * 32 + 8 * fq;
        f32x4 bv[2][2];
#pragma unroll
        for (int bj = 0; bj < 2; ++bj)
#pragma unroll
            for (int n = 0; n < 2; ++n) bv[bj][n] = bias ? *(const f32x4*)(bias + bcol0 + bj * HALF + 4 * n) : (f32x4){0.f, 0.f, 0.f, 0.f};
#pragma unroll
        for (int ai = 0; ai < 2; ++ai)
#pragma unroll
            for (int m = 0; m < 4; ++m) { bf16_t* rowp = base + (size_t)(row0 + ai * HALF + m * 16) * ldc + col0;
#pragma unroll
                for (int bj = 0; bj < 2; ++bj) { f32x4 v0 = acc[ai][bj][m][0] + bv[bj][0], v1 = acc[ai][bj][m][1] + bv[bj][1];
                    if (ACT == 1) { f32x2 a = gelu_pk((f32x2){v0[0], v0[1]}), b = gelu_pk((f32x2){v0[2], v0[3]}), c = gelu_pk((f32x2){v1[0], v1[1]}), d = gelu_pk((f32x2){v1[2], v1[3]});
                        v0 = (f32x4){a.x, a.y, b.x, b.y}; v1 = (f32x4){c.x, c.y, d.x, d.y}; }
                    v0 = v0 * sc; v1 = v1 * sc; u32x4 w; w.x = cvt_pk_bf16(v0[0], v0[1]); w.y = cvt_pk_bf16(v0[2], v0[3]); w.z = cvt_pk_bf16(v1[0], v1[1]); w.w = cvt_pk_bf16(v1[2], v1[3]);
                    *(u32x4*)(rowp + bj * HALF) = w; } }
    }
};
struct EpiResid {
    static constexpr bool PERM = false, AFTER_DRAIN = false;
    const float* base; float* out; const float* gate; int gstride;
    __device__ __forceinline__ void operator()(const f32x4 (&acc)[2][2][4][2], const Unit& u, int wr, int wc, int fr, int fq) const {
        const int row0 = u.pm * BM + wr * 64 + fr; const int col0 = u.pn * BM + wc * 32 + 4 * fq;
        const float* gp = gate + ((u.pm * BM) >= 8192 ? gstride : 0);
        f32x4 gv[2][2];
#pragma unroll
        for (int bj = 0; bj < 2; ++bj)
#pragma unroll
            for (int n = 0; n < 2; ++n) gv[bj][n] = *(const f32x4*)(gp + col0 + bj * HALF + n * 16);
#pragma unroll
        for (int ai = 0; ai < 2; ++ai)
#pragma unroll
            for (int m = 0; m < 4; ++m) { const size_t off = (size_t)(row0 + ai * HALF + m * 16) * 1024 + col0;
#pragma unroll
                for (int bj = 0; bj < 2; ++bj)
#pragma unroll
                    for (int n = 0; n < 2; ++n) { const f32x4 bs = *(const f32x4*)(base + off + bj * HALF + n * 16);
                        *(f32x4*)(out + off + bj * HALF + n * 16) = bs + gv[bj][n] * acc[ai][bj][m][n]; } }
    }
};
template <class Epi, class Sched, bool ALIGN_EPI = false, bool SP2 = false>
__device__ __forceinline__ void gemm_phase(PG8_LAS unsigned char* lds, const Gemm g, const Sched& S, const Epi& E) {
    int tid_l = threadIdx.x; asm volatile("" : "+v"(tid_l));
    const int tid = tid_l, wid = __builtin_amdgcn_readfirstlane(tid >> 6), lane = tid & 63, wr = wid >> 2, wc = wid & 3, fr = lane & 15, fq = lane >> 4;
    const int K = g.K, nt = K / BK;
    unsigned voffA[2], voffB[2];
#pragma unroll
    for (int i = 0; i < 2; ++i) { int R, C; stage_rc(tid * 16 + i * 8192, R, C); const int Rb = Epi::PERM ? ((R & ~31) + perm32(R & 31)) : R;
        voffA[i] = (unsigned)(R * K + C) * 2u; voffB[i] = (unsigned)(Rb * K + C) * 2u; }
    const size_t kstep = (size_t)(BK * 2);
    const size_t hstep = (size_t)HALF * K * 2;
    const size_t tstep = 2 * hstep;
    const unsigned ldsw = (unsigned)wid * 1024u;
    const int aoff = lds_byte(wr * 64 + fr, fq * 8), boff = lds_byte(wc * 32 + fr, fq * 8);
#define PG8_SA(b, h) (((b) * 2 + (h)) * HTB)
#define PG8_SB(b, h) ((4 + (b) * 2 + (h)) * HTB)
#define PG8_STAGE(bufoff, gbase, voff) do { _Pragma("unroll") for (int _i = 0; _i < 2; ++_i) \
        __builtin_amdgcn_global_load_lds((const unsigned*)((const char*)(gbase) + (voff)[_i]), (PG8_LAS unsigned*)(lds + (bufoff) + ldsw + _i * 8192), 16, 0, 0); } while (0)
#define PG8_LDA(dst, b, h) do { _Pragma("unroll") for (int m = 0; m < 4; ++m) _Pragma("unroll") for (int k = 0; k < 2; ++k) dst[m][k] = *(const PG8_LAS bf16x8*)(lds + PG8_SA(b, h) + aoff + m * 2048 + k * 1024); } while (0)
#define PG8_LDB(dst, b, h) do { _Pragma("unroll") for (int n = 0; n < 2; ++n) _Pragma("unroll") for (int k = 0; k < 2; ++k) dst[n][k] = *(const PG8_LAS bf16x8*)(lds + PG8_SB(b, h) + boff + n * 2048 + k * 1024); } while (0)
#define PG8_MMA(ai, bj, At, Bt) do { __builtin_amdgcn_s_setprio(1); _Pragma("unroll") for (int m = 0; m < 4; ++m) _Pragma("unroll") for (int n = 0; n < 2; ++n) _Pragma("unroll") for (int k = 0; k < 2; ++k) \
        acc[ai][bj][m][n] = __builtin_amdgcn_mfma_f32_16x16x32_bf16(Bt[n][k], At[m][k], acc[ai][bj][m][n], 0, 0, 0); __builtin_amdgcn_s_setprio(0); } while (0)
#define PG8_WAIT_V(n) asm volatile("s_waitcnt vmcnt(" #n ")" ::: "memory")
#define PG8_WAIT_L(n) asm volatile("s_waitcnt lgkmcnt(" #n ")" ::: "memory")
#define PG8_BAR __builtin_amdgcn_s_barrier()
#define PG8_SCHED __builtin_amdgcn_sched_barrier(0)
    Unit cur, nxt; int ui = 0;
    if (!S.next(0, cur)) return;
    f32x4 acc[2][2][4][2];
#pragma unroll
    for (int a = 0; a < 2; ++a)
#pragma unroll
        for (int b = 0; b < 2; ++b)
#pragma unroll
            for (int m = 0; m < 4; ++m)
#pragma unroll
                for (int n = 0; n < 2; ++n) acc[a][b][m][n] = (f32x4){0.f, 0.f, 0.f, 0.f};
    bf16x8 At[4][2], B0[2][2], B1[2][2];
    const char* cA = (const char*)g.A + (size_t)cur.pm * tstep; const char* cB = (const char*)g.Bt + (size_t)cur.pn * tstep;
    S.a_ready(cur);
    if constexpr (SP2) {
        PG8_STAGE(PG8_SB(0, 0), cB, voffB); PG8_STAGE(PG8_SB(0, 1), cB + hstep, voffB); PG8_STAGE(PG8_SA(0, 0), cA, voffA); PG8_STAGE(PG8_SA(0, 1), cA + hstep, voffA);
        if (wr == 1) PG8_BAR;
        PG8_WAIT_V(2); PG8_BAR;
        PG8_STAGE(PG8_SB(1, 0), cB + kstep, voffB); PG8_STAGE(PG8_SA(1, 0), cA + kstep, voffA); PG8_STAGE(PG8_SB(1, 1), cB + hstep + kstep, voffB);
        PG8_WAIT_V(6); PG8_BAR;
    } else {
        PG8_STAGE(PG8_SB(0, 0), cB, voffB); PG8_STAGE(PG8_SA(0, 0), cA, voffA); PG8_STAGE(PG8_SB(0, 1), cB + hstep, voffB); PG8_STAGE(PG8_SA(0, 1), cA + hstep, voffA);
        if (wr == 1) PG8_BAR;
        PG8_WAIT_V(4); PG8_BAR;
        PG8_STAGE(PG8_SB(1, 0), cB + kstep, voffB); PG8_STAGE(PG8_SA(1, 0), cA + kstep, voffA); PG8_STAGE(PG8_SB(1, 1), cB + hstep + kstep, voffB);
        PG8_WAIT_V(6); PG8_BAR;
    }
    for (;;) {
        const bool has_next = S.next(ui + 1, nxt);
        const char* nA = has_next ? (const char*)g.A + (size_t)nxt.pm * tstep : cA; const char* nB = has_next ? (const char*)g.Bt + (size_t)nxt.pn * tstep : cB;
        for (int t = 0; t < nt; t += 2) {
            const bool last = (t == nt - 2);
            const char* a1 = cA + (size_t)(t + 1) * kstep;
            const char* a2 = last ? nA : cA + (size_t)(t + 2) * kstep; const char* b2 = last ? nB : cB + (size_t)(t + 2) * kstep;
            const char* a3 = a2 + kstep; const char* b3 = b2 + kstep;
            if (last && has_next) S.a_ready(nxt);
            if constexpr (SP2) {
            PG8_LDB(B0, 0, 0); PG8_LDB(B1, 0, 1); PG8_SCHED; PG8_LDA(At, 0, 0); PG8_STAGE(PG8_SA(1, 1), a1 + hstep, voffA);
            PG8_WAIT_V(8); PG8_WAIT_L(0); PG8_BAR; PG8_MMA(0, 0, At, B0); PG8_MMA(0, 1, At, B1); PG8_BAR; PG8_SCHED;
            PG8_LDA(At, 0, 1); PG8_STAGE(PG8_SB(0, 0), b2, voffB); PG8_STAGE(PG8_SB(0, 1), b2 + hstep, voffB); PG8_STAGE(PG8_SA(0, 0), a2, voffA);
            PG8_WAIT_V(8); PG8_WAIT_L(0); PG8_BAR; PG8_MMA(1, 0, At, B0); PG8_MMA(1, 1, At, B1); PG8_BAR; PG8_SCHED;
            PG8_LDB(B0, 1, 0); PG8_LDB(B1, 1, 1); PG8_SCHED; PG8_LDA(At, 1, 0); PG8_STAGE(PG8_SA(0, 1), a2 + hstep, voffA);
            PG8_WAIT_V(8); PG8_WAIT_L(0); PG8_BAR; PG8_MMA(0, 0, At, B0); PG8_MMA(0, 1, At, B1); PG8_BAR; PG8_SCHED;
            PG8_LDA(At, 1, 1); PG8_STAGE(PG8_SB(1, 0), b3, voffB); PG8_STAGE(PG8_SB(1, 1), b3 + hstep, voffB); PG8_STAGE(PG8_SA(1, 0), a3, voffA);
            PG8_WAIT_V(8); PG8_WAIT_L(0); PG8_BAR; PG8_MMA(1, 0, At, B0); PG8_MMA(1, 1, At, B1); PG8_BAR; PG8_SCHED;
            } else {
            PG8_LDB(B0, 0, 0); PG8_SCHED; PG8_LDA(At, 0, 0); PG8_STAGE(PG8_SA(1, 1), a1 + hstep, voffA);
            PG8_WAIT_L(8); PG8_BAR; PG8_WAIT_L(0); PG8_MMA(0, 0, At, B0); PG8_BAR; PG8_SCHED;
            PG8_LDB(B1, 0, 1); PG8_STAGE(PG8_SB(0, 0), b2, voffB);
            PG8_BAR; PG8_WAIT_L(0); PG8_MMA(0, 1, At, B1); PG8_BAR;
            PG8_LDA(At, 0, 1); PG8_STAGE(PG8_SA(0, 0), a2, voffA);
            PG8_BAR; PG8_WAIT_L(0); PG8_MMA(1, 0, At, B0); PG8_BAR; PG8_SCHED;
            PG8_STAGE(PG8_SB(0, 1), b2 + hstep, voffB);
            PG8_WAIT_V(6); PG8_BAR; PG8_MMA(1, 1, At, B1); PG8_BAR;
            PG8_LDB(B0, 1, 0); PG8_SCHED; PG8_LDA(At, 1, 0); PG8_STAGE(PG8_SA(0, 1), a2 + hstep, voffA);
            PG8_WAIT_L(8); PG8_BAR; PG8_WAIT_L(0); PG8_MMA(0, 0, At, B0); PG8_BAR; PG8_SCHED;
            PG8_LDB(B1, 1, 1); PG8_STAGE(PG8_SB(1, 0), b3, voffB);
            PG8_BAR; PG8_WAIT_L(0); PG8_MMA(0, 1, At, B1); PG8_BAR;
            PG8_LDA(At, 1, 1); PG8_STAGE(PG8_SA(1, 0), a3, voffA);
            PG8_BAR; PG8_WAIT_L(0); PG8_MMA(1, 0, At, B0); PG8_BAR; PG8_SCHED;
            PG8_STAGE(PG8_SB(1, 1), b3 + hstep, voffB);
            PG8_WAIT_V(6); PG8_BAR; PG8_MMA(1, 1, At, B1); PG8_BAR;
            }
        }
        if constexpr (ALIGN_EPI) { if (wr == 0) PG8_BAR; }
        if constexpr (!Epi::AFTER_DRAIN) { E(acc, cur, wr, wc, fr, fq); S.done(cur); }
        if (!has_next) break;
#pragma unroll
        for (int a = 0; a < 2; ++a)
#pragma unroll
            for (int b = 0; b < 2; ++b)
#pragma unroll
                for (int m = 0; m < 4; ++m)
#pragma unroll
                    for (int n = 0; n < 2; ++n) acc[a][b][m][n] = (f32x4){0.f, 0.f, 0.f, 0.f};
        cur = nxt; cA = nA; cB = nB; ++ui;
        if constexpr (ALIGN_EPI) { if (wr == 1) PG8_BAR; }
    }
    PG8_WAIT_V(0);
    if constexpr (!ALIGN_EPI) { if (wr == 0) PG8_BAR; }
    PG8_BAR;
    if constexpr (Epi::AFTER_DRAIN) { E.fused(acc, cur, wr, wc, fr, fq, lds, wid, lane); S.done(cur); }
#undef PG8_SA
#undef PG8_SB
#undef PG8_STAGE
#undef PG8_LDA
#undef PG8_LDB
#undef PG8_MMA
#undef PG8_WAIT_V
#undef PG8_WAIT_L
#undef PG8_BAR
#undef PG8_SCHED
}
}
#ifndef PG8_SP2
#define PG8_SP2 true
#endif
#ifndef PG8_ALIGN
#define PG8_ALIGN true
#endif
#ifndef MK_ONE_LAUNCH
#define MK_ONE_LAUNCH 1
#endif

constexpr int NWAVES = 8, NTHR = NWAVES * 64;
constexpr int BATCH = 2, SEQ = 8192, D = 1024, T = BATCH * SEQ, DEPTH = 4;
constexpr int EVEN_IN = 2048, ODD_LD = 3848, ODD_N = 3840;
constexpr int NEXP = 16384;
constexpr float NORM_EPS = 1e-6f, GN_EPS = 64e-5f;

constexpr size_t MiB = 1u << 20;
constexpr size_t WS_CTL = 0, CTL_ZERO_BYTES = 1 * MiB;
constexpr size_t WS_MOD = 1 * MiB;
constexpr size_t WS_WF = WS_MOD + 256 * 1024;
constexpr size_t WS_KEYS = WS_MOD + 512 * 1024;
constexpr size_t WS_LOGF = 2 * MiB;
constexpr size_t WS_DCUM = 2 * MiB + 512 * 1024;
constexpr size_t WS_WIN = 4 * MiB;
constexpr size_t WS_WOUT = 36 * MiB;
constexpr size_t WS_WQ = 44 * MiB;
constexpr size_t WS_H = 64 * MiB;
constexpr size_t WS_MIX = 96 * MiB;
constexpr size_t WS_PROJ = 128 * MiB;
constexpr size_t WS_Q = 256 * MiB;
constexpr size_t WS_IDX = 320 * MiB;
constexpr size_t WS_GATE = 328 * MiB;
constexpr size_t WS_RW = 336 * MiB;
constexpr size_t RW_SLOT = 32 * MiB;
constexpr size_t WS_PU = WS_RW + 8 * RW_SLOT;
constexpr size_t WS_PV = WS_PU + 128 * MiB;
constexpr size_t WS_CG = WS_PV + 128 * MiB;
constexpr size_t WS_CQ = WS_CG + 16 * MiB;
constexpr size_t WS_CH = WS_CQ + 16 * MiB;
constexpr size_t WS_CY = WS_CH + 32 * MiB;
constexpr size_t WS_END = WS_CY + 32 * MiB;
constexpr int CW_WORK = 64;
constexpr int CW_WORK2 = 1024;
constexpr int CW_BAR = 4096;

constexpr int RING_OFF = 0, RING_BYTES = 131072;
constexpr int MISC_OFF = 159744;
constexpr int LDS_BYTES = 163840;

#define GAS __attribute__((address_space(1)))
#define LAS __attribute__((address_space(3)))
typedef unsigned short bf16;
typedef unsigned v4u __attribute__((ext_vector_type(4)));
typedef unsigned v2u __attribute__((ext_vector_type(2)));
typedef float f32x4 __attribute__((ext_vector_type(4)));
typedef short bf16x8 __attribute__((ext_vector_type(8)));
typedef GAS unsigned gu32;
#define LDS_WAIT() asm volatile("s_waitcnt lgkmcnt(0)" ::: "memory")
#define VM_WAIT() asm volatile("s_waitcnt vmcnt(0)" ::: "memory")
__device__ __forceinline__ unsigned f2bf(float f) { unsigned u = __builtin_bit_cast(unsigned, f); return (u + 0x7fffu + ((u >> 16) & 1u)) >> 16; }
__device__ __forceinline__ unsigned pk2(float lo, float hi) { return f2bf(lo) | (f2bf(hi) << 16); }
__device__ __forceinline__ float bf2f(bf16 v) { return __builtin_bit_cast(float, (unsigned)v << 16); }
__device__ __forceinline__ float bflo(unsigned w) { return __builtin_bit_cast(float, w << 16); }
__device__ __forceinline__ float bfhi(unsigned w) { return __builtin_bit_cast(float, w & 0xffff0000u); }
__device__ __forceinline__ float wave_sum(float v) {
#pragma unroll
    for (int o = 1; o < 64; o <<= 1) v += __shfl_xor(v, o);
    return v;
}
__device__ __forceinline__ float wave_max(float v) {
#pragma unroll
    for (int o = 1; o < 64; o <<= 1) v = fmaxf(v, __shfl_xor(v, o));
    return v;
}
__device__ __forceinline__ float rl(float x, int j) { return __builtin_bit_cast(float, __builtin_amdgcn_readlane(__builtin_bit_cast(int, x), j)); }
__device__ __forceinline__ float sigmoidf_(float x) { return 1.f / (1.f + expf(-x)); }
__device__ __forceinline__ float softplusf_(float x) { return fmaxf(x, 0.f) + log1pf(expf(-fabsf(x))); }
__device__ __forceinline__ float gelu_erf(float x) { return 0.5f * x * (1.f + erff(x * 0.70710678118654752f)); }

#define XB_TMO      128
#define XB_XCNT(j)  (256  + 64 * (j))
#define XB_XSUB(j)  (1280 + 64 * (j))
#define XB_XGEN(j)  (2304 + 64 * (j))
#define XB_TOP      3328
#define XB_TOPGEN   3392
#define XCD_BAR_WORDS 3456
#define XB_SPIN_CAP (1u << 18)

__device__ __forceinline__ unsigned xb_ld(unsigned* p)              { return __hip_atomic_load(p, __ATOMIC_RELAXED, __HIP_MEMORY_SCOPE_AGENT); }
__device__ __forceinline__ unsigned xb_add(unsigned* p, unsigned v) { return __hip_atomic_fetch_add(p, v, __ATOMIC_RELAXED, __HIP_MEMORY_SCOPE_AGENT); }
__device__ __forceinline__ unsigned xb_xcc_id() { return (unsigned)__builtin_amdgcn_s_getreg((3 << 11) | 20) & 0xFu; }
#define XB_SPIN(cond, bar) do { unsigned _sp = 0; while (cond) { __builtin_amdgcn_s_sleep(1); \
    if ((++_sp & 255u) == 0u) { if (xb_ld(&(bar)[XB_TMO])) break; if (_sp > XB_SPIN_CAP) { atomicAdd(&(bar)[XB_TMO], 1u); break; } } } } while (0)

struct XcdBarrier {
    unsigned* bar; unsigned x;
    volatile LAS unsigned* st;
};

__device__ __forceinline__ XcdBarrier xcd_barrier_post(unsigned* bar, volatile LAS unsigned* st) {
    XcdBarrier b; b.bar = bar; b.x = xb_xcc_id(); b.st = st;
    if (threadIdx.x == 0) (void)xb_add(&bar[XB_XCNT(b.x)], 1u);
    return b;
}
__device__ __forceinline__ void xcd_barrier_complete(unsigned* bar, unsigned x, unsigned& nloc, unsigned& nx) {
    const unsigned G = gridDim.x * gridDim.y * gridDim.z;
    unsigned sum, cnt, mine, sp = 0u;
    for (;;) {
        sum = 0u; cnt = 0u; mine = 0u;
#pragma unroll
        for (unsigned j = 0; j < 16; ++j) { const unsigned c = xb_ld(&bar[XB_XCNT(j)]); sum += c; cnt += (c > 0u) ? 1u : 0u; mine = (j == x) ? c : mine; }
        if (sum == G) break;
        __builtin_amdgcn_s_sleep(1);
        if ((++sp & 255u) == 0u) { if (xb_ld(&bar[XB_TMO])) break; if (sp > XB_SPIN_CAP) { atomicAdd(&bar[XB_TMO], 1u); break; } }
    }
    nloc = mine > 0u ? mine : 1u; nx = cnt > 0u ? cnt : 1u;
}

__device__ __forceinline__ void xcd_barrier(const XcdBarrier& b) {
    asm volatile("s_waitcnt vmcnt(0)" ::: "memory");
    __syncthreads();
    if (threadIdx.x == 0) {
        unsigned* bar = b.bar;
        __builtin_amdgcn_s_waitcnt(0);
        unsigned nloc = b.st[0], nx = b.st[1];
        if (nloc == 0u) { xcd_barrier_complete(bar, b.x, nloc, nx); b.st[0] = nloc; b.st[1] = nx; }
        const unsigned old = xb_add(&bar[XB_XSUB(b.x)], 1u);
        const unsigned gen = old / nloc;
        if (old + 1u == (gen + 1u) * nloc) {
            __builtin_amdgcn_fence(__ATOMIC_RELEASE, "agent");
            asm volatile("s_waitcnt vmcnt(0)" ::: "memory");
            const unsigned og = xb_add(&bar[XB_TOP], 1u);
            const unsigned tg = og / nx;
            if (og + 1u == (tg + 1u) * nx) xb_add(&bar[XB_TOPGEN], 1u);
            else XB_SPIN(xb_ld(&bar[XB_TOPGEN]) == tg, bar);
            __builtin_amdgcn_fence(__ATOMIC_ACQUIRE, "agent");
            xb_add(&bar[XB_XGEN(b.x)], 1u);
            asm volatile("s_waitcnt vmcnt(0)" ::: "memory");
        } else {
            XB_SPIN(xb_ld(&bar[XB_XGEN(b.x)]) == gen, bar);
            __builtin_amdgcn_fence(__ATOMIC_ACQUIRE, "agent");
            asm volatile("s_waitcnt vmcnt(0)" ::: "memory");
        }
    }
    __syncthreads();
}


struct Frame {
    LAS unsigned char* lds;
    volatile LAS unsigned* MISC;
    gu32* ctl;
    int tid, lane, wave, G, bid;
};
struct Args { const float* in[32]; float* out; unsigned char* ws; int ph_lo, ph_hi; };
#define CAS __attribute__((address_space(4)))
#define KARGS const CAS Args* ka_; { unsigned long long kp_ = (unsigned long long)__builtin_amdgcn_kernarg_segment_ptr(); asm volatile("" : "+s"(kp_)); ka_ = (const CAS Args*)kp_; } unsigned char* const ws_ = ka_->ws
#define IN(i) (ka_->in[i])
#define OUTP (ka_->out)
#define WSP(type, off) ((type*)(ws_ + (off)))

__device__ __forceinline__ void transpose_item(const float* W, int ldw, bf16* WT, int row_off, LAS float* scr, int item, int nblk, int lane) {
    const int kb = item / nblk, nb = item % nblk, k0 = 64 * kb, n0 = 32 * nb;
#pragma unroll 8
    for (int i = 0; i < 32; ++i) { const int kk = 2 * i + (lane >> 5); scr[kk * 33 + (lane & 31)] = W[(size_t)(k0 + kk) * ldw + n0 + (lane & 31)]; }
    LDS_WAIT(); asm volatile("" ::: "memory");
    const int c = lane & 7;
#pragma unroll
    for (int j = 0; j < 4; ++j) { const int n = (lane >> 3) + 8 * j; const LAS float* s = scr + (8 * c) * 33 + n;
        v4u o; o.x = pk2(s[0 * 33], s[1 * 33]); o.y = pk2(s[2 * 33], s[3 * 33]); o.z = pk2(s[4 * 33], s[5 * 33]); o.w = pk2(s[6 * 33], s[7 * 33]);
        *(v4u*)(WT + (size_t)(row_off + n0 + n) * 1024 + k0 + 8 * c) = o; }
    LDS_WAIT(); asm volatile("" ::: "memory");
}

__device__ __forceinline__ void phase_prologue(Frame& F) {
    KARGS;
    LAS float* cact = (LAS float*)F.lds;
    LAS float* part = cact + 2048;
    {   const float* c = IN(1);
        for (int i = F.tid; i < 2048; i += NTHR) { const float v = c[i]; cact[i] = v / (1.f + expf(-v)); } }
    __syncthreads();
    {
        const float* ada_w = IN(2); const float* ada_b = IN(3); float* MOD = WSP(float, WS_MOD);
        for (int it = F.bid; it < 384; it += F.G) {
            const int l = it / 96, j0 = (it % 96) * 64;
            const float* wp = ada_w + ((size_t)l * 1024 + F.wave * 128) * 6144 + j0 + F.lane;
            float a0 = 0.f, a1 = 0.f;
#pragma unroll 8
            for (int k = 0; k < 128; ++k) { const float w = wp[(size_t)k * 6144]; a0 += cact[F.wave * 128 + k] * w; a1 += cact[1024 + F.wave * 128 + k] * w; }
            part[(F.wave * 2 + 0) * 64 + F.lane] = a0; part[(F.wave * 2 + 1) * 64 + F.lane] = a1;
            __syncthreads();
            if (F.tid < 128) { const int b = F.tid >> 6, col = F.tid & 63; float s = 0.f;
#pragma unroll
                for (int w = 0; w < 8; ++w) s += part[(w * 2 + b) * 64 + col];
                MOD[(l * 2 + b) * 6144 + j0 + col] = s + ada_b[l * 6144 + j0 + col]; }
            __syncthreads();
        }
    }
    {
        LAS float* scr = (LAS float*)(F.lds + 16384 + F.wave * 8448);
        const int gw = F.bid * NWAVES + F.wave, NGW = F.G * NWAVES;
        constexpr int I_A = 16 * 64, I_B = 16 * 64, I_C = 16 * 56, I_D = 16 * 32, I_E = 16 * 64;
        constexpr int NITEMS = 2 * I_A + 2 * I_B + 2 * I_C + 4 * I_D + 4 * I_E;
        for (int it = gw; it < NITEMS; it += NGW) {
            int r = it;
            if (r < 2 * I_A) { const int j = r / I_A; transpose_item(IN(6) + (size_t)j * 1024 * 2048, 2048, WSP(bf16, WS_WIN + (size_t)(2 * j) * 8 * MiB), 0, scr, r % I_A, 64, F.lane); continue; } r -= 2 * I_A;
            if (r < 2 * I_B) { const int j = r / I_B; transpose_item(IN(10) + (size_t)j * 1024 * ODD_LD, ODD_LD, WSP(bf16, WS_WIN + (size_t)(2 * j + 1) * 8 * MiB), 0, scr, r % I_B, 64, F.lane); continue; } r -= 2 * I_B;
            if (r < 2 * I_C) { const int j = r / I_C; transpose_item(IN(10) + (size_t)j * 1024 * ODD_LD + 2056, ODD_LD, WSP(bf16, WS_WIN + (size_t)(2 * j + 1) * 8 * MiB), 2048, scr, r % I_C, 56, F.lane); continue; } r -= 2 * I_C;
            if (r < 4 * I_D) { const int l = r / I_D; const int j = l >> 1; const float* src = (l & 1) ? IN(11) : IN(7);
                transpose_item(src + (size_t)j * 1024 * 1024, 1024, WSP(bf16, WS_WOUT + (size_t)l * 2 * MiB), 0, scr, r % I_D, 32, F.lane); continue; } r -= 4 * I_D;
            { const int l = r / I_E; transpose_item(IN(26) + (size_t)l * 1024 * 2048, 2048, WSP(bf16, WS_WQ + (size_t)l * 4 * MiB), 0, scr, r % I_E, 64, F.lane); }
        }
    }
    {
        const int gt = F.bid * NTHR + F.tid, NGT = F.G * NTHR;
        float* WF = WSP(float, WS_WF);
        for (int i = gt; i < 2 * 8 * 1024; i += NGT) { const int j = i >> 13, h = (i >> 10) & 7, k = i & 1023; WF[i] = IN(10)[((size_t)j * 1024 + k) * ODD_LD + 2048 + h]; }
        bf16* KEYS = WSP(bf16, WS_KEYS);
        for (int i = gt; i < 4 * 16384; i += NGT) { const int l = i >> 14, r = i & 16383;
            KEYS[(size_t)(l * 2 + 0) * 16384 + r] = (bf16)f2bf(IN(27)[i]); KEYS[(size_t)(l * 2 + 1) * 16384 + r] = (bf16)f2bf(IN(28)[i]); }
        const f32x4* su = (const f32x4*)IN(29); const f32x4* sv = (const f32x4*)IN(30); v2u* du = WSP(v2u, WS_PU); v2u* dv = WSP(v2u, WS_PV);
        for (size_t i = gt; i < (size_t)4 * NEXP * 1024 / 4; i += NGT) { const f32x4 a = su[i], b = sv[i];
            v2u o; o.x = pk2(a.x, a.y); o.y = pk2(a.z, a.w); du[i] = o; o.x = pk2(b.x, b.y); o.y = pk2(b.z, b.w); dv[i] = o; }
    }
}

__device__ __forceinline__ void phase_norm(Frame& F, int layer, int which) {
    KARGS;
    const float* X = (layer == 0 && which == 0) ? IN(0) : OUTP;
    const float* gain = (which ? IN(5) : IN(4)) + layer * 1024;
    const float* mod = WSP(float, WS_MOD) + (size_t)layer * 2 * 6144 + (which ? 3072 : 0);
    bf16* H = WSP(bf16, WS_H);
    const bool do_f = (layer & 1) && which == 0;
    const int jj = layer >> 1;
    const float* WF = WSP(float, WS_WF) + (size_t)jj * 8 * 1024;
    float* LOGF = WSP(float, WS_LOGF);
    const int gw = F.bid * NWAVES + F.wave, NGW = F.G * NWAVES, lane = F.lane;
    f32x4 gn[4];
#pragma unroll
    for (int j = 0; j < 4; ++j) gn[j] = *(const f32x4*)(gain + 256 * j + 4 * lane);
    for (int row = gw; row < T; row += NGW) {
        const int b = row >= SEQ ? 1 : 0;
        const float* sh = mod + b * 6144; const float* sc = sh + 1024;
        const float* xr = X + (size_t)row * D + 4 * lane;
        f32x4 v[4]; float ss = 0.f;
#pragma unroll
        for (int j = 0; j < 4; ++j) { v[j] = *(const f32x4*)(xr + 256 * j); ss += (v[j].x * v[j].x + v[j].y * v[j].y) + (v[j].z * v[j].z + v[j].w * v[j].w); }
        const float rstd = rsqrtf(wave_sum(ss) * (1.f / D) + NORM_EPS);
        bf16* hr = H + (size_t)row * D + 4 * lane;
#pragma unroll
        for (int j = 0; j < 4; ++j) { const f32x4 s4 = *(const f32x4*)(sc + 256 * j + 4 * lane), h4 = *(const f32x4*)(sh + 256 * j + 4 * lane);
            v[j] = v[j] * rstd * gn[j] * (s4 + 1.f) + h4;
            v2u o; o.x = pk2(v[j].x, v[j].y); o.y = pk2(v[j].z, v[j].w); *(v2u*)(hr + 256 * j) = o; }
        if (do_f) {
            const float* fb = IN(14) + jj * 8;
            const int t = row - b * SEQ;
#pragma unroll
            for (int hh = 0; hh < 8; ++hh) { float d = 0.f;
#pragma unroll
                for (int j = 0; j < 4; ++j) { const f32x4 w4 = *(const f32x4*)(WF + hh * 1024 + 256 * j + 4 * lane); d += (v[j].x * w4.x + v[j].y * w4.y) + (v[j].z * w4.z + v[j].w * w4.w); }
                d = wave_sum(d) + fb[hh];
                const float lf = fminf(d, 0.f) - log1pf(expf(-fabsf(d)));
                if (lane == 0) LOGF[(size_t)(b * 8 + hh) * SEQ + t] = lf; }
        }
    }
}

__device__ __forceinline__ void load_q64(float (&q)[64], const bf16* p, float scale) {
#pragma unroll
    for (int c = 0; c < 8; ++c) { const v4u w = *(const v4u*)(p + 8 * c);
        q[8 * c + 0] = bflo(w.x) * scale; q[8 * c + 1] = bfhi(w.x) * scale; q[8 * c + 2] = bflo(w.y) * scale; q[8 * c + 3] = bfhi(w.y) * scale;
        q[8 * c + 4] = bflo(w.z) * scale; q[8 * c + 5] = bfhi(w.z) * scale; q[8 * c + 6] = bflo(w.w) * scale; q[8 * c + 7] = bfhi(w.w) * scale; }
}
__device__ __forceinline__ float dot_q64(const float (&q)[64], const bf16* p) {
    float z0 = 0.f, z1 = 0.f;
#pragma unroll
    for (int c = 0; c < 8; ++c) { const v4u w = *(const v4u*)(p + 8 * c);
        z0 += q[8 * c + 0] * bflo(w.x) + q[8 * c + 2] * bflo(w.y) + q[8 * c + 4] * bflo(w.z) + q[8 * c + 6] * bflo(w.w);
        z1 += q[8 * c + 1] * bfhi(w.x) + q[8 * c + 3] * bfhi(w.y) + q[8 * c + 5] * bfhi(w.z) + q[8 * c + 7] * bfhi(w.w); }
    return z0 + z1;
}
__device__ __forceinline__ void phase_even_mixer(Frame& F, int layer) {
    KARGS;
    const bf16* P = WSP(bf16, WS_PROJ); bf16* MIX = WSP(bf16, WS_MIX);
    const int lane = F.lane;
    {
        const int gw = F.bid * NWAVES + F.wave, NGW = F.G * NWAVES;
        for (int it = gw; it < BATCH * 8 * SEQ; it += NGW) {
            const int b = it >> 16, h = (it >> 13) & 7, t = it & 8191;
            const bf16* base = P + (size_t)b * SEQ * EVEN_IN;
            float q[64]; load_q64(q, base + (size_t)t * EVEN_IN + h * 64, 0.125f);
            float acc = 0.f, carry = 0.f;
            for (int s0 = t - 1; s0 >= 0; s0 -= 64) {
                const int s = s0 - lane; const bool valid = s >= 0; const int sc = valid ? s : 0;
                const float z = dot_q64(q, base + (size_t)sc * EVEN_IN + 512 + h * 64);
                const float sp = softplusf_(z);
                const float l1m = valid ? -sp : 0.f;
                const float lb = z - sp;
                float inc = l1m;
#pragma unroll
                for (int o = 1; o < 64; o <<= 1) { const float n = __shfl_up(inc, o); if (lane >= o) inc += n; }
                const float w = valid ? expf(lb + carry + (inc - l1m)) : 0.f;
                const float tot = __shfl(inc, 63);
#pragma unroll 16
                for (int j = 0; j < 64; ++j) { const float wj = rl(w, j); int sj = s0 - j; sj = sj < 0 ? 0 : sj;
                    acc += wj * bf2f(base[(size_t)sj * EVEN_IN + 1024 + h * 64 + lane]); }
                carry += tot;
                if (carry < -104.f) break;
            }
            MIX[((size_t)b * SEQ + t) * D + h * 64 + lane] = (bf16)f2bf(acc);
        }
    }
    {
        LAS float* pl = (LAS float*)F.lds;
        const int jj = layer >> 1;
        const float* pw = IN(8) + (size_t)jj * 4 * 128 * 128; const float* ps = IN(9) + jj * 512;
        const int c = F.tid, g = c >> 7, w = 2 << g, d = c & 127;
        for (int tile = F.bid; tile < T / 32; tile += F.G) {
            const int t0 = tile * 32, b = t0 / SEQ, tl0 = t0 % SEQ;
            const bf16* base = P + (size_t)b * SEQ * EVEN_IN + 1536 + c;
            for (int tt = 0; tt < 32; ++tt) { const int tl = tl0 + tt, cend = (tl / 64 + 1) * 64;
                int lo = tl - w / 2; lo = lo < 0 ? 0 : lo; int hi = tl + w / 2; hi = hi > cend ? cend : hi;
                float s = 0.f; for (int u = lo; u < hi; ++u) s += bf2f(base[(size_t)u * EVEN_IN]);
                pl[c * 33 + tt] = s / (float)(hi - lo) - bf2f(base[(size_t)tl * EVEN_IN]); }
            __syncthreads();
            float acc[32];
#pragma unroll
            for (int tt = 0; tt < 32; ++tt) acc[tt] = 0.f;
            for (int cc = 0; cc < 128; ++cc) { const float wv = pw[((size_t)g * 128 + cc) * 128 + d]; const LAS float* pr = pl + (g * 128 + cc) * 33;
#pragma unroll
                for (int tt = 0; tt < 32; ++tt) acc[tt] += pr[tt] * wv; }
            const float sc = ps[c];
#pragma unroll
            for (int tt = 0; tt < 32; ++tt) MIX[(size_t)(t0 + tt) * D + 512 + c] = (bf16)f2bf(acc[tt] * sc);
            __syncthreads();
        }
    }
}

__device__ __forceinline__ void phase_odd_prep(Frame& F, int layer) {
    KARGS;
    const int jj = layer >> 1, lane = F.lane;
    bf16* P = WSP(bf16, WS_PROJ);
    if (F.wave == 0 && F.bid < 16) {
        const float* lf = WSP(float, WS_LOGF) + (size_t)F.bid * SEQ; float* dc = WSP(float, WS_DCUM) + (size_t)F.bid * SEQ; double carry = 0.0;
        for (int t0 = 0; t0 < SEQ; t0 += 64) { float inc = lf[t0 + lane];
#pragma unroll
            for (int o = 1; o < 64; o <<= 1) { const float n = __shfl_up(inc, o); if (lane >= o) inc += n; }
            dc[t0 + lane] = (float)(carry + (double)inc); carry += (double)__shfl(inc, 63); }
    }
    LAS float* lx = (LAS float*)F.lds;
    const float* mix = IN(15) + jj * 1792;
    const float* w0 = IN(16) + jj * 512; const float* w2 = IN(17) + (size_t)jj * 64 * 512;
    const float* a0 = IN(18) + jj * 512; const float* a2 = IN(19) + (size_t)jj * 64 * 512;
    const float* g2 = IN(20) + (size_t)jj * 128 * 512;
    const float* kkp = IN(21) + jj * 512; const float* kap = IN(22) + jj * 512;
    const float* qn = IN(12) + jj * 64; const float* kn = IN(13) + jj * 64;
    float* R = WSP(float, WS_RW); float* Wd = WSP(float, WS_RW + RW_SLOT); float* K = WSP(float, WS_RW + 2 * RW_SLOT); float* V = WSP(float, WS_RW + 3 * RW_SLOT);
    float* KK = WSP(float, WS_RW + 4 * RW_SLOT); float* A = WSP(float, WS_RW + 5 * RW_SLOT); float* Gt = WSP(float, WS_RW + 6 * RW_SLOT);
    const int ch = F.tid;
    const float m_r = mix[ch], m_k = mix[512 + ch], m_v = mix[1024 + ch];
    const float w0c = w0[ch], a0c = a0[ch], kkc = kkp[ch], kac = kap[ch], qnc = qn[ch & 63], knc = kn[ch & 63];
    for (int item = F.bid; item < T / 16; item += F.G) {
        const int t0 = item * 16;
        for (int i = F.tid; i < 16 * 256; i += NTHR) { const int tt = i >> 8, j = i & 255, tg = t0 + tt, tl = tg % SEQ, col = 1536 + j;
            const float cur = bf2f(P[(size_t)tg * ODD_N + 2048 + col]); const float prev = tl > 0 ? bf2f(P[(size_t)(tg - 1) * ODD_N + 2048 + col]) : 0.f;
            const float x = cur + (prev - cur) * mix[col];
            lx[i] = j < 64 ? tanhf(x) : (j < 128 ? x : sigmoidf_(x)); }
        __syncthreads();
        float aw[16], aa[16], ag[16];
#pragma unroll
        for (int tt = 0; tt < 16; ++tt) { aw[tt] = 0.f; aa[tt] = 0.f; ag[tt] = 0.f; }
        for (int i = 0; i < 64; ++i) { const float w2v = w2[i * 512 + ch], a2v = a2[i * 512 + ch];
#pragma unroll
            for (int tt = 0; tt < 16; ++tt) { aw[tt] += lx[tt * 256 + i] * w2v; aa[tt] += lx[tt * 256 + 64 + i] * a2v; } }
        for (int i = 0; i < 128; ++i) { const float g2v = g2[i * 512 + ch];
#pragma unroll
            for (int tt = 0; tt < 16; ++tt) ag[tt] += lx[tt * 256 + 128 + i] * g2v; }
#pragma unroll
        for (int tt = 0; tt < 16; ++tt) { const int tg = t0 + tt, tl = tg % SEQ;
            const bf16* pc = P + (size_t)tg * ODD_N + 2048 + ch; const bf16* pp = pc - ODD_N;
            const float rc = bf2f(pc[0]), kc = bf2f(pc[512]), vc = bf2f(pc[1024]);
            const float rp = tl > 0 ? bf2f(pp[0]) : 0.f, kp = tl > 0 ? bf2f(pp[512]) : 0.f, vp = tl > 0 ? bf2f(pp[1024]) : 0.f;
            const float r = rc + (rp - rc) * m_r, kr = kc + (kp - kc) * m_k, vr = vc + (vp - vc) * m_v;
            const float wl = -softplusf_(-(w0c + aw[tt])) - 0.5f; const float decay = -expf(wl);
            const float a = sigmoidf_(a0c + aa[tt]);
            const float kkv = kr * kkc; const float n2 = wave_sum(kkv * kkv); const float kkn = kkv / fmaxf(sqrtf(n2), 1e-12f);
            const float kmod = kr * (1.f + (a - 1.f) * kac);
            const size_t o = (size_t)tg * 512 + ch;
            R[o] = r; Wd[o] = decay; K[o] = kmod; V[o] = vr; KK[o] = kkn; A[o] = a; Gt[o] = ag[tt];
            bf16* pq = P + (size_t)tg * ODD_N + ch;
            const float qv = bf2f(pq[0]), kv = bf2f(pq[512]);
            const float qs = wave_sum(qv * qv) * (1.f / 64.f), ks = wave_sum(kv * kv) * (1.f / 64.f);
            pq[0] = (bf16)f2bf(qv * rsqrtf(qs + NORM_EPS) * qnc); pq[512] = (bf16)f2bf(kv * rsqrtf(ks + NORM_EPS) * knc); }
        __syncthreads();
    }
}

typedef float f32x16 __attribute__((ext_vector_type(16)));
typedef short s16x4 __attribute__((ext_vector_type(4)));
constexpr int CP = 144;
constexpr int CM = 64 * CP;
__device__ __forceinline__ void mm_nt(f32x16& acc, const LAS unsigned char* A, const LAS unsigned char* B, int m0, int n0, int r32, int hh) {
#pragma unroll
    for (int s4 = 0; s4 < 4; ++s4) { const bf16x8 a = *(const LAS bf16x8*)(A + (m0 + r32) * CP + 32 * s4 + 16 * hh); const bf16x8 b = *(const LAS bf16x8*)(B + (n0 + r32) * CP + 32 * s4 + 16 * hh);
        acc = __builtin_amdgcn_mfma_f32_32x32x16_bf16(a, b, acc, 0, 0, 0); }
}
__device__ __forceinline__ void store_t(LAS unsigned char* Dst, const f32x16& acc, int m0, int n0, int r32, int hh, float sg) {
#pragma unroll
    for (int g = 0; g < 4; ++g) { v2u w; w.x = pk2(sg * acc[4 * g], sg * acc[4 * g + 1]); w.y = pk2(sg * acc[4 * g + 2], sg * acc[4 * g + 3]); *(LAS v2u*)(Dst + (n0 + r32) * CP + (m0 + 8 * g + 4 * hh) * 2) = w; }
}
__device__ __forceinline__ void load_t(f32x16& acc, const LAS unsigned char* Src, int m0, int n0, int r32, int hh, float sg) {
#pragma unroll
    for (int g = 0; g < 4; ++g) { const v2u w = *(const LAS v2u*)(Src + (n0 + r32) * CP + (m0 + 8 * g + 4 * hh) * 2);
        acc[4 * g] = sg * bflo(w.x); acc[4 * g + 1] = sg * bfhi(w.x); acc[4 * g + 2] = sg * bflo(w.y); acc[4 * g + 3] = sg * bfhi(w.y); }
}
#define ZERO16(a) do { _Pragma("unroll") for (int r_ = 0; r_ < 16; ++r_) a[r_] = 0.f; } while (0)
__device__ __forceinline__ void mask16(f32x16& acc, int m0, int n0, int r32, int hh, int mode) {
    const int n = n0 + r32;
#pragma unroll
    for (int r = 0; r < 16; ++r) { const int m = m0 + (r & 3) + 8 * (r >> 2) + 4 * hh; const bool keep = mode == 0 ? (n < m) : (mode == 1 ? (m < n) : (m <= n)); acc[r] = keep ? acc[r] : 0.f; }
}
__device__ __forceinline__ void phase_rwkv_chunk(Frame& F, int layer) {
    KARGS;
    const float* R = WSP(float, WS_RW); const float* LW = WSP(float, WS_RW + RW_SLOT); const float* K = WSP(float, WS_RW + 2 * RW_SLOT); const float* V = WSP(float, WS_RW + 3 * RW_SLOT);
    const float* KK = WSP(float, WS_RW + 4 * RW_SLOT); const float* A = WSP(float, WS_RW + 5 * RW_SLOT);
    bf16* CGp = WSP(bf16, WS_CG); bf16* CQp = WSP(bf16, WS_CQ); float* CHp = WSP(float, WS_CH); float* CYp = WSP(float, WS_CY);
    const int tid = F.tid, lane = F.lane, w = F.wave, r32 = lane & 31, hh = lane >> 5;
    LAS unsigned char* L = F.lds;
    LAS unsigned char* Ab = L, *Bb = L + CM, *Kb = L + 2 * CM, *Rb = L + 3 * CM, *BtT = L + 4 * CM, *KtT = L + 5 * CM, *VT = L + 6 * CM;
    LAS unsigned char* XT0 = L + 7 * CM, *XT1 = L + 9 * CM;
    LAS unsigned char* NB = L + 11 * CM;
    LAS unsigned char* Prb = L + 15 * CM;
    LAS float* tot = (LAS float*)(L + 16 * CM);
    LAS float* gCl = tot + 512;
    for (int item = F.bid; item < 16 * 128; item += F.G) {
        const int bh = item >> 7, c = item & 127, b = bh >> 3, h = bh & 7;
        {
            const size_t g0 = ((size_t)b * SEQ + c * 64 + 8 * w) * 512 + h * 64 + lane;
            float lw[8], cum[8]; float run = 0.f;
#pragma unroll
            for (int i = 0; i < 8; ++i) { lw[i] = LW[g0 + (size_t)i * 512]; run += lw[i]; cum[i] = run; }
            tot[w * 64 + lane] = run;
            __syncthreads();
            float off = 0.f, all = 0.f;
#pragma unroll
            for (int ww = 0; ww < 8; ++ww) { const float tv = tot[ww * 64 + lane]; if (ww < w) off += tv; all += tv; }
            if (w == 0) gCl[lane] = expf(all);
#pragma unroll
            for (int i = 0; i < 8; ++i) {
                const int t = 8 * w + i; const float cm = cum[i] + off;
                const float g = expf(cm), gex = expf(cm - lw[i]), gi = expf(-cm), gcg = expf(all - cm);
                const size_t gg = g0 + (size_t)i * 512;
                const float r = R[gg], k = K[gg], v = V[gg], kk = KK[gg], a = A[gg];
                const bf16 ab = (bf16)f2bf(kk * gex), bb = (bf16)f2bf(kk * a * gi), kb = (bf16)f2bf(k * gi), rb = (bf16)f2bf(r * g), bt = (bf16)f2bf(kk * a * gcg), kt = (bf16)f2bf(k * gcg), vb = (bf16)f2bf(v);
                *(LAS bf16*)(Ab + t * CP + lane * 2) = ab; *(LAS bf16*)(Bb + t * CP + lane * 2) = bb; *(LAS bf16*)(Kb + t * CP + lane * 2) = kb; *(LAS bf16*)(Rb + t * CP + lane * 2) = rb;
                *(LAS bf16*)(XT0 + lane * CP + t * 2) = ab; *(LAS bf16*)(BtT + lane * CP + t * 2) = bt; *(LAS bf16*)(KtT + lane * CP + t * 2) = kt; *(LAS bf16*)(VT + lane * CP + t * 2) = vb;
            }
            __syncthreads();
        }
        const int xtm = w & 1, xtn = w >> 1;
        f32x16 xacc;
        {
#pragma unroll
            for (int qq = 0; qq < 2; ++qq) {
                int q; if (w < 4) q = 2 * w + qq; else { if (qq == 1) break; q = 8 + (w - 4); }
                const int pr = q >> 2, tm = (q >> 1) & 1, tn = q & 1; f32x16 acc; ZERO16(acc);
                if (pr == 0) { mm_nt(acc, Ab, Bb, 32 * tm, 32 * tn, r32, hh); mask16(acc, 32 * tm, 32 * tn, r32, hh, 0); store_t(NB + 1 * CM, acc, 32 * tm, 32 * tn, r32, hh, -1.f); }
                else if (pr == 1) { mm_nt(acc, Bb, Ab, 32 * tm, 32 * tn, r32, hh); mask16(acc, 32 * tm, 32 * tn, r32, hh, 1); store_t(NB + 0 * CM, acc, 32 * tm, 32 * tn, r32, hh, -1.f); }
                else { mm_nt(acc, Bb, Rb, 32 * tm, 32 * tn, r32, hh); mask16(acc, 32 * tm, 32 * tn, r32, hh, 2); store_t(Prb, acc, 32 * tm, 32 * tn, r32, hh, 1.f); }
            }
            if (xtn >= 2) { ZERO16(xacc); mm_nt(xacc, Ab, Kb, 32 * xtm, 32 * (xtn - 2), r32, hh); mask16(xacc, 32 * xtm, 32 * (xtn - 2), r32, hh, 0); store_t(XT0 + 64 * CP, xacc, 32 * xtm, 32 * (xtn - 2), r32, hh, 1.f); }
            else load_t(xacc, XT0, 32 * xtm, 32 * xtn, r32, hh, 1.f);
            __syncthreads();
        }
        LAS unsigned char* XTc = XT0; LAS unsigned char* XTn = XT1; int nb = 0;
#pragma unroll 1
        for (int j = 0; j < 6; ++j) {
            const LAS unsigned char* Nc = NB + (2 * nb) * CM; const LAS unsigned char* NTc = NB + (2 * nb + 1) * CM;
            mm_nt(xacc, Nc, XTc, 32 * xtm, 32 * xtn, r32, hh);
            store_t(XTn, xacc, 32 * xtm, 32 * xtn, r32, hh, 1.f);
            if (j < 5) { const int tm = (w >> 1) & 1, tn = w & 1; f32x16 acc; ZERO16(acc);
                if (w < 4) { mm_nt(acc, Nc, NTc, 32 * tm, 32 * tn, r32, hh); store_t(NB + (2 * (nb ^ 1) + 1) * CM, acc, 32 * tm, 32 * tn, r32, hh, 1.f); }
                else       { mm_nt(acc, NTc, Nc, 32 * tm, 32 * tn, r32, hh); store_t(NB + (2 * (nb ^ 1)) * CM, acc, 32 * tm, 32 * tn, r32, hh, 1.f); } }
            __syncthreads();
            { LAS unsigned char* t_ = XTc; XTc = XTn; XTn = t_; } nb ^= 1;
        }
        const size_t cbase = (size_t)(bh * 128 + c) * 4096;
#pragma unroll
        for (int qq = 0; qq < 2; ++qq) {
            const int q = 2 * w + qq, pr = q >> 2, tm = (q >> 1) & 1, tn = q & 1, m0 = 32 * tm, n0 = 32 * tn; f32x16 acc;
            if (pr == 0) {
                load_t(acc, Rb, m0, n0, r32, hh, -1.f); mm_nt(acc, XTc, Prb, m0, n0, r32, hh);
                bf16* dst = CQp + cbase + (size_t)(n0 + r32) * 64 + m0 + 4 * hh;
#pragma unroll
                for (int g = 0; g < 4; ++g) { v2u o; o.x = pk2(-acc[4 * g], -acc[4 * g + 1]); o.y = pk2(-acc[4 * g + 2], -acc[4 * g + 3]); *(v2u*)(dst + 8 * g) = o; }
            } else if (pr == 1) {
                ZERO16(acc); mm_nt(acc, XTc, BtT, m0, n0, r32, hh);
                const int k1 = n0 + r32; const float gc = gCl[k1];
                bf16* dst = CGp + cbase + (size_t)k1 * 64 + m0 + 4 * hh;
#pragma unroll
                for (int g = 0; g < 4; ++g) { float e[4];
#pragma unroll
                    for (int i = 0; i < 4; ++i) { const int k2 = m0 + 8 * g + 4 * hh + i; e[i] = (k2 == k1 ? gc : 0.f) - acc[4 * g + i]; }
                    v2u o; o.x = pk2(e[0], e[1]); o.y = pk2(e[2], e[3]); *(v2u*)(dst + 8 * g) = o; }
            } else if (pr == 2) {
                load_t(acc, KtT, m0, n0, r32, hh, -1.f); mm_nt(acc, XTc + 64 * CP, BtT, m0, n0, r32, hh); store_t(NB, acc, m0, n0, r32, hh, -1.f);
            } else {
                f32x16 a1; ZERO16(a1); mm_nt(a1, Kb, Rb, m0, n0, r32, hh); mask16(a1, m0, n0, r32, hh, 2);
                ZERO16(acc); mm_nt(acc, XTc + 64 * CP, Prb, m0, n0, r32, hh);
#pragma unroll
                for (int r = 0; r < 16; ++r) acc[r] = a1[r] - acc[r];
                store_t(NB + CM, acc, m0, n0, r32, hh, 1.f);
            }
        }
        __syncthreads();
        {
            const int ww = w & 3, tm = ww >> 1, tn = ww & 1, m0 = 32 * tm, n0 = 32 * tn; f32x16 acc; ZERO16(acc);
            mm_nt(acc, w < 4 ? NB : NB + CM, VT, m0, n0, r32, hh);
            float* dst = (w < 4 ? CHp : CYp) + cbase + (size_t)(n0 + r32) * 64 + m0 + 4 * hh;
#pragma unroll
            for (int g = 0; g < 4; ++g) *(f32x4*)(dst + 8 * g) = (f32x4){acc[4 * g], acc[4 * g + 1], acc[4 * g + 2], acc[4 * g + 3]};
        }
        __syncthreads();
    }
}

__device__ __forceinline__ void rwkv_scan(Frame& F, int bh) {
    KARGS;
    const bf16* CGp = WSP(bf16, WS_CG) + (size_t)bh * 128 * 4096; const bf16* CQp = WSP(bf16, WS_CQ) + (size_t)bh * 128 * 4096;
    const float* CHp = WSP(float, WS_CH) + (size_t)bh * 128 * 4096; const float* CYp = WSP(float, WS_CY) + (size_t)bh * 128 * 4096;
    float* Y = WSP(float, WS_RW + 7 * RW_SLOT);
    const int lane = F.lane, w = F.wave, r32 = lane & 31, hh = lane >> 5, b = bh >> 3, h = bh & 7;
    LAS unsigned char* S0 = F.lds; LAS unsigned char* S1 = F.lds + CM;
    for (int i = F.tid; i < 2 * CM / 4; i += NTHR) ((LAS unsigned*)F.lds)[i] = 0u;
    const bool upd = w < 4; const int ww = w & 3, tm = ww >> 1, tn = ww & 1, m0 = 32 * tm, n0 = 32 * tn;
    const bf16* Ap = (upd ? CGp : CQp) + (size_t)(m0 + r32) * 64 + 8 * hh;
    const float* Ip = (upd ? CHp : CYp) + (size_t)(n0 + r32) * 64 + m0 + 4 * hh;
    bf16x8 an[4]; f32x4 in_[4];
#pragma unroll
    for (int s4 = 0; s4 < 4; ++s4) { an[s4] = *(const bf16x8*)(Ap + 16 * s4); in_[s4] = *(const f32x4*)(Ip + 8 * s4); }
    __syncthreads();
    for (int c = 0; c < 128; ++c) {
        LAS unsigned char* Sc = (c & 1) ? S1 : S0; LAS unsigned char* Sn = (c & 1) ? S0 : S1;
        bf16x8 a[4]; f32x16 acc;
#pragma unroll
        for (int s4 = 0; s4 < 4; ++s4) { a[s4] = an[s4]; acc[4 * s4] = in_[s4][0]; acc[4 * s4 + 1] = in_[s4][1]; acc[4 * s4 + 2] = in_[s4][2]; acc[4 * s4 + 3] = in_[s4][3]; }
        if (c + 1 < 128) {
#pragma unroll
            for (int s4 = 0; s4 < 4; ++s4) { an[s4] = *(const bf16x8*)(Ap + (size_t)(c + 1) * 4096 + 16 * s4); in_[s4] = *(const f32x4*)(Ip + (size_t)(c + 1) * 4096 + 8 * s4); } }
#pragma unroll
        for (int s4 = 0; s4 < 4; ++s4) { const bf16x8 bb = *(const LAS bf16x8*)(Sc + (n0 + r32) * CP + 32 * s4 + 16 * hh); acc = __builtin_amdgcn_mfma_f32_32x32x16_bf16(a[s4], bb, acc, 0, 0, 0); }
        if (upd) store_t(Sn, acc, m0, n0, r32, hh, 1.f);
        else { float* yp = Y + ((size_t)b * SEQ + c * 64 + m0 + 4 * hh) * 512 + h * 64 + n0 + r32;
#pragma unroll
            for (int r = 0; r < 16; ++r) yp[(size_t)((r & 3) + 8 * (r >> 2)) * 512] = acc[r]; }
        __syncthreads();
    }
}

constexpr int FX_KROW = 144, FX_VROW = 192;
constexpr int FX_KB = 64 * FX_KROW, FX_VB = 64 * FX_VROW, FX_BUF = FX_KB + FX_VB + 256;
__device__ __forceinline__ void phase_odd_main(Frame& F, int layer) {
    KARGS;
    const bf16* P = WSP(bf16, WS_PROJ); bf16* MIX = WSP(bf16, WS_MIX); const float* DC = WSP(float, WS_DCUM);
    const int tid = F.tid, lane = F.lane, wave = F.wave, r32 = lane & 31, hh = lane >> 5;
    const float LOG2E = 1.4426950408889634f, CS = 0.125f * LOG2E;
    const int srow = tid >> 3, sch = tid & 7;
    for (int bhs = F.bid; bhs < 16; bhs += F.G) rwkv_scan(F, bhs);
    unsigned* ctr = (unsigned*)F.ctl + CW_WORK + 64 * layer;
    for (;;) {
        {
            __syncthreads();
            if (tid == 0) F.MISC[16] = atomicAdd(ctr, 1u);
            __syncthreads();
            const int u = (int)F.MISC[16];
            if (u >= 512) break;
            const int bh = u & 15, qb = 31 - (u >> 4), b = bh >> 3, h = bh & 7;
            const bf16* base = P + (size_t)b * SEQ * ODD_N; const float* dc = DC + (size_t)bh * SEQ;
            const int q0 = 256 * qb + 32 * wave, myq = q0 + r32;
            bf16x8 qf[4];
#pragma unroll
            for (int d0 = 0; d0 < 4; ++d0) qf[d0] = *(const bf16x8*)(base + (size_t)myq * ODD_N + h * 64 + 16 * d0 + 8 * hh);
            const float dq = dc[myq] * LOG2E;
            float m = -INFINITY, lsum = 0.f;
            f32x16 o[2];
#pragma unroll
            for (int r = 0; r < 16; ++r) { o[0][r] = 0.f; o[1][r] = 0.f; }
            const int NT = 4 * qb + 4;
            v4u kreg = *(const v4u*)(base + (size_t)srow * ODD_N + 512 + h * 64 + sch * 8);
            v4u vreg = *(const v4u*)(base + (size_t)srow * ODD_N + 1024 + h * 64 + sch * 8);
            float dreg = tid < 64 ? dc[tid] * LOG2E : 0.f;
            *(LAS v4u*)(F.lds + srow * FX_KROW + sch * 16) = kreg; *(LAS v4u*)(F.lds + FX_KB + srow * FX_VROW + sch * 16) = vreg;
            if (tid < 64) *(LAS float*)(F.lds + FX_KB + FX_VB + tid * 4) = dreg;
            __syncthreads();
            for (int j = 0; j < NT; ++j) {
                const int cur = (j & 1) * FX_BUF, nxt = ((j + 1) & 1) * FX_BUF;
                if (j + 1 < NT) { const size_t krow = (size_t)(64 * (j + 1) + srow) * ODD_N;
                    kreg = *(const v4u*)(base + krow + 512 + h * 64 + sch * 8); vreg = *(const v4u*)(base + krow + 1024 + h * 64 + sch * 8);
                    if (tid < 64) dreg = dc[64 * (j + 1) + tid] * LOG2E; }
                if (64 * j <= q0 + 31) {
                    const LAS unsigned char* Kb = F.lds + cur; const LAS unsigned char* Vb = F.lds + cur + FX_KB; const LAS float* dkb = (const LAS float*)(F.lds + cur + FX_KB + FX_VB);
                    f32x16 p0, p1;
#pragma unroll
                    for (int r = 0; r < 16; ++r) { p0[r] = 0.f; p1[r] = 0.f; }
#pragma unroll
                    for (int d0 = 0; d0 < 4; ++d0) {
                        const bf16x8 a0 = *(const LAS bf16x8*)(Kb + r32 * FX_KROW + 32 * d0 + 16 * hh);
                        const bf16x8 a1 = *(const LAS bf16x8*)(Kb + (r32 + 32) * FX_KROW + 32 * d0 + 16 * hh);
                        p0 = __builtin_amdgcn_mfma_f32_32x32x16_bf16(a0, qf[d0], p0, 0, 0, 0);
                        p1 = __builtin_amdgcn_mfma_f32_32x32x16_bf16(a1, qf[d0], p1, 0, 0, 0);
                    }
                    const bool diag = 64 * j + 63 > q0;
                    float tmax = -INFINITY;
#pragma unroll
                    for (int g = 0; g < 4; ++g) {
                        const f32x4 dk0 = *(const LAS f32x4*)(dkb + 8 * g + 4 * hh), dk1 = *(const LAS f32x4*)(dkb + 32 + 8 * g + 4 * hh);
#pragma unroll
                        for (int i = 0; i < 4; ++i) {
                            float z0 = p0[4 * g + i] * CS + (dq - dk0[i]), z1 = p1[4 * g + i] * CS + (dq - dk1[i]);
                            if (diag) { const int key = 64 * j + 8 * g + 4 * hh + i; if (key > myq) z0 = -INFINITY; if (key + 32 > myq) z1 = -INFINITY; }
                            p0[4 * g + i] = z0; p1[4 * g + i] = z1; tmax = fmaxf(tmax, fmaxf(z0, z1)); }
                    }
                    tmax = fmaxf(tmax, __shfl_xor(tmax, 32));
                    const float mn = fmaxf(m, tmax); const float corr = __builtin_amdgcn_exp2f(m - mn); m = mn;
                    float ps = 0.f;
#pragma unroll
                    for (int r = 0; r < 16; ++r) { p0[r] = __builtin_amdgcn_exp2f(p0[r] - mn); p1[r] = __builtin_amdgcn_exp2f(p1[r] - mn); ps += p0[r] + p1[r]; }
                    lsum = lsum * corr + ps;
#pragma unroll
                    for (int r = 0; r < 16; ++r) { o[0][r] *= corr; o[1][r] *= corr; }
                    bf16x8 pf[4];
#pragma unroll
                    for (int s4 = 0; s4 < 4; ++s4) {
                        v4u w;
                        if (s4 < 2) { w.x = pk2(p0[8 * s4 + 0], p0[8 * s4 + 1]); w.y = pk2(p0[8 * s4 + 2], p0[8 * s4 + 3]); w.z = pk2(p0[8 * s4 + 4], p0[8 * s4 + 5]); w.w = pk2(p0[8 * s4 + 6], p0[8 * s4 + 7]); }
                        else { const int sp = s4 - 2; w.x = pk2(p1[8 * sp + 0], p1[8 * sp + 1]); w.y = pk2(p1[8 * sp + 2], p1[8 * sp + 3]); w.z = pk2(p1[8 * sp + 4], p1[8 * sp + 5]); w.w = pk2(p1[8 * sp + 6], p1[8 * sp + 7]); }
                        pf[s4] = __builtin_bit_cast(bf16x8, w);
                    }
                    const int gi = lane >> 4, li = lane & 15;
                    const LAS unsigned char* vbase = Vb + (4 * (gi >> 1) + (li >> 2)) * FX_VROW + (16 * (gi & 1) + 4 * (li & 3)) * 2;
#pragma unroll
                    for (int d0 = 0; d0 < 2; ++d0)
#pragma unroll
                        for (int s4 = 0; s4 < 4; ++s4) {
                            const s16x4 lo = __builtin_bit_cast(s16x4, __builtin_amdgcn_ds_read_tr16_b64_v4i16((LAS s16x4*)(vbase + (16 * s4) * FX_VROW + 64 * d0)));
                            const s16x4 hi = __builtin_bit_cast(s16x4, __builtin_amdgcn_ds_read_tr16_b64_v4i16((LAS s16x4*)(vbase + (16 * s4 + 8) * FX_VROW + 64 * d0)));
                            const bf16x8 vf = (bf16x8){lo[0], lo[1], lo[2], lo[3], hi[0], hi[1], hi[2], hi[3]};
                            o[d0] = __builtin_amdgcn_mfma_f32_32x32x16_bf16(vf, pf[s4], o[d0], 0, 0, 0);
                        }
                }
                if (j + 1 < NT) {
                    *(LAS v4u*)(F.lds + nxt + srow * FX_KROW + sch * 16) = kreg; *(LAS v4u*)(F.lds + nxt + FX_KB + srow * FX_VROW + sch * 16) = vreg;
                    if (tid < 64) *(LAS float*)(F.lds + nxt + FX_KB + FX_VB + tid * 4) = dreg;
                }
                __syncthreads();
            }
            const float l = lsum + __shfl_xor(lsum, 32); const float inv = 1.f / l;
            const bf16* gp = base + (size_t)myq * ODD_N + 1536 + h * 64; bf16* op = MIX + ((size_t)b * SEQ + myq) * D + h * 64;
#pragma unroll
            for (int d0 = 0; d0 < 2; ++d0)
#pragma unroll
                for (int g = 0; g < 4; ++g) { const int db = 32 * d0 + 8 * g + 4 * hh; const v2u gw = *(const v2u*)(gp + db);
                    const float g0 = sigmoidf_(bflo(gw.x)), g1 = sigmoidf_(bfhi(gw.x)), g2 = sigmoidf_(bflo(gw.y)), g3 = sigmoidf_(bfhi(gw.y));
                    v2u ow; ow.x = pk2(o[d0][4 * g + 0] * inv * g0, o[d0][4 * g + 1] * inv * g1); ow.y = pk2(o[d0][4 * g + 2] * inv * g2, o[d0][4 * g + 3] * inv * g3);
                    *(v2u*)(op + db) = ow; }
        }
    }
}

__device__ __forceinline__ void phase_rwkv_post(Frame& F, int layer) {
    KARGS;
    const int jj = layer >> 1, ch = F.tid;
    const float* R = WSP(float, WS_RW); const float* K = WSP(float, WS_RW + 2 * RW_SLOT); const float* V = WSP(float, WS_RW + 3 * RW_SLOT);
    const float* Gt = WSP(float, WS_RW + 6 * RW_SLOT); const float* Y = WSP(float, WS_RW + 7 * RW_SLOT);
    bf16* MIX = WSP(bf16, WS_MIX);
    const float lw = IN(24)[jj * 512 + ch], lb = IN(25)[jj * 512 + ch], rk = IN(23)[jj * 512 + ch];
    for (int tg = F.bid; tg < T; tg += F.G) {
        const size_t o = (size_t)tg * 512 + ch;
        const float y = Y[o]; const float mu = wave_sum(y) * (1.f / 64.f); const float dlt = y - mu; const float var = wave_sum(dlt * dlt) * (1.f / 64.f);
        const float yn = dlt * rsqrtf(var + GN_EPS) * lw + lb;
        const float v = V[o]; const float bonus = wave_sum(R[o] * K[o] * rk) * v;
        MIX[(size_t)tg * D + 512 + ch] = (bf16)f2bf((yn + bonus) * Gt[o]);
    }
}

#define BUBBLE(x_, V_) do { float bx_ = (x_); _Pragma("unroll") for (int p_ = 0; p_ < 16; ++p_) { const float hi_ = fmaxf(bx_, V_[p_]); bx_ = fminf(bx_, V_[p_]); V_[p_] = hi_; } } while (0)
__device__ __forceinline__ float pack_low(float v, unsigned bits, unsigned mask) { return __builtin_bit_cast(float, (__builtin_bit_cast(unsigned, v) & ~mask) | bits); }
__device__ __forceinline__ void phase_peer_topk(Frame& F, int layer) {
    KARGS;
    const bf16* Q = WSP(bf16, WS_Q); const bf16* KEYS = WSP(bf16, WS_KEYS) + (size_t)layer * 2 * 16384;
    int* IDX = WSP(int, WS_IDX); float* GATE = WSP(float, WS_GATE);
    LAS float* sc = (LAS float*)(F.lds + F.wave * 16512);
    LAS unsigned* li = (LAS unsigned*)sc;
    const int lane = F.lane, fr = lane & 15, fq = lane >> 4;
    const int gw = F.bid * NWAVES + F.wave, NGW = F.G * NWAVES;
    for (int it = gw; it < (T / 32) * 8; it += NGW) {
        const int tile = it >> 3, h = it & 7, t0 = tile * 32;
        float v1[16], v2[16];
#pragma unroll
        for (int half = 0; half < 2; ++half) {
            f32x4 acc[2][8];
#pragma unroll
            for (int rt = 0; rt < 2; ++rt)
#pragma unroll
                for (int ct = 0; ct < 8; ++ct) acc[rt][ct] = (f32x4){0.f, 0.f, 0.f, 0.f};
            const bf16* kb = KEYS + (size_t)half * 16384;
#pragma unroll 1
            for (int ks = 0; ks < 4; ++ks) {
                bf16x8 a[2];
#pragma unroll
                for (int rt = 0; rt < 2; ++rt) a[rt] = *(const bf16x8*)(Q + (size_t)(t0 + rt * 16 + fr) * 2048 + h * 256 + half * 128 + ks * 32 + 8 * fq);
#pragma unroll
                for (int ct = 0; ct < 8; ++ct) { const bf16x8 bb = *(const bf16x8*)(kb + (size_t)(ct * 16 + fr) * 128 + ks * 32 + 8 * fq);
#pragma unroll
                    for (int rt = 0; rt < 2; ++rt) acc[rt][ct] = __builtin_amdgcn_mfma_f32_16x16x32_bf16(a[rt], bb, acc[rt][ct], 0, 0, 0); }
            }
#pragma unroll
            for (int rt = 0; rt < 2; ++rt)
#pragma unroll
                for (int ct = 0; ct < 8; ++ct)
#pragma unroll
                    for (int r = 0; r < 4; ++r) sc[(rt * 16 + 4 * fq + r) * 129 + ct * 16 + fr] = pack_low(acc[rt][ct][r], (unsigned)(ct * 16 + fr), 0x7Fu);
            LDS_WAIT(); asm volatile("" ::: "memory");
            float vv[16];
#pragma unroll
            for (int p = 0; p < 16; ++p) vv[p] = -INFINITY;
            if (lane < 32) { const LAS float* row = sc + lane * 129;
#pragma unroll 4
                for (int n = 0; n < 128; ++n) { const float x = row[n]; BUBBLE(x, vv); } }
            LDS_WAIT(); asm volatile("" ::: "memory");
#pragma unroll
            for (int p = 0; p < 16; ++p) { if (half == 0) v1[p] = vv[p]; else v2[p] = vv[p]; }
        }
        if (lane < 32) {
#pragma unroll
            for (int p = 0; p < 16; ++p) { li[lane * 33 + p] = __builtin_bit_cast(unsigned, v1[p]) & 0x7Fu; li[lane * 33 + 16 + p] = __builtin_bit_cast(unsigned, v2[p]) & 0x7Fu; }
            float ts[16];
#pragma unroll
            for (int p = 0; p < 16; ++p) ts[p] = -INFINITY;
#pragma unroll
            for (int a = 0; a < 16; ++a)
#pragma unroll
                for (int bq = 0; bq < 16; ++bq) if ((a + 1) * (bq + 1) <= 16) { const float x = pack_low(v1[a] + v2[bq], (unsigned)(a * 16 + bq), 0xFFu); BUBBLE(x, ts); }
            LDS_WAIT(); asm volatile("" ::: "memory");
            float e[16], sum = 0.f;
#pragma unroll
            for (int p = 0; p < 16; ++p) { e[p] = expf(ts[p] - ts[0]); sum += e[p]; }
            const float inv = 1.f / sum;
            int* ip = IDX + (size_t)(t0 + lane) * 128 + h * 16; float* gp = GATE + (size_t)(t0 + lane) * 128 + h * 16;
#pragma unroll
            for (int p = 0; p < 16; ++p) { const unsigned ab = __builtin_bit_cast(unsigned, ts[p]) & 0xFFu;
                ip[p] = (int)(li[lane * 33 + (ab >> 4)] * 128u + li[lane * 33 + 16 + (ab & 15u)]); gp[p] = e[p] * inv; }
        }
        LDS_WAIT(); asm volatile("" ::: "memory");
    }
}

__device__ __forceinline__ void unpack8(float (&o)[8], const v4u w) {
    o[0] = bflo(w.x); o[1] = bfhi(w.x); o[2] = bflo(w.y); o[3] = bfhi(w.y); o[4] = bflo(w.z); o[5] = bfhi(w.z); o[6] = bflo(w.w); o[7] = bfhi(w.w);
}
__device__ __forceinline__ void phase_peer_gather(Frame& F, int layer) {
    KARGS;
    const bf16* H = WSP(bf16, WS_H); const int* IDX = WSP(int, WS_IDX); const float* GATE = WSP(float, WS_GATE);
    const bf16* U = WSP(bf16, WS_PU) + (size_t)layer * NEXP * 1024; const bf16* Vt = WSP(bf16, WS_PV) + (size_t)layer * NEXP * 1024;
    const float* g2 = WSP(float, WS_MOD) + (size_t)layer * 2 * 6144 + 5120;
    float* X = OUTP;
    const int lane = F.lane, gw = F.bid * NWAVES + F.wave, NGW = F.G * NWAVES;
    for (int tg = gw; tg < T; tg += NGW) {
        const int b = tg >= SEQ ? 1 : 0;
        float x0[8], x1[8];
        unpack8(x0, *(const v4u*)(H + (size_t)tg * D + 8 * lane)); unpack8(x1, *(const v4u*)(H + (size_t)tg * D + 512 + 8 * lane));
        const int id0 = IDX[(size_t)tg * 128 + lane], id1 = IDX[(size_t)tg * 128 + 64 + lane];
        const float gt0 = GATE[(size_t)tg * 128 + lane], gt1 = GATE[(size_t)tg * 128 + 64 + lane];
        float a0[8], a1[8];
#pragma unroll
        for (int i = 0; i < 8; ++i) { a0[i] = 0.f; a1[i] = 0.f; }
        for (int e0 = 0; e0 < 128; e0 += 8) {
            int idx[8]; float d[8];
            v4u ua[8], ub[8];
#pragma unroll
            for (int q = 0; q < 8; ++q) { const int e = e0 + q; idx[q] = __builtin_amdgcn_readlane(e0 < 64 ? id0 : id1, e & 63);
                const bf16* up = U + (size_t)idx[q] * 1024 + 8 * lane; ua[q] = *(const v4u*)up; ub[q] = *(const v4u*)(up + 512); }
#pragma unroll
            for (int q = 0; q < 8; ++q) { float u0[8], u1[8]; unpack8(u0, ua[q]); unpack8(u1, ub[q]); float s = 0.f;
#pragma unroll
                for (int i = 0; i < 8; ++i) s += u0[i] * x0[i] + u1[i] * x1[i];
                d[q] = s; }
#pragma unroll
            for (int o = 1; o < 64; o <<= 1) {
#pragma unroll
                for (int q = 0; q < 8; ++q) d[q] += __shfl_xor(d[q], o); }
#pragma unroll
            for (int q = 0; q < 8; ++q) { const int e = e0 + q; const bf16* vp = Vt + (size_t)idx[q] * 1024 + 8 * lane; ua[q] = *(const v4u*)vp; ub[q] = *(const v4u*)(vp + 512);
                d[q] = gelu_erf(d[q]) * rl(e0 < 64 ? gt0 : gt1, e & 63); }
#pragma unroll
            for (int q = 0; q < 8; ++q) { float v0[8], v1[8]; unpack8(v0, ua[q]); unpack8(v1, ub[q]);
#pragma unroll
                for (int i = 0; i < 8; ++i) { a0[i] += v0[i] * d[q]; a1[i] += v1[i] * d[q]; } }
        }
        float* xr = X + (size_t)tg * D + 8 * lane; const float* gg = g2 + b * 6144 + 8 * lane;
#pragma unroll
        for (int hh = 0; hh < 2; ++hh) {
#pragma unroll
            for (int c = 0; c < 2; ++c) { const int off = hh * 512 + c * 4; const f32x4 g4 = *(const f32x4*)(gg + off); const f32x4 xv = *(const f32x4*)(xr + off);
                f32x4 av; if (hh == 0) av = (f32x4){a0[c * 4], a0[c * 4 + 1], a0[c * 4 + 2], a0[c * 4 + 3]}; else av = (f32x4){a1[c * 4], a1[c * 4 + 1], a1[c * 4 + 2], a1[c * 4 + 3]};
                *(f32x4*)(xr + off) = xv + g4 * av; } }
    }
}

__device__ __forceinline__ void phase_final(Frame& F) {
    KARGS;
    float* X = OUTP; const float* gain = IN(31);
    const int lane = F.lane, gw = F.bid * NWAVES + F.wave, NGW = F.G * NWAVES;
    f32x4 gn[4];
#pragma unroll
    for (int j = 0; j < 4; ++j) gn[j] = *(const f32x4*)(gain + 256 * j + 4 * lane);
    for (int row = gw; row < T; row += NGW) {
        float* xr = X + (size_t)row * D + 4 * lane;
        f32x4 v[4]; float ss = 0.f;
#pragma unroll
        for (int j = 0; j < 4; ++j) { v[j] = *(const f32x4*)(xr + 256 * j); ss += (v[j].x * v[j].x + v[j].y * v[j].y) + (v[j].z * v[j].z + v[j].w * v[j].w); }
        const float rstd = rsqrtf(wave_sum(ss) * (1.f / D) + NORM_EPS);
#pragma unroll
        for (int j = 0; j < 4; ++j) *(f32x4*)(xr + 256 * j) = v[j] * rstd * gn[j];
    }
}

#ifndef PH_MASK
#define PH_MASK 0xFFFF
#endif
#define PH_EN(k) ((PH_MASK >> (k)) & 1)
constexpr int NPH = 46;
__host__ __device__ inline bool phase_skipped(int p) { if (p == 0 || p == NPH - 1) return false; const int layer = (p - 1) / 11, step = (p - 1) % 11; return (layer & 1) == 0 && (step == 3 || step == 4 || step == 5); }
__global__ void __launch_bounds__(NTHR, 2) mk_fwd(Args args) {
    extern __shared__ __attribute__((aligned(16))) unsigned char lds[];
    Frame F;
    F.lds = (LAS unsigned char*)lds;
    F.MISC = (volatile LAS unsigned*)(F.lds + MISC_OFF);
    F.tid = threadIdx.x; F.lane = F.tid & 63; F.wave = __builtin_amdgcn_readfirstlane(F.tid >> 6);
    F.G = gridDim.x; F.bid = blockIdx.x;
    F.ctl = (gu32*)(args.ws + WS_CTL);
    for (int u = F.tid; u < (LDS_BYTES - MISC_OFF) / 4; u += NTHR) ((LAS unsigned*)(F.lds + MISC_OFF))[u] = 0u;
    __syncthreads();
    XcdBarrier bar; bar.bar = (unsigned*)(F.ctl + CW_BAR); bar.x = 0; bar.st = nullptr;
    const int lo = args.ph_lo, hi = args.ph_hi;
    if (hi - lo > 1) bar = xcd_barrier_post((unsigned*)(F.ctl + CW_BAR), F.MISC + 8);
    bool ran = false;
    for (int p = lo; p < hi; ++p) {
        if (phase_skipped(p)) continue;
        if (ran) xcd_barrier(bar);
        ran = true;
        { int t_ = threadIdx.x; asm volatile("" : "+v"(t_)); F.tid = t_; F.lane = t_ & 63; F.wave = __builtin_amdgcn_readfirstlane(t_ >> 6);
          int b_ = blockIdx.x, g_ = gridDim.x; asm volatile("" : "+s"(b_), "+s"(g_)); F.bid = b_; F.G = g_; }
        if (p == 0) { if (PH_EN(0)) phase_prologue(F); continue; }
        if (p == NPH - 1) { if (PH_EN(1)) phase_final(F); continue; }
        const int layer = (p - 1) / 11, step = (p - 1) % 11; const bool odd = layer & 1;
        KARGS;
        if (step == 0 || step == 7) { if (PH_EN(2)) phase_norm(F, layer, step == 7 ? 1 : 0); }
        else if (step == 1 || step == 8) { if (PH_EN(3)) {
            const int N = step == 8 ? 2048 : (odd ? ODD_N : EVEN_IN);
            const bf16* Bt = step == 8 ? WSP(bf16, WS_WQ + (size_t)layer * 4 * MiB) : WSP(bf16, WS_WIN + (size_t)layer * 8 * MiB);
            bf16* O = step == 8 ? WSP(bf16, WS_Q) : WSP(bf16, WS_PROJ);
            pg8::Gemm g{WSP(bf16, WS_H), Bt, T, N, D}; pg8::StaticOrder S; S.init(T, N, F.G, F.bid);
            pg8::EpiBf16<0> E{O, N, nullptr, 0, 0, 1.f};
            pg8::gemm_phase<pg8::EpiBf16<0>, pg8::StaticOrder, PG8_ALIGN, PG8_SP2>(F.lds + RING_OFF, g, S, E);
        } }
        else if (step == 2) { if (odd) { if (PH_EN(4)) phase_odd_prep(F, layer); } else { if (PH_EN(5)) phase_even_mixer(F, layer); } }
        else if (step == 3) { if (PH_EN(11)) phase_rwkv_chunk(F, layer); }
        else if (step == 4) { if (PH_EN(6)) phase_odd_main(F, layer); }
        else if (step == 5) { if (PH_EN(7)) phase_rwkv_post(F, layer); }
        else if (step == 6) { if (PH_EN(8)) {
            pg8::Gemm g{WSP(bf16, WS_MIX), WSP(bf16, WS_WOUT + (size_t)layer * 2 * MiB), T, D, D}; pg8::StaticOrder S; S.init(T, D, F.G, F.bid);
            pg8::EpiResid E{layer == 0 ? IN(0) : OUTP, OUTP, WSP(float, WS_MOD) + (size_t)layer * 2 * 6144 + 2048, 6144};
            pg8::gemm_phase<pg8::EpiResid, pg8::StaticOrder, PG8_ALIGN, PG8_SP2>(F.lds + RING_OFF, g, S, E);
        } }
        else if (step == 9) { if (PH_EN(9)) phase_peer_topk(F, layer); }
        else { if (PH_EN(10)) phase_peer_gather(F, layer); }
    }
}

extern "C" void kernel_launch(void* const* d_in, const int* in_sizes, int n_in, void* d_out, int out_size, void* d_ws, size_t ws_size, hipStream_t stream) {
    static int grid = 0;
    if (grid == 0) {
        if (n_in != 32 || in_sizes[0] != T * D || out_size != T * D || ws_size < WS_END) { fprintf(stderr, "kernel_launch: unexpected shapes (n_in %d, in0 %d, out %d, ws %zu < %zu); nothing launched\n", n_in, n_in > 0 ? in_sizes[0] : -1, out_size, ws_size, (size_t)WS_END); grid = -1; return; }
        int dev = 0, cus = 0, per_cu = 0;
        if (hipGetDevice(&dev) != hipSuccess || hipDeviceGetAttribute(&cus, hipDeviceAttributeMultiprocessorCount, dev) != hipSuccess) { grid = -1; return; }
        if (hipFuncSetAttribute((const void*)mk_fwd, hipFuncAttributeMaxDynamicSharedMemorySize, LDS_BYTES) != hipSuccess) { fprintf(stderr, "kernel_launch: hipFuncSetAttribute failed\n"); grid = -1; return; }
        if (hipOccupancyMaxActiveBlocksPerMultiprocessor(&per_cu, (const void*)mk_fwd, NTHR, LDS_BYTES) != hipSuccess || per_cu < 1) fprintf(stderr, "kernel_launch: occupancy query reports %d workgroups per CU\n", per_cu);
        (void)hipGetLastError();
        grid = cus;
    }
    if (grid < 0) return;
    if (hipMemsetAsync((char*)d_ws + WS_CTL, 0, CTL_ZERO_BYTES, stream) != hipSuccess) { fprintf(stderr, "kernel_launch: hipMemsetAsync failed\n"); return; }
    Args a{};
    for (int i = 0; i < 32; ++i) a.in[i] = (const float*)d_in[i];
    a.out = (float*)d_out; a.ws = (unsigned char*)d_ws;
#if MK_ONE_LAUNCH
    a.ph_lo = 0; a.ph_hi = NPH;
    hipLaunchKernelGGL(mk_fwd, dim3(grid), dim3(NTHR), LDS_BYTES, stream, a);
#else
    for (int p = 0; p < NPH; ++p) { if (phase_skipped(p)) continue; a.ph_lo = p; a.ph_hi = p + 1;
        hipLaunchKernelGGL(mk_fwd, dim3(grid), dim3(NTHR), LDS_BYTES, stream, a); }
#endif
    const hipError_t le = hipPeekAtLastError();
    if (le != hipSuccess) fprintf(stderr, "kernel_launch: launch failed: %s\n", hipGetErrorName(le));
}
```

```cpp
#include <hip/hip_runtime.h>
#include <cstdio>
#include <cstdint>
namespace pg8 {
#define PG8_LAS __attribute__((address_space(3)))
typedef unsigned short bf16_t;
typedef short bf16x8 __attribute__((ext_vector_type(8)));
typedef float f32x4 __attribute__((ext_vector_type(4)));
typedef unsigned u32x4 __attribute__((ext_vector_type(4)));
constexpr int BM = 256, BK = 64, HALF = 128, HTB = HALF * BK * 2  , STAGE_BYTES = 8 * HTB, NXCD = 8, WGM = 8;

__host__ __device__ __forceinline__ int lds_byte(int r, int c) { const int st = (r >> 4) * 2 + (c >> 5), rr = r & 15, cc = c & 31, ob = rr * 64 + cc * 2; return st * 1024 + (ob ^ (((ob >> 9) & 1) << 5)); }
__host__ __device__ __forceinline__ void stage_rc(int b, int& R, int& C) { const int st = b / 1024, sb = b % 1024, swz = sb ^ (((sb >> 9) & 1) << 5); R = (st >> 1) * 16 + swz / 64; C = (st & 1) * 32 + (swz % 64) / 2; }
__host__ __device__ __forceinline__ int perm32(int rho) { const int n = rho >> 4, i = rho & 15; return 8 * (i >> 2) + 4 * n + (i & 3); }

struct Unit { int pm, pn; };
struct Gemm { const bf16_t* A; const bf16_t* Bt; int M, N, K; };

struct StaticOrder {
    int nM, nN, nwg, G, c;
    __host__ __device__ void init(int M, int N, int G_, int c_) { nM = M / BM; nN = N / BM; nwg = nM * nN; G = G_; c = c_; }
    __host__ __device__ bool next(int i, Unit& u) const {
        const long L = (long)i * G + c; if (L >= nwg) return false;
        int wgid = (int)L; { const int q = nwg / NXCD, r = nwg % NXCD, xcd = wgid % NXCD, off = wgid / NXCD; wgid = (xcd < r ? xcd * (q + 1) : r * (q + 1) + (xcd - r) * q) + off; }
        const int nig = WGM * nN, gid = wgid / nig, fm = gid * WGM, gsz = (nM - fm) < WGM ? (nM - fm) : WGM;
        u.pm = fm + ((wgid % nig) % gsz); u.pn = (wgid % nig) / gsz; return true;
    }
    __device__ __forceinline__ void a_ready(const Unit&) const {}
    __device__ __forceinline__ void done(const Unit&) const {}
};

__device__ __forceinline__ unsigned cvt_pk_bf16(float lo, float hi) { unsigned r; asm volatile("v_cvt_pk_bf16_f32 %0, %1, %2" : "=v"(r) : "v"(lo), "v"(hi)); return r; }
typedef float f32x2 __attribute__((ext_vector_type(2)));
__device__ __forceinline__ f32x2 gelu_pk(f32x2 v) {
    const f32x2 av = __builtin_elementwise_abs(v), d = av * 0.2316418882f + 1.0f;
    f32x2 t; t.x = __builtin_amdgcn_rcpf(d.x); t.y = __builtin_amdgcn_rcpf(d.y);
    f32x2 q = t * 0.5307027145f + (-0.7265760135f); q = q * t + 0.7107068705f; q = q * t + (-0.142248368f); q = q * t + 0.127414796f; q = q * t;
    const f32x2 s = (v * v) * (-0.72134752044f);
    f32x2 e; e.x = __builtin_amdgcn_exp2f(s.x); e.y = __builtin_amdgcn_exp2f(s.y);
    const f32x2 m = v * (q * e), r = v - m;
    f32x2 o; o.x = v.x < 0.f ? m.x : r.x; o.y = v.y < 0.f ? m.y : r.y; return o;
}

template <int ACT  > struct EpiBf16 {
    static constexpr bool PERM = true, AFTER_DRAIN = false; static_assert(ACT == 0 || ACT == 1, "EpiBf16: ACT is 0 (none) or 1 (gelu_pk)");
    bf16_t* O; int ldc; const float* bias; int split_cols; size_t split_stride; float scale0;
    __device__ __forceinline__ void operator()(const f32x4 (&acc)[2][2][4][2], const Unit& u, int wr, int wc, int fr, int fq) const {
        const int row0 = u.pm * BM + wr * 64 + fr; int colt = u.pn * BM; bf16_t* base = O;
        float sc = 1.f; if (split_cols) { const int t = colt / split_cols; base += (size_t)t * split_stride; colt -= t * split_cols; if (t == 0) sc = scale0; }
        const int col0 = colt + wc * 32 + 8 * fq, bcol0 = u.pn * BM + wc * 32 + 8 * fq;
        f32x4 bv[2][2];
#pragma unroll
        for (int bj = 0; bj < 2; ++bj)
#pragma unroll
            for (int n = 0; n < 2; ++n) bv[bj][n] = bias ? *(const f32x4*)(bias + bcol0 + bj * HALF + 4 * n) : (f32x4){0.f, 0.f, 0.f, 0.f};
#pragma unroll
        for (int ai = 0; ai < 2; ++ai)
#pragma unroll
            for (int m = 0; m < 4; ++m) { bf16_t* rowp = base + (size_t)(row0 + ai * HALF + m * 16) * ldc + col0;
#pragma unroll
                for (int bj = 0; bj < 2; ++bj) { f32x4 v0 = acc[ai][bj][m][0] + bv[bj][0], v1 = acc[ai][bj][m][1] + bv[bj][1];
                    if (ACT == 1) { f32x2 a = gelu_pk((f32x2){v0[0], v0[1]}), b = gelu_pk((f32x2){v0[2], v0[3]}), c = gelu_pk((f32x2){v1[0], v1[1]}), d = gelu_pk((f32x2){v1[2], v1[3]});
                        v0 = (f32x4){a.x, a.y, b.x, b.y}; v1 = (f32x4){c.x, c.y, d.x, d.y}; }
                    v0 = v0 * sc; v1 = v1 * sc; u32x4 w; w.x = cvt_pk_bf16(v0[0], v0[1]); w.y = cvt_pk_bf16(v0[2], v0[3]); w.z = cvt_pk_bf16(v1[0], v1[1]); w.w = cvt_pk_bf16(v1[2], v1[3]);
                    *(u32x4*)(rowp + bj * HALF) = w; } }
    }
};
struct EpiResid {
    static constexpr bool PERM = false, AFTER_DRAIN = false;
    const float* base; float* out; const float* gate; int gstride;
    __device__ __forceinline__ void operator()(const f32x4 (&acc)[2][2][4][2], const Unit& u, int wr, int wc, int fr, int fq) const {
        const int row0 = u.pm * BM + wr * 64 + fr; const int col0 = u.pn * BM + wc * 32 + 4 * fq;
        const float* gp = gate + ((u.pm * BM) >= 8192 ? gstride : 0);
        f32x4 gv[2][2];
#pragma unroll
        for (int bj = 0; bj < 2; ++bj)
#pragma unroll
            for (int n = 0; n < 2; ++n) gv[bj][n] = *(const f32x4*)(gp + col0 + bj * HALF + n * 16);
#pragma unroll
        for (int ai = 0; ai < 2; ++ai)
#pragma unroll
            for (int m = 0; m < 4; ++m) { const size_t off = (size_t)(row0 + ai * HALF + m * 16) * 1024 + col0;
#pragma unroll
                for (int bj = 0; bj < 2; ++bj)
#pragma unroll
                    for (int n = 0; n < 2; ++n) { const f32x4 bs = *(const f32x4*)(base + off + bj * HALF + n * 16);
                        *(f32x4*)(out + off + bj * HALF + n * 16) = bs + gv[bj][n] * acc[ai][bj][m][n]; } }
    }
};
template <class Epi, class Sched, bool ALIGN_EPI = false, bool SP2 = false>
__device__ __forceinline__ void gemm_phase(PG8_LAS unsigned char* lds, const Gemm g, const Sched& S, const Epi& E) {
    int tid_l = threadIdx.x; asm volatile("" : "+v"(tid_l));
    const int tid = tid_l, wid = __builtin_amdgcn_readfirstlane(tid >> 6), lane = tid & 63, wr = wid >> 2, wc = wid & 3, fr = lane & 15, fq = lane >> 4;
    const int K = g.K, nt = K / BK;
    unsigned voffA[2], voffB[2];
#pragma unroll
    for (int i = 0; i < 2; ++i) { int R, C; stage_rc(tid * 16 + i * 8192, R, C); const int Rb = Epi::PERM ? ((R & ~31) + perm32(R & 31)) : R;
        voffA[i] = (unsigned)(R * K + C) * 2u; voffB[i] = (unsigned)(Rb * K + C) * 2u; }
    const size_t kstep = (size_t)(BK * 2);
    const size_t hstep = (size_t)HALF * K * 2;
    const size_t tstep = 2 * hstep;
    const unsigned ldsw = (unsigned)wid * 1024u;
    const int aoff = lds_byte(wr * 64 + fr, fq * 8), boff = lds_byte(wc * 32 + fr, fq * 8);
#define PG8_SA(b, h) (((b) * 2 + (h)) * HTB)
#define PG8_SB(b, h) ((4 + (b) * 2 + (h)) * HTB)
#define PG8_STAGE(bufoff, gbase, voff) do { _Pragma("unroll") for (int _i = 0; _i < 2; ++_i) \
        __builtin_amdgcn_global_load_lds((const unsigned*)((const char*)(gbase) + (voff)[_i]), (PG8_LAS unsigned*)(lds + (bufoff) + ldsw + _i * 8192), 16, 0, 0); } while (0)
#define PG8_LDA(dst, b, h) do { _Pragma("unroll") for (int m = 0; m < 4; ++m) _Pragma("unroll") for (int k = 0; k < 2; ++k) dst[m][k] = *(const PG8_LAS bf16x8*)(lds + PG8_SA(b, h) + aoff + m * 2048 + k * 1024); } while (0)
#define PG8_LDB(dst, b, h) do { _Pragma("unroll") for (int n = 0; n < 2; ++n) _Pragma("unroll") for (int k = 0; k < 2; ++k) dst[n][k] = *(const PG8_LAS bf16x8*)(lds + PG8_SB(b, h) + boff + n * 2048 + k * 1024); } while (0)
#define PG8_MMA(ai, bj, At, Bt) do { __builtin_amdgcn_s_setprio(1); _Pragma("unroll") for (int m = 0; m < 4; ++m) _Pragma("unroll") for (int n = 0; n < 2; ++n) _Pragma("unroll") for (int k = 0; k < 2; ++k) \
        acc[ai][bj][m][n] = __builtin_amdgcn_mfma_f32_16x16x32_bf16(Bt[n][k], At[m][k], acc[ai][bj][m][n], 0, 0, 0); __builtin_amdgcn_s_setprio(0); } while (0)
#define PG8_WAIT_V(n) asm volatile("s_waitcnt vmcnt(" #n ")" ::: "memory")
#define PG8_WAIT_L(n) asm volatile("s_waitcnt lgkmcnt(" #n ")" ::: "memory")
#define PG8_BAR __builtin_amdgcn_s_barrier()
#define PG8_SCHED __builtin_amdgcn_sched_barrier(0)
    Unit cur, nxt; int ui = 0;
    if (!S.next(0, cur)) return;
    f32x4 acc[2][2][4][2];
#pragma unroll
    for (int a = 0; a < 2; ++a)
#pragma unroll
        for (int b = 0; b < 2; ++b)
#pragma unroll
            for (int m = 0; m < 4; ++m)
#pragma unroll
                for (int n = 0; n < 2; ++n) acc[a][b][m][n] = (f32x4){0.f, 0.f, 0.f, 0.f};
    bf16x8 At[4][2], B0[2][2], B1[2][2];
    const char* cA = (const char*)g.A + (size_t)cur.pm * tstep; const char* cB = (const char*)g.Bt + (size_t)cur.pn * tstep;
    S.a_ready(cur);
    if constexpr (SP2) {
        PG8_STAGE(PG8_SB(0, 0), cB, voffB); PG8_STAGE(PG8_SB(0, 1), cB + hstep, voffB); PG8_STAGE(PG8_SA(0, 0), cA, voffA); PG8_STAGE(PG8_SA(0, 1), cA + hstep, voffA);
        if (wr == 1) PG8_BAR;
        PG8_WAIT_V(2); PG8_BAR;
        PG8_STAGE(PG8_SB(1, 0), cB + kstep, voffB); PG8_STAGE(PG8_SA(1, 0), cA + kstep, voffA); PG8_STAGE(PG8_SB(1, 1), cB + hstep + kstep, voffB);
        PG8_WAIT_V(6); PG8_BAR;
    } else {
        PG8_STAGE(PG8_SB(0, 0), cB, voffB); PG8_STAGE(PG8_SA(0, 0), cA, voffA); PG8_STAGE(PG8_SB(0, 1), cB + hstep, voffB); PG8_STAGE(PG8_SA(0, 1), cA + hstep, voffA);
        if (wr == 1) PG8_BAR;
        PG8_WAIT_V(4); PG8_BAR;
        PG8_STAGE(PG8_SB(1, 0), cB + kstep, voffB); PG8_STAGE(PG8_SA(1, 0), cA + kstep, voffA); PG8_STAGE(PG8_SB(1, 1), cB + hstep + kstep, voffB);
        PG8_WAIT_V(6); PG8_BAR;
    }
    for (;;) {
        const bool has_next = S.next(ui + 1, nxt);
        const char* nA = has_next ? (const char*)g.A + (size_t)nxt.pm * tstep : cA; const char* nB = has_next ? (const char*)g.Bt + (size_t)nxt.pn * tstep : cB;
        for (int t = 0; t < nt; t += 2) {
            const bool last = (t == nt - 2);
            const char* a1 = cA + (size_t)(t + 1) * kstep;
            const char* a2 = last ? nA : cA + (size_t)(t + 2) * kstep; const char* b2 = last ? nB : cB + (size_t)(t + 2) * kstep;
            const char* a3 = a2 + kstep; const char* b3 = b2 + kstep;
            if (last && has_next) S.a_ready(nxt);
            if constexpr (SP2) {
            PG8_LDB(B0, 0, 0); PG8_LDB(B1, 0, 1); PG8_SCHED; PG8_LDA(At, 0, 0); PG8_STAGE(PG8_SA(1, 1), a1 + hstep, voffA);
            PG8_WAIT_V(8); PG8_WAIT_L(0); PG8_BAR; PG8_MMA(0, 0, At, B0); PG8_MMA(0, 1, At, B1); PG8_BAR; PG8_SCHED;
            PG8_LDA(At, 0, 1); PG8_STAGE(PG8_SB(0, 0), b2, voffB); PG8_STAGE(PG8_SB(0, 1), b2 + hstep, voffB); PG8_STAGE(PG8_SA(0, 0), a2, voffA);
            PG8_WAIT_V(8); PG8_WAIT_L(0); PG8_BAR; PG8_MMA(1, 0, At, B0); PG8_MMA(1, 1, At, B1); PG8_BAR; PG8_SCHED;
            PG8_LDB(B0, 1, 0); PG8_LDB(B1, 1, 1); PG8_SCHED; PG8_LDA(At, 1, 0); PG8_STAGE(PG8_SA(0, 1), a2 + hstep, voffA);
            PG8_WAIT_V(8); PG8_WAIT_L(0); PG8_BAR; PG8_MMA(0, 0, At, B0); PG8_MMA(0, 1, At, B1); PG8_BAR; PG8_SCHED;
            PG8_LDA(At, 1, 1); PG8_STAGE(PG8_SB(1, 0), b3, voffB); PG8_STAGE(PG8_SB(1, 1), b3 + hstep, voffB); PG8_STAGE(PG8_SA(1, 0), a3, voffA);
            PG8_WAIT_V(8); PG8_WAIT_L(0); PG8_BAR; PG8_MMA(1, 0, At, B0); PG8_MMA(1, 1, At, B1); PG8_BAR; PG8_SCHED;
            } else {
            PG8_LDB(B0, 0, 0); PG8_SCHED; PG8_LDA(At, 0, 0); PG8_STAGE(PG8_SA(1, 1), a1 + hstep, voffA);
            PG8_WAIT_L(8); PG8_BAR; PG8_WAIT_L(0); PG8_MMA(0, 0, At, B0); PG8_BAR; PG8_SCHED;
            PG8_LDB(B1, 0, 1); PG8_STAGE(PG8_SB(0, 0), b2, voffB);
            PG8_BAR; PG8_WAIT_L(0); PG8_MMA(0, 1, At, B1); PG8_BAR;
            PG8_LDA(At, 0, 1); PG8_STAGE(PG8_SA(0, 0), a2, voffA);
            PG8_BAR; PG8_WAIT_L(0); PG8_MMA(1, 0, At, B0); PG8_BAR; PG8_SCHED;
            PG8_STAGE(PG8_SB(0, 1), b2 + hstep, voffB);
            PG8_WAIT_V(6); PG8_BAR; PG8_MMA(1, 1, At, B1); PG8_BAR;
            PG8_LDB(B0, 1, 0); PG8_SCHED; PG8_LDA(At, 1, 0); PG8_STAGE(PG8_SA(0, 1), a2 + hstep, voffA);
            PG8_WAIT_L(8); PG8_BAR; PG8_WAIT_L(0); PG8_MMA(0, 0, At, B0); PG8_BAR; PG8_SCHED;
            PG8_LDB(B1, 1, 1); PG8_STAGE(PG8_SB(1, 0), b3, voffB);
            PG8_BAR; PG8_WAIT_L(0); PG8_MMA(0, 1, At, B1); PG8_BAR;
            PG8_LDA(At, 1, 1); PG8_STAGE(PG8_SA(1, 0), a3, voffA);
            PG8_BAR; PG8_WAIT_L(0); PG8_MMA(1, 0, At, B0); PG8_BAR; PG8_SCHED;
            PG8_STAGE(PG8_SB(1, 1), b3 + hstep, voffB);
            PG8_WAIT_V(6); PG8_BAR; PG8_MMA(1, 1, At, B1); PG8_BAR;
            }
        }
        if constexpr (ALIGN_EPI) { if (wr == 0) PG8_BAR; }
        if constexpr (!Epi::AFTER_DRAIN) { E(acc, cur, wr, wc, fr, fq); S.done(cur); }
        if (!has_next) break;
#pragma unroll
        for (int a = 0; a < 2; ++a)
#pragma unroll
            for (int b = 0; b < 2; ++b)
#pragma unroll
                for (int m = 0; m < 4; ++m)
#pragma unroll
                    for (int n = 0; n < 2; ++n) acc[a][b][m][n] = (f32x4){0.f, 0.f, 0.f, 0.f};
        cur = nxt; cA = nA; cB = nB; ++ui;
        if constexpr (ALIGN_EPI) { if (wr == 1) PG8_BAR; }
    }
    PG8_WAIT_V(0);
    if constexpr (!ALIGN_EPI) { if (wr == 0) PG8_BAR; }
    PG8_BAR;
    if constexpr (Epi::AFTER_DRAIN) { E.fused(acc, cur, wr, wc, fr, fq, lds, wid, lane); S.done(cur); }
#undef PG8_SA
#undef PG8_SB
#undef PG8_STAGE
#undef PG8_LDA
#undef PG8_LDB
#undef PG8_MMA
#undef PG8_WAIT_V
#undef PG8_WAIT_L
#undef PG8_BAR
#undef PG8_SCHED
}
}
#ifndef PG8_SP2
#define PG8_SP2 true
#endif
#ifndef PG8_ALIGN
#define PG8_ALIGN true
#endif
#ifndef MK_ONE_LAUNCH
#define MK_ONE_LAUNCH 1
#endif

constexpr int NWAVES = 8, NTHR = NWAVES * 64;
constexpr int BATCH = 2, SEQ = 8192, D = 1024, T = BATCH * SEQ, DEPTH = 4;
constexpr int EVEN_IN = 2048, ODD_LD = 3848, ODD_N = 3840;
constexpr int NEXP = 16384;
constexpr float NORM_EPS = 1e-6f, GN_EPS = 64e-5f;

constexpr size_t MiB = 1u << 20;
constexpr size_t WS_CTL = 0, CTL_ZERO_BYTES = 1 * MiB;
constexpr size_t WS_MOD = 1 * MiB;
constexpr size_t WS_WF = WS_MOD + 256 * 1024;
constexpr size_t WS_KEYS = WS_MOD + 512 * 1024;
constexpr size_t WS_LOGF = 2 * MiB;
constexpr size_t WS_DCUM = 2 * MiB + 512 * 1024;
constexpr size_t WS_WIN = 4 * MiB;
constexpr size_t WS_WOUT = 36 * MiB;
constexpr size_t WS_WQ = 44 * MiB;
constexpr size_t WS_H = 64 * MiB;
constexpr size_t WS_MIX = 96 * MiB;
constexpr size_t WS_PROJ = 128 * MiB;
constexpr size_t WS_Q = 256 * MiB;
constexpr size_t WS_IDX = 320 * MiB;
constexpr size_t WS_GATE = 328 * MiB;
constexpr size_t WS_RW = 336 * MiB;
constexpr size_t RW_SLOT = 32 * MiB;
constexpr size_t WS_PU = WS_RW + 8 * RW_SLOT;
constexpr size_t WS_PV = WS_PU + 128 * MiB;
constexpr size_t WS_CG = WS_PV + 128 * MiB;
constexpr size_t WS_CQ = WS_CG + 16 * MiB;
constexpr size_t WS_CH = WS_CQ + 16 * MiB;
constexpr size_t WS_CY = WS_CH + 32 * MiB;
constexpr size_t WS_END = WS_CY + 32 * MiB;
constexpr int CW_WORK = 64;
constexpr int CW_WORK2 = 1024;
constexpr int CW_BAR = 4096;

constexpr int RING_OFF = 0, RING_BYTES = 131072;
constexpr int MISC_OFF = 159744;
constexpr int LDS_BYTES = 163840;

#define GAS __attribute__((address_space(1)))
#define LAS __attribute__((address_space(3)))
typedef unsigned short bf16;
typedef unsigned v4u __attribute__((ext_vector_type(4)));
typedef unsigned v2u __attribute__((ext_vector_type(2)));
typedef float f32x4 __attribute__((ext_vector_type(4)));
typedef short bf16x8 __attribute__((ext_vector_type(8)));
typedef GAS unsigned gu32;
#define LDS_WAIT() asm volatile("s_waitcnt lgkmcnt(0)" ::: "memory")
#define VM_WAIT() asm volatile("s_waitcnt vmcnt(0)" ::: "memory")
__device__ __forceinline__ unsigned f2bf(float f) { unsigned u = __builtin_bit_cast(unsigned, f); return (u + 0x7fffu + ((u >> 16) & 1u)) >> 16; }
__device__ __forceinline__ unsigned pk2(float lo, float hi) { return f2bf(lo) | (f2bf(hi) << 16); }
__device__ __forceinline__ float bf2f(bf16 v) { return __builtin_bit_cast(float, (unsigned)v << 16); }
__device__ __forceinline__ float bflo(unsigned w) { return __builtin_bit_cast(float, w << 16); }
__device__ __forceinline__ float bfhi(unsigned w) { return __builtin_bit_cast(float, w & 0xffff0000u); }
__device__ __forceinline__ float wave_sum(float v) {
#pragma unroll
    for (int o = 1; o < 64; o <<= 1) v += __shfl_xor(v, o);
    return v;
}
__device__ __forceinline__ float wave_max(float v) {
#pragma unroll
    for (int o = 1; o < 64; o <<= 1) v = fmaxf(v, __shfl_xor(v, o));
    return v;
}
__device__ __forceinline__ float rl(float x, int j) { return __builtin_bit_cast(float, __builtin_amdgcn_readlane(__builtin_bit_cast(int, x), j)); }
__device__ __forceinline__ float sigmoidf_(float x) { return 1.f / (1.f + expf(-x)); }
__device__ __forceinline__ float softplusf_(float x) { return fmaxf(x, 0.f) + log1pf(expf(-fabsf(x))); }
__device__ __forceinline__ float gelu_erf(float x) { return 0.5f * x * (1.f + erff(x * 0.70710678118654752f)); }

#define XB_TMO      128
#define XB_XCNT(j)  (256  + 64 * (j))
#define XB_XSUB(j)  (1280 + 64 * (j))
#define XB_XGEN(j)  (2304 + 64 * (j))
#define XB_TOP      3328
#define XB_TOPGEN   3392
#define XCD_BAR_WORDS 3456
#define XB_SPIN_CAP (1u << 18)

__device__ __forceinline__ unsigned xb_ld(unsigned* p)              { return __hip_atomic_load(p, __ATOMIC_RELAXED, __HIP_MEMORY_SCOPE_AGENT); }
__device__ __forceinline__ unsigned xb_add(unsigned* p, unsigned v) { return __hip_atomic_fetch_add(p, v, __ATOMIC_RELAXED, __HIP_MEMORY_SCOPE_AGENT); }
__device__ __forceinline__ unsigned xb_xcc_id() { return (unsigned)__builtin_amdgcn_s_getreg((3 << 11) | 20) & 0xFu; }
#define XB_SPIN(cond, bar) do { unsigned _sp = 0; while (cond) { __builtin_amdgcn_s_sleep(1); \
    if ((++_sp & 255u) == 0u) { if (xb_ld(&(bar)[XB_TMO])) break; if (_sp > XB_SPIN_CAP) { atomicAdd(&(bar)[XB_TMO], 1u); break; } } } } while (0)

struct XcdBarrier {
    unsigned* bar; unsigned x;
    volatile LAS unsigned* st;
};

__device__ __forceinline__ XcdBarrier xcd_barrier_post(unsigned* bar, volatile LAS unsigned* st) {
    XcdBarrier b; b.bar = bar; b.x = xb_xcc_id(); b.st = st;
    if (threadIdx.x == 0) (void)xb_add(&bar[XB_XCNT(b.x)], 1u);
    return b;
}
__device__ __forceinline__ void xcd_barrier_complete(unsigned* bar, unsigned x, unsigned& nloc, unsigned& nx) {
    const unsigned G = gridDim.x * gridDim.y * gridDim.z;
    unsigned sum, cnt, mine, sp = 0u;
    for (;;) {
        sum = 0u; cnt = 0u; mine = 0u;
#pragma unroll
        for (unsigned j = 0; j < 16; ++j) { const unsigned c = xb_ld(&bar[XB_XCNT(j)]); sum += c; cnt += (c > 0u) ? 1u : 0u; mine = (j == x) ? c : mine; }
        if (sum == G) break;
        __builtin_amdgcn_s_sleep(1);
        if ((++sp & 255u) == 0u) { if (xb_ld(&bar[XB_TMO])) break; if (sp > XB_SPIN_CAP) { atomicAdd(&bar[XB_TMO], 1u); break; } }
    }
    nloc = mine > 0u ? mine : 1u; nx = cnt > 0u ? cnt : 1u;
}

__device__ __forceinline__ void xcd_barrier(const XcdBarrier& b) {
    asm volatile("s_waitcnt vmcnt(0)" ::: "memory");
    __syncthreads();
    if (threadIdx.x == 0) {
        unsigned* bar = b.bar;
        __builtin_amdgcn_s_waitcnt(0);
        unsigned nloc = b.st[0], nx = b.st[1];
        if (nloc == 0u) { xcd_barrier_complete(bar, b.x, nloc, nx); b.st[0] = nloc; b.st[1] = nx; }
        const unsigned old = xb_add(&bar[XB_XSUB(b.x)], 1u);
        const unsigned gen = old / nloc;
        if (old + 1u == (gen + 1u) * nloc) {
            __builtin_amdgcn_fence(__ATOMIC_RELEASE, "agent");
            asm volatile("s_waitcnt vmcnt(0)" ::: "memory");
            const unsigned og = xb_add(&bar[XB_TOP], 1u);
            const unsigned tg = og / nx;
            if (og + 1u == (tg + 1u) * nx) xb_add(&bar[XB_TOPGEN], 1u);
            else XB_SPIN(xb_ld(&bar[XB_TOPGEN]) == tg, bar);
            __builtin_amdgcn_fence(__ATOMIC_ACQUIRE, "agent");
            xb_add(&bar[XB_XGEN(b.x)], 1u);
            asm volatile("s_waitcnt vmcnt(0)" ::: "memory");
        } else {
            XB_SPIN(xb_ld(&bar[XB_XGEN(b.x)]) == gen, bar);
            __builtin_amdgcn_fence(__ATOMIC_ACQUIRE, "agent");
            asm volatile("s_waitcnt vmcnt(0)" ::: "memory");
        }
    }
    __syncthreads();
}


struct Frame {
    LAS unsigned char* lds;
    volatile LAS unsigned* MISC;
    gu32* ctl;
    int tid, lane, wave, G, bid;
};
struct Args { const float* in[32]; float* out; unsigned char* ws; int ph_lo, ph_hi; };
#define CAS __attribute__((address_space(4)))
#define KARGS const CAS Args* ka_; { unsigned long long kp_ = (unsigned long long)__builtin_amdgcn_kernarg_segment_ptr(); asm volatile("" : "+s"(kp_)); ka_ = (const CAS Args*)kp_; } unsigned char* const ws_ = ka_->ws
#define IN(i) (ka_->in[i])
#define OUTP (ka_->out)
#define WSP(type, off) ((type*)(ws_ + (off)))

__device__ __forceinline__ void transpose_item(const float* W, int ldw, bf16* WT, int row_off, LAS float* scr, int item, int nblk, int lane) {
    const int kb = item / nblk, nb = item % nblk, k0 = 64 * kb, n0 = 32 * nb;
#pragma unroll 8
    for (int i = 0; i < 32; ++i) { const int kk = 2 * i + (lane >> 5); scr[kk * 33 + (lane & 31)] = W[(size_t)(k0 + kk) * ldw + n0 + (lane & 31)]; }
    LDS_WAIT(); asm volatile("" ::: "memory");
    const int c = lane & 7;
#pragma unroll
    for (int j = 0; j < 4; ++j) { const int n = (lane >> 3) + 8 * j; const LAS float* s = scr + (8 * c) * 33 + n;
        v4u o; o.x = pk2(s[0 * 33], s[1 * 33]); o.y = pk2(s[2 * 33], s[3 * 33]); o.z = pk2(s[4 * 33], s[5 * 33]); o.w = pk2(s[6 * 33], s[7 * 33]);
        *(v4u*)(WT + (size_t)(row_off + n0 + n) * 1024 + k0 + 8 * c) = o; }
    LDS_WAIT(); asm volatile("" ::: "memory");
}

__device__ __forceinline__ void phase_prologue(Frame& F) {
    KARGS;
    LAS float* cact = (LAS float*)F.lds;
    LAS float* part = cact + 2048;
    {   const float* c = IN(1);
        for (int i = F.tid; i < 2048; i += NTHR) { const float v = c[i]; cact[i] = v / (1.f + expf(-v)); } }
    __syncthreads();
    {
        const float* ada_w = IN(2); const float* ada_b = IN(3); float* MOD = WSP(float, WS_MOD);
        for (int it = F.bid; it < 384; it += F.G) {
            const int l = it / 96, j0 = (it % 96) * 64;
            const float* wp = ada_w + ((size_t)l * 1024 + F.wave * 128) * 6144 + j0 + F.lane;
            float a0 = 0.f, a1 = 0.f;
#pragma unroll 8
            for (int k = 0; k < 128; ++k) { const float w = wp[(size_t)k * 6144]; a0 += cact[F.wave * 128 + k] * w; a1 += cact[1024 + F.wave * 128 + k] * w; }
            part[(F.wave * 2 + 0) * 64 + F.lane] = a0; part[(F.wave * 2 + 1) * 64 + F.lane] = a1;
            __syncthreads();
            if (F.tid < 128) { const int b = F.tid >> 6, col = F.tid & 63; float s = 0.f;
#pragma unroll
                for (int w = 0; w < 8; ++w) s += part[(w * 2 + b) * 64 + col];
                MOD[(l * 2 + b) * 6144 + j0 + col] = s + ada_b[l * 6144 + j0 + col]; }
            __syncthreads();
        }
    }
    {
        LAS float* scr = (LAS float*)(F.lds + 16384 + F.wave * 8448);
        const int gw = F.bid * NWAVES + F.wave, NGW = F.G * NWAVES;
        constexpr int I_A = 16 * 64, I_B = 16 * 64, I_C = 16 * 56, I_D = 16 * 32, I_E = 16 * 64;
        constexpr int NITEMS = 2 * I_A + 2 * I_B + 2 * I_C + 4 * I_D + 4 * I_E;
        for (int it = gw; it < NITEMS; it += NGW) {
            int r = it;
            if (r < 2 * I_A) { const int j = r / I_A; transpose_item(IN(6) + (size_t)j * 1024 * 2048, 2048, WSP(bf16, WS_WIN + (size_t)(2 * j) * 8 * MiB), 0, scr, r % I_A, 64, F.lane); continue; } r -= 2 * I_A;
            if (r < 2 * I_B) { const int j = r / I_B; transpose_item(IN(10) + (size_t)j * 1024 * ODD_LD, ODD_LD, WSP(bf16, WS_WIN + (size_t)(2 * j + 1) * 8 * MiB), 0, scr, r % I_B, 64, F.lane); continue; } r -= 2 * I_B;
            if (r < 2 * I_C) { const int j = r / I_C; transpose_item(IN(10) + (size_t)j * 1024 * ODD_LD + 2056, ODD_LD, WSP(bf16, WS_WIN + (size_t)(2 * j + 1) * 8 * MiB), 2048, scr, r % I_C, 56, F.lane); continue; } r -= 2 * I_C;
            if (r < 4 * I_D) { const int l = r / I_D; const int j = l >> 1; const float* src = (l & 1) ? IN(11) : IN(7);
                if ((l & 1) || (r % I_D) < 8 * 32) transpose_item(src + (size_t)j * 1024 * 1024, 1024, WSP(bf16, WS_WOUT + (size_t)l * 2 * MiB), 0, scr, r % I_D, 32, F.lane); continue; } r -= 4 * I_D;
            { const int l = r / I_E; transpose_item(IN(26) + (size_t)l * 1024 * 2048, 2048, WSP(bf16, WS_WQ + (size_t)l * 4 * MiB), 0, scr, r % I_E, 64, F.lane); }
        }
    }
    {
        const int gt = F.bid * NTHR + F.tid, NGT = F.G * NTHR;
        float* WF = WSP(float, WS_WF);
        for (int i = gt; i < 2 * 8 * 1024; i += NGT) { const int j = i >> 13, h = (i >> 10) & 7, k = i & 1023; WF[i] = IN(10)[((size_t)j * 1024 + k) * ODD_LD + 2048 + h]; }
        bf16* KEYS = WSP(bf16, WS_KEYS);
        for (int i = gt; i < 4 * 16384; i += NGT) { const int l = i >> 14, r = i & 16383;
            KEYS[(size_t)(l * 2 + 0) * 16384 + r] = (bf16)f2bf(IN(27)[i]); KEYS[(size_t)(l * 2 + 1) * 16384 + r] = (bf16)f2bf(IN(28)[i]); }
        for (int i = gt; i < 2 * 1024 * 512; i += NGT) { const int j = i >> 19, n = (i >> 9) & 1023, gc = i & 511, g = gc >> 7, c = gc & 127;
            const float* pw = IN(8) + ((size_t)(j * 4 + g) * 128 + c) * 128; const float* psc = IN(9) + j * 512 + g * 128; const float* wo = IN(7) + ((size_t)j * 1024 + 512 + g * 128) * 1024 + n;
            float a = 0.f;
#pragma unroll 8
            for (int d = 0; d < 128; ++d) a += pw[d] * psc[d] * wo[(size_t)d * 1024];
            WSP(bf16, WS_WOUT + (size_t)(2 * j) * 2 * MiB)[(size_t)n * 1024 + 512 + gc] = (bf16)f2bf(a); }
        const f32x4* su = (const f32x4*)IN(29); const f32x4* sv = (const f32x4*)IN(30); v2u* du = WSP(v2u, WS_PU); v2u* dv = WSP(v2u, WS_PV);
        for (size_t i = gt; i < (size_t)4 * NEXP * 1024 / 4; i += NGT) { const f32x4 a = su[i], b = sv[i];
            v2u o; o.x = pk2(a.x, a.y); o.y = pk2(a.z, a.w); du[i] = o; o.x = pk2(b.x, b.y); o.y = pk2(b.z, b.w); dv[i] = o; }
    }
}

__device__ __forceinline__ void phase_norm(Frame& F, int layer, int which) {
    KARGS;
    const float* X = (layer == 0 && which == 0) ? IN(0) : OUTP;
    const float* gain = (which ? IN(5) : IN(4)) + layer * 1024;
    const float* mod = WSP(float, WS_MOD) + (size_t)layer * 2 * 6144 + (which ? 3072 : 0);
    bf16* H = WSP(bf16, WS_H);
    const bool do_f = (layer & 1) && which == 0;
    const int jj = layer >> 1;
    const float* WF = WSP(float, WS_WF) + (size_t)jj * 8 * 1024;
    float* LOGF = WSP(float, WS_LOGF);
    const int gw = F.bid * NWAVES + F.wave, NGW = F.G * NWAVES, lane = F.lane;
    f32x4 gn[4];
#pragma unroll
    for (int j = 0; j < 4; ++j) gn[j] = *(const f32x4*)(gain + 256 * j + 4 * lane);
    for (int row = gw; row < T; row += NGW) {
        const int b = row >= SEQ ? 1 : 0;
        const float* sh = mod + b * 6144; const float* sc = sh + 1024;
        const float* xr = X + (size_t)row * D + 4 * lane;
        f32x4 v[4]; float ss = 0.f;
#pragma unroll
        for (int j = 0; j < 4; ++j) { v[j] = *(const f32x4*)(xr + 256 * j); ss += (v[j].x * v[j].x + v[j].y * v[j].y) + (v[j].z * v[j].z + v[j].w * v[j].w); }
        const float rstd = rsqrtf(wave_sum(ss) * (1.f / D) + NORM_EPS);
        bf16* hr = H + (size_t)row * D + 4 * lane;
#pragma unroll
        for (int j = 0; j < 4; ++j) { const f32x4 s4 = *(const f32x4*)(sc + 256 * j + 4 * lane), h4 = *(const f32x4*)(sh + 256 * j + 4 * lane);
            v[j] = v[j] * rstd * gn[j] * (s4 + 1.f) + h4;
            v2u o; o.x = pk2(v[j].x, v[j].y); o.y = pk2(v[j].z, v[j].w); *(v2u*)(hr + 256 * j) = o; }
        if (do_f) {
            const float* fb = IN(14) + jj * 8;
            const int t = row - b * SEQ;
#pragma unroll
            for (int hh = 0; hh < 8; ++hh) { float d = 0.f;
#pragma unroll
                for (int j = 0; j < 4; ++j) { const f32x4 w4 = *(const f32x4*)(WF + hh * 1024 + 256 * j + 4 * lane); d += (v[j].x * w4.x + v[j].y * w4.y) + (v[j].z * w4.z + v[j].w * w4.w); }
                d = wave_sum(d) + fb[hh];
                const float lf = fminf(d, 0.f) - log1pf(expf(-fabsf(d)));
                if (lane == 0) LOGF[(size_t)(b * 8 + hh) * SEQ + t] = lf; }
        }
    }
}

__device__ __forceinline__ void load_q64(float (&q)[64], const bf16* p, float scale) {
#pragma unroll
    for (int c = 0; c < 8; ++c) { const v4u w = *(const v4u*)(p + 8 * c);
        q[8 * c + 0] = bflo(w.x) * scale; q[8 * c + 1] = bfhi(w.x) * scale; q[8 * c + 2] = bflo(w.y) * scale; q[8 * c + 3] = bfhi(w.y) * scale;
        q[8 * c + 4] = bflo(w.z) * scale; q[8 * c + 5] = bfhi(w.z) * scale; q[8 * c + 6] = bflo(w.w) * scale; q[8 * c + 7] = bfhi(w.w) * scale; }
}
__device__ __forceinline__ float dot_q64(const float (&q)[64], const bf16* p) {
    float z0 = 0.f, z1 = 0.f;
#pragma unroll
    for (int c = 0; c < 8; ++c) { const v4u w = *(const v4u*)(p + 8 * c);
        z0 += q[8 * c + 0] * bflo(w.x) + q[8 * c + 2] * bflo(w.y) + q[8 * c + 4] * bflo(w.z) + q[8 * c + 6] * bflo(w.w);
        z1 += q[8 * c + 1] * bfhi(w.x) + q[8 * c + 3] * bfhi(w.y) + q[8 * c + 5] * bfhi(w.z) + q[8 * c + 7] * bfhi(w.w); }
    return z0 + z1;
}
#ifdef MK_SIMPLE_EVEN
__device__ __forceinline__ void phase_even_mixer_simple(Frame& F, int layer) {
    KARGS;
    const bf16* P = WSP(bf16, WS_PROJ); bf16* MIX = WSP(bf16, WS_MIX);
    const int lane = F.lane;
    {
        const int gw = F.bid * NWAVES + F.wave, NGW = F.G * NWAVES;
        for (int it = gw; it < BATCH * 8 * SEQ; it += NGW) {
            const int b = it >> 16, h = (it >> 13) & 7, t = it & 8191;
            const bf16* base = P + (size_t)b * SEQ * EVEN_IN;
            float q[64]; load_q64(q, base + (size_t)t * EVEN_IN + h * 64, 0.125f);
            float acc = 0.f, carry = 0.f;
            for (int s0 = t - 1; s0 >= 0; s0 -= 64) {
                const int s = s0 - lane; const bool valid = s >= 0; const int sc = valid ? s : 0;
                const float z = dot_q64(q, base + (size_t)sc * EVEN_IN + 512 + h * 64);
                const float sp = softplusf_(z);
                const float l1m = valid ? -sp : 0.f;
                const float lb = z - sp;
                float inc = l1m;
#pragma unroll
                for (int o = 1; o < 64; o <<= 1) { const float n = __shfl_up(inc, o); if (lane >= o) inc += n; }
                const float w = valid ? expf(lb + carry + (inc - l1m)) : 0.f;
                const float tot = __shfl(inc, 63);
#pragma unroll 16
                for (int j = 0; j < 64; ++j) { const float wj = rl(w, j); int sj = s0 - j; sj = sj < 0 ? 0 : sj;
                    acc += wj * bf2f(base[(size_t)sj * EVEN_IN + 1024 + h * 64 + lane]); }
                carry += tot;
                if (carry < -104.f) break;
            }
            MIX[((size_t)b * SEQ + t) * D + h * 64 + lane] = (bf16)f2bf(acc);
        }
    }
    {
        LAS float* pl = (LAS float*)F.lds;
        const int jj = layer >> 1;
        const float* pw = IN(8) + (size_t)jj * 4 * 128 * 128; const float* ps = IN(9) + jj * 512;
        const int c = F.tid, g = c >> 7, w = 2 << g, d = c & 127;
        for (int tile = F.bid; tile < T / 32; tile += F.G) {
            const int t0 = tile * 32, b = t0 / SEQ, tl0 = t0 % SEQ;
            const bf16* base = P + (size_t)b * SEQ * EVEN_IN + 1536 + c;
            for (int tt = 0; tt < 32; ++tt) { const int tl = tl0 + tt, cend = (tl / 64 + 1) * 64;
                int lo = tl - w / 2; lo = lo < 0 ? 0 : lo; int hi = tl + w / 2; hi = hi > cend ? cend : hi;
                float s = 0.f; for (int u = lo; u < hi; ++u) s += bf2f(base[(size_t)u * EVEN_IN]);
                pl[c * 33 + tt] = s / (float)(hi - lo) - bf2f(base[(size_t)tl * EVEN_IN]); }
            __syncthreads();
            float acc[32];
#pragma unroll
            for (int tt = 0; tt < 32; ++tt) acc[tt] = 0.f;
            for (int cc = 0; cc < 128; ++cc) { const float wv = pw[((size_t)g * 128 + cc) * 128 + d]; const LAS float* pr = pl + (g * 128 + cc) * 33;
#pragma unroll
                for (int tt = 0; tt < 32; ++tt) acc[tt] += pr[tt] * wv; }
            const float sc = ps[c];
#pragma unroll
            for (int tt = 0; tt < 32; ++tt) MIX[(size_t)(t0 + tt) * D + 512 + c] = (bf16)f2bf(acc[tt] * sc);
            __syncthreads();
        }
    }
}

#endif
typedef float f32x16 __attribute__((ext_vector_type(16)));
typedef short s16x4 __attribute__((ext_vector_type(4)));
constexpr int FX_KROW = 144, FX_VROW = 192;
constexpr int FX_KB = 64 * FX_KROW, FX_VB = 64 * FX_VROW, FX_BUF = FX_KB + FX_VB + 256;
template <int HW> __device__ __forceinline__ void pool_chunk(const bf16* src, bf16* dst, int tl0) {
    float ps[HW + 65 + HW]; ps[0] = 0.f;
#pragma unroll
    for (int i = 0; i < 64 + HW; ++i) { const int tl = tl0 - HW + i; const float x = tl >= 0 ? bf2f(src[(long)(i - HW) * EVEN_IN]) : 0.f; ps[i + 1] = ps[i] + x; }
#pragma unroll
    for (int tt = 0; tt < 64; ++tt) { const int tl = tl0 + tt; int lo = tl - HW; lo = lo < 0 ? 0 : lo; const int hie = tt + HW > 64 ? 64 : tt + HW;
        const float sum = ps[hie + HW] - ps[tt]; const float x = ps[tt + HW + 1] - ps[tt + HW];
        dst[(size_t)tt * D] = (bf16)f2bf(sum / (float)(tl0 + hie - lo) - x); }
}
__device__ __forceinline__ void phase_even_mixer(Frame& F, int layer) {
    KARGS;
    const bf16* P = WSP(bf16, WS_PROJ); bf16* MIX = WSP(bf16, WS_MIX);
    const int tid = F.tid, lane = F.lane, wave = F.wave, r32 = lane & 31, hh = lane >> 5;
    const float LOG2E = 1.4426950408889634f, CS = 0.125f * LOG2E;
    const int srow = tid >> 3, sch = tid & 7;
    {
        const int c = tid, g = c >> 7;
        for (int ck = F.bid; ck < T / 64; ck += F.G) {
            const int t0 = ck * 64, tl0 = t0 % SEQ;
            const bf16* src = P + (size_t)t0 * EVEN_IN + 1536 + c; bf16* dst = MIX + (size_t)t0 * D + 512 + c;
            if (g == 0) pool_chunk<1>(src, dst, tl0); else if (g == 1) pool_chunk<2>(src, dst, tl0); else if (g == 2) pool_chunk<4>(src, dst, tl0); else pool_chunk<8>(src, dst, tl0);
        }
    }
    __syncthreads();
    for (int u = F.bid; u < 256; u += F.G) {
        for (int ui = 0; ui < 2; ++ui) {
            const int bh = u >> 4, ss = u & 15, qb = ui == 0 ? ss : 31 - ss, b = bh >> 3, h = bh & 7;
            const bf16* base = P + (size_t)b * SEQ * EVEN_IN;
            const int q0 = 256 * qb + 32 * wave, myq = q0 + r32;
            bf16x8 qf[4];
#pragma unroll
            for (int d0 = 0; d0 < 4; ++d0) qf[d0] = *(const bf16x8*)(base + (size_t)myq * EVEN_IN + h * 64 + 16 * d0 + 8 * hh);
            float carry = 0.f;
            f32x16 o[2];
#pragma unroll
            for (int r = 0; r < 16; ++r) { o[0][r] = 0.f; o[1][r] = 0.f; }
            const int jtop = 4 * qb + 3;
            v4u kreg = *(const v4u*)(base + (size_t)(64 * jtop + srow) * EVEN_IN + 512 + h * 64 + sch * 8);
            v4u vreg = *(const v4u*)(base + (size_t)(64 * jtop + srow) * EVEN_IN + 1024 + h * 64 + sch * 8);
            __syncthreads();
            *(LAS v4u*)(F.lds + srow * FX_KROW + sch * 16) = kreg; *(LAS v4u*)(F.lds + FX_KB + srow * FX_VROW + sch * 16) = vreg;
            if (tid < 16) ((LAS unsigned*)(F.lds + 2 * FX_BUF))[tid] = 0u;
            __syncthreads();
            int it = 0;
            for (int j = jtop; j >= 0; --j, ++it) {
                const int cur = (it & 1) * FX_BUF, nxt = ((it + 1) & 1) * FX_BUF;
                if (j > 0) { const size_t krow = (size_t)(64 * (j - 1) + srow) * EVEN_IN;
                    kreg = *(const v4u*)(base + krow + 512 + h * 64 + sch * 8); vreg = *(const v4u*)(base + krow + 1024 + h * 64 + sch * 8); }
                const bool started = 64 * j <= q0 + 30;
                const bool wprev = __all(carry < -150.f);
                if (started && !wprev) {
                    const LAS unsigned char* Kb = F.lds + cur; const LAS unsigned char* Vb = F.lds + cur + FX_KB;
                    f32x16 p0, p1;
#pragma unroll
                    for (int r = 0; r < 16; ++r) { p0[r] = 0.f; p1[r] = 0.f; }
#pragma unroll
                    for (int d0 = 0; d0 < 4; ++d0) {
                        const bf16x8 a0 = *(const LAS bf16x8*)(Kb + r32 * FX_KROW + 32 * d0 + 16 * hh);
                        const bf16x8 a1 = *(const LAS bf16x8*)(Kb + (r32 + 32) * FX_KROW + 32 * d0 + 16 * hh);
                        p0 = __builtin_amdgcn_mfma_f32_32x32x16_bf16(a0, qf[d0], p0, 0, 0, 0);
                        p1 = __builtin_amdgcn_mfma_f32_32x32x16_bf16(a1, qf[d0], p1, 0, 0, 0);
                    }
                    f32x16 l0, l1v;
#pragma unroll
                    for (int r = 0; r < 16; ++r) {
                        const int key = 64 * j + (r & 3) + 8 * (r >> 2) + 4 * hh;
                        const float za = p0[r] * CS, zb = p1[r] * CS;
                        const float sa = fmaxf(za, 0.f) + __builtin_amdgcn_logf(1.f + __builtin_amdgcn_exp2f(-fabsf(za)));
                        const float sb = fmaxf(zb, 0.f) + __builtin_amdgcn_logf(1.f + __builtin_amdgcn_exp2f(-fabsf(zb)));
                        const bool va = key < myq, vb = key + 32 < myq;
                        l0[r] = va ? -sa : 0.f; l1v[r] = vb ? -sb : 0.f;
                        p0[r] = va ? za - sa : -INFINITY; p1[r] = vb ? zb - sb : -INFINITY;
                    }
                    float tot[8], oth[8];
#pragma unroll
                    for (int g = 0; g < 4; ++g) { tot[g] = (l0[4 * g] + l0[4 * g + 1]) + (l0[4 * g + 2] + l0[4 * g + 3]); tot[4 + g] = (l1v[4 * g] + l1v[4 * g + 1]) + (l1v[4 * g + 2] + l1v[4 * g + 3]); }
#pragma unroll
                    for (int g = 0; g < 8; ++g) oth[g] = __shfl_xor(tot[g], 32);
                    float sfx[8]; float run = 0.f;
#pragma unroll
                    for (int x = 7; x >= 0; --x) { sfx[x] = run; run += tot[x] + oth[x]; }
#pragma unroll
                    for (int x = 0; x < 8; ++x) {
                        const float goff = carry + sfx[x] + (hh == 0 ? oth[x] : 0.f);
                        if (x < 4) { const float s3 = goff, s2 = s3 + l0[4 * x + 3], s1 = s2 + l0[4 * x + 2], s0 = s1 + l0[4 * x + 1];
                            p0[4 * x] = __builtin_amdgcn_exp2f(p0[4 * x] + s0); p0[4 * x + 1] = __builtin_amdgcn_exp2f(p0[4 * x + 1] + s1); p0[4 * x + 2] = __builtin_amdgcn_exp2f(p0[4 * x + 2] + s2); p0[4 * x + 3] = __builtin_amdgcn_exp2f(p0[4 * x + 3] + s3); }
                        else { const int y = x - 4; const float s3 = goff, s2 = s3 + l1v[4 * y + 3], s1 = s2 + l1v[4 * y + 2], s0 = s1 + l1v[4 * y + 1];
                            p1[4 * y] = __builtin_amdgcn_exp2f(p1[4 * y] + s0); p1[4 * y + 1] = __builtin_amdgcn_exp2f(p1[4 * y + 1] + s1); p1[4 * y + 2] = __builtin_amdgcn_exp2f(p1[4 * y + 2] + s2); p1[4 * y + 3] = __builtin_amdgcn_exp2f(p1[4 * y + 3] + s3); }
                    }
                    carry += run;
                    bf16x8 pf[4];
#pragma unroll
                    for (int s4 = 0; s4 < 4; ++s4) {
                        v4u w;
                        if (s4 < 2) { w.x = pk2(p0[8 * s4 + 0], p0[8 * s4 + 1]); w.y = pk2(p0[8 * s4 + 2], p0[8 * s4 + 3]); w.z = pk2(p0[8 * s4 + 4], p0[8 * s4 + 5]); w.w = pk2(p0[8 * s4 + 6], p0[8 * s4 + 7]); }
                        else { const int sp = s4 - 2; w.x = pk2(p1[8 * sp + 0], p1[8 * sp + 1]); w.y = pk2(p1[8 * sp + 2], p1[8 * sp + 3]); w.z = pk2(p1[8 * sp + 4], p1[8 * sp + 5]); w.w = pk2(p1[8 * sp + 6], p1[8 * sp + 7]); }
                        pf[s4] = __builtin_bit_cast(bf16x8, w);
                    }
                    const int gi = lane >> 4, li = lane & 15;
                    const LAS unsigned char* vbase = Vb + (4 * (gi >> 1) + (li >> 2)) * FX_VROW + (16 * (gi & 1) + 4 * (li & 3)) * 2;
#pragma unroll
                    for (int d0 = 0; d0 < 2; ++d0)
#pragma unroll
                        for (int s4 = 0; s4 < 4; ++s4) {
                            const s16x4 lo = __builtin_bit_cast(s16x4, __builtin_amdgcn_ds_read_tr16_b64_v4i16((LAS s16x4*)(vbase + (16 * s4) * FX_VROW + 64 * d0)));
                            const s16x4 hi = __builtin_bit_cast(s16x4, __builtin_amdgcn_ds_read_tr16_b64_v4i16((LAS s16x4*)(vbase + (16 * s4 + 8) * FX_VROW + 64 * d0)));
                            const bf16x8 vf = (bf16x8){lo[0], lo[1], lo[2], lo[3], hi[0], hi[1], hi[2], hi[3]};
                            o[d0] = __builtin_amdgcn_mfma_f32_32x32x16_bf16(vf, pf[s4], o[d0], 0, 0, 0);
                        }
                }
                const bool wdone = started && __all(carry < -150.f);
                if (lane == 0) ((LAS unsigned*)(F.lds + 2 * FX_BUF))[(it & 1) * 8 + wave] = wdone ? 1u : 0u;
                if (j > 0) { *(LAS v4u*)(F.lds + nxt + srow * FX_KROW + sch * 16) = kreg; *(LAS v4u*)(F.lds + nxt + FX_KB + srow * FX_VROW + sch * 16) = vreg; }
                __syncthreads();
                const LAS unsigned* fl = (const LAS unsigned*)(F.lds + 2 * FX_BUF) + (it & 1) * 8;
                const unsigned alld = fl[0] & fl[1] & fl[2] & fl[3] & fl[4] & fl[5] & fl[6] & fl[7];
                if (alld) break;
            }
            bf16* op = MIX + ((size_t)b * SEQ + myq) * D + h * 64;
#pragma unroll
            for (int d0 = 0; d0 < 2; ++d0)
#pragma unroll
                for (int g = 0; g < 4; ++g) { const int db = 32 * d0 + 8 * g + 4 * hh;
                    v2u ow; ow.x = pk2(o[d0][4 * g + 0], o[d0][4 * g + 1]); ow.y = pk2(o[d0][4 * g + 2], o[d0][4 * g + 3]); *(v2u*)(op + db) = ow; }
        }
    }
}

__device__ __forceinline__ void phase_odd_prep(Frame& F, int layer) {
    KARGS;
    const int jj = layer >> 1, lane = F.lane;
    bf16* P = WSP(bf16, WS_PROJ);
    if (F.wave == 0 && F.bid < 16) {
        const float* lf = WSP(float, WS_LOGF) + (size_t)F.bid * SEQ; float* dc = WSP(float, WS_DCUM) + (size_t)F.bid * SEQ; double carry = 0.0;
        for (int t0 = 0; t0 < SEQ; t0 += 64) { float inc = lf[t0 + lane];
#pragma unroll
            for (int o = 1; o < 64; o <<= 1) { const float n = __shfl_up(inc, o); if (lane >= o) inc += n; }
            dc[t0 + lane] = (float)(carry + (double)inc); carry += (double)__shfl(inc, 63); }
    }
    LAS float* lx = (LAS float*)F.lds;
    const float* mix = IN(15) + jj * 1792;
    const float* w0 = IN(16) + jj * 512; const float* w2 = IN(17) + (size_t)jj * 64 * 512;
    const float* a0 = IN(18) + jj * 512; const float* a2 = IN(19) + (size_t)jj * 64 * 512;
    const float* g2 = IN(20) + (size_t)jj * 128 * 512;
    const float* kkp = IN(21) + jj * 512; const float* kap = IN(22) + jj * 512;
    const float* qn = IN(12) + jj * 64; const float* kn = IN(13) + jj * 64;
    float* R = WSP(float, WS_RW); float* Wd = WSP(float, WS_RW + RW_SLOT); float* K = WSP(float, WS_RW + 2 * RW_SLOT); float* V = WSP(float, WS_RW + 3 * RW_SLOT);
    float* KK = WSP(float, WS_RW + 4 * RW_SLOT); float* A = WSP(float, WS_RW + 5 * RW_SLOT); float* Gt = WSP(float, WS_RW + 6 * RW_SLOT);
    const int ch = F.tid;
    const float m_r = mix[ch], m_k = mix[512 + ch], m_v = mix[1024 + ch];
    const float w0c = w0[ch], a0c = a0[ch], kkc = kkp[ch], kac = kap[ch], qnc = qn[ch & 63], knc = kn[ch & 63];
    for (int item = F.bid; item < T / 16; item += F.G) {
        const int t0 = item * 16;
        for (int i = F.tid; i < 16 * 256; i += NTHR) { const int tt = i >> 8, j = i & 255, tg = t0 + tt, tl = tg % SEQ, col = 1536 + j;
            const float cur = bf2f(P[(size_t)tg * ODD_N + 2048 + col]); const float prev = tl > 0 ? bf2f(P[(size_t)(tg - 1) * ODD_N + 2048 + col]) : 0.f;
            const float x = cur + (prev - cur) * mix[col];
            lx[i] = j < 64 ? tanhf(x) : (j < 128 ? x : sigmoidf_(x)); }
        __syncthreads();
        float aw[16], aa[16], ag[16];
#pragma unroll
        for (int tt = 0; tt < 16; ++tt) { aw[tt] = 0.f; aa[tt] = 0.f; ag[tt] = 0.f; }
        for (int i = 0; i < 64; ++i) { const float w2v = w2[i * 512 + ch], a2v = a2[i * 512 + ch];
#pragma unroll
            for (int tt = 0; tt < 16; ++tt) { aw[tt] += lx[tt * 256 + i] * w2v; aa[tt] += lx[tt * 256 + 64 + i] * a2v; } }
        for (int i = 0; i < 128; ++i) { const float g2v = g2[i * 512 + ch];
#pragma unroll
            for (int tt = 0; tt < 16; ++tt) ag[tt] += lx[tt * 256 + 128 + i] * g2v; }
#pragma unroll
        for (int tt = 0; tt < 16; ++tt) { const int tg = t0 + tt, tl = tg % SEQ;
            const bf16* pc = P + (size_t)tg * ODD_N + 2048 + ch; const bf16* pp = pc - ODD_N;
            const float rc = bf2f(pc[0]), kc = bf2f(pc[512]), vc = bf2f(pc[1024]);
            const float rp = tl > 0 ? bf2f(pp[0]) : 0.f, kp = tl > 0 ? bf2f(pp[512]) : 0.f, vp = tl > 0 ? bf2f(pp[1024]) : 0.f;
            const float r = rc + (rp - rc) * m_r, kr = kc + (kp - kc) * m_k, vr = vc + (vp - vc) * m_v;
            const float wl = -softplusf_(-(w0c + aw[tt])) - 0.5f; const float decay = -expf(wl);
            const float a = sigmoidf_(a0c + aa[tt]);
            const float kkv = kr * kkc; const float n2 = wave_sum(kkv * kkv); const float kkn = kkv / fmaxf(sqrtf(n2), 1e-12f);
            const float kmod = kr * (1.f + (a - 1.f) * kac);
            const size_t o = (size_t)tg * 512 + ch;
            R[o] = r; Wd[o] = decay; K[o] = kmod; V[o] = vr; KK[o] = kkn; A[o] = a; Gt[o] = ag[tt];
            bf16* pq = P + (size_t)tg * ODD_N + ch;
            const float qv = bf2f(pq[0]), kv = bf2f(pq[512]);
            const float qs = wave_sum(qv * qv) * (1.f / 64.f), ks = wave_sum(kv * kv) * (1.f / 64.f);
            pq[0] = (bf16)f2bf(qv * rsqrtf(qs + NORM_EPS) * qnc); pq[512] = (bf16)f2bf(kv * rsqrtf(ks + NORM_EPS) * knc); }
        __syncthreads();
    }
}

constexpr int CP = 144;
constexpr int CM = 64 * CP;
__device__ __forceinline__ void mm_nt(f32x16& acc, const LAS unsigned char* A, const LAS unsigned char* B, int m0, int n0, int r32, int hh) {
#pragma unroll
    for (int s4 = 0; s4 < 4; ++s4) { const bf16x8 a = *(const LAS bf16x8*)(A + (m0 + r32) * CP + 32 * s4 + 16 * hh); const bf16x8 b = *(const LAS bf16x8*)(B + (n0 + r32) * CP + 32 * s4 + 16 * hh);
        acc = __builtin_amdgcn_mfma_f32_32x32x16_bf16(a, b, acc, 0, 0, 0); }
}
__device__ __forceinline__ void store_t(LAS unsigned char* Dst, const f32x16& acc, int m0, int n0, int r32, int hh, float sg) {
#pragma unroll
    for (int g = 0; g < 4; ++g) { v2u w; w.x = pk2(sg * acc[4 * g], sg * acc[4 * g + 1]); w.y = pk2(sg * acc[4 * g + 2], sg * acc[4 * g + 3]); *(LAS v2u*)(Dst + (n0 + r32) * CP + (m0 + 8 * g + 4 * hh) * 2) = w; }
}
__device__ __forceinline__ void load_t(f32x16& acc, const LAS unsigned char* Src, int m0, int n0, int r32, int hh, float sg) {
#pragma unroll
    for (int g = 0; g < 4; ++g) { const v2u w = *(const LAS v2u*)(Src + (n0 + r32) * CP + (m0 + 8 * g + 4 * hh) * 2);
        acc[4 * g] = sg * bflo(w.x); acc[4 * g + 1] = sg * bfhi(w.x); acc[4 * g + 2] = sg * bflo(w.y); acc[4 * g + 3] = sg * bfhi(w.y); }
}
#define ZERO16(a) do { _Pragma("unroll") for (int r_ = 0; r_ < 16; ++r_) a[r_] = 0.f; } while (0)
__device__ __forceinline__ void mask16(f32x16& acc, int m0, int n0, int r32, int hh, int mode) {
    const int n = n0 + r32;
#pragma unroll
    for (int r = 0; r < 16; ++r) { const int m = m0 + (r & 3) + 8 * (r >> 2) + 4 * hh; const bool keep = mode == 0 ? (n < m) : (mode == 1 ? (m < n) : (m <= n)); acc[r] = keep ? acc[r] : 0.f; }
}
__device__ __forceinline__ void phase_rwkv_chunk(Frame& F, int layer) {
    KARGS;
    const float* R = WSP(float, WS_RW); const float* LW = WSP(float, WS_RW + RW_SLOT); const float* K = WSP(float, WS_RW + 2 * RW_SLOT); const float* V = WSP(float, WS_RW + 3 * RW_SLOT);
    const float* KK = WSP(float, WS_RW + 4 * RW_SLOT); const float* A = WSP(float, WS_RW + 5 * RW_SLOT);
    bf16* CGp = WSP(bf16, WS_CG); bf16* CQp = WSP(bf16, WS_CQ); float* CHp = WSP(float, WS_CH); float* CYp = WSP(float, WS_CY);
    const int tid = F.tid, lane = F.lane, w = F.wave, r32 = lane & 31, hh = lane >> 5;
    LAS unsigned char* L = F.lds;
    LAS unsigned char* Ab = L, *Bb = L + CM, *Kb = L + 2 * CM, *Rb = L + 3 * CM, *BtT = L + 4 * CM, *KtT = L + 5 * CM, *VT = L + 6 * CM;
    LAS unsigned char* XT0 = L + 7 * CM, *XT1 = L + 9 * CM;
    LAS unsigned char* NB = L + 11 * CM;
    LAS unsigned char* Prb = L + 15 * CM;
    LAS float* tot = (LAS float*)(L + 16 * CM);
    LAS float* gCl = tot + 512;
    for (int item = F.bid; item < 16 * 128; item += F.G) {
        const int bh = item >> 7, c = item & 127, b = bh >> 3, h = bh & 7;
        {
            const size_t g0 = ((size_t)b * SEQ + c * 64 + 8 * w) * 512 + h * 64 + lane;
            float lw[8], cum[8]; float run = 0.f;
#pragma unroll
            for (int i = 0; i < 8; ++i) { lw[i] = LW[g0 + (size_t)i * 512]; run += lw[i]; cum[i] = run; }
            tot[w * 64 + lane] = run;
            __syncthreads();
            float off = 0.f, all = 0.f;
#pragma unroll
            for (int ww = 0; ww < 8; ++ww) { const float tv = tot[ww * 64 + lane]; if (ww < w) off += tv; all += tv; }
            if (w == 0) gCl[lane] = expf(all);
#pragma unroll
            for (int i = 0; i < 8; ++i) {
                const int t = 8 * w + i; const float cm = cum[i] + off;
                const float g = expf(cm), gex = expf(cm - lw[i]), gi = expf(-cm), gcg = expf(all - cm);
                const size_t gg = g0 + (size_t)i * 512;
                const float r = R[gg], k = K[gg], v = V[gg], kk = KK[gg], a = A[gg];
                const bf16 ab = (bf16)f2bf(kk * gex), bb = (bf16)f2bf(kk * a * gi), kb = (bf16)f2bf(k * gi), rb = (bf16)f2bf(r * g), bt = (bf16)f2bf(kk * a * gcg), kt = (bf16)f2bf(k * gcg), vb = (bf16)f2bf(v);
                *(LAS bf16*)(Ab + t * CP + lane * 2) = ab; *(LAS bf16*)(Bb + t * CP + lane * 2) = bb; *(LAS bf16*)(Kb + t * CP + lane * 2) = kb; *(LAS bf16*)(Rb + t * CP + lane * 2) = rb;
                *(LAS bf16*)(XT0 + lane * CP + t * 2) = ab; *(LAS bf16*)(BtT + lane * CP + t * 2) = bt; *(LAS bf16*)(KtT + lane * CP + t * 2) = kt; *(LAS bf16*)(VT + lane * CP + t * 2) = vb;
            }
            __syncthreads();
        }
        const int xtm = w & 1, xtn = w >> 1;
        f32x16 xacc;
        {
#pragma unroll
            for (int qq = 0; qq < 2; ++qq) {
                int q; if (w < 4) q = 2 * w + qq; else { if (qq == 1) break; q = 8 + (w - 4); }
                const int pr = q >> 2, tm = (q >> 1) & 1, tn = q & 1; f32x16 acc; ZERO16(acc);
                if (pr == 0) { mm_nt(acc, Ab, Bb, 32 * tm, 32 * tn, r32, hh); mask16(acc, 32 * tm, 32 * tn, r32, hh, 0); store_t(NB + 1 * CM, acc, 32 * tm, 32 * tn, r32, hh, -1.f); }
                else if (pr == 1) { mm_nt(acc, Bb, Ab, 32 * tm, 32 * tn, r32, hh); mask16(acc, 32 * tm, 32 * tn, r32, hh, 1); store_t(NB + 0 * CM, acc, 32 * tm, 32 * tn, r32, hh, -1.f); }
                else { mm_nt(acc, Bb, Rb, 32 * tm, 32 * tn, r32, hh); mask16(acc, 32 * tm, 32 * tn, r32, hh, 2); store_t(Prb, acc, 32 * tm, 32 * tn, r32, hh, 1.f); }
            }
            if (xtn >= 2) { ZERO16(xacc); mm_nt(xacc, Ab, Kb, 32 * xtm, 32 * (xtn - 2), r32, hh); mask16(xacc, 32 * xtm, 32 * (xtn - 2), r32, hh, 0); store_t(XT0 + 64 * CP, xacc, 32 * xtm, 32 * (xtn - 2), r32, hh, 1.f); }
            else load_t(xacc, XT0, 32 * xtm, 32 * xtn, r32, hh, 1.f);
            __syncthreads();
        }
        LAS unsigned char* XTc = XT0; LAS unsigned char* XTn = XT1; int nb = 0;
#pragma unroll 1
        for (int j = 0; j < 6; ++j) {
            const LAS unsigned char* Nc = NB + (2 * nb) * CM; const LAS unsigned char* NTc = NB + (2 * nb + 1) * CM;
            mm_nt(xacc, Nc, XTc, 32 * xtm, 32 * xtn, r32, hh);
            store_t(XTn, xacc, 32 * xtm, 32 * xtn, r32, hh, 1.f);
            if (j < 5) { const int tm = (w >> 1) & 1, tn = w & 1; f32x16 acc; ZERO16(acc);
                if (w < 4) { mm_nt(acc, Nc, NTc, 32 * tm, 32 * tn, r32, hh); store_t(NB + (2 * (nb ^ 1) + 1) * CM, acc, 32 * tm, 32 * tn, r32, hh, 1.f); }
                else       { mm_nt(acc, NTc, Nc, 32 * tm, 32 * tn, r32, hh); store_t(NB + (2 * (nb ^ 1)) * CM, acc, 32 * tm, 32 * tn, r32, hh, 1.f); } }
            __syncthreads();
            { LAS unsigned char* t_ = XTc; XTc = XTn; XTn = t_; } nb ^= 1;
        }
        const size_t cbase = (size_t)(bh * 128 + c) * 4096;
#pragma unroll
        for (int qq = 0; qq < 2; ++qq) {
            const int q = 2 * w + qq, pr = q >> 2, tm = (q >> 1) & 1, tn = q & 1, m0 = 32 * tm, n0 = 32 * tn; f32x16 acc;
            if (pr == 0) {
                load_t(acc, Rb, m0, n0, r32, hh, -1.f); mm_nt(acc, XTc, Prb, m0, n0, r32, hh);
                bf16* dst = CQp + cbase + (size_t)(n0 + r32) * 64 + m0 + 4 * hh;
#pragma unroll
                for (int g = 0; g < 4; ++g) { v2u o; o.x = pk2(-acc[4 * g], -acc[4 * g + 1]); o.y = pk2(-acc[4 * g + 2], -acc[4 * g + 3]); *(v2u*)(dst + 8 * g) = o; }
            } else if (pr == 1) {
                ZERO16(acc); mm_nt(acc, XTc, BtT, m0, n0, r32, hh);
                const int k1 = n0 + r32; const float gc = gCl[k1];
                bf16* dst = CGp + cbase + (size_t)k1 * 64 + m0 + 4 * hh;
#pragma unroll
                for (int g = 0; g < 4; ++g) { float e[4];
#pragma unroll
                    for (int i = 0; i < 4; ++i) { const int k2 = m0 + 8 * g + 4 * hh + i; e[i] = (k2 == k1 ? gc : 0.f) - acc[4 * g + i]; }
                    v2u o; o.x = pk2(e[0], e[1]); o.y = pk2(e[2], e[3]); *(v2u*)(dst + 8 * g) = o; }
            } else if (pr == 2) {
                load_t(acc, KtT, m0, n0, r32, hh, -1.f); mm_nt(acc, XTc + 64 * CP, BtT, m0, n0, r32, hh); store_t(NB, acc, m0, n0, r32, hh, -1.f);
            } else {
                f32x16 a1; ZERO16(a1); mm_nt(a1, Kb, Rb, m0, n0, r32, hh); mask16(a1, m0, n0, r32, hh, 2);
                ZERO16(acc); mm_nt(acc, XTc + 64 * CP, Prb, m0, n0, r32, hh);
#pragma unroll
                for (int r = 0; r < 16; ++r) acc[r] = a1[r] - acc[r];
                store_t(NB + CM, acc, m0, n0, r32, hh, 1.f);
            }
        }
        __syncthreads();
        {
            const int ww = w & 3, tm = ww >> 1, tn = ww & 1, m0 = 32 * tm, n0 = 32 * tn; f32x16 acc; ZERO16(acc);
            mm_nt(acc, w < 4 ? NB : NB + CM, VT, m0, n0, r32, hh);
            float* dst = (w < 4 ? CHp : CYp) + cbase + (size_t)(n0 + r32) * 64 + m0 + 4 * hh;
#pragma unroll
            for (int g = 0; g < 4; ++g) *(f32x4*)(dst + 8 * g) = (f32x4){acc[4 * g], acc[4 * g + 1], acc[4 * g + 2], acc[4 * g + 3]};
        }
        __syncthreads();
    }
}

__device__ __forceinline__ void rwkv_scan(Frame& F, int bh) {
    KARGS;
    const bf16* CGp = WSP(bf16, WS_CG) + (size_t)bh * 128 * 4096; const bf16* CQp = WSP(bf16, WS_CQ) + (size_t)bh * 128 * 4096;
    const float* CHp = WSP(float, WS_CH) + (size_t)bh * 128 * 4096; const float* CYp = WSP(float, WS_CY) + (size_t)bh * 128 * 4096;
    float* Y = WSP(float, WS_RW + 7 * RW_SLOT);
    const int lane = F.lane, w = F.wave, r32 = lane & 31, hh = lane >> 5, b = bh >> 3, h = bh & 7;
    LAS unsigned char* S0 = F.lds; LAS unsigned char* S1 = F.lds + CM;
    for (int i = F.tid; i < 2 * CM / 4; i += NTHR) ((LAS unsigned*)F.lds)[i] = 0u;
    const bool upd = w < 4; const int ww = w & 3, tm = ww >> 1, tn = ww & 1, m0 = 32 * tm, n0 = 32 * tn;
    const bf16* Ap = (upd ? CGp : CQp) + (size_t)(m0 + r32) * 64 + 8 * hh;
    const float* Ip = (upd ? CHp : CYp) + (size_t)(n0 + r32) * 64 + m0 + 4 * hh;
    bf16x8 an[4]; f32x4 in_[4];
#pragma unroll
    for (int s4 = 0; s4 < 4; ++s4) { an[s4] = *(const bf16x8*)(Ap + 16 * s4); in_[s4] = *(const f32x4*)(Ip + 8 * s4); }
    __syncthreads();
    for (int c = 0; c < 128; ++c) {
        LAS unsigned char* Sc = (c & 1) ? S1 : S0; LAS unsigned char* Sn = (c & 1) ? S0 : S1;
        bf16x8 a[4]; f32x16 acc;
#pragma unroll
        for (int s4 = 0; s4 < 4; ++s4) { a[s4] = an[s4]; acc[4 * s4] = in_[s4][0]; acc[4 * s4 + 1] = in_[s4][1]; acc[4 * s4 + 2] = in_[s4][2]; acc[4 * s4 + 3] = in_[s4][3]; }
        if (c + 1 < 128) {
#pragma unroll
            for (int s4 = 0; s4 < 4; ++s4) { an[s4] = *(const bf16x8*)(Ap + (size_t)(c + 1) * 4096 + 16 * s4); in_[s4] = *(const f32x4*)(Ip + (size_t)(c + 1) * 4096 + 8 * s4); } }
#pragma unroll
        for (int s4 = 0; s4 < 4; ++s4) { const bf16x8 bb = *(const LAS bf16x8*)(Sc + (n0 + r32) * CP + 32 * s4 + 16 * hh); acc = __builtin_amdgcn_mfma_f32_32x32x16_bf16(a[s4], bb, acc, 0, 0, 0); }
        if (upd) store_t(Sn, acc, m0, n0, r32, hh, 1.f);
        else { float* yp = Y + ((size_t)b * SEQ + c * 64 + m0 + 4 * hh) * 512 + h * 64 + n0 + r32;
#pragma unroll
            for (int r = 0; r < 16; ++r) yp[(size_t)((r & 3) + 8 * (r >> 2)) * 512] = acc[r]; }
        __syncthreads();
    }
}

__device__ __forceinline__ void phase_odd_main(Frame& F, int layer) {
    KARGS;
    const bf16* P = WSP(bf16, WS_PROJ); bf16* MIX = WSP(bf16, WS_MIX); const float* DC = WSP(float, WS_DCUM);
    const int tid = F.tid, lane = F.lane, wave = F.wave, r32 = lane & 31, hh = lane >> 5;
    const float LOG2E = 1.4426950408889634f, CS = 0.125f * LOG2E;
    const int srow = tid >> 3, sch = tid & 7;
    for (int bhs = F.bid; bhs < 16; bhs += F.G) rwkv_scan(F, bhs);
    unsigned* ctr = (unsigned*)F.ctl + CW_WORK + 64 * layer;
    for (;;) {
        {
            __syncthreads();
            if (tid == 0) F.MISC[16] = atomicAdd(ctr, 1u);
            __syncthreads();
            const int u = (int)F.MISC[16];
            if (u >= 512) break;
            const int bh = u & 15, qb = 31 - (u >> 4), b = bh >> 3, h = bh & 7;
            const bf16* base = P + (size_t)b * SEQ * ODD_N; const float* dc = DC + (size_t)bh * SEQ;
            const int q0 = 256 * qb + 32 * wave, myq = q0 + r32;
            bf16x8 qf[4];
#pragma unroll
            for (int d0 = 0; d0 < 4; ++d0) qf[d0] = *(const bf16x8*)(base + (size_t)myq * ODD_N + h * 64 + 16 * d0 + 8 * hh);
            const float dq = dc[myq] * LOG2E;
            float m = -INFINITY, lsum = 0.f;
            f32x16 o[2];
#pragma unroll
            for (int r = 0; r < 16; ++r) { o[0][r] = 0.f; o[1][r] = 0.f; }
            const int NT = 4 * qb + 4;
            v4u kreg = *(const v4u*)(base + (size_t)srow * ODD_N + 512 + h * 64 + sch * 8);
            v4u vreg = *(const v4u*)(base + (size_t)srow * ODD_N + 1024 + h * 64 + sch * 8);
            float dreg = tid < 64 ? dc[tid] * LOG2E : 0.f;
            *(LAS v4u*)(F.lds + srow * FX_KROW + sch * 16) = kreg; *(LAS v4u*)(F.lds + FX_KB + srow * FX_VROW + sch * 16) = vreg;
            if (tid < 64) *(LAS float*)(F.lds + FX_KB + FX_VB + tid * 4) = dreg;
            __syncthreads();
            for (int j = 0; j < NT; ++j) {
                const int cur = (j & 1) * FX_BUF, nxt = ((j + 1) & 1) * FX_BUF;
                if (j + 1 < NT) { const size_t krow = (size_t)(64 * (j + 1) + srow) * ODD_N;
                    kreg = *(const v4u*)(base + krow + 512 + h * 64 + sch * 8); vreg = *(const v4u*)(base + krow + 1024 + h * 64 + sch * 8);
                    if (tid < 64) dreg = dc[64 * (j + 1) + tid] * LOG2E; }
                if (64 * j <= q0 + 31) {
                    const LAS unsigned char* Kb = F.lds + cur; const LAS unsigned char* Vb = F.lds + cur + FX_KB; const LAS float* dkb = (const LAS float*)(F.lds + cur + FX_KB + FX_VB);
                    f32x16 p0, p1;
#pragma unroll
                    for (int r = 0; r < 16; ++r) { p0[r] = 0.f; p1[r] = 0.f; }
#pragma unroll
                    for (int d0 = 0; d0 < 4; ++d0) {
                        const bf16x8 a0 = *(const LAS bf16x8*)(Kb + r32 * FX_KROW + 32 * d0 + 16 * hh);
                        const bf16x8 a1 = *(const LAS bf16x8*)(Kb + (r32 + 32) * FX_KROW + 32 * d0 + 16 * hh);
                        p0 = __builtin_amdgcn_mfma_f32_32x32x16_bf16(a0, qf[d0], p0, 0, 0, 0);
                        p1 = __builtin_amdgcn_mfma_f32_32x32x16_bf16(a1, qf[d0], p1, 0, 0, 0);
                    }
                    const bool diag = 64 * j + 63 > q0;
                    float tmax = -INFINITY;
#pragma unroll
                    for (int g = 0; g < 4; ++g) {
                        const f32x4 dk0 = *(const LAS f32x4*)(dkb + 8 * g + 4 * hh), dk1 = *(const LAS f32x4*)(dkb + 32 + 8 * g + 4 * hh);
#pragma unroll
                        for (int i = 0; i < 4; ++i) {
                            float z0 = p0[4 * g + i] * CS + (dq - dk0[i]), z1 = p1[4 * g + i] * CS + (dq - dk1[i]);
                            if (diag) { const int key = 64 * j + 8 * g + 4 * hh + i; if (key > myq) z0 = -INFINITY; if (key + 32 > myq) z1 = -INFINITY; }
                            p0[4 * g + i] = z0; p1[4 * g + i] = z1; tmax = fmaxf(tmax, fmaxf(z0, z1)); }
                    }
                    tmax = fmaxf(tmax, __shfl_xor(tmax, 32));
                    const float mn = fmaxf(m, tmax); const float corr = __builtin_amdgcn_exp2f(m - mn); m = mn;
                    float ps = 0.f;
#pragma unroll
                    for (int r = 0; r < 16; ++r) { p0[r] = __builtin_amdgcn_exp2f(p0[r] - mn); p1[r] = __builtin_amdgcn_exp2f(p1[r] - mn); ps += p0[r] + p1[r]; }
                    lsum = lsum * corr + ps;
#pragma unroll
                    for (int r = 0; r < 16; ++r) { o[0][r] *= corr; o[1][r] *= corr; }
                    bf16x8 pf[4];
#pragma unroll
                    for (int s4 = 0; s4 < 4; ++s4) {
                        v4u w;
                        if (s4 < 2) { w.x = pk2(p0[8 * s4 + 0], p0[8 * s4 + 1]); w.y = pk2(p0[8 * s4 + 2], p0[8 * s4 + 3]); w.z = pk2(p0[8 * s4 + 4], p0[8 * s4 + 5]); w.w = pk2(p0[8 * s4 + 6], p0[8 * s4 + 7]); }
                        else { const int sp = s4 - 2; w.x = pk2(p1[8 * sp + 0], p1[8 * sp + 1]); w.y = pk2(p1[8 * sp + 2], p1[8 * sp + 3]); w.z = pk2(p1[8 * sp + 4], p1[8 * sp + 5]); w.w = pk2(p1[8 * sp + 6], p1[8 * sp + 7]); }
                        pf[s4] = __builtin_bit_cast(bf16x8, w);
                    }
                    const int gi = lane >> 4, li = lane & 15;
                    const LAS unsigned char* vbase = Vb + (4 * (gi >> 1) + (li >> 2)) * FX_VROW + (16 * (gi & 1) + 4 * (li & 3)) * 2;
#pragma unroll
                    for (int d0 = 0; d0 < 2; ++d0)
#pragma unroll
                        for (int s4 = 0; s4 < 4; ++s4) {
                            const s16x4 lo = __builtin_bit_cast(s16x4, __builtin_amdgcn_ds_read_tr16_b64_v4i16((LAS s16x4*)(vbase + (16 * s4) * FX_VROW + 64 * d0)));
                            const s16x4 hi = __builtin_bit_cast(s16x4, __builtin_amdgcn_ds_read_tr16_b64_v4i16((LAS s16x4*)(vbase + (16 * s4 + 8) * FX_VROW + 64 * d0)));
                            const bf16x8 vf = (bf16x8){lo[0], lo[1], lo[2], lo[3], hi[0], hi[1], hi[2], hi[3]};
                            o[d0] = __builtin_amdgcn_mfma_f32_32x32x16_bf16(vf, pf[s4], o[d0], 0, 0, 0);
                        }
                }
                if (j + 1 < NT) {
                    *(LAS v4u*)(F.lds + nxt + srow * FX_KROW + sch * 16) = kreg; *(LAS v4u*)(F.lds + nxt + FX_KB + srow * FX_VROW + sch * 16) = vreg;
                    if (tid < 64) *(LAS float*)(F.lds + nxt + FX_KB + FX_VB + tid * 4) = dreg;
                }
                __syncthreads();
            }
            const float l = lsum + __shfl_xor(lsum, 32); const float inv = 1.f / l;
            const bf16* gp = base + (size_t)myq * ODD_N + 1536 + h * 64; bf16* op = MIX + ((size_t)b * SEQ + myq) * D + h * 64;
#pragma unroll
            for (int d0 = 0; d0 < 2; ++d0)
#pragma unroll
                for (int g = 0; g < 4; ++g) { const int db = 32 * d0 + 8 * g + 4 * hh; const v2u gw = *(const v2u*)(gp + db);
                    const float g0 = sigmoidf_(bflo(gw.x)), g1 = sigmoidf_(bfhi(gw.x)), g2 = sigmoidf_(bflo(gw.y)), g3 = sigmoidf_(bfhi(gw.y));
                    v2u ow; ow.x = pk2(o[d0][4 * g + 0] * inv * g0, o[d0][4 * g + 1] * inv * g1); ow.y = pk2(o[d0][4 * g + 2] * inv * g2, o[d0][4 * g + 3] * inv * g3);
                    *(v2u*)(op + db) = ow; }
        }
    }
}

__device__ __forceinline__ void phase_rwkv_post(Frame& F, int layer) {
    KARGS;
    const int jj = layer >> 1, ch = F.tid;
    const float* R = WSP(float, WS_RW); const float* K = WSP(float, WS_RW + 2 * RW_SLOT); const float* V = WSP(float, WS_RW + 3 * RW_SLOT);
    const float* Gt = WSP(float, WS_RW + 6 * RW_SLOT); const float* Y = WSP(float, WS_RW + 7 * RW_SLOT);
    bf16* MIX = WSP(bf16, WS_MIX);
    const float lw = IN(24)[jj * 512 + ch], lb = IN(25)[jj * 512 + ch], rk = IN(23)[jj * 512 + ch];
    for (int tg = F.bid; tg < T; tg += F.G) {
        const size_t o = (size_t)tg * 512 + ch;
        const float y = Y[o]; const float mu = wave_sum(y) * (1.f / 64.f); const float dlt = y - mu; const float var = wave_sum(dlt * dlt) * (1.f / 64.f);
        const float yn = dlt * rsqrtf(var + GN_EPS) * lw + lb;
        const float v = V[o]; const float bonus = wave_sum(R[o] * K[o] * rk) * v;
        MIX[(size_t)tg * D + 512 + ch] = (bf16)f2bf((yn + bonus) * Gt[o]);
    }
}

#define BUBBLE(x_, V_) do { float bx_ = (x_); _Pragma("unroll") for (int p_ = 0; p_ < 16; ++p_) { const float hi_ = fmaxf(bx_, V_[p_]); bx_ = fminf(bx_, V_[p_]); V_[p_] = hi_; } } while (0)
__device__ __forceinline__ float pack_low(float v, unsigned bits, unsigned mask) { return __builtin_bit_cast(float, (__builtin_bit_cast(unsigned, v) & ~mask) | bits); }
__device__ __forceinline__ void phase_peer_topk(Frame& F, int layer) {
    KARGS;
    const bf16* Q = WSP(bf16, WS_Q); const bf16* KEYS = WSP(bf16, WS_KEYS) + (size_t)layer * 2 * 16384;
    int* IDX = WSP(int, WS_IDX); float* GATE = WSP(float, WS_GATE);
    LAS float* sc = (LAS float*)(F.lds + F.wave * 16512);
    LAS unsigned* li = (LAS unsigned*)sc;
    const int lane = F.lane, fr = lane & 15, fq = lane >> 4;
    const int gw = F.bid * NWAVES + F.wave, NGW = F.G * NWAVES;
    for (int it = gw; it < (T / 32) * 8; it += NGW) {
        const int tile = it >> 3, h = it & 7, t0 = tile * 32;
        float v1[16], v2[16];
#pragma unroll
        for (int half = 0; half < 2; ++half) {
            f32x4 acc[2][8];
#pragma unroll
            for (int rt = 0; rt < 2; ++rt)
#pragma unroll
                for (int ct = 0; ct < 8; ++ct) acc[rt][ct] = (f32x4){0.f, 0.f, 0.f, 0.f};
            const bf16* kb = KEYS + (size_t)half * 16384;
#pragma unroll 1
            for (int ks = 0; ks < 4; ++ks) {
                bf16x8 a[2];
#pragma unroll
                for (int rt = 0; rt < 2; ++rt) a[rt] = *(const bf16x8*)(Q + (size_t)(t0 + rt * 16 + fr) * 2048 + h * 256 + half * 128 + ks * 32 + 8 * fq);
#pragma unroll
                for (int ct = 0; ct < 8; ++ct) { const bf16x8 bb = *(const bf16x8*)(kb + (size_t)(ct * 16 + fr) * 128 + ks * 32 + 8 * fq);
#pragma unroll
                    for (int rt = 0; rt < 2; ++rt) acc[rt][ct] = __builtin_amdgcn_mfma_f32_16x16x32_bf16(a[rt], bb, acc[rt][ct], 0, 0, 0); }
            }
#pragma unroll
            for (int rt = 0; rt < 2; ++rt)
#pragma unroll
                for (int ct = 0; ct < 8; ++ct)
#pragma unroll
                    for (int r = 0; r < 4; ++r) sc[(rt * 16 + 4 * fq + r) * 129 + ct * 16 + fr] = pack_low(acc[rt][ct][r], (unsigned)(ct * 16 + fr), 0x7Fu);
            LDS_WAIT(); asm volatile("" ::: "memory");
            float vv[16];
#pragma unroll
            for (int p = 0; p < 16; ++p) vv[p] = -INFINITY;
            if (lane < 32) { const LAS float* row = sc + lane * 129;
#pragma unroll 4
                for (int n = 0; n < 128; ++n) { const float x = row[n]; BUBBLE(x, vv); } }
            LDS_WAIT(); asm volatile("" ::: "memory");
#pragma unroll
            for (int p = 0; p < 16; ++p) { if (half == 0) v1[p] = vv[p]; else v2[p] = vv[p]; }
        }
        if (lane < 32) {
#pragma unroll
            for (int p = 0; p < 16; ++p) { li[lane * 33 + p] = __builtin_bit_cast(unsigned, v1[p]) & 0x7Fu; li[lane * 33 + 16 + p] = __builtin_bit_cast(unsigned, v2[p]) & 0x7Fu; }
            float ts[16];
#pragma unroll
            for (int p = 0; p < 16; ++p) ts[p] = -INFINITY;
#pragma unroll
            for (int a = 0; a < 16; ++a)
#pragma unroll
                for (int bq = 0; bq < 16; ++bq) if ((a + 1) * (bq + 1) <= 16) { const float x = pack_low(v1[a] + v2[bq], (unsigned)(a * 16 + bq), 0xFFu); BUBBLE(x, ts); }
            LDS_WAIT(); asm volatile("" ::: "memory");
            float e[16], sum = 0.f;
#pragma unroll
            for (int p = 0; p < 16; ++p) { e[p] = expf(ts[p] - ts[0]); sum += e[p]; }
            const float inv = 1.f / sum;
            int* ip = IDX + (size_t)(t0 + lane) * 128 + h * 16; float* gp = GATE + (size_t)(t0 + lane) * 128 + h * 16;
#pragma unroll
            for (int p = 0; p < 16; ++p) { const unsigned ab = __builtin_bit_cast(unsigned, ts[p]) & 0xFFu;
                ip[p] = (int)(li[lane * 33 + (ab >> 4)] * 128u + li[lane * 33 + 16 + (ab & 15u)]); gp[p] = e[p] * inv; }
        }
        LDS_WAIT(); asm volatile("" ::: "memory");
    }
}

__device__ __forceinline__ void unpack8(float (&o)[8], const v4u w) {
    o[0] = bflo(w.x); o[1] = bfhi(w.x); o[2] = bflo(w.y); o[3] = bfhi(w.y); o[4] = bflo(w.z); o[5] = bfhi(w.z); o[6] = bflo(w.w); o[7] = bfhi(w.w);
}
__device__ __forceinline__ void phase_peer_gather(Frame& F, int layer, bool dummy) {
    KARGS;
    const bf16* H = WSP(bf16, WS_H); const int* IDX = WSP(int, WS_IDX); const float* GATE = WSP(float, WS_GATE);
    const bf16* U = WSP(bf16, WS_PU) + (size_t)layer * NEXP * 1024; const bf16* Vt = WSP(bf16, WS_PV) + (size_t)layer * NEXP * 1024;
    const float* g2 = WSP(float, WS_MOD) + (size_t)layer * 2 * 6144 + 5120;
    const float* X = OUTP; float* XO = dummy ? WSP(float, WS_PROJ) : OUTP;
    const int lane = F.lane, gw = F.bid * NWAVES + F.wave, NGW = F.G * NWAVES;
    for (int tg = gw; tg < T; tg += NGW) {
        const int b = tg >= SEQ ? 1 : 0;
        float x0[8], x1[8];
        unpack8(x0, *(const v4u*)(H + (size_t)tg * D + 8 * lane)); unpack8(x1, *(const v4u*)(H + (size_t)tg * D + 512 + 8 * lane));
        const int id0 = IDX[(size_t)tg * 128 + lane], id1 = IDX[(size_t)tg * 128 + 64 + lane];
        const float gt0 = GATE[(size_t)tg * 128 + lane], gt1 = GATE[(size_t)tg * 128 + 64 + lane];
        float a0[8], a1[8];
#pragma unroll
        for (int i = 0; i < 8; ++i) { a0[i] = 0.f; a1[i] = 0.f; }
        for (int e0 = 0; e0 < 128; e0 += 8) {
            int idx[8]; float d[8];
            v4u ua[8], ub[8];
#pragma unroll
            for (int q = 0; q < 8; ++q) { const int e = e0 + q; idx[q] = __builtin_amdgcn_readlane(e0 < 64 ? id0 : id1, e & 63);
                const bf16* up = U + (size_t)idx[q] * 1024 + 8 * lane; ua[q] = *(const v4u*)up; ub[q] = *(const v4u*)(up + 512); }
#pragma unroll
            for (int q = 0; q < 8; ++q) { float u0[8], u1[8]; unpack8(u0, ua[q]); unpack8(u1, ub[q]); float s = 0.f;
#pragma unroll
                for (int i = 0; i < 8; ++i) s += u0[i] * x0[i] + u1[i] * x1[i];
                d[q] = s; }
#pragma unroll
            for (int o = 1; o < 64; o <<= 1) {
#pragma unroll
                for (int q = 0; q < 8; ++q) d[q] += __shfl_xor(d[q], o); }
#pragma unroll
            for (int q = 0; q < 8; ++q) { const int e = e0 + q; const bf16* vp = Vt + (size_t)idx[q] * 1024 + 8 * lane; ua[q] = *(const v4u*)vp; ub[q] = *(const v4u*)(vp + 512);
                d[q] = gelu_erf(d[q]) * rl(e0 < 64 ? gt0 : gt1, e & 63); }
#pragma unroll
            for (int q = 0; q < 8; ++q) { float v0[8], v1[8]; unpack8(v0, ua[q]); unpack8(v1, ub[q]);
#pragma unroll
                for (int i = 0; i < 8; ++i) { a0[i] += v0[i] * d[q]; a1[i] += v1[i] * d[q]; } }
        }
        const float* xr = X + (size_t)tg * D + 8 * lane; float* xo = XO + (size_t)tg * D + 8 * lane; const float* gg = g2 + b * 6144 + 8 * lane;
#pragma unroll
        for (int hh = 0; hh < 2; ++hh) {
#pragma unroll
            for (int c = 0; c < 2; ++c) { const int off = hh * 512 + c * 4; const f32x4 g4 = *(const f32x4*)(gg + off); const f32x4 xv = *(const f32x4*)(xr + off);
                f32x4 av; if (hh == 0) av = (f32x4){a0[c * 4], a0[c * 4 + 1], a0[c * 4 + 2], a0[c * 4 + 3]}; else av = (f32x4){a1[c * 4], a1[c * 4 + 1], a1[c * 4 + 2], a1[c * 4 + 3]};
                *(f32x4*)(xo + off) = xv + g4 * av; } }
    }
}

__device__ __forceinline__ void phase_final(Frame& F) {
    KARGS;
    float* X = OUTP; const float* gain = IN(31);
    const int lane = F.lane, gw = F.bid * NWAVES + F.wave, NGW = F.G * NWAVES;
    f32x4 gn[4];
#pragma unroll
    for (int j = 0; j < 4; ++j) gn[j] = *(const f32x4*)(gain + 256 * j + 4 * lane);
    for (int row = gw; row < T; row += NGW) {
        float* xr = X + (size_t)row * D + 4 * lane;
        f32x4 v[4]; float ss = 0.f;
#pragma unroll
        for (int j = 0; j < 4; ++j) { v[j] = *(const f32x4*)(xr + 256 * j); ss += (v[j].x * v[j].x + v[j].y * v[j].y) + (v[j].z * v[j].z + v[j].w * v[j].w); }
        const float rstd = rsqrtf(wave_sum(ss) * (1.f / D) + NORM_EPS);
#pragma unroll
        for (int j = 0; j < 4; ++j) *(f32x4*)(xr + 256 * j) = v[j] * rstd * gn[j];
    }
}

#ifndef PROBE_DUP
#define PROBE_DUP 0
#endif
#ifndef PH_MASK
#define PH_MASK 0xFFFF
#endif
#define PH_EN(k) ((PH_MASK >> (k)) & 1)
constexpr int NPH = 46;
__host__ __device__ inline bool phase_skipped(int p) { if (p == 0 || p == NPH - 1) return false; const int layer = (p - 1) / 11, step = (p - 1) % 11; return (layer & 1) == 0 && (step == 3 || step == 4 || step == 5); }
__global__ void __launch_bounds__(NTHR, 2) mk_fwd(Args args) {
    extern __shared__ __attribute__((aligned(16))) unsigned char lds[];
    Frame F;
    F.lds = (LAS unsigned char*)lds;
    F.MISC = (volatile LAS unsigned*)(F.lds + MISC_OFF);
    F.tid = threadIdx.x; F.lane = F.tid & 63; F.wave = __builtin_amdgcn_readfirstlane(F.tid >> 6);
    F.G = gridDim.x; F.bid = blockIdx.x;
    F.ctl = (gu32*)(args.ws + WS_CTL);
    for (int u = F.tid; u < (LDS_BYTES - MISC_OFF) / 4; u += NTHR) ((LAS unsigned*)(F.lds + MISC_OFF))[u] = 0u;
    __syncthreads();
    XcdBarrier bar; bar.bar = (unsigned*)(F.ctl + CW_BAR); bar.x = 0; bar.st = nullptr;
    const int lo = args.ph_lo, hi = args.ph_hi;
    if (hi - lo > 1) bar = xcd_barrier_post((unsigned*)(F.ctl + CW_BAR), F.MISC + 8);
    bool ran = false;
    for (int p = lo; p < hi; ++p) {
        if (phase_skipped(p)) continue;
        if (ran) xcd_barrier(bar);
        ran = true;
        { int t_ = threadIdx.x; asm volatile("" : "+v"(t_)); F.tid = t_; F.lane = t_ & 63; F.wave = __builtin_amdgcn_readfirstlane(t_ >> 6);
          int b_ = blockIdx.x, g_ = gridDim.x; asm volatile("" : "+s"(b_), "+s"(g_)); F.bid = b_; F.G = g_; }
        if (p == 0) { if (PH_EN(0)) phase_prologue(F); continue; }
        if (p == NPH - 1) { if (PH_EN(1)) phase_final(F); continue; }
        const int layer = (p - 1) / 11, step = (p - 1) % 11; const bool odd = layer & 1;
        KARGS;
        if (step == 0 || step == 7) { if (PH_EN(2)) phase_norm(F, layer, step == 7 ? 1 : 0); }
        else if (step == 1 || step == 8) { if (PH_EN(3)) {
            const int N = step == 8 ? 2048 : (odd ? ODD_N : EVEN_IN);
            const bf16* Bt = step == 8 ? WSP(bf16, WS_WQ + (size_t)layer * 4 * MiB) : WSP(bf16, WS_WIN + (size_t)layer * 8 * MiB);
            bf16* O = step == 8 ? WSP(bf16, WS_Q) : WSP(bf16, WS_PROJ);
            pg8::Gemm g{WSP(bf16, WS_H), Bt, T, N, D}; pg8::StaticOrder S; S.init(T, N, F.G, F.bid);
            pg8::EpiBf16<0> E{O, N, nullptr, 0, 0, 1.f};
            pg8::gemm_phase<pg8::EpiBf16<0>, pg8::StaticOrder, PG8_ALIGN, PG8_SP2>(F.lds + RING_OFF, g, S, E);
        } }
        else if (step == 2) { if (odd) { if (PH_EN(4)) phase_odd_prep(F, layer); } else { if (PH_EN(5)) {
#if (PROBE_DUP >> 5) & 1
            phase_even_mixer(F, layer);
#endif
            phase_even_mixer(F, layer); } } }
        else if (step == 3) { if (PH_EN(11)) phase_rwkv_chunk(F, layer); }
        else if (step == 4) { if (PH_EN(6)) phase_odd_main(F, layer); }
        else if (step == 5) { if (PH_EN(7)) phase_rwkv_post(F, layer); }
        else if (step == 6) { if (PH_EN(8)) {
            pg8::Gemm g{WSP(bf16, WS_MIX), WSP(bf16, WS_WOUT + (size_t)layer * 2 * MiB), T, D, D}; pg8::StaticOrder S; S.init(T, D, F.G, F.bid);
            pg8::EpiResid E{layer == 0 ? IN(0) : OUTP, OUTP, WSP(float, WS_MOD) + (size_t)layer * 2 * 6144 + 2048, 6144};
            pg8::gemm_phase<pg8::EpiResid, pg8::StaticOrder, PG8_ALIGN, PG8_SP2>(F.lds + RING_OFF, g, S, E);
        } }
        else if (step == 9) { if (PH_EN(9)) {
#if (PROBE_DUP >> 9) & 1
            phase_peer_topk(F, layer);
#endif
            phase_peer_topk(F, layer); } }
        else { if (PH_EN(10)) {
#if (PROBE_DUP >> 10) & 1
            phase_peer_gather(F, layer, true);
#endif
            phase_peer_gather(F, layer, false); } }
    }
}

extern "C" void kernel_launch(void* const* d_in, const int* in_sizes, int n_in, void* d_out, int out_size, void* d_ws, size_t ws_size, hipStream_t stream) {
    static int grid = 0;
    if (grid == 0) {
        if (n_in != 32 || in_sizes[0] != T * D || out_size != T * D || ws_size < WS_END) { fprintf(stderr, "kernel_launch: unexpected shapes (n_in %d, in0 %d, out %d, ws %zu < %zu); nothing launched\n", n_in, n_in > 0 ? in_sizes[0] : -1, out_size, ws_size, (size_t)WS_END); grid = -1; return; }
        int dev = 0, cus = 0, per_cu = 0;
        if (hipGetDevice(&dev) != hipSuccess || hipDeviceGetAttribute(&cus, hipDeviceAttributeMultiprocessorCount, dev) != hipSuccess) { grid = -1; return; }
        if (hipFuncSetAttribute((const void*)mk_fwd, hipFuncAttributeMaxDynamicSharedMemorySize, LDS_BYTES) != hipSuccess) { fprintf(stderr, "kernel_launch: hipFuncSetAttribute failed\n"); grid = -1; return; }
        if (hipOccupancyMaxActiveBlocksPerMultiprocessor(&per_cu, (const void*)mk_fwd, NTHR, LDS_BYTES) != hipSuccess || per_cu < 1) fprintf(stderr, "kernel_launch: occupancy query reports %d workgroups per CU\n", per_cu);
        (void)hipGetLastError();
        grid = cus;
    }
    if (grid < 0) return;
    if (hipMemsetAsync((char*)d_ws + WS_CTL, 0, CTL_ZERO_BYTES, stream) != hipSuccess) { fprintf(stderr, "kernel_launch: hipMemsetAsync failed\n"); return; }
    Args a{};
    for (int i = 0; i < 32; ++i) a.in[i] = (const float*)d_in[i];
    a.out = (float*)d_out; a.ws = (unsigned char*)d_ws;
#if MK_ONE_LAUNCH
    a.ph_lo = 0; a.ph_hi = NPH;
    hipLaunchKernelGGL(mk_fwd, dim3(grid), dim3(NTHR), LDS_BYTES, stream, a);
#else
    for (int p = 0; p < NPH; ++p) { if (phase_skipped(p)) continue; a.ph_lo = p; a.ph_hi = p + 1;
        hipLaunchKernelGGL(mk_fwd, dim3(grid), dim3(NTHR), LDS_BYTES, stream, a); }
#endif
    const hipError_t le = hipPeekAtLastError();
    if (le != hipSuccess) fprintf(stderr, "kernel_launch: launch failed: %s\n", hipGetErrorName(le));
}
```

```cpp
#include <hip/hip_runtime.h>
#include <cstdio>
#include <cstdint>
namespace pg8 {
#define PG8_LAS __attribute__((address_space(3)))
typedef unsigned short bf16_t;
typedef short bf16x8 __attribute__((ext_vector_type(8)));
typedef float f32x4 __attribute__((ext_vector_type(4)));
typedef unsigned u32x4 __attribute__((ext_vector_type(4)));
constexpr int BM = 256, BK = 64, HALF = 128, HTB = HALF * BK * 2  , STAGE_BYTES = 8 * HTB, NXCD = 8, WGM = 8;

__host__ __device__ __forceinline__ int lds_byte(int r, int c) { const int st = (r >> 4) * 2 + (c >> 5), rr = r & 15, cc = c & 31, ob = rr * 64 + cc * 2; return st * 1024 + (ob ^ (((ob >> 9) & 1) << 5)); }
__host__ __device__ __forceinline__ void stage_rc(int b, int& R, int& C) { const int st = b / 1024, sb = b % 1024, swz = sb ^ (((sb >> 9) & 1) << 5); R = (st >> 1) * 16 + swz / 64; C = (st & 1) * 32 + (swz % 64) / 2; }
__host__ __device__ __forceinline__ int perm32(int rho) { const int n = rho >> 4, i = rho & 15; return 8 * (i >> 2) + 4 * n + (i & 3); }

struct Unit { int pm, pn; };
struct Gemm { const bf16_t* A; const bf16_t* Bt; int M, N, K; };

struct StaticOrder {
    int nM, nN, nwg, G, c;
    __host__ __device__ void init(int M, int N, int G_, int c_) { nM = M / BM; nN = N / BM; nwg = nM * nN; G = G_; c = c_; }
    __host__ __device__ bool next(int i, Unit& u) const {
        const long L = (long)i * G + c; if (L >= nwg) return false;
        int wgid = (int)L; { const int q = nwg / NXCD, r = nwg % NXCD, xcd = wgid % NXCD, off = wgid / NXCD; wgid = (xcd < r ? xcd * (q + 1) : r * (q + 1) + (xcd - r) * q) + off; }
        const int nig = WGM * nN, gid = wgid / nig, fm = gid * WGM, gsz = (nM - fm) < WGM ? (nM - fm) : WGM;
        u.pm = fm + ((wgid % nig) % gsz); u.pn = (wgid % nig) / gsz; return true;
    }
    __device__ __forceinline__ void a_ready(const Unit&) const {}
    __device__ __forceinline__ void done(const Unit&) const {}
};

__device__ __forceinline__ unsigned cvt_pk_bf16(float lo, float hi) { unsigned r; asm volatile("v_cvt_pk_bf16_f32 %0, %1, %2" : "=v"(r) : "v"(lo), "v"(hi)); return r; }
typedef float f32x2 __attribute__((ext_vector_type(2)));
__device__ __forceinline__ f32x2 gelu_pk(f32x2 v) {
    const f32x2 av = __builtin_elementwise_abs(v), d = av * 0.2316418882f + 1.0f;
    f32x2 t; t.x = __builtin_amdgcn_rcpf(d.x); t.y = __builtin_amdgcn_rcpf(d.y);
    f32x2 q = t * 0.5307027145f + (-0.7265760135f); q = q * t + 0.7107068705f; q = q * t + (-0.142248368f); q = q * t + 0.127414796f; q = q * t;
    const f32x2 s = (v * v) * (-0.72134752044f);
    f32x2 e; e.x = __builtin_amdgcn_exp2f(s.x); e.y = __builtin_amdgcn_exp2f(s.y);
    const f32x2 m = v * (q * e), r = v - m;
    f32x2 o; o.x = v.x < 0.f ? m.x : r.x; o.y = v.y < 0.f ? m.y : r.y; return o;
}

template <int ACT  > struct EpiBf16 {
    static constexpr bool PERM = true, AFTER_DRAIN = false; static_assert(ACT == 0 || ACT == 1, "EpiBf16: ACT is 0 (none) or 1 (gelu_pk)");
    bf16_t* O; int ldc; const float* bias; int split_cols; size_t split_stride; float scale0;
    __device__ __forceinline__ void operator()(const f32x4 (&acc)[2][2][4][2], const Unit& u, int wr, int wc, int fr, int fq) const {
        const int row0 = u.pm * BM + wr * 64 + fr; int colt = u.pn * BM; bf16_t* base = O;
        float sc = 1.f; if (split_cols) { const int t = colt / split_cols; base += (size_t)t * split_stride; colt -= t * split_cols; if (t == 0) sc = scale0; }
        const int col0 = colt + wc * 32 + 8 * fq, bcol0 = u.pn * BM + wc * 32 + 8 * fq;
        f32x4 bv[2][2];
#pragma unroll
        for (int bj = 0; bj < 2; ++bj)
#pragma unroll
            for (int n = 0; n < 2; ++n) bv[bj][n] = bias ? *(const f32x4*)(bias + bcol0 + bj * HALF + 4 * n) : (f32x4){0.f, 0.f, 0.f, 0.f};
#pragma unroll
        for (int ai = 0; ai < 2; ++ai)
#pragma unroll
            for (int m = 0; m < 4; ++m) { bf16_t* rowp = base + (size_t)(row0 + ai * HALF + m * 16) * ldc + col0;
#pragma unroll
                for (int bj = 0; bj < 2; ++bj) { f32x4 v0 = acc[ai][bj][m][0] + bv[bj][0], v1 = acc[ai][bj][m][1] + bv[bj][1];
                    if (ACT == 1) { f32x2 a = gelu_pk((f32x2){v0[0], v0[1]}), b = gelu_pk((f32x2){v0[2], v0[3]}), c = gelu_pk((f32x2){v1[0], v1[1]}), d = gelu_pk((f32x2){v1[2], v1[3]});
                        v0 = (f32x4){a.x, a.y, b.x, b.y}; v1 = (f32x4){c.x, c.y, d.x, d.y}; }
                    v0 = v0 * sc; v1 = v1 * sc; u32x4 w; w.x = cvt_pk_bf16(v0[0], v0[1]); w.y = cvt_pk_bf16(v0[2], v0[3]); w.z = cvt_pk_bf16(v1[0], v1[1]); w.w = cvt_pk_bf16(v1[2], v1[3]);
                    *(u32x4*)(rowp + bj * HALF) = w; } }
    }
};
struct EpiResid {
    static constexpr bool PERM = false, AFTER_DRAIN = false;
    const float* base; float* out; const float* gate; int gstride;
    __device__ __forceinline__ void operator()(const f32x4 (&acc)[2][2][4][2], const Unit& u, int wr, int wc, int fr, int fq) const {
        const int row0 = u.pm * BM + wr * 64 + fr; const int col0 = u.pn * BM + wc * 32 + 4 * fq;
        const float* gp = gate + ((u.pm * BM) >= 8192 ? gstride : 0);
        f32x4 gv[2][2];
#pragma unroll
        for (int bj = 0; bj < 2; ++bj)
#pragma unroll
            for (int n = 0; n < 2; ++n) gv[bj][n] = *(const f32x4*)(gp + col0 + bj * HALF + n * 16);
#pragma unroll
        for (int ai = 0; ai < 2; ++ai)
#pragma unroll
            for (int m = 0; m < 4; ++m) { const size_t off = (size_t)(row0 + ai * HALF + m * 16) * 1024 + col0;
#pragma unroll
                for (int bj = 0; bj < 2; ++bj)
#pragma unroll
                    for (int n = 0; n < 2; ++n) { const f32x4 bs = *(const f32x4*)(base + off + bj * HALF + n * 16);
                        *(f32x4*)(out + off + bj * HALF + n * 16) = bs + gv[bj][n] * acc[ai][bj][m][n]; } }
    }
};
template <class Epi, class Sched, bool ALIGN_EPI = false, bool SP2 = false>
__device__ __forceinline__ void gemm_phase(PG8_LAS unsigned char* lds, const Gemm g, const Sched& S, const Epi& E) {
    int tid_l = threadIdx.x; asm volatile("" : "+v"(tid_l));
    const int tid = tid_l, wid = __builtin_amdgcn_readfirstlane(tid >> 6), lane = tid & 63, wr = wid >> 2, wc = wid & 3, fr = lane & 15, fq = lane >> 4;
    const int K = g.K, nt = K / BK;
    unsigned voffA[2], voffB[2];
#pragma unroll
    for (int i = 0; i < 2; ++i) { int R, C; stage_rc(tid * 16 + i * 8192, R, C); const int Rb = Epi::PERM ? ((R & ~31) + perm32(R & 31)) : R;
        voffA[i] = (unsigned)(R * K + C) * 2u; voffB[i] = (unsigned)(Rb * K + C) * 2u; }
    const size_t kstep = (size_t)(BK * 2);
    const size_t hstep = (size_t)HALF * K * 2;
    const size_t tstep = 2 * hstep;
    const unsigned ldsw = (unsigned)wid * 1024u;
    const int aoff = lds_byte(wr * 64 + fr, fq * 8), boff = lds_byte(wc * 32 + fr, fq * 8);
#define PG8_SA(b, h) (((b) * 2 + (h)) * HTB)
#define PG8_SB(b, h) ((4 + (b) * 2 + (h)) * HTB)
#define PG8_STAGE(bufoff, gbase, voff) do { _Pragma("unroll") for (int _i = 0; _i < 2; ++_i) \
        __builtin_amdgcn_global_load_lds((const unsigned*)((const char*)(gbase) + (voff)[_i]), (PG8_LAS unsigned*)(lds + (bufoff) + ldsw + _i * 8192), 16, 0, 0); } while (0)
#define PG8_LDA(dst, b, h) do { _Pragma("unroll") for (int m = 0; m < 4; ++m) _Pragma("unroll") for (int k = 0; k < 2; ++k) dst[m][k] = *(const PG8_LAS bf16x8*)(lds + PG8_SA(b, h) + aoff + m * 2048 + k * 1024); } while (0)
#define PG8_LDB(dst, b, h) do { _Pragma("unroll") for (int n = 0; n < 2; ++n) _Pragma("unroll") for (int k = 0; k < 2; ++k) dst[n][k] = *(const PG8_LAS bf16x8*)(lds + PG8_SB(b, h) + boff + n * 2048 + k * 1024); } while (0)
#define PG8_MMA(ai, bj, At, Bt) do { __builtin_amdgcn_s_setprio(1); _Pragma("unroll") for (int m = 0; m < 4; ++m) _Pragma("unroll") for (int n = 0; n < 2; ++n) _Pragma("unroll") for (int k = 0; k < 2; ++k) \
        acc[ai][bj][m][n] = __builtin_amdgcn_mfma_f32_16x16x32_bf16(Bt[n][k], At[m][k], acc[ai][bj][m][n], 0, 0, 0); __builtin_amdgcn_s_setprio(0); } while (0)
#define PG8_WAIT_V(n) asm volatile("s_waitcnt vmcnt(" #n ")" ::: "memory")
#define PG8_WAIT_L(n) asm volatile("s_waitcnt lgkmcnt(" #n ")" ::: "memory")
#define PG8_BAR __builtin_amdgcn_s_barrier()
#define PG8_SCHED __builtin_amdgcn_sched_barrier(0)
    Unit cur, nxt; int ui = 0;
    if (!S.next(0, cur)) return;
    f32x4 acc[2][2][4][2];
#pragma unroll
    for (int a = 0; a < 2; ++a)
#pragma unroll
        for (int b = 0; b < 2; ++b)
#pragma unroll
            for (int m = 0; m < 4; ++m)
#pragma unroll
                for (int n = 0; n < 2; ++n) acc[a][b][m][n] = (f32x4){0.f, 0.f, 0.f, 0.f};
    bf16x8 At[4][2], B0[2][2], B1[2][2];
    const char* cA = (const char*)g.A + (size_t)cur.pm * tstep; const char* cB = (const char*)g.Bt + (size_t)cur.pn * tstep;
    S.a_ready(cur);
    if constexpr (SP2) {
        PG8_STAGE(PG8_SB(0, 0), cB, voffB); PG8_STAGE(PG8_SB(0, 1), cB + hstep, voffB); PG8_STAGE(PG8_SA(0, 0), cA, voffA); PG8_STAGE(PG8_SA(0, 1), cA + hstep, voffA);
        if (wr == 1) PG8_BAR;
        PG8_WAIT_V(2); PG8_BAR;
        PG8_STAGE(PG8_SB(1, 0), cB + kstep, voffB); PG8_STAGE(PG8_SA(1, 0), cA + kstep, voffA); PG8_STAGE(PG8_SB(1, 1), cB + hstep + kstep, voffB);
        PG8_WAIT_V(6); PG8_BAR;
    } else {
        PG8_STAGE(PG8_SB(0, 0), cB, voffB); PG8_STAGE(PG8_SA(0, 0), cA, voffA); PG8_STAGE(PG8_SB(0, 1), cB + hstep, voffB); PG8_STAGE(PG8_SA(0, 1), cA + hstep, voffA);
        if (wr == 1) PG8_BAR;
        PG8_WAIT_V(4); PG8_BAR;
        PG8_STAGE(PG8_SB(1, 0), cB + kstep, voffB); PG8_STAGE(PG8_SA(1, 0), cA + kstep, voffA); PG8_STAGE(PG8_SB(1, 1), cB + hstep + kstep, voffB);
        PG8_WAIT_V(6); PG8_BAR;
    }
    for (;;) {
        const bool has_next = S.next(ui + 1, nxt);
        const char* nA = has_next ? (const char*)g.A + (size_t)nxt.pm * tstep : cA; const char* nB = has_next ? (const char*)g.Bt + (size_t)nxt.pn * tstep : cB;
        for (int t = 0; t < nt; t += 2) {
            const bool last = (t == nt - 2);
            const char* a1 = cA + (size_t)(t + 1) * kstep;
            const char* a2 = last ? nA : cA + (size_t)(t + 2) * kstep; const char* b2 = last ? nB : cB + (size_t)(t + 2) * kstep;
            const char* a3 = a2 + kstep; const char* b3 = b2 + kstep;
            if (last && has_next) S.a_ready(nxt);
            if constexpr (SP2) {
            PG8_LDB(B0, 0, 0); PG8_LDB(B1, 0, 1); PG8_SCHED; PG8_LDA(At, 0, 0); PG8_STAGE(PG8_SA(1, 1), a1 + hstep, voffA);
            PG8_WAIT_V(8); PG8_WAIT_L(0); PG8_BAR; PG8_MMA(0, 0, At, B0); PG8_MMA(0, 1, At, B1); PG8_BAR; PG8_SCHED;
            PG8_LDA(At, 0, 1); PG8_STAGE(PG8_SB(0, 0), b2, voffB); PG8_STAGE(PG8_SB(0, 1), b2 + hstep, voffB); PG8_STAGE(PG8_SA(0, 0), a2, voffA);
            PG8_WAIT_V(8); PG8_WAIT_L(0); PG8_BAR; PG8_MMA(1, 0, At, B0); PG8_MMA(1, 1, At, B1); PG8_BAR; PG8_SCHED;
            PG8_LDB(B0, 1, 0); PG8_LDB(B1, 1, 1); PG8_SCHED; PG8_LDA(At, 1, 0); PG8_STAGE(PG8_SA(0, 1), a2 + hstep, voffA);
            PG8_WAIT_V(8); PG8_WAIT_L(0); PG8_BAR; PG8_MMA(0, 0, At, B0); PG8_MMA(0, 1, At, B1); PG8_BAR; PG8_SCHED;
            PG8_LDA(At, 1, 1); PG8_STAGE(PG8_SB(1, 0), b3, voffB); PG8_STAGE(PG8_SB(1, 1), b3 + hstep, voffB); PG8_STAGE(PG8_SA(1, 0), a3, voffA);
            PG8_WAIT_V(8); PG8_WAIT_L(0); PG8_BAR; PG8_MMA(1, 0, At, B0); PG8_MMA(1, 1, At, B1); PG8_BAR; PG8_SCHED;
            } else {
            PG8_LDB(B0, 0, 0); PG8_SCHED; PG8_LDA(At, 0, 0); PG8_STAGE(PG8_SA(1, 1), a1 + hstep, voffA);
            PG8_WAIT_L(8); PG8_BAR; PG8_WAIT_L(0); PG8_MMA(0, 0, At, B0); PG8_BAR; PG8_SCHED;
            PG8_LDB(B1, 0, 1); PG8_STAGE(PG8_SB(0, 0), b2, voffB);
            PG8_BAR; PG8_WAIT_L(0); PG8_MMA(0, 1, At, B1); PG8_BAR;
            PG8_LDA(At, 0, 1); PG8_STAGE(PG8_SA(0, 0), a2, voffA);
            PG8_BAR; PG8_WAIT_L(0); PG8_MMA(1, 0, At, B0); PG8_BAR; PG8_SCHED;
            PG8_STAGE(PG8_SB(0, 1), b2 + hstep, voffB);
            PG8_WAIT_V(6); PG8_BAR; PG8_MMA(1, 1, At, B1); PG8_BAR;
            PG8_LDB(B0, 1, 0); PG8_SCHED; PG8_LDA(At, 1, 0); PG8_STAGE(PG8_SA(0, 1), a2 + hstep, voffA);
            PG8_WAIT_L(8); PG8_BAR; PG8_WAIT_L(0); PG8_MMA(0, 0, At, B0); PG8_BAR; PG8_SCHED;
            PG8_LDB(B1, 1, 1); PG8_STAGE(PG8_SB(1, 0), b3, voffB);
            PG8_BAR; PG8_WAIT_L(0); PG8_MMA(0, 1, At, B1); PG8_BAR;
            PG8_LDA(At, 1, 1); PG8_STAGE(PG8_SA(1, 0), a3, voffA);
            PG8_BAR; PG8_WAIT_L(0); PG8_MMA(1, 0, At, B0); PG8_BAR; PG8_SCHED;
            PG8_STAGE(PG8_SB(1, 1), b3 + hstep, voffB);
            PG8_WAIT_V(6); PG8_BAR; PG8_MMA(1, 1, At, B1); PG8_BAR;
            }
        }
        if constexpr (ALIGN_EPI) { if (wr == 0) PG8_BAR; }
        if constexpr (!Epi::AFTER_DRAIN) { E(acc, cur, wr, wc, fr, fq); S.done(cur); }
        if (!has_next) break;
#pragma unroll
        for (int a = 0; a < 2; ++a)
#pragma unroll
            for (int b = 0; b < 2; ++b)
#pragma unroll
                for (int m = 0; m < 4; ++m)
#pragma unroll
                    for (int n = 0; n < 2; ++n) acc[a][b][m][n] = (f32x4){0.f, 0.f, 0.f, 0.f};
        cur = nxt; cA = nA; cB = nB; ++ui;
        if constexpr (ALIGN_EPI) { if (wr == 1) PG8_BAR; }
    }
    PG8_WAIT_V(0);
    if constexpr (!ALIGN_EPI) { if (wr == 0) PG8_BAR; }
    PG8_BAR;
    if constexpr (Epi::AFTER_DRAIN) { E.fused(acc, cur, wr, wc, fr, fq, lds, wid, lane); S.done(cur); }
#undef PG8_SA
#undef PG8_SB
#undef PG8_STAGE
#undef PG8_LDA
#undef PG8_LDB
#undef PG8_MMA
#undef PG8_WAIT_V
#undef PG8_WAIT_L
#undef PG8_BAR
#undef PG8_SCHED
}
}
#ifndef PG8_SP2
#define PG8_SP2 true
#endif
#ifndef PG8_ALIGN
#define PG8_ALIGN true
#endif
#ifndef MK_ONE_LAUNCH
#define MK_ONE_LAUNCH 1
#endif

constexpr int NWAVES = 8, NTHR = NWAVES * 64;
constexpr int BATCH = 2, SEQ = 8192, D = 1024, T = BATCH * SEQ, DEPTH = 4;
constexpr int EVEN_IN = 2048, ODD_LD = 3848, ODD_N = 3840;
constexpr int NEXP = 16384;
constexpr float NORM_EPS = 1e-6f, GN_EPS = 64e-5f;

constexpr size_t MiB = 1u << 20;
constexpr size_t WS_CTL = 0, CTL_ZERO_BYTES = 1 * MiB;
constexpr size_t WS_MOD = 1 * MiB;
constexpr size_t WS_WF = WS_MOD + 256 * 1024;
constexpr size_t WS_KEYS = WS_MOD + 512 * 1024;
constexpr size_t WS_LOGF = 2 * MiB;
constexpr size_t WS_DCUM = 2 * MiB + 512 * 1024;
constexpr size_t WS_WIN = 4 * MiB;
constexpr size_t WS_WOUT = 36 * MiB;
constexpr size_t WS_WQ = 44 * MiB;
constexpr size_t WS_H = 64 * MiB;
constexpr size_t WS_MIX = 96 * MiB;
constexpr size_t WS_PROJ = 128 * MiB;
constexpr size_t WS_Q = 256 * MiB;
constexpr size_t WS_IDX = 320 * MiB;
constexpr size_t WS_GATE = 328 * MiB;
constexpr size_t WS_RW = 336 * MiB;
constexpr size_t RW_SLOT = 32 * MiB;
constexpr size_t WS_PU = WS_RW + 8 * RW_SLOT;
constexpr size_t WS_PV = WS_PU + 64 * MiB;
constexpr size_t WS_PS = WS_PV + 64 * MiB;
constexpr size_t WS_CG = WS_PS + 1 * MiB;
constexpr size_t WS_CQ = WS_CG + 16 * MiB;
constexpr size_t WS_CH = WS_CQ + 16 * MiB;
constexpr size_t WS_CY = WS_CH + 32 * MiB;
constexpr size_t WS_END = WS_CY + 32 * MiB;
constexpr int CW_WORK = 64;
constexpr int CW_WORK2 = 1024;
constexpr int CW_BAR = 4096;

constexpr int RING_OFF = 0, RING_BYTES = 131072;
constexpr int MISC_OFF = 159744;
constexpr int LDS_BYTES = 163840;

#define GAS __attribute__((address_space(1)))
#define LAS __attribute__((address_space(3)))
typedef unsigned short bf16;
typedef unsigned v4u __attribute__((ext_vector_type(4)));
typedef unsigned v2u __attribute__((ext_vector_type(2)));
typedef float f32x4 __attribute__((ext_vector_type(4)));
typedef short bf16x8 __attribute__((ext_vector_type(8)));
typedef GAS unsigned gu32;
#define LDS_WAIT() asm volatile("s_waitcnt lgkmcnt(0)" ::: "memory")
#define VM_WAIT() asm volatile("s_waitcnt vmcnt(0)" ::: "memory")
__device__ __forceinline__ unsigned f2bf(float f) { unsigned u = __builtin_bit_cast(unsigned, f); return (u + 0x7fffu + ((u >> 16) & 1u)) >> 16; }
__device__ __forceinline__ unsigned pk2(float lo, float hi) { return f2bf(lo) | (f2bf(hi) << 16); }
__device__ __forceinline__ float bf2f(bf16 v) { return __builtin_bit_cast(float, (unsigned)v << 16); }
__device__ __forceinline__ float bflo(unsigned w) { return __builtin_bit_cast(float, w << 16); }
__device__ __forceinline__ float bfhi(unsigned w) { return __builtin_bit_cast(float, w & 0xffff0000u); }
__device__ __forceinline__ float wave_sum(float v) {
#pragma unroll
    for (int o = 1; o < 64; o <<= 1) v += __shfl_xor(v, o);
    return v;
}
__device__ __forceinline__ float wave_max(float v) {
#pragma unroll
    for (int o = 1; o < 64; o <<= 1) v = fmaxf(v, __shfl_xor(v, o));
    return v;
}
__device__ __forceinline__ float rl(float x, int j) { return __builtin_bit_cast(float, __builtin_amdgcn_readlane(__builtin_bit_cast(int, x), j)); }
__device__ __forceinline__ float sigmoidf_(float x) { return 1.f / (1.f + expf(-x)); }
__device__ __forceinline__ float softplusf_(float x) { return fmaxf(x, 0.f) + log1pf(expf(-fabsf(x))); }
__device__ __forceinline__ float gelu_erf(float x) { return 0.5f * x * (1.f + erff(x * 0.70710678118654752f)); }

#define XB_TMO      128
#define XB_XCNT(j)  (256  + 64 * (j))
#define XB_XSUB(j)  (1280 + 64 * (j))
#define XB_XGEN(j)  (2304 + 64 * (j))
#define XB_TOP      3328
#define XB_TOPGEN   3392
#define XCD_BAR_WORDS 3456
#define XB_SPIN_CAP (1u << 18)

__device__ __forceinline__ unsigned xb_ld(unsigned* p)              { return __hip_atomic_load(p, __ATOMIC_RELAXED, __HIP_MEMORY_SCOPE_AGENT); }
__device__ __forceinline__ unsigned xb_add(unsigned* p, unsigned v) { return __hip_atomic_fetch_add(p, v, __ATOMIC_RELAXED, __HIP_MEMORY_SCOPE_AGENT); }
__device__ __forceinline__ unsigned xb_xcc_id() { return (unsigned)__builtin_amdgcn_s_getreg((3 << 11) | 20) & 0xFu; }
#define XB_SPIN(cond, bar) do { unsigned _sp = 0; while (cond) { __builtin_amdgcn_s_sleep(1); \
    if ((++_sp & 255u) == 0u) { if (xb_ld(&(bar)[XB_TMO])) break; if (_sp > XB_SPIN_CAP) { atomicAdd(&(bar)[XB_TMO], 1u); break; } } } } while (0)

struct XcdBarrier {
    unsigned* bar; unsigned x;
    volatile LAS unsigned* st;
};

__device__ __forceinline__ XcdBarrier xcd_barrier_post(unsigned* bar, volatile LAS unsigned* st) {
    XcdBarrier b; b.bar = bar; b.x = xb_xcc_id(); b.st = st;
    if (threadIdx.x == 0) (void)xb_add(&bar[XB_XCNT(b.x)], 1u);
    return b;
}
__device__ __forceinline__ void xcd_barrier_complete(unsigned* bar, unsigned x, unsigned& nloc, unsigned& nx) {
    const unsigned G = gridDim.x * gridDim.y * gridDim.z;
    unsigned sum, cnt, mine, sp = 0u;
    for (;;) {
        sum = 0u; cnt = 0u; mine = 0u;
#pragma unroll
        for (unsigned j = 0; j < 16; ++j) { const unsigned c = xb_ld(&bar[XB_XCNT(j)]); sum += c; cnt += (c > 0u) ? 1u : 0u; mine = (j == x) ? c : mine; }
        if (sum == G) break;
        __builtin_amdgcn_s_sleep(1);
        if ((++sp & 255u) == 0u) { if (xb_ld(&bar[XB_TMO])) break; if (sp > XB_SPIN_CAP) { atomicAdd(&bar[XB_TMO], 1u); break; } }
    }
    nloc = mine > 0u ? mine : 1u; nx = cnt > 0u ? cnt : 1u;
}

__device__ __forceinline__ void xcd_barrier(const XcdBarrier& b) {
    asm volatile("s_waitcnt vmcnt(0)" ::: "memory");
    __syncthreads();
    if (threadIdx.x == 0) {
        unsigned* bar = b.bar;
        __builtin_amdgcn_s_waitcnt(0);
        unsigned nloc = b.st[0], nx = b.st[1];
        if (nloc == 0u) { xcd_barrier_complete(bar, b.x, nloc, nx); b.st[0] = nloc; b.st[1] = nx; }
        const unsigned old = xb_add(&bar[XB_XSUB(b.x)], 1u);
        const unsigned gen = old / nloc;
        if (old + 1u == (gen + 1u) * nloc) {
            __builtin_amdgcn_fence(__ATOMIC_RELEASE, "agent");
            asm volatile("s_waitcnt vmcnt(0)" ::: "memory");
            const unsigned og = xb_add(&bar[XB_TOP], 1u);
            const unsigned tg = og / nx;
            if (og + 1u == (tg + 1u) * nx) xb_add(&bar[XB_TOPGEN], 1u);
            else XB_SPIN(xb_ld(&bar[XB_TOPGEN]) == tg, bar);
            __builtin_amdgcn_fence(__ATOMIC_ACQUIRE, "agent");
            xb_add(&bar[XB_XGEN(b.x)], 1u);
            asm volatile("s_waitcnt vmcnt(0)" ::: "memory");
        } else {
            XB_SPIN(xb_ld(&bar[XB_XGEN(b.x)]) == gen, bar);
            __builtin_amdgcn_fence(__ATOMIC_ACQUIRE, "agent");
            asm volatile("s_waitcnt vmcnt(0)" ::: "memory");
        }
    }
    __syncthreads();
}


struct Frame {
    LAS unsigned char* lds;
    volatile LAS unsigned* MISC;
    gu32* ctl;
    int tid, lane, wave, G, bid;
};
struct Args { const float* in[32]; float* out; unsigned char* ws; int ph_lo, ph_hi; };
#define CAS __attribute__((address_space(4)))
#define KARGS const CAS Args* ka_; { unsigned long long kp_ = (unsigned long long)__builtin_amdgcn_kernarg_segment_ptr(); asm volatile("" : "+s"(kp_)); ka_ = (const CAS Args*)kp_; } unsigned char* const ws_ = ka_->ws
#define IN(i) (ka_->in[i])
#define OUTP (ka_->out)
#define WSP(type, off) ((type*)(ws_ + (off)))

__device__ __forceinline__ void transpose_item(const float* W, int ldw, bf16* WT, int row_off, LAS float* scr, int item, int nblk, int lane) {
    const int kb = item / nblk, nb = item % nblk, k0 = 64 * kb, n0 = 32 * nb;
#pragma unroll 8
    for (int i = 0; i < 32; ++i) { const int kk = 2 * i + (lane >> 5); scr[kk * 33 + (lane & 31)] = W[(size_t)(k0 + kk) * ldw + n0 + (lane & 31)]; }
    LDS_WAIT(); asm volatile("" ::: "memory");
    const int c = lane & 7;
#pragma unroll
    for (int j = 0; j < 4; ++j) { const int n = (lane >> 3) + 8 * j; const LAS float* s = scr + (8 * c) * 33 + n;
        v4u o; o.x = pk2(s[0 * 33], s[1 * 33]); o.y = pk2(s[2 * 33], s[3 * 33]); o.z = pk2(s[4 * 33], s[5 * 33]); o.w = pk2(s[6 * 33], s[7 * 33]);
        *(v4u*)(WT + (size_t)(row_off + n0 + n) * 1024 + k0 + 8 * c) = o; }
    LDS_WAIT(); asm volatile("" ::: "memory");
}

__device__ __forceinline__ void phase_prologue(Frame& F) {
    KARGS;
    LAS float* cact = (LAS float*)F.lds;
    LAS float* part = cact + 2048;
    {   const float* c = IN(1);
        for (int i = F.tid; i < 2048; i += NTHR) { const float v = c[i]; cact[i] = v / (1.f + expf(-v)); } }
    __syncthreads();
    {
        const float* ada_w = IN(2); const float* ada_b = IN(3); float* MOD = WSP(float, WS_MOD);
        for (int it = F.bid; it < 384; it += F.G) {
            const int l = it / 96, j0 = (it % 96) * 64;
            const float* wp = ada_w + ((size_t)l * 1024 + F.wave * 128) * 6144 + j0 + F.lane;
            float a0 = 0.f, a1 = 0.f;
#pragma unroll 8
            for (int k = 0; k < 128; ++k) { const float w = wp[(size_t)k * 6144]; a0 += cact[F.wave * 128 + k] * w; a1 += cact[1024 + F.wave * 128 + k] * w; }
            part[(F.wave * 2 + 0) * 64 + F.lane] = a0; part[(F.wave * 2 + 1) * 64 + F.lane] = a1;
            __syncthreads();
            if (F.tid < 128) { const int b = F.tid >> 6, col = F.tid & 63; float s = 0.f;
#pragma unroll
                for (int w = 0; w < 8; ++w) s += part[(w * 2 + b) * 64 + col];
                MOD[(l * 2 + b) * 6144 + j0 + col] = s + ada_b[l * 6144 + j0 + col]; }
            __syncthreads();
        }
    }
    {
        LAS float* scr = (LAS float*)(F.lds + 16384 + F.wave * 8448);
        const int gw = F.bid * NWAVES + F.wave, NGW = F.G * NWAVES;
        constexpr int I_A = 16 * 64, I_B = 16 * 64, I_C = 16 * 56, I_D = 16 * 32, I_E = 16 * 64;
        constexpr int NITEMS = 2 * I_A + 2 * I_B + 2 * I_C + 4 * I_D + 4 * I_E;
        for (int it = gw; it < NITEMS; it += NGW) {
            int r = it;
            if (r < 2 * I_A) { const int j = r / I_A; transpose_item(IN(6) + (size_t)j * 1024 * 2048, 2048, WSP(bf16, WS_WIN + (size_t)(2 * j) * 8 * MiB), 0, scr, r % I_A, 64, F.lane); continue; } r -= 2 * I_A;
            if (r < 2 * I_B) { const int j = r / I_B; transpose_item(IN(10) + (size_t)j * 1024 * ODD_LD, ODD_LD, WSP(bf16, WS_WIN + (size_t)(2 * j + 1) * 8 * MiB), 0, scr, r % I_B, 64, F.lane); continue; } r -= 2 * I_B;
            if (r < 2 * I_C) { const int j = r / I_C; transpose_item(IN(10) + (size_t)j * 1024 * ODD_LD + 2056, ODD_LD, WSP(bf16, WS_WIN + (size_t)(2 * j + 1) * 8 * MiB), 2048, scr, r % I_C, 56, F.lane); continue; } r -= 2 * I_C;
            if (r < 4 * I_D) { const int l = r / I_D; const int j = l >> 1; const float* src = (l & 1) ? IN(11) : IN(7);
                if ((l & 1) || (r % I_D) < 8 * 32) transpose_item(src + (size_t)j * 1024 * 1024, 1024, WSP(bf16, WS_WOUT + (size_t)l * 2 * MiB), 0, scr, r % I_D, 32, F.lane); continue; } r -= 4 * I_D;
            { const int l = r / I_E; transpose_item(IN(26) + (size_t)l * 1024 * 2048, 2048, WSP(bf16, WS_WQ + (size_t)l * 4 * MiB), 0, scr, r % I_E, 64, F.lane); }
        }
    }
    {
        const int gt = F.bid * NTHR + F.tid, NGT = F.G * NTHR;
        float* WF = WSP(float, WS_WF);
        for (int i = gt; i < 2 * 8 * 1024; i += NGT) { const int j = i >> 13, h = (i >> 10) & 7, k = i & 1023; WF[i] = IN(10)[((size_t)j * 1024 + k) * ODD_LD + 2048 + h]; }
        bf16* KEYS = WSP(bf16, WS_KEYS);
        for (int i = gt; i < 4 * 16384; i += NGT) { const int l = i >> 14, r = i & 16383;
            KEYS[(size_t)(l * 2 + 0) * 16384 + r] = (bf16)f2bf(IN(27)[i]); KEYS[(size_t)(l * 2 + 1) * 16384 + r] = (bf16)f2bf(IN(28)[i]); }
        for (int i = gt; i < 2 * 1024 * 512; i += NGT) { const int j = i >> 19, n = (i >> 9) & 1023, gc = i & 511, g = gc >> 7, c = gc & 127;
            const float* pw = IN(8) + ((size_t)(j * 4 + g) * 128 + c) * 128; const float* psc = IN(9) + j * 512 + g * 128; const float* wo = IN(7) + ((size_t)j * 1024 + 512 + g * 128) * 1024 + n;
            float a = 0.f;
#pragma unroll 8
            for (int d = 0; d < 128; ++d) a += pw[d] * psc[d] * wo[(size_t)d * 1024];
            WSP(bf16, WS_WOUT + (size_t)(2 * j) * 2 * MiB)[(size_t)n * 1024 + 512 + gc] = (bf16)f2bf(a); }
        {
            const int gw = F.bid * NWAVES + F.wave, NGW = F.G * NWAVES, lane = F.lane;
            float* PS = WSP(float, WS_PS);
            for (int row = gw; row < 2 * 4 * NEXP; row += NGW) {
                const int tb = row >= 4 * NEXP ? 1 : 0, rr = row - tb * 4 * NEXP;
                const float* src = (tb ? IN(30) : IN(29)) + (size_t)rr * 1024 + 16 * lane;
                f32x4 v[4]; float am = 0.f;
#pragma unroll
                for (int j = 0; j < 4; ++j) { v[j] = *(const f32x4*)(src + 4 * j); am = fmaxf(am, fmaxf(fmaxf(fabsf(v[j].x), fabsf(v[j].y)), fmaxf(fabsf(v[j].z), fabsf(v[j].w)))); }
                am = wave_max(am);
                const float sc = am > 0.f ? am * (1.f / 224.f) : 1.f, inv = 1.f / sc;
                v4u o;
#pragma unroll
                for (int j = 0; j < 4; ++j) { int w = 0; w = __builtin_amdgcn_cvt_pk_fp8_f32(v[j].x * inv, v[j].y * inv, w, false); w = __builtin_amdgcn_cvt_pk_fp8_f32(v[j].z * inv, v[j].w * inv, w, true); o[j] = (unsigned)w; }
                *(v4u*)(WSP(unsigned char, tb ? WS_PV : WS_PU) + (size_t)rr * 1024 + 16 * lane) = o;
                if (lane == 0) PS[row] = sc;
            }
        }
    }
}

__device__ __forceinline__ void phase_norm(Frame& F, int layer, int which) {
    KARGS;
    const float* X = (layer == 0 && which == 0) ? IN(0) : OUTP;
    const float* gain = (which ? IN(5) : IN(4)) + layer * 1024;
    const float* mod = WSP(float, WS_MOD) + (size_t)layer * 2 * 6144 + (which ? 3072 : 0);
    bf16* H = WSP(bf16, WS_H);
    const bool do_f = (layer & 1) && which == 0;
    const int jj = layer >> 1;
    const float* WF = WSP(float, WS_WF) + (size_t)jj * 8 * 1024;
    float* LOGF = WSP(float, WS_LOGF);
    const int gw = F.bid * NWAVES + F.wave, NGW = F.G * NWAVES, lane = F.lane;
    f32x4 gn[4];
#pragma unroll
    for (int j = 0; j < 4; ++j) gn[j] = *(const f32x4*)(gain + 256 * j + 4 * lane);
    for (int row = gw; row < T; row += NGW) {
        const int b = row >= SEQ ? 1 : 0;
        const float* sh = mod + b * 6144; const float* sc = sh + 1024;
        const float* xr = X + (size_t)row * D + 4 * lane;
        f32x4 v[4]; float ss = 0.f;
#pragma unroll
        for (int j = 0; j < 4; ++j) { v[j] = *(const f32x4*)(xr + 256 * j); ss += (v[j].x * v[j].x + v[j].y * v[j].y) + (v[j].z * v[j].z + v[j].w * v[j].w); }
        const float rstd = rsqrtf(wave_sum(ss) * (1.f / D) + NORM_EPS);
        bf16* hr = H + (size_t)row * D + 4 * lane;
#pragma unroll
        for (int j = 0; j < 4; ++j) { const f32x4 s4 = *(const f32x4*)(sc + 256 * j + 4 * lane), h4 = *(const f32x4*)(sh + 256 * j + 4 * lane);
            v[j] = v[j] * rstd * gn[j] * (s4 + 1.f) + h4;
            v2u o; o.x = pk2(v[j].x, v[j].y); o.y = pk2(v[j].z, v[j].w); *(v2u*)(hr + 256 * j) = o; }
        if (do_f) {
            const float* fb = IN(14) + jj * 8;
            const int t = row - b * SEQ;
#pragma unroll
            for (int hh = 0; hh < 8; ++hh) { float d = 0.f;
#pragma unroll
                for (int j = 0; j < 4; ++j) { const f32x4 w4 = *(const f32x4*)(WF + hh * 1024 + 256 * j + 4 * lane); d += (v[j].x * w4.x + v[j].y * w4.y) + (v[j].z * w4.z + v[j].w * w4.w); }
                d = wave_sum(d) + fb[hh];
                const float lf = fminf(d, 0.f) - log1pf(expf(-fabsf(d)));
                if (lane == 0) LOGF[(size_t)(b * 8 + hh) * SEQ + t] = lf; }
        }
    }
}

__device__ __forceinline__ void load_q64(float (&q)[64], const bf16* p, float scale) {
#pragma unroll
    for (int c = 0; c < 8; ++c) { const v4u w = *(const v4u*)(p + 8 * c);
        q[8 * c + 0] = bflo(w.x) * scale; q[8 * c + 1] = bfhi(w.x) * scale; q[8 * c + 2] = bflo(w.y) * scale; q[8 * c + 3] = bfhi(w.y) * scale;
        q[8 * c + 4] = bflo(w.z) * scale; q[8 * c + 5] = bfhi(w.z) * scale; q[8 * c + 6] = bflo(w.w) * scale; q[8 * c + 7] = bfhi(w.w) * scale; }
}
__device__ __forceinline__ float dot_q64(const float (&q)[64], const bf16* p) {
    float z0 = 0.f, z1 = 0.f;
#pragma unroll
    for (int c = 0; c < 8; ++c) { const v4u w = *(const v4u*)(p + 8 * c);
        z0 += q[8 * c + 0] * bflo(w.x) + q[8 * c + 2] * bflo(w.y) + q[8 * c + 4] * bflo(w.z) + q[8 * c + 6] * bflo(w.w);
        z1 += q[8 * c + 1] * bfhi(w.x) + q[8 * c + 3] * bfhi(w.y) + q[8 * c + 5] * bfhi(w.z) + q[8 * c + 7] * bfhi(w.w); }
    return z0 + z1;
}
#ifdef MK_SIMPLE_EVEN
__device__ __forceinline__ void phase_even_mixer_simple(Frame& F, int layer) {
    KARGS;
    const bf16* P = WSP(bf16, WS_PROJ); bf16* MIX = WSP(bf16, WS_MIX);
    const int lane = F.lane;
    {
        const int gw = F.bid * NWAVES + F.wave, NGW = F.G * NWAVES;
        for (int it = gw; it < BATCH * 8 * SEQ; it += NGW) {
            const int b = it >> 16, h = (it >> 13) & 7, t = it & 8191;
            const bf16* base = P + (size_t)b * SEQ * EVEN_IN;
            float q[64]; load_q64(q, base + (size_t)t * EVEN_IN + h * 64, 0.125f);
            float acc = 0.f, carry = 0.f;
            for (int s0 = t - 1; s0 >= 0; s0 -= 64) {
                const int s = s0 - lane; const bool valid = s >= 0; const int sc = valid ? s : 0;
                const float z = dot_q64(q, base + (size_t)sc * EVEN_IN + 512 + h * 64);
                const float sp = softplusf_(z);
                const float l1m = valid ? -sp : 0.f;
                const float lb = z - sp;
                float inc = l1m;
#pragma unroll
                for (int o = 1; o < 64; o <<= 1) { const float n = __shfl_up(inc, o); if (lane >= o) inc += n; }
                const float w = valid ? expf(lb + carry + (inc - l1m)) : 0.f;
                const float tot = __shfl(inc, 63);
#pragma unroll 16
                for (int j = 0; j < 64; ++j) { const float wj = rl(w, j); int sj = s0 - j; sj = sj < 0 ? 0 : sj;
                    acc += wj * bf2f(base[(size_t)sj * EVEN_IN + 1024 + h * 64 + lane]); }
                carry += tot;
                if (carry < -104.f) break;
            }
            MIX[((size_t)b * SEQ + t) * D + h * 64 + lane] = (bf16)f2bf(acc);
        }
    }
    {
        LAS float* pl = (LAS float*)F.lds;
        const int jj = layer >> 1;
        const float* pw = IN(8) + (size_t)jj * 4 * 128 * 128; const float* ps = IN(9) + jj * 512;
        const int c = F.tid, g = c >> 7, w = 2 << g, d = c & 127;
        for (int tile = F.bid; tile < T / 32; tile += F.G) {
            const int t0 = tile * 32, b = t0 / SEQ, tl0 = t0 % SEQ;
            const bf16* base = P + (size_t)b * SEQ * EVEN_IN + 1536 + c;
            for (int tt = 0; tt < 32; ++tt) { const int tl = tl0 + tt, cend = (tl / 64 + 1) * 64;
                int lo = tl - w / 2; lo = lo < 0 ? 0 : lo; int hi = tl + w / 2; hi = hi > cend ? cend : hi;
                float s = 0.f; for (int u = lo; u < hi; ++u) s += bf2f(base[(size_t)u * EVEN_IN]);
                pl[c * 33 + tt] = s / (float)(hi - lo) - bf2f(base[(size_t)tl * EVEN_IN]); }
            __syncthreads();
            float acc[32];
#pragma unroll
            for (int tt = 0; tt < 32; ++tt) acc[tt] = 0.f;
            for (int cc = 0; cc < 128; ++cc) { const float wv = pw[((size_t)g * 128 + cc) * 128 + d]; const LAS float* pr = pl + (g * 128 + cc) * 33;
#pragma unroll
                for (int tt = 0; tt < 32; ++tt) acc[tt] += pr[tt] * wv; }
            const float sc = ps[c];
#pragma unroll
            for (int tt = 0; tt < 32; ++tt) MIX[(size_t)(t0 + tt) * D + 512 + c] = (bf16)f2bf(acc[tt] * sc);
            __syncthreads();
        }
    }
}

#endif
typedef float f32x16 __attribute__((ext_vector_type(16)));
typedef short s16x4 __attribute__((ext_vector_type(4)));
constexpr int FX_KROW = 144, FX_VROW = 192;
constexpr int FX_KB = 64 * FX_KROW, FX_VB = 64 * FX_VROW, FX_BUF = FX_KB + FX_VB + 256;
template <int HW> __device__ __forceinline__ void pool_chunk(const bf16* src, bf16* dst, int tl0) {
    float ps[HW + 65 + HW]; ps[0] = 0.f;
#pragma unroll
    for (int i = 0; i < 64 + HW; ++i) { const int tl = tl0 - HW + i; const float x = tl >= 0 ? bf2f(src[(long)(i - HW) * EVEN_IN]) : 0.f; ps[i + 1] = ps[i] + x; }
#pragma unroll
    for (int tt = 0; tt < 64; ++tt) { const int tl = tl0 + tt; int lo = tl - HW; lo = lo < 0 ? 0 : lo; const int hie = tt + HW > 64 ? 64 : tt + HW;
        const float sum = ps[hie + HW] - ps[tt]; const float x = ps[tt + HW + 1] - ps[tt + HW];
        dst[(size_t)tt * D] = (bf16)f2bf(sum / (float)(tl0 + hie - lo) - x); }
}
__device__ __forceinline__ void phase_even_mixer(Frame& F, int layer) {
    KARGS;
    const bf16* P = WSP(bf16, WS_PROJ); bf16* MIX = WSP(bf16, WS_MIX);
    const int tid = F.tid, lane = F.lane, wave = F.wave, r32 = lane & 31, hh = lane >> 5;
    const float LOG2E = 1.4426950408889634f, CS = 0.125f * LOG2E;
    const int srow = tid >> 3, sch = tid & 7;
    {
        const int c = tid, g = c >> 7;
        for (int ck = F.bid; ck < T / 64; ck += F.G) {
            const int t0 = ck * 64, tl0 = t0 % SEQ;
            const bf16* src = P + (size_t)t0 * EVEN_IN + 1536 + c; bf16* dst = MIX + (size_t)t0 * D + 512 + c;
            if (g == 0) pool_chunk<1>(src, dst, tl0); else if (g == 1) pool_chunk<2>(src, dst, tl0); else if (g == 2) pool_chunk<4>(src, dst, tl0); else pool_chunk<8>(src, dst, tl0);
        }
    }
    __syncthreads();
    for (int u = F.bid; u < 256; u += F.G) {
        for (int ui = 0; ui < 2; ++ui) {
            const int bh = u >> 4, ss = u & 15, qb = ui == 0 ? ss : 31 - ss, b = bh >> 3, h = bh & 7;
            const bf16* base = P + (size_t)b * SEQ * EVEN_IN;
            const int q0 = 256 * qb + 32 * wave, myq = q0 + r32;
            bf16x8 qf[4];
#pragma unroll
            for (int d0 = 0; d0 < 4; ++d0) qf[d0] = *(const bf16x8*)(base + (size_t)myq * EVEN_IN + h * 64 + 16 * d0 + 8 * hh);
            float carry = 0.f;
            f32x16 o[2];
#pragma unroll
            for (int r = 0; r < 16; ++r) { o[0][r] = 0.f; o[1][r] = 0.f; }
            const int jtop = 4 * qb + 3;
            v4u kreg = *(const v4u*)(base + (size_t)(64 * jtop + srow) * EVEN_IN + 512 + h * 64 + sch * 8);
            v4u vreg = *(const v4u*)(base + (size_t)(64 * jtop + srow) * EVEN_IN + 1024 + h * 64 + sch * 8);
            __syncthreads();
            *(LAS v4u*)(F.lds + srow * FX_KROW + sch * 16) = kreg; *(LAS v4u*)(F.lds + FX_KB + srow * FX_VROW + sch * 16) = vreg;
            if (tid < 16) ((LAS unsigned*)(F.lds + 2 * FX_BUF))[tid] = 0u;
            __syncthreads();
            int it = 0;
            for (int j = jtop; j >= 0; --j, ++it) {
                const int cur = (it & 1) * FX_BUF, nxt = ((it + 1) & 1) * FX_BUF;
                if (j > 0) { const size_t krow = (size_t)(64 * (j - 1) + srow) * EVEN_IN;
                    kreg = *(const v4u*)(base + krow + 512 + h * 64 + sch * 8); vreg = *(const v4u*)(base + krow + 1024 + h * 64 + sch * 8); }
                const bool started = 64 * j <= q0 + 30;
                const bool wprev = __all(carry < -150.f);
                if (started && !wprev) {
                    const LAS unsigned char* Kb = F.lds + cur; const LAS unsigned char* Vb = F.lds + cur + FX_KB;
                    f32x16 p0, p1;
#pragma unroll
                    for (int r = 0; r < 16; ++r) { p0[r] = 0.f; p1[r] = 0.f; }
#pragma unroll
                    for (int d0 = 0; d0 < 4; ++d0) {
                        const bf16x8 a0 = *(const LAS bf16x8*)(Kb + r32 * FX_KROW + 32 * d0 + 16 * hh);
                        const bf16x8 a1 = *(const LAS bf16x8*)(Kb + (r32 + 32) * FX_KROW + 32 * d0 + 16 * hh);
                        p0 = __builtin_amdgcn_mfma_f32_32x32x16_bf16(a0, qf[d0], p0, 0, 0, 0);
                        p1 = __builtin_amdgcn_mfma_f32_32x32x16_bf16(a1, qf[d0], p1, 0, 0, 0);
                    }
                    f32x16 l0, l1v;
#pragma unroll
                    for (int r = 0; r < 16; ++r) {
                        const int key = 64 * j + (r & 3) + 8 * (r >> 2) + 4 * hh;
                        const float za = p0[r] * CS, zb = p1[r] * CS;
                        const float sa = fmaxf(za, 0.f) + __builtin_amdgcn_logf(1.f + __builtin_amdgcn_exp2f(-fabsf(za)));
                        const float sb = fmaxf(zb, 0.f) + __builtin_amdgcn_logf(1.f + __builtin_amdgcn_exp2f(-fabsf(zb)));
                        const bool va = key < myq, vb = key + 32 < myq;
                        l0[r] = va ? -sa : 0.f; l1v[r] = vb ? -sb : 0.f;
                        p0[r] = va ? za - sa : -INFINITY; p1[r] = vb ? zb - sb : -INFINITY;
                    }
                    float tot[8], oth[8];
#pragma unroll
                    for (int g = 0; g < 4; ++g) { tot[g] = (l0[4 * g] + l0[4 * g + 1]) + (l0[4 * g + 2] + l0[4 * g + 3]); tot[4 + g] = (l1v[4 * g] + l1v[4 * g + 1]) + (l1v[4 * g + 2] + l1v[4 * g + 3]); }
#pragma unroll
                    for (int g = 0; g < 8; ++g) oth[g] = __shfl_xor(tot[g], 32);
                    float sfx[8]; float run = 0.f;
#pragma unroll
                    for (int x = 7; x >= 0; --x) { sfx[x] = run; run += tot[x] + oth[x]; }
#pragma unroll
                    for (int x = 0; x < 8; ++x) {
                        const float goff = carry + sfx[x] + (hh == 0 ? oth[x] : 0.f);
                        if (x < 4) { const float s3 = goff, s2 = s3 + l0[4 * x + 3], s1 = s2 + l0[4 * x + 2], s0 = s1 + l0[4 * x + 1];
                            p0[4 * x] = __builtin_amdgcn_exp2f(p0[4 * x] + s0); p0[4 * x + 1] = __builtin_amdgcn_exp2f(p0[4 * x + 1] + s1); p0[4 * x + 2] = __builtin_amdgcn_exp2f(p0[4 * x + 2] + s2); p0[4 * x + 3] = __builtin_amdgcn_exp2f(p0[4 * x + 3] + s3); }
                        else { const int y = x - 4; const float s3 = goff, s2 = s3 + l1v[4 * y + 3], s1 = s2 + l1v[4 * y + 2], s0 = s1 + l1v[4 * y + 1];
                            p1[4 * y] = __builtin_amdgcn_exp2f(p1[4 * y] + s0); p1[4 * y + 1] = __builtin_amdgcn_exp2f(p1[4 * y + 1] + s1); p1[4 * y + 2] = __builtin_amdgcn_exp2f(p1[4 * y + 2] + s2); p1[4 * y + 3] = __builtin_amdgcn_exp2f(p1[4 * y + 3] + s3); }
                    }
                    carry += run;
                    bf16x8 pf[4];
#pragma unroll
                    for (int s4 = 0; s4 < 4; ++s4) {
                        v4u w;
                        if (s4 < 2) { w.x = pk2(p0[8 * s4 + 0], p0[8 * s4 + 1]); w.y = pk2(p0[8 * s4 + 2], p0[8 * s4 + 3]); w.z = pk2(p0[8 * s4 + 4], p0[8 * s4 + 5]); w.w = pk2(p0[8 * s4 + 6], p0[8 * s4 + 7]); }
                        else { const int sp = s4 - 2; w.x = pk2(p1[8 * sp + 0], p1[8 * sp + 1]); w.y = pk2(p1[8 * sp + 2], p1[8 * sp + 3]); w.z = pk2(p1[8 * sp + 4], p1[8 * sp + 5]); w.w = pk2(p1[8 * sp + 6], p1[8 * sp + 7]); }
                        pf[s4] = __builtin_bit_cast(bf16x8, w);
                    }
                    const int gi = lane >> 4, li = lane & 15;
                    const LAS unsigned char* vbase = Vb + (4 * (gi >> 1) + (li >> 2)) * FX_VROW + (16 * (gi & 1) + 4 * (li & 3)) * 2;
#pragma unroll
                    for (int d0 = 0; d0 < 2; ++d0)
#pragma unroll
                        for (int s4 = 0; s4 < 4; ++s4) {
                            const s16x4 lo = __builtin_bit_cast(s16x4, __builtin_amdgcn_ds_read_tr16_b64_v4i16((LAS s16x4*)(vbase + (16 * s4) * FX_VROW + 64 * d0)));
                            const s16x4 hi = __builtin_bit_cast(s16x4, __builtin_amdgcn_ds_read_tr16_b64_v4i16((LAS s16x4*)(vbase + (16 * s4 + 8) * FX_VROW + 64 * d0)));
                            const bf16x8 vf = (bf16x8){lo[0], lo[1], lo[2], lo[3], hi[0], hi[1], hi[2], hi[3]};
                            o[d0] = __builtin_amdgcn_mfma_f32_32x32x16_bf16(vf, pf[s4], o[d0], 0, 0, 0);
                        }
                }
                const bool wdone = started && __all(carry < -150.f);
                if (lane == 0) ((LAS unsigned*)(F.lds + 2 * FX_BUF))[(it & 1) * 8 + wave] = wdone ? 1u : 0u;
                if (j > 0) { *(LAS v4u*)(F.lds + nxt + srow * FX_KROW + sch * 16) = kreg; *(LAS v4u*)(F.lds + nxt + FX_KB + srow * FX_VROW + sch * 16) = vreg; }
                __syncthreads();
                const LAS unsigned* fl = (const LAS unsigned*)(F.lds + 2 * FX_BUF) + (it & 1) * 8;
                const unsigned alld = fl[0] & fl[1] & fl[2] & fl[3] & fl[4] & fl[5] & fl[6] & fl[7];
                if (alld) break;
            }
            bf16* op = MIX + ((size_t)b * SEQ + myq) * D + h * 64;
#pragma unroll
            for (int d0 = 0; d0 < 2; ++d0)
#pragma unroll
                for (int g = 0; g < 4; ++g) { const int db = 32 * d0 + 8 * g + 4 * hh;
                    v2u ow; ow.x = pk2(o[d0][4 * g + 0], o[d0][4 * g + 1]); ow.y = pk2(o[d0][4 * g + 2], o[d0][4 * g + 3]); *(v2u*)(op + db) = ow; }
        }
    }
}

__device__ __forceinline__ void phase_odd_prep(Frame& F, int layer) {
    KARGS;
    const int jj = layer >> 1, lane = F.lane;
    bf16* P = WSP(bf16, WS_PROJ);
    if (F.wave == 0 && F.bid < 16) {
        const float* lf = WSP(float, WS_LOGF) + (size_t)F.bid * SEQ; float* dc = WSP(float, WS_DCUM) + (size_t)F.bid * SEQ; double carry = 0.0;
        for (int t0 = 0; t0 < SEQ; t0 += 64) { float inc = lf[t0 + lane];
#pragma unroll
            for (int o = 1; o < 64; o <<= 1) { const float n = __shfl_up(inc, o); if (lane >= o) inc += n; }
            dc[t0 + lane] = (float)(carry + (double)inc); carry += (double)__shfl(inc, 63); }
    }
    LAS float* lx = (LAS float*)F.lds;
    const float* mix = IN(15) + jj * 1792;
    const float* w0 = IN(16) + jj * 512; const float* w2 = IN(17) + (size_t)jj * 64 * 512;
    const float* a0 = IN(18) + jj * 512; const float* a2 = IN(19) + (size_t)jj * 64 * 512;
    const float* g2 = IN(20) + (size_t)jj * 128 * 512;
    const float* kkp = IN(21) + jj * 512; const float* kap = IN(22) + jj * 512;
    const float* qn = IN(12) + jj * 64; const float* kn = IN(13) + jj * 64;
    float* R = WSP(float, WS_RW); float* Wd = WSP(float, WS_RW + RW_SLOT); float* K = WSP(float, WS_RW + 2 * RW_SLOT); float* V = WSP(float, WS_RW + 3 * RW_SLOT);
    float* KK = WSP(float, WS_RW + 4 * RW_SLOT); float* A = WSP(float, WS_RW + 5 * RW_SLOT); float* Gt = WSP(float, WS_RW + 6 * RW_SLOT);
    const int ch = F.tid;
    const float m_r = mix[ch], m_k = mix[512 + ch], m_v = mix[1024 + ch];
    const float w0c = w0[ch], a0c = a0[ch], kkc = kkp[ch], kac = kap[ch], qnc = qn[ch & 63], knc = kn[ch & 63];
    for (int item = F.bid; item < T / 16; item += F.G) {
        const int t0 = item * 16;
        for (int i = F.tid; i < 16 * 256; i += NTHR) { const int tt = i >> 8, j = i & 255, tg = t0 + tt, tl = tg % SEQ, col = 1536 + j;
            const float cur = bf2f(P[(size_t)tg * ODD_N + 2048 + col]); const float prev = tl > 0 ? bf2f(P[(size_t)(tg - 1) * ODD_N + 2048 + col]) : 0.f;
            const float x = cur + (prev - cur) * mix[col];
            lx[i] = j < 64 ? tanhf(x) : (j < 128 ? x : sigmoidf_(x)); }
        __syncthreads();
        float aw[16], aa[16], ag[16];
#pragma unroll
        for (int tt = 0; tt < 16; ++tt) { aw[tt] = 0.f; aa[tt] = 0.f; ag[tt] = 0.f; }
        for (int i = 0; i < 64; ++i) { const float w2v = w2[i * 512 + ch], a2v = a2[i * 512 + ch];
#pragma unroll
            for (int tt = 0; tt < 16; ++tt) { aw[tt] += lx[tt * 256 + i] * w2v; aa[tt] += lx[tt * 256 + 64 + i] * a2v; } }
        for (int i = 0; i < 128; ++i) { const float g2v = g2[i * 512 + ch];
#pragma unroll
            for (int tt = 0; tt < 16; ++tt) ag[tt] += lx[tt * 256 + 128 + i] * g2v; }
#pragma unroll
        for (int tt = 0; tt < 16; ++tt) { const int tg = t0 + tt, tl = tg % SEQ;
            const bf16* pc = P + (size_t)tg * ODD_N + 2048 + ch; const bf16* pp = pc - ODD_N;
            const float rc = bf2f(pc[0]), kc = bf2f(pc[512]), vc = bf2f(pc[1024]);
            const float rp = tl > 0 ? bf2f(pp[0]) : 0.f, kp = tl > 0 ? bf2f(pp[512]) : 0.f, vp = tl > 0 ? bf2f(pp[1024]) : 0.f;
            const float r = rc + (rp - rc) * m_r, kr = kc + (kp - kc) * m_k, vr = vc + (vp - vc) * m_v;
            const float wl = -softplusf_(-(w0c + aw[tt])) - 0.5f; const float decay = -expf(wl);
            const float a = sigmoidf_(a0c + aa[tt]);
            const float kkv = kr * kkc; const float n2 = wave_sum(kkv * kkv); const float kkn = kkv / fmaxf(sqrtf(n2), 1e-12f);
            const float kmod = kr * (1.f + (a - 1.f) * kac);
            const size_t o = (size_t)tg * 512 + ch;
            R[o] = r; Wd[o] = decay; K[o] = kmod; V[o] = vr; KK[o] = kkn; A[o] = a; Gt[o] = ag[tt];
            bf16* pq = P + (size_t)tg * ODD_N + ch;
            const float qv = bf2f(pq[0]), kv = bf2f(pq[512]);
            const float qs = wave_sum(qv * qv) * (1.f / 64.f), ks = wave_sum(kv * kv) * (1.f / 64.f);
            pq[0] = (bf16)f2bf(qv * rsqrtf(qs + NORM_EPS) * qnc); pq[512] = (bf16)f2bf(kv * rsqrtf(ks + NORM_EPS) * knc); }
        __syncthreads();
    }
}

constexpr int CP = 144;
constexpr int CM = 64 * CP;
__device__ __forceinline__ void mm_nt(f32x16& acc, const LAS unsigned char* A, const LAS unsigned char* B, int m0, int n0, int r32, int hh) {
#pragma unroll
    for (int s4 = 0; s4 < 4; ++s4) { const bf16x8 a = *(const LAS bf16x8*)(A + (m0 + r32) * CP + 32 * s4 + 16 * hh); const bf16x8 b = *(const LAS bf16x8*)(B + (n0 + r32) * CP + 32 * s4 + 16 * hh);
        acc = __builtin_amdgcn_mfma_f32_32x32x16_bf16(a, b, acc, 0, 0, 0); }
}
__device__ __forceinline__ void store_t(LAS unsigned char* Dst, const f32x16& acc, int m0, int n0, int r32, int hh, float sg) {
#pragma unroll
    for (int g = 0; g < 4; ++g) { v2u w; w.x = pk2(sg * acc[4 * g], sg * acc[4 * g + 1]); w.y = pk2(sg * acc[4 * g + 2], sg * acc[4 * g + 3]); *(LAS v2u*)(Dst + (n0 + r32) * CP + (m0 + 8 * g + 4 * hh) * 2) = w; }
}
__device__ __forceinline__ void load_t(f32x16& acc, const LAS unsigned char* Src, int m0, int n0, int r32, int hh, float sg) {
#pragma unroll
    for (int g = 0; g < 4; ++g) { const v2u w = *(const LAS v2u*)(Src + (n0 + r32) * CP + (m0 + 8 * g + 4 * hh) * 2);
        acc[4 * g] = sg * bflo(w.x); acc[4 * g + 1] = sg * bfhi(w.x); acc[4 * g + 2] = sg * bflo(w.y); acc[4 * g + 3] = sg * bfhi(w.y); }
}
#define ZERO16(a) do { _Pragma("unroll") for (int r_ = 0; r_ < 16; ++r_) a[r_] = 0.f; } while (0)
__device__ __forceinline__ void mask16(f32x16& acc, int m0, int n0, int r32, int hh, int mode) {
    const int n = n0 + r32;
#pragma unroll
    for (int r = 0; r < 16; ++r) { const int m = m0 + (r & 3) + 8 * (r >> 2) + 4 * hh; const bool keep = mode == 0 ? (n < m) : (mode == 1 ? (m < n) : (m <= n)); acc[r] = keep ? acc[r] : 0.f; }
}
__device__ __forceinline__ void phase_rwkv_chunk(Frame& F, int layer) {
    KARGS;
    const float* R = WSP(float, WS_RW); const float* LW = WSP(float, WS_RW + RW_SLOT); const float* K = WSP(float, WS_RW + 2 * RW_SLOT); const float* V = WSP(float, WS_RW + 3 * RW_SLOT);
    const float* KK = WSP(float, WS_RW + 4 * RW_SLOT); const float* A = WSP(float, WS_RW + 5 * RW_SLOT);
    bf16* CGp = WSP(bf16, WS_CG); bf16* CQp = WSP(bf16, WS_CQ); float* CHp = WSP(float, WS_CH); float* CYp = WSP(float, WS_CY);
    const int tid = F.tid, lane = F.lane, w = F.wave, r32 = lane & 31, hh = lane >> 5;
    LAS unsigned char* L = F.lds;
    LAS unsigned char* Ab = L, *Bb = L + CM, *Kb = L + 2 * CM, *Rb = L + 3 * CM, *BtT = L + 4 * CM, *KtT = L + 5 * CM, *VT = L + 6 * CM;
    LAS unsigned char* XT0 = L + 7 * CM, *XT1 = L + 9 * CM;
    LAS unsigned char* NB = L + 11 * CM;
    LAS unsigned char* Prb = L + 15 * CM;
    LAS float* tot = (LAS float*)(L + 16 * CM);
    LAS float* gCl = tot + 512;
    for (int item = F.bid; item < 16 * 128; item += F.G) {
        const int bh = item >> 7, c = item & 127, b = bh >> 3, h = bh & 7;
        {
            const size_t g0 = ((size_t)b * SEQ + c * 64 + 8 * w) * 512 + h * 64 + lane;
            float lw[8], cum[8]; float run = 0.f;
#pragma unroll
            for (int i = 0; i < 8; ++i) { lw[i] = LW[g0 + (size_t)i * 512]; run += lw[i]; cum[i] = run; }
            tot[w * 64 + lane] = run;
            __syncthreads();
            float off = 0.f, all = 0.f;
#pragma unroll
            for (int ww = 0; ww < 8; ++ww) { const float tv = tot[ww * 64 + lane]; if (ww < w) off += tv; all += tv; }
            if (w == 0) gCl[lane] = expf(all);
#pragma unroll
            for (int i = 0; i < 8; ++i) {
                const int t = 8 * w + i; const float cm = cum[i] + off;
                const float g = expf(cm), gex = expf(cm - lw[i]), gi = expf(-cm), gcg = expf(all - cm);
                const size_t gg = g0 + (size_t)i * 512;
                const float r = R[gg], k = K[gg], v = V[gg], kk = KK[gg], a = A[gg];
                const bf16 ab = (bf16)f2bf(kk * gex), bb = (bf16)f2bf(kk * a * gi), kb = (bf16)f2bf(k * gi), rb = (bf16)f2bf(r * g), bt = (bf16)f2bf(kk * a * gcg), kt = (bf16)f2bf(k * gcg), vb = (bf16)f2bf(v);
                *(LAS bf16*)(Ab + t * CP + lane * 2) = ab; *(LAS bf16*)(Bb + t * CP + lane * 2) = bb; *(LAS bf16*)(Kb + t * CP + lane * 2) = kb; *(LAS bf16*)(Rb + t * CP + lane * 2) = rb;
                *(LAS bf16*)(XT0 + lane * CP + t * 2) = ab; *(LAS bf16*)(BtT + lane * CP + t * 2) = bt; *(LAS bf16*)(KtT + lane * CP + t * 2) = kt; *(LAS bf16*)(VT + lane * CP + t * 2) = vb;
            }
            __syncthreads();
        }
        const int xtm = w & 1, xtn = w >> 1;
        f32x16 xacc;
        {
#pragma unroll
            for (int qq = 0; qq < 2; ++qq) {
                int q; if (w < 4) q = 2 * w + qq; else { if (qq == 1) break; q = 8 + (w - 4); }
                const int pr = q >> 2, tm = (q >> 1) & 1, tn = q & 1; f32x16 acc; ZERO16(acc);
                if (pr == 0) { mm_nt(acc, Ab, Bb, 32 * tm, 32 * tn, r32, hh); mask16(acc, 32 * tm, 32 * tn, r32, hh, 0); store_t(NB + 1 * CM, acc, 32 * tm, 32 * tn, r32, hh, -1.f); }
                else if (pr == 1) { mm_nt(acc, Bb, Ab, 32 * tm, 32 * tn, r32, hh); mask16(acc, 32 * tm, 32 * tn, r32, hh, 1); store_t(NB + 0 * CM, acc, 32 * tm, 32 * tn, r32, hh, -1.f); }
                else { mm_nt(acc, Bb, Rb, 32 * tm, 32 * tn, r32, hh); mask16(acc, 32 * tm, 32 * tn, r32, hh, 2); store_t(Prb, acc, 32 * tm, 32 * tn, r32, hh, 1.f); }
            }
            if (xtn >= 2) { ZERO16(xacc); mm_nt(xacc, Ab, Kb, 32 * xtm, 32 * (xtn - 2), r32, hh); mask16(xacc, 32 * xtm, 32 * (xtn - 2), r32, hh, 0); store_t(XT0 + 64 * CP, xacc, 32 * xtm, 32 * (xtn - 2), r32, hh, 1.f); }
            else load_t(xacc, XT0, 32 * xtm, 32 * xtn, r32, hh, 1.f);
            __syncthreads();
        }
        LAS unsigned char* XTc = XT0; LAS unsigned char* XTn = XT1; int nb = 0;
#pragma unroll 1
        for (int j = 0; j < 6; ++j) {
            const LAS unsigned char* Nc = NB + (2 * nb) * CM; const LAS unsigned char* NTc = NB + (2 * nb + 1) * CM;
            mm_nt(xacc, Nc, XTc, 32 * xtm, 32 * xtn, r32, hh);
            store_t(XTn, xacc, 32 * xtm, 32 * xtn, r32, hh, 1.f);
            if (j < 5) { const int tm = (w >> 1) & 1, tn = w & 1; f32x16 acc; ZERO16(acc);
                if (w < 4) { mm_nt(acc, Nc, NTc, 32 * tm, 32 * tn, r32, hh); store_t(NB + (2 * (nb ^ 1) + 1) * CM, acc, 32 * tm, 32 * tn, r32, hh, 1.f); }
                else       { mm_nt(acc, NTc, Nc, 32 * tm, 32 * tn, r32, hh); store_t(NB + (2 * (nb ^ 1)) * CM, acc, 32 * tm, 32 * tn, r32, hh, 1.f); } }
            __syncthreads();
            { LAS unsigned char* t_ = XTc; XTc = XTn; XTn = t_; } nb ^= 1;
        }
        const size_t cbase = (size_t)(bh * 128 + c) * 4096;
#pragma unroll
        for (int qq = 0; qq < 2; ++qq) {
            const int q = 2 * w + qq, pr = q >> 2, tm = (q >> 1) & 1, tn = q & 1, m0 = 32 * tm, n0 = 32 * tn; f32x16 acc;
            if (pr == 0) {
                load_t(acc, Rb, m0, n0, r32, hh, -1.f); mm_nt(acc, XTc, Prb, m0, n0, r32, hh);
                bf16* dst = CQp + cbase + (size_t)(n0 + r32) * 64 + m0 + 4 * hh;
#pragma unroll
                for (int g = 0; g < 4; ++g) { v2u o; o.x = pk2(-acc[4 * g], -acc[4 * g + 1]); o.y = pk2(-acc[4 * g + 2], -acc[4 * g + 3]); *(v2u*)(dst + 8 * g) = o; }
            } else if (pr == 1) {
                ZERO16(acc); mm_nt(acc, XTc, BtT, m0, n0, r32, hh);
                const int k1 = n0 + r32; const float gc = gCl[k1];
                bf16* dst = CGp + cbase + (size_t)k1 * 64 + m0 + 4 * hh;
#pragma unroll
                for (int g = 0; g < 4; ++g) { float e[4];
#pragma unroll
                    for (int i = 0; i < 4; ++i) { const int k2 = m0 + 8 * g + 4 * hh + i; e[i] = (k2 == k1 ? gc : 0.f) - acc[4 * g + i]; }
                    v2u o; o.x = pk2(e[0], e[1]); o.y = pk2(e[2], e[3]); *(v2u*)(dst + 8 * g) = o; }
            } else if (pr == 2) {
                load_t(acc, KtT, m0, n0, r32, hh, -1.f); mm_nt(acc, XTc + 64 * CP, BtT, m0, n0, r32, hh); store_t(NB, acc, m0, n0, r32, hh, -1.f);
            } else {
                f32x16 a1; ZERO16(a1); mm_nt(a1, Kb, Rb, m0, n0, r32, hh); mask16(a1, m0, n0, r32, hh, 2);
                ZERO16(acc); mm_nt(acc, XTc + 64 * CP, Prb, m0, n0, r32, hh);
#pragma unroll
                for (int r = 0; r < 16; ++r) acc[r] = a1[r] - acc[r];
                store_t(NB + CM, acc, m0, n0, r32, hh, 1.f);
            }
        }
        __syncthreads();
        {
            const int ww = w & 3, tm = ww >> 1, tn = ww & 1, m0 = 32 * tm, n0 = 32 * tn; f32x16 acc; ZERO16(acc);
            mm_nt(acc, w < 4 ? NB : NB + CM, VT, m0, n0, r32, hh);
            float* dst = (w < 4 ? CHp : CYp) + cbase + (size_t)(n0 + r32) * 64 + m0 + 4 * hh;
#pragma unroll
            for (int g = 0; g < 4; ++g) *(f32x4*)(dst + 8 * g) = (f32x4){acc[4 * g], acc[4 * g + 1], acc[4 * g + 2], acc[4 * g + 3]};
        }
        __syncthreads();
    }
}

__device__ __forceinline__ void rwkv_scan(Frame& F, int bh) {
    KARGS;
    const bf16* CGp = WSP(bf16, WS_CG) + (size_t)bh * 128 * 4096; const bf16* CQp = WSP(bf16, WS_CQ) + (size_t)bh * 128 * 4096;
    const float* CHp = WSP(float, WS_CH) + (size_t)bh * 128 * 4096; const float* CYp = WSP(float, WS_CY) + (size_t)bh * 128 * 4096;
    float* Y = WSP(float, WS_RW + 7 * RW_SLOT);
    const int lane = F.lane, w = F.wave, r32 = lane & 31, hh = lane >> 5, b = bh >> 3, h = bh & 7;
    LAS unsigned char* S0 = F.lds; LAS unsigned char* S1 = F.lds + CM;
    for (int i = F.tid; i < 2 * CM / 4; i += NTHR) ((LAS unsigned*)F.lds)[i] = 0u;
    const bool upd = w < 4; const int ww = w & 3, tm = ww >> 1, tn = ww & 1, m0 = 32 * tm, n0 = 32 * tn;
    const bf16* Ap = (upd ? CGp : CQp) + (size_t)(m0 + r32) * 64 + 8 * hh;
    const float* Ip = (upd ? CHp : CYp) + (size_t)(n0 + r32) * 64 + m0 + 4 * hh;
    bf16x8 an[4]; f32x4 in_[4];
#pragma unroll
    for (int s4 = 0; s4 < 4; ++s4) { an[s4] = *(const bf16x8*)(Ap + 16 * s4); in_[s4] = *(const f32x4*)(Ip + 8 * s4); }
    __syncthreads();
    for (int c = 0; c < 128; ++c) {
        LAS unsigned char* Sc = (c & 1) ? S1 : S0; LAS unsigned char* Sn = (c & 1) ? S0 : S1;
        bf16x8 a[4]; f32x16 acc;
#pragma unroll
        for (int s4 = 0; s4 < 4; ++s4) { a[s4] = an[s4]; acc[4 * s4] = in_[s4][0]; acc[4 * s4 + 1] = in_[s4][1]; acc[4 * s4 + 2] = in_[s4][2]; acc[4 * s4 + 3] = in_[s4][3]; }
        if (c + 1 < 128) {
#pragma unroll
            for (int s4 = 0; s4 < 4; ++s4) { an[s4] = *(const bf16x8*)(Ap + (size_t)(c + 1) * 4096 + 16 * s4); in_[s4] = *(const f32x4*)(Ip + (size_t)(c + 1) * 4096 + 8 * s4); } }
#pragma unroll
        for (int s4 = 0; s4 < 4; ++s4) { const bf16x8 bb = *(const LAS bf16x8*)(Sc + (n0 + r32) * CP + 32 * s4 + 16 * hh); acc = __builtin_amdgcn_mfma_f32_32x32x16_bf16(a[s4], bb, acc, 0, 0, 0); }
        if (upd) store_t(Sn, acc, m0, n0, r32, hh, 1.f);
        else { float* yp = Y + ((size_t)b * SEQ + c * 64 + m0 + 4 * hh) * 512 + h * 64 + n0 + r32;
#pragma unroll
            for (int r = 0; r < 16; ++r) yp[(size_t)((r & 3) + 8 * (r >> 2)) * 512] = acc[r]; }
        __syncthreads();
    }
}

__device__ __forceinline__ void phase_odd_main(Frame& F, int layer) {
    KARGS;
    const bf16* P = WSP(bf16, WS_PROJ); bf16* MIX = WSP(bf16, WS_MIX); const float* DC = WSP(float, WS_DCUM);
    const int tid = F.tid, lane = F.lane, wave = F.wave, r32 = lane & 31, hh = lane >> 5;
    const float LOG2E = 1.4426950408889634f, CS = 0.125f * LOG2E;
    const int srow = tid >> 3, sch = tid & 7;
    for (int bhs = F.bid; bhs < 16; bhs += F.G) rwkv_scan(F, bhs);
    unsigned* ctr = (unsigned*)F.ctl + CW_WORK + 64 * layer;
    for (;;) {
        {
            __syncthreads();
            if (tid == 0) F.MISC[16] = atomicAdd(ctr, 1u);
            __syncthreads();
            const int u = (int)F.MISC[16];
            if (u >= 512) break;
            const int bh = u & 15, qb = 31 - (u >> 4), b = bh >> 3, h = bh & 7;
            const bf16* base = P + (size_t)b * SEQ * ODD_N; const float* dc = DC + (size_t)bh * SEQ;
            const int q0 = 256 * qb + 32 * wave, myq = q0 + r32;
            bf16x8 qf[4];
#pragma unroll
            for (int d0 = 0; d0 < 4; ++d0) qf[d0] = *(const bf16x8*)(base + (size_t)myq * ODD_N + h * 64 + 16 * d0 + 8 * hh);
            const float dq = dc[myq] * LOG2E;
            float m = -INFINITY, lsum = 0.f;
            f32x16 o[2];
#pragma unroll
            for (int r = 0; r < 16; ++r) { o[0][r] = 0.f; o[1][r] = 0.f; }
            const int NT = 4 * qb + 4;
            v4u kreg = *(const v4u*)(base + (size_t)srow * ODD_N + 512 + h * 64 + sch * 8);
            v4u vreg = *(const v4u*)(base + (size_t)srow * ODD_N + 1024 + h * 64 + sch * 8);
            float dreg = tid < 64 ? dc[tid] * LOG2E : 0.f;
            *(LAS v4u*)(F.lds + srow * FX_KROW + sch * 16) = kreg; *(LAS v4u*)(F.lds + FX_KB + srow * FX_VROW + sch * 16) = vreg;
            if (tid < 64) *(LAS float*)(F.lds + FX_KB + FX_VB + tid * 4) = dreg;
            __syncthreads();
            for (int j = 0; j < NT; ++j) {
                const int cur = (j & 1) * FX_BUF, nxt = ((j + 1) & 1) * FX_BUF;
                if (j + 1 < NT) { const size_t krow = (size_t)(64 * (j + 1) + srow) * ODD_N;
                    kreg = *(const v4u*)(base + krow + 512 + h * 64 + sch * 8); vreg = *(const v4u*)(base + krow + 1024 + h * 64 + sch * 8);
                    if (tid < 64) dreg = dc[64 * (j + 1) + tid] * LOG2E; }
                if (64 * j <= q0 + 31) {
                    const LAS unsigned char* Kb = F.lds + cur; const LAS unsigned char* Vb = F.lds + cur + FX_KB; const LAS float* dkb = (const LAS float*)(F.lds + cur + FX_KB + FX_VB);
                    f32x16 p0, p1;
#pragma unroll
                    for (int r = 0; r < 16; ++r) { p0[r] = 0.f; p1[r] = 0.f; }
#pragma unroll
                    for (int d0 = 0; d0 < 4; ++d0) {
                        const bf16x8 a0 = *(const LAS bf16x8*)(Kb + r32 * FX_KROW + 32 * d0 + 16 * hh);
                        const bf16x8 a1 = *(const LAS bf16x8*)(Kb + (r32 + 32) * FX_KROW + 32 * d0 + 16 * hh);
                        p0 = __builtin_amdgcn_mfma_f32_32x32x16_bf16(a0, qf[d0], p0, 0, 0, 0);
                        p1 = __builtin_amdgcn_mfma_f32_32x32x16_bf16(a1, qf[d0], p1, 0, 0, 0);
                    }
                    const bool diag = 64 * j + 63 > q0;
                    float tmax = -INFINITY;
#pragma unroll
                    for (int g = 0; g < 4; ++g) {
                        const f32x4 dk0 = *(const LAS f32x4*)(dkb + 8 * g + 4 * hh), dk1 = *(const LAS f32x4*)(dkb + 32 + 8 * g + 4 * hh);
#pragma unroll
                        for (int i = 0; i < 4; ++i) {
                            float z0 = p0[4 * g + i] * CS + (dq - dk0[i]), z1 = p1[4 * g + i] * CS + (dq - dk1[i]);
                            if (diag) { const int key = 64 * j + 8 * g + 4 * hh + i; if (key > myq) z0 = -INFINITY; if (key + 32 > myq) z1 = -INFINITY; }
                            p0[4 * g + i] = z0; p1[4 * g + i] = z1; tmax = fmaxf(tmax, fmaxf(z0, z1)); }
                    }
                    tmax = fmaxf(tmax, __shfl_xor(tmax, 32));
                    const float mn = fmaxf(m, tmax); const float corr = __builtin_amdgcn_exp2f(m - mn); m = mn;
                    float ps = 0.f;
#pragma unroll
                    for (int r = 0; r < 16; ++r) { p0[r] = __builtin_amdgcn_exp2f(p0[r] - mn); p1[r] = __builtin_amdgcn_exp2f(p1[r] - mn); ps += p0[r] + p1[r]; }
                    lsum = lsum * corr + ps;
#pragma unroll
                    for (int r = 0; r < 16; ++r) { o[0][r] *= corr; o[1][r] *= corr; }
                    bf16x8 pf[4];
#pragma unroll
                    for (int s4 = 0; s4 < 4; ++s4) {
                        v4u w;
                        if (s4 < 2) { w.x = pk2(p0[8 * s4 + 0], p0[8 * s4 + 1]); w.y = pk2(p0[8 * s4 + 2], p0[8 * s4 + 3]); w.z = pk2(p0[8 * s4 + 4], p0[8 * s4 + 5]); w.w = pk2(p0[8 * s4 + 6], p0[8 * s4 + 7]); }
                        else { const int sp = s4 - 2; w.x = pk2(p1[8 * sp + 0], p1[8 * sp + 1]); w.y = pk2(p1[8 * sp + 2], p1[8 * sp + 3]); w.z = pk2(p1[8 * sp + 4], p1[8 * sp + 5]); w.w = pk2(p1[8 * sp + 6], p1[8 * sp + 7]); }
                        pf[s4] = __builtin_bit_cast(bf16x8, w);
                    }
                    const int gi = lane >> 4, li = lane & 15;
                    const LAS unsigned char* vbase = Vb + (4 * (gi >> 1) + (li >> 2)) * FX_VROW + (16 * (gi & 1) + 4 * (li & 3)) * 2;
#pragma unroll
                    for (int d0 = 0; d0 < 2; ++d0)
#pragma unroll
                        for (int s4 = 0; s4 < 4; ++s4) {
                            const s16x4 lo = __builtin_bit_cast(s16x4, __builtin_amdgcn_ds_read_tr16_b64_v4i16((LAS s16x4*)(vbase + (16 * s4) * FX_VROW + 64 * d0)));
                            const s16x4 hi = __builtin_bit_cast(s16x4, __builtin_amdgcn_ds_read_tr16_b64_v4i16((LAS s16x4*)(vbase + (16 * s4 + 8) * FX_VROW + 64 * d0)));
                            const bf16x8 vf = (bf16x8){lo[0], lo[1], lo[2], lo[3], hi[0], hi[1], hi[2], hi[3]};
                            o[d0] = __builtin_amdgcn_mfma_f32_32x32x16_bf16(vf, pf[s4], o[d0], 0, 0, 0);
                        }
                }
                if (j + 1 < NT) {
                    *(LAS v4u*)(F.lds + nxt + srow * FX_KROW + sch * 16) = kreg; *(LAS v4u*)(F.lds + nxt + FX_KB + srow * FX_VROW + sch * 16) = vreg;
                    if (tid < 64) *(LAS float*)(F.lds + nxt + FX_KB + FX_VB + tid * 4) = dreg;
                }
                __syncthreads();
            }
            const float l = lsum + __shfl_xor(lsum, 32); const float inv = 1.f / l;
            const bf16* gp = base + (size_t)myq * ODD_N + 1536 + h * 64; bf16* op = MIX + ((size_t)b * SEQ + myq) * D + h * 64;
#pragma unroll
            for (int d0 = 0; d0 < 2; ++d0)
#pragma unroll
                for (int g = 0; g < 4; ++g) { const int db = 32 * d0 + 8 * g + 4 * hh; const v2u gw = *(const v2u*)(gp + db);
                    const float g0 = sigmoidf_(bflo(gw.x)), g1 = sigmoidf_(bfhi(gw.x)), g2 = sigmoidf_(bflo(gw.y)), g3 = sigmoidf_(bfhi(gw.y));
                    v2u ow; ow.x = pk2(o[d0][4 * g + 0] * inv * g0, o[d0][4 * g + 1] * inv * g1); ow.y = pk2(o[d0][4 * g + 2] * inv * g2, o[d0][4 * g + 3] * inv * g3);
                    *(v2u*)(op + db) = ow; }
        }
    }
}

__device__ __forceinline__ void phase_rwkv_post(Frame& F, int layer) {
    KARGS;
    const int jj = layer >> 1, ch = F.tid;
    const float* R = WSP(float, WS_RW); const float* K = WSP(float, WS_RW + 2 * RW_SLOT); const float* V = WSP(float, WS_RW + 3 * RW_SLOT);
    const float* Gt = WSP(float, WS_RW + 6 * RW_SLOT); const float* Y = WSP(float, WS_RW + 7 * RW_SLOT);
    bf16* MIX = WSP(bf16, WS_MIX);
    const float lw = IN(24)[jj * 512 + ch], lb = IN(25)[jj * 512 + ch], rk = IN(23)[jj * 512 + ch];
    for (int tg = F.bid; tg < T; tg += F.G) {
        const size_t o = (size_t)tg * 512 + ch;
        const float y = Y[o]; const float mu = wave_sum(y) * (1.f / 64.f); const float dlt = y - mu; const float var = wave_sum(dlt * dlt) * (1.f / 64.f);
        const float yn = dlt * rsqrtf(var + GN_EPS) * lw + lb;
        const float v = V[o]; const float bonus = wave_sum(R[o] * K[o] * rk) * v;
        MIX[(size_t)tg * D + 512 + ch] = (bf16)f2bf((yn + bonus) * Gt[o]);
    }
}

#define BUBBLE(x_, V_) do { float bx_ = (x_); _Pragma("unroll") for (int p_ = 0; p_ < 16; ++p_) { const float hi_ = fmaxf(bx_, V_[p_]); bx_ = fminf(bx_, V_[p_]); V_[p_] = hi_; } } while (0)
__device__ __forceinline__ float pack_low(float v, unsigned bits, unsigned mask) { return __builtin_bit_cast(float, (__builtin_bit_cast(unsigned, v) & ~mask) | bits); }
__device__ __forceinline__ void phase_peer_topk(Frame& F, int layer) {
    KARGS;
    const bf16* Q = WSP(bf16, WS_Q); const bf16* KEYS = WSP(bf16, WS_KEYS) + (size_t)layer * 2 * 16384;
    int* IDX = WSP(int, WS_IDX); float* GATE = WSP(float, WS_GATE);
    LAS float* sc = (LAS float*)(F.lds + F.wave * 16512);
    LAS unsigned* li = (LAS unsigned*)sc;
    const int lane = F.lane, fr = lane & 15, fq = lane >> 4;
    const int gw = F.bid * NWAVES + F.wave, NGW = F.G * NWAVES;
    for (int it = gw; it < (T / 32) * 8; it += NGW) {
        const int tile = it >> 3, h = it & 7, t0 = tile * 32;
        float v1[16], v2[16];
#pragma unroll
        for (int half = 0; half < 2; ++half) {
            f32x4 acc[2][8];
#pragma unroll
            for (int rt = 0; rt < 2; ++rt)
#pragma unroll
                for (int ct = 0; ct < 8; ++ct) acc[rt][ct] = (f32x4){0.f, 0.f, 0.f, 0.f};
            const bf16* kb = KEYS + (size_t)half * 16384;
#pragma unroll 1
            for (int ks = 0; ks < 4; ++ks) {
                bf16x8 a[2];
#pragma unroll
                for (int rt = 0; rt < 2; ++rt) a[rt] = *(const bf16x8*)(Q + (size_t)(t0 + rt * 16 + fr) * 2048 + h * 256 + half * 128 + ks * 32 + 8 * fq);
#pragma unroll
                for (int ct = 0; ct < 8; ++ct) { const bf16x8 bb = *(const bf16x8*)(kb + (size_t)(ct * 16 + fr) * 128 + ks * 32 + 8 * fq);
#pragma unroll
                    for (int rt = 0; rt < 2; ++rt) acc[rt][ct] = __builtin_amdgcn_mfma_f32_16x16x32_bf16(a[rt], bb, acc[rt][ct], 0, 0, 0); }
            }
#pragma unroll
            for (int rt = 0; rt < 2; ++rt)
#pragma unroll
                for (int ct = 0; ct < 8; ++ct)
#pragma unroll
                    for (int r = 0; r < 4; ++r) sc[(rt * 16 + 4 * fq + r) * 129 + ct * 16 + fr] = pack_low(acc[rt][ct][r], (unsigned)(ct * 16 + fr), 0x7Fu);
            LDS_WAIT(); asm volatile("" ::: "memory");
            float vv[16];
#pragma unroll
            for (int p = 0; p < 16; ++p) vv[p] = -INFINITY;
            if (lane < 32) { const LAS float* row = sc + lane * 129;
#pragma unroll 4
                for (int n = 0; n < 128; ++n) { const float x = row[n]; BUBBLE(x, vv); } }
            LDS_WAIT(); asm volatile("" ::: "memory");
#pragma unroll
            for (int p = 0; p < 16; ++p) { if (half == 0) v1[p] = vv[p]; else v2[p] = vv[p]; }
        }
        if (lane < 32) {
#pragma unroll
            for (int p = 0; p < 16; ++p) { li[lane * 33 + p] = __builtin_bit_cast(unsigned, v1[p]) & 0x7Fu; li[lane * 33 + 16 + p] = __builtin_bit_cast(unsigned, v2[p]) & 0x7Fu; }
            float ts[16];
#pragma unroll
            for (int p = 0; p < 16; ++p) ts[p] = -INFINITY;
#pragma unroll
            for (int a = 0; a < 16; ++a)
#pragma unroll
                for (int bq = 0; bq < 16; ++bq) if ((a + 1) * (bq + 1) <= 16) { const float x = pack_low(v1[a] + v2[bq], (unsigned)(a * 16 + bq), 0xFFu); BUBBLE(x, ts); }
            LDS_WAIT(); asm volatile("" ::: "memory");
            float e[16], sum = 0.f;
#pragma unroll
            for (int p = 0; p < 16; ++p) { e[p] = expf(ts[p] - ts[0]); sum += e[p]; }
            const float inv = 1.f / sum;
            int* ip = IDX + (size_t)(t0 + lane) * 128 + h * 16; float* gp = GATE + (size_t)(t0 + lane) * 128 + h * 16;
#pragma unroll
            for (int p = 0; p < 16; ++p) { const unsigned ab = __builtin_bit_cast(unsigned, ts[p]) & 0xFFu;
                ip[p] = (int)(li[lane * 33 + (ab >> 4)] * 128u + li[lane * 33 + 16 + (ab & 15u)]); gp[p] = e[p] * inv; }
        }
        LDS_WAIT(); asm volatile("" ::: "memory");
    }
}

typedef float f32x2 __attribute__((ext_vector_type(2)));
__device__ __forceinline__ void unpack16_fp8(float (&o)[16], const v4u w) {
#pragma unroll
    for (int j = 0; j < 4; ++j) { const f32x2 a = __builtin_amdgcn_cvt_pk_f32_fp8((int)w[j], false), b = __builtin_amdgcn_cvt_pk_f32_fp8((int)w[j], true); o[4 * j] = a.x; o[4 * j + 1] = a.y; o[4 * j + 2] = b.x; o[4 * j + 3] = b.y; }
}
__device__ __forceinline__ void phase_peer_gather(Frame& F, int layer, bool dummy) {
    KARGS;
    bf16* H = WSP(bf16, WS_H); const int* IDX = WSP(int, WS_IDX); const float* GATE = WSP(float, WS_GATE);
    const unsigned char* U = WSP(unsigned char, WS_PU) + (size_t)layer * NEXP * 1024; const unsigned char* Vt = WSP(unsigned char, WS_PV) + (size_t)layer * NEXP * 1024;
    const float* SU = WSP(float, WS_PS) + (size_t)layer * NEXP; const float* SV = SU + 4 * NEXP;
    const float* g2 = WSP(float, WS_MOD) + (size_t)layer * 2 * 6144 + 5120;
    const float* X = OUTP; float* XO = dummy ? WSP(float, WS_PROJ) : OUTP;
    const int lane = F.lane, gw = F.bid * NWAVES + F.wave, NGW = F.G * NWAVES;
    const bool last = layer == DEPTH - 1; const int nl = layer + 1;
    const float* ngain = last ? IN(31) : IN(4) + nl * 1024;
    const float* nmod = WSP(float, WS_MOD) + (size_t)(last ? 0 : nl) * 2 * 6144;
    const bool do_f = !last && (nl & 1);
    const float* WF = WSP(float, WS_WF) + (size_t)(nl >> 1) * 8 * 1024; float* LOGF = WSP(float, WS_LOGF);
    for (int tg = gw; tg < T; tg += NGW) {
        const int b = tg >= SEQ ? 1 : 0;
        float x[16];
        { const v4u w0 = *(const v4u*)(H + (size_t)tg * D + 16 * lane), w1 = *(const v4u*)(H + (size_t)tg * D + 16 * lane + 8);
          x[0] = bflo(w0.x); x[1] = bfhi(w0.x); x[2] = bflo(w0.y); x[3] = bfhi(w0.y); x[4] = bflo(w0.z); x[5] = bfhi(w0.z); x[6] = bflo(w0.w); x[7] = bfhi(w0.w);
          x[8] = bflo(w1.x); x[9] = bfhi(w1.x); x[10] = bflo(w1.y); x[11] = bfhi(w1.y); x[12] = bflo(w1.z); x[13] = bfhi(w1.z); x[14] = bflo(w1.w); x[15] = bfhi(w1.w); }
        const int id0 = IDX[(size_t)tg * 128 + lane], id1 = IDX[(size_t)tg * 128 + 64 + lane];
        const float su0 = SU[id0], su1 = SU[id1];
        const float gv0 = GATE[(size_t)tg * 128 + lane] * SV[id0], gv1 = GATE[(size_t)tg * 128 + 64 + lane] * SV[id1];
        float acc[16];
#pragma unroll
        for (int i = 0; i < 16; ++i) acc[i] = 0.f;
#pragma unroll 1
        for (int e0 = 0; e0 < 128; e0 += 8) {
            int idx[8]; float d[8]; v4u ua[8];
#pragma unroll
            for (int q = 0; q < 8; ++q) { idx[q] = __builtin_amdgcn_readlane(e0 < 64 ? id0 : id1, (e0 + q) & 63); ua[q] = *(const v4u*)(U + (size_t)idx[q] * 1024 + 16 * lane); }
#pragma unroll
            for (int q = 0; q < 8; ++q) { float u[16]; unpack16_fp8(u, ua[q]); float sm = 0.f;
#pragma unroll
                for (int i = 0; i < 16; ++i) sm += u[i] * x[i];
                d[q] = sm; }
#pragma unroll
            for (int q = 0; q < 8; ++q) ua[q] = *(const v4u*)(Vt + (size_t)idx[q] * 1024 + 16 * lane);
#pragma unroll
            for (int o = 1; o < 64; o <<= 1) {
#pragma unroll
                for (int q = 0; q < 8; ++q) d[q] += __shfl_xor(d[q], o); }
#pragma unroll
            for (int q = 0; q < 8; ++q) d[q] = gelu_erf(d[q] * rl(e0 < 64 ? su0 : su1, (e0 + q) & 63)) * rl(e0 < 64 ? gv0 : gv1, (e0 + q) & 63);
#pragma unroll
            for (int q = 0; q < 8; ++q) { float v[16]; unpack16_fp8(v, ua[q]);
#pragma unroll
                for (int i = 0; i < 16; ++i) acc[i] += v[i] * d[q]; }
        }
        const float* xr = X + (size_t)tg * D + 16 * lane; float* xo = XO + (size_t)tg * D + 16 * lane; const float* gg = g2 + b * 6144 + 16 * lane;
        f32x4 xn[4]; float ss = 0.f;
#pragma unroll
        for (int j = 0; j < 4; ++j) { const f32x4 g4 = *(const f32x4*)(gg + 4 * j); const f32x4 xv = *(const f32x4*)(xr + 4 * j);
            xn[j] = xv + g4 * (f32x4){acc[4 * j], acc[4 * j + 1], acc[4 * j + 2], acc[4 * j + 3]};
            ss += (xn[j].x * xn[j].x + xn[j].y * xn[j].y) + (xn[j].z * xn[j].z + xn[j].w * xn[j].w); }
        const float rstd = rsqrtf(wave_sum(ss) * (1.f / D) + NORM_EPS);
        if (last) {
#pragma unroll
            for (int j = 0; j < 4; ++j) *(f32x4*)(xo + 4 * j) = xn[j] * rstd * *(const f32x4*)(ngain + 16 * lane + 4 * j);
        } else {
            const float* sh = nmod + b * 6144 + 16 * lane; const float* sc = sh + 1024;
            f32x4 hv[4];
#pragma unroll
            for (int j = 0; j < 4; ++j) { *(f32x4*)(xo + 4 * j) = xn[j];
                hv[j] = xn[j] * rstd * *(const f32x4*)(ngain + 16 * lane + 4 * j) * (*(const f32x4*)(sc + 4 * j) + 1.f) + *(const f32x4*)(sh + 4 * j); }
            if (!dummy) { v4u o0, o1; o0.x = pk2(hv[0].x, hv[0].y); o0.y = pk2(hv[0].z, hv[0].w); o0.z = pk2(hv[1].x, hv[1].y); o0.w = pk2(hv[1].z, hv[1].w);
                o1.x = pk2(hv[2].x, hv[2].y); o1.y = pk2(hv[2].z, hv[2].w); o1.z = pk2(hv[3].x, hv[3].y); o1.w = pk2(hv[3].z, hv[3].w);
                *(v4u*)(H + (size_t)tg * D + 16 * lane) = o0; *(v4u*)(H + (size_t)tg * D + 16 * lane + 8) = o1; }
            if (do_f && !dummy) {
                const float* fb = IN(14) + (nl >> 1) * 8; const int t = tg - b * SEQ;
#pragma unroll
                for (int hq = 0; hq < 8; ++hq) { float dd = 0.f;
#pragma unroll
                    for (int j = 0; j < 4; ++j) { const f32x4 w4 = *(const f32x4*)(WF + hq * 1024 + 16 * lane + 4 * j); dd += (hv[j].x * w4.x + hv[j].y * w4.y) + (hv[j].z * w4.z + hv[j].w * w4.w); }
                    dd = wave_sum(dd) + fb[hq];
                    const float lf = fminf(dd, 0.f) - log1pf(expf(-fabsf(dd)));
                    if (lane == 0) LOGF[(size_t)(b * 8 + hq) * SEQ + t] = lf; }
            }
        }
    }
}

__device__ __forceinline__ void phase_final(Frame& F) {
    KARGS;
    float* X = OUTP; const float* gain = IN(31);
    const int lane = F.lane, gw = F.bid * NWAVES + F.wave, NGW = F.G * NWAVES;
    f32x4 gn[4];
#pragma unroll
    for (int j = 0; j < 4; ++j) gn[j] = *(const f32x4*)(gain + 256 * j + 4 * lane);
    for (int row = gw; row < T; row += NGW) {
        float* xr = X + (size_t)row * D + 4 * lane;
        f32x4 v[4]; float ss = 0.f;
#pragma unroll
        for (int j = 0; j < 4; ++j) { v[j] = *(const f32x4*)(xr + 256 * j); ss += (v[j].x * v[j].x + v[j].y * v[j].y) + (v[j].z * v[j].z + v[j].w * v[j].w); }
        const float rstd = rsqrtf(wave_sum(ss) * (1.f / D) + NORM_EPS);
#pragma unroll
        for (int j = 0; j < 4; ++j) *(f32x4*)(xr + 256 * j) = v[j] * rstd * gn[j];
    }
}

#ifndef PROBE_DUP
#define PROBE_DUP 0
#endif
#ifndef PH_MASK
#define PH_MASK 0xFFFF
#endif
#define PH_EN(k) ((PH_MASK >> (k)) & 1)
constexpr int NPH = 46;
__host__ __device__ inline bool phase_skipped(int p) { if (p == 0) return false; if (p == NPH - 1) return true; const int layer = (p - 1) / 11, step = (p - 1) % 11;
    if (step == 0 && layer > 0) return true;
    return (layer & 1) == 0 && (step == 3 || step == 4 || step == 5); }
__global__ void __launch_bounds__(NTHR, 2) mk_fwd(Args args) {
    extern __shared__ __attribute__((aligned(16))) unsigned char lds[];
    Frame F;
    F.lds = (LAS unsigned char*)lds;
    F.MISC = (volatile LAS unsigned*)(F.lds + MISC_OFF);
    F.tid = threadIdx.x; F.lane = F.tid & 63; F.wave = __builtin_amdgcn_readfirstlane(F.tid >> 6);
    F.G = gridDim.x; F.bid = blockIdx.x;
    F.ctl = (gu32*)(args.ws + WS_CTL);
    for (int u = F.tid; u < (LDS_BYTES - MISC_OFF) / 4; u += NTHR) ((LAS unsigned*)(F.lds + MISC_OFF))[u] = 0u;
    __syncthreads();
    XcdBarrier bar; bar.bar = (unsigned*)(F.ctl + CW_BAR); bar.x = 0; bar.st = nullptr;
    const int lo = args.ph_lo, hi = args.ph_hi;
    if (hi - lo > 1) bar = xcd_barrier_post((unsigned*)(F.ctl + CW_BAR), F.MISC + 8);
    bool ran = false;
    for (int p = lo; p < hi; ++p) {
        if (phase_skipped(p)) continue;
        if (ran) xcd_barrier(bar);
        ran = true;
        { int t_ = threadIdx.x; asm volatile("" : "+v"(t_)); F.tid = t_; F.lane = t_ & 63; F.wave = __builtin_amdgcn_readfirstlane(t_ >> 6);
          int b_ = blockIdx.x, g_ = gridDim.x; asm volatile("" : "+s"(b_), "+s"(g_)); F.bid = b_; F.G = g_; }
        if (p == 0) { if (PH_EN(0)) phase_prologue(F); continue; }
        if (p == NPH - 1) { if (PH_EN(1)) phase_final(F); continue; }
        const int layer = (p - 1) / 11, step = (p - 1) % 11; const bool odd = layer & 1;
        KARGS;
        if (step == 0 || step == 7) { if (PH_EN(2)) phase_norm(F, layer, step == 7 ? 1 : 0); }
        else if (step == 1 || step == 8) { if (PH_EN(3)) {
            const int N = step == 8 ? 2048 : (odd ? ODD_N : EVEN_IN);
            const bf16* Bt = step == 8 ? WSP(bf16, WS_WQ + (size_t)layer * 4 * MiB) : WSP(bf16, WS_WIN + (size_t)layer * 8 * MiB);
            bf16* O = step == 8 ? WSP(bf16, WS_Q) : WSP(bf16, WS_PROJ);
            pg8::Gemm g{WSP(bf16, WS_H), Bt, T, N, D}; pg8::StaticOrder S; S.init(T, N, F.G, F.bid);
            pg8::EpiBf16<0> E{O, N, nullptr, 0, 0, 1.f};
            pg8::gemm_phase<pg8::EpiBf16<0>, pg8::StaticOrder, PG8_ALIGN, PG8_SP2>(F.lds + RING_OFF, g, S, E);
        } }
        else if (step == 2) { if (odd) { if (PH_EN(4)) phase_odd_prep(F, layer); } else { if (PH_EN(5)) {
#if (PROBE_DUP >> 5) & 1
            phase_even_mixer(F, layer);
#endif
            phase_even_mixer(F, layer); } } }
        else if (step == 3) { if (PH_EN(11)) phase_rwkv_chunk(F, layer); }
        else if (step == 4) { if (PH_EN(6)) phase_odd_main(F, layer); }
        else if (step == 5) { if (PH_EN(7)) phase_rwkv_post(F, layer); }
        else if (step == 6) { if (PH_EN(8)) {
            pg8::Gemm g{WSP(bf16, WS_MIX), WSP(bf16, WS_WOUT + (size_t)layer * 2 * MiB), T, D, D}; pg8::StaticOrder S; S.init(T, D, F.G, F.bid);
            pg8::EpiResid E{layer == 0 ? IN(0) : OUTP, OUTP, WSP(float, WS_MOD) + (size_t)layer * 2 * 6144 + 2048, 6144};
            pg8::gemm_phase<pg8::EpiResid, pg8::StaticOrder, PG8_ALIGN, PG8_SP2>(F.lds + RING_OFF, g, S, E);
        } }
        else if (step == 9) { if (PH_EN(9)) {
#if (PROBE_DUP >> 9) & 1
            phase_peer_topk(F, layer);
#endif
            phase_peer_topk(F, layer); } }
        else { if (PH_EN(10)) {
#if (PROBE_DUP >> 10) & 1
            phase_peer_gather(F, layer, true);
#endif
            phase_peer_gather(F, layer, false); } }
    }
}

extern "C" void kernel_launch(void* const* d_in, const int* in_sizes, int n_in, void* d_out, int out_size, void* d_ws, size_t ws_size, hipStream_t stream) {
    static int grid = 0;
    if (grid == 0) {
        if (n_in != 32 || in_sizes[0] != T * D || out_size != T * D || ws_size < WS_END) { fprintf(stderr, "kernel_launch: unexpected shapes (n_in %d, in0 %d, out %d, ws %zu < %zu); nothing launched\n", n_in, n_in > 0 ? in_sizes[0] : -1, out_size, ws_size, (size_t)WS_END); grid = -1; return; }
        int dev = 0, cus = 0, per_cu = 0;
        if (hipGetDevice(&dev) != hipSuccess || hipDeviceGetAttribute(&cus, hipDeviceAttributeMultiprocessorCount, dev) != hipSuccess) { grid = -1; return; }
        if (hipFuncSetAttribute((const void*)mk_fwd, hipFuncAttributeMaxDynamicSharedMemorySize, LDS_BYTES) != hipSuccess) { fprintf(stderr, "kernel_launch: hipFuncSetAttribute failed\n"); grid = -1; return; }
        if (hipOccupancyMaxActiveBlocksPerMultiprocessor(&per_cu, (const void*)mk_fwd, NTHR, LDS_BYTES) != hipSuccess || per_cu < 1) fprintf(stderr, "kernel_launch: occupancy query reports %d workgroups per CU\n", per_cu);
        (void)hipGetLastError();
        grid = cus;
    }
    if (grid < 0) return;
    if (hipMemsetAsync((char*)d_ws + WS_CTL, 0, CTL_ZERO_BYTES, stream) != hipSuccess) { fprintf(stderr, "kernel_launch: hipMemsetAsync failed\n"); return; }
    Args a{};
    for (int i = 0; i < 32; ++i) a.in[i] = (const float*)d_in[i];
    a.out = (float*)d_out; a.ws = (unsigned char*)d_ws;
#if MK_ONE_LAUNCH
    a.ph_lo = 0; a.ph_hi = NPH;
    hipLaunchKernelGGL(mk_fwd, dim3(grid), dim3(NTHR), LDS_BYTES, stream, a);
#else
    for (int p = 0; p < NPH; ++p) { if (phase_skipped(p)) continue; a.ph_lo = p; a.ph_hi = p + 1;
        hipLaunchKernelGGL(mk_fwd, dim3(grid), dim3(NTHR), LDS_BYTES, stream, a); }
#endif
    const hipError_t le = hipPeekAtLastError();
    if (le != hipSuccess) fprintf(stderr, "kernel_launch: launch failed: %s\n", hipGetErrorName(le));
}
```

```cpp
#include <hip/hip_runtime.h>
#include <cstdio>
#include <cstdint>
namespace pg8 {
#define PG8_LAS __attribute__((address_space(3)))
typedef unsigned short bf16_t;
typedef short bf16x8 __attribute__((ext_vector_type(8)));
typedef float f32x4 __attribute__((ext_vector_type(4)));
typedef unsigned u32x4 __attribute__((ext_vector_type(4)));
constexpr int BM = 256, BK = 64, HALF = 128, HTB = HALF * BK * 2  , STAGE_BYTES = 8 * HTB, NXCD = 8, WGM = 8;

__host__ __device__ __forceinline__ int lds_byte(int r, int c) { const int st = (r >> 4) * 2 + (c >> 5), rr = r & 15, cc = c & 31, ob = rr * 64 + cc * 2; return st * 1024 + (ob ^ (((ob >> 9) & 1) << 5)); }
__host__ __device__ __forceinline__ void stage_rc(int b, int& R, int& C) { const int st = b / 1024, sb = b % 1024, swz = sb ^ (((sb >> 9) & 1) << 5); R = (st >> 1) * 16 + swz / 64; C = (st & 1) * 32 + (swz % 64) / 2; }
__host__ __device__ __forceinline__ int perm32(int rho) { const int n = rho >> 4, i = rho & 15; return 8 * (i >> 2) + 4 * n + (i & 3); }

struct Unit { int pm, pn; };
struct Gemm { const bf16_t* A; const bf16_t* Bt; int M, N, K; };

struct StaticOrder {
    int nM, nN, nwg, G, c;
    __host__ __device__ void init(int M, int N, int G_, int c_) { nM = M / BM; nN = N / BM; nwg = nM * nN; G = G_; c = c_; }
    __host__ __device__ bool next(int i, Unit& u) const {
        const long L = (long)i * G + c; if (L >= nwg) return false;
        int wgid = (int)L; { const int q = nwg / NXCD, r = nwg % NXCD, xcd = wgid % NXCD, off = wgid / NXCD; wgid = (xcd < r ? xcd * (q + 1) : r * (q + 1) + (xcd - r) * q) + off; }
        const int nig = WGM * nN, gid = wgid / nig, fm = gid * WGM, gsz = (nM - fm) < WGM ? (nM - fm) : WGM;
        u.pm = fm + ((wgid % nig) % gsz); u.pn = (wgid % nig) / gsz; return true;
    }
    __device__ __forceinline__ void a_ready(const Unit&) const {}
    __device__ __forceinline__ void done(const Unit&) const {}
};

__device__ __forceinline__ unsigned cvt_pk_bf16(float lo, float hi) { unsigned r; asm volatile("v_cvt_pk_bf16_f32 %0, %1, %2" : "=v"(r) : "v"(lo), "v"(hi)); return r; }
typedef float f32x2 __attribute__((ext_vector_type(2)));
__device__ __forceinline__ f32x2 gelu_pk(f32x2 v) {
    const f32x2 av = __builtin_elementwise_abs(v), d = av * 0.2316418882f + 1.0f;
    f32x2 t; t.x = __builtin_amdgcn_rcpf(d.x); t.y = __builtin_amdgcn_rcpf(d.y);
    f32x2 q = t * 0.5307027145f + (-0.7265760135f); q = q * t + 0.7107068705f; q = q * t + (-0.142248368f); q = q * t + 0.127414796f; q = q * t;
    const f32x2 s = (v * v) * (-0.72134752044f);
    f32x2 e; e.x = __builtin_amdgcn_exp2f(s.x); e.y = __builtin_amdgcn_exp2f(s.y);
    const f32x2 m = v * (q * e), r = v - m;
    f32x2 o; o.x = v.x < 0.f ? m.x : r.x; o.y = v.y < 0.f ? m.y : r.y; return o;
}

template <int ACT  > struct EpiBf16 {
    static constexpr bool PERM = true, AFTER_DRAIN = false; static_assert(ACT == 0 || ACT == 1, "EpiBf16: ACT is 0 (none) or 1 (gelu_pk)");
    bf16_t* O; int ldc; const float* bias; int split_cols; size_t split_stride; float scale0;
    __device__ __forceinline__ void operator()(const f32x4 (&acc)[2][2][4][2], const Unit& u, int wr, int wc, int fr, int fq) const {
        const int row0 = u.pm * BM + wr * 64 + fr; int colt = u.pn * BM; bf16_t* base = O;
        float sc = 1.f; if (split_cols) { const int t = colt / split_cols; base += (size_t)t * split_stride; colt -= t * split_cols; if (t == 0) sc = scale0; }
        const int col0 = colt + wc * 32 + 8 * fq, bcol0 = u.pn * BM + wc * 32 + 8 * fq;
        f32x4 bv[2][2];
#pragma unroll
        for (int bj = 0; bj < 2; ++bj)
#pragma unroll
            for (int n = 0; n < 2; ++n) bv[bj][n] = bias ? *(const f32x4*)(bias + bcol0 + bj * HALF + 4 * n) : (f32x4){0.f, 0.f, 0.f, 0.f};
#pragma unroll
        for (int ai = 0; ai < 2; ++ai)
#pragma unroll
            for (int m = 0; m < 4; ++m) { bf16_t* rowp = base + (size_t)(row0 + ai * HALF + m * 16) * ldc + col0;
#pragma unroll
                for (int bj = 0; bj < 2; ++bj) { f32x4 v0 = acc[ai][bj][m][0] + bv[bj][0], v1 = acc[ai][bj][m][1] + bv[bj][1];
                    if (ACT == 1) { f32x2 a = gelu_pk((f32x2){v0[0], v0[1]}), b = gelu_pk((f32x2){v0[2], v0[3]}), c = gelu_pk((f32x2){v1[0], v1[1]}), d = gelu_pk((f32x2){v1[2], v1[3]});
                        v0 = (f32x4){a.x, a.y, b.x, b.y}; v1 = (f32x4){c.x, c.y, d.x, d.y}; }
                    v0 = v0 * sc; v1 = v1 * sc; u32x4 w; w.x = cvt_pk_bf16(v0[0], v0[1]); w.y = cvt_pk_bf16(v0[2], v0[3]); w.z = cvt_pk_bf16(v1[0], v1[1]); w.w = cvt_pk_bf16(v1[2], v1[3]);
                    *(u32x4*)(rowp + bj * HALF) = w; } }
    }
};
struct EpiResid {
    static constexpr bool PERM = false, AFTER_DRAIN = false;
    const float* base; float* out; const float* gate; int gstride;
    __device__ __forceinline__ void operator()(const f32x4 (&acc)[2][2][4][2], const Unit& u, int wr, int wc, int fr, int fq) const {
        const int row0 = u.pm * BM + wr * 64 + fr; const int col0 = u.pn * BM + wc * 32 + 4 * fq;
        const float* gp = gate + ((u.pm * BM) >= 8192 ? gstride : 0);
        f32x4 gv[2][2];
#pragma unroll
        for (int bj = 0; bj < 2; ++bj)
#pragma unroll
            for (int n = 0; n < 2; ++n) gv[bj][n] = *(const f32x4*)(gp + col0 + bj * HALF + n * 16);
#pragma unroll
        for (int ai = 0; ai < 2; ++ai)
#pragma unroll
            for (int m = 0; m < 4; ++m) { const size_t off = (size_t)(row0 + ai * HALF + m * 16) * 1024 + col0;
#pragma unroll
                for (int bj = 0; bj < 2; ++bj)
#pragma unroll
                    for (int n = 0; n < 2; ++n) { const f32x4 bs = *(const f32x4*)(base + off + bj * HALF + n * 16);
                        *(f32x4*)(out + off + bj * HALF + n * 16) = bs + gv[bj][n] * acc[ai][bj][m][n]; } }
    }
};
template <class Epi, class Sched, bool ALIGN_EPI = false, bool SP2 = false>
__device__ __forceinline__ void gemm_phase(PG8_LAS unsigned char* lds, const Gemm g, const Sched& S, const Epi& E) {
    int tid_l = threadIdx.x; asm volatile("" : "+v"(tid_l));
    const int tid = tid_l, wid = __builtin_amdgcn_readfirstlane(tid >> 6), lane = tid & 63, wr = wid >> 2, wc = wid & 3, fr = lane & 15, fq = lane >> 4;
    const int K = g.K, nt = K / BK;
    unsigned voffA[2], voffB[2];
#pragma unroll
    for (int i = 0; i < 2; ++i) { int R, C; stage_rc(tid * 16 + i * 8192, R, C); const int Rb = Epi::PERM ? ((R & ~31) + perm32(R & 31)) : R;
        voffA[i] = (unsigned)(R * K + C) * 2u; voffB[i] = (unsigned)(Rb * K + C) * 2u; }
    const size_t kstep = (size_t)(BK * 2);
    const size_t hstep = (size_t)HALF * K * 2;
    const size_t tstep = 2 * hstep;
    const unsigned ldsw = (unsigned)wid * 1024u;
    const int aoff = lds_byte(wr * 64 + fr, fq * 8), boff = lds_byte(wc * 32 + fr, fq * 8);
#define PG8_SA(b, h) (((b) * 2 + (h)) * HTB)
#define PG8_SB(b, h) ((4 + (b) * 2 + (h)) * HTB)
#define PG8_STAGE(bufoff, gbase, voff) do { _Pragma("unroll") for (int _i = 0; _i < 2; ++_i) \
        __builtin_amdgcn_global_load_lds((const unsigned*)((const char*)(gbase) + (voff)[_i]), (PG8_LAS unsigned*)(lds + (bufoff) + ldsw + _i * 8192), 16, 0, 0); } while (0)
#define PG8_LDA(dst, b, h) do { _Pragma("unroll") for (int m = 0; m < 4; ++m) _Pragma("unroll") for (int k = 0; k < 2; ++k) dst[m][k] = *(const PG8_LAS bf16x8*)(lds + PG8_SA(b, h) + aoff + m * 2048 + k * 1024); } while (0)
#define PG8_LDB(dst, b, h) do { _Pragma("unroll") for (int n = 0; n < 2; ++n) _Pragma("unroll") for (int k = 0; k < 2; ++k) dst[n][k] = *(const PG8_LAS bf16x8*)(lds + PG8_SB(b, h) + boff + n * 2048 + k * 1024); } while (0)
#define PG8_MMA(ai, bj, At, Bt) do { __builtin_amdgcn_s_setprio(1); _Pragma("unroll") for (int m = 0; m < 4; ++m) _Pragma("unroll") for (int n = 0; n < 2; ++n) _Pragma("unroll") for (int k = 0; k < 2; ++k) \
        acc[ai][bj][m][n] = __builtin_amdgcn_mfma_f32_16x16x32_bf16(Bt[n][k], At[m][k], acc[ai][bj][m][n], 0, 0, 0); __builtin_amdgcn_s_setprio(0); } while (0)
#define PG8_WAIT_V(n) asm volatile("s_waitcnt vmcnt(" #n ")" ::: "memory")
#define PG8_WAIT_L(n) asm volatile("s_waitcnt lgkmcnt(" #n ")" ::: "memory")
#define PG8_BAR __builtin_amdgcn_s_barrier()
#define PG8_SCHED __builtin_amdgcn_sched_barrier(0)
    Unit cur, nxt; int ui = 0;
    if (!S.next(0, cur)) return;
    f32x4 acc[2][2][4][2];
#pragma unroll
    for (int a = 0; a < 2; ++a)
#pragma unroll
        for (int b = 0; b < 2; ++b)
#pragma unroll
            for (int m = 0; m < 4; ++m)
#pragma unroll
                for (int n = 0; n < 2; ++n) acc[a][b][m][n] = (f32x4){0.f, 0.f, 0.f, 0.f};
    bf16x8 At[4][2], B0[2][2], B1[2][2];
    const char* cA = (const char*)g.A + (size_t)cur.pm * tstep; const char* cB = (const char*)g.Bt + (size_t)cur.pn * tstep;
    S.a_ready(cur);
    if constexpr (SP2) {
        PG8_STAGE(PG8_SB(0, 0), cB, voffB); PG8_STAGE(PG8_SB(0, 1), cB + hstep, voffB); PG8_STAGE(PG8_SA(0, 0), cA, voffA); PG8_STAGE(PG8_SA(0, 1), cA + hstep, voffA);
        if (wr == 1) PG8_BAR;
        PG8_WAIT_V(2); PG8_BAR;
        PG8_STAGE(PG8_SB(1, 0), cB + kstep, voffB); PG8_STAGE(PG8_SA(1, 0), cA + kstep, voffA); PG8_STAGE(PG8_SB(1, 1), cB + hstep + kstep, voffB);
        PG8_WAIT_V(6); PG8_BAR;
    } else {
        PG8_STAGE(PG8_SB(0, 0), cB, voffB); PG8_STAGE(PG8_SA(0, 0), cA, voffA); PG8_STAGE(PG8_SB(0, 1), cB + hstep, voffB); PG8_STAGE(PG8_SA(0, 1), cA + hstep, voffA);
        if (wr == 1) PG8_BAR;
        PG8_WAIT_V(4); PG8_BAR;
        PG8_STAGE(PG8_SB(1, 0), cB + kstep, voffB); PG8_STAGE(PG8_SA(1, 0), cA + kstep, voffA); PG8_STAGE(PG8_SB(1, 1), cB + hstep + kstep, voffB);
        PG8_WAIT_V(6); PG8_BAR;
    }
    for (;;) {
        const bool has_next = S.next(ui + 1, nxt);
        const char* nA = has_next ? (const char*)g.A + (size_t)nxt.pm * tstep : cA; const char* nB = has_next ? (const char*)g.Bt + (size_t)nxt.pn * tstep : cB;
        for (int t = 0; t < nt; t += 2) {
            const bool last = (t == nt - 2);
            const char* a1 = cA + (size_t)(t + 1) * kstep;
            const char* a2 = last ? nA : cA + (size_t)(t + 2) * kstep; const char* b2 = last ? nB : cB + (size_t)(t + 2) * kstep;
            const char* a3 = a2 + kstep; const char* b3 = b2 + kstep;
            if (last && has_next) S.a_ready(nxt);
            if constexpr (SP2) {
            PG8_LDB(B0, 0, 0); PG8_LDB(B1, 0, 1); PG8_SCHED; PG8_LDA(At, 0, 0); PG8_STAGE(PG8_SA(1, 1), a1 + hstep, voffA);
            PG8_WAIT_V(8); PG8_WAIT_L(0); PG8_BAR; PG8_MMA(0, 0, At, B0); PG8_MMA(0, 1, At, B1); PG8_BAR; PG8_SCHED;
            PG8_LDA(At, 0, 1); PG8_STAGE(PG8_SB(0, 0), b2, voffB); PG8_STAGE(PG8_SB(0, 1), b2 + hstep, voffB); PG8_STAGE(PG8_SA(0, 0), a2, voffA);
            PG8_WAIT_V(8); PG8_WAIT_L(0); PG8_BAR; PG8_MMA(1, 0, At, B0); PG8_MMA(1, 1, At, B1); PG8_BAR; PG8_SCHED;
            PG8_LDB(B0, 1, 0); PG8_LDB(B1, 1, 1); PG8_SCHED; PG8_LDA(At, 1, 0); PG8_STAGE(PG8_SA(0, 1), a2 + hstep, voffA);
            PG8_WAIT_V(8); PG8_WAIT_L(0); PG8_BAR; PG8_MMA(0, 0, At, B0); PG8_MMA(0, 1, At, B1); PG8_BAR; PG8_SCHED;
            PG8_LDA(At, 1, 1); PG8_STAGE(PG8_SB(1, 0), b3, voffB); PG8_STAGE(PG8_SB(1, 1), b3 + hstep, voffB); PG8_STAGE(PG8_SA(1, 0), a3, voffA);
            PG8_WAIT_V(8); PG8_WAIT_L(0); PG8_BAR; PG8_MMA(1, 0, At, B0); PG8_MMA(1, 1, At, B1); PG8_BAR; PG8_SCHED;
            } else {
            PG8_LDB(B0, 0, 0); PG8_SCHED; PG8_LDA(At, 0, 0); PG8_STAGE(PG8_SA(1, 1), a1 + hstep, voffA);
            PG8_WAIT_L(8); PG8_BAR; PG8_WAIT_L(0); PG8_MMA(0, 0, At, B0); PG8_BAR; PG8_SCHED;
            PG8_LDB(B1, 0, 1); PG8_STAGE(PG8_SB(0, 0), b2, voffB);
            PG8_BAR; PG8_WAIT_L(0); PG8_MMA(0, 1, At, B1); PG8_BAR;
            PG8_LDA(At, 0, 1); PG8_STAGE(PG8_SA(0, 0), a2, voffA);
            PG8_BAR; PG8_WAIT_L(0); PG8_MMA(1, 0, At, B0); PG8_BAR; PG8_SCHED;
            PG8_STAGE(PG8_SB(0, 1), b2 + hstep, voffB);
            PG8_WAIT_V(6); PG8_BAR; PG8_MMA(1, 1, At, B1); PG8_BAR;
            PG8_LDB(B0, 1, 0); PG8_SCHED; PG8_LDA(At, 1, 0); PG8_STAGE(PG8_SA(0, 1), a2 + hstep, voffA);
            PG8_WAIT_L(8); PG8_BAR; PG8_WAIT_L(0); PG8_MMA(0, 0, At, B0); PG8_BAR; PG8_SCHED;
            PG8_LDB(B1, 1, 1); PG8_STAGE(PG8_SB(1, 0), b3, voffB);
            PG8_BAR; PG8_WAIT_L(0); PG8_MMA(0, 1, At, B1); PG8_BAR;
            PG8_LDA(At, 1, 1); PG8_STAGE(PG8_SA(1, 0), a3, voffA);
            PG8_BAR; PG8_WAIT_L(0); PG8_MMA(1, 0, At, B0); PG8_BAR; PG8_SCHED;
            PG8_STAGE(PG8_SB(1, 1), b3 + hstep, voffB);
            PG8_WAIT_V(6); PG8_BAR; PG8_MMA(1, 1, At, B1); PG8_BAR;
            }
        }
        if constexpr (ALIGN_EPI) { if (wr == 0) PG8_BAR; }
        if constexpr (!Epi::AFTER_DRAIN) { E(acc, cur, wr, wc, fr, fq); S.done(cur); }
        if (!has_next) break;
#pragma unroll
        for (int a = 0; a < 2; ++a)
#pragma unroll
            for (int b = 0; b < 2; ++b)
#pragma unroll
                for (int m = 0; m < 4; ++m)
#pragma unroll
                    for (int n = 0; n < 2; ++n) acc[a][b][m][n] = (f32x4){0.f, 0.f, 0.f, 0.f};
        cur = nxt; cA = nA; cB = nB; ++ui;
        if constexpr (ALIGN_EPI) { if (wr == 1) PG8_BAR; }
    }
    PG8_WAIT_V(0);
    if constexpr (!ALIGN_EPI) { if (wr == 0) PG8_BAR; }
    PG8_BAR;
    if constexpr (Epi::AFTER_DRAIN) { E.fused(acc, cur, wr, wc, fr, fq, lds, wid, lane); S.done(cur); }
#undef PG8_SA
#undef PG8_SB
#undef PG8_STAGE
#undef PG8_LDA
#undef PG8_LDB
#undef PG8_MMA
#undef PG8_WAIT_V
#undef PG8_WAIT_L
#undef PG8_BAR
#undef PG8_SCHED
}
}
#ifndef PG8_SP2
#define PG8_SP2 true
#endif
#ifndef PG8_ALIGN
#define PG8_ALIGN true
#endif
#ifndef MK_ONE_LAUNCH
#define MK_ONE_LAUNCH 1
#endif

constexpr int NWAVES = 8, NTHR = NWAVES * 64;
constexpr int BATCH = 2, SEQ = 8192, D = 1024, T = BATCH * SEQ, DEPTH = 4;
constexpr int EVEN_IN = 2048, ODD_LD = 3848, ODD_N = 3840;
constexpr int NEXP = 16384;
constexpr float NORM_EPS = 1e-6f, GN_EPS = 64e-5f;

constexpr size_t MiB = 1u << 20;
constexpr size_t WS_CTL = 0, CTL_ZERO_BYTES = 1 * MiB;
constexpr size_t WS_MOD = 1 * MiB;
constexpr size_t WS_WF = WS_MOD + 256 * 1024;
constexpr size_t WS_KEYS = WS_MOD + 512 * 1024;
constexpr size_t WS_LORA = 3 * MiB;
constexpr size_t WS_LOGF = 2 * MiB;
constexpr size_t WS_DCUM = 2 * MiB + 512 * 1024;
constexpr size_t WS_WIN = 4 * MiB;
constexpr size_t WS_WOUT = 36 * MiB;
constexpr size_t WS_WQ = 44 * MiB;
constexpr size_t WS_H = 64 * MiB;
constexpr size_t WS_MIX = 96 * MiB;
constexpr size_t WS_PROJ = 128 * MiB;
constexpr size_t WS_Q = 256 * MiB;
constexpr size_t WS_IDX = 320 * MiB;
constexpr size_t WS_GATE = 328 * MiB;
constexpr size_t WS_RW = 336 * MiB;
constexpr size_t RW_SLOT = 32 * MiB;
constexpr size_t WS_PU = WS_RW + 8 * RW_SLOT;
constexpr size_t WS_PV = WS_PU + 64 * MiB;
constexpr size_t WS_PS = WS_PV + 64 * MiB;
constexpr size_t WS_CG = WS_PS + 1 * MiB;
constexpr size_t WS_CQ = WS_CG + 16 * MiB;
constexpr size_t WS_CH = WS_CQ + 16 * MiB;
constexpr size_t WS_CY = WS_CH + 32 * MiB;
constexpr size_t WS_H8 = WS_CY + 32 * MiB;
constexpr size_t WS_HS = WS_H8 + 16 * MiB;
constexpr size_t WS_ACT = WS_HS + 1 * MiB;
constexpr size_t WS_END = WS_ACT + 8 * MiB;
constexpr int CW_WORK = 64;
constexpr int CW_WORK2 = 1024;
constexpr int CW_G1 = 24576, CW_G2 = 28672;
constexpr int CW_CHQ = 16384, CW_SCQ = 20480;
constexpr int CW_BAR = 4096;

constexpr int RING_OFF = 0, RING_BYTES = 131072;
constexpr int MISC_OFF = 159744;
constexpr int LDS_BYTES = 163840;

#define GAS __attribute__((address_space(1)))
#define LAS __attribute__((address_space(3)))
typedef unsigned short bf16;
typedef unsigned v4u __attribute__((ext_vector_type(4)));
typedef unsigned v2u __attribute__((ext_vector_type(2)));
typedef int v8i __attribute__((ext_vector_type(8)));
typedef float f32x4 __attribute__((ext_vector_type(4)));
typedef short bf16x8 __attribute__((ext_vector_type(8)));
typedef GAS unsigned gu32;
#define LDS_WAIT() asm volatile("s_waitcnt lgkmcnt(0)" ::: "memory")
#define VM_WAIT() asm volatile("s_waitcnt vmcnt(0)" ::: "memory")
#define LBAR() do { asm volatile("s_waitcnt lgkmcnt(0)" ::: "memory"); __builtin_amdgcn_s_barrier(); asm volatile("" ::: "memory"); } while (0)
typedef float f32x2_t __attribute__((ext_vector_type(2))); typedef __bf16 bf16x2_t __attribute__((ext_vector_type(2)));
__device__ __forceinline__ unsigned pk2(float lo, float hi) { const f32x2_t v = {lo, hi}; const bf16x2_t b = __builtin_convertvector(v, bf16x2_t); return __builtin_bit_cast(unsigned, b); }
__device__ __forceinline__ unsigned f2bf(float f) { return pk2(f, 0.f) & 0xffffu; }
__device__ __forceinline__ float bf2f(bf16 v) { return __builtin_bit_cast(float, (unsigned)v << 16); }
__device__ __forceinline__ float bflo(unsigned w) { return __builtin_bit_cast(float, w << 16); }
__device__ __forceinline__ float bfhi(unsigned w) { return __builtin_bit_cast(float, w & 0xffff0000u); }
__device__ __forceinline__ float wave_sum(float v) {
#pragma unroll
    for (int o = 1; o < 64; o <<= 1) v += __shfl_xor(v, o);
    return v;
}
__device__ __forceinline__ float wave_max(float v) {
#pragma unroll
    for (int o = 1; o < 64; o <<= 1) v = fmaxf(v, __shfl_xor(v, o));
    return v;
}
__device__ __forceinline__ float rl(float x, int j) { return __builtin_bit_cast(float, __builtin_amdgcn_readlane(__builtin_bit_cast(int, x), j)); }
__device__ __forceinline__ float sigmoidf_(float x) { return 1.f / (1.f + expf(-x)); }
__device__ __forceinline__ float softplusf_(float x) { return fmaxf(x, 0.f) + log1pf(expf(-fabsf(x))); }
__device__ __forceinline__ float gelu_erf(float x) { return 0.5f * x * (1.f + erff(x * 0.70710678118654752f)); }

#define XB_TMO      128
#define XB_XCNT(j)  (256  + 64 * (j))
#define XB_XSUB(j)  (1280 + 64 * (j))
#define XB_XGEN(j)  (2304 + 64 * (j))
#define XB_TOP      3328
#define XB_TOPGEN   3392
#define XCD_BAR_WORDS 3456
#define XB_SPIN_CAP (1u << 18)

__device__ __forceinline__ unsigned xb_ld(unsigned* p)              { return __hip_atomic_load(p, __ATOMIC_RELAXED, __HIP_MEMORY_SCOPE_AGENT); }
__device__ __forceinline__ unsigned xb_add(unsigned* p, unsigned v) { return __hip_atomic_fetch_add(p, v, __ATOMIC_RELAXED, __HIP_MEMORY_SCOPE_AGENT); }
__device__ __forceinline__ unsigned xb_xcc_id() { return (unsigned)__builtin_amdgcn_s_getreg((3 << 11) | 20) & 0xFu; }
#define XB_SPIN(cond, bar) do { unsigned _sp = 0; while (cond) { __builtin_amdgcn_s_sleep(1); \
    if ((++_sp & 255u) == 0u) { if (xb_ld(&(bar)[XB_TMO])) break; if (_sp > XB_SPIN_CAP) { atomicAdd(&(bar)[XB_TMO], 1u); break; } } } } while (0)

struct XcdBarrier {
    unsigned* bar; unsigned x;
    volatile LAS unsigned* st;
};

__device__ __forceinline__ XcdBarrier xcd_barrier_post(unsigned* bar, volatile LAS unsigned* st) {
    XcdBarrier b; b.bar = bar; b.x = xb_xcc_id(); b.st = st;
    if (threadIdx.x == 0) (void)xb_add(&bar[XB_XCNT(b.x)], 1u);
    return b;
}
__device__ __forceinline__ void xcd_barrier_complete(unsigned* bar, unsigned x, unsigned& nloc, unsigned& nx) {
    const unsigned G = gridDim.x * gridDim.y * gridDim.z;
    unsigned sum, cnt, mine, sp = 0u;
    for (;;) {
        sum = 0u; cnt = 0u; mine = 0u;
#pragma unroll
        for (unsigned j = 0; j < 16; ++j) { const unsigned c = xb_ld(&bar[XB_XCNT(j)]); sum += c; cnt += (c > 0u) ? 1u : 0u; mine = (j == x) ? c : mine; }
        if (sum == G) break;
        __builtin_amdgcn_s_sleep(1);
        if ((++sp & 255u) == 0u) { if (xb_ld(&bar[XB_TMO])) break; if (sp > XB_SPIN_CAP) { atomicAdd(&bar[XB_TMO], 1u); break; } }
    }
    nloc = mine > 0u ? mine : 1u; nx = cnt > 0u ? cnt : 1u;
}

__device__ __forceinline__ void xcd_barrier(const XcdBarrier& b) {
    asm volatile("s_waitcnt vmcnt(0)" ::: "memory");
    __syncthreads();
    if (threadIdx.x == 0) {
        unsigned* bar = b.bar;
        __builtin_amdgcn_s_waitcnt(0);
        unsigned nloc = b.st[0], nx = b.st[1];
        if (nloc == 0u) { xcd_barrier_complete(bar, b.x, nloc, nx); b.st[0] = nloc; b.st[1] = nx; }
        const unsigned old = xb_add(&bar[XB_XSUB(b.x)], 1u);
        const unsigned gen = old / nloc;
        if (old + 1u == (gen + 1u) * nloc) {
            __builtin_amdgcn_fence(__ATOMIC_RELEASE, "agent");
            asm volatile("s_waitcnt vmcnt(0)" ::: "memory");
            const unsigned og = xb_add(&bar[XB_TOP], 1u);
            const unsigned tg = og / nx;
            if (og + 1u == (tg + 1u) * nx) xb_add(&bar[XB_TOPGEN], 1u);
            else XB_SPIN(xb_ld(&bar[XB_TOPGEN]) == tg, bar);
            __builtin_amdgcn_fence(__ATOMIC_ACQUIRE, "agent");
            xb_add(&bar[XB_XGEN(b.x)], 1u);
            asm volatile("s_waitcnt vmcnt(0)" ::: "memory");
        } else {
            XB_SPIN(xb_ld(&bar[XB_XGEN(b.x)]) == gen, bar);
            __builtin_amdgcn_fence(__ATOMIC_ACQUIRE, "agent");
            asm volatile("s_waitcnt vmcnt(0)" ::: "memory");
        }
    }
    __syncthreads();
}


struct Frame {
    LAS unsigned char* lds;
    volatile LAS unsigned* MISC;
    gu32* ctl;
    int tid, lane, wave, G, bid;
};
struct Args { const float* in[32]; float* out; unsigned char* ws; int ph_lo, ph_hi; };
#define CAS __attribute__((address_space(4)))
#define KARGS const CAS Args* ka_; { unsigned long long kp_ = (unsigned long long)__builtin_amdgcn_kernarg_segment_ptr(); asm volatile("" : "+s"(kp_)); ka_ = (const CAS Args*)kp_; } unsigned char* const ws_ = ka_->ws
#define IN(i) (ka_->in[i])
#define OUTP (ka_->out)
#define WSP(type, off) ((type*)(ws_ + (off)))

template <int NR> __device__ __forceinline__ void conv_issue(const float* TU, const float* TV, int l, int row0, int NGW, int lane, f32x4 (&v)[NR][4]) {
#pragma unroll
    for (int q = 0; q < NR; ++q) { const int r = row0 + q * NGW; if (r < 2 * NEXP) { const int tb = r >= NEXP ? 1 : 0, e = r - tb * NEXP;
        const float* src = (tb ? TV : TU) + ((size_t)l * NEXP + e) * 1024 + 4 * lane;
#pragma unroll
        for (int j = 0; j < 4; ++j) v[q][j] = *(const f32x4*)(src + 256 * j); } }
}
template <int NR> __device__ __forceinline__ void conv_finish(unsigned char* PU, unsigned char* PV, float* PS, int l, int row0, int NGW, int lane, f32x4 (&v)[NR][4], LAS unsigned char* scr) {
#pragma unroll
    for (int q = 0; q < NR; ++q) { const int r = row0 + q * NGW; if (r < 2 * NEXP) { const int tb = r >= NEXP ? 1 : 0, e = r - tb * NEXP;
        if (tb) {
            float am = 0.f;
#pragma unroll
            for (int j = 0; j < 4; ++j) am = fmaxf(am, fmaxf(fmaxf(fabsf(v[q][j].x), fabsf(v[q][j].y)), fmaxf(fabsf(v[q][j].z), fabsf(v[q][j].w))));
            am = wave_max(am);
            const float sc = am > 0.f ? am * (1.f / 224.f) : 1.f, inv = 1.f / sc;
#pragma unroll
            for (int j = 0; j < 4; ++j) { int w = 0; w = __builtin_amdgcn_cvt_pk_fp8_f32(v[q][j].x * inv, v[q][j].y * inv, w, false); w = __builtin_amdgcn_cvt_pk_fp8_f32(v[q][j].z * inv, v[q][j].w * inv, w, true);
                const int c = 32 * j + (lane >> 1);
                *(int*)(PV + ((size_t)(l * 128 + c) * NEXP + e) * 8 + 4 * (lane & 1)) = w; }
            if (lane == 0) PS[4 * NEXP + l * NEXP + e] = sc;
        } else {
#pragma unroll
            for (int j = 0; j < 4; ++j) {
                float am = fmaxf(fmaxf(fabsf(v[q][j].x), fabsf(v[q][j].y)), fmaxf(fabsf(v[q][j].z), fabsf(v[q][j].w)));
                am = fmaxf(am, __shfl_xor(am, 1)); am = fmaxf(am, __shfl_xor(am, 2)); am = fmaxf(am, __shfl_xor(am, 4));
                int ex = 0; if (am > 0.f) { (void)frexpf(am * (1.f / 7.5f), &ex); }
                ex = ex < -126 ? -126 : (ex > 126 ? 126 : ex);
                const float inv = __builtin_bit_cast(float, (unsigned)(127 - ex) << 23);
                unsigned w24 = 0u;
#pragma unroll
                for (int c = 0; c < 4; ++c) { const float y = v[q][j][c] * inv, a_ = fabsf(y);
                    float cf = a_ < 2.f ? rintf(a_ * 8.f) : (a_ < 4.f ? 16.f + rintf((a_ - 2.f) * 4.f) : 24.f + rintf((a_ - 4.f) * 2.f));
                    cf = fminf(cf, 31.f);
                    const unsigned s6 = (unsigned)(int)cf | (y < 0.f ? 32u : 0u);
                    w24 |= s6 << (6 * c); }
                const int qb = 8 * j + (lane >> 3), kc_ = qb & 3, m_ = qb >> 2;
#pragma unroll
                for (int t = 0; t < 3; ++t) { const int L = 24 * m_ + 3 * (lane & 7) + t;
                    scr[64 * (L >> 4) + 16 * kc_ + (L & 15)] = (unsigned char)((w24 >> (8 * t)) & 0xFFu); }
                if ((lane & 7) == 0) scr[768 + kc_ * 8 + m_] = (unsigned char)(ex + 127);
            }
            LDS_WAIT(); asm volatile("" ::: "memory");
            if (lane < 48) *(v4u*)(PU + ((size_t)l * NEXP + e) * 768 + 16 * lane) = *(const LAS v4u*)(scr + 16 * lane);
            else if (lane < 50) *(v4u*)(PU + (size_t)48 * MiB + ((size_t)l * NEXP + e) * 32 + 16 * (lane - 48)) = *(const LAS v4u*)(scr + 768 + 16 * (lane - 48));
            LDS_WAIT(); asm volatile("" ::: "memory");
        } } }
}

__device__ __forceinline__ void transpose_item(const float* W, int ldw, bf16* WT, int row_off, LAS float* scr, int item, int nblk, int lane) {
    const int kb = item / nblk, nb = item % nblk, k0 = 64 * kb, n0 = 32 * nb;
#pragma unroll 8
    for (int i = 0; i < 32; ++i) { const int kk = 2 * i + (lane >> 5); scr[kk * 33 + (lane & 31)] = W[(size_t)(k0 + kk) * ldw + n0 + (lane & 31)]; }
    LDS_WAIT(); asm volatile("" ::: "memory");
    const int c = lane & 7;
#pragma unroll
    for (int j = 0; j < 4; ++j) { const int n = (lane >> 3) + 8 * j; const LAS float* s = scr + (8 * c) * 33 + n;
        v4u o; o.x = pk2(s[0 * 33], s[1 * 33]); o.y = pk2(s[2 * 33], s[3 * 33]); o.z = pk2(s[4 * 33], s[5 * 33]); o.w = pk2(s[6 * 33], s[7 * 33]);
        *(v4u*)(WT + (size_t)(row_off + n0 + n) * 1024 + k0 + 8 * c) = o; }
    LDS_WAIT(); asm volatile("" ::: "memory");
}

__device__ __forceinline__ void phase_prologue(Frame& F) {
    KARGS;
    LAS float* cact = (LAS float*)F.lds;
    LAS float* part = cact + 2048;
    {   const float* c = IN(1);
        for (int i = F.tid; i < 2048; i += NTHR) { const float v = c[i]; cact[i] = v / (1.f + expf(-v)); } }
    __syncthreads();
    {
        const float* ada_w = IN(2); const float* ada_b = IN(3); float* MOD = WSP(float, WS_MOD);
        for (int it = F.bid; it < 384; it += F.G) {
            const int l = it / 96, j0 = (it % 96) * 64;
            const float* wp = ada_w + ((size_t)l * 1024 + F.wave * 128) * 6144 + j0 + F.lane;
            float a0 = 0.f, a1 = 0.f;
#pragma unroll 8
            for (int k = 0; k < 128; ++k) { const float w = wp[(size_t)k * 6144]; a0 += cact[F.wave * 128 + k] * w; a1 += cact[1024 + F.wave * 128 + k] * w; }
            part[(F.wave * 2 + 0) * 64 + F.lane] = a0; part[(F.wave * 2 + 1) * 64 + F.lane] = a1;
            __syncthreads();
            if (F.tid < 128) { const int b = F.tid >> 6, col = F.tid & 63; float s = 0.f;
#pragma unroll
                for (int w = 0; w < 8; ++w) s += part[(w * 2 + b) * 64 + col];
                MOD[(l * 2 + b) * 6144 + j0 + col] = s + ada_b[l * 6144 + j0 + col]; }
            __syncthreads();
        }
    }
    {
        LAS float* scr = (LAS float*)(F.lds + 16384 + F.wave * 8448);
        const int gw = F.bid * NWAVES + F.wave, NGW = F.G * NWAVES;
        constexpr int I_A = 16 * 64, I_B = 16 * 64, I_C = 16 * 56, I_D = 16 * 32, I_E = 16 * 64;
        constexpr int NITEMS = 2 * I_A + 2 * I_B + 2 * I_C + 4 * I_D + 4 * I_E;
        for (int it = gw; it < NITEMS; it += NGW) {
            int r = it;
            if (r < 2 * I_A) { const int j = r / I_A; transpose_item(IN(6) + (size_t)j * 1024 * 2048, 2048, WSP(bf16, WS_WIN + (size_t)(2 * j) * 8 * MiB), 0, scr, r % I_A, 64, F.lane); continue; } r -= 2 * I_A;
            if (r < 2 * I_B) { const int j = r / I_B; transpose_item(IN(10) + (size_t)j * 1024 * ODD_LD, ODD_LD, WSP(bf16, WS_WIN + (size_t)(2 * j + 1) * 8 * MiB), 0, scr, r % I_B, 64, F.lane); continue; } r -= 2 * I_B;
            if (r < 2 * I_C) { const int j = r / I_C; transpose_item(IN(10) + (size_t)j * 1024 * ODD_LD + 2056, ODD_LD, WSP(bf16, WS_WIN + (size_t)(2 * j + 1) * 8 * MiB), 2048, scr, r % I_C, 56, F.lane); continue; } r -= 2 * I_C;
            if (r < 4 * I_D) { const int l = r / I_D; const int j = l >> 1; const float* src = (l & 1) ? IN(11) : IN(7);
                if ((l & 1) || (r % I_D) < 8 * 32) transpose_item(src + (size_t)j * 1024 * 1024, 1024, WSP(bf16, WS_WOUT + (size_t)l * 2 * MiB), 0, scr, r % I_D, 32, F.lane); continue; } r -= 4 * I_D;
            { const int l = r / I_E; transpose_item(IN(26) + (size_t)l * 1024 * 2048, 2048, WSP(bf16, WS_WQ + (size_t)l * 4 * MiB), 0, scr, r % I_E, 64, F.lane); }
        }
    }
    {
        const int gt = F.bid * NTHR + F.tid, NGT = F.G * NTHR;
        float* WF = WSP(float, WS_WF);
        for (int i = gt; i < 2 * 8 * 1024; i += NGT) { const int j = i >> 13, h = (i >> 10) & 7, k = i & 1023; WF[i] = IN(10)[((size_t)j * 1024 + k) * ODD_LD + 2048 + h]; }
        bf16* KEYS = WSP(bf16, WS_KEYS);
        for (int i = gt; i < 4 * 16384; i += NGT) { const int l = i >> 14, r = i & 16383;
            KEYS[(size_t)(l * 2 + 0) * 16384 + r] = (bf16)f2bf(IN(27)[i]); KEYS[(size_t)(l * 2 + 1) * 16384 + r] = (bf16)f2bf(IN(28)[i]); }
        for (int i = gt; i < 2 * 512 * 256; i += NGT) { const int j = i >> 17, ch = (i >> 8) & 511, k = i & 255; bf16* dst = WSP(bf16, WS_LORA) + (size_t)j * 131072;
            if (k < 64) dst[ch * 64 + k] = (bf16)f2bf(IN(17)[((size_t)j * 64 + k) * 512 + ch]);
            else if (k < 128) dst[32768 + ch * 64 + (k - 64)] = (bf16)f2bf(IN(19)[((size_t)j * 64 + (k - 64)) * 512 + ch]);
            else dst[65536 + ch * 128 + (k - 128)] = (bf16)f2bf(IN(20)[((size_t)j * 128 + (k - 128)) * 512 + ch]); }
        {   LAS float* pwl = (LAS float*)(F.lds + 98304);
            for (int it = (F.bid + F.G - 128 % F.G) % F.G; it < 128; it += F.G) { const int j = it >> 6, g = (it >> 4) & 3, cq = (it >> 1) & 7, nh = it & 1;
                __syncthreads();
                for (int i = F.tid; i < 2048; i += NTHR) { const int d = i >> 4, cc = i & 15; pwl[i] = IN(8)[((size_t)(j * 4 + g) * 128 + cq * 16 + cc) * 128 + d] * IN(9)[j * 512 + g * 128 + d]; }
                __syncthreads();
                const int n = nh * 512 + F.tid; const float* wo = IN(7) + ((size_t)j * 1024 + 512 + g * 128) * 1024 + n;
                float acc[16];
#pragma unroll
                for (int cc = 0; cc < 16; ++cc) acc[cc] = 0.f;
#pragma unroll 8
                for (int d = 0; d < 128; ++d) { const float wv = wo[(size_t)d * 1024];
#pragma unroll
                    for (int q4 = 0; q4 < 4; ++q4) { const f32x4 p4 = *(const LAS f32x4*)(pwl + d * 16 + 4 * q4); acc[4 * q4] += p4.x * wv; acc[4 * q4 + 1] += p4.y * wv; acc[4 * q4 + 2] += p4.z * wv; acc[4 * q4 + 3] += p4.w * wv; } }
                v4u o0, o1; o0.x = pk2(acc[0], acc[1]); o0.y = pk2(acc[2], acc[3]); o0.z = pk2(acc[4], acc[5]); o0.w = pk2(acc[6], acc[7]);
                o1.x = pk2(acc[8], acc[9]); o1.y = pk2(acc[10], acc[11]); o1.z = pk2(acc[12], acc[13]); o1.w = pk2(acc[14], acc[15]);
                bf16* dst = WSP(bf16, WS_WOUT + (size_t)(2 * j) * 2 * MiB) + (size_t)n * 1024 + 512 + g * 128 + cq * 16;
                *(v4u*)dst = o0; *(v4u*)(dst + 8) = o1; }
            __syncthreads(); }
        {
            const int gw = F.bid * NWAVES + F.wave, NGW = F.G * NWAVES, lane = F.lane;
            for (int row0 = gw; row0 < 2 * NEXP; row0 += 4 * NGW) {
                f32x4 v[4][4];
                conv_issue<4>(IN(29), IN(30), 0, row0, NGW, lane, v);
                conv_finish<4>(WSP(unsigned char, WS_PU), WSP(unsigned char, WS_PV), WSP(float, WS_PS), 0, row0, NGW, lane, v, F.lds + 135168 + F.wave * 1024);
            }
        }
    }
}

__device__ __forceinline__ void phase_norm(Frame& F, int layer, int which) {
    KARGS;
    const float* X = (layer == 0 && which == 0) ? IN(0) : OUTP;
    const float* gain = (which ? IN(5) : IN(4)) + layer * 1024;
    const float* mod = WSP(float, WS_MOD) + (size_t)layer * 2 * 6144 + (which ? 3072 : 0);
    bf16* H = WSP(bf16, WS_H);
    const bool do_f = (layer & 1) && which == 0;
    const int jj = layer >> 1;
    const float* WF = WSP(float, WS_WF) + (size_t)jj * 8 * 1024;
    float* LOGF = WSP(float, WS_LOGF);
    const int gw = F.bid * NWAVES + F.wave, NGW = F.G * NWAVES, lane = F.lane;
    f32x4 gn[4];
#pragma unroll
    for (int j = 0; j < 4; ++j) gn[j] = *(const f32x4*)(gain + 256 * j + 4 * lane);
    for (int row = gw; row < T; row += NGW) {
        const int b = row >= SEQ ? 1 : 0;
        const float* sh = mod + b * 6144; const float* sc = sh + 1024;
        const float* xr = X + (size_t)row * D + 4 * lane;
        f32x4 v[4]; float ss = 0.f;
#pragma unroll
        for (int j = 0; j < 4; ++j) { v[j] = *(const f32x4*)(xr + 256 * j); ss += (v[j].x * v[j].x + v[j].y * v[j].y) + (v[j].z * v[j].z + v[j].w * v[j].w); }
        const float rstd = rsqrtf(wave_sum(ss) * (1.f / D) + NORM_EPS);
        bf16* hr = H + (size_t)row * D + 4 * lane;
#pragma unroll
        for (int j = 0; j < 4; ++j) { const f32x4 s4 = *(const f32x4*)(sc + 256 * j + 4 * lane), h4 = *(const f32x4*)(sh + 256 * j + 4 * lane);
            v[j] = v[j] * rstd * gn[j] * (s4 + 1.f) + h4;
            v2u o; o.x = pk2(v[j].x, v[j].y); o.y = pk2(v[j].z, v[j].w); *(v2u*)(hr + 256 * j) = o; }
        if (which == 1) {
            float am = 0.f;
#pragma unroll
            for (int j = 0; j < 4; ++j) am = fmaxf(am, fmaxf(fmaxf(fabsf(v[j].x), fabsf(v[j].y)), fmaxf(fabsf(v[j].z), fabsf(v[j].w))));
            am = wave_max(am); const float s8 = am > 0.f ? am * (1.f / 224.f) : 1.f, i8 = 1.f / s8;
            unsigned char* h8 = WSP(unsigned char, WS_H8) + (size_t)row * D + 4 * lane;
#pragma unroll
            for (int j = 0; j < 4; ++j) { int w8 = 0; w8 = __builtin_amdgcn_cvt_pk_fp8_f32(v[j].x * i8, v[j].y * i8, w8, false); w8 = __builtin_amdgcn_cvt_pk_fp8_f32(v[j].z * i8, v[j].w * i8, w8, true); *(int*)(h8 + 256 * j) = w8; }
            if (lane == 0) WSP(float, WS_HS)[row] = s8;
        }
        if (do_f) {
            const float* fb = IN(14) + jj * 8;
            const int t = row - b * SEQ;
#pragma unroll
            for (int hh = 0; hh < 8; ++hh) { float d = 0.f;
#pragma unroll
                for (int j = 0; j < 4; ++j) { const f32x4 w4 = *(const f32x4*)(WF + hh * 1024 + 256 * j + 4 * lane); d += (v[j].x * w4.x + v[j].y * w4.y) + (v[j].z * w4.z + v[j].w * w4.w); }
                d = wave_sum(d) + fb[hh];
                const float lf = fminf(d, 0.f) - log1pf(expf(-fabsf(d)));
                if (lane == 0) LOGF[(size_t)(b * 8 + hh) * SEQ + t] = lf; }
        }
    }
}

__device__ __forceinline__ void load_q64(float (&q)[64], const bf16* p, float scale) {
#pragma unroll
    for (int c = 0; c < 8; ++c) { const v4u w = *(const v4u*)(p + 8 * c);
        q[8 * c + 0] = bflo(w.x) * scale; q[8 * c + 1] = bfhi(w.x) * scale; q[8 * c + 2] = bflo(w.y) * scale; q[8 * c + 3] = bfhi(w.y) * scale;
        q[8 * c + 4] = bflo(w.z) * scale; q[8 * c + 5] = bfhi(w.z) * scale; q[8 * c + 6] = bflo(w.w) * scale; q[8 * c + 7] = bfhi(w.w) * scale; }
}
__device__ __forceinline__ float dot_q64(const float (&q)[64], const bf16* p) {
    float z0 = 0.f, z1 = 0.f;
#pragma unroll
    for (int c = 0; c < 8; ++c) { const v4u w = *(const v4u*)(p + 8 * c);
        z0 += q[8 * c + 0] * bflo(w.x) + q[8 * c + 2] * bflo(w.y) + q[8 * c + 4] * bflo(w.z) + q[8 * c + 6] * bflo(w.w);
        z1 += q[8 * c + 1] * bfhi(w.x) + q[8 * c + 3] * bfhi(w.y) + q[8 * c + 5] * bfhi(w.z) + q[8 * c + 7] * bfhi(w.w); }
    return z0 + z1;
}
#ifdef MK_SIMPLE_EVEN
__device__ __forceinline__ void phase_even_mixer_simple(Frame& F, int layer) {
    KARGS;
    const bf16* P = WSP(bf16, WS_PROJ); bf16* MIX = WSP(bf16, WS_MIX);
    const int lane = F.lane;
    {
        const int gw = F.bid * NWAVES + F.wave, NGW = F.G * NWAVES;
        for (int it = gw; it < BATCH * 8 * SEQ; it += NGW) {
            const int b = it >> 16, h = (it >> 13) & 7, t = it & 8191;
            const bf16* base = P + (size_t)b * SEQ * EVEN_IN;
            float q[64]; load_q64(q, base + (size_t)t * EVEN_IN + h * 64, 0.125f);
            float acc = 0.f, carry = 0.f;
            for (int s0 = t - 1; s0 >= 0; s0 -= 64) {
                const int s = s0 - lane; const bool valid = s >= 0; const int sc = valid ? s : 0;
                const float z = dot_q64(q, base + (size_t)sc * EVEN_IN + 512 + h * 64);
                const float sp = softplusf_(z);
                const float l1m = valid ? -sp : 0.f;
                const float lb = z - sp;
                float inc = l1m;
#pragma unroll
                for (int o = 1; o < 64; o <<= 1) { const float n = __shfl_up(inc, o); if (lane >= o) inc += n; }
                const float w = valid ? expf(lb + carry + (inc - l1m)) : 0.f;
                const float tot = __shfl(inc, 63);
#pragma unroll 16
                for (int j = 0; j < 64; ++j) { const float wj = rl(w, j); int sj = s0 - j; sj = sj < 0 ? 0 : sj;
                    acc += wj * bf2f(base[(size_t)sj * EVEN_IN + 1024 + h * 64 + lane]); }
                carry += tot;
                if (carry < -104.f) break;
            }
            MIX[((size_t)b * SEQ + t) * D + h * 64 + lane] = (bf16)f2bf(acc);
        }
    }
    {
        LAS float* pl = (LAS float*)F.lds;
        const int jj = layer >> 1;
        const float* pw = IN(8) + (size_t)jj * 4 * 128 * 128; const float* ps = IN(9) + jj * 512;
        const int c = F.tid, g = c >> 7, w = 2 << g, d = c & 127;
        for (int tile = F.bid; tile < T / 32; tile += F.G) {
            const int t0 = tile * 32, b = t0 / SEQ, tl0 = t0 % SEQ;
            const bf16* base = P + (size_t)b * SEQ * EVEN_IN + 1536 + c;
            for (int tt = 0; tt < 32; ++tt) { const int tl = tl0 + tt, cend = (tl / 64 + 1) * 64;
                int lo = tl - w / 2; lo = lo < 0 ? 0 : lo; int hi = tl + w / 2; hi = hi > cend ? cend : hi;
                float s = 0.f; for (int u = lo; u < hi; ++u) s += bf2f(base[(size_t)u * EVEN_IN]);
                pl[c * 33 + tt] = s / (float)(hi - lo) - bf2f(base[(size_t)tl * EVEN_IN]); }
            __syncthreads();
            float acc[32];
#pragma unroll
            for (int tt = 0; tt < 32; ++tt) acc[tt] = 0.f;
            for (int cc = 0; cc < 128; ++cc) { const float wv = pw[((size_t)g * 128 + cc) * 128 + d]; const LAS float* pr = pl + (g * 128 + cc) * 33;
#pragma unroll
                for (int tt = 0; tt < 32; ++tt) acc[tt] += pr[tt] * wv; }
            const float sc = ps[c];
#pragma unroll
            for (int tt = 0; tt < 32; ++tt) MIX[(size_t)(t0 + tt) * D + 512 + c] = (bf16)f2bf(acc[tt] * sc);
            __syncthreads();
        }
    }
}

#endif
typedef float f32x16 __attribute__((ext_vector_type(16)));
typedef short s16x4 __attribute__((ext_vector_type(4)));
#define MAX3F(a, b, c) __builtin_fmaxf(__builtin_fmaxf((a), (b)), (c))
#define ZERO16(a) do { _Pragma("unroll") for (int r_ = 0; r_ < 16; ++r_) a[r_] = 0.f; } while (0)
constexpr int FX_KROW = 144, FX_VROW = 192;
constexpr int FX_KB = 64 * FX_KROW, FX_VB = 64 * FX_VROW, FX_BUF = FX_KB + FX_VB + 256;
template <int HW> __device__ __forceinline__ void pool_chunk(const bf16* src, bf16* dst, int tl0) {
    float ps[HW + 65 + HW]; ps[0] = 0.f;
#pragma unroll
    for (int i = 0; i < 64 + HW; ++i) { const int tl = tl0 - HW + i; const float x = tl >= 0 ? bf2f(src[(long)(i - HW) * EVEN_IN]) : 0.f; ps[i + 1] = ps[i] + x; }
#pragma unroll
    for (int tt = 0; tt < 64; ++tt) { const int tl = tl0 + tt; int lo = tl - HW; lo = lo < 0 ? 0 : lo; const int hie = tt + HW > 64 ? 64 : tt + HW;
        const float sum = ps[hie + HW] - ps[tt]; const float x = ps[tt + HW + 1] - ps[tt + HW];
        dst[(size_t)tt * D] = (bf16)f2bf(sum / (float)(tl0 + hie - lo) - x); }
}
__device__ __forceinline__ void phase_even_mixer(Frame& F, int layer) {
    KARGS;
    const bf16* P = WSP(bf16, WS_PROJ); bf16* MIX = WSP(bf16, WS_MIX);
    const int tid = F.tid, lane = F.lane, wave = F.wave, r32 = lane & 31, hh = lane >> 5;
    const float LOG2E = 1.4426950408889634f, CS = 0.125f * LOG2E;
    const int srow = tid >> 3, sch = tid & 7;
    {
        const int c = tid, g = c >> 7;
        for (int ck = F.bid; ck < T / 64; ck += F.G) {
            const int t0 = ck * 64, tl0 = t0 % SEQ;
            const bf16* src = P + (size_t)t0 * EVEN_IN + 1536 + c; bf16* dst = MIX + (size_t)t0 * D + 512 + c;
            if (g == 0) pool_chunk<1>(src, dst, tl0); else if (g == 1) pool_chunk<2>(src, dst, tl0); else if (g == 2) pool_chunk<4>(src, dst, tl0); else pool_chunk<8>(src, dst, tl0);
        }
    }
    __syncthreads();
    for (int u = F.bid; u < 256; u += F.G) {
        for (int ui = 0; ui < 2; ++ui) {
            const int bh = u >> 4, ss = u & 15, qb = ui == 0 ? ss : 31 - ss, b = bh >> 3, h = bh & 7;
            const bf16* base = P + (size_t)b * SEQ * EVEN_IN;
            const int q0 = 256 * qb + 32 * wave, myq = q0 + r32;
            bf16x8 qf[4];
#pragma unroll
            for (int d0 = 0; d0 < 4; ++d0) qf[d0] = *(const bf16x8*)(base + (size_t)myq * EVEN_IN + h * 64 + 16 * d0 + 8 * hh);
            float carry = 0.f;
            f32x16 o[2];
#pragma unroll
            for (int r = 0; r < 16; ++r) { o[0][r] = 0.f; o[1][r] = 0.f; }
            const int jtop = 4 * qb + 3;
            v4u kreg = *(const v4u*)(base + (size_t)(64 * jtop + srow) * EVEN_IN + 512 + h * 64 + sch * 8);
            v4u vreg = *(const v4u*)(base + (size_t)(64 * jtop + srow) * EVEN_IN + 1024 + h * 64 + sch * 8);
            __syncthreads();
            *(LAS v4u*)(F.lds + srow * FX_KROW + sch * 16) = kreg; *(LAS v4u*)(F.lds + FX_KB + srow * FX_VROW + sch * 16) = vreg;
            if (tid < 16) ((LAS unsigned*)(F.lds + 2 * FX_BUF))[tid] = 0u;
            __syncthreads();
            int it = 0;
            for (int j = jtop; j >= 0; --j, ++it) {
                const int cur = (it & 1) * FX_BUF, nxt = ((it + 1) & 1) * FX_BUF;
                if (j > 0) { const size_t krow = (size_t)(64 * (j - 1) + srow) * EVEN_IN;
                    kreg = *(const v4u*)(base + krow + 512 + h * 64 + sch * 8); vreg = *(const v4u*)(base + krow + 1024 + h * 64 + sch * 8); }
                const bool started = 64 * j <= q0 + 30;
                const bool wprev = __all(carry < -150.f);
                if (started && !wprev) {
                    const LAS unsigned char* Kb = F.lds + cur; const LAS unsigned char* Vb = F.lds + cur + FX_KB;
                    f32x16 p0, p1;
#pragma unroll
                    for (int r = 0; r < 16; ++r) { p0[r] = 0.f; p1[r] = 0.f; }
#pragma unroll
                    for (int d0 = 0; d0 < 4; ++d0) {
                        const bf16x8 a0 = *(const LAS bf16x8*)(Kb + r32 * FX_KROW + 32 * d0 + 16 * hh);
                        const bf16x8 a1 = *(const LAS bf16x8*)(Kb + (r32 + 32) * FX_KROW + 32 * d0 + 16 * hh);
                        p0 = __builtin_amdgcn_mfma_f32_32x32x16_bf16(a0, qf[d0], p0, 0, 0, 0);
                        p1 = __builtin_amdgcn_mfma_f32_32x32x16_bf16(a1, qf[d0], p1, 0, 0, 0);
                    }
                    f32x16 l0, l1v;
#pragma unroll
                    for (int r = 0; r < 16; ++r) {
                        const int key = 64 * j + (r & 3) + 8 * (r >> 2) + 4 * hh;
                        const float za = p0[r] * CS, zb = p1[r] * CS;
                        const float sa = fmaxf(za, 0.f) + __builtin_amdgcn_logf(1.f + __builtin_amdgcn_exp2f(-fabsf(za)));
                        const float sb = fmaxf(zb, 0.f) + __builtin_amdgcn_logf(1.f + __builtin_amdgcn_exp2f(-fabsf(zb)));
                        l0[r] = -sa; l1v[r] = -sb; p0[r] = za - sa; p1[r] = zb - sb; (void)key;
                    }
                    if (64 * j + 63 >= q0) {
                        asm volatile("" ::: "memory");
#pragma unroll
                        for (int r = 0; r < 16; ++r) { const int key = 64 * j + (r & 3) + 8 * (r >> 2) + 4 * hh;
                            if (!(key < myq)) { l0[r] = 0.f; p0[r] = -INFINITY; } if (!(key + 32 < myq)) { l1v[r] = 0.f; p1[r] = -INFINITY; } }
                    }
                    float tot[8], oth[8];
#pragma unroll
                    for (int g = 0; g < 4; ++g) { tot[g] = (l0[4 * g] + l0[4 * g + 1]) + (l0[4 * g + 2] + l0[4 * g + 3]); tot[4 + g] = (l1v[4 * g] + l1v[4 * g + 1]) + (l1v[4 * g + 2] + l1v[4 * g + 3]); }
#pragma unroll
                    for (int g = 0; g < 8; ++g) oth[g] = __shfl_xor(tot[g], 32);
                    float sfx[8]; float run = 0.f;
#pragma unroll
                    for (int x = 7; x >= 0; --x) { sfx[x] = run; run += tot[x] + oth[x]; }
#pragma unroll
                    for (int x = 0; x < 8; ++x) {
                        const float goff = carry + sfx[x] + (hh == 0 ? oth[x] : 0.f);
                        if (x < 4) { const float s3 = goff, s2 = s3 + l0[4 * x + 3], s1 = s2 + l0[4 * x + 2], s0 = s1 + l0[4 * x + 1];
                            p0[4 * x] = __builtin_amdgcn_exp2f(p0[4 * x] + s0); p0[4 * x + 1] = __builtin_amdgcn_exp2f(p0[4 * x + 1] + s1); p0[4 * x + 2] = __builtin_amdgcn_exp2f(p0[4 * x + 2] + s2); p0[4 * x + 3] = __builtin_amdgcn_exp2f(p0[4 * x + 3] + s3); }
                        else { const int y = x - 4; const float s3 = goff, s2 = s3 + l1v[4 * y + 3], s1 = s2 + l1v[4 * y + 2], s0 = s1 + l1v[4 * y + 1];
                            p1[4 * y] = __builtin_amdgcn_exp2f(p1[4 * y] + s0); p1[4 * y + 1] = __builtin_amdgcn_exp2f(p1[4 * y + 1] + s1); p1[4 * y + 2] = __builtin_amdgcn_exp2f(p1[4 * y + 2] + s2); p1[4 * y + 3] = __builtin_amdgcn_exp2f(p1[4 * y + 3] + s3); }
                    }
                    carry += run;
                    bf16x8 pf[4];
#pragma unroll
                    for (int s4 = 0; s4 < 4; ++s4) {
                        v4u w;
                        if (s4 < 2) { w.x = pk2(p0[8 * s4 + 0], p0[8 * s4 + 1]); w.y = pk2(p0[8 * s4 + 2], p0[8 * s4 + 3]); w.z = pk2(p0[8 * s4 + 4], p0[8 * s4 + 5]); w.w = pk2(p0[8 * s4 + 6], p0[8 * s4 + 7]); }
                        else { const int sp = s4 - 2; w.x = pk2(p1[8 * sp + 0], p1[8 * sp + 1]); w.y = pk2(p1[8 * sp + 2], p1[8 * sp + 3]); w.z = pk2(p1[8 * sp + 4], p1[8 * sp + 5]); w.w = pk2(p1[8 * sp + 6], p1[8 * sp + 7]); }
                        pf[s4] = __builtin_bit_cast(bf16x8, w);
                    }
                    const int gi = lane >> 4, li = lane & 15;
                    const LAS unsigned char* vbase = Vb + (4 * (gi >> 1) + (li >> 2)) * FX_VROW + (16 * (gi & 1) + 4 * (li & 3)) * 2;
#pragma unroll
                    for (int d0 = 0; d0 < 2; ++d0)
#pragma unroll
                        for (int s4 = 0; s4 < 4; ++s4) {
                            const s16x4 lo = __builtin_bit_cast(s16x4, __builtin_amdgcn_ds_read_tr16_b64_v4i16((LAS s16x4*)(vbase + (16 * s4) * FX_VROW + 64 * d0)));
                            const s16x4 hi = __builtin_bit_cast(s16x4, __builtin_amdgcn_ds_read_tr16_b64_v4i16((LAS s16x4*)(vbase + (16 * s4 + 8) * FX_VROW + 64 * d0)));
                            const bf16x8 vf = (bf16x8){lo[0], lo[1], lo[2], lo[3], hi[0], hi[1], hi[2], hi[3]};
                            o[d0] = __builtin_amdgcn_mfma_f32_32x32x16_bf16(vf, pf[s4], o[d0], 0, 0, 0);
                        }
                }
                const bool wdone = started && __all(carry < -150.f);
                if (lane == 0) ((LAS unsigned*)(F.lds + 2 * FX_BUF))[(it & 1) * 8 + wave] = wdone ? 1u : 0u;
                if (j > 0) { *(LAS v4u*)(F.lds + nxt + srow * FX_KROW + sch * 16) = kreg; *(LAS v4u*)(F.lds + nxt + FX_KB + srow * FX_VROW + sch * 16) = vreg; }
                LBAR();
                const LAS unsigned* fl = (const LAS unsigned*)(F.lds + 2 * FX_BUF) + (it & 1) * 8;
                const unsigned alld = fl[0] & fl[1] & fl[2] & fl[3] & fl[4] & fl[5] & fl[6] & fl[7];
                if (alld) break;
            }
            bf16* op = MIX + ((size_t)b * SEQ + myq) * D + h * 64;
#pragma unroll
            for (int d0 = 0; d0 < 2; ++d0)
#pragma unroll
                for (int g = 0; g < 4; ++g) { const int db = 32 * d0 + 8 * g + 4 * hh;
                    v2u ow; ow.x = pk2(o[d0][4 * g + 0], o[d0][4 * g + 1]); ow.y = pk2(o[d0][4 * g + 2], o[d0][4 * g + 3]); *(v2u*)(op + db) = ow; }
        }
    }
}

__device__ __forceinline__ void phase_odd_prep(Frame& F, int layer, int parts) {
    KARGS;
    const int jj = layer >> 1, lane = F.lane, tid = F.tid, w = F.wave, r32 = lane & 31, hh = lane >> 5;
    bf16* P = WSP(bf16, WS_PROJ);
    if (F.bid < 16 && (parts & 4)) {
        const float* lf = WSP(float, WS_LOGF) + (size_t)F.bid * SEQ + 1024 * w; float* dc = WSP(float, WS_DCUM) + (size_t)F.bid * SEQ + 1024 * w;
        float inc[16];
#pragma unroll
        for (int i = 0; i < 16; ++i) inc[i] = lf[64 * i + lane];
        double offs[16]; double carry = 0.0;
#pragma unroll
        for (int i = 0; i < 16; ++i) {
#pragma unroll
            for (int o = 1; o < 64; o <<= 1) { const float n = __shfl_up(inc[i], o); if (lane >= o) inc[i] += n; }
            offs[i] = carry; carry += (double)__shfl(inc[i], 63); }
        LAS double* wt = (LAS double*)F.lds;
        if (lane == 0) wt[w] = carry;
        __syncthreads();
        double base = 0.0;
#pragma unroll
        for (int ww = 0; ww < 8; ++ww) if (ww < w) base += wt[ww];
#pragma unroll
        for (int i = 0; i < 16; ++i) dc[64 * i + lane] = (float)(base + offs[i] + (double)inc[i]);
        __syncthreads();
    }
    constexpr int LXP = 528;
    LAS unsigned char* lx = F.lds;
    const float* mix = IN(15) + jj * 1792;
    const float* w0 = IN(16) + jj * 512; const float* a0 = IN(18) + jj * 512;
    const float* kkp = IN(21) + jj * 512; const float* kap = IN(22) + jj * 512;
    const float* qn = IN(12) + jj * 64; const float* kn = IN(13) + jj * 64;
    const bf16* LT = WSP(bf16, WS_LORA) + (size_t)jj * 131072;
    float* R = WSP(float, WS_RW); float* LWp = WSP(float, WS_RW + RW_SLOT); float* K = WSP(float, WS_RW + 2 * RW_SLOT); float* V = WSP(float, WS_RW + 3 * RW_SLOT);
    float* KK = WSP(float, WS_RW + 4 * RW_SLOT); float* A = WSP(float, WS_RW + 5 * RW_SLOT); float* Gt = WSP(float, WS_RW + 6 * RW_SLOT);
    for (int item = F.bid; item < T / 64; item += F.G) {
        const int t0 = item * 64;
        if (parts & 1) {
        for (int i = tid; i < 64 * 32; i += NTHR) { const int tt = i >> 5, j8 = 8 * (i & 31), tg = t0 + tt, tl = tg % SEQ, col = 1536 + j8;
            const v4u cw = *(const v4u*)(P + (size_t)tg * ODD_N + 2048 + col); v4u pw = (v4u){0u, 0u, 0u, 0u}; if (tl > 0) pw = *(const v4u*)(P + (size_t)(tg - 1) * ODD_N + 2048 + col);
            const f32x4 m0 = *(const f32x4*)(mix + col), m1 = *(const f32x4*)(mix + col + 4);
            v4u ow;
#pragma unroll
            for (int q = 0; q < 4; ++q) { const float c0 = bflo(cw[q]), c1 = bfhi(cw[q]), p0 = bflo(pw[q]), p1 = bfhi(pw[q]);
                const float mm0 = q < 2 ? m0[2 * q] : m1[2 * q - 4], mm1 = q < 2 ? m0[2 * q + 1] : m1[2 * q - 3];
                const float x0 = c0 + (p0 - c0) * mm0, x1 = c1 + (p1 - c1) * mm1;
                ow[q] = j8 < 64 ? pk2(tanhf(x0), tanhf(x1)) : (j8 < 128 ? pk2(x0, x1) : pk2(sigmoidf_(x0), sigmoidf_(x1))); }
            *(LAS v4u*)(lx + tt * LXP + j8 * 2) = ow; }
        __syncthreads();
#pragma unroll 1
        for (int L = 0; L < 3; ++L) {
            const int koff = L == 0 ? 0 : (L == 1 ? 64 : 128), ksteps = L == 2 ? 8 : 4, kdim = L == 2 ? 128 : 64;
            const bf16* Wt = LT + (L == 0 ? 0 : (L == 1 ? 32768 : 65536));
            float* dst = L == 0 ? LWp : (L == 1 ? A : Gt);
            f32x16 acc[2][2];
#pragma unroll
            for (int a_ = 0; a_ < 2; ++a_)
#pragma unroll
                for (int b_ = 0; b_ < 2; ++b_) ZERO16(acc[a_][b_]);
#pragma unroll 1
            for (int s4 = 0; s4 < ksteps; ++s4) {
                bf16x8 af[2], bfr[2];
#pragma unroll
                for (int tm = 0; tm < 2; ++tm) af[tm] = *(const LAS bf16x8*)(lx + (32 * tm + r32) * LXP + (koff + 16 * s4 + 8 * hh) * 2);
#pragma unroll
                for (int tn = 0; tn < 2; ++tn) bfr[tn] = *(const bf16x8*)(Wt + (size_t)(64 * w + 32 * tn + r32) * kdim + 16 * s4 + 8 * hh);
#pragma unroll
                for (int tm = 0; tm < 2; ++tm)
#pragma unroll
                    for (int tn = 0; tn < 2; ++tn) acc[tm][tn] = __builtin_amdgcn_mfma_f32_32x32x16_bf16(af[tm], bfr[tn], acc[tm][tn], 0, 0, 0);
            }
#pragma unroll
            for (int tn = 0; tn < 2; ++tn)
#pragma unroll
                for (int tm = 0; tm < 2; ++tm) { float* dp = dst + (size_t)(t0 + 32 * tm + 4 * hh) * 512 + 64 * w + 32 * tn + r32;
#pragma unroll
                    for (int r = 0; r < 16; ++r) dp[(size_t)((r & 3) + 8 * (r >> 2)) * 512] = acc[tm][tn][r]; }
        }
        asm volatile("s_waitcnt vmcnt(0)" ::: "memory");
        __syncthreads();
        }
        if (parts & 2) {
            LAS float* nrm = (LAS float*)(F.lds + 40960);
            {
                const int tt = tid >> 3, hd = tid & 7, tg = t0 + tt, tl = tg % SEQ;
                const bf16* bp = P + (size_t)tg * ODD_N + hd * 64;
                float qs = 0.f, ks = 0.f, n2 = 0.f;
#pragma unroll 2
                for (int c = 0; c < 8; ++c) {
                    const v4u wq = *(const v4u*)(bp + 8 * c), wk = *(const v4u*)(bp + 512 + 8 * c), wc = *(const v4u*)(bp + 2048 + 512 + 8 * c);
                    v4u wp = (v4u){0u, 0u, 0u, 0u}; if (tl > 0) wp = *(const v4u*)(bp - ODD_N + 2048 + 512 + 8 * c);
                    const f32x4 mk0 = *(const f32x4*)(mix + 512 + hd * 64 + 8 * c), mk1 = *(const f32x4*)(mix + 512 + hd * 64 + 8 * c + 4);
                    const f32x4 kc0 = *(const f32x4*)(kkp + hd * 64 + 8 * c), kc1 = *(const f32x4*)(kkp + hd * 64 + 8 * c + 4);
#pragma unroll
                    for (int i = 0; i < 4; ++i) {
                        const float q0 = bflo(wq[i]), q1 = bfhi(wq[i]), k0 = bflo(wk[i]), k1 = bfhi(wk[i]);
                        qs += q0 * q0 + q1 * q1; ks += k0 * k0 + k1 * k1;
                        const float c0 = bflo(wc[i]), c1 = bfhi(wc[i]), p0 = bflo(wp[i]), p1 = bfhi(wp[i]);
                        const float m0 = i < 2 ? mk0[2 * i] : mk1[2 * i - 4], m1 = i < 2 ? mk0[2 * i + 1] : mk1[2 * i - 3];
                        const float g0 = i < 2 ? kc0[2 * i] : kc1[2 * i - 4], g1 = i < 2 ? kc0[2 * i + 1] : kc1[2 * i - 3];
                        const float x0 = (c0 + (p0 - c0) * m0) * g0, x1 = (c1 + (p1 - c1) * m1) * g1;
                        n2 += x0 * x0 + x1 * x1; }
                }
                *(LAS f32x4*)(nrm + (tt * 8 + hd) * 4) = (f32x4){rsqrtf(qs * (1.f / 64.f) + NORM_EPS), rsqrtf(ks * (1.f / 64.f) + NORM_EPS), 1.f / fmaxf(sqrtf(n2), 1e-12f), 0.f};
            }
            __syncthreads();
            const int c4 = 4 * (tid & 127), hd = c4 >> 6, th = tid >> 7;
            const f32x4 mr = *(const f32x4*)(mix + c4), mk = *(const f32x4*)(mix + 512 + c4), mv = *(const f32x4*)(mix + 1024 + c4);
            const f32x4 kk4 = *(const f32x4*)(kkp + c4), ka4 = *(const f32x4*)(kap + c4), w04 = *(const f32x4*)(w0 + c4), a04 = *(const f32x4*)(a0 + c4);
            const f32x4 qn4 = *(const f32x4*)(qn + (c4 & 63)), kn4 = *(const f32x4*)(kn + (c4 & 63));
#pragma unroll 2
            for (int t2 = 0; t2 < 16; ++t2) { const int tt = 16 * th + t2, tg = t0 + tt, tl = tg % SEQ;
                const bf16* pc = P + (size_t)tg * ODD_N + 2048 + c4; const bf16* pp = pc - ODD_N;
                const size_t o = (size_t)tg * 512 + c4;
                const f32x4 wraw = *(const f32x4*)(LWp + o), araw = *(const f32x4*)(A + o);
                const v2u rc = *(const v2u*)pc, kc = *(const v2u*)(pc + 512), vc = *(const v2u*)(pc + 1024);
                v2u rp = (v2u){0u, 0u}, kp = rp, vp = rp; if (tl > 0) { rp = *(const v2u*)pp; kp = *(const v2u*)(pp + 512); vp = *(const v2u*)(pp + 1024); }
                bf16* pq = P + (size_t)tg * ODD_N + c4;
                const v2u qw = *(const v2u*)pq, kw = *(const v2u*)(pq + 512);
                const f32x4 nm = *(const LAS f32x4*)(nrm + (tt * 8 + hd) * 4);
                f32x4 R4, V4, KK4, LW4, A4, K4; float qo[4], ko[4];
#pragma unroll
                for (int e = 0; e < 4; ++e) {
                    const float rcv = (e & 1) ? bfhi(rc[e >> 1]) : bflo(rc[e >> 1]), rpv = (e & 1) ? bfhi(rp[e >> 1]) : bflo(rp[e >> 1]);
                    const float kcv = (e & 1) ? bfhi(kc[e >> 1]) : bflo(kc[e >> 1]), kpv = (e & 1) ? bfhi(kp[e >> 1]) : bflo(kp[e >> 1]);
                    const float vcv = (e & 1) ? bfhi(vc[e >> 1]) : bflo(vc[e >> 1]), vpv = (e & 1) ? bfhi(vp[e >> 1]) : bflo(vp[e >> 1]);
                    const float qv = (e & 1) ? bfhi(qw[e >> 1]) : bflo(qw[e >> 1]), kv = (e & 1) ? bfhi(kw[e >> 1]) : bflo(kw[e >> 1]);
                    const float r = rcv + (rpv - rcv) * mr[e], k = kcv + (kpv - kcv) * mk[e], v = vcv + (vpv - vcv) * mv[e];
                    const float wl = -softplusf_(-(w04[e] + wraw[e])) - 0.5f, av = sigmoidf_(a04[e] + araw[e]);
                    R4[e] = r; V4[e] = v; KK4[e] = k * kk4[e] * nm.z; LW4[e] = -expf(wl); A4[e] = av; K4[e] = k * (1.f + (av - 1.f) * ka4[e]);
                    qo[e] = qv * nm.x * qn4[e]; ko[e] = kv * nm.y * kn4[e]; }
                *(f32x4*)(R + o) = R4; *(f32x4*)(V + o) = V4; *(f32x4*)(KK + o) = KK4; *(f32x4*)(LWp + o) = LW4; *(f32x4*)(A + o) = A4; *(f32x4*)(K + o) = K4;
                v2u qv2, kv2; qv2.x = pk2(qo[0], qo[1]); qv2.y = pk2(qo[2], qo[3]); kv2.x = pk2(ko[0], ko[1]); kv2.y = pk2(ko[2], ko[3]);
                *(v2u*)pq = qv2; *(v2u*)(pq + 512) = kv2; }
        }
        __syncthreads();
    }
}

constexpr int CP = 144;
constexpr int CM = 64 * CP;
__device__ __forceinline__ void mm_nt(f32x16& acc, const LAS unsigned char* A, const LAS unsigned char* B, int m0, int n0, int r32, int hh) {
#pragma unroll
    for (int s4 = 0; s4 < 4; ++s4) { const bf16x8 a = *(const LAS bf16x8*)(A + (m0 + r32) * CP + 32 * s4 + 16 * hh); const bf16x8 b = *(const LAS bf16x8*)(B + (n0 + r32) * CP + 32 * s4 + 16 * hh);
        acc = __builtin_amdgcn_mfma_f32_32x32x16_bf16(a, b, acc, 0, 0, 0); }
}
__device__ __forceinline__ void store_t(LAS unsigned char* Dst, const f32x16& acc, int m0, int n0, int r32, int hh, float sg) {
#pragma unroll
    for (int g = 0; g < 4; ++g) { v2u w; w.x = pk2(sg * acc[4 * g], sg * acc[4 * g + 1]); w.y = pk2(sg * acc[4 * g + 2], sg * acc[4 * g + 3]); *(LAS v2u*)(Dst + (n0 + r32) * CP + (m0 + 8 * g + 4 * hh) * 2) = w; }
}
__device__ __forceinline__ void load_t(f32x16& acc, const LAS unsigned char* Src, int m0, int n0, int r32, int hh, float sg) {
#pragma unroll
    for (int g = 0; g < 4; ++g) { const v2u w = *(const LAS v2u*)(Src + (n0 + r32) * CP + (m0 + 8 * g + 4 * hh) * 2);
        acc[4 * g] = sg * bflo(w.x); acc[4 * g + 1] = sg * bfhi(w.x); acc[4 * g + 2] = sg * bflo(w.y); acc[4 * g + 3] = sg * bfhi(w.y); }
}
__device__ __forceinline__ void mask16(f32x16& acc, int m0, int n0, int r32, int hh, int mode) {
    const int n = n0 + r32;
#pragma unroll
    for (int r = 0; r < 16; ++r) { const int m = m0 + (r & 3) + 8 * (r >> 2) + 4 * hh; const bool keep = mode == 0 ? (n < m) : (mode == 1 ? (m < n) : (m <= n)); acc[r] = keep ? acc[r] : 0.f; }
}
__device__ __forceinline__ void phase_rwkv_chunk(Frame& F, int layer, int qoff = 0, int parts = 15) {
    KARGS;
    const float* R = WSP(float, WS_RW); const float* LW = WSP(float, WS_RW + RW_SLOT); const float* K = WSP(float, WS_RW + 2 * RW_SLOT); const float* V = WSP(float, WS_RW + 3 * RW_SLOT);
    const float* KK = WSP(float, WS_RW + 4 * RW_SLOT); const float* A = WSP(float, WS_RW + 5 * RW_SLOT);
    bf16* CGp = WSP(bf16, WS_CG); bf16* CQp = WSP(bf16, WS_CQ); float* CHp = WSP(float, WS_CH); float* CYp = WSP(float, WS_CY);
    const int tid = F.tid, lane = F.lane, w = F.wave, r32 = lane & 31, hh = lane >> 5;
    LAS unsigned char* L = F.lds;
    LAS unsigned char* Ab = L, *Bb = L + CM, *Kb = L + 2 * CM, *Rb = L + 3 * CM, *BtT = L + 4 * CM, *KtT = L + 5 * CM, *VT = L + 6 * CM;
    LAS unsigned char* XT0 = L + 7 * CM, *XT1 = L + 9 * CM;
    LAS unsigned char* NB = L + 11 * CM;
    LAS unsigned char* Prb = L + 15 * CM;
    LAS float* tot = (LAS float*)(L + 16 * CM);
    LAS float* gCl = tot + 512;
    const int myx = (int)((unsigned)__builtin_amdgcn_s_getreg((3 << 11) | 20) & 7u);
    unsigned* qh = (unsigned*)F.ctl + CW_CHQ + qoff + layer * 8 * 64;
    for (int dx = 0; dx < 8; ++dx) { const int xs = (myx + dx) & 7;
    for (;;) {
        LBAR();
        if (tid == 0) F.MISC[20] = atomicAdd(qh + xs * 64, 1u);
        LBAR();
        const int kq = (int)F.MISC[20];
        if (kq >= 256) break;
        const int bh = xs + 8 * (kq >> 7), c = kq & 127, b = bh >> 3, h = bh & 7;
        {
            const size_t g0 = ((size_t)b * SEQ + c * 64 + 8 * w) * 512 + h * 64 + lane;
            float lw[8], cum[8]; float run = 0.f;
#pragma unroll
            for (int i = 0; i < 8; ++i) { lw[i] = LW[g0 + (size_t)i * 512]; run += lw[i]; cum[i] = run; }
            tot[w * 64 + lane] = run;
            LBAR();
            float off = 0.f, all = 0.f;
#pragma unroll
            for (int ww = 0; ww < 8; ++ww) { const float tv = tot[ww * 64 + lane]; if (ww < w) off += tv; all += tv; }
            if (w == 0) gCl[lane] = expf(all);
#pragma unroll
            for (int i = 0; i < 8; ++i) {
                const int t = 8 * w + i; const float cm = cum[i] + off;
                const float g = expf(cm), gex = expf(cm - lw[i]), gi = expf(-cm), gcg = expf(all - cm);
                const size_t gg = g0 + (size_t)i * 512;
                const float r = R[gg], k = K[gg], v = V[gg], kk = KK[gg], a = A[gg];
                const bf16 ab = (bf16)f2bf(kk * gex), bb = (bf16)f2bf(kk * a * gi), kb = (bf16)f2bf(k * gi), rb = (bf16)f2bf(r * g), bt = (bf16)f2bf(kk * a * gcg), kt = (bf16)f2bf(k * gcg), vb = (bf16)f2bf(v);
                *(LAS bf16*)(Ab + t * CP + lane * 2) = ab; *(LAS bf16*)(Bb + t * CP + lane * 2) = bb; *(LAS bf16*)(Kb + t * CP + lane * 2) = kb; *(LAS bf16*)(Rb + t * CP + lane * 2) = rb;
                *(LAS bf16*)(XT0 + lane * CP + t * 2) = ab; *(LAS bf16*)(BtT + lane * CP + t * 2) = bt; *(LAS bf16*)(KtT + lane * CP + t * 2) = kt; *(LAS bf16*)(VT + lane * CP + t * 2) = vb;
            }
            LBAR();
        }
        if (!(parts & 2)) continue;
        int r32m = r32; asm volatile("" : "+v"(r32m));
        const int xtm = w & 1, xtn = w >> 1;
        f32x16 xacc;
        {
#pragma unroll
            for (int qq = 0; qq < 2; ++qq) {
                int q; if (w < 4) q = 2 * w + qq; else { if (qq == 1) break; q = 8 + (w - 4); }
                const int pr = q >> 2, tm = (q >> 1) & 1, tn = q & 1; f32x16 acc; ZERO16(acc);
                if (pr == 0) { mm_nt(acc, Ab, Bb, 32 * tm, 32 * tn, r32, hh); mask16(acc, 32 * tm, 32 * tn, r32m, hh, 0); store_t(NB + 1 * CM, acc, 32 * tm, 32 * tn, r32, hh, -1.f); }
                else if (pr == 1) { mm_nt(acc, Bb, Ab, 32 * tm, 32 * tn, r32, hh); mask16(acc, 32 * tm, 32 * tn, r32m, hh, 1); store_t(NB + 0 * CM, acc, 32 * tm, 32 * tn, r32, hh, -1.f); }
                else { mm_nt(acc, Bb, Rb, 32 * tm, 32 * tn, r32, hh); mask16(acc, 32 * tm, 32 * tn, r32m, hh, 2); store_t(Prb, acc, 32 * tm, 32 * tn, r32, hh, 1.f); }
            }
            if (xtn >= 2) { ZERO16(xacc); mm_nt(xacc, Ab, Kb, 32 * xtm, 32 * (xtn - 2), r32, hh); mask16(xacc, 32 * xtm, 32 * (xtn - 2), r32m, hh, 0); store_t(XT0 + 64 * CP, xacc, 32 * xtm, 32 * (xtn - 2), r32, hh, 1.f); }
            else load_t(xacc, XT0, 32 * xtm, 32 * xtn, r32, hh, 1.f);
            LBAR();
        }
        if (!(parts & 4)) continue;
        LAS unsigned char* XTc = XT0; LAS unsigned char* XTn = XT1; int nb = 0;
#pragma unroll 1
        for (int j = 0; j < 6; ++j) {
            const LAS unsigned char* Nc = NB + (2 * nb) * CM; const LAS unsigned char* NTc = NB + (2 * nb + 1) * CM;
            mm_nt(xacc, Nc, XTc, 32 * xtm, 32 * xtn, r32, hh);
            store_t(XTn, xacc, 32 * xtm, 32 * xtn, r32, hh, 1.f);
            if (j < 5) { const int tm = (w >> 1) & 1, tn = w & 1; f32x16 acc; ZERO16(acc);
                if (w < 4) { mm_nt(acc, Nc, NTc, 32 * tm, 32 * tn, r32, hh); store_t(NB + (2 * (nb ^ 1) + 1) * CM, acc, 32 * tm, 32 * tn, r32, hh, 1.f); }
                else       { mm_nt(acc, NTc, Nc, 32 * tm, 32 * tn, r32, hh); store_t(NB + (2 * (nb ^ 1)) * CM, acc, 32 * tm, 32 * tn, r32, hh, 1.f); } }
            LBAR();
            { LAS unsigned char* t_ = XTc; XTc = XTn; XTn = t_; } nb ^= 1;
        }
        if (!(parts & 8)) continue;
        const size_t cbase = (size_t)(bh * 128 + c) * 4096;
#pragma unroll
        for (int qq = 0; qq < 2; ++qq) {
            const int q = 2 * w + qq, pr = q >> 2, tm = (q >> 1) & 1, tn = q & 1, m0 = 32 * tm, n0 = 32 * tn; f32x16 acc;
            if (pr == 0) {
                load_t(acc, Rb, m0, n0, r32, hh, -1.f); mm_nt(acc, XTc, Prb, m0, n0, r32, hh);
#pragma unroll
                for (int g = 0; g < 4; ++g) { v2u o; o.x = pk2(-acc[4 * g], -acc[4 * g + 1]); o.y = pk2(-acc[4 * g + 2], -acc[4 * g + 3]);
                    *(v2u*)(CQp + cbase + (size_t)((((tn * 4 + 2 * tm + (g >> 1)) * 2 + (g & 1)) * 32 + r32) * 8 + hh * 4)) = o; }
            } else if (pr == 1) {
                ZERO16(acc); mm_nt(acc, XTc, BtT, m0, n0, r32, hh);
                const int k1 = n0 + r32; const float gc = gCl[k1];
#pragma unroll
                for (int g = 0; g < 4; ++g) { float e[4];
#pragma unroll
                    for (int i = 0; i < 4; ++i) { const int k2 = m0 + 8 * g + 4 * hh + i; e[i] = (k2 == k1 ? gc : 0.f) - acc[4 * g + i]; }
                    v2u o; o.x = pk2(e[0], e[1]); o.y = pk2(e[2], e[3]);
                    *(v2u*)(CGp + cbase + (size_t)((((tn * 4 + 2 * tm + (g >> 1)) * 2 + (g & 1)) * 32 + r32) * 8 + hh * 4)) = o; }
            } else if (pr == 2) {
                load_t(acc, KtT, m0, n0, r32, hh, -1.f); mm_nt(acc, XTc + 64 * CP, BtT, m0, n0, r32, hh); store_t(NB, acc, m0, n0, r32, hh, -1.f);
            } else {
                f32x16 a1; ZERO16(a1); mm_nt(a1, Kb, Rb, m0, n0, r32, hh); mask16(a1, m0, n0, r32m, hh, 2);
                ZERO16(acc); mm_nt(acc, XTc + 64 * CP, Prb, m0, n0, r32, hh);
#pragma unroll
                for (int r = 0; r < 16; ++r) acc[r] = a1[r] - acc[r];
                store_t(NB + CM, acc, m0, n0, r32, hh, 1.f);
            }
        }
        LBAR();
        {
            const int ww = w & 3, tm = ww >> 1, tn = ww & 1, m0 = 32 * tm, n0 = 32 * tn; f32x16 acc; ZERO16(acc);
            mm_nt(acc, w < 4 ? NB : NB + CM, VT, m0, n0, r32, hh);
            bf16* dst = (bf16*)(w < 4 ? CHp : CYp) + cbase + (size_t)((tm * 2 + tn) * 4 * 64 + lane) * 4;
#pragma unroll
            for (int g = 0; g < 4; ++g) { v2u o; o.x = pk2(acc[4 * g], acc[4 * g + 1]); o.y = pk2(acc[4 * g + 2], acc[4 * g + 3]); *(v2u*)(dst + g * 256) = o; }
        }
        LBAR();
    }
    }
}

__device__ __forceinline__ void rwkv_scan(Frame& F, int bh, const int mode = 7) {
    KARGS;
    const unsigned char* CG8 = WSP(unsigned char, WS_CG) + (size_t)bh * 128 * 8192; const unsigned char* CQ8 = WSP(unsigned char, WS_CQ) + (size_t)bh * 128 * 8192;
    const unsigned char* CH8 = WSP(unsigned char, WS_CH) + (size_t)bh * 128 * 8192; const unsigned char* CY8 = WSP(unsigned char, WS_CY) + (size_t)bh * 128 * 8192;
    float* Y = WSP(float, WS_RW + 7 * RW_SLOT);
    const int lane = F.lane, w = F.wave, r32 = lane & 31, hh = lane >> 5, b = bh >> 3, h = bh & 7;
    LAS unsigned char* S0 = F.lds; LAS unsigned char* S1 = F.lds + CM;
    LAS unsigned char* RING = F.lds + 2 * CM;
    LAS float* YR = (LAS float*)(F.lds + 2 * CM + 3 * 32768);
    for (int i = F.tid; i < 2 * CM / 4; i += NTHR) ((LAS unsigned*)F.lds)[i] = 0u;
    __syncthreads();
#define SC_DMA(gsrc, ldst) __builtin_amdgcn_global_load_lds((const unsigned*)(gsrc), (LAS unsigned*)(ldst), 16, 0, 0)
    auto issue = [&](const int c) {
        LAS unsigned char* slot = RING + (c % 3) * 32768; const size_t go = (size_t)c * 8192 + lane * 16;
        if (w < 4) {
#pragma unroll
            for (int q = 0; q < 2; ++q) { const int p = 2 * w + q; SC_DMA(CG8 + go + p * 1024, slot + p * 1024); SC_DMA(CH8 + go + p * 1024, slot + 8192 + p * 1024); } }
        else if (w < 6) {
#pragma unroll
            for (int q = 0; q < 4; ++q) { const int p = 4 * (w - 4) + q; SC_DMA(CQ8 + go + p * 1024, slot + 16384 + p * 1024); SC_DMA(CY8 + go + p * 1024, slot + 24576 + p * 1024); } }
    };
    issue(0); issue(1);
    if (w < 4) asm volatile("s_waitcnt vmcnt(4)" ::: "memory"); else asm volatile("s_waitcnt vmcnt(8)" ::: "memory");
    LBAR();
    if (w < 4) {
        const int tm = w >> 1, tn = w & 1, m0 = 32 * tm, n0 = 32 * tn;
#pragma unroll 1
        for (int c = 0; c < 128; ++c) {
            const LAS unsigned char* slot = RING + (c % 3) * 32768;
            const LAS unsigned char* Sc = (c & 1) ? S1 : S0; LAS unsigned char* Sn = (c & 1) ? S0 : S1;
            f32x16 acc;
#pragma unroll
            for (int g = 0; g < 4; ++g) { const v2u iw = *(const LAS v2u*)(slot + 8192 + (((tm * 2 + tn) * 4 + g) * 64 + lane) * 8);
                acc[4 * g] = bflo(iw.x); acc[4 * g + 1] = bfhi(iw.x); acc[4 * g + 2] = bflo(iw.y); acc[4 * g + 3] = bfhi(iw.y); }
#pragma unroll
            for (int s4 = 0; s4 < 4; ++s4) { const bf16x8 a = *(const LAS bf16x8*)(slot + ((tm * 8 + hh) * 32 + r32) * 16 + 1024 * s4);
                const bf16x8 bb = *(const LAS bf16x8*)(Sc + (n0 + r32) * CP + 32 * s4 + 16 * hh); acc = __builtin_amdgcn_mfma_f32_32x32x16_bf16(a, bb, acc, 0, 0, 0); }
            store_t(Sn, acc, m0, n0, r32, hh, 1.f);
            if (c + 2 < 128) { issue(c + 2); asm volatile("s_waitcnt vmcnt(4)" ::: "memory"); } else asm volatile("s_waitcnt vmcnt(0)" ::: "memory");
            LBAR();
        }
        LBAR();
    } else if (w < 6) {
        const int tmY = w - 4, m0 = 32 * tmY;
#pragma unroll 1
        for (int c = 0; c < 128; ++c) {
            const LAS unsigned char* slot = RING + (c % 3) * 32768;
            const LAS unsigned char* Sc = (c & 1) ? S1 : S0; LAS float* yo = YR + (c & 1) * 4096;
            f32x16 acc[2]; bf16x8 a[4];
#pragma unroll
            for (int s4 = 0; s4 < 4; ++s4) a[s4] = *(const LAS bf16x8*)(slot + 16384 + ((tmY * 8 + hh) * 32 + r32) * 16 + 1024 * s4);
#pragma unroll
            for (int tn = 0; tn < 2; ++tn) {
#pragma unroll
                for (int g = 0; g < 4; ++g) { const v2u iw = *(const LAS v2u*)(slot + 24576 + (((tmY * 2 + tn) * 4 + g) * 64 + lane) * 8);
                    acc[tn][4 * g] = bflo(iw.x); acc[tn][4 * g + 1] = bfhi(iw.x); acc[tn][4 * g + 2] = bflo(iw.y); acc[tn][4 * g + 3] = bfhi(iw.y); }
#pragma unroll
                for (int s4 = 0; s4 < 4; ++s4) { const bf16x8 bb = *(const LAS bf16x8*)(Sc + (32 * tn + r32) * CP + 32 * s4 + 16 * hh); acc[tn] = __builtin_amdgcn_mfma_f32_32x32x16_bf16(a[s4], bb, acc[tn], 0, 0, 0); }
#pragma unroll
                for (int r = 0; r < 16; ++r) yo[(m0 + (r & 3) + 8 * (r >> 2) + 4 * hh) * 64 + 32 * tn + r32] = acc[tn][r];
            }
            if (c + 2 < 128) { issue(c + 2); asm volatile("s_waitcnt vmcnt(8)" ::: "memory"); } else asm volatile("s_waitcnt vmcnt(0)" ::: "memory");
            LBAR();
        }
        LBAR();
    } else {
        const int row0 = 32 * (w - 6) + (lane >> 4), cq = (lane & 15) * 4;
        float* yg = Y + ((size_t)b * SEQ + row0) * 512 + h * 64 + cq;
        LBAR();
#pragma unroll 1
        for (int c = 1; c <= 128; ++c) {
            const LAS float* yi = YR + ((c - 1) & 1) * 4096 + row0 * 64 + cq;
            f32x4 ty[8];
#pragma unroll
            for (int i = 0; i < 8; ++i) ty[i] = *(const LAS f32x4*)(yi + 4 * i * 64);
            asm volatile("s_waitcnt lgkmcnt(0)" ::: "memory");
#pragma unroll
            for (int i = 0; i < 8; ++i) *(f32x4*)(yg + (size_t)((c - 1) * 64 + 4 * i) * 512) = ty[i];
            LBAR();
        }
    }
#undef SC_DMA
}

__device__ __forceinline__ void phase_odd_main(Frame& F, int layer, int ctr_base, int parts) {
    KARGS;
    const bf16* P = WSP(bf16, WS_PROJ); bf16* MIX = WSP(bf16, WS_MIX); const float* DC = WSP(float, WS_DCUM);
    const int tid = F.tid, lane = F.lane, wave = F.wave, r32 = lane & 31, hh = lane >> 5;
    const float LOG2E = 1.4426950408889634f, CS = 0.125f * LOG2E;
    const int srow = tid >> 3, sch = tid & 7;
    const int myx = (int)((unsigned)__builtin_amdgcn_s_getreg((3 << 11) | 20) & 7u);
    unsigned* sq = (unsigned*)F.ctl + CW_SCQ + (ctr_base == CW_WORK ? 0 : 2048) + layer * 8 * 64;
    if (parts & 1) {
        __syncthreads(); if (tid == 0) F.MISC[19] = atomicAdd(sq + myx * 64, 1u); __syncthreads();
        const int kc = (int)F.MISC[19]; if (kc < 2) rwkv_scan(F, myx + 8 * kc, parts >> 4 ? (parts >> 4) & 7 : 7); }
    if (0) for (int bhs = F.bid; bhs < 16; bhs += F.G) rwkv_scan(F, bhs);
    unsigned* ctr = (unsigned*)F.ctl + ctr_base + 64 * layer;
#ifdef NOSKIP_PROBE
    const float BND = 1e30f;
#else
    const float BND = 2.04f * 8.f * LOG2E * wave_max(fabsf(IN(12)[(layer >> 1) * 64 + lane])) * wave_max(fabsf(IN(13)[(layer >> 1) * 64 + lane]));
#endif
    for (;;) {
        {
            __syncthreads();
            if (tid == 0) F.MISC[16] = atomicAdd(ctr, 1u);
            __syncthreads();
            const int u = (int)F.MISC[16];
            if (u >= 512 || !(parts & 2)) break;
            const int bh = u & 15, qb = 31 - (u >> 4), b = bh >> 3, h = bh & 7;
            const bf16* base = P + (size_t)b * SEQ * ODD_N; const float* dc = DC + (size_t)bh * SEQ;
            const int q0 = 256 * qb + 32 * wave, myq = q0 + r32;
            bf16x8 qf[4];
#pragma unroll
            for (int d0 = 0; d0 < 4; ++d0) qf[d0] = *(const bf16x8*)(base + (size_t)myq * ODD_N + h * 64 + 16 * d0 + 8 * hh);
            const float dq = dc[myq] * LOG2E;
            float m = -INFINITY, lsum = 0.f;
            f32x16 o[2];
#pragma unroll
            for (int r = 0; r < 16; ++r) { o[0][r] = 0.f; o[1][r] = 0.f; }
            const int NT = 4 * qb + 4;
            if (wave < 2) { const int jt = tid; const bool nd = jt < NT && (BND + (dc[256 * qb] - dc[64 * (jt < NT ? jt : 0) + 63]) * LOG2E >= -150.f);
                const unsigned long long mk = __ballot(nd); if (lane == 0) F.MISC[17 + wave] = mk ? (unsigned)(64 * wave + (int)__builtin_ctzll(mk)) : 1000u; }
            __syncthreads();
            const int jstart = (int)(F.MISC[17] < F.MISC[18] ? F.MISC[17] : F.MISC[18]);
            const float dqw = __builtin_bit_cast(float, __builtin_amdgcn_readfirstlane(__builtin_bit_cast(int, dq)));
            v4u kreg = *(const v4u*)(base + (size_t)(64 * jstart + srow) * ODD_N + 512 + h * 64 + sch * 8);
            v4u vreg = *(const v4u*)(base + (size_t)(64 * jstart + srow) * ODD_N + 1024 + h * 64 + sch * 8);
            float dreg = tid < 64 ? -dc[64 * jstart + tid] * LOG2E : 0.f;
            *(LAS v4u*)(F.lds + srow * FX_KROW + sch * 16) = kreg; *(LAS v4u*)(F.lds + FX_KB + srow * FX_VROW + sch * 16) = vreg;
            if (tid < 64) *(LAS float*)(F.lds + FX_KB + FX_VB + tid * 4) = dreg;
            __syncthreads();
            v4u kA = kreg, vA = vreg, kB = kreg, vB = vreg; float dA = 0.f, dB = 0.f;
            if (jstart + 1 < NT) { const size_t krow = (size_t)(64 * (jstart + 1) + srow) * ODD_N;
                kA = *(const v4u*)(base + krow + 512 + h * 64 + sch * 8); vA = *(const v4u*)(base + krow + 1024 + h * 64 + sch * 8);
                if (tid < 64) dA = dc[64 * (jstart + 1) + tid]; }
            auto tile_step = [&](const int j, v4u& kx, v4u& vx, float& dx, v4u& ky, v4u& vy, float& dy) {
                const int cur = ((j - jstart) & 1) * FX_BUF, nxt = ((j - jstart + 1) & 1) * FX_BUF;
                if (j + 2 < NT) { const size_t krow = (size_t)(64 * (j + 2) + srow) * ODD_N;
                    ky = *(const v4u*)(base + krow + 512 + h * 64 + sch * 8); vy = *(const v4u*)(base + krow + 1024 + h * 64 + sch * 8);
                    if (tid < 64) dy = dc[64 * (j + 2) + tid]; }
                if (64 * j <= q0 + 31 && BND + dqw + *(const LAS float*)(F.lds + cur + FX_KB + FX_VB + 63 * 4) >= -150.f) {
                    const LAS unsigned char* Kb = F.lds + cur; const LAS unsigned char* Vb = F.lds + cur + FX_KB; const LAS float* dkb = (const LAS float*)(F.lds + cur + FX_KB + FX_VB);
                    f32x16 p0, p1;
#pragma unroll
                    for (int r = 0; r < 16; ++r) { p0[r] = 0.f; p1[r] = 0.f; }
#pragma unroll
                    for (int d0 = 0; d0 < 4; ++d0) {
                        const bf16x8 a0 = *(const LAS bf16x8*)(Kb + r32 * FX_KROW + 32 * d0 + 16 * hh);
                        const bf16x8 a1 = *(const LAS bf16x8*)(Kb + (r32 + 32) * FX_KROW + 32 * d0 + 16 * hh);
                        p0 = __builtin_amdgcn_mfma_f32_32x32x16_bf16(a0, qf[d0], p0, 0, 0, 0);
                        p1 = __builtin_amdgcn_mfma_f32_32x32x16_bf16(a1, qf[d0], p1, 0, 0, 0);
                    }
                    const bool diag = 64 * j + 63 > q0;
#pragma unroll
                    for (int g = 0; g < 4; ++g) {
                        const f32x4 dk0 = *(const LAS f32x4*)(dkb + 8 * g + 4 * hh), dk1 = *(const LAS f32x4*)(dkb + 32 + 8 * g + 4 * hh);
#pragma unroll
                        for (int i = 0; i < 4; ++i) { p0[4 * g + i] = p0[4 * g + i] * CS + dk0[i]; p1[4 * g + i] = p1[4 * g + i] * CS + dk1[i]; }
                    }
                    if (diag) {
                        asm volatile("" ::: "memory");
#pragma unroll
                        for (int r = 0; r < 16; ++r) { const int key = 64 * j + (r & 3) + 8 * (r >> 2) + 4 * hh; if (key > myq) p0[r] = -INFINITY; if (key + 32 > myq) p1[r] = -INFINITY; }
                    }
                    float tmax;
                    {
                        float ta = MAX3F(p0[0], p0[1], p1[0]), tb = MAX3F(p0[2], p0[3], p1[1]); ta = MAX3F(ta, p1[2], p1[3]);
#pragma unroll
                        for (int r = 4; r < 16; r += 4) { ta = MAX3F(ta, p0[r], p0[r + 1]); tb = MAX3F(tb, p0[r + 2], p0[r + 3]); ta = MAX3F(ta, p1[r], p1[r + 1]); tb = MAX3F(tb, p1[r + 2], p1[r + 3]); }
                        tmax = fmaxf(ta, tb); }
                    tmax = fmaxf(tmax, __shfl_xor(tmax, 32));
                    const float mn = fmaxf(m, tmax); const float corr = __builtin_amdgcn_exp2f(m - mn); m = mn;
                    float ps = 0.f;
#pragma unroll
                    for (int r = 0; r < 16; ++r) { p0[r] = __builtin_amdgcn_exp2f(p0[r] - mn); p1[r] = __builtin_amdgcn_exp2f(p1[r] - mn); ps += p0[r] + p1[r]; }
                    lsum = lsum * corr + ps;
                    if (__any(corr != 1.f)) {
                        asm volatile("" ::: "memory");
#pragma unroll
                        for (int r = 0; r < 16; ++r) { o[0][r] *= corr; o[1][r] *= corr; } }
                    bf16x8 pf[4];
#pragma unroll
                    for (int s4 = 0; s4 < 4; ++s4) {
                        v4u w;
                        if (s4 < 2) { w.x = pk2(p0[8 * s4 + 0], p0[8 * s4 + 1]); w.y = pk2(p0[8 * s4 + 2], p0[8 * s4 + 3]); w.z = pk2(p0[8 * s4 + 4], p0[8 * s4 + 5]); w.w = pk2(p0[8 * s4 + 6], p0[8 * s4 + 7]); }
                        else { const int sp = s4 - 2; w.x = pk2(p1[8 * sp + 0], p1[8 * sp + 1]); w.y = pk2(p1[8 * sp + 2], p1[8 * sp + 3]); w.z = pk2(p1[8 * sp + 4], p1[8 * sp + 5]); w.w = pk2(p1[8 * sp + 6], p1[8 * sp + 7]); }
                        pf[s4] = __builtin_bit_cast(bf16x8, w);
                    }
                    const int gi = lane >> 4, li = lane & 15;
                    const LAS unsigned char* vbase = Vb + (4 * (gi >> 1) + (li >> 2)) * FX_VROW + (16 * (gi & 1) + 4 * (li & 3)) * 2;
#pragma unroll
                    for (int d0 = 0; d0 < 2; ++d0)
#pragma unroll
                        for (int s4 = 0; s4 < 4; ++s4) {
                            const s16x4 lo = __builtin_bit_cast(s16x4, __builtin_amdgcn_ds_read_tr16_b64_v4i16((LAS s16x4*)(vbase + (16 * s4) * FX_VROW + 64 * d0)));
                            const s16x4 hi = __builtin_bit_cast(s16x4, __builtin_amdgcn_ds_read_tr16_b64_v4i16((LAS s16x4*)(vbase + (16 * s4 + 8) * FX_VROW + 64 * d0)));
                            const bf16x8 vf = (bf16x8){lo[0], lo[1], lo[2], lo[3], hi[0], hi[1], hi[2], hi[3]};
                            o[d0] = __builtin_amdgcn_mfma_f32_32x32x16_bf16(vf, pf[s4], o[d0], 0, 0, 0);
                        }
                }
                if (j + 1 < NT) {
                    *(LAS v4u*)(F.lds + nxt + srow * FX_KROW + sch * 16) = kx; *(LAS v4u*)(F.lds + nxt + FX_KB + srow * FX_VROW + sch * 16) = vx;
                    if (tid < 64) *(LAS float*)(F.lds + nxt + FX_KB + FX_VB + tid * 4) = -dx * LOG2E;
                }
                LBAR();
            };
            for (int j = jstart; j < NT; j += 2) {
                tile_step(j, kA, vA, dA, kB, vB, dB);
                if (j + 1 < NT) tile_step(j + 1, kB, vB, dB, kA, vA, dA);
            }
            const float l = lsum + __shfl_xor(lsum, 32); const float inv = 1.f / l;
            const bf16* gp = base + (size_t)myq * ODD_N + 1536 + h * 64; bf16* op = MIX + ((size_t)b * SEQ + myq) * D + h * 64;
#pragma unroll
            for (int d0 = 0; d0 < 2; ++d0)
#pragma unroll
                for (int g = 0; g < 4; ++g) { const int db = 32 * d0 + 8 * g + 4 * hh; const v2u gw = *(const v2u*)(gp + db);
                    const float g0 = sigmoidf_(bflo(gw.x)), g1 = sigmoidf_(bfhi(gw.x)), g2 = sigmoidf_(bflo(gw.y)), g3 = sigmoidf_(bfhi(gw.y));
                    v2u ow; ow.x = pk2(o[d0][4 * g + 0] * inv * g0, o[d0][4 * g + 1] * inv * g1); ow.y = pk2(o[d0][4 * g + 2] * inv * g2, o[d0][4 * g + 3] * inv * g3);
                    *(v2u*)(op + db) = ow; }
        }
    }
    if (parts & 1) for (int dx = 0; dx < 8; ++dx) { const int xs = (myx + dx) & 7;
        for (;;) { __syncthreads(); if (tid == 0) F.MISC[19] = atomicAdd(sq + xs * 64, 1u); __syncthreads(); const int kc = (int)F.MISC[19]; if (kc >= 2) break; rwkv_scan(F, xs + 8 * kc); } }
}

__device__ __forceinline__ void phase_rwkv_post(Frame& F, int layer) {
    KARGS;
    const int jj = layer >> 1, ch = F.tid;
    const float* R = WSP(float, WS_RW); const float* K = WSP(float, WS_RW + 2 * RW_SLOT); const float* V = WSP(float, WS_RW + 3 * RW_SLOT);
    const float* Gt = WSP(float, WS_RW + 6 * RW_SLOT); const float* Y = WSP(float, WS_RW + 7 * RW_SLOT);
    bf16* MIX = WSP(bf16, WS_MIX);
    const float lw = IN(24)[jj * 512 + ch], lb = IN(25)[jj * 512 + ch], rk = IN(23)[jj * 512 + ch];
#pragma unroll 4
    for (int tg = F.bid; tg < T; tg += F.G) {
        const size_t o = (size_t)tg * 512 + ch;
        const float y = Y[o]; const float mu = wave_sum(y) * (1.f / 64.f); const float dlt = y - mu; const float var = wave_sum(dlt * dlt) * (1.f / 64.f);
        const float yn = dlt * rsqrtf(var + GN_EPS) * lw + lb;
        const float v = V[o]; const float bonus = wave_sum(R[o] * K[o] * rk) * v;
        MIX[(size_t)tg * D + 512 + ch] = (bf16)f2bf((yn + bonus) * Gt[o]);
    }
}

__device__ __forceinline__ void sort16_desc(float (&v)[16]) {
#pragma unroll
    for (int k = 2; k <= 16; k <<= 1)
#pragma unroll
        for (int j = k >> 1; j > 0; j >>= 1)
#pragma unroll
            for (int i = 0; i < 16; ++i) { const int l = i ^ j; if (l > i) { const float a_ = v[i], b_ = v[l]; const float mx = fmaxf(a_, b_), mn = fminf(a_, b_);
                if ((i & k) == 0) { v[i] = mx; v[l] = mn; } else { v[i] = mn; v[l] = mx; } } }
}
__device__ __forceinline__ void merge16_desc(float (&A)[16], const float (&B)[16]) {
#pragma unroll
    for (int i = 0; i < 16; ++i) A[i] = fmaxf(A[i], B[15 - i]);
#pragma unroll
    for (int j = 8; j > 0; j >>= 1)
#pragma unroll
        for (int i = 0; i < 16; ++i) { const int l = i ^ j; if (l > i) { const float a_ = A[i], b_ = A[l]; A[i] = fmaxf(a_, b_); A[l] = fminf(a_, b_); } }
}
__device__ __forceinline__ float pack_low(float v, unsigned bits, unsigned mask) { return __builtin_bit_cast(float, (__builtin_bit_cast(unsigned, v) & ~mask) | bits); }
template <bool OWN> __device__ __forceinline__ void phase_peer_topk(Frame& F, int layer, const pg8::StaticOrder S) {
    KARGS;
    const bf16* Q = WSP(bf16, WS_Q); const bf16* KEYS = WSP(bf16, WS_KEYS) + (size_t)layer * 2 * 16384;
    int* IDX = WSP(int, WS_IDX); float* GATE = WSP(float, WS_GATE);
    constexpr int SCP = 132;
    LAS float* sc = (LAS float*)(F.lds + F.wave * (32 * SCP * 4));
    LAS unsigned* li = (LAS unsigned*)sc;
    const int lane = F.lane, fr = lane & 15, fq = lane >> 4, tok = lane & 31, hp = lane >> 5;
    const int gw = F.bid * NWAVES + F.wave, NGW = F.G * NWAVES;
    pg8::Unit un{0, 0};
    const bool cv = OWN && layer < 3;
    const int NRW = (2 * NEXP + NGW - 1) / NGW;
    int cr = 0;
    f32x4 cvv[2][4];
    for (int it = OWN ? 0 : gw; OWN ? S.next(it, un) : (it < (T / 32) * 8); it += OWN ? 1 : NGW) {
        const int tile = OWN ? un.pm * 8 + F.wave : (it >> 3), h = OWN ? un.pn : (it & 7), t0 = tile * 32;
        float v1[16], v2[16];
#pragma unroll
        for (int half = 0; half < 2; ++half) {
            f32x4 acc[2][8];
#pragma unroll
            for (int rt = 0; rt < 2; ++rt)
#pragma unroll
                for (int ct = 0; ct < 8; ++ct) acc[rt][ct] = (f32x4){0.f, 0.f, 0.f, 0.f};
            const bf16* kb = KEYS + (size_t)half * 16384;
#pragma unroll 1
            for (int ks = 0; ks < 4; ++ks) {
                bf16x8 a[2];
#pragma unroll
                for (int rt = 0; rt < 2; ++rt) a[rt] = *(const bf16x8*)(Q + (size_t)(t0 + rt * 16 + fr) * 2048 + h * 256 + half * 128 + ks * 32 + 8 * fq);
#pragma unroll
                for (int ct = 0; ct < 8; ++ct) { const bf16x8 bb = *(const bf16x8*)(kb + (size_t)(ct * 16 + fr) * 128 + ks * 32 + 8 * fq);
#pragma unroll
                    for (int rt = 0; rt < 2; ++rt) acc[rt][ct] = __builtin_amdgcn_mfma_f32_16x16x32_bf16(a[rt], bb, acc[rt][ct], 0, 0, 0); }
            }
            if (cv && cr < NRW) conv_issue<2>(IN(29), IN(30), layer + 1, gw + cr * NGW, NGW, lane, cvv);
#pragma unroll
            for (int rt = 0; rt < 2; ++rt)
#pragma unroll
                for (int ct = 0; ct < 8; ++ct)
#pragma unroll
                    for (int r = 0; r < 4; ++r) sc[(rt * 16 + 4 * fq + r) * SCP + ct * 16 + fr] = pack_low(acc[rt][ct][r], (unsigned)(ct * 16 + fr), 0x7Fu);
            LDS_WAIT(); asm volatile("" ::: "memory");
            float top[16];
            const LAS float* row = sc + tok * SCP + 64 * hp;
#pragma unroll 1
            for (int g = 0; g < 4; ++g) {
                float grp[16];
#pragma unroll
                for (int q4 = 0; q4 < 4; ++q4) { const f32x4 x = *(const LAS f32x4*)(row + 16 * g + 4 * q4); grp[4 * q4] = x.x; grp[4 * q4 + 1] = x.y; grp[4 * q4 + 2] = x.z; grp[4 * q4 + 3] = x.w; }
                sort16_desc(grp);
                if (g == 0) {
#pragma unroll
                    for (int p = 0; p < 16; ++p) top[p] = grp[p]; }
                else merge16_desc(top, grp);
            }
            { float oth[16];
#pragma unroll
              for (int p = 0; p < 16; ++p) oth[p] = __shfl_xor(top[p], 32);
              merge16_desc(top, oth); }
            LDS_WAIT(); asm volatile("" ::: "memory");
#pragma unroll
            for (int p = 0; p < 16; ++p) { if (half == 0) v1[p] = top[p]; else v2[p] = top[p]; }
            if (cv && cr < NRW) { conv_finish<2>(WSP(unsigned char, WS_PU), WSP(unsigned char, WS_PV), WSP(float, WS_PS), layer + 1, gw + cr * NGW, NGW, lane, cvv, F.lds + 135168 + F.wave * 1024); cr += 2; }
        }
        if (hp == 0) {
#pragma unroll
            for (int p = 0; p < 16; ++p) { li[tok * 33 + p] = __builtin_bit_cast(unsigned, v1[p]) & 0x7Fu; li[tok * 33 + 16 + p] = __builtin_bit_cast(unsigned, v2[p]) & 0x7Fu; } }
        if (cv && cr < NRW) conv_issue<2>(IN(29), IN(30), layer + 1, gw + cr * NGW, NGW, lane, cvv);
        float ts[16];
        {
            float c0[16], c1[16];
            int n = 0;
#pragma unroll
            for (int a_ = 0; a_ < 16; ++a_)
#pragma unroll
                for (int b_ = 0; b_ < 16; ++b_) if ((a_ + 1) * (b_ + 1) <= 16) {
                    const float x = pack_low(v1[a_] + v2[b_], (unsigned)(a_ * 16 + b_), 0xFFu);
                    const int slot = n >> 1; const bool mine = (n & 1) == hp;
                    if (slot < 16) { if ((n & 1) == 0) c0[slot] = mine ? x : -INFINITY; else c0[slot] = mine ? x : c0[slot]; }
                    else { if ((n & 1) == 0) c1[slot - 16] = mine ? x : -INFINITY; else c1[slot - 16] = mine ? x : c1[slot - 16]; }
                    ++n; }
#pragma unroll
            for (int sl = 9; sl < 16; ++sl) c1[sl] = -INFINITY;
            sort16_desc(c0); sort16_desc(c1); merge16_desc(c0, c1);
            float oth[16];
#pragma unroll
            for (int p = 0; p < 16; ++p) oth[p] = __shfl_xor(c0[p], 32);
            merge16_desc(c0, oth);
#pragma unroll
            for (int p = 0; p < 16; ++p) ts[p] = c0[p];
        }
        LDS_WAIT(); asm volatile("" ::: "memory");
        if (cv && cr < NRW) { conv_finish<2>(WSP(unsigned char, WS_PU), WSP(unsigned char, WS_PV), WSP(float, WS_PS), layer + 1, gw + cr * NGW, NGW, lane, cvv, F.lds + 135168 + F.wave * 1024); cr += 2; }
        if (hp == 0) {
            float e[16], sum = 0.f;
#pragma unroll
            for (int p = 0; p < 16; ++p) { e[p] = expf(ts[p] - ts[0]); sum += e[p]; }
            const float inv = 1.f / sum;
            int* ip = IDX + (size_t)(t0 + tok) * 128 + h * 16; float* gp = GATE + (size_t)(t0 + tok) * 128 + h * 16;
#pragma unroll
            for (int p = 0; p < 16; ++p) { const unsigned ab = __builtin_bit_cast(unsigned, ts[p]) & 0xFFu;
                ip[p] = (int)(li[tok * 33 + (ab >> 4)] * 128u + li[tok * 33 + 16 + (ab & 15u)]); gp[p] = e[p] * inv; }
        }
        LDS_WAIT(); asm volatile("" ::: "memory");
    }
    while (cv && cr < NRW) { f32x4 v4[4][4];
        conv_issue<4>(IN(29), IN(30), layer + 1, gw + cr * NGW, NGW, lane, v4);
        conv_finish<4>(WSP(unsigned char, WS_PU), WSP(unsigned char, WS_PV), WSP(float, WS_PS), layer + 1, gw + cr * NGW, NGW, lane, v4, F.lds + 135168 + F.wave * 1024); cr += 4; }
}

typedef float f32x2 __attribute__((ext_vector_type(2)));
__device__ __forceinline__ void unpack16_fp8(float (&o)[16], const v4u w) {
#pragma unroll
    for (int j = 0; j < 4; ++j) { const f32x2 a = __builtin_amdgcn_cvt_pk_f32_fp8((int)w[j], false), b = __builtin_amdgcn_cvt_pk_f32_fp8((int)w[j], true); o[4 * j] = a.x; o[4 * j + 1] = a.y; o[4 * j + 2] = b.x; o[4 * j + 3] = b.y; }
}
__device__ __forceinline__ void gu_token(const unsigned char* U, const float* SU, const float* SV, const bf16* H, const int* IDX, const float* GATE, float* ACT, int s, int tg, int lane) {
    float x[16];
    { const v4u w0 = *(const v4u*)(H + (size_t)tg * D + 16 * lane), w1 = *(const v4u*)(H + (size_t)tg * D + 16 * lane + 8);
      x[0] = bflo(w0.x); x[1] = bfhi(w0.x); x[2] = bflo(w0.y); x[3] = bfhi(w0.y); x[4] = bflo(w0.z); x[5] = bfhi(w0.z); x[6] = bflo(w0.w); x[7] = bfhi(w0.w);
      x[8] = bflo(w1.x); x[9] = bfhi(w1.x); x[10] = bflo(w1.y); x[11] = bfhi(w1.y); x[12] = bflo(w1.z); x[13] = bfhi(w1.z); x[14] = bflo(w1.w); x[15] = bfhi(w1.w); }
#pragma unroll
    for (int half = 0; half < 2; ++half) {
        const int id = IDX[(size_t)tg * 128 + 64 * half + lane];
        const bool sel = (id >> 11) == s;
        unsigned long long m = __ballot(sel);
        const float su = sel ? SU[id] : 0.f, cf = sel ? GATE[(size_t)tg * 128 + 64 * half + lane] * SV[id] : 0.f;
        int actb = 0;
        while (m) {
            int pos[8]; v4u ua[8]; float d[8];
#pragma unroll
            for (int q = 0; q < 8; ++q) { pos[q] = m ? (int)__builtin_ctzll(m) : -1; m = m ? (m & (m - 1)) : m;
                const int idx = pos[q] >= 0 ? __builtin_amdgcn_readlane(id, pos[q]) : (s << 11);
                ua[q] = *(const v4u*)(U + (size_t)idx * 1024 + 16 * lane); }
#pragma unroll
            for (int q = 0; q < 8; ++q) { float u[16]; unpack16_fp8(u, ua[q]); float sm = 0.f;
#pragma unroll
                for (int i = 0; i < 16; ++i) sm += u[i] * x[i];
                d[q] = sm; }
#pragma unroll
            for (int o = 1; o < 64; o <<= 1) {
#pragma unroll
                for (int q = 0; q < 8; ++q) d[q] += __shfl_xor(d[q], o); }
#pragma unroll
            for (int q = 0; q < 8; ++q) if (pos[q] >= 0) { const float val = gelu_erf(d[q] * rl(su, pos[q])) * rl(cf, pos[q]);
                actb = lane == pos[q] ? __builtin_bit_cast(int, val) : actb; }
        }
        if (sel) ACT[(size_t)tg * 128 + 64 * half + lane] = __builtin_bit_cast(float, actb);
    }
}

__device__ __forceinline__ void phase_peer_gu_valu(Frame& F, int layer) {
    KARGS;
    const bf16* H = WSP(bf16, WS_H); const int* IDX = WSP(int, WS_IDX); const float* GATE = WSP(float, WS_GATE); float* ACT = WSP(float, WS_ACT);
    const unsigned char* U = WSP(unsigned char, WS_PU) + (size_t)layer * NEXP * 1024;
    const float* SU = WSP(float, WS_PS) + (size_t)layer * NEXP; const float* SV = SU + 4 * NEXP;
    const int lane = F.lane;
    unsigned* heads = (unsigned*)F.ctl + CW_G1 + layer * 8 * 64;
    const int myx = (int)((unsigned)__builtin_amdgcn_s_getreg((3 << 11) | 20) & 7u);
    for (int k = 0; k < 8; ++k) { const int s = (myx + k) & 7;
        for (;;) { unsigned u = 0; if (lane == 0) u = atomicAdd(heads + s * 64, 1u); u = (unsigned)__builtin_amdgcn_readfirstlane((int)u);
            if (u >= (unsigned)(T / 8)) break;
#pragma unroll 1
            for (int i = 0; i < 8; ++i) gu_token(U, SU, SV, H, IDX, GATE, ACT, s, (int)u * 8 + i, lane); } }
}
__device__ __forceinline__ void phase_peer_gu(Frame& F, int layer) {
    KARGS;
    const int* IDX = WSP(int, WS_IDX); const float* GATE = WSP(float, WS_GATE); float* ACT = WSP(float, WS_ACT);
    const unsigned char* U = WSP(unsigned char, WS_PU) + (size_t)layer * NEXP * 768; const unsigned char* SC6 = WSP(unsigned char, WS_PU) + (size_t)48 * MiB + (size_t)layer * NEXP * 32;
    const unsigned char* H8 = WSP(unsigned char, WS_H8); const float* HS = WSP(float, WS_HS);
    const float* SU = WSP(float, WS_PS) + (size_t)layer * NEXP; const float* SV = SU + 4 * NEXP;
    const int lane = F.lane, row = lane & 15, kc = lane >> 4;
    LAS int* lst = (LAS int*)(F.lds + F.wave * 18432);
    LAS unsigned char* xl = F.lds + F.wave * 18432 + 8192;
    LAS float* cpatch = (LAS float*)(F.lds + F.wave * 18432 + 8192 + 8320);
    unsigned* heads = (unsigned*)F.ctl + CW_G1 + layer * 8 * 64;
    const int myx = (int)((unsigned)__builtin_amdgcn_s_getreg((3 << 11) | 20) & 7u);
    struct TSet { v4u ua[12]; v2u sc; int e, meta; float su, sv, gt, xs; bool valid; };
    for (int k = 0; k < 8; ++k) {
        const int s = (myx + k) & 7;
        for (;;) {
            unsigned u = 0; if (lane == 0) u = atomicAdd(heads + s * 64, 1u); u = (unsigned)__builtin_amdgcn_readfirstlane((int)u);
            if (u >= (unsigned)(T / 8)) break;
            const int tg0 = (int)u * 8;
            int total = 0;
            int ida[8], idb[8]; v4u hx[8];
#pragma unroll
            for (int i = 0; i < 8; ++i) { ida[i] = IDX[(size_t)(tg0 + i) * 128 + lane]; idb[i] = IDX[(size_t)(tg0 + i) * 128 + 64 + lane]; hx[i] = *(const v4u*)(H8 + (size_t)(tg0 + i) * D + 16 * lane); }
#pragma unroll
            for (int i = 0; i < 8; ++i) {
                const int id0 = ida[i], id1 = idb[i];
                *(LAS v4u*)(xl + i * 1040 + 16 * lane) = hx[i];
                const bool sel0 = (id0 >> 11) == s, sel1 = (id1 >> 11) == s;
                const unsigned long long m0 = __ballot(sel0), m1 = __ballot(sel1);
                const int n0 = __builtin_popcountll(m0), cnt = n0 + __builtin_popcountll(m1);
                const int r0 = total + (int)__builtin_amdgcn_mbcnt_hi((unsigned)(m0 >> 32), __builtin_amdgcn_mbcnt_lo((unsigned)m0, 0u));
                const int r1 = total + n0 + (int)__builtin_amdgcn_mbcnt_hi((unsigned)(m1 >> 32), __builtin_amdgcn_mbcnt_lo((unsigned)m1, 0u));
                if (sel0) { lst[r0] = id0; lst[1024 + r0] = i * 128 + lane; }
                if (sel1) { lst[r1] = id1; lst[1024 + r1] = i * 128 + 64 + lane; }
                total += cnt; }
            LDS_WAIT(); asm volatile("" ::: "memory");
            const int ntile = (total + 15) >> 4;
            auto load_tile = [&](TSet& S, const int t) { if (t < ntile) {
                const int rr = 16 * t + row; S.valid = rr < total;
                const int ri = S.valid ? rr : 16 * t;
                S.e = lst[ri]; S.meta = lst[1024 + ri];
                const unsigned char* up = U + (size_t)S.e * 768 + 16 * kc;
#pragma unroll
                for (int j = 0; j < 12; ++j) S.ua[j] = *(const v4u*)(up + 64 * j);
                S.sc = *(const v2u*)(SC6 + (size_t)S.e * 32 + 8 * kc);
                S.su = 0.f; S.sv = 0.f; S.gt = 0.f; S.xs = 0.f;
                if (kc == 0) { S.su = 1.f; S.sv = SV[S.e]; S.gt = GATE[(size_t)(tg0 + (S.meta >> 7)) * 128 + (S.meta & 127)]; S.xs = HS[tg0 + (S.meta >> 7)]; } } };
            const LAS unsigned char* xp = xl + (row & 7) * 1040 + 16 * kc;
            auto compute_tile = [&](TSet& S, const int t) { if (t < ntile) {
                f32x4 acc0 = (f32x4){0.f, 0.f, 0.f, 0.f}, acc1 = acc0;
#define GU_MM(m, ACC) { const v4u xb0 = *(const LAS v4u*)(xp + 128 * (m)), xb1 = *(const LAS v4u*)(xp + 128 * (m) + 64); v8i av; \
                    _Pragma("unroll") for (int d = 0; d < 8; ++d) { const int i = 6 * (m) + d; av[d] = i < 48 ? (int)S.ua[i >> 2][i & 3] : 0; } \
                    const v8i bv = (v8i){(int)xb0.x, (int)xb0.y, (int)xb0.z, (int)xb0.w, (int)xb1.x, (int)xb1.y, (int)xb1.z, (int)xb1.w}; \
                    ACC = __builtin_amdgcn_mfma_scale_f32_16x16x128_f8f6f4(av, bv, ACC, 2, 0, (m) & 3, (int)S.sc[(m) >> 2], 0, 0x7F7F7F7F); }
                GU_MM(0, acc0) GU_MM(1, acc1) GU_MM(2, acc0) GU_MM(3, acc1) GU_MM(4, acc0) GU_MM(5, acc1) GU_MM(6, acc0) GU_MM(7, acc1)
#undef GU_MM
                acc0 += acc1;
#pragma unroll
                for (int q = 0; q < 4; ++q) cpatch[(4 * kc + q) * 17 + row] = acc0[q];
                LDS_WAIT(); asm volatile("" ::: "memory");
                const float d = cpatch[row * 17 + (S.meta >> 7)];
                if (S.valid && kc == 0) { const int tg = tg0 + (S.meta >> 7); const float av = gelu_erf(d * S.su * S.xs) * S.gt * S.sv;
                    const unsigned sl = (unsigned)(S.meta & 127);
                    const unsigned ab = __builtin_bit_cast(unsigned, av), eo = (unsigned)S.e << 3, mag = ab & 0x7FFFFFFFu;
                    const unsigned tq = mag > eo ? (mag - eo + 0x10000u) & 0xFFFE0000u : 0u;
                    ((unsigned*)ACT)[(((size_t)(tg >> 6) * 32 + (sl >> 2)) * 64 + (tg & 63)) * 4 + (sl & 3)] = (ab & 0x80000000u) | tq | eo; }
                LDS_WAIT(); asm volatile("" ::: "memory"); } };
            TSet A_, B_;
            load_tile(A_, 0);
#pragma unroll 1
            for (int t = 0; t < ntile; t += 2) { load_tile(B_, t + 1); compute_tile(A_, t); load_tile(A_, t + 2); compute_tile(B_, t + 1); }
            LDS_WAIT(); asm volatile("" ::: "memory");
        }
    }
}
__device__ __forceinline__ void gv_token(const unsigned char* Vc, const int* IDX, const float* ACT, const float* g2, float* X, int c, int tg, int lane) {
    const int g = lane >> 3, cl = lane & 7, b = tg >= SEQ ? 1 : 0;
    int iv[16]; float cv[16];
#pragma unroll
    for (int j = 0; j < 4; ++j) { const v4u a = *(const v4u*)(IDX + (size_t)tg * 128 + 16 * g + 4 * j); const f32x4 f = *(const f32x4*)(ACT + (size_t)tg * 128 + 16 * g + 4 * j);
        iv[4 * j] = (int)a.x; iv[4 * j + 1] = (int)a.y; iv[4 * j + 2] = (int)a.z; iv[4 * j + 3] = (int)a.w; cv[4 * j] = f.x; cv[4 * j + 1] = f.y; cv[4 * j + 2] = f.z; cv[4 * j + 3] = f.w; }
    float acc[16];
#pragma unroll
    for (int i = 0; i < 16; ++i) acc[i] = 0.f;
#pragma unroll
    for (int k0 = 0; k0 < 16; k0 += 8) {
        v4u seg[8];
#pragma unroll
        for (int k = 0; k < 8; ++k) seg[k] = *(const v4u*)(Vc + ((size_t)c * NEXP + iv[k0 + k]) * 128 + 16 * cl);
#pragma unroll
        for (int k = 0; k < 8; ++k) { float v[16]; unpack16_fp8(v, seg[k]);
#pragma unroll
            for (int i = 0; i < 16; ++i) acc[i] += v[i] * cv[k0 + k]; }
    }
#pragma unroll
    for (int o = 8; o < 64; o <<= 1) {
#pragma unroll
        for (int i = 0; i < 16; ++i) acc[i] += __shfl_xor(acc[i], o); }
    if (lane < 8) { float* xr = X + (size_t)tg * D + 128 * c + 16 * cl; const float* gg = g2 + b * 6144 + 128 * c + 16 * cl;
#pragma unroll
        for (int j = 0; j < 4; ++j) { const f32x4 g4 = *(const f32x4*)(gg + 4 * j); *(f32x4*)(xr + 4 * j) = *(const f32x4*)(xr + 4 * j) + g4 * (f32x4){acc[4 * j], acc[4 * j + 1], acc[4 * j + 2], acc[4 * j + 3]}; } }
}

__device__ __forceinline__ void phase_peer_gv_old(Frame& F, int layer) {
    KARGS;
    const int* IDX = WSP(int, WS_IDX); const float* ACT = WSP(float, WS_ACT);
    const unsigned char* Vc = WSP(unsigned char, WS_PV) + (size_t)layer * NEXP * 1024;
    const float* g2 = WSP(float, WS_MOD) + (size_t)layer * 2 * 6144 + 5120;
    float* X = OUTP; const int lane = F.lane;
    unsigned* heads = (unsigned*)F.ctl + CW_G2 + layer * 8 * 64;
    const int myx = (int)((unsigned)__builtin_amdgcn_s_getreg((3 << 11) | 20) & 7u);
    for (int k = 0; k < 8; ++k) { const int c = (myx + k) & 7;
        for (;;) { unsigned u = 0; if (lane == 0) u = atomicAdd(heads + c * 64, 1u); u = (unsigned)__builtin_amdgcn_readfirstlane((int)u);
            if (u >= (unsigned)(T / 8)) break;
#pragma unroll 1
            for (int i = 0; i < 8; ++i) gv_token(Vc, IDX, ACT, g2, X, c, (int)u * 8 + i, lane); } }
}
__device__ __forceinline__ void phase_peer_gv_l2(Frame& F, int layer) {
    KARGS;
    const int* IDX = WSP(int, WS_IDX); const float* ACT = WSP(float, WS_ACT);
    const unsigned char* Vc = WSP(unsigned char, WS_PV) + (size_t)layer * NEXP * 1024;
    const float* g2 = WSP(float, WS_MOD) + (size_t)layer * 2 * 6144 + 5120;
    float* X = OUTP;
    const int lane = F.lane, g = lane >> 3, cl = lane & 7;
    LAS unsigned* li_ = (LAS unsigned*)(F.lds + 8192 + F.wave * 8192);
    LAS float* la_ = (LAS float*)(F.lds + 8192 + F.wave * 8192 + 4096);
    unsigned* heads = (unsigned*)F.ctl + CW_G2 + layer * 8 * 64;
    const int myx = (int)((unsigned)__builtin_amdgcn_s_getreg((3 << 11) | 20) & 7u);
    for (int k = 0; k < 8; ++k) {
        const int c = (myx + k) & 7;
        for (;;) {
            unsigned u = 0; if (lane == 0) u = atomicAdd(heads + c * 64, 1u); u = (unsigned)__builtin_amdgcn_readfirstlane((int)u);
            if (u >= (unsigned)(T / 8)) break;
            const int tg = (int)u * 8 + g, b = tg >= SEQ ? 1 : 0;
#pragma unroll
            for (int j = 0; j < 4; ++j) { const v4u a = *(const v4u*)(IDX + (size_t)tg * 128 + 16 * cl + 4 * j); const f32x4 f = *(const f32x4*)(ACT + (size_t)tg * 128 + 16 * cl + 4 * j);
                *(LAS v4u*)(li_ + g * 128 + 16 * cl + 4 * j) = a; *(LAS f32x4*)(la_ + g * 128 + 16 * cl + 4 * j) = f; }
            LDS_WAIT(); asm volatile("" ::: "memory");
            f32x2 acc[8];
#pragma unroll
            for (int q = 0; q < 8; ++q) acc[q] = (f32x2){0.f, 0.f};
#pragma unroll 1
            for (int k0 = 0; k0 < 128; k0 += 16) {
                unsigned ei[16]; float ec[16]; v4u seg[16];
#pragma unroll
                for (int q4 = 0; q4 < 4; ++q4) { const v4u a = *(const LAS v4u*)(li_ + g * 128 + k0 + 4 * q4); const f32x4 f = *(const LAS f32x4*)(la_ + g * 128 + k0 + 4 * q4);
                    ei[4 * q4] = a.x; ei[4 * q4 + 1] = a.y; ei[4 * q4 + 2] = a.z; ei[4 * q4 + 3] = a.w; ec[4 * q4] = f.x; ec[4 * q4 + 1] = f.y; ec[4 * q4 + 2] = f.z; ec[4 * q4 + 3] = f.w; }
#pragma unroll
                for (int kk = 0; kk < 16; ++kk) seg[kk] = *(const v4u*)(Vc + ((size_t)c * NEXP + ei[kk]) * 128 + 16 * cl);
#pragma unroll
                for (int kk = 0; kk < 16; ++kk) { const float cf = ec[kk]; const f32x2 cf2 = (f32x2){cf, cf};
#pragma unroll
                    for (int j = 0; j < 4; ++j) { acc[2 * j] += __builtin_amdgcn_cvt_pk_f32_fp8((int)seg[kk][j], false) * cf2; acc[2 * j + 1] += __builtin_amdgcn_cvt_pk_f32_fp8((int)seg[kk][j], true) * cf2; } }
            }
            float* xr = X + (size_t)tg * D + 128 * c + 16 * cl; const float* gg = g2 + b * 6144 + 128 * c + 16 * cl;
#pragma unroll
            for (int j = 0; j < 4; ++j) { const f32x4 g4 = *(const f32x4*)(gg + 4 * j);
                *(f32x4*)(xr + 4 * j) = *(const f32x4*)(xr + 4 * j) + g4 * (f32x4){acc[2 * j].x, acc[2 * j].y, acc[2 * j + 1].x, acc[2 * j + 1].y}; }
            LDS_WAIT(); asm volatile("" ::: "memory");
        }
    }
}

__device__ __forceinline__ void phase_peer_gv(Frame& F, int layer) {
    KARGS;
    const unsigned* ACTP = WSP(unsigned, WS_ACT);
    const unsigned char* PV8 = WSP(unsigned char, WS_PV) + (size_t)layer * NEXP * 1024;
    const float* g2 = WSP(float, WS_MOD) + (size_t)layer * 2 * 6144 + 5120;
    float* X = OUTP;
    const int lane = F.lane, tid = F.tid;
    for (int u = F.bid; u < 256; u += F.G) {
        const int xq = u >> 3, c = 4 * (4 * (u & 7) + (xq >> 3)) + (xq & 3), hf = (xq >> 2) & 1;
        if (u != F.bid) __syncthreads();
        {   const v4u* src = (const v4u*)(PV8 + (size_t)c * NEXP * 8);
            v4u t[16];
#pragma unroll
            for (int i = 0; i < 16; ++i) t[i] = src[i * NTHR + tid];
#pragma unroll
            for (int i = 0; i < 16; ++i) *(LAS v4u*)(F.lds + (size_t)(i * NTHR + tid) * 16) = t[i]; }
        __syncthreads();
        const float* gg = g2 + hf * 6144 + 8 * c;
        const f32x4 ga = *(const f32x4*)gg, gb = *(const f32x4*)(gg + 4);
        const unsigned lbase = (unsigned)(size_t)F.lds; __builtin_assume(lbase == 0u);
        constexpr int NBLK = 128 / NWAVES;
        auto wptr = [&](int i, int j) { return (const v4u*)(ACTP + (((size_t)(hf * 128 + F.wave + NWAVES * i) * 32 + j * 4) * 64 + lane) * 4); };
        v4u w[4][4];
#pragma unroll
        for (int jj = 0; jj < 4; ++jj) { const v4u* wp = wptr(0, jj);
#pragma unroll
            for (int g = 0; g < 4; ++g) w[jj][g] = wp[g * 64]; }
        v2u v[2][16];
#pragma unroll
        for (int kk = 0; kk < 16; ++kk) v[0][kk] = *(const LAS v2u*)(unsigned)((w[0][kk >> 2][kk & 3] & 0x1FFF8u) + lbase);
#pragma unroll 1
        for (int i = 0; i < NBLK; ++i) {
            float* xr = X + (size_t)((hf * 128 + F.wave + NWAVES * i) * 64 + lane) * D + 8 * c;
            const f32x4 x0 = *(const f32x4*)xr, x1 = *(const f32x4*)(xr + 4);
            const int inx = i + 1 < NBLK ? i + 1 : i;
            f32x2 acc[4];
#pragma unroll
            for (int q = 0; q < 4; ++q) acc[q] = (f32x2){0.f, 0.f};
#pragma unroll
            for (int j = 0; j < 8; ++j) {
#pragma unroll
                for (int kk = 0; kk < 16; ++kk) v[(j + 1) & 1][kk] = *(const LAS v2u*)(unsigned)((w[(j + 1) & 3][kk >> 2][kk & 3] & 0x1FFF8u) + lbase);
                asm volatile("" ::: "memory");
#pragma unroll
                for (int kk = 0; kk < 16; ++kk) {
                    const v4u wq = w[j & 3][kk >> 2]; v2u pr; pr.x = (kk & 2) ? wq.z : wq.x; pr.y = (kk & 2) ? wq.w : wq.y;
                    const f32x2 f0 = __builtin_amdgcn_cvt_pk_f32_fp8((int)v[j & 1][kk].x, false), f1 = __builtin_amdgcn_cvt_pk_f32_fp8((int)v[j & 1][kk].x, true);
                    const f32x2 f2 = __builtin_amdgcn_cvt_pk_f32_fp8((int)v[j & 1][kk].y, false), f3 = __builtin_amdgcn_cvt_pk_f32_fp8((int)v[j & 1][kk].y, true);
                    if (kk & 1) {
                        asm("v_pk_fma_f32 %0, %1, %2, %0 op_sel:[1,0,0] op_sel_hi:[1,1,1]" : "+v"(acc[0]) : "v"(pr), "v"(f0)); asm("v_pk_fma_f32 %0, %1, %2, %0 op_sel:[1,0,0] op_sel_hi:[1,1,1]" : "+v"(acc[1]) : "v"(pr), "v"(f1));
                        asm("v_pk_fma_f32 %0, %1, %2, %0 op_sel:[1,0,0] op_sel_hi:[1,1,1]" : "+v"(acc[2]) : "v"(pr), "v"(f2)); asm("v_pk_fma_f32 %0, %1, %2, %0 op_sel:[1,0,0] op_sel_hi:[1,1,1]" : "+v"(acc[3]) : "v"(pr), "v"(f3));
                    } else {
                        asm("v_pk_fma_f32 %0, %1, %2, %0 op_sel_hi:[0,1,1]" : "+v"(acc[0]) : "v"(pr), "v"(f0)); asm("v_pk_fma_f32 %0, %1, %2, %0 op_sel_hi:[0,1,1]" : "+v"(acc[1]) : "v"(pr), "v"(f1));
                        asm("v_pk_fma_f32 %0, %1, %2, %0 op_sel_hi:[0,1,1]" : "+v"(acc[2]) : "v"(pr), "v"(f2)); asm("v_pk_fma_f32 %0, %1, %2, %0 op_sel_hi:[0,1,1]" : "+v"(acc[3]) : "v"(pr), "v"(f3)); } }
                asm volatile("" ::: "memory");
                { const v4u* wp = j + 4 < 8 ? wptr(i, j + 4) : wptr(inx, j - 4);
#pragma unroll
                  for (int g = 0; g < 4; ++g) w[j & 3][g] = wp[g * 64]; }
                asm volatile("" ::: "memory");
            }
            *(f32x4*)xr = x0 + ga * (f32x4){acc[0].x, acc[0].y, acc[1].x, acc[1].y};
            *(f32x4*)(xr + 4) = x1 + gb * (f32x4){acc[2].x, acc[2].y, acc[3].x, acc[3].y};
        }
    }
}

__device__ __forceinline__ void phase_final(Frame& F) {
    KARGS;
    float* X = OUTP; const float* gain = IN(31);
    const int lane = F.lane, gw = F.bid * NWAVES + F.wave, NGW = F.G * NWAVES;
    f32x4 gn[4];
#pragma unroll
    for (int j = 0; j < 4; ++j) gn[j] = *(const f32x4*)(gain + 256 * j + 4 * lane);
    for (int row = gw; row < T; row += NGW) {
        float* xr = X + (size_t)row * D + 4 * lane;
        f32x4 v[4]; float ss = 0.f;
#pragma unroll
        for (int j = 0; j < 4; ++j) { v[j] = *(const f32x4*)(xr + 256 * j); ss += (v[j].x * v[j].x + v[j].y * v[j].y) + (v[j].z * v[j].z + v[j].w * v[j].w); }
        const float rstd = rsqrtf(wave_sum(ss) * (1.f / D) + NORM_EPS);
#pragma unroll
        for (int j = 0; j < 4; ++j) *(f32x4*)(xr + 256 * j) = v[j] * rstd * gn[j];
    }
}

#ifndef TS_LMASK
#define TS_LMASK 15
#endif
#ifndef PROBE_PARTS
#define PROBE_PARTS 3
#endif
#ifndef PROBE_DUP
#define PROBE_DUP 0
#endif
#ifndef PH_MASK
#define PH_MASK 0xFFFF
#endif
#define PH_EN(k) ((PH_MASK >> (k)) & 1)
constexpr int NPH = 50;
__host__ __device__ inline bool phase_skipped(int p) { if (p == 0 || p == NPH - 1) return false; const int layer = (p - 1) / 12, step = (p - 1) % 12;
    if (step == 9) return true;
    return (layer & 1) == 0 && (step == 3 || step == 4 || step == 5); }
__global__ void __launch_bounds__(NTHR, 2) mk_fwd(Args args) {
    extern __shared__ __attribute__((aligned(16))) unsigned char lds[];
    Frame F;
    F.lds = (LAS unsigned char*)lds;
    F.MISC = (volatile LAS unsigned*)(F.lds + MISC_OFF);
    F.tid = threadIdx.x; F.lane = F.tid & 63; F.wave = __builtin_amdgcn_readfirstlane(F.tid >> 6);
    F.G = gridDim.x; F.bid = blockIdx.x;
    F.ctl = (gu32*)(args.ws + WS_CTL);
    for (int u = F.tid; u < (LDS_BYTES - MISC_OFF) / 4; u += NTHR) ((LAS unsigned*)(F.lds + MISC_OFF))[u] = 0u;
    __syncthreads();
    XcdBarrier bar; bar.bar = (unsigned*)(F.ctl + CW_BAR); bar.x = 0; bar.st = nullptr;
    const int lo = args.ph_lo, hi = args.ph_hi;
    if (hi - lo > 1) bar = xcd_barrier_post((unsigned*)(F.ctl + CW_BAR), F.MISC + 8);
    bool ran = false;
#ifdef TS_STEP
    unsigned long long ts_acc = 0ull;
#endif
    for (int p = lo; p < hi; ++p) {
        if (phase_skipped(p)) continue;
        if (ran) xcd_barrier(bar);
        ran = true;
        { int t_ = threadIdx.x; asm volatile("" : "+v"(t_)); F.tid = t_; F.lane = t_ & 63; F.wave = __builtin_amdgcn_readfirstlane(t_ >> 6);
          int b_ = blockIdx.x, g_ = gridDim.x; asm volatile("" : "+s"(b_), "+s"(g_)); F.bid = b_; F.G = g_; }
#ifdef TS_STEP
        const bool ts_sel = (p == 0) ? (TS_STEP == 100) : (((p - 1) % 12) == TS_STEP && ((TS_LMASK >> ((p - 1) / 12)) & 1));
        unsigned long long ts0 = 0ull; if (ts_sel) ts0 = __builtin_amdgcn_s_memrealtime();
#define TS_END() do { if (ts_sel) { xcd_barrier(bar); ts_acc += __builtin_amdgcn_s_memrealtime() - ts0; } } while (0)
#else
#define TS_END() do {} while (0)
#endif
        if (p == 0) { if (PH_EN(0)) {
#if (PROBE_DUP >> 0) & 1
            phase_prologue(F); __syncthreads();
#endif
            phase_prologue(F); } TS_END(); continue; }
        if (p == NPH - 1) { if (PH_EN(1)) phase_final(F); continue; }
        const int layer = (p - 1) / 12, step = (p - 1) % 12; const bool odd = layer & 1;
        KARGS;
        if (step == 0 || step == 7) { if (PH_EN(2)) {
#if (PROBE_DUP >> 2) & 1
            phase_norm(F, layer, step == 7 ? 1 : 0);
#endif
            phase_norm(F, layer, step == 7 ? 1 : 0); } }
        else if (step == 1 || step == 8) { if (PH_EN(3)) {
            const int N = step == 8 ? 2048 : (odd ? ODD_N : EVEN_IN);
            const bf16* Bt = step == 8 ? WSP(bf16, WS_WQ + (size_t)layer * 4 * MiB) : WSP(bf16, WS_WIN + (size_t)layer * 8 * MiB);
            bf16* O = step == 8 ? WSP(bf16, WS_Q) : WSP(bf16, WS_PROJ);
            pg8::Gemm g{WSP(bf16, WS_H), Bt, T, N, D}; pg8::StaticOrder S; S.init(T, N, F.G, F.bid);
            pg8::EpiBf16<0> E{O, N, nullptr, 0, 0, 1.f};
#if (PROBE_DUP >> 3) & 1
            pg8::gemm_phase<pg8::EpiBf16<0>, pg8::StaticOrder, PG8_ALIGN, PG8_SP2>(F.lds + RING_OFF, g, S, E); __syncthreads();
#endif
            pg8::gemm_phase<pg8::EpiBf16<0>, pg8::StaticOrder, PG8_ALIGN, PG8_SP2>(F.lds + RING_OFF, g, S, E);
            if (step == 8) { asm volatile("s_waitcnt vmcnt(0)" ::: "memory"); __syncthreads(); phase_peer_topk<true>(F, layer, S); }
        } }
        else if (step == 2) { if (odd) { if (PH_EN(4)) {
#if (PROBE_DUP >> 4) & 1
            phase_odd_prep(F, layer, PROBE_PARTS); xcd_barrier(bar);
#endif
            phase_odd_prep(F, layer, 7); } } else { if (PH_EN(5)) {
#if (PROBE_DUP >> 5) & 1
            phase_even_mixer(F, layer);
#endif
            phase_even_mixer(F, layer); } } }
        else if (step == 3) { if (PH_EN(11)) {
#if (PROBE_DUP >> 11) & 1
            phase_rwkv_chunk(F, layer, 2048, PROBE_PARTS); xcd_barrier(bar);
#endif
            phase_rwkv_chunk(F, layer); } }
        else if (step == 4) { if (PH_EN(6)) {
#if (PROBE_DUP >> 6) & 1
            phase_odd_main(F, layer, CW_WORK2, PROBE_PARTS); xcd_barrier(bar);
#endif
            phase_odd_main(F, layer, CW_WORK, 3); } }
        else if (step == 5) { if (PH_EN(7)) {
#if (PROBE_DUP >> 7) & 1
            phase_rwkv_post(F, layer);
#endif
            phase_rwkv_post(F, layer); } }
        else if (step == 6) { if (PH_EN(8)) {
            pg8::Gemm g{WSP(bf16, WS_MIX), WSP(bf16, WS_WOUT + (size_t)layer * 2 * MiB), T, D, D}; pg8::StaticOrder S; S.init(T, D, F.G, F.bid);
            pg8::EpiResid E{layer == 0 ? IN(0) : OUTP, OUTP, WSP(float, WS_MOD) + (size_t)layer * 2 * 6144 + 2048, 6144};
            pg8::gemm_phase<pg8::EpiResid, pg8::StaticOrder, PG8_ALIGN, PG8_SP2>(F.lds + RING_OFF, g, S, E);
        } }
        else if (step == 9) { }
        else if (step == 10) { if (PH_EN(10)) {
#ifdef GU_VALU
            phase_peer_gu_valu(F, layer);
#else
            phase_peer_gu(F, layer);
#endif
            } }
        else { if (PH_EN(12)) {
#ifdef GV_OLD
            phase_peer_gv_old(F, layer);
#else
            phase_peer_gv(F, layer);
#endif
            } }
        TS_END();
    }
#ifdef TS_STEP
    if (blockIdx.x == 0 && threadIdx.x == 0) args.out[0] = (float)ts_acc;
#endif
}

extern "C" void kernel_launch(void* const* d_in, const int* in_sizes, int n_in, void* d_out, int out_size, void* d_ws, size_t ws_size, hipStream_t stream) {
    static int grid = 0;
    if (grid == 0) {
        if (n_in != 32 || in_sizes[0] != T * D || out_size != T * D || ws_size < WS_END) { fprintf(stderr, "kernel_launch: unexpected shapes (n_in %d, in0 %d, out %d, ws %zu < %zu); nothing launched\n", n_in, n_in > 0 ? in_sizes[0] : -1, out_size, ws_size, (size_t)WS_END); grid = -1; return; }
        int dev = 0, cus = 0, per_cu = 0;
        if (hipGetDevice(&dev) != hipSuccess || hipDeviceGetAttribute(&cus, hipDeviceAttributeMultiprocessorCount, dev) != hipSuccess) { grid = -1; return; }
        if (hipFuncSetAttribute((const void*)mk_fwd, hipFuncAttributeMaxDynamicSharedMemorySize, LDS_BYTES) != hipSuccess) { fprintf(stderr, "kernel_launch: hipFuncSetAttribute failed\n"); grid = -1; return; }
        if (hipOccupancyMaxActiveBlocksPerMultiprocessor(&per_cu, (const void*)mk_fwd, NTHR, LDS_BYTES) != hipSuccess || per_cu < 1) fprintf(stderr, "kernel_launch: occupancy query reports %d workgroups per CU\n", per_cu);
        (void)hipGetLastError();
        grid = cus;
    }
    if (grid < 0) return;
    if (hipMemsetAsync((char*)d_ws + WS_CTL, 0, CTL_ZERO_BYTES, stream) != hipSuccess) { fprintf(stderr, "kernel_launch: hipMemsetAsync failed\n"); return; }
    Args a{};
    for (int i = 0; i < 32; ++i) a.in[i] = (const float*)d_in[i];
    a.out = (float*)d_out; a.ws = (unsigned char*)d_ws;
#if MK_ONE_LAUNCH
    a.ph_lo = 0; a.ph_hi = NPH;
    hipLaunchKernelGGL(mk_fwd, dim3(grid), dim3(NTHR), LDS_BYTES, stream, a);
#else
    for (int p = 0; p < NPH; ++p) { if (phase_skipped(p)) continue; a.ph_lo = p; a.ph_hi = p + 1;
        hipLaunchKernelGGL(mk_fwd, dim3(grid), dim3(NTHR), LDS_BYTES, stream, a); }
#endif
    const hipError_t le = hipPeekAtLastError();
    if (le != hipSuccess) fprintf(stderr, "kernel_launch: launch failed: %s\n", hipGetErrorName(le));
}
```

```cpp
#include <hip/hip_runtime.h>
#include <cstdio>
#include <cstdint>
namespace pg8 {
#define PG8_LAS __attribute__((address_space(3)))
typedef unsigned short bf16_t;
typedef short bf16x8 __attribute__((ext_vector_type(8)));
typedef float f32x4 __attribute__((ext_vector_type(4)));
typedef unsigned u32x4 __attribute__((ext_vector_type(4)));
constexpr int BM = 256, BK = 64, HALF = 128, HTB = HALF * BK * 2  , STAGE_BYTES = 8 * HTB, NXCD = 8, WGM = 8;

__host__ __device__ __forceinline__ int lds_byte(int r, int c) { const int st = (r >> 4) * 2 + (c >> 5), rr = r & 15, cc = c & 31, ob = rr * 64 + cc * 2; return st * 1024 + (ob ^ (((ob >> 9) & 1) << 5)); }
__host__ __device__ __forceinline__ void stage_rc(int b, int& R, int& C) { const int st = b / 1024, sb = b % 1024, swz = sb ^ (((sb >> 9) & 1) << 5); R = (st >> 1) * 16 + swz / 64; C = (st & 1) * 32 + (swz % 64) / 2; }
__host__ __device__ __forceinline__ int perm32(int rho) { const int n = rho >> 4, i = rho & 15; return 8 * (i >> 2) + 4 * n + (i & 3); }

struct Unit { int pm, pn; };
struct Gemm { const bf16_t* A; const bf16_t* Bt; int M, N, K; };

struct StaticOrder {
    int nM, nN, nwg, G, c;
    __host__ __device__ void init(int M, int N, int G_, int c_) { nM = M / BM; nN = N / BM; nwg = nM * nN; G = G_; c = c_; }
    __host__ __device__ bool next(int i, Unit& u) const {
        const long L = (long)i * G + c; if (L >= nwg) return false;
        int wgid = (int)L; { const int q = nwg / NXCD, r = nwg % NXCD, xcd = wgid % NXCD, off = wgid / NXCD; wgid = (xcd < r ? xcd * (q + 1) : r * (q + 1) + (xcd - r) * q) + off; }
        const int nig = WGM * nN, gid = wgid / nig, fm = gid * WGM, gsz = (nM - fm) < WGM ? (nM - fm) : WGM;
        u.pm = fm + ((wgid % nig) % gsz); u.pn = (wgid % nig) / gsz; return true;
    }
    __device__ __forceinline__ void a_ready(const Unit&) const {}
    __device__ __forceinline__ void done(const Unit&) const {}
};

__device__ __forceinline__ unsigned cvt_pk_bf16(float lo, float hi) { unsigned r; asm volatile("v_cvt_pk_bf16_f32 %0, %1, %2" : "=v"(r) : "v"(lo), "v"(hi)); return r; }
typedef float f32x2 __attribute__((ext_vector_type(2)));
__device__ __forceinline__ f32x2 gelu_pk(f32x2 v) {
    const f32x2 av = __builtin_elementwise_abs(v), d = av * 0.2316418882f + 1.0f;
    f32x2 t; t.x = __builtin_amdgcn_rcpf(d.x); t.y = __builtin_amdgcn_rcpf(d.y);
    f32x2 q = t * 0.5307027145f + (-0.7265760135f); q = q * t + 0.7107068705f; q = q * t + (-0.142248368f); q = q * t + 0.127414796f; q = q * t;
    const f32x2 s = (v * v) * (-0.72134752044f);
    f32x2 e; e.x = __builtin_amdgcn_exp2f(s.x); e.y = __builtin_amdgcn_exp2f(s.y);
    const f32x2 m = v * (q * e), r = v - m;
    f32x2 o; o.x = v.x < 0.f ? m.x : r.x; o.y = v.y < 0.f ? m.y : r.y; return o;
}

template <int ACT  > struct EpiBf16 {
    static constexpr bool PERM = true, AFTER_DRAIN = false; static_assert(ACT == 0 || ACT == 1, "EpiBf16: ACT is 0 (none) or 1 (gelu_pk)");
    bf16_t* O; int ldc; const float* bias; int split_cols; size_t split_stride; float scale0;
    __device__ __forceinline__ void operator()(const f32x4 (&acc)[2][2][4][2], const Unit& u, int wr, int wc, int fr, int fq) const {
        const int row0 = u.pm * BM + wr * 64 + fr; int colt = u.pn * BM; bf16_t* base = O;
        float sc = 1.f; if (split_cols) { const int t = colt / split_cols; base += (size_t)t * split_stride; colt -= t * split_cols; if (t == 0) sc = scale0; }
        const int col0 = colt + wc * 32 + 8 * fq, bcol0 = u.pn * BM + wc * 32 + 8 * fq;
        f32x4 bv[2][2];
#pragma unroll
        for (int bj = 0; bj < 2; ++bj)
#pragma unroll
            for (int n = 0; n < 2; ++n) bv[bj][n] = bias ? *(const f32x4*)(bias + bcol0 + bj * HALF + 4 * n) : (f32x4){0.f, 0.f, 0.f, 0.f};
#pragma unroll
        for (int ai = 0; ai < 2; ++ai)
#pragma unroll
            for (int m = 0; m < 4; ++m) { bf16_t* rowp = base + (size_t)(row0 + ai * HALF + m * 16) * ldc + col0;
#pragma unroll
                for (int bj = 0; bj < 2; ++bj) { f32x4 v0 = acc[ai][bj][m][0] + bv[bj][0], v1 = acc[ai][bj][m][1] + bv[bj][1];
                    if (ACT == 1) { f32x2 a = gelu_pk((f32x2){v0[0], v0[1]}), b = gelu_pk((f32x2){v0[2], v0[3]}), c = gelu_pk((f32x2){v1[0], v1[1]}), d = gelu_pk((f32x2){v1[2], v1[3]});
                        v0 = (f32x4){a.x, a.y, b.x, b.y}; v1 = (f32x4){c.x, c.y, d.x, d.y}; }
                    v0 = v0 * sc; v1 = v1 * sc; u32x4 w; w.x = cvt_pk_bf16(v0[0], v0[1]); w.y = cvt_pk_bf16(v0[2], v0[3]); w.z = cvt_pk_bf16(v1[0], v1[1]); w.w = cvt_pk_bf16(v1[2], v1[3]);
                    *(u32x4*)(rowp + bj * HALF) = w; } }
    }
};
struct EpiResid {
    static constexpr bool PERM = false, AFTER_DRAIN = false;
    const float* base; float* out; const float* gate; int gstride;
    __device__ __forceinline__ void operator()(const f32x4 (&acc)[2][2][4][2], const Unit& u, int wr, int wc, int fr, int fq) const {
        const int row0 = u.pm * BM + wr * 64 + fr; const int col0 = u.pn * BM + wc * 32 + 4 * fq;
        const float* gp = gate + ((u.pm * BM) >= 8192 ? gstride : 0);
        f32x4 gv[2][2];
#pragma unroll
        for (int bj = 0; bj < 2; ++bj)
#pragma unroll
            for (int n = 0; n < 2; ++n) gv[bj][n] = *(const f32x4*)(gp + col0 + bj * HALF + n * 16);
#pragma unroll
        for (int ai = 0; ai < 2; ++ai)
#pragma unroll
            for (int m = 0; m < 4; ++m) { const size_t off = (size_t)(row0 + ai * HALF + m * 16) * 1024 + col0;
#pragma unroll
                for (int bj = 0; bj < 2; ++bj)
#pragma unroll
                    for (int n = 0; n < 2; ++n) { const f32x4 bs = *(const f32x4*)(base + off + bj * HALF + n * 16);
                        *(f32x4*)(out + off + bj * HALF + n * 16) = bs + gv[bj][n] * acc[ai][bj][m][n]; } }
    }
};
template <class Epi, class Sched, bool ALIGN_EPI = false, bool SP2 = false>
__device__ __forceinline__ void gemm_phase(PG8_LAS unsigned char* lds, const Gemm g, const Sched& S, const Epi& E) {
    int tid_l = threadIdx.x; asm volatile("" : "+v"(tid_l));
    const int tid = tid_l, wid = __builtin_amdgcn_readfirstlane(tid >> 6), lane = tid & 63, wr = wid >> 2, wc = wid & 3, fr = lane & 15, fq = lane >> 4;
    const int K = g.K, nt = K / BK;
    unsigned voffA[2], voffB[2];
#pragma unroll
    for (int i = 0; i < 2; ++i) { int R, C; stage_rc(tid * 16 + i * 8192, R, C); const int Rb = Epi::PERM ? ((R & ~31) + perm32(R & 31)) : R;
        voffA[i] = (unsigned)(R * K + C) * 2u; voffB[i] = (unsigned)(Rb * K + C) * 2u; }
    const size_t kstep = (size_t)(BK * 2);
    const size_t hstep = (size_t)HALF * K * 2;
    const size_t tstep = 2 * hstep;
    const unsigned ldsw = (unsigned)wid * 1024u;
    const int aoff = lds_byte(wr * 64 + fr, fq * 8), boff = lds_byte(wc * 32 + fr, fq * 8);
#define PG8_SA(b, h) (((b) * 2 + (h)) * HTB)
#define PG8_SB(b, h) ((4 + (b) * 2 + (h)) * HTB)
#define PG8_STAGE(bufoff, gbase, voff) do { _Pragma("unroll") for (int _i = 0; _i < 2; ++_i) \
        __builtin_amdgcn_global_load_lds((const unsigned*)((const char*)(gbase) + (voff)[_i]), (PG8_LAS unsigned*)(lds + (bufoff) + ldsw + _i * 8192), 16, 0, 0); } while (0)
#define PG8_LDA(dst, b, h) do { _Pragma("unroll") for (int m = 0; m < 4; ++m) _Pragma("unroll") for (int k = 0; k < 2; ++k) dst[m][k] = *(const PG8_LAS bf16x8*)(lds + PG8_SA(b, h) + aoff + m * 2048 + k * 1024); } while (0)
#define PG8_LDB(dst, b, h) do { _Pragma("unroll") for (int n = 0; n < 2; ++n) _Pragma("unroll") for (int k = 0; k < 2; ++k) dst[n][k] = *(const PG8_LAS bf16x8*)(lds + PG8_SB(b, h) + boff + n * 2048 + k * 1024); } while (0)
#define PG8_MMA(ai, bj, At, Bt) do { __builtin_amdgcn_s_setprio(1); _Pragma("unroll") for (int m = 0; m < 4; ++m) _Pragma("unroll") for (int n = 0; n < 2; ++n) _Pragma("unroll") for (int k = 0; k < 2; ++k) \
        acc[ai][bj][m][n] = __builtin_amdgcn_mfma_f32_16x16x32_bf16(Bt[n][k], At[m][k], acc[ai][bj][m][n], 0, 0, 0); __builtin_amdgcn_s_setprio(0); } while (0)
#define PG8_WAIT_V(n) asm volatile("s_waitcnt vmcnt(" #n ")" ::: "memory")
#define PG8_WAIT_L(n) asm volatile("s_waitcnt lgkmcnt(" #n ")" ::: "memory")
#define PG8_BAR __builtin_amdgcn_s_barrier()
#define PG8_SCHED __builtin_amdgcn_sched_barrier(0)
    Unit cur, nxt; int ui = 0;
    if (!S.next(0, cur)) return;
    f32x4 acc[2][2][4][2];
#pragma unroll
    for (int a = 0; a < 2; ++a)
#pragma unroll
        for (int b = 0; b < 2; ++b)
#pragma unroll
            for (int m = 0; m < 4; ++m)
#pragma unroll
                for (int n = 0; n < 2; ++n) acc[a][b][m][n] = (f32x4){0.f, 0.f, 0.f, 0.f};
    bf16x8 At[4][2], B0[2][2], B1[2][2];
    const char* cA = (const char*)g.A + (size_t)cur.pm * tstep; const char* cB = (const char*)g.Bt + (size_t)cur.pn * tstep;
    S.a_ready(cur);
    if constexpr (SP2) {
        PG8_STAGE(PG8_SB(0, 0), cB, voffB); PG8_STAGE(PG8_SB(0, 1), cB + hstep, voffB); PG8_STAGE(PG8_SA(0, 0), cA, voffA); PG8_STAGE(PG8_SA(0, 1), cA + hstep, voffA);
        if (wr == 1) PG8_BAR;
        PG8_WAIT_V(2); PG8_BAR;
        PG8_STAGE(PG8_SB(1, 0), cB + kstep, voffB); PG8_STAGE(PG8_SA(1, 0), cA + kstep, voffA); PG8_STAGE(PG8_SB(1, 1), cB + hstep + kstep, voffB);
        PG8_WAIT_V(6); PG8_BAR;
    } else {
        PG8_STAGE(PG8_SB(0, 0), cB, voffB); PG8_STAGE(PG8_SA(0, 0), cA, voffA); PG8_STAGE(PG8_SB(0, 1), cB + hstep, voffB); PG8_STAGE(PG8_SA(0, 1), cA + hstep, voffA);
        if (wr == 1) PG8_BAR;
        PG8_WAIT_V(4); PG8_BAR;
        PG8_STAGE(PG8_SB(1, 0), cB + kstep, voffB); PG8_STAGE(PG8_SA(1, 0), cA + kstep, voffA); PG8_STAGE(PG8_SB(1, 1), cB + hstep + kstep, voffB);
        PG8_WAIT_V(6); PG8_BAR;
    }
    for (;;) {
        const bool has_next = S.next(ui + 1, nxt);
        const char* nA = has_next ? (const char*)g.A + (size_t)nxt.pm * tstep : cA; const char* nB = has_next ? (const char*)g.Bt + (size_t)nxt.pn * tstep : cB;
        for (int t = 0; t < nt; t += 2) {
            const bool last = (t == nt - 2);
            const char* a1 = cA + (size_t)(t + 1) * kstep;
            const char* a2 = last ? nA : cA + (size_t)(t + 2) * kstep; const char* b2 = last ? nB : cB + (size_t)(t + 2) * kstep;
            const char* a3 = a2 + kstep; const char* b3 = b2 + kstep;
            if (last && has_next) S.a_ready(nxt);
            if constexpr (SP2) {
            PG8_LDB(B0, 0, 0); PG8_LDB(B1, 0, 1); PG8_SCHED; PG8_LDA(At, 0, 0); PG8_STAGE(PG8_SA(1, 1), a1 + hstep, voffA);
            PG8_WAIT_V(8); PG8_WAIT_L(0); PG8_BAR; PG8_MMA(0, 0, At, B0); PG8_MMA(0, 1, At, B1); PG8_BAR; PG8_SCHED;
            PG8_LDA(At, 0, 1); PG8_STAGE(PG8_SB(0, 0), b2, voffB); PG8_STAGE(PG8_SB(0, 1), b2 + hstep, voffB); PG8_STAGE(PG8_SA(0, 0), a2, voffA);
            PG8_WAIT_V(8); PG8_WAIT_L(0); PG8_BAR; PG8_MMA(1, 0, At, B0); PG8_MMA(1, 1, At, B1); PG8_BAR; PG8_SCHED;
            PG8_LDB(B0, 1, 0); PG8_LDB(B1, 1, 1); PG8_SCHED; PG8_LDA(At, 1, 0); PG8_STAGE(PG8_SA(0, 1), a2 + hstep, voffA);
            PG8_WAIT_V(8); PG8_WAIT_L(0); PG8_BAR; PG8_MMA(0, 0, At, B0); PG8_MMA(0, 1, At, B1); PG8_BAR; PG8_SCHED;
            PG8_LDA(At, 1, 1); PG8_STAGE(PG8_SB(1, 0), b3, voffB); PG8_STAGE(PG8_SB(1, 1), b3 + hstep, voffB); PG8_STAGE(PG8_SA(1, 0), a3, voffA);
            PG8_WAIT_V(8); PG8_WAIT_L(0); PG8_BAR; PG8_MMA(1, 0, At, B0); PG8_MMA(1, 1, At, B1); PG8_BAR; PG8_SCHED;
            } else {
            PG8_LDB(B0, 0, 0); PG8_SCHED; PG8_LDA(At, 0, 0); PG8_STAGE(PG8_SA(1, 1), a1 + hstep, voffA);
            PG8_WAIT_L(8); PG8_BAR; PG8_WAIT_L(0); PG8_MMA(0, 0, At, B0); PG8_BAR; PG8_SCHED;
            PG8_LDB(B1, 0, 1); PG8_STAGE(PG8_SB(0, 0), b2, voffB);
            PG8_BAR; PG8_WAIT_L(0); PG8_MMA(0, 1, At, B1); PG8_BAR;
            PG8_LDA(At, 0, 1); PG8_STAGE(PG8_SA(0, 0), a2, voffA);
            PG8_BAR; PG8_WAIT_L(0); PG8_MMA(1, 0, At, B0); PG8_BAR; PG8_SCHED;
            PG8_STAGE(PG8_SB(0, 1), b2 + hstep, voffB);
            PG8_WAIT_V(6); PG8_BAR; PG8_MMA(1, 1, At, B1); PG8_BAR;
            PG8_LDB(B0, 1, 0); PG8_SCHED; PG8_LDA(At, 1, 0); PG8_STAGE(PG8_SA(0, 1), a2 + hstep, voffA);
            PG8_WAIT_L(8); PG8_BAR; PG8_WAIT_L(0); PG8_MMA(0, 0, At, B0); PG8_BAR; PG8_SCHED;
            PG8_LDB(B1, 1, 1); PG8_STAGE(PG8_SB(1, 0), b3, voffB);
            PG8_BAR; PG8_WAIT_L(0); PG8_MMA(0, 1, At, B1); PG8_BAR;
            PG8_LDA(At, 1, 1); PG8_STAGE(PG8_SA(1, 0), a3, voffA);
            PG8_BAR; PG8_WAIT_L(0); PG8_MMA(1, 0, At, B0); PG8_BAR; PG8_SCHED;
            PG8_STAGE(PG8_SB(1, 1), b3 + hstep, voffB);
            PG8_WAIT_V(6); PG8_BAR; PG8_MMA(1, 1, At, B1); PG8_BAR;
            }
        }
        if constexpr (ALIGN_EPI) { if (wr == 0) PG8_BAR; }
        if constexpr (!Epi::AFTER_DRAIN) { E(acc, cur, wr, wc, fr, fq); S.done(cur); }
        if (!has_next) break;
#pragma unroll
        for (int a = 0; a < 2; ++a)
#pragma unroll
            for (int b = 0; b < 2; ++b)
#pragma unroll
                for (int m = 0; m < 4; ++m)
#pragma unroll
                    for (int n = 0; n < 2; ++n) acc[a][b][m][n] = (f32x4){0.f, 0.f, 0.f, 0.f};
        cur = nxt; cA = nA; cB = nB; ++ui;
        if constexpr (ALIGN_EPI) { if (wr == 1) PG8_BAR; }
    }
    PG8_WAIT_V(0);
    if constexpr (!ALIGN_EPI) { if (wr == 0) PG8_BAR; }
    PG8_BAR;
    if constexpr (Epi::AFTER_DRAIN) { E.fused(acc, cur, wr, wc, fr, fq, lds, wid, lane); S.done(cur); }
#undef PG8_SA
#undef PG8_SB
#undef PG8_STAGE
#undef PG8_LDA
#undef PG8_LDB
#undef PG8_MMA
#undef PG8_WAIT_V
#undef PG8_WAIT_L
#undef PG8_BAR
#undef PG8_SCHED
}
}
#ifndef PG8_SP2
#define PG8_SP2 true
#endif
#ifndef PG8_ALIGN
#define PG8_ALIGN true
#endif
#ifndef MK_ONE_LAUNCH
#define MK_ONE_LAUNCH 1
#endif

constexpr int NWAVES = 8, NTHR = NWAVES * 64;
constexpr int BATCH = 2, SEQ = 8192, D = 1024, T = BATCH * SEQ, DEPTH = 4;
constexpr int EVEN_IN = 2048, ODD_LD = 3848, ODD_N = 3840;
constexpr int NEXP = 16384;
constexpr float NORM_EPS = 1e-6f, GN_EPS = 64e-5f;

constexpr size_t MiB = 1u << 20;
constexpr size_t WS_CTL = 0, CTL_ZERO_BYTES = 1 * MiB;
constexpr size_t WS_MOD = 1 * MiB;
constexpr size_t WS_WF = WS_MOD + 256 * 1024;
constexpr size_t WS_KEYS = WS_MOD + 512 * 1024;
constexpr size_t WS_LORA = 3 * MiB;
constexpr size_t WS_LOGF = 2 * MiB;
constexpr size_t WS_DCUM = 2 * MiB + 512 * 1024;
constexpr size_t WS_WIN = 4 * MiB;
constexpr size_t WS_WOUT = 36 * MiB;
constexpr size_t WS_WQ = 44 * MiB;
constexpr size_t WS_H = 64 * MiB;
constexpr size_t WS_MIX = 96 * MiB;
constexpr size_t WS_PROJ = 128 * MiB;
constexpr size_t WS_Q = 256 * MiB;
constexpr size_t WS_IDX = 320 * MiB;
constexpr size_t WS_GATE = 328 * MiB;
constexpr size_t WS_RW = 336 * MiB;
constexpr size_t RW_SLOT = 32 * MiB;
constexpr size_t WS_PU = WS_RW + 8 * RW_SLOT;
constexpr size_t WS_PV = WS_PU + 64 * MiB;
constexpr size_t WS_PS = WS_PV + 64 * MiB;
constexpr size_t WS_CG = WS_PS + 1 * MiB;
constexpr size_t WS_CQ = WS_CG + 16 * MiB;
constexpr size_t WS_CH = WS_CQ + 16 * MiB;
constexpr size_t WS_CY = WS_CH + 32 * MiB;
constexpr size_t WS_H8 = WS_CY + 32 * MiB;
constexpr size_t WS_HS = WS_H8 + 16 * MiB;
constexpr size_t WS_ACT = WS_HS + 1 * MiB;
constexpr size_t WS_END = WS_ACT + 8 * MiB;
constexpr int CW_WORK = 64;
constexpr int CW_WORK2 = 1024;
constexpr int CW_G1 = 24576, CW_G2 = 28672;
constexpr int CW_CHQ = 16384, CW_SCQ = 20480;
constexpr int CW_BAR = 4096;

constexpr int RING_OFF = 0, RING_BYTES = 131072;
constexpr int MISC_OFF = 159744;
constexpr int LDS_BYTES = 163840;

#define GAS __attribute__((address_space(1)))
#define LAS __attribute__((address_space(3)))
typedef unsigned short bf16;
typedef unsigned v4u __attribute__((ext_vector_type(4)));
typedef unsigned v2u __attribute__((ext_vector_type(2)));
typedef int v8i __attribute__((ext_vector_type(8)));
typedef float f32x4 __attribute__((ext_vector_type(4)));
typedef short bf16x8 __attribute__((ext_vector_type(8)));
typedef GAS unsigned gu32;
#define LDS_WAIT() asm volatile("s_waitcnt lgkmcnt(0)" ::: "memory")
#define VM_WAIT() asm volatile("s_waitcnt vmcnt(0)" ::: "memory")
#define LBAR() do { asm volatile("s_waitcnt lgkmcnt(0)" ::: "memory"); __builtin_amdgcn_s_barrier(); asm volatile("" ::: "memory"); } while (0)
typedef float f32x2_t __attribute__((ext_vector_type(2))); typedef __bf16 bf16x2_t __attribute__((ext_vector_type(2)));
__device__ __forceinline__ unsigned pk2(float lo, float hi) { const f32x2_t v = {lo, hi}; const bf16x2_t b = __builtin_convertvector(v, bf16x2_t); return __builtin_bit_cast(unsigned, b); }
__device__ __forceinline__ unsigned f2bf(float f) { return pk2(f, 0.f) & 0xffffu; }
__device__ __forceinline__ float bf2f(bf16 v) { return __builtin_bit_cast(float, (unsigned)v << 16); }
__device__ __forceinline__ float bflo(unsigned w) { return __builtin_bit_cast(float, w << 16); }
__device__ __forceinline__ float bfhi(unsigned w) { return __builtin_bit_cast(float, w & 0xffff0000u); }
__device__ __forceinline__ float wave_sum(float v) {
#pragma unroll
    for (int o = 1; o < 64; o <<= 1) v += __shfl_xor(v, o);
    return v;
}
__device__ __forceinline__ float wave_max(float v) {
#pragma unroll
    for (int o = 1; o < 64; o <<= 1) v = fmaxf(v, __shfl_xor(v, o));
    return v;
}
__device__ __forceinline__ float rl(float x, int j) { return __builtin_bit_cast(float, __builtin_amdgcn_readlane(__builtin_bit_cast(int, x), j)); }
__device__ __forceinline__ float sigmoidf_(float x) { return 1.f / (1.f + expf(-x)); }
__device__ __forceinline__ float softplusf_(float x) { return fmaxf(x, 0.f) + log1pf(expf(-fabsf(x))); }
__device__ __forceinline__ float gelu_erf(float x) { return 0.5f * x * (1.f + erff(x * 0.70710678118654752f)); }

#define XB_TMO      128
#define XB_XCNT(j)  (256  + 64 * (j))
#define XB_XSUB(j)  (1280 + 64 * (j))
#define XB_XGEN(j)  (2304 + 64 * (j))
#define XB_TOP      3328
#define XB_TOPGEN   3392
#define XCD_BAR_WORDS 3456
#define XB_SPIN_CAP (1u << 18)

__device__ __forceinline__ unsigned xb_ld(unsigned* p)              { return __hip_atomic_load(p, __ATOMIC_RELAXED, __HIP_MEMORY_SCOPE_AGENT); }
__device__ __forceinline__ unsigned xb_add(unsigned* p, unsigned v) { return __hip_atomic_fetch_add(p, v, __ATOMIC_RELAXED, __HIP_MEMORY_SCOPE_AGENT); }
__device__ __forceinline__ unsigned xb_xcc_id() { return (unsigned)__builtin_amdgcn_s_getreg((3 << 11) | 20) & 0xFu; }
#define XB_SPIN(cond, bar) do { unsigned _sp = 0; while (cond) { __builtin_amdgcn_s_sleep(1); \
    if ((++_sp & 255u) == 0u) { if (xb_ld(&(bar)[XB_TMO])) break; if (_sp > XB_SPIN_CAP) { atomicAdd(&(bar)[XB_TMO], 1u); break; } } } } while (0)

struct XcdBarrier {
    unsigned* bar; unsigned x;
    volatile LAS unsigned* st;
};

__device__ __forceinline__ XcdBarrier xcd_barrier_post(unsigned* bar, volatile LAS unsigned* st) {
    XcdBarrier b; b.bar = bar; b.x = xb_xcc_id(); b.st = st;
    if (threadIdx.x == 0) (void)xb_add(&bar[XB_XCNT(b.x)], 1u);
    return b;
}
__device__ __forceinline__ void xcd_barrier_complete(unsigned* bar, unsigned x, unsigned& nloc, unsigned& nx) {
    const unsigned G = gridDim.x * gridDim.y * gridDim.z;
    unsigned sum, cnt, mine, sp = 0u;
    for (;;) {
        sum = 0u; cnt = 0u; mine = 0u;
#pragma unroll
        for (unsigned j = 0; j < 16; ++j) { const unsigned c = xb_ld(&bar[XB_XCNT(j)]); sum += c; cnt += (c > 0u) ? 1u : 0u; mine = (j == x) ? c : mine; }
        if (sum == G) break;
        __builtin_amdgcn_s_sleep(1);
        if ((++sp & 255u) == 0u) { if (xb_ld(&bar[XB_TMO])) break; if (sp > XB_SPIN_CAP) { atomicAdd(&bar[XB_TMO], 1u); break; } }
    }
    nloc = mine > 0u ? mine : 1u; nx = cnt > 0u ? cnt : 1u;
}

__device__ __forceinline__ void xcd_barrier(const XcdBarrier& b) {
    asm volatile("s_waitcnt vmcnt(0)" ::: "memory");
    __syncthreads();
    if (threadIdx.x == 0) {
        unsigned* bar = b.bar;
        __builtin_amdgcn_s_waitcnt(0);
        unsigned nloc = b.st[0], nx = b.st[1];
        if (nloc == 0u) { xcd_barrier_complete(bar, b.x, nloc, nx); b.st[0] = nloc; b.st[1] = nx; }
        const unsigned old = xb_add(&bar[XB_XSUB(b.x)], 1u);
        const unsigned gen = old / nloc;
        if (old + 1u == (gen + 1u) * nloc) {
            __builtin_amdgcn_fence(__ATOMIC_RELEASE, "agent");
            asm volatile("s_waitcnt vmcnt(0)" ::: "memory");
            const unsigned og = xb_add(&bar[XB_TOP], 1u);
            const unsigned tg = og / nx;
            if (og + 1u == (tg + 1u) * nx) xb_add(&bar[XB_TOPGEN], 1u);
            else XB_SPIN(xb_ld(&bar[XB_TOPGEN]) == tg, bar);
            __builtin_amdgcn_fence(__ATOMIC_ACQUIRE, "agent");
            xb_add(&bar[XB_XGEN(b.x)], 1u);
            asm volatile("s_waitcnt vmcnt(0)" ::: "memory");
        } else {
            XB_SPIN(xb_ld(&bar[XB_XGEN(b.x)]) == gen, bar);
            __builtin_amdgcn_fence(__ATOMIC_ACQUIRE, "agent");
            asm volatile("s_waitcnt vmcnt(0)" ::: "memory");
        }
    }
    __syncthreads();
}


struct Frame {
    LAS unsigned char* lds;
    volatile LAS unsigned* MISC;
    gu32* ctl;
    int tid, lane, wave, G, bid;
};
struct Args { const float* in[32]; float* out; unsigned char* ws; int ph_lo, ph_hi; };
#define CAS __attribute__((address_space(4)))
#define KARGS const CAS Args* ka_; { unsigned long long kp_ = (unsigned long long)__builtin_amdgcn_kernarg_segment_ptr(); asm volatile("" : "+s"(kp_)); ka_ = (const CAS Args*)kp_; } unsigned char* const ws_ = ka_->ws
#define IN(i) (ka_->in[i])
#define OUTP (ka_->out)
#define WSP(type, off) ((type*)(ws_ + (off)))

template <int NR> __device__ __forceinline__ void conv_issue(const float* TU, const float* TV, int l, int row0, int NGW, int lane, f32x4 (&v)[NR][4]) {
#pragma unroll
    for (int q = 0; q < NR; ++q) { const int r = row0 + q * NGW; if (r < 2 * NEXP) { const int tb = r >= NEXP ? 1 : 0, e = r - tb * NEXP;
        const float* src = (tb ? TV : TU) + ((size_t)l * NEXP + e) * 1024 + 4 * lane;
#pragma unroll
        for (int j = 0; j < 4; ++j) v[q][j] = *(const f32x4*)(src + 256 * j); } }
}
template <int NR> __device__ __forceinline__ void conv_finish(unsigned char* PU, unsigned char* PV, float* PS, int l, int row0, int NGW, int lane, f32x4 (&v)[NR][4], LAS unsigned char* scr) {
#pragma unroll
    for (int q = 0; q < NR; ++q) { const int r = row0 + q * NGW; if (r < 2 * NEXP) { const int tb = r >= NEXP ? 1 : 0, e = r - tb * NEXP;
        if (tb) {
            float am = 0.f;
#pragma unroll
            for (int j = 0; j < 4; ++j) am = fmaxf(am, fmaxf(fmaxf(fabsf(v[q][j].x), fabsf(v[q][j].y)), fmaxf(fabsf(v[q][j].z), fabsf(v[q][j].w))));
            am = wave_max(am);
            const float sc = am > 0.f ? am * (1.f / 224.f) : 1.f, inv = 1.f / sc;
#pragma unroll
            for (int j = 0; j < 4; ++j) { int w = 0; w = __builtin_amdgcn_cvt_pk_fp8_f32(v[q][j].x * inv, v[q][j].y * inv, w, false); w = __builtin_amdgcn_cvt_pk_fp8_f32(v[q][j].z * inv, v[q][j].w * inv, w, true);
                const int c = 32 * j + (lane >> 1);
                *(int*)(PV + ((size_t)(l * 128 + c) * NEXP + e) * 8 + 4 * (lane & 1)) = w; }
            if (lane == 0) PS[4 * NEXP + l * NEXP + e] = sc;
        } else {
#pragma unroll
            for (int j = 0; j < 4; ++j) {
                float am = fmaxf(fmaxf(fabsf(v[q][j].x), fabsf(v[q][j].y)), fmaxf(fabsf(v[q][j].z), fabsf(v[q][j].w)));
                am = fmaxf(am, __shfl_xor(am, 1)); am = fmaxf(am, __shfl_xor(am, 2)); am = fmaxf(am, __shfl_xor(am, 4));
                int ex = 0; if (am > 0.f) { (void)frexpf(am * (1.f / 6.f), &ex); }
                ex = ex < -126 ? -126 : (ex > 126 ? 126 : ex);
                const float inv = __builtin_bit_cast(float, (unsigned)(127 - ex) << 23);
                unsigned w16 = 0u;
#pragma unroll
                for (int c = 0; c < 4; ++c) { const float y = v[q][j][c] * inv, a_ = fabsf(y);
                    float cf = a_ < 2.f ? rintf(a_ * 2.f) : (a_ < 4.f ? 4.f + rintf(a_ - 2.f) : 6.f + rintf((a_ - 4.f) * 0.5f));
                    cf = fminf(cf, 7.f);
                    const unsigned s4 = (unsigned)(int)cf | (y < 0.f ? 8u : 0u);
                    w16 |= s4 << (4 * c); }
                const int qb = 8 * j + (lane >> 3), kc_ = qb & 3, m_ = qb >> 2;
#pragma unroll
                for (int t = 0; t < 2; ++t) { const int L = 16 * m_ + 2 * (lane & 7) + t;
                    scr[64 * (L >> 4) + 16 * kc_ + (L & 15)] = (unsigned char)((w16 >> (8 * t)) & 0xFFu); }
                if ((lane & 7) == 0) scr[512 + kc_ * 8 + m_] = (unsigned char)(ex + 127);
            }
            LDS_WAIT(); asm volatile("" ::: "memory");
            if (lane < 32) *(v4u*)(PU + ((size_t)l * NEXP + e) * 512 + 16 * lane) = *(const LAS v4u*)(scr + 16 * lane);
            else if (lane < 34) *(v4u*)(PU + (size_t)48 * MiB + ((size_t)l * NEXP + e) * 32 + 16 * (lane - 32)) = *(const LAS v4u*)(scr + 512 + 16 * (lane - 32));
            LDS_WAIT(); asm volatile("" ::: "memory");
        } } }
}

__device__ __forceinline__ void transpose_item(const float* W, int ldw, bf16* WT, int row_off, LAS float* scr, int item, int nblk, int lane) {
    const int kb = item / nblk, nb = item % nblk, k0 = 64 * kb, n0 = 32 * nb;
#pragma unroll 8
    for (int i = 0; i < 32; ++i) { const int kk = 2 * i + (lane >> 5); scr[kk * 33 + (lane & 31)] = W[(size_t)(k0 + kk) * ldw + n0 + (lane & 31)]; }
    LDS_WAIT(); asm volatile("" ::: "memory");
    const int c = lane & 7;
#pragma unroll
    for (int j = 0; j < 4; ++j) { const int n = (lane >> 3) + 8 * j; const LAS float* s = scr + (8 * c) * 33 + n;
        v4u o; o.x = pk2(s[0 * 33], s[1 * 33]); o.y = pk2(s[2 * 33], s[3 * 33]); o.z = pk2(s[4 * 33], s[5 * 33]); o.w = pk2(s[6 * 33], s[7 * 33]);
        *(v4u*)(WT + (size_t)(row_off + n0 + n) * 1024 + k0 + 8 * c) = o; }
    LDS_WAIT(); asm volatile("" ::: "memory");
}

__device__ __forceinline__ void phase_prologue(Frame& F) {
    KARGS;
    LAS float* cact = (LAS float*)F.lds;
    LAS float* part = cact + 2048;
    {   const float* c = IN(1);
        for (int i = F.tid; i < 2048; i += NTHR) { const float v = c[i]; cact[i] = v / (1.f + expf(-v)); } }
    __syncthreads();
    {
        const float* ada_w = IN(2); const float* ada_b = IN(3); float* MOD = WSP(float, WS_MOD);
        for (int it = F.bid; it < 384; it += F.G) {
            const int l = it / 96, j0 = (it % 96) * 64;
            const float* wp = ada_w + ((size_t)l * 1024 + F.wave * 128) * 6144 + j0 + F.lane;
            float a0 = 0.f, a1 = 0.f;
#pragma unroll 8
            for (int k = 0; k < 128; ++k) { const float w = wp[(size_t)k * 6144]; a0 += cact[F.wave * 128 + k] * w; a1 += cact[1024 + F.wave * 128 + k] * w; }
            part[(F.wave * 2 + 0) * 64 + F.lane] = a0; part[(F.wave * 2 + 1) * 64 + F.lane] = a1;
            __syncthreads();
            if (F.tid < 128) { const int b = F.tid >> 6, col = F.tid & 63; float s = 0.f;
#pragma unroll
                for (int w = 0; w < 8; ++w) s += part[(w * 2 + b) * 64 + col];
                MOD[(l * 2 + b) * 6144 + j0 + col] = s + ada_b[l * 6144 + j0 + col]; }
            __syncthreads();
        }
    }
    {
        LAS float* scr = (LAS float*)(F.lds + 16384 + F.wave * 8448);
        const int gw = F.bid * NWAVES + F.wave, NGW = F.G * NWAVES;
        constexpr int I_A = 16 * 64, I_B = 16 * 64, I_C = 16 * 56, I_D = 16 * 32, I_E = 16 * 64;
        constexpr int NITEMS = 2 * I_A + 2 * I_B + 2 * I_C + 4 * I_D + 4 * I_E;
        for (int it = gw; it < NITEMS; it += NGW) {
            int r = it;
            if (r < 2 * I_A) { const int j = r / I_A; transpose_item(IN(6) + (size_t)j * 1024 * 2048, 2048, WSP(bf16, WS_WIN + (size_t)(2 * j) * 8 * MiB), 0, scr, r % I_A, 64, F.lane); continue; } r -= 2 * I_A;
            if (r < 2 * I_B) { const int j = r / I_B; transpose_item(IN(10) + (size_t)j * 1024 * ODD_LD, ODD_LD, WSP(bf16, WS_WIN + (size_t)(2 * j + 1) * 8 * MiB), 0, scr, r % I_B, 64, F.lane); continue; } r -= 2 * I_B;
            if (r < 2 * I_C) { const int j = r / I_C; transpose_item(IN(10) + (size_t)j * 1024 * ODD_LD + 2056, ODD_LD, WSP(bf16, WS_WIN + (size_t)(2 * j + 1) * 8 * MiB), 2048, scr, r % I_C, 56, F.lane); continue; } r -= 2 * I_C;
            if (r < 4 * I_D) { const int l = r / I_D; const int j = l >> 1; const float* src = (l & 1) ? IN(11) : IN(7);
                if ((l & 1) || (r % I_D) < 8 * 32) transpose_item(src + (size_t)j * 1024 * 1024, 1024, WSP(bf16, WS_WOUT + (size_t)l * 2 * MiB), 0, scr, r % I_D, 32, F.lane); continue; } r -= 4 * I_D;
            { const int l = r / I_E; transpose_item(IN(26) + (size_t)l * 1024 * 2048, 2048, WSP(bf16, WS_WQ + (size_t)l * 4 * MiB), 0, scr, r % I_E, 64, F.lane); }
        }
    }
    {
        const int gt = F.bid * NTHR + F.tid, NGT = F.G * NTHR;
        float* WF = WSP(float, WS_WF);
        for (int i = gt; i < 2 * 8 * 1024; i += NGT) { const int j = i >> 13, h = (i >> 10) & 7, k = i & 1023; WF[i] = IN(10)[((size_t)j * 1024 + k) * ODD_LD + 2048 + h]; }
        bf16* KEYS = WSP(bf16, WS_KEYS);
        for (int i = gt; i < 4 * 16384; i += NGT) { const int l = i >> 14, r = i & 16383;
            KEYS[(size_t)(l * 2 + 0) * 16384 + r] = (bf16)f2bf(IN(27)[i]); KEYS[(size_t)(l * 2 + 1) * 16384 + r] = (bf16)f2bf(IN(28)[i]); }
        for (int i = gt; i < 2 * 512 * 256; i += NGT) { const int j = i >> 17, ch = (i >> 8) & 511, k = i & 255; bf16* dst = WSP(bf16, WS_LORA) + (size_t)j * 131072;
            if (k < 64) dst[ch * 64 + k] = (bf16)f2bf(IN(17)[((size_t)j * 64 + k) * 512 + ch]);
            else if (k < 128) dst[32768 + ch * 64 + (k - 64)] = (bf16)f2bf(IN(19)[((size_t)j * 64 + (k - 64)) * 512 + ch]);
            else dst[65536 + ch * 128 + (k - 128)] = (bf16)f2bf(IN(20)[((size_t)j * 128 + (k - 128)) * 512 + ch]); }
        {   LAS float* pwl = (LAS float*)(F.lds + 98304);
            for (int it = (F.bid + F.G - 128 % F.G) % F.G; it < 128; it += F.G) { const int j = it >> 6, g = (it >> 4) & 3, cq = (it >> 1) & 7, nh = it & 1;
                __syncthreads();
                for (int i = F.tid; i < 2048; i += NTHR) { const int d = i >> 4, cc = i & 15; pwl[i] = IN(8)[((size_t)(j * 4 + g) * 128 + cq * 16 + cc) * 128 + d] * IN(9)[j * 512 + g * 128 + d]; }
                __syncthreads();
                const int n = nh * 512 + F.tid; const float* wo = IN(7) + ((size_t)j * 1024 + 512 + g * 128) * 1024 + n;
                float acc[16];
#pragma unroll
                for (int cc = 0; cc < 16; ++cc) acc[cc] = 0.f;
#pragma unroll 8
                for (int d = 0; d < 128; ++d) { const float wv = wo[(size_t)d * 1024];
#pragma unroll
                    for (int q4 = 0; q4 < 4; ++q4) { const f32x4 p4 = *(const LAS f32x4*)(pwl + d * 16 + 4 * q4); acc[4 * q4] += p4.x * wv; acc[4 * q4 + 1] += p4.y * wv; acc[4 * q4 + 2] += p4.z * wv; acc[4 * q4 + 3] += p4.w * wv; } }
                v4u o0, o1; o0.x = pk2(acc[0], acc[1]); o0.y = pk2(acc[2], acc[3]); o0.z = pk2(acc[4], acc[5]); o0.w = pk2(acc[6], acc[7]);
                o1.x = pk2(acc[8], acc[9]); o1.y = pk2(acc[10], acc[11]); o1.z = pk2(acc[12], acc[13]); o1.w = pk2(acc[14], acc[15]);
                bf16* dst = WSP(bf16, WS_WOUT + (size_t)(2 * j) * 2 * MiB) + (size_t)n * 1024 + 512 + g * 128 + cq * 16;
                *(v4u*)dst = o0; *(v4u*)(dst + 8) = o1; }
            __syncthreads(); }
        {
            const int gw = F.bid * NWAVES + F.wave, NGW = F.G * NWAVES, lane = F.lane;
            for (int row0 = gw; row0 < 2 * NEXP; row0 += 4 * NGW) {
                f32x4 v[4][4];
                conv_issue<4>(IN(29), IN(30), 0, row0, NGW, lane, v);
                conv_finish<4>(WSP(unsigned char, WS_PU), WSP(unsigned char, WS_PV), WSP(float, WS_PS), 0, row0, NGW, lane, v, F.lds + 135168 + F.wave * 1024);
            }
        }
    }
}

__device__ __forceinline__ void phase_norm(Frame& F, int layer, int which) {
    KARGS;
    const float* X = (layer == 0 && which == 0) ? IN(0) : OUTP;
    const float* gain = (which ? IN(5) : IN(4)) + layer * 1024;
    const float* mod = WSP(float, WS_MOD) + (size_t)layer * 2 * 6144 + (which ? 3072 : 0);
    bf16* H = WSP(bf16, WS_H);
    const bool do_f = (layer & 1) && which == 0;
    const int jj = layer >> 1;
    const float* WF = WSP(float, WS_WF) + (size_t)jj * 8 * 1024;
    float* LOGF = WSP(float, WS_LOGF);
    const int gw = F.bid * NWAVES + F.wave, NGW = F.G * NWAVES, lane = F.lane;
    f32x4 gn[4];
#pragma unroll
    for (int j = 0; j < 4; ++j) gn[j] = *(const f32x4*)(gain + 256 * j + 4 * lane);
    for (int row = gw; row < T; row += NGW) {
        const int b = row >= SEQ ? 1 : 0;
        const float* sh = mod + b * 6144; const float* sc = sh + 1024;
        const float* xr = X + (size_t)row * D + 4 * lane;
        f32x4 v[4]; float ss = 0.f;
#pragma unroll
        for (int j = 0; j < 4; ++j) { v[j] = *(const f32x4*)(xr + 256 * j); ss += (v[j].x * v[j].x + v[j].y * v[j].y) + (v[j].z * v[j].z + v[j].w * v[j].w); }
        const float rstd = rsqrtf(wave_sum(ss) * (1.f / D) + NORM_EPS);
        bf16* hr = H + (size_t)row * D + 4 * lane;
#pragma unroll
        for (int j = 0; j < 4; ++j) { const f32x4 s4 = *(const f32x4*)(sc + 256 * j + 4 * lane), h4 = *(const f32x4*)(sh + 256 * j + 4 * lane);
            v[j] = v[j] * rstd * gn[j] * (s4 + 1.f) + h4;
            v2u o; o.x = pk2(v[j].x, v[j].y); o.y = pk2(v[j].z, v[j].w); *(v2u*)(hr + 256 * j) = o; }
        if (which == 1) {
            float am = 0.f;
#pragma unroll
            for (int j = 0; j < 4; ++j) am = fmaxf(am, fmaxf(fmaxf(fabsf(v[j].x), fabsf(v[j].y)), fmaxf(fabsf(v[j].z), fabsf(v[j].w))));
            am = wave_max(am); const float s8 = am > 0.f ? am * (1.f / 224.f) : 1.f, i8 = 1.f / s8;
            unsigned char* h8 = WSP(unsigned char, WS_H8) + (size_t)row * D + 4 * lane;
#pragma unroll
            for (int j = 0; j < 4; ++j) { int w8 = 0; w8 = __builtin_amdgcn_cvt_pk_fp8_f32(v[j].x * i8, v[j].y * i8, w8, false); w8 = __builtin_amdgcn_cvt_pk_fp8_f32(v[j].z * i8, v[j].w * i8, w8, true); *(int*)(h8 + 256 * j) = w8; }
            if (lane == 0) WSP(float, WS_HS)[row] = s8;
        }
        if (do_f) {
            const float* fb = IN(14) + jj * 8;
            const int t = row - b * SEQ;
#pragma unroll
            for (int hh = 0; hh < 8; ++hh) { float d = 0.f;
#pragma unroll
                for (int j = 0; j < 4; ++j) { const f32x4 w4 = *(const f32x4*)(WF + hh * 1024 + 256 * j + 4 * lane); d += (v[j].x * w4.x + v[j].y * w4.y) + (v[j].z * w4.z + v[j].w * w4.w); }
                d = wave_sum(d) + fb[hh];
                const float lf = fminf(d, 0.f) - log1pf(expf(-fabsf(d)));
                if (lane == 0) LOGF[(size_t)(b * 8 + hh) * SEQ + t] = lf; }
        }
    }
}

__device__ __forceinline__ void load_q64(float (&q)[64], const bf16* p, float scale) {
#pragma unroll
    for (int c = 0; c < 8; ++c) { const v4u w = *(const v4u*)(p + 8 * c);
        q[8 * c + 0] = bflo(w.x) * scale; q[8 * c + 1] = bfhi(w.x) * scale; q[8 * c + 2] = bflo(w.y) * scale; q[8 * c + 3] = bfhi(w.y) * scale;
        q[8 * c + 4] = bflo(w.z) * scale; q[8 * c + 5] = bfhi(w.z) * scale; q[8 * c + 6] = bflo(w.w) * scale; q[8 * c + 7] = bfhi(w.w) * scale; }
}
__device__ __forceinline__ float dot_q64(const float (&q)[64], const bf16* p) {
    float z0 = 0.f, z1 = 0.f;
#pragma unroll
    for (int c = 0; c < 8; ++c) { const v4u w = *(const v4u*)(p + 8 * c);
        z0 += q[8 * c + 0] * bflo(w.x) + q[8 * c + 2] * bflo(w.y) + q[8 * c + 4] * bflo(w.z) + q[8 * c + 6] * bflo(w.w);
        z1 += q[8 * c + 1] * bfhi(w.x) + q[8 * c + 3] * bfhi(w.y) + q[8 * c + 5] * bfhi(w.z) + q[8 * c + 7] * bfhi(w.w); }
    return z0 + z1;
}
#ifdef MK_SIMPLE_EVEN
__device__ __forceinline__ void phase_even_mixer_simple(Frame& F, int layer) {
    KARGS;
    const bf16* P = WSP(bf16, WS_PROJ); bf16* MIX = WSP(bf16, WS_MIX);
    const int lane = F.lane;
    {
        const int gw = F.bid * NWAVES + F.wave, NGW = F.G * NWAVES;
        for (int it = gw; it < BATCH * 8 * SEQ; it += NGW) {
            const int b = it >> 16, h = (it >> 13) & 7, t = it & 8191;
            const bf16* base = P + (size_t)b * SEQ * EVEN_IN;
            float q[64]; load_q64(q, base + (size_t)t * EVEN_IN + h * 64, 0.125f);
            float acc = 0.f, carry = 0.f;
            for (int s0 = t - 1; s0 >= 0; s0 -= 64) {
                const int s = s0 - lane; const bool valid = s >= 0; const int sc = valid ? s : 0;
                const float z = dot_q64(q, base + (size_t)sc * EVEN_IN + 512 + h * 64);
                const float sp = softplusf_(z);
                const float l1m = valid ? -sp : 0.f;
                const float lb = z - sp;
                float inc = l1m;
#pragma unroll
                for (int o = 1; o < 64; o <<= 1) { const float n = __shfl_up(inc, o); if (lane >= o) inc += n; }
                const float w = valid ? expf(lb + carry + (inc - l1m)) : 0.f;
                const float tot = __shfl(inc, 63);
#pragma unroll 16
                for (int j = 0; j < 64; ++j) { const float wj = rl(w, j); int sj = s0 - j; sj = sj < 0 ? 0 : sj;
                    acc += wj * bf2f(base[(size_t)sj * EVEN_IN + 1024 + h * 64 + lane]); }
                carry += tot;
                if (carry < -104.f) break;
            }
            MIX[((size_t)b * SEQ + t) * D + h * 64 + lane] = (bf16)f2bf(acc);
        }
    }
    {
        LAS float* pl = (LAS float*)F.lds;
        const int jj = layer >> 1;
        const float* pw = IN(8) + (size_t)jj * 4 * 128 * 128; const float* ps = IN(9) + jj * 512;
        const int c = F.tid, g = c >> 7, w = 2 << g, d = c & 127;
        for (int tile = F.bid; tile < T / 32; tile += F.G) {
            const int t0 = tile * 32, b = t0 / SEQ, tl0 = t0 % SEQ;
            const bf16* base = P + (size_t)b * SEQ * EVEN_IN + 1536 + c;
            for (int tt = 0; tt < 32; ++tt) { const int tl = tl0 + tt, cend = (tl / 64 + 1) * 64;
                int lo = tl - w / 2; lo = lo < 0 ? 0 : lo; int hi = tl + w / 2; hi = hi > cend ? cend : hi;
                float s = 0.f; for (int u = lo; u < hi; ++u) s += bf2f(base[(size_t)u * EVEN_IN]);
                pl[c * 33 + tt] = s / (float)(hi - lo) - bf2f(base[(size_t)tl * EVEN_IN]); }
            __syncthreads();
            float acc[32];
#pragma unroll
            for (int tt = 0; tt < 32; ++tt) acc[tt] = 0.f;
            for (int cc = 0; cc < 128; ++cc) { const float wv = pw[((size_t)g * 128 + cc) * 128 + d]; const LAS float* pr = pl + (g * 128 + cc) * 33;
#pragma unroll
                for (int tt = 0; tt < 32; ++tt) acc[tt] += pr[tt] * wv; }
            const float sc = ps[c];
#pragma unroll
            for (int tt = 0; tt < 32; ++tt) MIX[(size_t)(t0 + tt) * D + 512 + c] = (bf16)f2bf(acc[tt] * sc);
            __syncthreads();
        }
    }
}

#endif
typedef float f32x16 __attribute__((ext_vector_type(16)));
typedef short s16x4 __attribute__((ext_vector_type(4)));
#define MAX3F(a, b, c) __builtin_fmaxf(__builtin_fmaxf((a), (b)), (c))
#define ZERO16(a) do { _Pragma("unroll") for (int r_ = 0; r_ < 16; ++r_) a[r_] = 0.f; } while (0)
constexpr int FX_KROW = 144, FX_VROW = 192;
constexpr int FX_KB = 64 * FX_KROW, FX_VB = 64 * FX_VROW, FX_BUF = FX_KB + FX_VB + 256;
template <int HW> __device__ __forceinline__ void pool_chunk(const bf16* src, bf16* dst, int tl0) {
    float ps[HW + 65 + HW]; ps[0] = 0.f;
#pragma unroll
    for (int i = 0; i < 64 + HW; ++i) { const int tl = tl0 - HW + i; const float x = tl >= 0 ? bf2f(src[(long)(i - HW) * EVEN_IN]) : 0.f; ps[i + 1] = ps[i] + x; }
#pragma unroll
    for (int tt = 0; tt < 64; ++tt) { const int tl = tl0 + tt; int lo = tl - HW; lo = lo < 0 ? 0 : lo; const int hie = tt + HW > 64 ? 64 : tt + HW;
        const float sum = ps[hie + HW] - ps[tt]; const float x = ps[tt + HW + 1] - ps[tt + HW];
        dst[(size_t)tt * D] = (bf16)f2bf(sum / (float)(tl0 + hie - lo) - x); }
}
__device__ __forceinline__ void phase_even_mixer(Frame& F, int layer) {
    KARGS;
    const bf16* P = WSP(bf16, WS_PROJ); bf16* MIX = WSP(bf16, WS_MIX);
    const int tid = F.tid, lane = F.lane, wave = F.wave, r32 = lane & 31, hh = lane >> 5;
    const float LOG2E = 1.4426950408889634f, CS = 0.125f * LOG2E;
    const int srow = tid >> 3, sch = tid & 7;
    {
        const int c = tid, g = c >> 7;
        for (int ck = F.bid; ck < T / 64; ck += F.G) {
            const int t0 = ck * 64, tl0 = t0 % SEQ;
            const bf16* src = P + (size_t)t0 * EVEN_IN + 1536 + c; bf16* dst = MIX + (size_t)t0 * D + 512 + c;
            if (g == 0) pool_chunk<1>(src, dst, tl0); else if (g == 1) pool_chunk<2>(src, dst, tl0); else if (g == 2) pool_chunk<4>(src, dst, tl0); else pool_chunk<8>(src, dst, tl0);
        }
    }
    __syncthreads();
    for (int u = F.bid; u < 256; u += F.G) {
        for (int ui = 0; ui < 2; ++ui) {
            const int bh = u >> 4, ss = u & 15, qb = ui == 0 ? ss : 31 - ss, b = bh >> 3, h = bh & 7;
            const bf16* base = P + (size_t)b * SEQ * EVEN_IN;
            const int q0 = 256 * qb + 32 * wave, myq = q0 + r32;
            bf16x8 qf[4];
#pragma unroll
            for (int d0 = 0; d0 < 4; ++d0) qf[d0] = *(const bf16x8*)(base + (size_t)myq * EVEN_IN + h * 64 + 16 * d0 + 8 * hh);
            float carry = 0.f;
            f32x16 o[2];
#pragma unroll
            for (int r = 0; r < 16; ++r) { o[0][r] = 0.f; o[1][r] = 0.f; }
            const int jtop = 4 * qb + 3;
            v4u kreg = *(const v4u*)(base + (size_t)(64 * jtop + srow) * EVEN_IN + 512 + h * 64 + sch * 8);
            v4u vreg = *(const v4u*)(base + (size_t)(64 * jtop + srow) * EVEN_IN + 1024 + h * 64 + sch * 8);
            __syncthreads();
            *(LAS v4u*)(F.lds + srow * FX_KROW + sch * 16) = kreg; *(LAS v4u*)(F.lds + FX_KB + srow * FX_VROW + sch * 16) = vreg;
            if (tid < 16) ((LAS unsigned*)(F.lds + 2 * FX_BUF))[tid] = 0u;
            __syncthreads();
            int it = 0;
            for (int j = jtop; j >= 0; --j, ++it) {
                const int cur = (it & 1) * FX_BUF, nxt = ((it + 1) & 1) * FX_BUF;
                if (j > 0) { const size_t krow = (size_t)(64 * (j - 1) + srow) * EVEN_IN;
                    kreg = *(const v4u*)(base + krow + 512 + h * 64 + sch * 8); vreg = *(const v4u*)(base + krow + 1024 + h * 64 + sch * 8); }
                const bool started = 64 * j <= q0 + 30;
                const bool wprev = __all(carry < -150.f);
                if (started && !wprev) {
                    const LAS unsigned char* Kb = F.lds + cur; const LAS unsigned char* Vb = F.lds + cur + FX_KB;
                    f32x16 p0, p1;
#pragma unroll
                    for (int r = 0; r < 16; ++r) { p0[r] = 0.f; p1[r] = 0.f; }
#pragma unroll
                    for (int d0 = 0; d0 < 4; ++d0) {
                        const bf16x8 a0 = *(const LAS bf16x8*)(Kb + r32 * FX_KROW + 32 * d0 + 16 * hh);
                        const bf16x8 a1 = *(const LAS bf16x8*)(Kb + (r32 + 32) * FX_KROW + 32 * d0 + 16 * hh);
                        p0 = __builtin_amdgcn_mfma_f32_32x32x16_bf16(a0, qf[d0], p0, 0, 0, 0);
                        p1 = __builtin_amdgcn_mfma_f32_32x32x16_bf16(a1, qf[d0], p1, 0, 0, 0);
                    }
                    f32x16 l0, l1v;
#pragma unroll
                    for (int r = 0; r < 16; ++r) {
                        const int key = 64 * j + (r & 3) + 8 * (r >> 2) + 4 * hh;
                        const float za = p0[r] * CS, zb = p1[r] * CS;
                        const float sa = fmaxf(za, 0.f) + __builtin_amdgcn_logf(1.f + __builtin_amdgcn_exp2f(-fabsf(za)));
                        const float sb = fmaxf(zb, 0.f) + __builtin_amdgcn_logf(1.f + __builtin_amdgcn_exp2f(-fabsf(zb)));
                        l0[r] = -sa; l1v[r] = -sb; p0[r] = za - sa; p1[r] = zb - sb; (void)key;
                    }
                    if (64 * j + 63 >= q0) {
                        asm volatile("" ::: "memory");
#pragma unroll
                        for (int r = 0; r < 16; ++r) { const int key = 64 * j + (r & 3) + 8 * (r >> 2) + 4 * hh;
                            if (!(key < myq)) { l0[r] = 0.f; p0[r] = -INFINITY; } if (!(key + 32 < myq)) { l1v[r] = 0.f; p1[r] = -INFINITY; } }
                    }
                    float tot[8], oth[8];
#pragma unroll
                    for (int g = 0; g < 4; ++g) { tot[g] = (l0[4 * g] + l0[4 * g + 1]) + (l0[4 * g + 2] + l0[4 * g + 3]); tot[4 + g] = (l1v[4 * g] + l1v[4 * g + 1]) + (l1v[4 * g + 2] + l1v[4 * g + 3]); }
#pragma unroll
                    for (int g = 0; g < 8; ++g) oth[g] = __shfl_xor(tot[g], 32);
                    float sfx[8]; float run = 0.f;
#pragma unroll
                    for (int x = 7; x >= 0; --x) { sfx[x] = run; run += tot[x] + oth[x]; }
#pragma unroll
                    for (int x = 0; x < 8; ++x) {
                        const float goff = carry + sfx[x] + (hh == 0 ? oth[x] : 0.f);
                        if (x < 4) { const float s3 = goff, s2 = s3 + l0[4 * x + 3], s1 = s2 + l0[4 * x + 2], s0 = s1 + l0[4 * x + 1];
                            p0[4 * x] = __builtin_amdgcn_exp2f(p0[4 * x] + s0); p0[4 * x + 1] = __builtin_amdgcn_exp2f(p0[4 * x + 1] + s1); p0[4 * x + 2] = __builtin_amdgcn_exp2f(p0[4 * x + 2] + s2); p0[4 * x + 3] = __builtin_amdgcn_exp2f(p0[4 * x + 3] + s3); }
                        else { const int y = x - 4; const float s3 = goff, s2 = s3 + l1v[4 * y + 3], s1 = s2 + l1v[4 * y + 2], s0 = s1 + l1v[4 * y + 1];
                            p1[4 * y] = __builtin_amdgcn_exp2f(p1[4 * y] + s0); p1[4 * y + 1] = __builtin_amdgcn_exp2f(p1[4 * y + 1] + s1); p1[4 * y + 2] = __builtin_amdgcn_exp2f(p1[4 * y + 2] + s2); p1[4 * y + 3] = __builtin_amdgcn_exp2f(p1[4 * y + 3] + s3); }
                    }
                    carry += run;
                    bf16x8 pf[4];
#pragma unroll
                    for (int s4 = 0; s4 < 4; ++s4) {
                        v4u w;
                        if (s4 < 2) { w.x = pk2(p0[8 * s4 + 0], p0[8 * s4 + 1]); w.y = pk2(p0[8 * s4 + 2], p0[8 * s4 + 3]); w.z = pk2(p0[8 * s4 + 4], p0[8 * s4 + 5]); w.w = pk2(p0[8 * s4 + 6], p0[8 * s4 + 7]); }
                        else { const int sp = s4 - 2; w.x = pk2(p1[8 * sp + 0], p1[8 * sp + 1]); w.y = pk2(p1[8 * sp + 2], p1[8 * sp + 3]); w.z = pk2(p1[8 * sp + 4], p1[8 * sp + 5]); w.w = pk2(p1[8 * sp + 6], p1[8 * sp + 7]); }
                        pf[s4] = __builtin_bit_cast(bf16x8, w);
                    }
                    const int gi = lane >> 4, li = lane & 15;
                    const LAS unsigned char* vbase = Vb + (4 * (gi >> 1) + (li >> 2)) * FX_VROW + (16 * (gi & 1) + 4 * (li & 3)) * 2;
#pragma unroll
                    for (int d0 = 0; d0 < 2; ++d0)
#pragma unroll
                        for (int s4 = 0; s4 < 4; ++s4) {
                            const s16x4 lo = __builtin_bit_cast(s16x4, __builtin_amdgcn_ds_read_tr16_b64_v4i16((LAS s16x4*)(vbase + (16 * s4) * FX_VROW + 64 * d0)));
                            const s16x4 hi = __builtin_bit_cast(s16x4, __builtin_amdgcn_ds_read_tr16_b64_v4i16((LAS s16x4*)(vbase + (16 * s4 + 8) * FX_VROW + 64 * d0)));
                            const bf16x8 vf = (bf16x8){lo[0], lo[1], lo[2], lo[3], hi[0], hi[1], hi[2], hi[3]};
                            o[d0] = __builtin_amdgcn_mfma_f32_32x32x16_bf16(vf, pf[s4], o[d0], 0, 0, 0);
                        }
                }
                const bool wdone = started && __all(carry < -150.f);
                if (lane == 0) ((LAS unsigned*)(F.lds + 2 * FX_BUF))[(it & 1) * 8 + wave] = wdone ? 1u : 0u;
                if (j > 0) { *(LAS v4u*)(F.lds + nxt + srow * FX_KROW + sch * 16) = kreg; *(LAS v4u*)(F.lds + nxt + FX_KB + srow * FX_VROW + sch * 16) = vreg; }
                LBAR();
                const LAS unsigned* fl = (const LAS unsigned*)(F.lds + 2 * FX_BUF) + (it & 1) * 8;
                const unsigned alld = fl[0] & fl[1] & fl[2] & fl[3] & fl[4] & fl[5] & fl[6] & fl[7];
                if (alld) break;
            }
            bf16* op = MIX + ((size_t)b * SEQ + myq) * D + h * 64;
#pragma unroll
            for (int d0 = 0; d0 < 2; ++d0)
#pragma unroll
                for (int g = 0; g < 4; ++g) { const int db = 32 * d0 + 8 * g + 4 * hh;
                    v2u ow; ow.x = pk2(o[d0][4 * g + 0], o[d0][4 * g + 1]); ow.y = pk2(o[d0][4 * g + 2], o[d0][4 * g + 3]); *(v2u*)(op + db) = ow; }
        }
    }
}

__device__ __forceinline__ void phase_odd_prep(Frame& F, int layer, int parts) {
    KARGS;
    const int jj = layer >> 1, lane = F.lane, tid = F.tid, w = F.wave, r32 = lane & 31, hh = lane >> 5;
    bf16* P = WSP(bf16, WS_PROJ);
    if (F.bid < 16 && (parts & 4)) {
        const float* lf = WSP(float, WS_LOGF) + (size_t)F.bid * SEQ + 1024 * w; float* dc = WSP(float, WS_DCUM) + (size_t)F.bid * SEQ + 1024 * w;
        float inc[16];
#pragma unroll
        for (int i = 0; i < 16; ++i) inc[i] = lf[64 * i + lane];
        double offs[16]; double carry = 0.0;
#pragma unroll
        for (int i = 0; i < 16; ++i) {
#pragma unroll
            for (int o = 1; o < 64; o <<= 1) { const float n = __shfl_up(inc[i], o); if (lane >= o) inc[i] += n; }
            offs[i] = carry; carry += (double)__shfl(inc[i], 63); }
        LAS double* wt = (LAS double*)F.lds;
        if (lane == 0) wt[w] = carry;
        __syncthreads();
        double base = 0.0;
#pragma unroll
        for (int ww = 0; ww < 8; ++ww) if (ww < w) base += wt[ww];
#pragma unroll
        for (int i = 0; i < 16; ++i) dc[64 * i + lane] = (float)(base + offs[i] + (double)inc[i]);
        __syncthreads();
    }
    constexpr int LXP = 528;
    LAS unsigned char* lx = F.lds;
    const float* mix = IN(15) + jj * 1792;
    const float* w0 = IN(16) + jj * 512; const float* a0 = IN(18) + jj * 512;
    const float* kkp = IN(21) + jj * 512; const float* kap = IN(22) + jj * 512;
    const float* qn = IN(12) + jj * 64; const float* kn = IN(13) + jj * 64;
    const bf16* LT = WSP(bf16, WS_LORA) + (size_t)jj * 131072;
    float* R = WSP(float, WS_RW); float* LWp = WSP(float, WS_RW + RW_SLOT); float* K = WSP(float, WS_RW + 2 * RW_SLOT); float* V = WSP(float, WS_RW + 3 * RW_SLOT);
    float* KK = WSP(float, WS_RW + 4 * RW_SLOT); float* A = WSP(float, WS_RW + 5 * RW_SLOT); float* Gt = WSP(float, WS_RW + 6 * RW_SLOT);
    for (int item = F.bid; item < T / 64; item += F.G) {
        const int t0 = item * 64;
        if (parts & 1) {
        for (int i = tid; i < 64 * 32; i += NTHR) { const int tt = i >> 5, j8 = 8 * (i & 31), tg = t0 + tt, tl = tg % SEQ, col = 1536 + j8;
            const v4u cw = *(const v4u*)(P + (size_t)tg * ODD_N + 2048 + col); v4u pw = (v4u){0u, 0u, 0u, 0u}; if (tl > 0) pw = *(const v4u*)(P + (size_t)(tg - 1) * ODD_N + 2048 + col);
            const f32x4 m0 = *(const f32x4*)(mix + col), m1 = *(const f32x4*)(mix + col + 4);
            v4u ow;
#pragma unroll
            for (int q = 0; q < 4; ++q) { const float c0 = bflo(cw[q]), c1 = bfhi(cw[q]), p0 = bflo(pw[q]), p1 = bfhi(pw[q]);
                const float mm0 = q < 2 ? m0[2 * q] : m1[2 * q - 4], mm1 = q < 2 ? m0[2 * q + 1] : m1[2 * q - 3];
                const float x0 = c0 + (p0 - c0) * mm0, x1 = c1 + (p1 - c1) * mm1;
                ow[q] = j8 < 64 ? pk2(tanhf(x0), tanhf(x1)) : (j8 < 128 ? pk2(x0, x1) : pk2(sigmoidf_(x0), sigmoidf_(x1))); }
            *(LAS v4u*)(lx + tt * LXP + j8 * 2) = ow; }
        __syncthreads();
#pragma unroll 1
        for (int L = 0; L < 3; ++L) {
            const int koff = L == 0 ? 0 : (L == 1 ? 64 : 128), ksteps = L == 2 ? 8 : 4, kdim = L == 2 ? 128 : 64;
            const bf16* Wt = LT + (L == 0 ? 0 : (L == 1 ? 32768 : 65536));
            float* dst = L == 0 ? LWp : (L == 1 ? A : Gt);
            f32x16 acc[2][2];
#pragma unroll
            for (int a_ = 0; a_ < 2; ++a_)
#pragma unroll
                for (int b_ = 0; b_ < 2; ++b_) ZERO16(acc[a_][b_]);
#pragma unroll 1
            for (int s4 = 0; s4 < ksteps; ++s4) {
                bf16x8 af[2], bfr[2];
#pragma unroll
                for (int tm = 0; tm < 2; ++tm) af[tm] = *(const LAS bf16x8*)(lx + (32 * tm + r32) * LXP + (koff + 16 * s4 + 8 * hh) * 2);
#pragma unroll
                for (int tn = 0; tn < 2; ++tn) bfr[tn] = *(const bf16x8*)(Wt + (size_t)(64 * w + 32 * tn + r32) * kdim + 16 * s4 + 8 * hh);
#pragma unroll
                for (int tm = 0; tm < 2; ++tm)
#pragma unroll
                    for (int tn = 0; tn < 2; ++tn) acc[tm][tn] = __builtin_amdgcn_mfma_f32_32x32x16_bf16(af[tm], bfr[tn], acc[tm][tn], 0, 0, 0);
            }
#pragma unroll
            for (int tn = 0; tn < 2; ++tn)
#pragma unroll
                for (int tm = 0; tm < 2; ++tm) { float* dp = dst + (size_t)(t0 + 32 * tm + 4 * hh) * 512 + 64 * w + 32 * tn + r32;
#pragma unroll
                    for (int r = 0; r < 16; ++r) dp[(size_t)((r & 3) + 8 * (r >> 2)) * 512] = acc[tm][tn][r]; }
        }
        asm volatile("s_waitcnt vmcnt(0)" ::: "memory");
        __syncthreads();
        }
        if (parts & 2) {
            LAS float* nrm = (LAS float*)(F.lds + 40960);
            {
                const int tt = tid >> 3, hd = tid & 7, tg = t0 + tt, tl = tg % SEQ;
                const bf16* bp = P + (size_t)tg * ODD_N + hd * 64;
                float qs = 0.f, ks = 0.f, n2 = 0.f;
#pragma unroll 2
                for (int c = 0; c < 8; ++c) {
                    const v4u wq = *(const v4u*)(bp + 8 * c), wk = *(const v4u*)(bp + 512 + 8 * c), wc = *(const v4u*)(bp + 2048 + 512 + 8 * c);
                    v4u wp = (v4u){0u, 0u, 0u, 0u}; if (tl > 0) wp = *(const v4u*)(bp - ODD_N + 2048 + 512 + 8 * c);
                    const f32x4 mk0 = *(const f32x4*)(mix + 512 + hd * 64 + 8 * c), mk1 = *(const f32x4*)(mix + 512 + hd * 64 + 8 * c + 4);
                    const f32x4 kc0 = *(const f32x4*)(kkp + hd * 64 + 8 * c), kc1 = *(const f32x4*)(kkp + hd * 64 + 8 * c + 4);
#pragma unroll
                    for (int i = 0; i < 4; ++i) {
                        const float q0 = bflo(wq[i]), q1 = bfhi(wq[i]), k0 = bflo(wk[i]), k1 = bfhi(wk[i]);
                        qs += q0 * q0 + q1 * q1; ks += k0 * k0 + k1 * k1;
                        const float c0 = bflo(wc[i]), c1 = bfhi(wc[i]), p0 = bflo(wp[i]), p1 = bfhi(wp[i]);
                        const float m0 = i < 2 ? mk0[2 * i] : mk1[2 * i - 4], m1 = i < 2 ? mk0[2 * i + 1] : mk1[2 * i - 3];
                        const float g0 = i < 2 ? kc0[2 * i] : kc1[2 * i - 4], g1 = i < 2 ? kc0[2 * i + 1] : kc1[2 * i - 3];
                        const float x0 = (c0 + (p0 - c0) * m0) * g0, x1 = (c1 + (p1 - c1) * m1) * g1;
                        n2 += x0 * x0 + x1 * x1; }
                }
                *(LAS f32x4*)(nrm + (tt * 8 + hd) * 4) = (f32x4){rsqrtf(qs * (1.f / 64.f) + NORM_EPS), rsqrtf(ks * (1.f / 64.f) + NORM_EPS), 1.f / fmaxf(sqrtf(n2), 1e-12f), 0.f};
            }
            __syncthreads();
            const int c4 = 4 * (tid & 127), hd = c4 >> 6, th = tid >> 7;
            const f32x4 mr = *(const f32x4*)(mix + c4), mk = *(const f32x4*)(mix + 512 + c4), mv = *(const f32x4*)(mix + 1024 + c4);
            const f32x4 kk4 = *(const f32x4*)(kkp + c4), ka4 = *(const f32x4*)(kap + c4), w04 = *(const f32x4*)(w0 + c4), a04 = *(const f32x4*)(a0 + c4);
            const f32x4 qn4 = *(const f32x4*)(qn + (c4 & 63)), kn4 = *(const f32x4*)(kn + (c4 & 63));
#pragma unroll 2
            for (int t2 = 0; t2 < 16; ++t2) { const int tt = 16 * th + t2, tg = t0 + tt, tl = tg % SEQ;
                const bf16* pc = P + (size_t)tg * ODD_N + 2048 + c4; const bf16* pp = pc - ODD_N;
                const size_t o = (size_t)tg * 512 + c4;
                const f32x4 wraw = *(const f32x4*)(LWp + o), araw = *(const f32x4*)(A + o);
                const v2u rc = *(const v2u*)pc, kc = *(const v2u*)(pc + 512), vc = *(const v2u*)(pc + 1024);
                v2u rp = (v2u){0u, 0u}, kp = rp, vp = rp; if (tl > 0) { rp = *(const v2u*)pp; kp = *(const v2u*)(pp + 512); vp = *(const v2u*)(pp + 1024); }
                bf16* pq = P + (size_t)tg * ODD_N + c4;
                const v2u qw = *(const v2u*)pq, kw = *(const v2u*)(pq + 512);
                const f32x4 nm = *(const LAS f32x4*)(nrm + (tt * 8 + hd) * 4);
                f32x4 R4, V4, KK4, LW4, A4, K4; float qo[4], ko[4];
#pragma unroll
                for (int e = 0; e < 4; ++e) {
                    const float rcv = (e & 1) ? bfhi(rc[e >> 1]) : bflo(rc[e >> 1]), rpv = (e & 1) ? bfhi(rp[e >> 1]) : bflo(rp[e >> 1]);
                    const float kcv = (e & 1) ? bfhi(kc[e >> 1]) : bflo(kc[e >> 1]), kpv = (e & 1) ? bfhi(kp[e >> 1]) : bflo(kp[e >> 1]);
                    const float vcv = (e & 1) ? bfhi(vc[e >> 1]) : bflo(vc[e >> 1]), vpv = (e & 1) ? bfhi(vp[e >> 1]) : bflo(vp[e >> 1]);
                    const float qv = (e & 1) ? bfhi(qw[e >> 1]) : bflo(qw[e >> 1]), kv = (e & 1) ? bfhi(kw[e >> 1]) : bflo(kw[e >> 1]);
                    const float r = rcv + (rpv - rcv) * mr[e], k = kcv + (kpv - kcv) * mk[e], v = vcv + (vpv - vcv) * mv[e];
                    const float wl = -softplusf_(-(w04[e] + wraw[e])) - 0.5f, av = sigmoidf_(a04[e] + araw[e]);
                    R4[e] = r; V4[e] = v; KK4[e] = k * kk4[e] * nm.z; LW4[e] = -expf(wl); A4[e] = av; K4[e] = k * (1.f + (av - 1.f) * ka4[e]);
                    qo[e] = qv * nm.x * qn4[e]; ko[e] = kv * nm.y * kn4[e]; }
                *(f32x4*)(R + o) = R4; *(f32x4*)(V + o) = V4; *(f32x4*)(KK + o) = KK4; *(f32x4*)(LWp + o) = LW4; *(f32x4*)(A + o) = A4; *(f32x4*)(K + o) = K4;
                v2u qv2, kv2; qv2.x = pk2(qo[0], qo[1]); qv2.y = pk2(qo[2], qo[3]); kv2.x = pk2(ko[0], ko[1]); kv2.y = pk2(ko[2], ko[3]);
                *(v2u*)pq = qv2; *(v2u*)(pq + 512) = kv2; }
        }
        __syncthreads();
    }
}

constexpr int CP = 144;
constexpr int CM = 64 * CP;
__device__ __forceinline__ void mm_nt(f32x16& acc, const LAS unsigned char* A, const LAS unsigned char* B, int m0, int n0, int r32, int hh) {
#pragma unroll
    for (int s4 = 0; s4 < 4; ++s4) { const bf16x8 a = *(const LAS bf16x8*)(A + (m0 + r32) * CP + 32 * s4 + 16 * hh); const bf16x8 b = *(const LAS bf16x8*)(B + (n0 + r32) * CP + 32 * s4 + 16 * hh);
        acc = __builtin_amdgcn_mfma_f32_32x32x16_bf16(a, b, acc, 0, 0, 0); }
}
__device__ __forceinline__ void store_t(LAS unsigned char* Dst, const f32x16& acc, int m0, int n0, int r32, int hh, float sg) {
#pragma unroll
    for (int g = 0; g < 4; ++g) { v2u w; w.x = pk2(sg * acc[4 * g], sg * acc[4 * g + 1]); w.y = pk2(sg * acc[4 * g + 2], sg * acc[4 * g + 3]); *(LAS v2u*)(Dst + (n0 + r32) * CP + (m0 + 8 * g + 4 * hh) * 2) = w; }
}
__device__ __forceinline__ void load_t(f32x16& acc, const LAS unsigned char* Src, int m0, int n0, int r32, int hh, float sg) {
#pragma unroll
    for (int g = 0; g < 4; ++g) { const v2u w = *(const LAS v2u*)(Src + (n0 + r32) * CP + (m0 + 8 * g + 4 * hh) * 2);
        acc[4 * g] = sg * bflo(w.x); acc[4 * g + 1] = sg * bfhi(w.x); acc[4 * g + 2] = sg * bflo(w.y); acc[4 * g + 3] = sg * bfhi(w.y); }
}
__device__ __forceinline__ void mask16(f32x16& acc, int m0, int n0, int r32, int hh, int mode) {
    const int n = n0 + r32;
#pragma unroll
    for (int r = 0; r < 16; ++r) { const int m = m0 + (r & 3) + 8 * (r >> 2) + 4 * hh; const bool keep = mode == 0 ? (n < m) : (mode == 1 ? (m < n) : (m <= n)); acc[r] = keep ? acc[r] : 0.f; }
}
__device__ __forceinline__ void phase_rwkv_chunk(Frame& F, int layer, int qoff = 0, int parts = 15) {
    KARGS;
    const float* R = WSP(float, WS_RW); const float* LW = WSP(float, WS_RW + RW_SLOT); const float* K = WSP(float, WS_RW + 2 * RW_SLOT); const float* V = WSP(float, WS_RW + 3 * RW_SLOT);
    const float* KK = WSP(float, WS_RW + 4 * RW_SLOT); const float* A = WSP(float, WS_RW + 5 * RW_SLOT);
    bf16* CGp = WSP(bf16, WS_CG); bf16* CQp = WSP(bf16, WS_CQ); float* CHp = WSP(float, WS_CH); float* CYp = WSP(float, WS_CY);
    const int tid = F.tid, lane = F.lane, w = F.wave, r32 = lane & 31, hh = lane >> 5;
    LAS unsigned char* L = F.lds;
    LAS unsigned char* Ab = L, *Bb = L + CM, *Kb = L + 2 * CM, *Rb = L + 3 * CM, *BtT = L + 4 * CM, *KtT = L + 5 * CM, *VT = L + 6 * CM;
    LAS unsigned char* XT0 = L + 7 * CM, *XT1 = L + 9 * CM;
    LAS unsigned char* NB = L + 11 * CM;
    LAS unsigned char* Prb = L + 15 * CM;
    LAS float* tot = (LAS float*)(L + 16 * CM);
    LAS float* gCl = tot + 512;
    const int myx = (int)((unsigned)__builtin_amdgcn_s_getreg((3 << 11) | 20) & 7u);
    unsigned* qh = (unsigned*)F.ctl + CW_CHQ + qoff + layer * 8 * 64;
    for (int dx = 0; dx < 8; ++dx) { const int xs = (myx + dx) & 7;
    for (;;) {
        LBAR();
        if (tid == 0) F.MISC[20] = atomicAdd(qh + xs * 64, 1u);
        LBAR();
        const int kq = (int)F.MISC[20];
        if (kq >= 256) break;
        const int bh = xs + 8 * (kq >> 7), c = kq & 127, b = bh >> 3, h = bh & 7;
        {
            const size_t g0 = ((size_t)b * SEQ + c * 64 + 8 * w) * 512 + h * 64 + lane;
            float lw[8], cum[8]; float run = 0.f;
#pragma unroll
            for (int i = 0; i < 8; ++i) { lw[i] = LW[g0 + (size_t)i * 512]; run += lw[i]; cum[i] = run; }
            tot[w * 64 + lane] = run;
            LBAR();
            float off = 0.f, all = 0.f;
#pragma unroll
            for (int ww = 0; ww < 8; ++ww) { const float tv = tot[ww * 64 + lane]; if (ww < w) off += tv; all += tv; }
            if (w == 0) gCl[lane] = expf(all);
#pragma unroll
            for (int i = 0; i < 8; ++i) {
                const int t = 8 * w + i; const float cm = cum[i] + off;
                const float g = expf(cm), gex = expf(cm - lw[i]), gi = expf(-cm), gcg = expf(all - cm);
                const size_t gg = g0 + (size_t)i * 512;
                const float r = R[gg], k = K[gg], v = V[gg], kk = KK[gg], a = A[gg];
                const bf16 ab = (bf16)f2bf(kk * gex), bb = (bf16)f2bf(kk * a * gi), kb = (bf16)f2bf(k * gi), rb = (bf16)f2bf(r * g), bt = (bf16)f2bf(kk * a * gcg), kt = (bf16)f2bf(k * gcg), vb = (bf16)f2bf(v);
                *(LAS bf16*)(Ab + t * CP + lane * 2) = ab; *(LAS bf16*)(Bb + t * CP + lane * 2) = bb; *(LAS bf16*)(Kb + t * CP + lane * 2) = kb; *(LAS bf16*)(Rb + t * CP + lane * 2) = rb;
                *(LAS bf16*)(XT0 + lane * CP + t * 2) = ab; *(LAS bf16*)(BtT + lane * CP + t * 2) = bt; *(LAS bf16*)(KtT + lane * CP + t * 2) = kt; *(LAS bf16*)(VT + lane * CP + t * 2) = vb;
            }
            LBAR();
        }
        if (!(parts & 2)) continue;
        int r32m = r32; asm volatile("" : "+v"(r32m));
        const int xtm = w & 1, xtn = w >> 1;
        f32x16 xacc;
        {
#pragma unroll
            for (int qq = 0; qq < 2; ++qq) {
                int q; if (w < 4) q = 2 * w + qq; else { if (qq == 1) break; q = 8 + (w - 4); }
                const int pr = q >> 2, tm = (q >> 1) & 1, tn = q & 1; f32x16 acc; ZERO16(acc);
                if (pr == 0) { mm_nt(acc, Ab, Bb, 32 * tm, 32 * tn, r32, hh); mask16(acc, 32 * tm, 32 * tn, r32m, hh, 0); store_t(NB + 1 * CM, acc, 32 * tm, 32 * tn, r32, hh, -1.f); }
                else if (pr == 1) { mm_nt(acc, Bb, Ab, 32 * tm, 32 * tn, r32, hh); mask16(acc, 32 * tm, 32 * tn, r32m, hh, 1); store_t(NB + 0 * CM, acc, 32 * tm, 32 * tn, r32, hh, -1.f); }
                else { mm_nt(acc, Bb, Rb, 32 * tm, 32 * tn, r32, hh); mask16(acc, 32 * tm, 32 * tn, r32m, hh, 2); store_t(Prb, acc, 32 * tm, 32 * tn, r32, hh, 1.f); }
            }
            if (xtn >= 2) { ZERO16(xacc); mm_nt(xacc, Ab, Kb, 32 * xtm, 32 * (xtn - 2), r32, hh); mask16(xacc, 32 * xtm, 32 * (xtn - 2), r32m, hh, 0); store_t(XT0 + 64 * CP, xacc, 32 * xtm, 32 * (xtn - 2), r32, hh, 1.f); }
            else load_t(xacc, XT0, 32 * xtm, 32 * xtn, r32, hh, 1.f);
            LBAR();
        }
        if (!(parts & 4)) continue;
        LAS unsigned char* XTc = XT0; LAS unsigned char* XTn = XT1; int nb = 0;
#pragma unroll 1
        for (int j = 0; j < 6; ++j) {
            const LAS unsigned char* Nc = NB + (2 * nb) * CM; const LAS unsigned char* NTc = NB + (2 * nb + 1) * CM;
            mm_nt(xacc, Nc, XTc, 32 * xtm, 32 * xtn, r32, hh);
            store_t(XTn, xacc, 32 * xtm, 32 * xtn, r32, hh, 1.f);
            if (j < 5) { const int tm = (w >> 1) & 1, tn = w & 1; f32x16 acc; ZERO16(acc);
                if (w < 4) { mm_nt(acc, Nc, NTc, 32 * tm, 32 * tn, r32, hh); store_t(NB + (2 * (nb ^ 1) + 1) * CM, acc, 32 * tm, 32 * tn, r32, hh, 1.f); }
                else       { mm_nt(acc, NTc, Nc, 32 * tm, 32 * tn, r32, hh); store_t(NB + (2 * (nb ^ 1)) * CM, acc, 32 * tm, 32 * tn, r32, hh, 1.f); } }
            LBAR();
            { LAS unsigned char* t_ = XTc; XTc = XTn; XTn = t_; } nb ^= 1;
        }
        if (!(parts & 8)) continue;
        const size_t cbase = (size_t)(bh * 128 + c) * 4096;
#pragma unroll
        for (int qq = 0; qq < 2; ++qq) {
            const int q = 2 * w + qq, pr = q >> 2, tm = (q >> 1) & 1, tn = q & 1, m0 = 32 * tm, n0 = 32 * tn; f32x16 acc;
            if (pr == 0) {
                load_t(acc, Rb, m0, n0, r32, hh, -1.f); mm_nt(acc, XTc, Prb, m0, n0, r32, hh);
#pragma unroll
                for (int g = 0; g < 4; ++g) { v2u o; o.x = pk2(-acc[4 * g], -acc[4 * g + 1]); o.y = pk2(-acc[4 * g + 2], -acc[4 * g + 3]);
                    *(v2u*)(CQp + cbase + (size_t)((((tn * 4 + 2 * tm + (g >> 1)) * 2 + (g & 1)) * 32 + r32) * 8 + hh * 4)) = o; }
            } else if (pr == 1) {
                ZERO16(acc); mm_nt(acc, XTc, BtT, m0, n0, r32, hh);
                const int k1 = n0 + r32; const float gc = gCl[k1];
#pragma unroll
                for (int g = 0; g < 4; ++g) { float e[4];
#pragma unroll
                    for (int i = 0; i < 4; ++i) { const int k2 = m0 + 8 * g + 4 * hh + i; e[i] = (k2 == k1 ? gc : 0.f) - acc[4 * g + i]; }
                    v2u o; o.x = pk2(e[0], e[1]); o.y = pk2(e[2], e[3]);
                    *(v2u*)(CGp + cbase + (size_t)((((tn * 4 + 2 * tm + (g >> 1)) * 2 + (g & 1)) * 32 + r32) * 8 + hh * 4)) = o; }
            } else if (pr == 2) {
                load_t(acc, KtT, m0, n0, r32, hh, -1.f); mm_nt(acc, XTc + 64 * CP, BtT, m0, n0, r32, hh); store_t(NB, acc, m0, n0, r32, hh, -1.f);
            } else {
                f32x16 a1; ZERO16(a1); mm_nt(a1, Kb, Rb, m0, n0, r32, hh); mask16(a1, m0, n0, r32m, hh, 2);
                ZERO16(acc); mm_nt(acc, XTc + 64 * CP, Prb, m0, n0, r32, hh);
#pragma unroll
                for (int r = 0; r < 16; ++r) acc[r] = a1[r] - acc[r];
                store_t(NB + CM, acc, m0, n0, r32, hh, 1.f);
            }
        }
        LBAR();
        {
            const int ww = w & 3, tm = ww >> 1, tn = ww & 1, m0 = 32 * tm, n0 = 32 * tn; f32x16 acc; ZERO16(acc);
            mm_nt(acc, w < 4 ? NB : NB + CM, VT, m0, n0, r32, hh);
            bf16* dst = (bf16*)(w < 4 ? CHp : CYp) + cbase + (size_t)((tm * 2 + tn) * 4 * 64 + lane) * 4;
#pragma unroll
            for (int g = 0; g < 4; ++g) { v2u o; o.x = pk2(acc[4 * g], acc[4 * g + 1]); o.y = pk2(acc[4 * g + 2], acc[4 * g + 3]); *(v2u*)(dst + g * 256) = o; }
        }
        LBAR();
    }
    }
}

__device__ __forceinline__ void rwkv_scan(Frame& F, int bh, const int mode = 7) {
    KARGS;
    const unsigned char* CG8 = WSP(unsigned char, WS_CG) + (size_t)bh * 128 * 8192; const unsigned char* CQ8 = WSP(unsigned char, WS_CQ) + (size_t)bh * 128 * 8192;
    const unsigned char* CH8 = WSP(unsigned char, WS_CH) + (size_t)bh * 128 * 8192; const unsigned char* CY8 = WSP(unsigned char, WS_CY) + (size_t)bh * 128 * 8192;
    float* Y = WSP(float, WS_RW + 7 * RW_SLOT);
    const int lane = F.lane, w = F.wave, r32 = lane & 31, hh = lane >> 5, b = bh >> 3, h = bh & 7;
    LAS unsigned char* S0 = F.lds; LAS unsigned char* S1 = F.lds + CM;
    LAS unsigned char* RING = F.lds + 2 * CM;
    LAS float* YR = (LAS float*)(F.lds + 2 * CM + 3 * 32768);
    for (int i = F.tid; i < 2 * CM / 4; i += NTHR) ((LAS unsigned*)F.lds)[i] = 0u;
    __syncthreads();
#define SC_DMA(gsrc, ldst) __builtin_amdgcn_global_load_lds((const unsigned*)(gsrc), (LAS unsigned*)(ldst), 16, 0, 0)
    auto issue = [&](const int c) {
        LAS unsigned char* slot = RING + (c % 3) * 32768; const size_t go = (size_t)c * 8192 + lane * 16;
        if (w < 4) {
#pragma unroll
            for (int q = 0; q < 2; ++q) { const int p = 2 * w + q; SC_DMA(CG8 + go + p * 1024, slot + p * 1024); SC_DMA(CH8 + go + p * 1024, slot + 8192 + p * 1024); } }
        else if (w < 6) {
#pragma unroll
            for (int q = 0; q < 4; ++q) { const int p = 4 * (w - 4) + q; SC_DMA(CQ8 + go + p * 1024, slot + 16384 + p * 1024); SC_DMA(CY8 + go + p * 1024, slot + 24576 + p * 1024); } }
    };
    issue(0); issue(1);
    if (w < 4) asm volatile("s_waitcnt vmcnt(4)" ::: "memory"); else asm volatile("s_waitcnt vmcnt(8)" ::: "memory");
    LBAR();
    if (w < 4) {
        const int tm = w >> 1, tn = w & 1, m0 = 32 * tm, n0 = 32 * tn;
#pragma unroll 1
        for (int c = 0; c < 128; ++c) {
            const LAS unsigned char* slot = RING + (c % 3) * 32768;
            const LAS unsigned char* Sc = (c & 1) ? S1 : S0; LAS unsigned char* Sn = (c & 1) ? S0 : S1;
            f32x16 acc;
#pragma unroll
            for (int g = 0; g < 4; ++g) { const v2u iw = *(const LAS v2u*)(slot + 8192 + (((tm * 2 + tn) * 4 + g) * 64 + lane) * 8);
                acc[4 * g] = bflo(iw.x); acc[4 * g + 1] = bfhi(iw.x); acc[4 * g + 2] = bflo(iw.y); acc[4 * g + 3] = bfhi(iw.y); }
#pragma unroll
            for (int s4 = 0; s4 < 4; ++s4) { const bf16x8 a = *(const LAS bf16x8*)(slot + ((tm * 8 + hh) * 32 + r32) * 16 + 1024 * s4);
                const bf16x8 bb = *(const LAS bf16x8*)(Sc + (n0 + r32) * CP + 32 * s4 + 16 * hh); acc = __builtin_amdgcn_mfma_f32_32x32x16_bf16(a, bb, acc, 0, 0, 0); }
            store_t(Sn, acc, m0, n0, r32, hh, 1.f);
            if (c + 2 < 128) { issue(c + 2); asm volatile("s_waitcnt vmcnt(4)" ::: "memory"); } else asm volatile("s_waitcnt vmcnt(0)" ::: "memory");
            LBAR();
        }
        LBAR();
    } else if (w < 6) {
        const int tmY = w - 4, m0 = 32 * tmY;
#pragma unroll 1
        for (int c = 0; c < 128; ++c) {
            const LAS unsigned char* slot = RING + (c % 3) * 32768;
            const LAS unsigned char* Sc = (c & 1) ? S1 : S0; LAS float* yo = YR + (c & 1) * 4096;
            f32x16 acc[2]; bf16x8 a[4];
#pragma unroll
            for (int s4 = 0; s4 < 4; ++s4) a[s4] = *(const LAS bf16x8*)(slot + 16384 + ((tmY * 8 + hh) * 32 + r32) * 16 + 1024 * s4);
#pragma unroll
            for (int tn = 0; tn < 2; ++tn) {
#pragma unroll
                for (int g = 0; g < 4; ++g) { const v2u iw = *(const LAS v2u*)(slot + 24576 + (((tmY * 2 + tn) * 4 + g) * 64 + lane) * 8);
                    acc[tn][4 * g] = bflo(iw.x); acc[tn][4 * g + 1] = bfhi(iw.x); acc[tn][4 * g + 2] = bflo(iw.y); acc[tn][4 * g + 3] = bfhi(iw.y); }
#pragma unroll
                for (int s4 = 0; s4 < 4; ++s4) { const bf16x8 bb = *(const LAS bf16x8*)(Sc + (32 * tn + r32) * CP + 32 * s4 + 16 * hh); acc[tn] = __builtin_amdgcn_mfma_f32_32x32x16_bf16(a[s4], bb, acc[tn], 0, 0, 0); }
#pragma unroll
                for (int r = 0; r < 16; ++r) yo[(m0 + (r & 3) + 8 * (r >> 2) + 4 * hh) * 64 + 32 * tn + r32] = acc[tn][r];
            }
            if (c + 2 < 128) { issue(c + 2); asm volatile("s_waitcnt vmcnt(8)" ::: "memory"); } else asm volatile("s_waitcnt vmcnt(0)" ::: "memory");
            LBAR();
        }
        LBAR();
    } else {
        const int row0 = 32 * (w - 6) + (lane >> 4), cq = (lane & 15) * 4;
        float* yg = Y + ((size_t)b * SEQ + row0) * 512 + h * 64 + cq;
        LBAR();
#pragma unroll 1
        for (int c = 1; c <= 128; ++c) {
            const LAS float* yi = YR + ((c - 1) & 1) * 4096 + row0 * 64 + cq;
            f32x4 ty[8];
#pragma unroll
            for (int i = 0; i < 8; ++i) ty[i] = *(const LAS f32x4*)(yi + 4 * i * 64);
            asm volatile("s_waitcnt lgkmcnt(0)" ::: "memory");
#pragma unroll
            for (int i = 0; i < 8; ++i) *(f32x4*)(yg + (size_t)((c - 1) * 64 + 4 * i) * 512) = ty[i];
            LBAR();
        }
    }
#undef SC_DMA
}

__device__ __forceinline__ void phase_odd_main(Frame& F, int layer, int ctr_base, int parts) {
    KARGS;
    const bf16* P = WSP(bf16, WS_PROJ); bf16* MIX = WSP(bf16, WS_MIX); const float* DC = WSP(float, WS_DCUM);
    const int tid = F.tid, lane = F.lane, wave = F.wave, r32 = lane & 31, hh = lane >> 5;
    const float LOG2E = 1.4426950408889634f, CS = 0.125f * LOG2E;
    const int srow = tid >> 3, sch = tid & 7;
    const int myx = (int)((unsigned)__builtin_amdgcn_s_getreg((3 << 11) | 20) & 7u);
    unsigned* sq = (unsigned*)F.ctl + CW_SCQ + (ctr_base == CW_WORK ? 0 : 2048) + layer * 8 * 64;
    if (parts & 1) {
        __syncthreads(); if (tid == 0) F.MISC[19] = atomicAdd(sq + myx * 64, 1u); __syncthreads();
        const int kc = (int)F.MISC[19]; if (kc < 2) rwkv_scan(F, myx + 8 * kc, parts >> 4 ? (parts >> 4) & 7 : 7); }
    if (0) for (int bhs = F.bid; bhs < 16; bhs += F.G) rwkv_scan(F, bhs);
    unsigned* ctr = (unsigned*)F.ctl + ctr_base + 64 * layer;
#ifdef NOSKIP_PROBE
    const float BND = 1e30f;
#else
    const float BND = 2.04f * 8.f * LOG2E * wave_max(fabsf(IN(12)[(layer >> 1) * 64 + lane])) * wave_max(fabsf(IN(13)[(layer >> 1) * 64 + lane]));
#endif
    for (;;) {
        {
            __syncthreads();
            if (tid == 0) F.MISC[16] = atomicAdd(ctr, 1u);
            __syncthreads();
            const int u = (int)F.MISC[16];
            if (u >= 512 || !(parts & 2)) break;
            const int bh = u & 15, qb = 31 - (u >> 4), b = bh >> 3, h = bh & 7;
            const bf16* base = P + (size_t)b * SEQ * ODD_N; const float* dc = DC + (size_t)bh * SEQ;
            const int q0 = 256 * qb + 32 * wave, myq = q0 + r32;
            bf16x8 qf[4];
#pragma unroll
            for (int d0 = 0; d0 < 4; ++d0) qf[d0] = *(const bf16x8*)(base + (size_t)myq * ODD_N + h * 64 + 16 * d0 + 8 * hh);
            const float dq = dc[myq] * LOG2E;
            float m = -INFINITY, lsum = 0.f;
            f32x16 o[2];
#pragma unroll
            for (int r = 0; r < 16; ++r) { o[0][r] = 0.f; o[1][r] = 0.f; }
            const int NT = 4 * qb + 4;
            if (wave < 2) { const int jt = tid; const bool nd = jt < NT && (BND + (dc[256 * qb] - dc[64 * (jt < NT ? jt : 0) + 63]) * LOG2E >= -150.f);
                const unsigned long long mk = __ballot(nd); if (lane == 0) F.MISC[17 + wave] = mk ? (unsigned)(64 * wave + (int)__builtin_ctzll(mk)) : 1000u; }
            __syncthreads();
            const int jstart = (int)(F.MISC[17] < F.MISC[18] ? F.MISC[17] : F.MISC[18]);
            const float dqw = __builtin_bit_cast(float, __builtin_amdgcn_readfirstlane(__builtin_bit_cast(int, dq)));
            v4u kreg = *(const v4u*)(base + (size_t)(64 * jstart + srow) * ODD_N + 512 + h * 64 + sch * 8);
            v4u vreg = *(const v4u*)(base + (size_t)(64 * jstart + srow) * ODD_N + 1024 + h * 64 + sch * 8);
            float dreg = tid < 64 ? -dc[64 * jstart + tid] * LOG2E : 0.f;
            *(LAS v4u*)(F.lds + srow * FX_KROW + sch * 16) = kreg; *(LAS v4u*)(F.lds + FX_KB + srow * FX_VROW + sch * 16) = vreg;
            if (tid < 64) *(LAS float*)(F.lds + FX_KB + FX_VB + tid * 4) = dreg;
            __syncthreads();
            v4u kA = kreg, vA = vreg, kB = kreg, vB = vreg; float dA = 0.f, dB = 0.f;
            if (jstart + 1 < NT) { const size_t krow = (size_t)(64 * (jstart + 1) + srow) * ODD_N;
                kA = *(const v4u*)(base + krow + 512 + h * 64 + sch * 8); vA = *(const v4u*)(base + krow + 1024 + h * 64 + sch * 8);
                if (tid < 64) dA = dc[64 * (jstart + 1) + tid]; }
            auto tile_step = [&](const int j, v4u& kx, v4u& vx, float& dx, v4u& ky, v4u& vy, float& dy) {
                const int cur = ((j - jstart) & 1) * FX_BUF, nxt = ((j - jstart + 1) & 1) * FX_BUF;
                if (j + 2 < NT) { const size_t krow = (size_t)(64 * (j + 2) + srow) * ODD_N;
                    ky = *(const v4u*)(base + krow + 512 + h * 64 + sch * 8); vy = *(const v4u*)(base + krow + 1024 + h * 64 + sch * 8);
                    if (tid < 64) dy = dc[64 * (j + 2) + tid]; }
                if (64 * j <= q0 + 31 && BND + dqw + *(const LAS float*)(F.lds + cur + FX_KB + FX_VB + 63 * 4) >= -150.f) {
                    const LAS unsigned char* Kb = F.lds + cur; const LAS unsigned char* Vb = F.lds + cur + FX_KB; const LAS float* dkb = (const LAS float*)(F.lds + cur + FX_KB + FX_VB);
                    f32x16 p0, p1;
#pragma unroll
                    for (int r = 0; r < 16; ++r) { p0[r] = 0.f; p1[r] = 0.f; }
#pragma unroll
                    for (int d0 = 0; d0 < 4; ++d0) {
                        const bf16x8 a0 = *(const LAS bf16x8*)(Kb + r32 * FX_KROW + 32 * d0 + 16 * hh);
                        const bf16x8 a1 = *(const LAS bf16x8*)(Kb + (r32 + 32) * FX_KROW + 32 * d0 + 16 * hh);
                        p0 = __builtin_amdgcn_mfma_f32_32x32x16_bf16(a0, qf[d0], p0, 0, 0, 0);
                        p1 = __builtin_amdgcn_mfma_f32_32x32x16_bf16(a1, qf[d0], p1, 0, 0, 0);
                    }
                    const bool diag = 64 * j + 63 > q0;
#pragma unroll
                    for (int g = 0; g < 4; ++g) {
                        const f32x4 dk0 = *(const LAS f32x4*)(dkb + 8 * g + 4 * hh), dk1 = *(const LAS f32x4*)(dkb + 32 + 8 * g + 4 * hh);
#pragma unroll
                        for (int i = 0; i < 4; ++i) { p0[4 * g + i] = p0[4 * g + i] * CS + dk0[i]; p1[4 * g + i] = p1[4 * g + i] * CS + dk1[i]; }
                    }
                    if (diag) {
                        asm volatile("" ::: "memory");
#pragma unroll
                        for (int r = 0; r < 16; ++r) { const int key = 64 * j + (r & 3) + 8 * (r >> 2) + 4 * hh; if (key > myq) p0[r] = -INFINITY; if (key + 32 > myq) p1[r] = -INFINITY; }
                    }
                    float tmax;
                    {
                        float ta = MAX3F(p0[0], p0[1], p1[0]), tb = MAX3F(p0[2], p0[3], p1[1]); ta = MAX3F(ta, p1[2], p1[3]);
#pragma unroll
                        for (int r = 4; r < 16; r += 4) { ta = MAX3F(ta, p0[r], p0[r + 1]); tb = MAX3F(tb, p0[r + 2], p0[r + 3]); ta = MAX3F(ta, p1[r], p1[r + 1]); tb = MAX3F(tb, p1[r + 2], p1[r + 3]); }
                        tmax = fmaxf(ta, tb); }
                    tmax = fmaxf(tmax, __shfl_xor(tmax, 32));
                    const float mn = fmaxf(m, tmax); const float corr = __builtin_amdgcn_exp2f(m - mn); m = mn;
                    float ps = 0.f;
#pragma unroll
                    for (int r = 0; r < 16; ++r) { p0[r] = __builtin_amdgcn_exp2f(p0[r] - mn); p1[r] = __builtin_amdgcn_exp2f(p1[r] - mn); ps += p0[r] + p1[r]; }
                    lsum = lsum * corr + ps;
                    if (__any(corr != 1.f)) {
                        asm volatile("" ::: "memory");
#pragma unroll
                        for (int r = 0; r < 16; ++r) { o[0][r] *= corr; o[1][r] *= corr; } }
                    bf16x8 pf[4];
#pragma unroll
                    for (int s4 = 0; s4 < 4; ++s4) {
                        v4u w;
                        if (s4 < 2) { w.x = pk2(p0[8 * s4 + 0], p0[8 * s4 + 1]); w.y = pk2(p0[8 * s4 + 2], p0[8 * s4 + 3]); w.z = pk2(p0[8 * s4 + 4], p0[8 * s4 + 5]); w.w = pk2(p0[8 * s4 + 6], p0[8 * s4 + 7]); }
                        else { const int sp = s4 - 2; w.x = pk2(p1[8 * sp + 0], p1[8 * sp + 1]); w.y = pk2(p1[8 * sp + 2], p1[8 * sp + 3]); w.z = pk2(p1[8 * sp + 4], p1[8 * sp + 5]); w.w = pk2(p1[8 * sp + 6], p1[8 * sp + 7]); }
                        pf[s4] = __builtin_bit_cast(bf16x8, w);
                    }
                    const int gi = lane >> 4, li = lane & 15;
                    const LAS unsigned char* vbase = Vb + (4 * (gi >> 1) + (li >> 2)) * FX_VROW + (16 * (gi & 1) + 4 * (li & 3)) * 2;
#pragma unroll
                    for (int d0 = 0; d0 < 2; ++d0)
#pragma unroll
                        for (int s4 = 0; s4 < 4; ++s4) {
                            const s16x4 lo = __builtin_bit_cast(s16x4, __builtin_amdgcn_ds_read_tr16_b64_v4i16((LAS s16x4*)(vbase + (16 * s4) * FX_VROW + 64 * d0)));
                            const s16x4 hi = __builtin_bit_cast(s16x4, __builtin_amdgcn_ds_read_tr16_b64_v4i16((LAS s16x4*)(vbase + (16 * s4 + 8) * FX_VROW + 64 * d0)));
                            const bf16x8 vf = (bf16x8){lo[0], lo[1], lo[2], lo[3], hi[0], hi[1], hi[2], hi[3]};
                            o[d0] = __builtin_amdgcn_mfma_f32_32x32x16_bf16(vf, pf[s4], o[d0], 0, 0, 0);
                        }
                }
                if (j + 1 < NT) {
                    *(LAS v4u*)(F.lds + nxt + srow * FX_KROW + sch * 16) = kx; *(LAS v4u*)(F.lds + nxt + FX_KB + srow * FX_VROW + sch * 16) = vx;
                    if (tid < 64) *(LAS float*)(F.lds + nxt + FX_KB + FX_VB + tid * 4) = -dx * LOG2E;
                }
                LBAR();
            };
            for (int j = jstart; j < NT; j += 2) {
                tile_step(j, kA, vA, dA, kB, vB, dB);
                if (j + 1 < NT) tile_step(j + 1, kB, vB, dB, kA, vA, dA);
            }
            const float l = lsum + __shfl_xor(lsum, 32); const float inv = 1.f / l;
            const bf16* gp = base + (size_t)myq * ODD_N + 1536 + h * 64; bf16* op = MIX + ((size_t)b * SEQ + myq) * D + h * 64;
#pragma unroll
            for (int d0 = 0; d0 < 2; ++d0)
#pragma unroll
                for (int g = 0; g < 4; ++g) { const int db = 32 * d0 + 8 * g + 4 * hh; const v2u gw = *(const v2u*)(gp + db);
                    const float g0 = sigmoidf_(bflo(gw.x)), g1 = sigmoidf_(bfhi(gw.x)), g2 = sigmoidf_(bflo(gw.y)), g3 = sigmoidf_(bfhi(gw.y));
                    v2u ow; ow.x = pk2(o[d0][4 * g + 0] * inv * g0, o[d0][4 * g + 1] * inv * g1); ow.y = pk2(o[d0][4 * g + 2] * inv * g2, o[d0][4 * g + 3] * inv * g3);
                    *(v2u*)(op + db) = ow; }
        }
    }
    if (parts & 1) for (int dx = 0; dx < 8; ++dx) { const int xs = (myx + dx) & 7;
        for (;;) { __syncthreads(); if (tid == 0) F.MISC[19] = atomicAdd(sq + xs * 64, 1u); __syncthreads(); const int kc = (int)F.MISC[19]; if (kc >= 2) break; rwkv_scan(F, xs + 8 * kc); } }
}

__device__ __forceinline__ void phase_rwkv_post(Frame& F, int layer) {
    KARGS;
    const int jj = layer >> 1, ch = F.tid;
    const float* R = WSP(float, WS_RW); const float* K = WSP(float, WS_RW + 2 * RW_SLOT); const float* V = WSP(float, WS_RW + 3 * RW_SLOT);
    const float* Gt = WSP(float, WS_RW + 6 * RW_SLOT); const float* Y = WSP(float, WS_RW + 7 * RW_SLOT);
    bf16* MIX = WSP(bf16, WS_MIX);
    const float lw = IN(24)[jj * 512 + ch], lb = IN(25)[jj * 512 + ch], rk = IN(23)[jj * 512 + ch];
#pragma unroll 4
    for (int tg = F.bid; tg < T; tg += F.G) {
        const size_t o = (size_t)tg * 512 + ch;
        const float y = Y[o]; const float mu = wave_sum(y) * (1.f / 64.f); const float dlt = y - mu; const float var = wave_sum(dlt * dlt) * (1.f / 64.f);
        const float yn = dlt * rsqrtf(var + GN_EPS) * lw + lb;
        const float v = V[o]; const float bonus = wave_sum(R[o] * K[o] * rk) * v;
        MIX[(size_t)tg * D + 512 + ch] = (bf16)f2bf((yn + bonus) * Gt[o]);
    }
}

__device__ __forceinline__ void sort16_desc(float (&v)[16]) {
#pragma unroll
    for (int k = 2; k <= 16; k <<= 1)
#pragma unroll
        for (int j = k >> 1; j > 0; j >>= 1)
#pragma unroll
            for (int i = 0; i < 16; ++i) { const int l = i ^ j; if (l > i) { const float a_ = v[i], b_ = v[l]; const float mx = fmaxf(a_, b_), mn = fminf(a_, b_);
                if ((i & k) == 0) { v[i] = mx; v[l] = mn; } else { v[i] = mn; v[l] = mx; } } }
}
__device__ __forceinline__ void merge16_desc(float (&A)[16], const float (&B)[16]) {
#pragma unroll
    for (int i = 0; i < 16; ++i) A[i] = fmaxf(A[i], B[15 - i]);
#pragma unroll
    for (int j = 8; j > 0; j >>= 1)
#pragma unroll
        for (int i = 0; i < 16; ++i) { const int l = i ^ j; if (l > i) { const float a_ = A[i], b_ = A[l]; A[i] = fmaxf(a_, b_); A[l] = fminf(a_, b_); } }
}
__device__ __forceinline__ float pack_low(float v, unsigned bits, unsigned mask) { return __builtin_bit_cast(float, (__builtin_bit_cast(unsigned, v) & ~mask) | bits); }
template <bool OWN> __device__ __forceinline__ void phase_peer_topk(Frame& F, int layer, const pg8::StaticOrder S) {
    KARGS;
    const bf16* Q = WSP(bf16, WS_Q); const bf16* KEYS = WSP(bf16, WS_KEYS) + (size_t)layer * 2 * 16384;
    int* IDX = WSP(int, WS_IDX); float* GATE = WSP(float, WS_GATE);
    constexpr int SCP = 132;
    LAS float* sc = (LAS float*)(F.lds + F.wave * (32 * SCP * 4));
    LAS unsigned* li = (LAS unsigned*)sc;
    const int lane = F.lane, fr = lane & 15, fq = lane >> 4, tok = lane & 31, hp = lane >> 5;
    const int gw = F.bid * NWAVES + F.wave, NGW = F.G * NWAVES;
    pg8::Unit un{0, 0};
    const bool cv = OWN && layer < 3;
    const int NRW = (2 * NEXP + NGW - 1) / NGW;
    int cr = 0;
    f32x4 cvv[2][4];
    for (int it = OWN ? 0 : gw; OWN ? S.next(it, un) : (it < (T / 32) * 8); it += OWN ? 1 : NGW) {
        const int tile = OWN ? un.pm * 8 + F.wave : (it >> 3), h = OWN ? un.pn : (it & 7), t0 = tile * 32;
        float v1[16], v2[16];
#pragma unroll
        for (int half = 0; half < 2; ++half) {
            f32x4 acc[2][8];
#pragma unroll
            for (int rt = 0; rt < 2; ++rt)
#pragma unroll
                for (int ct = 0; ct < 8; ++ct) acc[rt][ct] = (f32x4){0.f, 0.f, 0.f, 0.f};
            const bf16* kb = KEYS + (size_t)half * 16384;
#pragma unroll 1
            for (int ks = 0; ks < 4; ++ks) {
                bf16x8 a[2];
#pragma unroll
                for (int rt = 0; rt < 2; ++rt) a[rt] = *(const bf16x8*)(Q + (size_t)(t0 + rt * 16 + fr) * 2048 + h * 256 + half * 128 + ks * 32 + 8 * fq);
#pragma unroll
                for (int ct = 0; ct < 8; ++ct) { const bf16x8 bb = *(const bf16x8*)(kb + (size_t)(ct * 16 + fr) * 128 + ks * 32 + 8 * fq);
#pragma unroll
                    for (int rt = 0; rt < 2; ++rt) acc[rt][ct] = __builtin_amdgcn_mfma_f32_16x16x32_bf16(a[rt], bb, acc[rt][ct], 0, 0, 0); }
            }
            if (cv && cr < NRW) conv_issue<2>(IN(29), IN(30), layer + 1, gw + cr * NGW, NGW, lane, cvv);
#pragma unroll
            for (int rt = 0; rt < 2; ++rt)
#pragma unroll
                for (int ct = 0; ct < 8; ++ct)
#pragma unroll
                    for (int r = 0; r < 4; ++r) sc[(rt * 16 + 4 * fq + r) * SCP + ct * 16 + fr] = pack_low(acc[rt][ct][r], (unsigned)(ct * 16 + fr), 0x7Fu);
            LDS_WAIT(); asm volatile("" ::: "memory");
            float top[16];
            const LAS float* row = sc + tok * SCP + 64 * hp;
#pragma unroll 1
            for (int g = 0; g < 4; ++g) {
                float grp[16];
#pragma unroll
                for (int q4 = 0; q4 < 4; ++q4) { const f32x4 x = *(const LAS f32x4*)(row + 16 * g + 4 * q4); grp[4 * q4] = x.x; grp[4 * q4 + 1] = x.y; grp[4 * q4 + 2] = x.z; grp[4 * q4 + 3] = x.w; }
                sort16_desc(grp);
                if (g == 0) {
#pragma unroll
                    for (int p = 0; p < 16; ++p) top[p] = grp[p]; }
                else merge16_desc(top, grp);
            }
            { float oth[16];
#pragma unroll
              for (int p = 0; p < 16; ++p) oth[p] = __shfl_xor(top[p], 32);
              merge16_desc(top, oth); }
            LDS_WAIT(); asm volatile("" ::: "memory");
#pragma unroll
            for (int p = 0; p < 16; ++p) { if (half == 0) v1[p] = top[p]; else v2[p] = top[p]; }
            if (cv && cr < NRW) { conv_finish<2>(WSP(unsigned char, WS_PU), WSP(unsigned char, WS_PV), WSP(float, WS_PS), layer + 1, gw + cr * NGW, NGW, lane, cvv, F.lds + 135168 + F.wave * 1024); cr += 2; }
        }
        if (hp == 0) {
#pragma unroll
            for (int p = 0; p < 16; ++p) { li[tok * 33 + p] = __builtin_bit_cast(unsigned, v1[p]) & 0x7Fu; li[tok * 33 + 16 + p] = __builtin_bit_cast(unsigned, v2[p]) & 0x7Fu; } }
        if (cv && cr < NRW) conv_issue<2>(IN(29), IN(30), layer + 1, gw + cr * NGW, NGW, lane, cvv);
        float ts[16];
        {
            float c0[16], c1[16];
            int n = 0;
#pragma unroll
            for (int a_ = 0; a_ < 16; ++a_)
#pragma unroll
                for (int b_ = 0; b_ < 16; ++b_) if ((a_ + 1) * (b_ + 1) <= 16) {
                    const float x = pack_low(v1[a_] + v2[b_], (unsigned)(a_ * 16 + b_), 0xFFu);
                    const int slot = n >> 1; const bool mine = (n & 1) == hp;
                    if (slot < 16) { if ((n & 1) == 0) c0[slot] = mine ? x : -INFINITY; else c0[slot] = mine ? x : c0[slot]; }
                    else { if ((n & 1) == 0) c1[slot - 16] = mine ? x : -INFINITY; else c1[slot - 16] = mine ? x : c1[slot - 16]; }
                    ++n; }
#pragma unroll
            for (int sl = 9; sl < 16; ++sl) c1[sl] = -INFINITY;
            sort16_desc(c0); sort16_desc(c1); merge16_desc(c0, c1);
            float oth[16];
#pragma unroll
            for (int p = 0; p < 16; ++p) oth[p] = __shfl_xor(c0[p], 32);
            merge16_desc(c0, oth);
#pragma unroll
            for (int p = 0; p < 16; ++p) ts[p] = c0[p];
        }
        LDS_WAIT(); asm volatile("" ::: "memory");
        if (cv && cr < NRW) { conv_finish<2>(WSP(unsigned char, WS_PU), WSP(unsigned char, WS_PV), WSP(float, WS_PS), layer + 1, gw + cr * NGW, NGW, lane, cvv, F.lds + 135168 + F.wave * 1024); cr += 2; }
        if (hp == 0) {
            float e[16], sum = 0.f;
#pragma unroll
            for (int p = 0; p < 16; ++p) { e[p] = expf(ts[p] - ts[0]); sum += e[p]; }
            const float inv = 1.f / sum;
            int* ip = IDX + (size_t)(t0 + tok) * 128 + h * 16; float* gp = GATE + (size_t)(t0 + tok) * 128 + h * 16;
#pragma unroll
            for (int p = 0; p < 16; ++p) { const unsigned ab = __builtin_bit_cast(unsigned, ts[p]) & 0xFFu;
                ip[p] = (int)(li[tok * 33 + (ab >> 4)] * 128u + li[tok * 33 + 16 + (ab & 15u)]); gp[p] = e[p] * inv; }
        }
        LDS_WAIT(); asm volatile("" ::: "memory");
    }
    while (cv && cr < NRW) { f32x4 v4[4][4];
        conv_issue<4>(IN(29), IN(30), layer + 1, gw + cr * NGW, NGW, lane, v4);
        conv_finish<4>(WSP(unsigned char, WS_PU), WSP(unsigned char, WS_PV), WSP(float, WS_PS), layer + 1, gw + cr * NGW, NGW, lane, v4, F.lds + 135168 + F.wave * 1024); cr += 4; }
}

typedef float f32x2 __attribute__((ext_vector_type(2)));
__device__ __forceinline__ void unpack16_fp8(float (&o)[16], const v4u w) {
#pragma unroll
    for (int j = 0; j < 4; ++j) { const f32x2 a = __builtin_amdgcn_cvt_pk_f32_fp8((int)w[j], false), b = __builtin_amdgcn_cvt_pk_f32_fp8((int)w[j], true); o[4 * j] = a.x; o[4 * j + 1] = a.y; o[4 * j + 2] = b.x; o[4 * j + 3] = b.y; }
}
__device__ __forceinline__ void gu_token(const unsigned char* U, const float* SU, const float* SV, const bf16* H, const int* IDX, const float* GATE, float* ACT, int s, int tg, int lane) {
    float x[16];
    { const v4u w0 = *(const v4u*)(H + (size_t)tg * D + 16 * lane), w1 = *(const v4u*)(H + (size_t)tg * D + 16 * lane + 8);
      x[0] = bflo(w0.x); x[1] = bfhi(w0.x); x[2] = bflo(w0.y); x[3] = bfhi(w0.y); x[4] = bflo(w0.z); x[5] = bfhi(w0.z); x[6] = bflo(w0.w); x[7] = bfhi(w0.w);
      x[8] = bflo(w1.x); x[9] = bfhi(w1.x); x[10] = bflo(w1.y); x[11] = bfhi(w1.y); x[12] = bflo(w1.z); x[13] = bfhi(w1.z); x[14] = bflo(w1.w); x[15] = bfhi(w1.w); }
#pragma unroll
    for (int half = 0; half < 2; ++half) {
        const int id = IDX[(size_t)tg * 128 + 64 * half + lane];
        const bool sel = (id >> 11) == s;
        unsigned long long m = __ballot(sel);
        const float su = sel ? SU[id] : 0.f, cf = sel ? GATE[(size_t)tg * 128 + 64 * half + lane] * SV[id] : 0.f;
        int actb = 0;
        while (m) {
            int pos[8]; v4u ua[8]; float d[8];
#pragma unroll
            for (int q = 0; q < 8; ++q) { pos[q] = m ? (int)__builtin_ctzll(m) : -1; m = m ? (m & (m - 1)) : m;
                const int idx = pos[q] >= 0 ? __builtin_amdgcn_readlane(id, pos[q]) : (s << 11);
                ua[q] = *(const v4u*)(U + (size_t)idx * 1024 + 16 * lane); }
#pragma unroll
            for (int q = 0; q < 8; ++q) { float u[16]; unpack16_fp8(u, ua[q]); float sm = 0.f;
#pragma unroll
                for (int i = 0; i < 16; ++i) sm += u[i] * x[i];
                d[q] = sm; }
#pragma unroll
            for (int o = 1; o < 64; o <<= 1) {
#pragma unroll
                for (int q = 0; q < 8; ++q) d[q] += __shfl_xor(d[q], o); }
#pragma unroll
            for (int q = 0; q < 8; ++q) if (pos[q] >= 0) { const float val = gelu_erf(d[q] * rl(su, pos[q])) * rl(cf, pos[q]);
                actb = lane == pos[q] ? __builtin_bit_cast(int, val) : actb; }
        }
        if (sel) ACT[(size_t)tg * 128 + 64 * half + lane] = __builtin_bit_cast(float, actb);
    }
}

__device__ __forceinline__ void phase_peer_gu_valu(Frame& F, int layer) {
    KARGS;
    const bf16* H = WSP(bf16, WS_H); const int* IDX = WSP(int, WS_IDX); const float* GATE = WSP(float, WS_GATE); float* ACT = WSP(float, WS_ACT);
    const unsigned char* U = WSP(unsigned char, WS_PU) + (size_t)layer * NEXP * 1024;
    const float* SU = WSP(float, WS_PS) + (size_t)layer * NEXP; const float* SV = SU + 4 * NEXP;
    const int lane = F.lane;
    unsigned* heads = (unsigned*)F.ctl + CW_G1 + layer * 8 * 64;
    const int myx = (int)((unsigned)__builtin_amdgcn_s_getreg((3 << 11) | 20) & 7u);
    for (int k = 0; k < 8; ++k) { const int s = (myx + k) & 7;
        for (;;) { unsigned u = 0; if (lane == 0) u = atomicAdd(heads + s * 64, 1u); u = (unsigned)__builtin_amdgcn_readfirstlane((int)u);
            if (u >= (unsigned)(T / 8)) break;
#pragma unroll 1
            for (int i = 0; i < 8; ++i) gu_token(U, SU, SV, H, IDX, GATE, ACT, s, (int)u * 8 + i, lane); } }
}
__device__ __forceinline__ void phase_peer_gu(Frame& F, int layer) {
    KARGS;
    const int* IDX = WSP(int, WS_IDX); const float* GATE = WSP(float, WS_GATE); float* ACT = WSP(float, WS_ACT);
    const unsigned char* U = WSP(unsigned char, WS_PU) + (size_t)layer * NEXP * 512; const unsigned char* SC6 = WSP(unsigned char, WS_PU) + (size_t)48 * MiB + (size_t)layer * NEXP * 32;
    const unsigned char* H8 = WSP(unsigned char, WS_H8); const float* HS = WSP(float, WS_HS);
    const float* SU = WSP(float, WS_PS) + (size_t)layer * NEXP; const float* SV = SU + 4 * NEXP;
    const int lane = F.lane, row = lane & 15, kc = lane >> 4;
    LAS int* lst = (LAS int*)(F.lds + F.wave * 18432);
    LAS unsigned char* xl = F.lds + F.wave * 18432 + 8192;
    LAS float* cpatch = (LAS float*)(F.lds + F.wave * 18432 + 8192 + 8320);
    unsigned* heads = (unsigned*)F.ctl + CW_G1 + layer * 8 * 64;
    const int myx = (int)((unsigned)__builtin_amdgcn_s_getreg((3 << 11) | 20) & 7u);
    struct TSet { v4u ua[8]; v2u sc; int e, meta; float su, sv, gt, xs; bool valid; };
    for (int k = 0; k < 8; ++k) {
        const int s = (myx + k) & 7;
        for (;;) {
            unsigned u = 0; if (lane == 0) u = atomicAdd(heads + s * 64, 1u); u = (unsigned)__builtin_amdgcn_readfirstlane((int)u);
            if (u >= (unsigned)(T / 8)) break;
            const int tg0 = (int)u * 8;
            int total = 0;
            int ida[8], idb[8]; v4u hx[8];
#pragma unroll
            for (int i = 0; i < 8; ++i) { ida[i] = IDX[(size_t)(tg0 + i) * 128 + lane]; idb[i] = IDX[(size_t)(tg0 + i) * 128 + 64 + lane]; hx[i] = *(const v4u*)(H8 + (size_t)(tg0 + i) * D + 16 * lane); }
#pragma unroll
            for (int i = 0; i < 8; ++i) {
                const int id0 = ida[i], id1 = idb[i];
                *(LAS v4u*)(xl + i * 1040 + 16 * lane) = hx[i];
                const bool sel0 = (id0 >> 11) == s, sel1 = (id1 >> 11) == s;
                const unsigned long long m0 = __ballot(sel0), m1 = __ballot(sel1);
                const int n0 = __builtin_popcountll(m0), cnt = n0 + __builtin_popcountll(m1);
                const int r0 = total + (int)__builtin_amdgcn_mbcnt_hi((unsigned)(m0 >> 32), __builtin_amdgcn_mbcnt_lo((unsigned)m0, 0u));
                const int r1 = total + n0 + (int)__builtin_amdgcn_mbcnt_hi((unsigned)(m1 >> 32), __builtin_amdgcn_mbcnt_lo((unsigned)m1, 0u));
                if (sel0) { lst[r0] = id0; lst[1024 + r0] = i * 128 + lane; }
                if (sel1) { lst[r1] = id1; lst[1024 + r1] = i * 128 + 64 + lane; }
                total += cnt; }
            LDS_WAIT(); asm volatile("" ::: "memory");
            const int ntile = (total + 15) >> 4;
            auto load_tile = [&](TSet& S, const int t) { if (t < ntile) {
                const int rr = 16 * t + row; S.valid = rr < total;
                const int ri = S.valid ? rr : 16 * t;
                S.e = lst[ri]; S.meta = lst[1024 + ri];
                const unsigned char* up = U + (size_t)S.e * 512 + 16 * kc;
#pragma unroll
                for (int j = 0; j < 8; ++j) S.ua[j] = *(const v4u*)(up + 64 * j);
                S.sc = *(const v2u*)(SC6 + (size_t)S.e * 32 + 8 * kc);
                S.su = 0.f; S.sv = 0.f; S.gt = 0.f; S.xs = 0.f;
                if (kc == 0) { S.su = 1.f; S.sv = SV[S.e]; S.gt = GATE[(size_t)(tg0 + (S.meta >> 7)) * 128 + (S.meta & 127)]; S.xs = HS[tg0 + (S.meta >> 7)]; } } };
            const LAS unsigned char* xp = xl + (row & 7) * 1040 + 16 * kc;
            auto compute_tile = [&](TSet& S, const int t) { if (t < ntile) {
                f32x4 acc0 = (f32x4){0.f, 0.f, 0.f, 0.f}, acc1 = acc0;
#define GU_MM(m, ACC) { const v4u xb0 = *(const LAS v4u*)(xp + 128 * (m)), xb1 = *(const LAS v4u*)(xp + 128 * (m) + 64); v8i av; \
                    _Pragma("unroll") for (int d = 0; d < 8; ++d) { av[d] = d < 4 ? (int)S.ua[(m)][d & 3] : 0; } \
                    const v8i bv = (v8i){(int)xb0.x, (int)xb0.y, (int)xb0.z, (int)xb0.w, (int)xb1.x, (int)xb1.y, (int)xb1.z, (int)xb1.w}; \
                    ACC = __builtin_amdgcn_mfma_scale_f32_16x16x128_f8f6f4(av, bv, ACC, 4, 0, (m) & 3, (int)S.sc[(m) >> 2], 0, 0x7F7F7F7F); }
                GU_MM(0, acc0) GU_MM(1, acc1) GU_MM(2, acc0) GU_MM(3, acc1) GU_MM(4, acc0) GU_MM(5, acc1) GU_MM(6, acc0) GU_MM(7, acc1)
#undef GU_MM
                acc0 += acc1;
#pragma unroll
                for (int q = 0; q < 4; ++q) cpatch[(4 * kc + q) * 17 + row] = acc0[q];
                LDS_WAIT(); asm volatile("" ::: "memory");
                const float d = cpatch[row * 17 + (S.meta >> 7)];
                if (S.valid && kc == 0) { const int tg = tg0 + (S.meta >> 7); const float av = gelu_erf(d * S.su * S.xs) * S.gt * S.sv;
                    const unsigned sl = (unsigned)(S.meta & 127);
                    const unsigned ab = __builtin_bit_cast(unsigned, av), eo = (unsigned)S.e << 3, mag = ab & 0x7FFFFFFFu;
                    const unsigned tq = mag > eo ? (mag - eo + 0x10000u) & 0xFFFE0000u : 0u;
                    ((unsigned*)ACT)[(((size_t)(tg >> 6) * 32 + (sl >> 2)) * 64 + (tg & 63)) * 4 + (sl & 3)] = (ab & 0x80000000u) | tq | eo; }
                LDS_WAIT(); asm volatile("" ::: "memory"); } };
            TSet A_, B_;
            load_tile(A_, 0);
#pragma unroll 1
            for (int t = 0; t < ntile; t += 2) { load_tile(B_, t + 1); compute_tile(A_, t); load_tile(A_, t + 2); compute_tile(B_, t + 1); }
            LDS_WAIT(); asm volatile("" ::: "memory");
        }
    }
}
__device__ __forceinline__ void gv_token(const unsigned char* Vc, const int* IDX, const float* ACT, const float* g2, float* X, int c, int tg, int lane) {
    const int g = lane >> 3, cl = lane & 7, b = tg >= SEQ ? 1 : 0;
    int iv[16]; float cv[16];
#pragma unroll
    for (int j = 0; j < 4; ++j) { const v4u a = *(const v4u*)(IDX + (size_t)tg * 128 + 16 * g + 4 * j); const f32x4 f = *(const f32x4*)(ACT + (size_t)tg * 128 + 16 * g + 4 * j);
        iv[4 * j] = (int)a.x; iv[4 * j + 1] = (int)a.y; iv[4 * j + 2] = (int)a.z; iv[4 * j + 3] = (int)a.w; cv[4 * j] = f.x; cv[4 * j + 1] = f.y; cv[4 * j + 2] = f.z; cv[4 * j + 3] = f.w; }
    float acc[16];
#pragma unroll
    for (int i = 0; i < 16; ++i) acc[i] = 0.f;
#pragma unroll
    for (int k0 = 0; k0 < 16; k0 += 8) {
        v4u seg[8];
#pragma unroll
        for (int k = 0; k < 8; ++k) seg[k] = *(const v4u*)(Vc + ((size_t)c * NEXP + iv[k0 + k]) * 128 + 16 * cl);
#pragma unroll
        for (int k = 0; k < 8; ++k) { float v[16]; unpack16_fp8(v, seg[k]);
#pragma unroll
            for (int i = 0; i < 16; ++i) acc[i] += v[i] * cv[k0 + k]; }
    }
#pragma unroll
    for (int o = 8; o < 64; o <<= 1) {
#pragma unroll
        for (int i = 0; i < 16; ++i) acc[i] += __shfl_xor(acc[i], o); }
    if (lane < 8) { float* xr = X + (size_t)tg * D + 128 * c + 16 * cl; const float* gg = g2 + b * 6144 + 128 * c + 16 * cl;
#pragma unroll
        for (int j = 0; j < 4; ++j) { const f32x4 g4 = *(const f32x4*)(gg + 4 * j); *(f32x4*)(xr + 4 * j) = *(const f32x4*)(xr + 4 * j) + g4 * (f32x4){acc[4 * j], acc[4 * j + 1], acc[4 * j + 2], acc[4 * j + 3]}; } }
}

__device__ __forceinline__ void phase_peer_gv_old(Frame& F, int layer) {
    KARGS;
    const int* IDX = WSP(int, WS_IDX); const float* ACT = WSP(float, WS_ACT);
    const unsigned char* Vc = WSP(unsigned char, WS_PV) + (size_t)layer * NEXP * 1024;
    const float* g2 = WSP(float, WS_MOD) + (size_t)layer * 2 * 6144 + 5120;
    float* X = OUTP; const int lane = F.lane;
    unsigned* heads = (unsigned*)F.ctl + CW_G2 + layer * 8 * 64;
    const int myx = (int)((unsigned)__builtin_amdgcn_s_getreg((3 << 11) | 20) & 7u);
    for (int k = 0; k < 8; ++k) { const int c = (myx + k) & 7;
        for (;;) { unsigned u = 0; if (lane == 0) u = atomicAdd(heads + c * 64, 1u); u = (unsigned)__builtin_amdgcn_readfirstlane((int)u);
            if (u >= (unsigned)(T / 8)) break;
#pragma unroll 1
            for (int i = 0; i < 8; ++i) gv_token(Vc, IDX, ACT, g2, X, c, (int)u * 8 + i, lane); } }
}
__device__ __forceinline__ void phase_peer_gv_l2(Frame& F, int layer) {
    KARGS;
    const int* IDX = WSP(int, WS_IDX); const float* ACT = WSP(float, WS_ACT);
    const unsigned char* Vc = WSP(unsigned char, WS_PV) + (size_t)layer * NEXP * 1024;
    const float* g2 = WSP(float, WS_MOD) + (size_t)layer * 2 * 6144 + 5120;
    float* X = OUTP;
    const int lane = F.lane, g = lane >> 3, cl = lane & 7;
    LAS unsigned* li_ = (LAS unsigned*)(F.lds + 8192 + F.wave * 8192);
    LAS float* la_ = (LAS float*)(F.lds + 8192 + F.wave * 8192 + 4096);
    unsigned* heads = (unsigned*)F.ctl + CW_G2 + layer * 8 * 64;
    const int myx = (int)((unsigned)__builtin_amdgcn_s_getreg((3 << 11) | 20) & 7u);
    for (int k = 0; k < 8; ++k) {
        const int c = (myx + k) & 7;
        for (;;) {
            unsigned u = 0; if (lane == 0) u = atomicAdd(heads + c * 64, 1u); u = (unsigned)__builtin_amdgcn_readfirstlane((int)u);
            if (u >= (unsigned)(T / 8)) break;
            const int tg = (int)u * 8 + g, b = tg >= SEQ ? 1 : 0;
#pragma unroll
            for (int j = 0; j < 4; ++j) { const v4u a = *(const v4u*)(IDX + (size_t)tg * 128 + 16 * cl + 4 * j); const f32x4 f = *(const f32x4*)(ACT + (size_t)tg * 128 + 16 * cl + 4 * j);
                *(LAS v4u*)(li_ + g * 128 + 16 * cl + 4 * j) = a; *(LAS f32x4*)(la_ + g * 128 + 16 * cl + 4 * j) = f; }
            LDS_WAIT(); asm volatile("" ::: "memory");
            f32x2 acc[8];
#pragma unroll
            for (int q = 0; q < 8; ++q) acc[q] = (f32x2){0.f, 0.f};
#pragma unroll 1
            for (int k0 = 0; k0 < 128; k0 += 16) {
                unsigned ei[16]; float ec[16]; v4u seg[16];
#pragma unroll
                for (int q4 = 0; q4 < 4; ++q4) { const v4u a = *(const LAS v4u*)(li_ + g * 128 + k0 + 4 * q4); const f32x4 f = *(const LAS f32x4*)(la_ + g * 128 + k0 + 4 * q4);
                    ei[4 * q4] = a.x; ei[4 * q4 + 1] = a.y; ei[4 * q4 + 2] = a.z; ei[4 * q4 + 3] = a.w; ec[4 * q4] = f.x; ec[4 * q4 + 1] = f.y; ec[4 * q4 + 2] = f.z; ec[4 * q4 + 3] = f.w; }
#pragma unroll
                for (int kk = 0; kk < 16; ++kk) seg[kk] = *(const v4u*)(Vc + ((size_t)c * NEXP + ei[kk]) * 128 + 16 * cl);
#pragma unroll
                for (int kk = 0; kk < 16; ++kk) { const float cf = ec[kk]; const f32x2 cf2 = (f32x2){cf, cf};
#pragma unroll
                    for (int j = 0; j < 4; ++j) { acc[2 * j] += __builtin_amdgcn_cvt_pk_f32_fp8((int)seg[kk][j], false) * cf2; acc[2 * j + 1] += __builtin_amdgcn_cvt_pk_f32_fp8((int)seg[kk][j], true) * cf2; } }
            }
            float* xr = X + (size_t)tg * D + 128 * c + 16 * cl; const float* gg = g2 + b * 6144 + 128 * c + 16 * cl;
#pragma unroll
            for (int j = 0; j < 4; ++j) { const f32x4 g4 = *(const f32x4*)(gg + 4 * j);
                *(f32x4*)(xr + 4 * j) = *(const f32x4*)(xr + 4 * j) + g4 * (f32x4){acc[2 * j].x, acc[2 * j].y, acc[2 * j + 1].x, acc[2 * j + 1].y}; }
            LDS_WAIT(); asm volatile("" ::: "memory");
        }
    }
}

__device__ __forceinline__ void phase_peer_gv(Frame& F, int layer) {
    KARGS;
    const unsigned* ACTP = WSP(unsigned, WS_ACT);
    const unsigned char* PV8 = WSP(unsigned char, WS_PV) + (size_t)layer * NEXP * 1024;
    const float* g2 = WSP(float, WS_MOD) + (size_t)layer * 2 * 6144 + 5120;
    float* X = OUTP;
    const int lane = F.lane, tid = F.tid;
    for (int u = F.bid; u < 256; u += F.G) {
        const int xq = u >> 3, c = 4 * (4 * (u & 7) + (xq >> 3)) + (xq & 3), hf = (xq >> 2) & 1;
        if (u != F.bid) __syncthreads();
        {   const v4u* src = (const v4u*)(PV8 + (size_t)c * NEXP * 8);
            v4u t[16];
#pragma unroll
            for (int i = 0; i < 16; ++i) t[i] = src[i * NTHR + tid];
#pragma unroll
            for (int i = 0; i < 16; ++i) *(LAS v4u*)(F.lds + (size_t)(i * NTHR + tid) * 16) = t[i]; }
        __syncthreads();
        const float* gg = g2 + hf * 6144 + 8 * c;
        const f32x4 ga = *(const f32x4*)gg, gb = *(const f32x4*)(gg + 4);
        const unsigned lbase = (unsigned)(size_t)F.lds; __builtin_assume(lbase == 0u);
        constexpr int NBLK = 128 / NWAVES;
        auto wptr = [&](int i, int j) { return (const v4u*)(ACTP + (((size_t)(hf * 128 + F.wave + NWAVES * i) * 32 + j * 4) * 64 + lane) * 4); };
        v4u w[4][4];
#pragma unroll
        for (int jj = 0; jj < 4; ++jj) { const v4u* wp = wptr(0, jj);
#pragma unroll
            for (int g = 0; g < 4; ++g) w[jj][g] = wp[g * 64]; }
        v2u v[2][16];
#pragma unroll
        for (int kk = 0; kk < 16; ++kk) v[0][kk] = *(const LAS v2u*)(unsigned)((w[0][kk >> 2][kk & 3] & 0x1FFF8u) + lbase);
#pragma unroll 1
        for (int i = 0; i < NBLK; ++i) {
            float* xr = X + (size_t)((hf * 128 + F.wave + NWAVES * i) * 64 + lane) * D + 8 * c;
            const f32x4 x0 = *(const f32x4*)xr, x1 = *(const f32x4*)(xr + 4);
            const int inx = i + 1 < NBLK ? i + 1 : i;
            f32x2 acc[4];
#pragma unroll
            for (int q = 0; q < 4; ++q) acc[q] = (f32x2){0.f, 0.f};
#pragma unroll
            for (int j = 0; j < 8; ++j) {
#pragma unroll
                for (int kk = 0; kk < 16; ++kk) v[(j + 1) & 1][kk] = *(const LAS v2u*)(unsigned)((w[(j + 1) & 3][kk >> 2][kk & 3] & 0x1FFF8u) + lbase);
                asm volatile("" ::: "memory");
#pragma unroll
                for (int kk = 0; kk < 16; ++kk) {
                    const v4u wq = w[j & 3][kk >> 2]; v2u pr; pr.x = (kk & 2) ? wq.z : wq.x; pr.y = (kk & 2) ? wq.w : wq.y;
                    const f32x2 f0 = __builtin_amdgcn_cvt_pk_f32_fp8((int)v[j & 1][kk].x, false), f1 = __builtin_amdgcn_cvt_pk_f32_fp8((int)v[j & 1][kk].x, true);
                    const f32x2 f2 = __builtin_amdgcn_cvt_pk_f32_fp8((int)v[j & 1][kk].y, false), f3 = __builtin_amdgcn_cvt_pk_f32_fp8((int)v[j & 1][kk].y, true);
                    if (kk & 1) {
                        asm("v_pk_fma_f32 %0, %1, %2, %0 op_sel:[1,0,0] op_sel_hi:[1,1,1]" : "+v"(acc[0]) : "v"(pr), "v"(f0)); asm("v_pk_fma_f32 %0, %1, %2, %0 op_sel:[1,0,0] op_sel_hi:[1,1,1]" : "+v"(acc[1]) : "v"(pr), "v"(f1));
                        asm("v_pk_fma_f32 %0, %1, %2, %0 op_sel:[1,0,0] op_sel_hi:[1,1,1]" : "+v"(acc[2]) : "v"(pr), "v"(f2)); asm("v_pk_fma_f32 %0, %1, %2, %0 op_sel:[1,0,0] op_sel_hi:[1,1,1]" : "+v"(acc[3]) : "v"(pr), "v"(f3));
                    } else {
                        asm("v_pk_fma_f32 %0, %1, %2, %0 op_sel_hi:[0,1,1]" : "+v"(acc[0]) : "v"(pr), "v"(f0)); asm("v_pk_fma_f32 %0, %1, %2, %0 op_sel_hi:[0,1,1]" : "+v"(acc[1]) : "v"(pr), "v"(f1));
                        asm("v_pk_fma_f32 %0, %1, %2, %0 op_sel_hi:[0,1,1]" : "+v"(acc[2]) : "v"(pr), "v"(f2)); asm("v_pk_fma_f32 %0, %1, %2, %0 op_sel_hi:[0,1,1]" : "+v"(acc[3]) : "v"(pr), "v"(f3)); } }
                asm volatile("" ::: "memory");
                { const v4u* wp = j + 4 < 8 ? wptr(i, j + 4) : wptr(inx, j - 4);
#pragma unroll
                  for (int g = 0; g < 4; ++g) w[j & 3][g] = wp[g * 64]; }
                asm volatile("" ::: "memory");
            }
            *(f32x4*)xr = x0 + ga * (f32x4){acc[0].x, acc[0].y, acc[1].x, acc[1].y};
            *(f32x4*)(xr + 4) = x1 + gb * (f32x4){acc[2].x, acc[2].y, acc[3].x, acc[3].y};
        }
    }
}

__device__ __forceinline__ void phase_final(Frame& F) {
    KARGS;
    float* X = OUTP; const float* gain = IN(31);
    const int lane = F.lane, gw = F.bid * NWAVES + F.wave, NGW = F.G * NWAVES;
    f32x4 gn[4];
#pragma unroll
    for (int j = 0; j < 4; ++j) gn[j] = *(const f32x4*)(gain + 256 * j + 4 * lane);
    for (int row = gw; row < T; row += NGW) {
        float* xr = X + (size_t)row * D + 4 * lane;
        f32x4 v[4]; float ss = 0.f;
#pragma unroll
        for (int j = 0; j < 4; ++j) { v[j] = *(const f32x4*)(xr + 256 * j); ss += (v[j].x * v[j].x + v[j].y * v[j].y) + (v[j].z * v[j].z + v[j].w * v[j].w); }
        const float rstd = rsqrtf(wave_sum(ss) * (1.f / D) + NORM_EPS);
#pragma unroll
        for (int j = 0; j < 4; ++j) *(f32x4*)(xr + 256 * j) = v[j] * rstd * gn[j];
    }
}

#ifndef TS_LMASK
#define TS_LMASK 15
#endif
#ifndef PROBE_PARTS
#define PROBE_PARTS 3
#endif
#ifndef PROBE_DUP
#define PROBE_DUP 0
#endif
#ifndef PH_MASK
#define PH_MASK 0xFFFF
#endif
#define PH_EN(k) ((PH_MASK >> (k)) & 1)
constexpr int NPH = 50;
__host__ __device__ inline bool phase_skipped(int p) { if (p == 0 || p == NPH - 1) return false; const int layer = (p - 1) / 12, step = (p - 1) % 12;
    if (step == 9) return true;
    return (layer & 1) == 0 && (step == 3 || step == 4 || step == 5); }
__global__ void __launch_bounds__(NTHR, 2) mk_fwd(Args args) {
    extern __shared__ __attribute__((aligned(16))) unsigned char lds[];
    Frame F;
    F.lds = (LAS unsigned char*)lds;
    F.MISC = (volatile LAS unsigned*)(F.lds + MISC_OFF);
    F.tid = threadIdx.x; F.lane = F.tid & 63; F.wave = __builtin_amdgcn_readfirstlane(F.tid >> 6);
    F.G = gridDim.x; F.bid = blockIdx.x;
    F.ctl = (gu32*)(args.ws + WS_CTL);
    for (int u = F.tid; u < (LDS_BYTES - MISC_OFF) / 4; u += NTHR) ((LAS unsigned*)(F.lds + MISC_OFF))[u] = 0u;
    __syncthreads();
    XcdBarrier bar; bar.bar = (unsigned*)(F.ctl + CW_BAR); bar.x = 0; bar.st = nullptr;
    const int lo = args.ph_lo, hi = args.ph_hi;
    if (hi - lo > 1) bar = xcd_barrier_post((unsigned*)(F.ctl + CW_BAR), F.MISC + 8);
    bool ran = false;
#ifdef TS_STEP
    unsigned long long ts_acc = 0ull;
#endif
    for (int p = lo; p < hi; ++p) {
        if (phase_skipped(p)) continue;
        if (ran) xcd_barrier(bar);
        ran = true;
        { int t_ = threadIdx.x; asm volatile("" : "+v"(t_)); F.tid = t_; F.lane = t_ & 63; F.wave = __builtin_amdgcn_readfirstlane(t_ >> 6);
          int b_ = blockIdx.x, g_ = gridDim.x; asm volatile("" : "+s"(b_), "+s"(g_)); F.bid = b_; F.G = g_; }
#ifdef TS_STEP
        const bool ts_sel = (p == 0) ? (TS_STEP == 100) : (((p - 1) % 12) == TS_STEP && ((TS_LMASK >> ((p - 1) / 12)) & 1));
        unsigned long long ts0 = 0ull; if (ts_sel) ts0 = __builtin_amdgcn_s_memrealtime();
#define TS_END() do { if (ts_sel) { xcd_barrier(bar); ts_acc += __builtin_amdgcn_s_memrealtime() - ts0; } } while (0)
#else
#define TS_END() do {} while (0)
#endif
        if (p == 0) { if (PH_EN(0)) {
#if (PROBE_DUP >> 0) & 1
            phase_prologue(F); __syncthreads();
#endif
            phase_prologue(F); } TS_END(); continue; }
        if (p == NPH - 1) { if (PH_EN(1)) phase_final(F); continue; }
        const int layer = (p - 1) / 12, step = (p - 1) % 12; const bool odd = layer & 1;
        KARGS;
        if (step == 0 || step == 7) { if (PH_EN(2)) {
#if (PROBE_DUP >> 2) & 1
            phase_norm(F, layer, step == 7 ? 1 : 0);
#endif
            phase_norm(F, layer, step == 7 ? 1 : 0); } }
        else if (step == 1 || step == 8) { if (PH_EN(3)) {
            const int N = step == 8 ? 2048 : (odd ? ODD_N : EVEN_IN);
            const bf16* Bt = step == 8 ? WSP(bf16, WS_WQ + (size_t)layer * 4 * MiB) : WSP(bf16, WS_WIN + (size_t)layer * 8 * MiB);
            bf16* O = step == 8 ? WSP(bf16, WS_Q) : WSP(bf16, WS_PROJ);
            pg8::Gemm g{WSP(bf16, WS_H), Bt, T, N, D}; pg8::StaticOrder S; S.init(T, N, F.G, F.bid);
            pg8::EpiBf16<0> E{O, N, nullptr, 0, 0, 1.f};
#if (PROBE_DUP >> 3) & 1
            pg8::gemm_phase<pg8::EpiBf16<0>, pg8::StaticOrder, PG8_ALIGN, PG8_SP2>(F.lds + RING_OFF, g, S, E); __syncthreads();
#endif
            pg8::gemm_phase<pg8::EpiBf16<0>, pg8::StaticOrder, PG8_ALIGN, PG8_SP2>(F.lds + RING_OFF, g, S, E);
            if (step == 8) { asm volatile("s_waitcnt vmcnt(0)" ::: "memory"); __syncthreads(); phase_peer_topk<true>(F, layer, S); }
        } }
        else if (step == 2) { if (odd) { if (PH_EN(4)) {
#if (PROBE_DUP >> 4) & 1
            phase_odd_prep(F, layer, PROBE_PARTS); xcd_barrier(bar);
#endif
            phase_odd_prep(F, layer, 7); } } else { if (PH_EN(5)) {
#if (PROBE_DUP >> 5) & 1
            phase_even_mixer(F, layer);
#endif
            phase_even_mixer(F, layer); } } }
        else if (step == 3) { if (PH_EN(11)) {
#if (PROBE_DUP >> 11) & 1
            phase_rwkv_chunk(F, layer, 2048, PROBE_PARTS); xcd_barrier(bar);
#endif
            phase_rwkv_chunk(F, layer); } }
        else if (step == 4) { if (PH_EN(6)) {
#if (PROBE_DUP >> 6) & 1
            phase_odd_main(F, layer, CW_WORK2, PROBE_PARTS); xcd_barrier(bar);
#endif
            phase_odd_main(F, layer, CW_WORK, 3); } }
        else if (step == 5) { if (PH_EN(7)) {
#if (PROBE_DUP >> 7) & 1
            phase_rwkv_post(F, layer);
#endif
            phase_rwkv_post(F, layer); } }
        else if (step == 6) { if (PH_EN(8)) {
            pg8::Gemm g{WSP(bf16, WS_MIX), WSP(bf16, WS_WOUT + (size_t)layer * 2 * MiB), T, D, D}; pg8::StaticOrder S; S.init(T, D, F.G, F.bid);
            pg8::EpiResid E{layer == 0 ? IN(0) : OUTP, OUTP, WSP(float, WS_MOD) + (size_t)layer * 2 * 6144 + 2048, 6144};
            pg8::gemm_phase<pg8::EpiResid, pg8::StaticOrder, PG8_ALIGN, PG8_SP2>(F.lds + RING_OFF, g, S, E);
        } }
        else if (step == 9) { }
        else if (step == 10) { if (PH_EN(10)) {
#ifdef GU_VALU
            phase_peer_gu_valu(F, layer);
#else
            phase_peer_gu(F, layer);
#endif
            } }
        else { if (PH_EN(12)) {
#ifdef GV_OLD
            phase_peer_gv_old(F, layer);
#else
            phase_peer_gv(F, layer);
#endif
            } }
        TS_END();
    }
#ifdef TS_STEP
    if (blockIdx.x == 0 && threadIdx.x == 0) args.out[0] = (float)ts_acc;
#endif
}

extern "C" void kernel_launch(void* const* d_in, const int* in_sizes, int n_in, void* d_out, int out_size, void* d_ws, size_t ws_size, hipStream_t stream) {
    static int grid = 0;
    if (grid == 0) {
        if (n_in != 32 || in_sizes[0] != T * D || out_size != T * D || ws_size < WS_END) { fprintf(stderr, "kernel_launch: unexpected shapes (n_in %d, in0 %d, out %d, ws %zu < %zu); nothing launched\n", n_in, n_in > 0 ? in_sizes[0] : -1, out_size, ws_size, (size_t)WS_END); grid = -1; return; }
        int dev = 0, cus = 0, per_cu = 0;
        if (hipGetDevice(&dev) != hipSuccess || hipDeviceGetAttribute(&cus, hipDeviceAttributeMultiprocessorCount, dev) != hipSuccess) { grid = -1; return; }
        if (hipFuncSetAttribute((const void*)mk_fwd, hipFuncAttributeMaxDynamicSharedMemorySize, LDS_BYTES) != hipSuccess) { fprintf(stderr, "kernel_launch: hipFuncSetAttribute failed\n"); grid = -1; return; }
        if (hipOccupancyMaxActiveBlocksPerMultiprocessor(&per_cu, (const void*)mk_fwd, NTHR, LDS_BYTES) != hipSuccess || per_cu < 1) fprintf(stderr, "kernel_launch: occupancy query reports %d workgroups per CU\n", per_cu);
        (void)hipGetLastError();
        grid = cus;
    }
    if (grid < 0) return;
    if (hipMemsetAsync((char*)d_ws + WS_CTL, 0, CTL_ZERO_BYTES, stream) != hipSuccess) { fprintf(stderr, "kernel_launch: hipMemsetAsync failed\n"); return; }
    Args a{};
    for (int i = 0; i < 32; ++i) a.in[i] = (const float*)d_in[i];
    a.out = (float*)d_out; a.ws = (unsigned char*)d_ws;
#if MK_ONE_LAUNCH
    a.ph_lo = 0; a.ph_hi = NPH;
    hipLaunchKernelGGL(mk_fwd, dim3(grid), dim3(NTHR), LDS_BYTES, stream, a);
#else
    for (int p = 0; p < NPH; ++p) { if (phase_skipped(p)) continue; a.ph_lo = p; a.ph_hi = p + 1;
        hipLaunchKernelGGL(mk_fwd, dim3(grid), dim3(NTHR), LDS_BYTES, stream, a); }
#endif
    const hipError_t le = hipPeekAtLastError();
    if (le != hipSuccess) fprintf(stderr, "kernel_launch: launch failed: %s\n", hipGetErrorName(le));
}
```

```cpp
#include <hip/hip_runtime.h>
#include <cstdio>
#include <cstdint>
namespace pg8 {
#define PG8_LAS __attribute__((address_space(3)))
typedef unsigned short bf16_t;
typedef short bf16x8 __attribute__((ext_vector_type(8)));
typedef float f32x4 __attribute__((ext_vector_type(4)));
typedef unsigned u32x4 __attribute__((ext_vector_type(4)));
constexpr int BM = 256, BK = 64, HALF = 128, HTB = HALF * BK * 2  , STAGE_BYTES = 8 * HTB, NXCD = 8, WGM = 8;

__host__ __device__ __forceinline__ int lds_byte(int r, int c) { const int st = (r >> 4) * 2 + (c >> 5), rr = r & 15, cc = c & 31, ob = rr * 64 + cc * 2; return st * 1024 + (ob ^ (((ob >> 9) & 1) << 5)); }
__host__ __device__ __forceinline__ void stage_rc(int b, int& R, int& C) { const int st = b / 1024, sb = b % 1024, swz = sb ^ (((sb >> 9) & 1) << 5); R = (st >> 1) * 16 + swz / 64; C = (st & 1) * 32 + (swz % 64) / 2; }
__host__ __device__ __forceinline__ int perm32(int rho) { const int n = rho >> 4, i = rho & 15; return 8 * (i >> 2) + 4 * n + (i & 3); }

struct Unit { int pm, pn; };
struct Gemm { const bf16_t* A; const bf16_t* Bt; int M, N, K; };

struct StaticOrder {
    int nM, nN, nwg, G, c;
    __host__ __device__ void init(int M, int N, int G_, int c_) { nM = M / BM; nN = N / BM; nwg = nM * nN; G = G_; c = c_; }
    __host__ __device__ bool next(int i, Unit& u) const {
        const long L = (long)i * G + c; if (L >= nwg) return false;
        int wgid = (int)L; { const int q = nwg / NXCD, r = nwg % NXCD, xcd = wgid % NXCD, off = wgid / NXCD; wgid = (xcd < r ? xcd * (q + 1) : r * (q + 1) + (xcd - r) * q) + off; }
        const int nig = WGM * nN, gid = wgid / nig, fm = gid * WGM, gsz = (nM - fm) < WGM ? (nM - fm) : WGM;
        u.pm = fm + ((wgid % nig) % gsz); u.pn = (wgid % nig) / gsz; return true;
    }
    __device__ __forceinline__ void a_ready(const Unit&) const {}
    __device__ __forceinline__ void done(const Unit&) const {}
};

__device__ __forceinline__ unsigned cvt_pk_bf16(float lo, float hi) { unsigned r; asm volatile("v_cvt_pk_bf16_f32 %0, %1, %2" : "=v"(r) : "v"(lo), "v"(hi)); return r; }
typedef float f32x2 __attribute__((ext_vector_type(2)));
__device__ __forceinline__ f32x2 gelu_pk(f32x2 v) {
    const f32x2 av = __builtin_elementwise_abs(v), d = av * 0.2316418882f + 1.0f;
    f32x2 t; t.x = __builtin_amdgcn_rcpf(d.x); t.y = __builtin_amdgcn_rcpf(d.y);
    f32x2 q = t * 0.5307027145f + (-0.7265760135f); q = q * t + 0.7107068705f; q = q * t + (-0.142248368f); q = q * t + 0.127414796f; q = q * t;
    const f32x2 s = (v * v) * (-0.72134752044f);
    f32x2 e; e.x = __builtin_amdgcn_exp2f(s.x); e.y = __builtin_amdgcn_exp2f(s.y);
    const f32x2 m = v * (q * e), r = v - m;
    f32x2 o; o.x = v.x < 0.f ? m.x : r.x; o.y = v.y < 0.f ? m.y : r.y; return o;
}

template <int ACT  > struct EpiBf16 {
    static constexpr bool PERM = true, AFTER_DRAIN = false; static_assert(ACT == 0 || ACT == 1, "EpiBf16: ACT is 0 (none) or 1 (gelu_pk)");
    bf16_t* O; int ldc; const float* bias; int split_cols; size_t split_stride; float scale0;
    __device__ __forceinline__ void operator()(const f32x4 (&acc)[2][2][4][2], const Unit& u, int wr, int wc, int fr, int fq) const {
        const int row0 = u.pm * BM + wr * 64 + fr; int colt = u.pn * BM; bf16_t* base = O;
        float sc = 1.f; if (split_cols) { const int t = colt / split_cols; base += (size_t)t * split_stride; colt -= t * split_cols; if (t == 0) sc = scale0; }
        const int col0 = colt + wc * 32 + 8 * fq, bcol0 = u.pn * BM + wc * 32 + 8 * fq;
        f32x4 bv[2][2];
#pragma unroll
        for (int bj = 0; bj < 2; ++bj)
#pragma unroll
            for (int n = 0; n < 2; ++n) bv[bj][n] = bias ? *(const f32x4*)(bias + bcol0 + bj * HALF + 4 * n) : (f32x4){0.f, 0.f, 0.f, 0.f};
#pragma unroll
        for (int ai = 0; ai < 2; ++ai)
#pragma unroll
            for (int m = 0; m < 4; ++m) { bf16_t* rowp = base + (size_t)(row0 + ai * HALF + m * 16) * ldc + col0;
#pragma unroll
                for (int bj = 0; bj < 2; ++bj) { f32x4 v0 = acc[ai][bj][m][0] + bv[bj][0], v1 = acc[ai][bj][m][1] + bv[bj][1];
                    if (ACT == 1) { f32x2 a = gelu_pk((f32x2){v0[0], v0[1]}), b = gelu_pk((f32x2){v0[2], v0[3]}), c = gelu_pk((f32x2){v1[0], v1[1]}), d = gelu_pk((f32x2){v1[2], v1[3]});
                        v0 = (f32x4){a.x, a.y, b.x, b.y}; v1 = (f32x4){c.x, c.y, d.x, d.y}; }
                    v0 = v0 * sc; v1 = v1 * sc; u32x4 w; w.x = cvt_pk_bf16(v0[0], v0[1]); w.y = cvt_pk_bf16(v0[2], v0[3]); w.z = cvt_pk_bf16(v1[0], v1[1]); w.w = cvt_pk_bf16(v1[2], v1[3]);
                    *(u32x4*)(rowp + bj * HALF) = w; } }
    }
};
struct EpiResid {
    static constexpr bool PERM = false, AFTER_DRAIN = false;
    const float* base; float* out; const float* gate; int gstride;
    __device__ __forceinline__ void operator()(const f32x4 (&acc)[2][2][4][2], const Unit& u, int wr, int wc, int fr, int fq) const {
        const int row0 = u.pm * BM + wr * 64 + fr; const int col0 = u.pn * BM + wc * 32 + 4 * fq;
        const float* gp = gate + ((u.pm * BM) >= 8192 ? gstride : 0);
        f32x4 gv[2][2];
#pragma unroll
        for (int bj = 0; bj < 2; ++bj)
#pragma unroll
            for (int n = 0; n < 2; ++n) gv[bj][n] = *(const f32x4*)(gp + col0 + bj * HALF + n * 16);
#pragma unroll
        for (int ai = 0; ai < 2; ++ai)
#pragma unroll
            for (int m = 0; m < 4; ++m) { const size_t off = (size_t)(row0 + ai * HALF + m * 16) * 1024 + col0;
#pragma unroll
                for (int bj = 0; bj < 2; ++bj)
#pragma unroll
                    for (int n = 0; n < 2; ++n) { const f32x4 bs = *(const f32x4*)(base + off + bj * HALF + n * 16);
                        *(f32x4*)(out + off + bj * HALF + n * 16) = bs + gv[bj][n] * acc[ai][bj][m][n]; } }
    }
};
template <class Epi, class Sched, bool ALIGN_EPI = false, bool SP2 = false>
__device__ __forceinline__ void gemm_phase(PG8_LAS unsigned char* lds, const Gemm g, const Sched& S, const Epi& E) {
    int tid_l = threadIdx.x; asm volatile("" : "+v"(tid_l));
    const int tid = tid_l, wid = __builtin_amdgcn_readfirstlane(tid >> 6), lane = tid & 63, wr = wid >> 2, wc = wid & 3, fr = lane & 15, fq = lane >> 4;
    const int K = g.K, nt = K / BK;
    unsigned voffA[2], voffB[2];
#pragma unroll
    for (int i = 0; i < 2; ++i) { int R, C; stage_rc(tid * 16 + i * 8192, R, C); const int Rb = Epi::PERM ? ((R & ~31) + perm32(R & 31)) : R;
        voffA[i] = (unsigned)(R * K + C) * 2u; voffB[i] = (unsigned)(Rb * K + C) * 2u; }
    const size_t kstep = (size_t)(BK * 2);
    const size_t hstep = (size_t)HALF * K * 2;
    const size_t tstep = 2 * hstep;
    const unsigned ldsw = (unsigned)wid * 1024u;
    const int aoff = lds_byte(wr * 64 + fr, fq * 8), boff = lds_byte(wc * 32 + fr, fq * 8);
#define PG8_SA(b, h) (((b) * 2 + (h)) * HTB)
#define PG8_SB(b, h) ((4 + (b) * 2 + (h)) * HTB)
#define PG8_STAGE(bufoff, gbase, voff) do { _Pragma("unroll") for (int _i = 0; _i < 2; ++_i) \
        __builtin_amdgcn_global_load_lds((const unsigned*)((const char*)(gbase) + (voff)[_i]), (PG8_LAS unsigned*)(lds + (bufoff) + ldsw + _i * 8192), 16, 0, 0); } while (0)
#define PG8_LDA(dst, b, h) do { _Pragma("unroll") for (int m = 0; m < 4; ++m) _Pragma("unroll") for (int k = 0; k < 2; ++k) dst[m][k] = *(const PG8_LAS bf16x8*)(lds + PG8_SA(b, h) + aoff + m * 2048 + k * 1024); } while (0)
#define PG8_LDB(dst, b, h) do { _Pragma("unroll") for (int n = 0; n < 2; ++n) _Pragma("unroll") for (int k = 0; k < 2; ++k) dst[n][k] = *(const PG8_LAS bf16x8*)(lds + PG8_SB(b, h) + boff + n * 2048 + k * 1024); } while (0)
#define PG8_MMA(ai, bj, At, Bt) do { __builtin_amdgcn_s_setprio(1); _Pragma("unroll") for (int m = 0; m < 4; ++m) _Pragma("unroll") for (int n = 0; n < 2; ++n) _Pragma("unroll") for (int k = 0; k < 2; ++k) \
        acc[ai][bj][m][n] = __builtin_amdgcn_mfma_f32_16x16x32_bf16(Bt[n][k], At[m][k], acc[ai][bj][m][n], 0, 0, 0); __builtin_amdgcn_s_setprio(0); } while (0)
#define PG8_WAIT_V(n) asm volatile("s_waitcnt vmcnt(" #n ")" ::: "memory")
#define PG8_WAIT_L(n) asm volatile("s_waitcnt lgkmcnt(" #n ")" ::: "memory")
#define PG8_BAR __builtin_amdgcn_s_barrier()
#define PG8_SCHED __builtin_amdgcn_sched_barrier(0)
    Unit cur, nxt; int ui = 0;
    if (!S.next(0, cur)) return;
    f32x4 acc[2][2][4][2];
#pragma unroll
    for (int a = 0; a < 2; ++a)
#pragma unroll
        for (int b = 0; b < 2; ++b)
#pragma unroll
            for (int m = 0; m < 4; ++m)
#pragma unroll
                for (int n = 0; n < 2; ++n) acc[a][b][m][n] = (f32x4){0.f, 0.f, 0.f, 0.f};
    bf16x8 At[4][2], B0[2][2], B1[2][2];
    const char* cA = (const char*)g.A + (size_t)cur.pm * tstep; const char* cB = (const char*)g.Bt + (size_t)cur.pn * tstep;
    S.a_ready(cur);
    if constexpr (SP2) {
        PG8_STAGE(PG8_SB(0, 0), cB, voffB); PG8_STAGE(PG8_SB(0, 1), cB + hstep, voffB); PG8_STAGE(PG8_SA(0, 0), cA, voffA); PG8_STAGE(PG8_SA(0, 1), cA + hstep, voffA);
        if (wr == 1) PG8_BAR;
        PG8_WAIT_V(2); PG8_BAR;
        PG8_STAGE(PG8_SB(1, 0), cB + kstep, voffB); PG8_STAGE(PG8_SA(1, 0), cA + kstep, voffA); PG8_STAGE(PG8_SB(1, 1), cB + hstep + kstep, voffB);
        PG8_WAIT_V(6); PG8_BAR;
    } else {
        PG8_STAGE(PG8_SB(0, 0), cB, voffB); PG8_STAGE(PG8_SA(0, 0), cA, voffA); PG8_STAGE(PG8_SB(0, 1), cB + hstep, voffB); PG8_STAGE(PG8_SA(0, 1), cA + hstep, voffA);
        if (wr == 1) PG8_BAR;
        PG8_WAIT_V(4); PG8_BAR;
        PG8_STAGE(PG8_SB(1, 0), cB + kstep, voffB); PG8_STAGE(PG8_SA(1, 0), cA + kstep, voffA); PG8_STAGE(PG8_SB(1, 1), cB + hstep + kstep, voffB);
        PG8_WAIT_V(6); PG8_BAR;
    }
    for (;;) {
        const bool has_next = S.next(ui + 1, nxt);
        const char* nA = has_next ? (const char*)g.A + (size_t)nxt.pm * tstep : cA; const char* nB = has_next ? (const char*)g.Bt + (size_t)nxt.pn * tstep : cB;
        for (int t = 0; t < nt; t += 2) {
            const bool last = (t == nt - 2);
            const char* a1 = cA + (size_t)(t + 1) * kstep;
            const char* a2 = last ? nA : cA + (size_t)(t + 2) * kstep; const char* b2 = last ? nB : cB + (size_t)(t + 2) * kstep;
            const char* a3 = a2 + kstep; const char* b3 = b2 + kstep;
            if (last && has_next) S.a_ready(nxt);
            if constexpr (SP2) {
            PG8_LDB(B0, 0, 0); PG8_LDB(B1, 0, 1); PG8_SCHED; PG8_LDA(At, 0, 0); PG8_STAGE(PG8_SA(1, 1), a1 + hstep, voffA);
            PG8_WAIT_V(8); PG8_WAIT_L(0); PG8_BAR; PG8_MMA(0, 0, At, B0); PG8_MMA(0, 1, At, B1); PG8_BAR; PG8_SCHED;
            PG8_LDA(At, 0, 1); PG8_STAGE(PG8_SB(0, 0), b2, voffB); PG8_STAGE(PG8_SB(0, 1), b2 + hstep, voffB); PG8_STAGE(PG8_SA(0, 0), a2, voffA);
            PG8_WAIT_V(8); PG8_WAIT_L(0); PG8_BAR; PG8_MMA(1, 0, At, B0); PG8_MMA(1, 1, At, B1); PG8_BAR; PG8_SCHED;
            PG8_LDB(B0, 1, 0); PG8_LDB(B1, 1, 1); PG8_SCHED; PG8_LDA(At, 1, 0); PG8_STAGE(PG8_SA(0, 1), a2 + hstep, voffA);
            PG8_WAIT_V(8); PG8_WAIT_L(0); PG8_BAR; PG8_MMA(0, 0, At, B0); PG8_MMA(0, 1, At, B1); PG8_BAR; PG8_SCHED;
            PG8_LDA(At, 1, 1); PG8_STAGE(PG8_SB(1, 0), b3, voffB); PG8_STAGE(PG8_SB(1, 1), b3 + hstep, voffB); PG8_STAGE(PG8_SA(1, 0), a3, voffA);
            PG8_WAIT_V(8); PG8_WAIT_L(0); PG8_BAR; PG8_MMA(1, 0, At, B0); PG8_MMA(1, 1, At, B1); PG8_BAR; PG8_SCHED;
            } else {
            PG8_LDB(B0, 0, 0); PG8_SCHED; PG8_LDA(At, 0, 0); PG8_STAGE(PG8_SA(1, 1), a1 + hstep, voffA);
            PG8_WAIT_L(8); PG8_BAR; PG8_WAIT_L(0); PG8_MMA(0, 0, At, B0); PG8_BAR; PG8_SCHED;
            PG8_LDB(B1, 0, 1); PG8_STAGE(PG8_SB(0, 0), b2, voffB);
            PG8_BAR; PG8_WAIT_L(0); PG8_MMA(0, 1, At, B1); PG8_BAR;
            PG8_LDA(At, 0, 1); PG8_STAGE(PG8_SA(0, 0), a2, voffA);
            PG8_BAR; PG8_WAIT_L(0); PG8_MMA(1, 0, At, B0); PG8_BAR; PG8_SCHED;
            PG8_STAGE(PG8_SB(0, 1), b2 + hstep, voffB);
            PG8_WAIT_V(6); PG8_BAR; PG8_MMA(1, 1, At, B1); PG8_BAR;
            PG8_LDB(B0, 1, 0); PG8_SCHED; PG8_LDA(At, 1, 0); PG8_STAGE(PG8_SA(0, 1), a2 + hstep, voffA);
            PG8_WAIT_L(8); PG8_BAR; PG8_WAIT_L(0); PG8_MMA(0, 0, At, B0); PG8_BAR; PG8_SCHED;
            PG8_LDB(B1, 1, 1); PG8_STAGE(PG8_SB(1, 0), b3, voffB);
            PG8_BAR; PG8_WAIT_L(0); PG8_MMA(0, 1, At, B1); PG8_BAR;
            PG8_LDA(At, 1, 1); PG8_STAGE(PG8_SA(1, 0), a3, voffA);
            PG8_BAR; PG8_WAIT_L(0); PG8_MMA(1, 0, At, B0); PG8_BAR; PG8_SCHED;
            PG8_STAGE(PG8_SB(1, 1), b3 + hstep, voffB);
            PG8_WAIT_V(6); PG8_BAR; PG8_MMA(1, 1, At, B1); PG8_BAR;
            }
        }
        if constexpr (ALIGN_EPI) { if (wr == 0) PG8_BAR; }
        if constexpr (!Epi::AFTER_DRAIN) { E(acc, cur, wr, wc, fr, fq); S.done(cur); }
        if (!has_next) break;
#pragma unroll
        for (int a = 0; a < 2; ++a)
#pragma unroll
            for (int b = 0; b < 2; ++b)
#pragma unroll
                for (int m = 0; m < 4; ++m)
#pragma unroll
                    for (int n = 0; n < 2; ++n) acc[a][b][m][n] = (f32x4){0.f, 0.f, 0.f, 0.f};
        cur = nxt; cA = nA; cB = nB; ++ui;
        if constexpr (ALIGN_EPI) { if (wr == 1) PG8_BAR; }
    }
    PG8_WAIT_V(0);
    if constexpr (!ALIGN_EPI) { if (wr == 0) PG8_BAR; }
    PG8_BAR;
    if constexpr (Epi::AFTER_DRAIN) { E.fused(acc, cur, wr, wc, fr, fq, lds, wid, lane); S.done(cur); }
#undef PG8_SA
#undef PG8_SB
#undef PG8_STAGE
#undef PG8_LDA
#undef PG8_LDB
#undef PG8_MMA
#undef PG8_WAIT_V
#undef PG8_WAIT_L
#undef PG8_BAR
#undef PG8_SCHED
}
}
#ifndef PG8_SP2
#define PG8_SP2 true
#endif
#ifndef PG8_ALIGN
#define PG8_ALIGN true
#endif
#ifndef MK_ONE_LAUNCH
#define MK_ONE_LAUNCH 1
#endif

constexpr int NWAVES = 8, NTHR = NWAVES * 64;
constexpr int BATCH = 2, SEQ = 8192, D = 1024, T = BATCH * SEQ, DEPTH = 4;
constexpr int EVEN_IN = 2048, ODD_LD = 3848, ODD_N = 3840;
constexpr int NEXP = 16384;
constexpr float NORM_EPS = 1e-6f, GN_EPS = 64e-5f;

constexpr size_t MiB = 1u << 20;
constexpr size_t WS_CTL = 0, CTL_ZERO_BYTES = 1 * MiB;
constexpr size_t WS_MOD = 1 * MiB;
constexpr size_t WS_WF = WS_MOD + 256 * 1024;
constexpr size_t WS_KEYS = WS_MOD + 512 * 1024;
constexpr size_t WS_LORA = 3 * MiB;
constexpr size_t WS_LOGF = 2 * MiB;
constexpr size_t WS_DCUM = 2 * MiB + 512 * 1024;
constexpr size_t WS_WIN = 4 * MiB;
constexpr size_t WS_WOUT = 36 * MiB;
constexpr size_t WS_WQ = 44 * MiB;
constexpr size_t WS_H = 64 * MiB;
constexpr size_t WS_MIX = 96 * MiB;
constexpr size_t WS_PROJ = 128 * MiB;
constexpr size_t WS_Q = 256 * MiB;
constexpr size_t WS_IDX = 320 * MiB;
constexpr size_t WS_GATE = 328 * MiB;
constexpr size_t WS_RW = 336 * MiB;
constexpr size_t RW_SLOT = 32 * MiB;
constexpr size_t WS_PU = WS_RW + 8 * RW_SLOT;
constexpr size_t WS_PV = WS_PU + 64 * MiB;
constexpr size_t WS_PS = WS_PV + 64 * MiB;
constexpr size_t WS_CG = WS_PS + 1 * MiB;
constexpr size_t WS_CQ = WS_CG + 16 * MiB;
constexpr size_t WS_CH = WS_CQ + 16 * MiB;
constexpr size_t WS_CY = WS_CH + 32 * MiB;
constexpr size_t WS_H8 = WS_CY + 32 * MiB;
constexpr size_t WS_HS = WS_H8 + 16 * MiB;
constexpr size_t WS_ACT = WS_HS + 1 * MiB;
constexpr size_t WS_END = WS_ACT + 8 * MiB;
constexpr int CW_WORK = 64;
constexpr int CW_WORK2 = 1024;
constexpr int CW_G1 = 24576, CW_G2 = 28672;
constexpr int CW_CHQ = 16384, CW_SCQ = 20480;
constexpr int CW_BAR = 4096;

constexpr int RING_OFF = 0, RING_BYTES = 131072;
constexpr int MISC_OFF = 159744;
constexpr int LDS_BYTES = 163840;

#define GAS __attribute__((address_space(1)))
#define LAS __attribute__((address_space(3)))
typedef unsigned short bf16;
typedef unsigned v4u __attribute__((ext_vector_type(4)));
typedef unsigned v2u __attribute__((ext_vector_type(2)));
typedef int v8i __attribute__((ext_vector_type(8)));
typedef float f32x4 __attribute__((ext_vector_type(4)));
typedef short bf16x8 __attribute__((ext_vector_type(8)));
typedef GAS unsigned gu32;
#define LDS_WAIT() asm volatile("s_waitcnt lgkmcnt(0)" ::: "memory")
#define VM_WAIT() asm volatile("s_waitcnt vmcnt(0)" ::: "memory")
#define LBAR() do { asm volatile("s_waitcnt lgkmcnt(0)" ::: "memory"); __builtin_amdgcn_s_barrier(); asm volatile("" ::: "memory"); } while (0)
typedef float f32x2_t __attribute__((ext_vector_type(2))); typedef __bf16 bf16x2_t __attribute__((ext_vector_type(2)));
__device__ __forceinline__ unsigned pk2(float lo, float hi) { const f32x2_t v = {lo, hi}; const bf16x2_t b = __builtin_convertvector(v, bf16x2_t); return __builtin_bit_cast(unsigned, b); }
__device__ __forceinline__ unsigned f2bf(float f) { return pk2(f, 0.f) & 0xffffu; }
__device__ __forceinline__ float bf2f(bf16 v) { return __builtin_bit_cast(float, (unsigned)v << 16); }
__device__ __forceinline__ float bflo(unsigned w) { return __builtin_bit_cast(float, w << 16); }
__device__ __forceinline__ float bfhi(unsigned w) { return __builtin_bit_cast(float, w & 0xffff0000u); }
__device__ __forceinline__ float wave_sum(float v) {
#pragma unroll
    for (int o = 1; o < 64; o <<= 1) v += __shfl_xor(v, o);
    return v;
}
__device__ __forceinline__ float wave_max(float v) {
#pragma unroll
    for (int o = 1; o < 64; o <<= 1) v = fmaxf(v, __shfl_xor(v, o));
    return v;
}
__device__ __forceinline__ float rl(float x, int j) { return __builtin_bit_cast(float, __builtin_amdgcn_readlane(__builtin_bit_cast(int, x), j)); }
__device__ __forceinline__ float sigmoidf_(float x) { return 1.f / (1.f + expf(-x)); }
__device__ __forceinline__ float softplusf_(float x) { return fmaxf(x, 0.f) + log1pf(expf(-fabsf(x))); }
__device__ __forceinline__ float gelu_erf(float x) { return 0.5f * x * (1.f + erff(x * 0.70710678118654752f)); }

#define XB_TMO      128
#define XB_XCNT(j)  (256  + 64 * (j))
#define XB_XSUB(j)  (1280 + 64 * (j))
#define XB_XGEN(j)  (2304 + 64 * (j))
#define XB_TOP      3328
#define XB_TOPGEN   3392
#define XCD_BAR_WORDS 3456
#define XB_SPIN_CAP (1u << 18)

__device__ __forceinline__ unsigned xb_ld(unsigned* p)              { return __hip_atomic_load(p, __ATOMIC_RELAXED, __HIP_MEMORY_SCOPE_AGENT); }
__device__ __forceinline__ unsigned xb_add(unsigned* p, unsigned v) { return __hip_atomic_fetch_add(p, v, __ATOMIC_RELAXED, __HIP_MEMORY_SCOPE_AGENT); }
__device__ __forceinline__ unsigned xb_xcc_id() { return (unsigned)__builtin_amdgcn_s_getreg((3 << 11) | 20) & 0xFu; }
#define XB_SPIN(cond, bar) do { unsigned _sp = 0; while (cond) { __builtin_amdgcn_s_sleep(1); \
    if ((++_sp & 255u) == 0u) { if (xb_ld(&(bar)[XB_TMO])) break; if (_sp > XB_SPIN_CAP) { atomicAdd(&(bar)[XB_TMO], 1u); break; } } } } while (0)

struct XcdBarrier {
    unsigned* bar; unsigned x;
    volatile LAS unsigned* st;
};

__device__ __forceinline__ XcdBarrier xcd_barrier_post(unsigned* bar, volatile LAS unsigned* st) {
    XcdBarrier b; b.bar = bar; b.x = xb_xcc_id(); b.st = st;
    if (threadIdx.x == 0) (void)xb_add(&bar[XB_XCNT(b.x)], 1u);
    return b;
}
__device__ __forceinline__ void xcd_barrier_complete(unsigned* bar, unsigned x, unsigned& nloc, unsigned& nx) {
    const unsigned G = gridDim.x * gridDim.y * gridDim.z;
    unsigned sum, cnt, mine, sp = 0u;
    for (;;) {
        sum = 0u; cnt = 0u; mine = 0u;
#pragma unroll
        for (unsigned j = 0; j < 16; ++j) { const unsigned c = xb_ld(&bar[XB_XCNT(j)]); sum += c; cnt += (c > 0u) ? 1u : 0u; mine = (j == x) ? c : mine; }
        if (sum == G) break;
        __builtin_amdgcn_s_sleep(1);
        if ((++sp & 255u) == 0u) { if (xb_ld(&bar[XB_TMO])) break; if (sp > XB_SPIN_CAP) { atomicAdd(&bar[XB_TMO], 1u); break; } }
    }
    nloc = mine > 0u ? mine : 1u; nx = cnt > 0u ? cnt : 1u;
}

__device__ __forceinline__ void xcd_barrier(const XcdBarrier& b) {
    asm volatile("s_waitcnt vmcnt(0)" ::: "memory");
    __syncthreads();
    if (threadIdx.x == 0) {
        unsigned* bar = b.bar;
        __builtin_amdgcn_s_waitcnt(0);
        unsigned nloc = b.st[0], nx = b.st[1];
        if (nloc == 0u) { xcd_barrier_complete(bar, b.x, nloc, nx); b.st[0] = nloc; b.st[1] = nx; }
        const unsigned old = xb_add(&bar[XB_XSUB(b.x)], 1u);
        const unsigned gen = old / nloc;
        if (old + 1u == (gen + 1u) * nloc) {
            __builtin_amdgcn_fence(__ATOMIC_RELEASE, "agent");
            asm volatile("s_waitcnt vmcnt(0)" ::: "memory");
            const unsigned og = xb_add(&bar[XB_TOP], 1u);
            const unsigned tg = og / nx;
            if (og + 1u == (tg + 1u) * nx) xb_add(&bar[XB_TOPGEN], 1u);
            else XB_SPIN(xb_ld(&bar[XB_TOPGEN]) == tg, bar);
            __builtin_amdgcn_fence(__ATOMIC_ACQUIRE, "agent");
            xb_add(&bar[XB_XGEN(b.x)], 1u);
            asm volatile("s_waitcnt vmcnt(0)" ::: "memory");
        } else {
            XB_SPIN(xb_ld(&bar[XB_XGEN(b.x)]) == gen, bar);
            __builtin_amdgcn_fence(__ATOMIC_ACQUIRE, "agent");
            asm volatile("s_waitcnt vmcnt(0)" ::: "memory");
        }
    }
    __syncthreads();
}


struct Frame {
    LAS unsigned char* lds;
    volatile LAS unsigned* MISC;
    gu32* ctl;
    int tid, lane, wave, G, bid;
};
struct Args { const float* in[32]; float* out; unsigned char* ws; int ph_lo, ph_hi; };
#define CAS __attribute__((address_space(4)))
#define KARGS const CAS Args* ka_; { unsigned long long kp_ = (unsigned long long)__builtin_amdgcn_kernarg_segment_ptr(); asm volatile("" : "+s"(kp_)); ka_ = (const CAS Args*)kp_; } unsigned char* const ws_ = ka_->ws
#define IN(i) (ka_->in[i])
#define OUTP (ka_->out)
#define WSP(type, off) ((type*)(ws_ + (off)))

template <int NR> __device__ __forceinline__ void conv_issue(const float* TU, const float* TV, int l, int row0, int NGW, int lane, f32x4 (&v)[NR][4]) {
#pragma unroll
    for (int q = 0; q < NR; ++q) { const int r = row0 + q * NGW; if (r < 2 * NEXP) { const int tb = r >= NEXP ? 1 : 0, e = r - tb * NEXP;
        const float* src = (tb ? TV : TU) + ((size_t)l * NEXP + e) * 1024 + 4 * lane;
#pragma unroll
        for (int j = 0; j < 4; ++j) v[q][j] = *(const f32x4*)(src + 256 * j); } }
}
template <int NR> __device__ __forceinline__ void conv_finish(unsigned char* PU, unsigned char* PV, float* PS, int l, int row0, int NGW, int lane, f32x4 (&v)[NR][4], LAS unsigned char* scr) {
#pragma unroll
    for (int q = 0; q < NR; ++q) { const int r = row0 + q * NGW; if (r < 2 * NEXP) { const int tb = r >= NEXP ? 1 : 0, e = r - tb * NEXP;
        if (tb) {
            float am = 0.f;
#pragma unroll
            for (int j = 0; j < 4; ++j) am = fmaxf(am, fmaxf(fmaxf(fabsf(v[q][j].x), fabsf(v[q][j].y)), fmaxf(fabsf(v[q][j].z), fabsf(v[q][j].w))));
            am = wave_max(am);
            const float sc = am > 0.f ? am * (1.f / 224.f) : 1.f, inv = 1.f / sc;
#pragma unroll
            for (int j = 0; j < 4; ++j) { int w = 0; w = __builtin_amdgcn_cvt_pk_fp8_f32(v[q][j].x * inv, v[q][j].y * inv, w, false); w = __builtin_amdgcn_cvt_pk_fp8_f32(v[q][j].z * inv, v[q][j].w * inv, w, true);
                const int c = 32 * j + (lane >> 1);
                *(int*)(PV + ((size_t)(l * 128 + c) * NEXP + e) * 8 + 4 * (lane & 1)) = w; }
            if (lane == 0) PS[4 * NEXP + l * NEXP + e] = sc;
        } else {
#pragma unroll
            for (int j = 0; j < 4; ++j) {
                float am = fmaxf(fmaxf(fabsf(v[q][j].x), fabsf(v[q][j].y)), fmaxf(fabsf(v[q][j].z), fabsf(v[q][j].w)));
                am = fmaxf(am, __shfl_xor(am, 1)); am = fmaxf(am, __shfl_xor(am, 2)); am = fmaxf(am, __shfl_xor(am, 4));
                int ex = 0; if (am > 0.f) { (void)frexpf(am * (1.f / 6.f), &ex); }
                ex = ex < -126 ? -126 : (ex > 126 ? 126 : ex);
                const float inv = __builtin_bit_cast(float, (unsigned)(127 - ex) << 23);
                unsigned w16 = 0u;
#pragma unroll
                for (int c = 0; c < 4; ++c) { const float y = v[q][j][c] * inv, a_ = fabsf(y);
                    float cf = a_ < 2.f ? rintf(a_ * 2.f) : (a_ < 4.f ? 4.f + rintf(a_ - 2.f) : 6.f + rintf((a_ - 4.f) * 0.5f));
                    cf = fminf(cf, 7.f);
                    const unsigned s4 = (unsigned)(int)cf | (y < 0.f ? 8u : 0u);
                    w16 |= s4 << (4 * c); }
                const int qb = 8 * j + (lane >> 3), kc_ = qb & 3, m_ = qb >> 2;
#pragma unroll
                for (int t = 0; t < 2; ++t) { const int L = 16 * m_ + 2 * (lane & 7) + t;
                    scr[64 * (L >> 4) + 16 * kc_ + (L & 15)] = (unsigned char)((w16 >> (8 * t)) & 0xFFu); }
                if ((lane & 7) == 0) scr[512 + kc_ * 8 + m_] = (unsigned char)(ex + 127);
            }
            LDS_WAIT(); asm volatile("" ::: "memory");
            if (lane < 32) *(v4u*)(PU + ((size_t)l * NEXP + e) * 512 + 16 * lane) = *(const LAS v4u*)(scr + 16 * lane);
            else if (lane < 34) *(v4u*)(PU + (size_t)48 * MiB + ((size_t)l * NEXP + e) * 32 + 16 * (lane - 32)) = *(const LAS v4u*)(scr + 512 + 16 * (lane - 32));
            LDS_WAIT(); asm volatile("" ::: "memory");
        } } }
}

__device__ __forceinline__ void transpose_item(const float* W, int ldw, bf16* WT, int row_off, LAS float* scr, int item, int nblk, int lane) {
    const int kb = item / nblk, nb = item % nblk, k0 = 64 * kb, n0 = 32 * nb;
#pragma unroll 8
    for (int i = 0; i < 32; ++i) { const int kk = 2 * i + (lane >> 5); scr[kk * 33 + (lane & 31)] = W[(size_t)(k0 + kk) * ldw + n0 + (lane & 31)]; }
    LDS_WAIT(); asm volatile("" ::: "memory");
    const int c = lane & 7;
#pragma unroll
    for (int j = 0; j < 4; ++j) { const int n = (lane >> 3) + 8 * j; const LAS float* s = scr + (8 * c) * 33 + n;
        v4u o; o.x = pk2(s[0 * 33], s[1 * 33]); o.y = pk2(s[2 * 33], s[3 * 33]); o.z = pk2(s[4 * 33], s[5 * 33]); o.w = pk2(s[6 * 33], s[7 * 33]);
        *(v4u*)(WT + (size_t)(row_off + n0 + n) * 1024 + k0 + 8 * c) = o; }
    LDS_WAIT(); asm volatile("" ::: "memory");
}

__device__ __forceinline__ void phase_prologue(Frame& F) {
    KARGS;
    LAS float* cact = (LAS float*)F.lds;
    LAS float* part = cact + 2048;
    {   const float* c = IN(1);
        for (int i = F.tid; i < 2048; i += NTHR) { const float v = c[i]; cact[i] = v / (1.f + expf(-v)); } }
    __syncthreads();
    {
        const float* ada_w = IN(2); const float* ada_b = IN(3); float* MOD = WSP(float, WS_MOD);
        for (int it = F.bid; it < 384; it += F.G) {
            const int l = it / 96, j0 = (it % 96) * 64;
            const float* wp = ada_w + ((size_t)l * 1024 + F.wave * 128) * 6144 + j0 + F.lane;
            float a0 = 0.f, a1 = 0.f;
#pragma unroll 8
            for (int k = 0; k < 128; ++k) { const float w = wp[(size_t)k * 6144]; a0 += cact[F.wave * 128 + k] * w; a1 += cact[1024 + F.wave * 128 + k] * w; }
            part[(F.wave * 2 + 0) * 64 + F.lane] = a0; part[(F.wave * 2 + 1) * 64 + F.lane] = a1;
            __syncthreads();
            if (F.tid < 128) { const int b = F.tid >> 6, col = F.tid & 63; float s = 0.f;
#pragma unroll
                for (int w = 0; w < 8; ++w) s += part[(w * 2 + b) * 64 + col];
                MOD[(l * 2 + b) * 6144 + j0 + col] = s + ada_b[l * 6144 + j0 + col]; }
            __syncthreads();
        }
    }
    {
        LAS float* scr = (LAS float*)(F.lds + 16384 + F.wave * 8448);
        const int gw = F.bid * NWAVES + F.wave, NGW = F.G * NWAVES;
        constexpr int I_A = 16 * 64, I_B = 16 * 64, I_C = 16 * 56, I_D = 16 * 32, I_E = 16 * 64;
        constexpr int NITEMS = 2 * I_A + 2 * I_B + 2 * I_C + 4 * I_D + 4 * I_E;
        for (int it = gw; it < NITEMS; it += NGW) {
            int r = it;
            if (r < 2 * I_A) { const int j = r / I_A; transpose_item(IN(6) + (size_t)j * 1024 * 2048, 2048, WSP(bf16, WS_WIN + (size_t)(2 * j) * 8 * MiB), 0, scr, r % I_A, 64, F.lane); continue; } r -= 2 * I_A;
            if (r < 2 * I_B) { const int j = r / I_B; transpose_item(IN(10) + (size_t)j * 1024 * ODD_LD, ODD_LD, WSP(bf16, WS_WIN + (size_t)(2 * j + 1) * 8 * MiB), 0, scr, r % I_B, 64, F.lane); continue; } r -= 2 * I_B;
            if (r < 2 * I_C) { const int j = r / I_C; transpose_item(IN(10) + (size_t)j * 1024 * ODD_LD + 2056, ODD_LD, WSP(bf16, WS_WIN + (size_t)(2 * j + 1) * 8 * MiB), 2048, scr, r % I_C, 56, F.lane); continue; } r -= 2 * I_C;
            if (r < 4 * I_D) { const int l = r / I_D; const int j = l >> 1; const float* src = (l & 1) ? IN(11) : IN(7);
                if ((l & 1) || (r % I_D) < 8 * 32) transpose_item(src + (size_t)j * 1024 * 1024, 1024, WSP(bf16, WS_WOUT + (size_t)l * 2 * MiB), 0, scr, r % I_D, 32, F.lane); continue; } r -= 4 * I_D;
            { const int l = r / I_E; transpose_item(IN(26) + (size_t)l * 1024 * 2048, 2048, WSP(bf16, WS_WQ + (size_t)l * 4 * MiB), 0, scr, r % I_E, 64, F.lane); }
        }
    }
    {
        const int gt = F.bid * NTHR + F.tid, NGT = F.G * NTHR;
        float* WF = WSP(float, WS_WF);
        for (int i = gt; i < 2 * 8 * 1024; i += NGT) { const int j = i >> 13, h = (i >> 10) & 7, k = i & 1023; WF[i] = IN(10)[((size_t)j * 1024 + k) * ODD_LD + 2048 + h]; }
        bf16* KEYS = WSP(bf16, WS_KEYS);
        for (int i = gt; i < 4 * 16384; i += NGT) { const int l = i >> 14, r = i & 16383;
            KEYS[(size_t)(l * 2 + 0) * 16384 + r] = (bf16)f2bf(IN(27)[i]); KEYS[(size_t)(l * 2 + 1) * 16384 + r] = (bf16)f2bf(IN(28)[i]); }
        for (int i = gt; i < 2 * 512 * 256; i += NGT) { const int j = i >> 17, ch = (i >> 8) & 511, k = i & 255; bf16* dst = WSP(bf16, WS_LORA) + (size_t)j * 131072;
            if (k < 64) dst[ch * 64 + k] = (bf16)f2bf(IN(17)[((size_t)j * 64 + k) * 512 + ch]);
            else if (k < 128) dst[32768 + ch * 64 + (k - 64)] = (bf16)f2bf(IN(19)[((size_t)j * 64 + (k - 64)) * 512 + ch]);
            else dst[65536 + ch * 128 + (k - 128)] = (bf16)f2bf(IN(20)[((size_t)j * 128 + (k - 128)) * 512 + ch]); }
        {   LAS float* pwl = (LAS float*)(F.lds + 98304);
            for (int it = (F.bid + F.G - 128 % F.G) % F.G; it < 128; it += F.G) { const int j = it >> 6, g = (it >> 4) & 3, cq = (it >> 1) & 7, nh = it & 1;
                __syncthreads();
                for (int i = F.tid; i < 2048; i += NTHR) { const int d = i >> 4, cc = i & 15; pwl[i] = IN(8)[((size_t)(j * 4 + g) * 128 + cq * 16 + cc) * 128 + d] * IN(9)[j * 512 + g * 128 + d]; }
                __syncthreads();
                const int n = nh * 512 + F.tid; const float* wo = IN(7) + ((size_t)j * 1024 + 512 + g * 128) * 1024 + n;
                float acc[16];
#pragma unroll
                for (int cc = 0; cc < 16; ++cc) acc[cc] = 0.f;
#pragma unroll 8
                for (int d = 0; d < 128; ++d) { const float wv = wo[(size_t)d * 1024];
#pragma unroll
                    for (int q4 = 0; q4 < 4; ++q4) { const f32x4 p4 = *(const LAS f32x4*)(pwl + d * 16 + 4 * q4); acc[4 * q4] += p4.x * wv; acc[4 * q4 + 1] += p4.y * wv; acc[4 * q4 + 2] += p4.z * wv; acc[4 * q4 + 3] += p4.w * wv; } }
                v4u o0, o1; o0.x = pk2(acc[0], acc[1]); o0.y = pk2(acc[2], acc[3]); o0.z = pk2(acc[4], acc[5]); o0.w = pk2(acc[6], acc[7]);
                o1.x = pk2(acc[8], acc[9]); o1.y = pk2(acc[10], acc[11]); o1.z = pk2(acc[12], acc[13]); o1.w = pk2(acc[14], acc[15]);
                bf16* dst = WSP(bf16, WS_WOUT + (size_t)(2 * j) * 2 * MiB) + (size_t)n * 1024 + 512 + g * 128 + cq * 16;
                *(v4u*)dst = o0; *(v4u*)(dst + 8) = o1; }
            __syncthreads(); }
        {
            const int gw = F.bid * NWAVES + F.wave, NGW = F.G * NWAVES, lane = F.lane;
            for (int row0 = gw; row0 < 2 * NEXP; row0 += 4 * NGW) {
                f32x4 v[4][4];
                conv_issue<4>(IN(29), IN(30), 0, row0, NGW, lane, v);
                conv_finish<4>(WSP(unsigned char, WS_PU), WSP(unsigned char, WS_PV), WSP(float, WS_PS), 0, row0, NGW, lane, v, F.lds + 135168 + F.wave * 1024);
            }
        }
    }
}

__device__ __forceinline__ void phase_norm(Frame& F, int layer, int which) {
    KARGS;
    const float* X = (layer == 0 && which == 0) ? IN(0) : OUTP;
    const float* gain = (which ? IN(5) : IN(4)) + layer * 1024;
    const float* mod = WSP(float, WS_MOD) + (size_t)layer * 2 * 6144 + (which ? 3072 : 0);
    bf16* H = WSP(bf16, WS_H);
    const bool do_f = (layer & 1) && which == 0;
    const int jj = layer >> 1;
    const float* WF = WSP(float, WS_WF) + (size_t)jj * 8 * 1024;
    float* LOGF = WSP(float, WS_LOGF);
    const int gw = F.bid * NWAVES + F.wave, NGW = F.G * NWAVES, lane = F.lane;
    f32x4 gn[4];
#pragma unroll
    for (int j = 0; j < 4; ++j) gn[j] = *(const f32x4*)(gain + 256 * j + 4 * lane);
    for (int row = gw; row < T; row += NGW) {
        const int b = row >= SEQ ? 1 : 0;
        const float* sh = mod + b * 6144; const float* sc = sh + 1024;
        const float* xr = X + (size_t)row * D + 4 * lane;
        f32x4 v[4]; float ss = 0.f;
#pragma unroll
        for (int j = 0; j < 4; ++j) { v[j] = *(const f32x4*)(xr + 256 * j); ss += (v[j].x * v[j].x + v[j].y * v[j].y) + (v[j].z * v[j].z + v[j].w * v[j].w); }
        const float rstd = rsqrtf(wave_sum(ss) * (1.f / D) + NORM_EPS);
        bf16* hr = H + (size_t)row * D + 4 * lane;
#pragma unroll
        for (int j = 0; j < 4; ++j) { const f32x4 s4 = *(const f32x4*)(sc + 256 * j + 4 * lane), h4 = *(const f32x4*)(sh + 256 * j + 4 * lane);
            v[j] = v[j] * rstd * gn[j] * (s4 + 1.f) + h4;
            v2u o; o.x = pk2(v[j].x, v[j].y); o.y = pk2(v[j].z, v[j].w); *(v2u*)(hr + 256 * j) = o; }
        if (which == 1) {
            float am = 0.f;
#pragma unroll
            for (int j = 0; j < 4; ++j) am = fmaxf(am, fmaxf(fmaxf(fabsf(v[j].x), fabsf(v[j].y)), fmaxf(fabsf(v[j].z), fabsf(v[j].w))));
            am = wave_max(am); const float s8 = am > 0.f ? am * (1.f / 224.f) : 1.f, i8 = 1.f / s8;
            unsigned char* h8 = WSP(unsigned char, WS_H8) + (size_t)row * D + 4 * lane;
#pragma unroll
            for (int j = 0; j < 4; ++j) { int w8 = 0; w8 = __builtin_amdgcn_cvt_pk_fp8_f32(v[j].x * i8, v[j].y * i8, w8, false); w8 = __builtin_amdgcn_cvt_pk_fp8_f32(v[j].z * i8, v[j].w * i8, w8, true); *(int*)(h8 + 256 * j) = w8; }
            if (lane == 0) WSP(float, WS_HS)[row] = s8;
        }
        if (do_f) {
            const float* fb = IN(14) + jj * 8;
            const int t = row - b * SEQ;
#pragma unroll
            for (int hh = 0; hh < 8; ++hh) { float d = 0.f;
#pragma unroll
                for (int j = 0; j < 4; ++j) { const f32x4 w4 = *(const f32x4*)(WF + hh * 1024 + 256 * j + 4 * lane); d += (v[j].x * w4.x + v[j].y * w4.y) + (v[j].z * w4.z + v[j].w * w4.w); }
                d = wave_sum(d) + fb[hh];
                const float lf = fminf(d, 0.f) - log1pf(expf(-fabsf(d)));
                if (lane == 0) LOGF[(size_t)(b * 8 + hh) * SEQ + t] = lf; }
        }
    }
}

__device__ __forceinline__ void load_q64(float (&q)[64], const bf16* p, float scale) {
#pragma unroll
    for (int c = 0; c < 8; ++c) { const v4u w = *(const v4u*)(p + 8 * c);
        q[8 * c + 0] = bflo(w.x) * scale; q[8 * c + 1] = bfhi(w.x) * scale; q[8 * c + 2] = bflo(w.y) * scale; q[8 * c + 3] = bfhi(w.y) * scale;
        q[8 * c + 4] = bflo(w.z) * scale; q[8 * c + 5] = bfhi(w.z) * scale; q[8 * c + 6] = bflo(w.w) * scale; q[8 * c + 7] = bfhi(w.w) * scale; }
}
__device__ __forceinline__ float dot_q64(const float (&q)[64], const bf16* p) {
    float z0 = 0.f, z1 = 0.f;
#pragma unroll
    for (int c = 0; c < 8; ++c) { const v4u w = *(const v4u*)(p + 8 * c);
        z0 += q[8 * c + 0] * bflo(w.x) + q[8 * c + 2] * bflo(w.y) + q[8 * c + 4] * bflo(w.z) + q[8 * c + 6] * bflo(w.w);
        z1 += q[8 * c + 1] * bfhi(w.x) + q[8 * c + 3] * bfhi(w.y) + q[8 * c + 5] * bfhi(w.z) + q[8 * c + 7] * bfhi(w.w); }
    return z0 + z1;
}
#ifdef MK_SIMPLE_EVEN
__device__ __forceinline__ void phase_even_mixer_simple(Frame& F, int layer) {
    KARGS;
    const bf16* P = WSP(bf16, WS_PROJ); bf16* MIX = WSP(bf16, WS_MIX);
    const int lane = F.lane;
    {
        const int gw = F.bid * NWAVES + F.wave, NGW = F.G * NWAVES;
        for (int it = gw; it < BATCH * 8 * SEQ; it += NGW) {
            const int b = it >> 16, h = (it >> 13) & 7, t = it & 8191;
            const bf16* base = P + (size_t)b * SEQ * EVEN_IN;
            float q[64]; load_q64(q, base + (size_t)t * EVEN_IN + h * 64, 0.125f);
            float acc = 0.f, carry = 0.f;
            for (int s0 = t - 1; s0 >= 0; s0 -= 64) {
                const int s = s0 - lane; const bool valid = s >= 0; const int sc = valid ? s : 0;
                const float z = dot_q64(q, base + (size_t)sc * EVEN_IN + 512 + h * 64);
                const float sp = softplusf_(z);
                const float l1m = valid ? -sp : 0.f;
                const float lb = z - sp;
                float inc = l1m;
#pragma unroll
                for (int o = 1; o < 64; o <<= 1) { const float n = __shfl_up(inc, o); if (lane >= o) inc += n; }
                const float w = valid ? expf(lb + carry + (inc - l1m)) : 0.f;
                const float tot = __shfl(inc, 63);
#pragma unroll 16
                for (int j = 0; j < 64; ++j) { const float wj = rl(w, j); int sj = s0 - j; sj = sj < 0 ? 0 : sj;
                    acc += wj * bf2f(base[(size_t)sj * EVEN_IN + 1024 + h * 64 + lane]); }
                carry += tot;
                if (carry < -104.f) break;
            }
            MIX[((size_t)b * SEQ + t) * D + h * 64 + lane] = (bf16)f2bf(acc);
        }
    }
    {
        LAS float* pl = (LAS float*)F.lds;
        const int jj = layer >> 1;
        const float* pw = IN(8) + (size_t)jj * 4 * 128 * 128; const float* ps = IN(9) + jj * 512;
        const int c = F.tid, g = c >> 7, w = 2 << g, d = c & 127;
        for (int tile = F.bid; tile < T / 32; tile += F.G) {
            const int t0 = tile * 32, b = t0 / SEQ, tl0 = t0 % SEQ;
            const bf16* base = P + (size_t)b * SEQ * EVEN_IN + 1536 + c;
            for (int tt = 0; tt < 32; ++tt) { const int tl = tl0 + tt, cend = (tl / 64 + 1) * 64;
                int lo = tl - w / 2; lo = lo < 0 ? 0 : lo; int hi = tl + w / 2; hi = hi > cend ? cend : hi;
                float s = 0.f; for (int u = lo; u < hi; ++u) s += bf2f(base[(size_t)u * EVEN_IN]);
                pl[c * 33 + tt] = s / (float)(hi - lo) - bf2f(base[(size_t)tl * EVEN_IN]); }
            __syncthreads();
            float acc[32];
#pragma unroll
            for (int tt = 0; tt < 32; ++tt) acc[tt] = 0.f;
            for (int cc = 0; cc < 128; ++cc) { const float wv = pw[((size_t)g * 128 + cc) * 128 + d]; const LAS float* pr = pl + (g * 128 + cc) * 33;
#pragma unroll
                for (int tt = 0; tt < 32; ++tt) acc[tt] += pr[tt] * wv; }
            const float sc = ps[c];
#pragma unroll
            for (int tt = 0; tt < 32; ++tt) MIX[(size_t)(t0 + tt) * D + 512 + c] = (bf16)f2bf(acc[tt] * sc);
            __syncthreads();
        }
    }
}

#endif
typedef float f32x16 __attribute__((ext_vector_type(16)));
typedef short s16x4 __attribute__((ext_vector_type(4)));
#define MAX3F(a, b, c) __builtin_fmaxf(__builtin_fmaxf((a), (b)), (c))
#define ZERO16(a) do { _Pragma("unroll") for (int r_ = 0; r_ < 16; ++r_) a[r_] = 0.f; } while (0)
constexpr int FX_KROW = 144, FX_VROW = 192;
constexpr int FX_KB = 64 * FX_KROW, FX_VB = 64 * FX_VROW, FX_BUF = FX_KB + FX_VB + 256;
template <int HW> __device__ __forceinline__ void pool_chunk(const bf16* src, bf16* dst, int tl0) {
    float ps[HW + 65 + HW]; ps[0] = 0.f;
#pragma unroll
    for (int i = 0; i < 64 + HW; ++i) { const int tl = tl0 - HW + i; const float x = tl >= 0 ? bf2f(src[(long)(i - HW) * EVEN_IN]) : 0.f; ps[i + 1] = ps[i] + x; }
#pragma unroll
    for (int tt = 0; tt < 64; ++tt) { const int tl = tl0 + tt; int lo = tl - HW; lo = lo < 0 ? 0 : lo; const int hie = tt + HW > 64 ? 64 : tt + HW;
        const float sum = ps[hie + HW] - ps[tt]; const float x = ps[tt + HW + 1] - ps[tt + HW];
        dst[(size_t)tt * D] = (bf16)f2bf(sum / (float)(tl0 + hie - lo) - x); }
}
__device__ __forceinline__ void phase_even_mixer(Frame& F, int layer) {
    KARGS;
    const bf16* P = WSP(bf16, WS_PROJ); bf16* MIX = WSP(bf16, WS_MIX);
    const int tid = F.tid, lane = F.lane, wave = F.wave, r32 = lane & 31, hh = lane >> 5;
    const float LOG2E = 1.4426950408889634f, CS = 0.125f * LOG2E;
    const int srow = tid >> 3, sch = tid & 7;
    {
        const int c = tid, g = c >> 7;
        for (int ck = F.bid; ck < T / 64; ck += F.G) {
            const int t0 = ck * 64, tl0 = t0 % SEQ;
            const bf16* src = P + (size_t)t0 * EVEN_IN + 1536 + c; bf16* dst = MIX + (size_t)t0 * D + 512 + c;
            if (g == 0) pool_chunk<1>(src, dst, tl0); else if (g == 1) pool_chunk<2>(src, dst, tl0); else if (g == 2) pool_chunk<4>(src, dst, tl0); else pool_chunk<8>(src, dst, tl0);
        }
    }
    __syncthreads();
    for (int u = F.bid; u < 256; u += F.G) {
        for (int ui = 0; ui < 2; ++ui) {
            const int bh = u >> 4, ss = u & 15, qb = ui == 0 ? ss : 31 - ss, b = bh >> 3, h = bh & 7;
            const bf16* base = P + (size_t)b * SEQ * EVEN_IN;
            const int q0 = 256 * qb + 32 * wave, myq = q0 + r32;
            bf16x8 qf[4];
#pragma unroll
            for (int d0 = 0; d0 < 4; ++d0) qf[d0] = *(const bf16x8*)(base + (size_t)myq * EVEN_IN + h * 64 + 16 * d0 + 8 * hh);
            float carry = 0.f;
            f32x16 o[2];
#pragma unroll
            for (int r = 0; r < 16; ++r) { o[0][r] = 0.f; o[1][r] = 0.f; }
            const int jtop = 4 * qb + 3;
            v4u kreg = *(const v4u*)(base + (size_t)(64 * jtop + srow) * EVEN_IN + 512 + h * 64 + sch * 8);
            v4u vreg = *(const v4u*)(base + (size_t)(64 * jtop + srow) * EVEN_IN + 1024 + h * 64 + sch * 8);
            __syncthreads();
            *(LAS v4u*)(F.lds + srow * FX_KROW + sch * 16) = kreg; *(LAS v4u*)(F.lds + FX_KB + srow * FX_VROW + sch * 16) = vreg;
            if (tid < 16) ((LAS unsigned*)(F.lds + 2 * FX_BUF))[tid] = 0u;
            __syncthreads();
            int it = 0;
            for (int j = jtop; j >= 0; --j, ++it) {
                const int cur = (it & 1) * FX_BUF, nxt = ((it + 1) & 1) * FX_BUF;
                if (j > 0) { const size_t krow = (size_t)(64 * (j - 1) + srow) * EVEN_IN;
                    kreg = *(const v4u*)(base + krow + 512 + h * 64 + sch * 8); vreg = *(const v4u*)(base + krow + 1024 + h * 64 + sch * 8); }
                const bool started = 64 * j <= q0 + 30;
                const bool wprev = __all(carry < -150.f);
                if (started && !wprev) {
                    const LAS unsigned char* Kb = F.lds + cur; const LAS unsigned char* Vb = F.lds + cur + FX_KB;
                    f32x16 p0, p1;
#pragma unroll
                    for (int r = 0; r < 16; ++r) { p0[r] = 0.f; p1[r] = 0.f; }
#pragma unroll
                    for (int d0 = 0; d0 < 4; ++d0) {
                        const bf16x8 a0 = *(const LAS bf16x8*)(Kb + r32 * FX_KROW + 32 * d0 + 16 * hh);
                        const bf16x8 a1 = *(const LAS bf16x8*)(Kb + (r32 + 32) * FX_KROW + 32 * d0 + 16 * hh);
                        p0 = __builtin_amdgcn_mfma_f32_32x32x16_bf16(a0, qf[d0], p0, 0, 0, 0);
                        p1 = __builtin_amdgcn_mfma_f32_32x32x16_bf16(a1, qf[d0], p1, 0, 0, 0);
                    }
                    f32x16 l0, l1v;
#pragma unroll
                    for (int r = 0; r < 16; ++r) {
                        const int key = 64 * j + (r & 3) + 8 * (r >> 2) + 4 * hh;
                        const float za = p0[r] * CS, zb = p1[r] * CS;
                        const float sa = fmaxf(za, 0.f) + __builtin_amdgcn_logf(1.f + __builtin_amdgcn_exp2f(-fabsf(za)));
                        const float sb = fmaxf(zb, 0.f) + __builtin_amdgcn_logf(1.f + __builtin_amdgcn_exp2f(-fabsf(zb)));
                        l0[r] = -sa; l1v[r] = -sb; p0[r] = za - sa; p1[r] = zb - sb; (void)key;
                    }
                    if (64 * j + 63 >= q0) {
                        asm volatile("" ::: "memory");
#pragma unroll
                        for (int r = 0; r < 16; ++r) { const int key = 64 * j + (r & 3) + 8 * (r >> 2) + 4 * hh;
                            if (!(key < myq)) { l0[r] = 0.f; p0[r] = -INFINITY; } if (!(key + 32 < myq)) { l1v[r] = 0.f; p1[r] = -INFINITY; } }
                    }
                    float tot[8], oth[8];
#pragma unroll
                    for (int g = 0; g < 4; ++g) { tot[g] = (l0[4 * g] + l0[4 * g + 1]) + (l0[4 * g + 2] + l0[4 * g + 3]); tot[4 + g] = (l1v[4 * g] + l1v[4 * g + 1]) + (l1v[4 * g + 2] + l1v[4 * g + 3]); }
#pragma unroll
                    for (int g = 0; g < 8; ++g) oth[g] = __shfl_xor(tot[g], 32);
                    float sfx[8]; float run = 0.f;
#pragma unroll
                    for (int x = 7; x >= 0; --x) { sfx[x] = run; run += tot[x] + oth[x]; }
#pragma unroll
                    for (int x = 0; x < 8; ++x) {
                        const float goff = carry + sfx[x] + (hh == 0 ? oth[x] : 0.f);
                        if (x < 4) { const float s3 = goff, s2 = s3 + l0[4 * x + 3], s1 = s2 + l0[4 * x + 2], s0 = s1 + l0[4 * x + 1];
                            p0[4 * x] = __builtin_amdgcn_exp2f(p0[4 * x] + s0); p0[4 * x + 1] = __builtin_amdgcn_exp2f(p0[4 * x + 1] + s1); p0[4 * x + 2] = __builtin_amdgcn_exp2f(p0[4 * x + 2] + s2); p0[4 * x + 3] = __builtin_amdgcn_exp2f(p0[4 * x + 3] + s3); }
                        else { const int y = x - 4; const float s3 = goff, s2 = s3 + l1v[4 * y + 3], s1 = s2 + l1v[4 * y + 2], s0 = s1 + l1v[4 * y + 1];
                            p1[4 * y] = __builtin_amdgcn_exp2f(p1[4 * y] + s0); p1[4 * y + 1] = __builtin_amdgcn_exp2f(p1[4 * y + 1] + s1); p1[4 * y + 2] = __builtin_amdgcn_exp2f(p1[4 * y + 2] + s2); p1[4 * y + 3] = __builtin_amdgcn_exp2f(p1[4 * y + 3] + s3); }
                    }
                    carry += run;
                    bf16x8 pf[4];
#pragma unroll
                    for (int s4 = 0; s4 < 4; ++s4) {
                        v4u w;
                        if (s4 < 2) { w.x = pk2(p0[8 * s4 + 0], p0[8 * s4 + 1]); w.y = pk2(p0[8 * s4 + 2], p0[8 * s4 + 3]); w.z = pk2(p0[8 * s4 + 4], p0[8 * s4 + 5]); w.w = pk2(p0[8 * s4 + 6], p0[8 * s4 + 7]); }
                        else { const int sp = s4 - 2; w.x = pk2(p1[8 * sp + 0], p1[8 * sp + 1]); w.y = pk2(p1[8 * sp + 2], p1[8 * sp + 3]); w.z = pk2(p1[8 * sp + 4], p1[8 * sp + 5]); w.w = pk2(p1[8 * sp + 6], p1[8 * sp + 7]); }
                        pf[s4] = __builtin_bit_cast(bf16x8, w);
                    }
                    const int gi = lane >> 4, li = lane & 15;
                    const LAS unsigned char* vbase = Vb + (4 * (gi >> 1) + (li >> 2)) * FX_VROW + (16 * (gi & 1) + 4 * (li & 3)) * 2;
#pragma unroll
                    for (int d0 = 0; d0 < 2; ++d0)
#pragma unroll
                        for (int s4 = 0; s4 < 4; ++s4) {
                            const s16x4 lo = __builtin_bit_cast(s16x4, __builtin_amdgcn_ds_read_tr16_b64_v4i16((LAS s16x4*)(vbase + (16 * s4) * FX_VROW + 64 * d0)));
                            const s16x4 hi = __builtin_bit_cast(s16x4, __builtin_amdgcn_ds_read_tr16_b64_v4i16((LAS s16x4*)(vbase + (16 * s4 + 8) * FX_VROW + 64 * d0)));
                            const bf16x8 vf = (bf16x8){lo[0], lo[1], lo[2], lo[3], hi[0], hi[1], hi[2], hi[3]};
                            o[d0] = __builtin_amdgcn_mfma_f32_32x32x16_bf16(vf, pf[s4], o[d0], 0, 0, 0);
                        }
                }
                const bool wdone = started && __all(carry < -150.f);
                if (lane == 0) ((LAS unsigned*)(F.lds + 2 * FX_BUF))[(it & 1) * 8 + wave] = wdone ? 1u : 0u;
                if (j > 0) { *(LAS v4u*)(F.lds + nxt + srow * FX_KROW + sch * 16) = kreg; *(LAS v4u*)(F.lds + nxt + FX_KB + srow * FX_VROW + sch * 16) = vreg; }
                LBAR();
                const LAS unsigned* fl = (const LAS unsigned*)(F.lds + 2 * FX_BUF) + (it & 1) * 8;
                const unsigned alld = fl[0] & fl[1] & fl[2] & fl[3] & fl[4] & fl[5] & fl[6] & fl[7];
                if (alld) break;
            }
            bf16* op = MIX + ((size_t)b * SEQ + myq) * D + h * 64;
#pragma unroll
            for (int d0 = 0; d0 < 2; ++d0)
#pragma unroll
                for (int g = 0; g < 4; ++g) { const int db = 32 * d0 + 8 * g + 4 * hh;
                    v2u ow; ow.x = pk2(o[d0][4 * g + 0], o[d0][4 * g + 1]); ow.y = pk2(o[d0][4 * g + 2], o[d0][4 * g + 3]); *(v2u*)(op + db) = ow; }
        }
    }
}

__device__ __forceinline__ void phase_odd_prep(Frame& F, int layer, int parts) {
    KARGS;
    const int jj = layer >> 1, lane = F.lane, tid = F.tid, w = F.wave, r32 = lane & 31, hh = lane >> 5;
    bf16* P = WSP(bf16, WS_PROJ);
    if (F.bid < 16 && (parts & 4)) {
        const float* lf = WSP(float, WS_LOGF) + (size_t)F.bid * SEQ + 1024 * w; float* dc = WSP(float, WS_DCUM) + (size_t)F.bid * SEQ + 1024 * w;
        float inc[16];
#pragma unroll
        for (int i = 0; i < 16; ++i) inc[i] = lf[64 * i + lane];
        double offs[16]; double carry = 0.0;
#pragma unroll
        for (int i = 0; i < 16; ++i) {
#pragma unroll
            for (int o = 1; o < 64; o <<= 1) { const float n = __shfl_up(inc[i], o); if (lane >= o) inc[i] += n; }
            offs[i] = carry; carry += (double)__shfl(inc[i], 63); }
        LAS double* wt = (LAS double*)F.lds;
        if (lane == 0) wt[w] = carry;
        __syncthreads();
        double base = 0.0;
#pragma unroll
        for (int ww = 0; ww < 8; ++ww) if (ww < w) base += wt[ww];
#pragma unroll
        for (int i = 0; i < 16; ++i) dc[64 * i + lane] = (float)(base + offs[i] + (double)inc[i]);
        __syncthreads();
    }
    constexpr int LXP = 528;
    LAS unsigned char* lx = F.lds;
    const float* mix = IN(15) + jj * 1792;
    const float* w0 = IN(16) + jj * 512; const float* a0 = IN(18) + jj * 512;
    const float* kkp = IN(21) + jj * 512; const float* kap = IN(22) + jj * 512;
    const float* qn = IN(12) + jj * 64; const float* kn = IN(13) + jj * 64;
    const bf16* LT = WSP(bf16, WS_LORA) + (size_t)jj * 131072;
    float* R = WSP(float, WS_RW); float* LWp = WSP(float, WS_RW + RW_SLOT); float* K = WSP(float, WS_RW + 2 * RW_SLOT); float* V = WSP(float, WS_RW + 3 * RW_SLOT);
    float* KK = WSP(float, WS_RW + 4 * RW_SLOT); float* A = WSP(float, WS_RW + 5 * RW_SLOT); float* Gt = WSP(float, WS_RW + 6 * RW_SLOT);
    for (int item = F.bid; item < T / 64; item += F.G) {
        const int t0 = item * 64;
        if (parts & 1) {
        for (int i = tid; i < 64 * 32; i += NTHR) { const int tt = i >> 5, j8 = 8 * (i & 31), tg = t0 + tt, tl = tg % SEQ, col = 1536 + j8;
            const v4u cw = *(const v4u*)(P + (size_t)tg * ODD_N + 2048 + col); v4u pw = (v4u){0u, 0u, 0u, 0u}; if (tl > 0) pw = *(const v4u*)(P + (size_t)(tg - 1) * ODD_N + 2048 + col);
            const f32x4 m0 = *(const f32x4*)(mix + col), m1 = *(const f32x4*)(mix + col + 4);
            v4u ow;
#pragma unroll
            for (int q = 0; q < 4; ++q) { const float c0 = bflo(cw[q]), c1 = bfhi(cw[q]), p0 = bflo(pw[q]), p1 = bfhi(pw[q]);
                const float mm0 = q < 2 ? m0[2 * q] : m1[2 * q - 4], mm1 = q < 2 ? m0[2 * q + 1] : m1[2 * q - 3];
                const float x0 = c0 + (p0 - c0) * mm0, x1 = c1 + (p1 - c1) * mm1;
                ow[q] = j8 < 64 ? pk2(tanhf(x0), tanhf(x1)) : (j8 < 128 ? pk2(x0, x1) : pk2(sigmoidf_(x0), sigmoidf_(x1))); }
            *(LAS v4u*)(lx + tt * LXP + j8 * 2) = ow; }
        __syncthreads();
#pragma unroll 1
        for (int L = 0; L < 3; ++L) {
            const int koff = L == 0 ? 0 : (L == 1 ? 64 : 128), ksteps = L == 2 ? 8 : 4, kdim = L == 2 ? 128 : 64;
            const bf16* Wt = LT + (L == 0 ? 0 : (L == 1 ? 32768 : 65536));
            float* dst = L == 0 ? LWp : (L == 1 ? A : Gt);
            f32x16 acc[2][2];
#pragma unroll
            for (int a_ = 0; a_ < 2; ++a_)
#pragma unroll
                for (int b_ = 0; b_ < 2; ++b_) ZERO16(acc[a_][b_]);
#pragma unroll 1
            for (int s4 = 0; s4 < ksteps; ++s4) {
                bf16x8 af[2], bfr[2];
#pragma unroll
                for (int tm = 0; tm < 2; ++tm) af[tm] = *(const LAS bf16x8*)(lx + (32 * tm + r32) * LXP + (koff + 16 * s4 + 8 * hh) * 2);
#pragma unroll
                for (int tn = 0; tn < 2; ++tn) bfr[tn] = *(const bf16x8*)(Wt + (size_t)(64 * w + 32 * tn + r32) * kdim + 16 * s4 + 8 * hh);
#pragma unroll
                for (int tm = 0; tm < 2; ++tm)
#pragma unroll
                    for (int tn = 0; tn < 2; ++tn) acc[tm][tn] = __builtin_amdgcn_mfma_f32_32x32x16_bf16(af[tm], bfr[tn], acc[tm][tn], 0, 0, 0);
            }
#pragma unroll
            for (int tn = 0; tn < 2; ++tn)
#pragma unroll
                for (int tm = 0; tm < 2; ++tm) { float* dp = dst + (size_t)(t0 + 32 * tm + 4 * hh) * 512 + 64 * w + 32 * tn + r32;
#pragma unroll
                    for (int r = 0; r < 16; ++r) dp[(size_t)((r & 3) + 8 * (r >> 2)) * 512] = acc[tm][tn][r]; }
        }
        asm volatile("s_waitcnt vmcnt(0)" ::: "memory");
        __syncthreads();
        }
        if (parts & 2) {
            LAS float* nrm = (LAS float*)(F.lds + 40960);
            {
                const int tt = tid >> 3, hd = tid & 7, tg = t0 + tt, tl = tg % SEQ;
                const bf16* bp = P + (size_t)tg * ODD_N + hd * 64;
                float qs = 0.f, ks = 0.f, n2 = 0.f;
#pragma unroll 2
                for (int c = 0; c < 8; ++c) {
                    const v4u wq = *(const v4u*)(bp + 8 * c), wk = *(const v4u*)(bp + 512 + 8 * c), wc = *(const v4u*)(bp + 2048 + 512 + 8 * c);
                    v4u wp = (v4u){0u, 0u, 0u, 0u}; if (tl > 0) wp = *(const v4u*)(bp - ODD_N + 2048 + 512 + 8 * c);
                    const f32x4 mk0 = *(const f32x4*)(mix + 512 + hd * 64 + 8 * c), mk1 = *(const f32x4*)(mix + 512 + hd * 64 + 8 * c + 4);
                    const f32x4 kc0 = *(const f32x4*)(kkp + hd * 64 + 8 * c), kc1 = *(const f32x4*)(kkp + hd * 64 + 8 * c + 4);
#pragma unroll
                    for (int i = 0; i < 4; ++i) {
                        const float q0 = bflo(wq[i]), q1 = bfhi(wq[i]), k0 = bflo(wk[i]), k1 = bfhi(wk[i]);
                        qs += q0 * q0 + q1 * q1; ks += k0 * k0 + k1 * k1;
                        const float c0 = bflo(wc[i]), c1 = bfhi(wc[i]), p0 = bflo(wp[i]), p1 = bfhi(wp[i]);
                        const float m0 = i < 2 ? mk0[2 * i] : mk1[2 * i - 4], m1 = i < 2 ? mk0[2 * i + 1] : mk1[2 * i - 3];
                        const float g0 = i < 2 ? kc0[2 * i] : kc1[2 * i - 4], g1 = i < 2 ? kc0[2 * i + 1] : kc1[2 * i - 3];
                        const float x0 = (c0 + (p0 - c0) * m0) * g0, x1 = (c1 + (p1 - c1) * m1) * g1;
                        n2 += x0 * x0 + x1 * x1; }
                }
                *(LAS f32x4*)(nrm + (tt * 8 + hd) * 4) = (f32x4){rsqrtf(qs * (1.f / 64.f) + NORM_EPS), rsqrtf(ks * (1.f / 64.f) + NORM_EPS), 1.f / fmaxf(sqrtf(n2), 1e-12f), 0.f};
            }
            __syncthreads();
            const int c4 = 4 * (tid & 127), hd = c4 >> 6, th = tid >> 7;
            const f32x4 mr = *(const f32x4*)(mix + c4), mk = *(const f32x4*)(mix + 512 + c4), mv = *(const f32x4*)(mix + 1024 + c4);
            const f32x4 kk4 = *(const f32x4*)(kkp + c4), ka4 = *(const f32x4*)(kap + c4), w04 = *(const f32x4*)(w0 + c4), a04 = *(const f32x4*)(a0 + c4);
            const f32x4 qn4 = *(const f32x4*)(qn + (c4 & 63)), kn4 = *(const f32x4*)(kn + (c4 & 63));
#pragma unroll 2
            for (int t2 = 0; t2 < 16; ++t2) { const int tt = 16 * th + t2, tg = t0 + tt, tl = tg % SEQ;
                const bf16* pc = P + (size_t)tg * ODD_N + 2048 + c4; const bf16* pp = pc - ODD_N;
                const size_t o = (size_t)tg * 512 + c4;
                const f32x4 wraw = *(const f32x4*)(LWp + o), araw = *(const f32x4*)(A + o);
                const v2u rc = *(const v2u*)pc, kc = *(const v2u*)(pc + 512), vc = *(const v2u*)(pc + 1024);
                v2u rp = (v2u){0u, 0u}, kp = rp, vp = rp; if (tl > 0) { rp = *(const v2u*)pp; kp = *(const v2u*)(pp + 512); vp = *(const v2u*)(pp + 1024); }
                bf16* pq = P + (size_t)tg * ODD_N + c4;
                const v2u qw = *(const v2u*)pq, kw = *(const v2u*)(pq + 512);
                const f32x4 nm = *(const LAS f32x4*)(nrm + (tt * 8 + hd) * 4);
                f32x4 R4, V4, KK4, LW4, A4, K4; float qo[4], ko[4];
#pragma unroll
                for (int e = 0; e < 4; ++e) {
                    const float rcv = (e & 1) ? bfhi(rc[e >> 1]) : bflo(rc[e >> 1]), rpv = (e & 1) ? bfhi(rp[e >> 1]) : bflo(rp[e >> 1]);
                    const float kcv = (e & 1) ? bfhi(kc[e >> 1]) : bflo(kc[e >> 1]), kpv = (e & 1) ? bfhi(kp[e >> 1]) : bflo(kp[e >> 1]);
                    const float vcv = (e & 1) ? bfhi(vc[e >> 1]) : bflo(vc[e >> 1]), vpv = (e & 1) ? bfhi(vp[e >> 1]) : bflo(vp[e >> 1]);
                    const float qv = (e & 1) ? bfhi(qw[e >> 1]) : bflo(qw[e >> 1]), kv = (e & 1) ? bfhi(kw[e >> 1]) : bflo(kw[e >> 1]);
                    const float r = rcv + (rpv - rcv) * mr[e], k = kcv + (kpv - kcv) * mk[e], v = vcv + (vpv - vcv) * mv[e];
                    const float wl = -softplusf_(-(w04[e] + wraw[e])) - 0.5f, av = sigmoidf_(a04[e] + araw[e]);
                    R4[e] = r; V4[e] = v; KK4[e] = k * kk4[e] * nm.z; LW4[e] = -expf(wl); A4[e] = av; K4[e] = k * (1.f + (av - 1.f) * ka4[e]);
                    qo[e] = qv * nm.x * qn4[e]; ko[e] = kv * nm.y * kn4[e]; }
                *(f32x4*)(R + o) = R4; *(f32x4*)(V + o) = V4; *(f32x4*)(KK + o) = KK4; *(f32x4*)(LWp + o) = LW4; *(f32x4*)(A + o) = A4; *(f32x4*)(K + o) = K4;
                v2u qv2, kv2; qv2.x = pk2(qo[0], qo[1]); qv2.y = pk2(qo[2], qo[3]); kv2.x = pk2(ko[0], ko[1]); kv2.y = pk2(ko[2], ko[3]);
                *(v2u*)pq = qv2; *(v2u*)(pq + 512) = kv2; }
        }
        __syncthreads();
    }
}

constexpr int CP = 144;
constexpr int CM = 64 * CP;
__device__ __forceinline__ void mm_nt(f32x16& acc, const LAS unsigned char* A, const LAS unsigned char* B, int m0, int n0, int r32, int hh) {
#pragma unroll
    for (int s4 = 0; s4 < 4; ++s4) { const bf16x8 a = *(const LAS bf16x8*)(A + (m0 + r32) * CP + 32 * s4 + 16 * hh); const bf16x8 b = *(const LAS bf16x8*)(B + (n0 + r32) * CP + 32 * s4 + 16 * hh);
        acc = __builtin_amdgcn_mfma_f32_32x32x16_bf16(a, b, acc, 0, 0, 0); }
}
__device__ __forceinline__ void store_t(LAS unsigned char* Dst, const f32x16& acc, int m0, int n0, int r32, int hh, float sg) {
#pragma unroll
    for (int g = 0; g < 4; ++g) { v2u w; w.x = pk2(sg * acc[4 * g], sg * acc[4 * g + 1]); w.y = pk2(sg * acc[4 * g + 2], sg * acc[4 * g + 3]); *(LAS v2u*)(Dst + (n0 + r32) * CP + (m0 + 8 * g + 4 * hh) * 2) = w; }
}
__device__ __forceinline__ void load_t(f32x16& acc, const LAS unsigned char* Src, int m0, int n0, int r32, int hh, float sg) {
#pragma unroll
    for (int g = 0; g < 4; ++g) { const v2u w = *(const LAS v2u*)(Src + (n0 + r32) * CP + (m0 + 8 * g + 4 * hh) * 2);
        acc[4 * g] = sg * bflo(w.x); acc[4 * g + 1] = sg * bfhi(w.x); acc[4 * g + 2] = sg * bflo(w.y); acc[4 * g + 3] = sg * bfhi(w.y); }
}
__device__ __forceinline__ void mask16(f32x16& acc, int m0, int n0, int r32, int hh, int mode) {
    const int n = n0 + r32;
#pragma unroll
    for (int r = 0; r < 16; ++r) { const int m = m0 + (r & 3) + 8 * (r >> 2) + 4 * hh; const bool keep = mode == 0 ? (n < m) : (mode == 1 ? (m < n) : (m <= n)); acc[r] = keep ? acc[r] : 0.f; }
}
__device__ __forceinline__ void phase_rwkv_chunk(Frame& F, int layer, int qoff = 0, int parts = 15) {
    KARGS;
    const float* R = WSP(float, WS_RW); const float* LW = WSP(float, WS_RW + RW_SLOT); const float* K = WSP(float, WS_RW + 2 * RW_SLOT); const float* V = WSP(float, WS_RW + 3 * RW_SLOT);
    const float* KK = WSP(float, WS_RW + 4 * RW_SLOT); const float* A = WSP(float, WS_RW + 5 * RW_SLOT);
    bf16* CGp = WSP(bf16, WS_CG); bf16* CQp = WSP(bf16, WS_CQ); float* CHp = WSP(float, WS_CH); float* CYp = WSP(float, WS_CY);
    const int tid = F.tid, lane = F.lane, w = F.wave, r32 = lane & 31, hh = lane >> 5;
    LAS unsigned char* L = F.lds;
    LAS unsigned char* Ab = L, *Bb = L + CM, *Kb = L + 2 * CM, *Rb = L + 3 * CM, *BtT = L + 4 * CM, *KtT = L + 5 * CM, *VT = L + 6 * CM;
    LAS unsigned char* XT0 = L + 7 * CM, *XT1 = L + 9 * CM;
    LAS unsigned char* NB = L + 11 * CM;
    LAS unsigned char* Prb = L + 15 * CM;
    LAS float* tot = (LAS float*)(L + 16 * CM);
    LAS float* gCl = tot + 512;
    const int myx = (int)((unsigned)__builtin_amdgcn_s_getreg((3 << 11) | 20) & 7u);
    unsigned* qh = (unsigned*)F.ctl + CW_CHQ + qoff + layer * 8 * 64;
    for (int dx = 0; dx < 8; ++dx) { const int xs = (myx + dx) & 7;
    for (;;) {
        LBAR();
        if (tid == 0) F.MISC[20] = atomicAdd(qh + xs * 64, 1u);
        LBAR();
        const int kq = (int)F.MISC[20];
        if (kq >= 256) break;
        const int bh = xs + 8 * (kq >> 7), c = kq & 127, b = bh >> 3, h = bh & 7;
        {
            const size_t g0 = ((size_t)b * SEQ + c * 64 + 8 * w) * 512 + h * 64 + lane;
            float lw[8], cum[8]; float run = 0.f;
#pragma unroll
            for (int i = 0; i < 8; ++i) { lw[i] = LW[g0 + (size_t)i * 512]; run += lw[i]; cum[i] = run; }
            tot[w * 64 + lane] = run;
            LBAR();
            float off = 0.f, all = 0.f;
#pragma unroll
            for (int ww = 0; ww < 8; ++ww) { const float tv = tot[ww * 64 + lane]; if (ww < w) off += tv; all += tv; }
            if (w == 0) gCl[lane] = expf(all);
#pragma unroll
            for (int i = 0; i < 8; ++i) {
                const int t = 8 * w + i; const float cm = cum[i] + off;
                const float g = expf(cm), gex = expf(cm - lw[i]), gi = expf(-cm), gcg = expf(all - cm);
                const size_t gg = g0 + (size_t)i * 512;
                const float r = R[gg], k = K[gg], v = V[gg], kk = KK[gg], a = A[gg];
                const bf16 ab = (bf16)f2bf(kk * gex), bb = (bf16)f2bf(kk * a * gi), kb = (bf16)f2bf(k * gi), rb = (bf16)f2bf(r * g), bt = (bf16)f2bf(kk * a * gcg), kt = (bf16)f2bf(k * gcg), vb = (bf16)f2bf(v);
                *(LAS bf16*)(Ab + t * CP + lane * 2) = ab; *(LAS bf16*)(Bb + t * CP + lane * 2) = bb; *(LAS bf16*)(Kb + t * CP + lane * 2) = kb; *(LAS bf16*)(Rb + t * CP + lane * 2) = rb;
                *(LAS bf16*)(XT0 + lane * CP + t * 2) = ab; *(LAS bf16*)(BtT + lane * CP + t * 2) = bt; *(LAS bf16*)(KtT + lane * CP + t * 2) = kt; *(LAS bf16*)(VT + lane * CP + t * 2) = vb;
            }
            LBAR();
        }
        if (!(parts & 2)) continue;
        int r32m = r32; asm volatile("" : "+v"(r32m));
        const int xtm = w & 1, xtn = w >> 1;
        f32x16 xacc;
        {
#pragma unroll
            for (int qq = 0; qq < 2; ++qq) {
                int q; if (w < 4) q = 2 * w + qq; else { if (qq == 1) break; q = 8 + (w - 4); }
                const int pr = q >> 2, tm = (q >> 1) & 1, tn = q & 1; f32x16 acc; ZERO16(acc);
                if (pr == 0) { mm_nt(acc, Ab, Bb, 32 * tm, 32 * tn, r32, hh); mask16(acc, 32 * tm, 32 * tn, r32m, hh, 0); store_t(NB + 1 * CM, acc, 32 * tm, 32 * tn, r32, hh, -1.f); }
                else if (pr == 1) { mm_nt(acc, Bb, Ab, 32 * tm, 32 * tn, r32, hh); mask16(acc, 32 * tm, 32 * tn, r32m, hh, 1); store_t(NB + 0 * CM, acc, 32 * tm, 32 * tn, r32, hh, -1.f); }
                else { mm_nt(acc, Bb, Rb, 32 * tm, 32 * tn, r32, hh); mask16(acc, 32 * tm, 32 * tn, r32m, hh, 2); store_t(Prb, acc, 32 * tm, 32 * tn, r32, hh, 1.f); }
            }
            if (xtn >= 2) { ZERO16(xacc); mm_nt(xacc, Ab, Kb, 32 * xtm, 32 * (xtn - 2), r32, hh); mask16(xacc, 32 * xtm, 32 * (xtn - 2), r32m, hh, 0); store_t(XT0 + 64 * CP, xacc, 32 * xtm, 32 * (xtn - 2), r32, hh, 1.f); }
            else load_t(xacc, XT0, 32 * xtm, 32 * xtn, r32, hh, 1.f);
            LBAR();
        }
        if (!(parts & 4)) continue;
        LAS unsigned char* XTc = XT0; LAS unsigned char* XTn = XT1; int nb = 0;
#pragma unroll 1
        for (int j = 0; j < 6; ++j) {
            const LAS unsigned char* Nc = NB + (2 * nb) * CM; const LAS unsigned char* NTc = NB + (2 * nb + 1) * CM;
            mm_nt(xacc, Nc, XTc, 32 * xtm, 32 * xtn, r32, hh);
            store_t(XTn, xacc, 32 * xtm, 32 * xtn, r32, hh, 1.f);
            if (j < 5) { const int tm = (w >> 1) & 1, tn = w & 1; f32x16 acc; ZERO16(acc);
                if (w < 4) { mm_nt(acc, Nc, NTc, 32 * tm, 32 * tn, r32, hh); store_t(NB + (2 * (nb ^ 1) + 1) * CM, acc, 32 * tm, 32 * tn, r32, hh, 1.f); }
                else       { mm_nt(acc, NTc, Nc, 32 * tm, 32 * tn, r32, hh); store_t(NB + (2 * (nb ^ 1)) * CM, acc, 32 * tm, 32 * tn, r32, hh, 1.f); } }
            LBAR();
            { LAS unsigned char* t_ = XTc; XTc = XTn; XTn = t_; } nb ^= 1;
        }
        if (!(parts & 8)) continue;
        const size_t cbase = (size_t)(bh * 128 + c) * 4096;
#pragma unroll
        for (int qq = 0; qq < 2; ++qq) {
            const int q = 2 * w + qq, pr = q >> 2, tm = (q >> 1) & 1, tn = q & 1, m0 = 32 * tm, n0 = 32 * tn; f32x16 acc;
            if (pr == 0) {
                load_t(acc, Rb, m0, n0, r32, hh, -1.f); mm_nt(acc, XTc, Prb, m0, n0, r32, hh);
#pragma unroll
                for (int g = 0; g < 4; ++g) { v2u o; o.x = pk2(-acc[4 * g], -acc[4 * g + 1]); o.y = pk2(-acc[4 * g + 2], -acc[4 * g + 3]);
                    *(v2u*)(CQp + cbase + (size_t)((((tn * 4 + 2 * tm + (g >> 1)) * 2 + (g & 1)) * 32 + r32) * 8 + hh * 4)) = o; }
            } else if (pr == 1) {
                ZERO16(acc); mm_nt(acc, XTc, BtT, m0, n0, r32, hh);
                const int k1 = n0 + r32; const float gc = gCl[k1];
#pragma unroll
                for (int g = 0; g < 4; ++g) { float e[4];
#pragma unroll
                    for (int i = 0; i < 4; ++i) { const int k2 = m0 + 8 * g + 4 * hh + i; e[i] = (k2 == k1 ? gc : 0.f) - acc[4 * g + i]; }
                    v2u o; o.x = pk2(e[0], e[1]); o.y = pk2(e[2], e[3]);
                    *(v2u*)(CGp + cbase + (size_t)((((tn * 4 + 2 * tm + (g >> 1)) * 2 + (g & 1)) * 32 + r32) * 8 + hh * 4)) = o; }
            } else if (pr == 2) {
                load_t(acc, KtT, m0, n0, r32, hh, -1.f); mm_nt(acc, XTc + 64 * CP, BtT, m0, n0, r32, hh); store_t(NB, acc, m0, n0, r32, hh, -1.f);
            } else {
                f32x16 a1; ZERO16(a1); mm_nt(a1, Kb, Rb, m0, n0, r32, hh); mask16(a1, m0, n0, r32m, hh, 2);
                ZERO16(acc); mm_nt(acc, XTc + 64 * CP, Prb, m0, n0, r32, hh);
#pragma unroll
                for (int r = 0; r < 16; ++r) acc[r] = a1[r] - acc[r];
                store_t(NB + CM, acc, m0, n0, r32, hh, 1.f);
            }
        }
        LBAR();
        {
            const int ww = w & 3, tm = ww >> 1, tn = ww & 1, m0 = 32 * tm, n0 = 32 * tn; f32x16 acc; ZERO16(acc);
            mm_nt(acc, w < 4 ? NB : NB + CM, VT, m0, n0, r32, hh);
            bf16* dst = (bf16*)(w < 4 ? CHp : CYp) + cbase + (size_t)((tm * 2 + tn) * 4 * 64 + lane) * 4;
#pragma unroll
            for (int g = 0; g < 4; ++g) { v2u o; o.x = pk2(acc[4 * g], acc[4 * g + 1]); o.y = pk2(acc[4 * g + 2], acc[4 * g + 3]); *(v2u*)(dst + g * 256) = o; }
        }
        LBAR();
    }
    }
}

__device__ __forceinline__ void rwkv_scan(Frame& F, int bh, const int mode = 7) {
    KARGS;
    const unsigned char* CG8 = WSP(unsigned char, WS_CG) + (size_t)bh * 128 * 8192; const unsigned char* CQ8 = WSP(unsigned char, WS_CQ) + (size_t)bh * 128 * 8192;
    const unsigned char* CH8 = WSP(unsigned char, WS_CH) + (size_t)bh * 128 * 8192; const unsigned char* CY8 = WSP(unsigned char, WS_CY) + (size_t)bh * 128 * 8192;
    float* Y = WSP(float, WS_RW + 7 * RW_SLOT);
    const int lane = F.lane, w = F.wave, r32 = lane & 31, hh = lane >> 5, b = bh >> 3, h = bh & 7;
    LAS unsigned char* S0 = F.lds; LAS unsigned char* S1 = F.lds + CM;
    LAS unsigned char* RING = F.lds + 2 * CM;
    LAS float* YR = (LAS float*)(F.lds + 2 * CM + 3 * 32768);
    for (int i = F.tid; i < 2 * CM / 4; i += NTHR) ((LAS unsigned*)F.lds)[i] = 0u;
    __syncthreads();
#define SC_DMA(gsrc, ldst) __builtin_amdgcn_global_load_lds((const unsigned*)(gsrc), (LAS unsigned*)(ldst), 16, 0, 0)
    auto issue = [&](const int c) {
        LAS unsigned char* slot = RING + (c % 3) * 32768; const size_t go = (size_t)c * 8192 + lane * 16;
        if (w < 4) {
#pragma unroll
            for (int q = 0; q < 2; ++q) { const int p = 2 * w + q; SC_DMA(CG8 + go + p * 1024, slot + p * 1024); SC_DMA(CH8 + go + p * 1024, slot + 8192 + p * 1024); } }
        else if (w < 6) {
#pragma unroll
            for (int q = 0; q < 4; ++q) { const int p = 4 * (w - 4) + q; SC_DMA(CQ8 + go + p * 1024, slot + 16384 + p * 1024); SC_DMA(CY8 + go + p * 1024, slot + 24576 + p * 1024); } }
    };
    issue(0); issue(1);
    if (w < 4) asm volatile("s_waitcnt vmcnt(4)" ::: "memory"); else asm volatile("s_waitcnt vmcnt(8)" ::: "memory");
    LBAR();
    if (w < 4) {
        const int tm = w >> 1, tn = w & 1, m0 = 32 * tm, n0 = 32 * tn;
#pragma unroll 1
        for (int c = 0; c < 128; ++c) {
            const LAS unsigned char* slot = RING + (c % 3) * 32768;
            const LAS unsigned char* Sc = (c & 1) ? S1 : S0; LAS unsigned char* Sn = (c & 1) ? S0 : S1;
            f32x16 acc;
#pragma unroll
            for (int g = 0; g < 4; ++g) { const v2u iw = *(const LAS v2u*)(slot + 8192 + (((tm * 2 + tn) * 4 + g) * 64 + lane) * 8);
                acc[4 * g] = bflo(iw.x); acc[4 * g + 1] = bfhi(iw.x); acc[4 * g + 2] = bflo(iw.y); acc[4 * g + 3] = bfhi(iw.y); }
#pragma unroll
            for (int s4 = 0; s4 < 4; ++s4) { const bf16x8 a = *(const LAS bf16x8*)(slot + ((tm * 8 + hh) * 32 + r32) * 16 + 1024 * s4);
                const bf16x8 bb = *(const LAS bf16x8*)(Sc + (n0 + r32) * CP + 32 * s4 + 16 * hh); acc = __builtin_amdgcn_mfma_f32_32x32x16_bf16(a, bb, acc, 0, 0, 0); }
            store_t(Sn, acc, m0, n0, r32, hh, 1.f);
            if (c + 2 < 128) { issue(c + 2); asm volatile("s_waitcnt vmcnt(4)" ::: "memory"); } else asm volatile("s_waitcnt vmcnt(0)" ::: "memory");
            LBAR();
        }
        LBAR();
    } else if (w < 6) {
        const int tmY = w - 4, m0 = 32 * tmY;
#pragma unroll 1
        for (int c = 0; c < 128; ++c) {
            const LAS unsigned char* slot = RING + (c % 3) * 32768;
            const LAS unsigned char* Sc = (c & 1) ? S1 : S0; LAS float* yo = YR + (c & 1) * 4096;
            f32x16 acc[2]; bf16x8 a[4];
#pragma unroll
            for (int s4 = 0; s4 < 4; ++s4) a[s4] = *(const LAS bf16x8*)(slot + 16384 + ((tmY * 8 + hh) * 32 + r32) * 16 + 1024 * s4);
#pragma unroll
            for (int tn = 0; tn < 2; ++tn) {
#pragma unroll
                for (int g = 0; g < 4; ++g) { const v2u iw = *(const LAS v2u*)(slot + 24576 + (((tmY * 2 + tn) * 4 + g) * 64 + lane) * 8);
                    acc[tn][4 * g] = bflo(iw.x); acc[tn][4 * g + 1] = bfhi(iw.x); acc[tn][4 * g + 2] = bflo(iw.y); acc[tn][4 * g + 3] = bfhi(iw.y); }
#pragma unroll
                for (int s4 = 0; s4 < 4; ++s4) { const bf16x8 bb = *(const LAS bf16x8*)(Sc + (32 * tn + r32) * CP + 32 * s4 + 16 * hh); acc[tn] = __builtin_amdgcn_mfma_f32_32x32x16_bf16(a[s4], bb, acc[tn], 0, 0, 0); }
#pragma unroll
                for (int r = 0; r < 16; ++r) yo[(m0 + (r & 3) + 8 * (r >> 2) + 4 * hh) * 64 + 32 * tn + r32] = acc[tn][r];
            }
            if (c + 2 < 128) { issue(c + 2); asm volatile("s_waitcnt vmcnt(8)" ::: "memory"); } else asm volatile("s_waitcnt vmcnt(0)" ::: "memory");
            LBAR();
        }
        LBAR();
    } else {
        const int row0 = 32 * (w - 6) + (lane >> 4), cq = (lane & 15) * 4;
        float* yg = Y + ((size_t)b * SEQ + row0) * 512 + h * 64 + cq;
        LBAR();
#pragma unroll 1
        for (int c = 1; c <= 128; ++c) {
            const LAS float* yi = YR + ((c - 1) & 1) * 4096 + row0 * 64 + cq;
            f32x4 ty[8];
#pragma unroll
            for (int i = 0; i < 8; ++i) ty[i] = *(const LAS f32x4*)(yi + 4 * i * 64);
            asm volatile("s_waitcnt lgkmcnt(0)" ::: "memory");
#pragma unroll
            for (int i = 0; i < 8; ++i) *(f32x4*)(yg + (size_t)((c - 1) * 64 + 4 * i) * 512) = ty[i];
            LBAR();
        }
    }
#undef SC_DMA
}

__device__ __forceinline__ void phase_odd_main(Frame& F, int layer, int ctr_base, int parts) {
    KARGS;
    const bf16* P = WSP(bf16, WS_PROJ); bf16* MIX = WSP(bf16, WS_MIX); const float* DC = WSP(float, WS_DCUM);
    const int tid = F.tid, lane = F.lane, wave = F.wave, r32 = lane & 31, hh = lane >> 5;
    const float LOG2E = 1.4426950408889634f, CS = 0.125f * LOG2E;
    const int srow = tid >> 3, sch = tid & 7;
    const int myx = (int)((unsigned)__builtin_amdgcn_s_getreg((3 << 11) | 20) & 7u);
    unsigned* sq = (unsigned*)F.ctl + CW_SCQ + (ctr_base == CW_WORK ? 0 : 2048) + layer * 8 * 64;
    if (parts & 1) {
        __syncthreads(); if (tid == 0) F.MISC[19] = atomicAdd(sq + myx * 64, 1u); __syncthreads();
        const int kc = (int)F.MISC[19]; if (kc < 2) rwkv_scan(F, myx + 8 * kc, parts >> 4 ? (parts >> 4) & 7 : 7); }
    if (0) for (int bhs = F.bid; bhs < 16; bhs += F.G) rwkv_scan(F, bhs);
    unsigned* ctr = (unsigned*)F.ctl + ctr_base + 64 * layer;
#ifdef NOSKIP_PROBE
    const float BND = 1e30f;
#else
    const float BND = 2.04f * 8.f * LOG2E * wave_max(fabsf(IN(12)[(layer >> 1) * 64 + lane])) * wave_max(fabsf(IN(13)[(layer >> 1) * 64 + lane]));
#endif
    for (;;) {
        {
            __syncthreads();
            if (tid == 0) F.MISC[16] = atomicAdd(ctr, 1u);
            __syncthreads();
            const int u = (int)F.MISC[16];
            if (u >= 512 || !(parts & 2)) break;
            const int bh = u & 15, qb = 31 - (u >> 4), b = bh >> 3, h = bh & 7;
            const bf16* base = P + (size_t)b * SEQ * ODD_N; const float* dc = DC + (size_t)bh * SEQ;
            const int q0 = 256 * qb + 32 * wave, myq = q0 + r32;
            bf16x8 qf[4];
#pragma unroll
            for (int d0 = 0; d0 < 4; ++d0) qf[d0] = *(const bf16x8*)(base + (size_t)myq * ODD_N + h * 64 + 16 * d0 + 8 * hh);
            const float dq = dc[myq] * LOG2E;
            float m = -INFINITY, lsum = 0.f;
            f32x16 o[2];
#pragma unroll
            for (int r = 0; r < 16; ++r) { o[0][r] = 0.f; o[1][r] = 0.f; }
            const int NT = 4 * qb + 4;
            if (wave < 2) { const int jt = tid; const bool nd = jt < NT && (BND + (dc[256 * qb] - dc[64 * (jt < NT ? jt : 0) + 63]) * LOG2E >= -150.f);
                const unsigned long long mk = __ballot(nd); if (lane == 0) F.MISC[17 + wave] = mk ? (unsigned)(64 * wave + (int)__builtin_ctzll(mk)) : 1000u; }
            __syncthreads();
            const int jstart = (int)(F.MISC[17] < F.MISC[18] ? F.MISC[17] : F.MISC[18]);
            const float dqw = __builtin_bit_cast(float, __builtin_amdgcn_readfirstlane(__builtin_bit_cast(int, dq)));
            v4u kreg = *(const v4u*)(base + (size_t)(64 * jstart + srow) * ODD_N + 512 + h * 64 + sch * 8);
            v4u vreg = *(const v4u*)(base + (size_t)(64 * jstart + srow) * ODD_N + 1024 + h * 64 + sch * 8);
            float dreg = tid < 64 ? -dc[64 * jstart + tid] * LOG2E : 0.f;
            *(LAS v4u*)(F.lds + srow * FX_KROW + sch * 16) = kreg; *(LAS v4u*)(F.lds + FX_KB + srow * FX_VROW + sch * 16) = vreg;
            if (tid < 64) *(LAS float*)(F.lds + FX_KB + FX_VB + tid * 4) = dreg;
            __syncthreads();
            v4u kA = kreg, vA = vreg, kB = kreg, vB = vreg; float dA = 0.f, dB = 0.f;
            if (jstart + 1 < NT) { const size_t krow = (size_t)(64 * (jstart + 1) + srow) * ODD_N;
                kA = *(const v4u*)(base + krow + 512 + h * 64 + sch * 8); vA = *(const v4u*)(base + krow + 1024 + h * 64 + sch * 8);
                if (tid < 64) dA = dc[64 * (jstart + 1) + tid]; }
            auto tile_step = [&](const int j, v4u& kx, v4u& vx, float& dx, v4u& ky, v4u& vy, float& dy) {
                const int cur = ((j - jstart) & 1) * FX_BUF, nxt = ((j - jstart + 1) & 1) * FX_BUF;
                if (j + 2 < NT) { const size_t krow = (size_t)(64 * (j + 2) + srow) * ODD_N;
                    ky = *(const v4u*)(base + krow + 512 + h * 64 + sch * 8); vy = *(const v4u*)(base + krow + 1024 + h * 64 + sch * 8);
                    if (tid < 64) dy = dc[64 * (j + 2) + tid]; }
                if (64 * j <= q0 + 31 && BND + dqw + *(const LAS float*)(F.lds + cur + FX_KB + FX_VB + 63 * 4) >= -150.f) {
                    const LAS unsigned char* Kb = F.lds + cur; const LAS unsigned char* Vb = F.lds + cur + FX_KB; const LAS float* dkb = (const LAS float*)(F.lds + cur + FX_KB + FX_VB);
                    f32x16 p0, p1;
#pragma unroll
                    for (int r = 0; r < 16; ++r) { p0[r] = 0.f; p1[r] = 0.f; }
#pragma unroll
                    for (int d0 = 0; d0 < 4; ++d0) {
                        const bf16x8 a0 = *(const LAS bf16x8*)(Kb + r32 * FX_KROW + 32 * d0 + 16 * hh);
                        const bf16x8 a1 = *(const LAS bf16x8*)(Kb + (r32 + 32) * FX_KROW + 32 * d0 + 16 * hh);
                        p0 = __builtin_amdgcn_mfma_f32_32x32x16_bf16(a0, qf[d0], p0, 0, 0, 0);
                        p1 = __builtin_amdgcn_mfma_f32_32x32x16_bf16(a1, qf[d0], p1, 0, 0, 0);
                    }
                    const bool diag = 64 * j + 63 > q0;
#pragma unroll
                    for (int g = 0; g < 4; ++g) {
                        const f32x4 dk0 = *(const LAS f32x4*)(dkb + 8 * g + 4 * hh), dk1 = *(const LAS f32x4*)(dkb + 32 + 8 * g + 4 * hh);
#pragma unroll
                        for (int i = 0; i < 4; ++i) { p0[4 * g + i] = p0[4 * g + i] * CS + dk0[i]; p1[4 * g + i] = p1[4 * g + i] * CS + dk1[i]; }
                    }
                    if (diag) {
                        asm volatile("" ::: "memory");
#pragma unroll
                        for (int r = 0; r < 16; ++r) { const int key = 64 * j + (r & 3) + 8 * (r >> 2) + 4 * hh; if (key > myq) p0[r] = -INFINITY; if (key + 32 > myq) p1[r] = -INFINITY; }
                    }
                    float tmax;
                    {
                        float ta = MAX3F(p0[0], p0[1], p1[0]), tb = MAX3F(p0[2], p0[3], p1[1]); ta = MAX3F(ta, p1[2], p1[3]);
#pragma unroll
                        for (int r = 4; r < 16; r += 4) { ta = MAX3F(ta, p0[r], p0[r + 1]); tb = MAX3F(tb, p0[r + 2], p0[r + 3]); ta = MAX3F(ta, p1[r], p1[r + 1]); tb = MAX3F(tb, p1[r + 2], p1[r + 3]); }
                        tmax = fmaxf(ta, tb); }
                    tmax = fmaxf(tmax, __shfl_xor(tmax, 32));
                    const float mn = fmaxf(m, tmax); const float corr = __builtin_amdgcn_exp2f(m - mn); m = mn;
                    float ps = 0.f;
#pragma unroll
                    for (int r = 0; r < 16; ++r) { p0[r] = __builtin_amdgcn_exp2f(p0[r] - mn); p1[r] = __builtin_amdgcn_exp2f(p1[r] - mn); ps += p0[r] + p1[r]; }
                    lsum = lsum * corr + ps;
                    if (__any(corr != 1.f)) {
                        asm volatile("" ::: "memory");
#pragma unroll
                        for (int r = 0; r < 16; ++r) { o[0][r] *= corr; o[1][r] *= corr; } }
                    bf16x8 pf[4];
#pragma unroll
                    for (int s4 = 0; s4 < 4; ++s4) {
                        v4u w;
                        if (s4 < 2) { w.x = pk2(p0[8 * s4 + 0], p0[8 * s4 + 1]); w.y = pk2(p0[8 * s4 + 2], p0[8 * s4 + 3]); w.z = pk2(p0[8 * s4 + 4], p0[8 * s4 + 5]); w.w = pk2(p0[8 * s4 + 6], p0[8 * s4 + 7]); }
                        else { const int sp = s4 - 2; w.x = pk2(p1[8 * sp + 0], p1[8 * sp + 1]); w.y = pk2(p1[8 * sp + 2], p1[8 * sp + 3]); w.z = pk2(p1[8 * sp + 4], p1[8 * sp + 5]); w.w = pk2(p1[8 * sp + 6], p1[8 * sp + 7]); }
                        pf[s4] = __builtin_bit_cast(bf16x8, w);
                    }
                    const int gi = lane >> 4, li = lane & 15;
                    const LAS unsigned char* vbase = Vb + (4 * (gi >> 1) + (li >> 2)) * FX_VROW + (16 * (gi & 1) + 4 * (li & 3)) * 2;
#pragma unroll
                    for (int d0 = 0; d0 < 2; ++d0)
#pragma unroll
                        for (int s4 = 0; s4 < 4; ++s4) {
                            const s16x4 lo = __builtin_bit_cast(s16x4, __builtin_amdgcn_ds_read_tr16_b64_v4i16((LAS s16x4*)(vbase + (16 * s4) * FX_VROW + 64 * d0)));
                            const s16x4 hi = __builtin_bit_cast(s16x4, __builtin_amdgcn_ds_read_tr16_b64_v4i16((LAS s16x4*)(vbase + (16 * s4 + 8) * FX_VROW + 64 * d0)));
                            const bf16x8 vf = (bf16x8){lo[0], lo[1], lo[2], lo[3], hi[0], hi[1], hi[2], hi[3]};
                            o[d0] = __builtin_amdgcn_mfma_f32_32x32x16_bf16(vf, pf[s4], o[d0], 0, 0, 0);
                        }
                }
                if (j + 1 < NT) {
                    *(LAS v4u*)(F.lds + nxt + srow * FX_KROW + sch * 16) = kx; *(LAS v4u*)(F.lds + nxt + FX_KB + srow * FX_VROW + sch * 16) = vx;
                    if (tid < 64) *(LAS float*)(F.lds + nxt + FX_KB + FX_VB + tid * 4) = -dx * LOG2E;
                }
                LBAR();
            };
            for (int j = jstart; j < NT; j += 2) {
                tile_step(j, kA, vA, dA, kB, vB, dB);
                if (j + 1 < NT) tile_step(j + 1, kB, vB, dB, kA, vA, dA);
            }
            const float l = lsum + __shfl_xor(lsum, 32); const float inv = 1.f / l;
            const bf16* gp = base + (size_t)myq * ODD_N + 1536 + h * 64; bf16* op = MIX + ((size_t)b * SEQ + myq) * D + h * 64;
#pragma unroll
            for (int d0 = 0; d0 < 2; ++d0)
#pragma unroll
                for (int g = 0; g < 4; ++g) { const int db = 32 * d0 + 8 * g + 4 * hh; const v2u gw = *(const v2u*)(gp + db);
                    const float g0 = sigmoidf_(bflo(gw.x)), g1 = sigmoidf_(bfhi(gw.x)), g2 = sigmoidf_(bflo(gw.y)), g3 = sigmoidf_(bfhi(gw.y));
                    v2u ow; ow.x = pk2(o[d0][4 * g + 0] * inv * g0, o[d0][4 * g + 1] * inv * g1); ow.y = pk2(o[d0][4 * g + 2] * inv * g2, o[d0][4 * g + 3] * inv * g3);
                    *(v2u*)(op + db) = ow; }
        }
    }
    if (parts & 1) for (int dx = 0; dx < 8; ++dx) { const int xs = (myx + dx) & 7;
        for (;;) { __syncthreads(); if (tid == 0) F.MISC[19] = atomicAdd(sq + xs * 64, 1u); __syncthreads(); const int kc = (int)F.MISC[19]; if (kc >= 2) break; rwkv_scan(F, xs + 8 * kc); } }
}

__device__ __forceinline__ void phase_rwkv_post(Frame& F, int layer) {
    KARGS;
    const int jj = layer >> 1, ch = F.tid;
    const float* R = WSP(float, WS_RW); const float* K = WSP(float, WS_RW + 2 * RW_SLOT); const float* V = WSP(float, WS_RW + 3 * RW_SLOT);
    const float* Gt = WSP(float, WS_RW + 6 * RW_SLOT); const float* Y = WSP(float, WS_RW + 7 * RW_SLOT);
    bf16* MIX = WSP(bf16, WS_MIX);
    const float lw = IN(24)[jj * 512 + ch], lb = IN(25)[jj * 512 + ch], rk = IN(23)[jj * 512 + ch];
#pragma unroll 4
    for (int tg = F.bid; tg < T; tg += F.G) {
        const size_t o = (size_t)tg * 512 + ch;
        const float y = Y[o]; const float mu = wave_sum(y) * (1.f / 64.f); const float dlt = y - mu; const float var = wave_sum(dlt * dlt) * (1.f / 64.f);
        const float yn = dlt * rsqrtf(var + GN_EPS) * lw + lb;
        const float v = V[o]; const float bonus = wave_sum(R[o] * K[o] * rk) * v;
        MIX[(size_t)tg * D + 512 + ch] = (bf16)f2bf((yn + bonus) * Gt[o]);
    }
}

__device__ __forceinline__ void sort16_desc(float (&v)[16]) {
#pragma unroll
    for (int k = 2; k <= 16; k <<= 1)
#pragma unroll
        for (int j = k >> 1; j > 0; j >>= 1)
#pragma unroll
            for (int i = 0; i < 16; ++i) { const int l = i ^ j; if (l > i) { const float a_ = v[i], b_ = v[l]; const float mx = fmaxf(a_, b_), mn = fminf(a_, b_);
                if ((i & k) == 0) { v[i] = mx; v[l] = mn; } else { v[i] = mn; v[l] = mx; } } }
}
__device__ __forceinline__ void merge16_desc(float (&A)[16], const float (&B)[16]) {
#pragma unroll
    for (int i = 0; i < 16; ++i) A[i] = fmaxf(A[i], B[15 - i]);
#pragma unroll
    for (int j = 8; j > 0; j >>= 1)
#pragma unroll
        for (int i = 0; i < 16; ++i) { const int l = i ^ j; if (l > i) { const float a_ = A[i], b_ = A[l]; A[i] = fmaxf(a_, b_); A[l] = fminf(a_, b_); } }
}
__device__ __forceinline__ float pack_low(float v, unsigned bits, unsigned mask) { return __builtin_bit_cast(float, (__builtin_bit_cast(unsigned, v) & ~mask) | bits); }
template <bool OWN> __device__ __forceinline__ void phase_peer_topk(Frame& F, int layer, const pg8::StaticOrder S) {
    KARGS;
    const bf16* Q = WSP(bf16, WS_Q); const bf16* KEYS = WSP(bf16, WS_KEYS) + (size_t)layer * 2 * 16384;
    int* IDX = WSP(int, WS_IDX); float* GATE = WSP(float, WS_GATE);
    constexpr int SCP = 132;
    LAS float* sc = (LAS float*)(F.lds + F.wave * (32 * SCP * 4));
    LAS unsigned* li = (LAS unsigned*)sc;
    const int lane = F.lane, fr = lane & 15, fq = lane >> 4, tok = lane & 31, hp = lane >> 5;
    const int gw = F.bid * NWAVES + F.wave, NGW = F.G * NWAVES;
    pg8::Unit un{0, 0};
    const bool cv = OWN && layer < 3;
    const int NRW = (2 * NEXP + NGW - 1) / NGW;
    int cr = 0;
    f32x4 cvv[2][4];
    for (int it = OWN ? 0 : gw; OWN ? S.next(it, un) : (it < (T / 32) * 8); it += OWN ? 1 : NGW) {
        const int tile = OWN ? un.pm * 8 + F.wave : (it >> 3), h = OWN ? un.pn : (it & 7), t0 = tile * 32;
        float v1[16], v2[16];
#pragma unroll
        for (int half = 0; half < 2; ++half) {
            f32x4 acc[2][8];
#pragma unroll
            for (int rt = 0; rt < 2; ++rt)
#pragma unroll
                for (int ct = 0; ct < 8; ++ct) acc[rt][ct] = (f32x4){0.f, 0.f, 0.f, 0.f};
            const bf16* kb = KEYS + (size_t)half * 16384;
#pragma unroll 1
            for (int ks = 0; ks < 4; ++ks) {
                bf16x8 a[2];
#pragma unroll
                for (int rt = 0; rt < 2; ++rt) a[rt] = *(const bf16x8*)(Q + (size_t)(t0 + rt * 16 + fr) * 2048 + h * 256 + half * 128 + ks * 32 + 8 * fq);
#pragma unroll
                for (int ct = 0; ct < 8; ++ct) { const bf16x8 bb = *(const bf16x8*)(kb + (size_t)(ct * 16 + fr) * 128 + ks * 32 + 8 * fq);
#pragma unroll
                    for (int rt = 0; rt < 2; ++rt) acc[rt][ct] = __builtin_amdgcn_mfma_f32_16x16x32_bf16(a[rt], bb, acc[rt][ct], 0, 0, 0); }
            }
            if (cv && cr < NRW) conv_issue<2>(IN(29), IN(30), layer + 1, gw + cr * NGW, NGW, lane, cvv);
#pragma unroll
            for (int rt = 0; rt < 2; ++rt)
#pragma unroll
                for (int ct = 0; ct < 8; ++ct)
#pragma unroll
                    for (int r = 0; r < 4; ++r) sc[(rt * 16 + 4 * fq + r) * SCP + ct * 16 + fr] = pack_low(acc[rt][ct][r], (unsigned)(ct * 16 + fr), 0x7Fu);
            LDS_WAIT(); asm volatile("" ::: "memory");
            float top[16];
            const LAS float* row = sc + tok * SCP + 64 * hp;
#pragma unroll 1
            for (int g = 0; g < 4; ++g) {
                float grp[16];
#pragma unroll
                for (int q4 = 0; q4 < 4; ++q4) { const f32x4 x = *(const LAS f32x4*)(row + 16 * g + 4 * q4); grp[4 * q4] = x.x; grp[4 * q4 + 1] = x.y; grp[4 * q4 + 2] = x.z; grp[4 * q4 + 3] = x.w; }
                sort16_desc(grp);
                if (g == 0) {
#pragma unroll
                    for (int p = 0; p < 16; ++p) top[p] = grp[p]; }
                else merge16_desc(top, grp);
            }
            { float oth[16];
#pragma unroll
              for (int p = 0; p < 16; ++p) oth[p] = __shfl_xor(top[p], 32);
              merge16_desc(top, oth); }
            LDS_WAIT(); asm volatile("" ::: "memory");
#pragma unroll
            for (int p = 0; p < 16; ++p) { if (half == 0) v1[p] = top[p]; else v2[p] = top[p]; }
            if (cv && cr < NRW) { conv_finish<2>(WSP(unsigned char, WS_PU), WSP(unsigned char, WS_PV), WSP(float, WS_PS), layer + 1, gw + cr * NGW, NGW, lane, cvv, F.lds + 135168 + F.wave * 1024); cr += 2; }
        }
        if (hp == 0) {
#pragma unroll
            for (int p = 0; p < 16; ++p) { li[tok * 33 + p] = __builtin_bit_cast(unsigned, v1[p]) & 0x7Fu; li[tok * 33 + 16 + p] = __builtin_bit_cast(unsigned, v2[p]) & 0x7Fu; } }
        if (cv && cr < NRW) conv_issue<2>(IN(29), IN(30), layer + 1, gw + cr * NGW, NGW, lane, cvv);
        float ts[16];
        {
            float c0[16], c1[16];
            int n = 0;
#pragma unroll
            for (int a_ = 0; a_ < 16; ++a_)
#pragma unroll
                for (int b_ = 0; b_ < 16; ++b_) if ((a_ + 1) * (b_ + 1) <= 16) {
                    const float x = pack_low(v1[a_] + v2[b_], (unsigned)(a_ * 16 + b_), 0xFFu);
                    const int slot = n >> 1; const bool mine = (n & 1) == hp;
                    if (slot < 16) { if ((n & 1) == 0) c0[slot] = mine ? x : -INFINITY; else c0[slot] = mine ? x : c0[slot]; }
                    else { if ((n & 1) == 0) c1[slot - 16] = mine ? x : -INFINITY; else c1[slot - 16] = mine ? x : c1[slot - 16]; }
                    ++n; }
#pragma unroll
            for (int sl = 9; sl < 16; ++sl) c1[sl] = -INFINITY;
            sort16_desc(c0); sort16_desc(c1); merge16_desc(c0, c1);
            float oth[16];
#pragma unroll
            for (int p = 0; p < 16; ++p) oth[p] = __shfl_xor(c0[p], 32);
            merge16_desc(c0, oth);
#pragma unroll
            for (int p = 0; p < 16; ++p) ts[p] = c0[p];
        }
        LDS_WAIT(); asm volatile("" ::: "memory");
        if (cv && cr < NRW) { conv_finish<2>(WSP(unsigned char, WS_PU), WSP(unsigned char, WS_PV), WSP(float, WS_PS), layer + 1, gw + cr * NGW, NGW, lane, cvv, F.lds + 135168 + F.wave * 1024); cr += 2; }
        if (hp == 0) {
            float e[16], sum = 0.f;
#pragma unroll
            for (int p = 0; p < 16; ++p) { e[p] = expf(ts[p] - ts[0]); sum += e[p]; }
            const float inv = 1.f / sum;
            int* ip = IDX + (size_t)(t0 + tok) * 128 + h * 16; float* gp = GATE + (size_t)(t0 + tok) * 128 + h * 16;
#pragma unroll
            for (int p = 0; p < 16; ++p) { const unsigned ab = __builtin_bit_cast(unsigned, ts[p]) & 0xFFu;
                ip[p] = (int)(li[tok * 33 + (ab >> 4)] * 128u + li[tok * 33 + 16 + (ab & 15u)]); gp[p] = e[p] * inv; }
        }
        LDS_WAIT(); asm volatile("" ::: "memory");
    }
    while (cv && cr < NRW) { f32x4 v4[4][4];
        conv_issue<4>(IN(29), IN(30), layer + 1, gw + cr * NGW, NGW, lane, v4);
        conv_finish<4>(WSP(unsigned char, WS_PU), WSP(unsigned char, WS_PV), WSP(float, WS_PS), layer + 1, gw + cr * NGW, NGW, lane, v4, F.lds + 135168 + F.wave * 1024); cr += 4; }
}

typedef float f32x2 __attribute__((ext_vector_type(2)));
__device__ __forceinline__ void unpack16_fp8(float (&o)[16], const v4u w) {
#pragma unroll
    for (int j = 0; j < 4; ++j) { const f32x2 a = __builtin_amdgcn_cvt_pk_f32_fp8((int)w[j], false), b = __builtin_amdgcn_cvt_pk_f32_fp8((int)w[j], true); o[4 * j] = a.x; o[4 * j + 1] = a.y; o[4 * j + 2] = b.x; o[4 * j + 3] = b.y; }
}
__device__ __forceinline__ void gu_token(const unsigned char* U, const float* SU, const float* SV, const bf16* H, const int* IDX, const float* GATE, float* ACT, int s, int tg, int lane) {
    float x[16];
    { const v4u w0 = *(const v4u*)(H + (size_t)tg * D + 16 * lane), w1 = *(const v4u*)(H + (size_t)tg * D + 16 * lane + 8);
      x[0] = bflo(w0.x); x[1] = bfhi(w0.x); x[2] = bflo(w0.y); x[3] = bfhi(w0.y); x[4] = bflo(w0.z); x[5] = bfhi(w0.z); x[6] = bflo(w0.w); x[7] = bfhi(w0.w);
      x[8] = bflo(w1.x); x[9] = bfhi(w1.x); x[10] = bflo(w1.y); x[11] = bfhi(w1.y); x[12] = bflo(w1.z); x[13] = bfhi(w1.z); x[14] = bflo(w1.w); x[15] = bfhi(w1.w); }
#pragma unroll
    for (int half = 0; half < 2; ++half) {
        const int id = IDX[(size_t)tg * 128 + 64 * half + lane];
        const bool sel = (id >> 11) == s;
        unsigned long long m = __ballot(sel);
        const float su = sel ? SU[id] : 0.f, cf = sel ? GATE[(size_t)tg * 128 + 64 * half + lane] * SV[id] : 0.f;
        int actb = 0;
        while (m) {
            int pos[8]; v4u ua[8]; float d[8];
#pragma unroll
            for (int q = 0; q < 8; ++q) { pos[q] = m ? (int)__builtin_ctzll(m) : -1; m = m ? (m & (m - 1)) : m;
                const int idx = pos[q] >= 0 ? __builtin_amdgcn_readlane(id, pos[q]) : (s << 11);
                ua[q] = *(const v4u*)(U + (size_t)idx * 1024 + 16 * lane); }
#pragma unroll
            for (int q = 0; q < 8; ++q) { float u[16]; unpack16_fp8(u, ua[q]); float sm = 0.f;
#pragma unroll
                for (int i = 0; i < 16; ++i) sm += u[i] * x[i];
                d[q] = sm; }
#pragma unroll
            for (int o = 1; o < 64; o <<= 1) {
#pragma unroll
                for (int q = 0; q < 8; ++q) d[q] += __shfl_xor(d[q], o); }
#pragma unroll
            for (int q = 0; q < 8; ++q) if (pos[q] >= 0) { const float val = gelu_erf(d[q] * rl(su, pos[q])) * rl(cf, pos[q]);
                actb = lane == pos[q] ? __builtin_bit_cast(int, val) : actb; }
        }
        if (sel) ACT[(size_t)tg * 128 + 64 * half + lane] = __builtin_bit_cast(float, actb);
    }
}

__device__ __forceinline__ void phase_peer_gu_valu(Frame& F, int layer) {
    KARGS;
    const bf16* H = WSP(bf16, WS_H); const int* IDX = WSP(int, WS_IDX); const float* GATE = WSP(float, WS_GATE); float* ACT = WSP(float, WS_ACT);
    const unsigned char* U = WSP(unsigned char, WS_PU) + (size_t)layer * NEXP * 1024;
    const float* SU = WSP(float, WS_PS) + (size_t)layer * NEXP; const float* SV = SU + 4 * NEXP;
    const int lane = F.lane;
    unsigned* heads = (unsigned*)F.ctl + CW_G1 + layer * 8 * 64;
    const int myx = (int)((unsigned)__builtin_amdgcn_s_getreg((3 << 11) | 20) & 7u);
    for (int k = 0; k < 8; ++k) { const int s = (myx + k) & 7;
        for (;;) { unsigned u = 0; if (lane == 0) u = atomicAdd(heads + s * 64, 1u); u = (unsigned)__builtin_amdgcn_readfirstlane((int)u);
            if (u >= (unsigned)(T / 8)) break;
#pragma unroll 1
            for (int i = 0; i < 8; ++i) gu_token(U, SU, SV, H, IDX, GATE, ACT, s, (int)u * 8 + i, lane); } }
}
__device__ __forceinline__ void phase_peer_gu(Frame& F, int layer) {
    KARGS;
    const int* IDX = WSP(int, WS_IDX); const float* GATE = WSP(float, WS_GATE); float* ACT = WSP(float, WS_ACT);
    const unsigned char* U = WSP(unsigned char, WS_PU) + (size_t)layer * NEXP * 512; const unsigned char* SC6 = WSP(unsigned char, WS_PU) + (size_t)48 * MiB + (size_t)layer * NEXP * 32;
    const unsigned char* H8 = WSP(unsigned char, WS_H8); const float* HS = WSP(float, WS_HS);
    const float* SU = WSP(float, WS_PS) + (size_t)layer * NEXP; const float* SV = SU + 4 * NEXP;
    const int lane = F.lane, row = lane & 15, kc = lane >> 4;
    LAS int* lst = (LAS int*)(F.lds + F.wave * 18432);
    LAS unsigned char* xl = F.lds + F.wave * 18432 + 8192;
    LAS float* cpatch = (LAS float*)(F.lds + F.wave * 18432 + 8192 + 8320);
    unsigned* heads = (unsigned*)F.ctl + CW_G1 + layer * 8 * 64;
    const int myx = (int)((unsigned)__builtin_amdgcn_s_getreg((3 << 11) | 20) & 7u);
    struct TSet { v4u ua[8]; v2u sc; int e, meta; float su, sv, gt, xs; bool valid; };
    for (int k = 0; k < 8; ++k) {
        const int s = (myx + k) & 7;
        for (;;) {
            unsigned u = 0; if (lane == 0) u = atomicAdd(heads + s * 64, 1u); u = (unsigned)__builtin_amdgcn_readfirstlane((int)u);
            if (u >= (unsigned)(T / 8)) break;
            const int tg0 = (int)u * 8;
            int total = 0;
            int ida[8], idb[8]; v4u hx[8];
#pragma unroll
            for (int i = 0; i < 8; ++i) { ida[i] = IDX[(size_t)(tg0 + i) * 128 + lane]; idb[i] = IDX[(size_t)(tg0 + i) * 128 + 64 + lane]; hx[i] = *(const v4u*)(H8 + (size_t)(tg0 + i) * D + 16 * lane); }
#pragma unroll
            for (int i = 0; i < 8; ++i) {
                const int id0 = ida[i], id1 = idb[i];
                *(LAS v4u*)(xl + i * 1040 + 16 * lane) = hx[i];
                const bool sel0 = (id0 >> 11) == s, sel1 = (id1 >> 11) == s;
                const unsigned long long m0 = __ballot(sel0), m1 = __ballot(sel1);
                const int n0 = __builtin_popcountll(m0), cnt = n0 + __builtin_popcountll(m1);
                const int r0 = total + (int)__builtin_amdgcn_mbcnt_hi((unsigned)(m0 >> 32), __builtin_amdgcn_mbcnt_lo((unsigned)m0, 0u));
                const int r1 = total + n0 + (int)__builtin_amdgcn_mbcnt_hi((unsigned)(m1 >> 32), __builtin_amdgcn_mbcnt_lo((unsigned)m1, 0u));
                if (sel0) { lst[r0] = id0; lst[1024 + r0] = i * 128 + lane; }
                if (sel1) { lst[r1] = id1; lst[1024 + r1] = i * 128 + 64 + lane; }
                total += cnt; }
            LDS_WAIT(); asm volatile("" ::: "memory");
            const int ntile = (total + 15) >> 4;
            auto load_tile = [&](TSet& S, const int t) { if (t < ntile) {
                const int rr = 16 * t + row; S.valid = rr < total;
                const int ri = S.valid ? rr : 16 * t;
                S.e = lst[ri]; S.meta = lst[1024 + ri];
                const int rq = 16 * t + (lane >> 2); const int eq = lst[rq < total ? rq : 16 * t];
                const unsigned char* up = U + (size_t)eq * 512 + 16 * (lane & 3);
#pragma unroll
                for (int j = 0; j < 8; ++j) S.ua[j] = *(const v4u*)(up + 64 * j);
                S.sc = *(const v2u*)(SC6 + (size_t)eq * 32 + 8 * (lane & 3));
                S.su = 0.f; S.sv = 0.f; S.gt = 0.f; S.xs = 0.f;
                if (kc == 0) { S.su = 1.f; S.sv = SV[S.e]; S.gt = GATE[(size_t)(tg0 + (S.meta >> 7)) * 128 + (S.meta & 127)]; S.xs = HS[tg0 + (S.meta >> 7)]; } } };
            const LAS unsigned char* xp = xl + (row & 7) * 1040 + 16 * kc;
            auto compute_tile = [&](TSet& S, const int t) { if (t < ntile) {
                f32x4 acc0 = (f32x4){0.f, 0.f, 0.f, 0.f}, acc1 = acc0;
                { const int psrc = 4 * (4 * (lane & 15) + (lane >> 4));
#pragma unroll
                  for (int j = 0; j < 8; ++j)
#pragma unroll
                      for (int c = 0; c < 4; ++c) S.ua[j][c] = (unsigned)__builtin_amdgcn_ds_bpermute(psrc, (int)S.ua[j][c]);
                  S.sc.x = (unsigned)__builtin_amdgcn_ds_bpermute(psrc, (int)S.sc.x); S.sc.y = (unsigned)__builtin_amdgcn_ds_bpermute(psrc, (int)S.sc.y); }
#define GU_MM(m, ACC) { const v4u xb0 = *(const LAS v4u*)(xp + 128 * (m)), xb1 = *(const LAS v4u*)(xp + 128 * (m) + 64); v8i av; \
                    _Pragma("unroll") for (int d = 0; d < 8; ++d) { av[d] = d < 4 ? (int)S.ua[(m)][d & 3] : 0; } \
                    const v8i bv = (v8i){(int)xb0.x, (int)xb0.y, (int)xb0.z, (int)xb0.w, (int)xb1.x, (int)xb1.y, (int)xb1.z, (int)xb1.w}; \
                    ACC = __builtin_amdgcn_mfma_scale_f32_16x16x128_f8f6f4(av, bv, ACC, 4, 0, (m) & 3, (int)S.sc[(m) >> 2], 0, 0x7F7F7F7F); }
                GU_MM(0, acc0) GU_MM(1, acc1) GU_MM(2, acc0) GU_MM(3, acc1) GU_MM(4, acc0) GU_MM(5, acc1) GU_MM(6, acc0) GU_MM(7, acc1)
#undef GU_MM
                acc0 += acc1;
#pragma unroll
                for (int q = 0; q < 4; ++q) cpatch[(4 * kc + q) * 17 + row] = acc0[q];
                LDS_WAIT(); asm volatile("" ::: "memory");
                const float d = cpatch[row * 17 + (S.meta >> 7)];
                if (S.valid && kc == 0) { const int tg = tg0 + (S.meta >> 7); const float av = gelu_erf(d * S.su * S.xs) * S.gt * S.sv;
                    const unsigned sl = (unsigned)(S.meta & 127);
                    const unsigned ab = __builtin_bit_cast(unsigned, av), eo = (unsigned)S.e << 3, mag = ab & 0x7FFFFFFFu;
                    const unsigned tq = mag > eo ? (mag - eo + 0x10000u) & 0xFFFE0000u : 0u;
                    ((unsigned*)ACT)[(((size_t)(tg >> 6) * 32 + (sl >> 2)) * 64 + (tg & 63)) * 4 + (sl & 3)] = (ab & 0x80000000u) | tq | eo; }
                LDS_WAIT(); asm volatile("" ::: "memory"); } };
            TSet A_, B_;
            load_tile(A_, 0);
#pragma unroll 1
            for (int t = 0; t < ntile; t += 2) { load_tile(B_, t + 1); compute_tile(A_, t); load_tile(A_, t + 2); compute_tile(B_, t + 1); }
            LDS_WAIT(); asm volatile("" ::: "memory");
        }
    }
}
__device__ __forceinline__ void gv_token(const unsigned char* Vc, const int* IDX, const float* ACT, const float* g2, float* X, int c, int tg, int lane) {
    const int g = lane >> 3, cl = lane & 7, b = tg >= SEQ ? 1 : 0;
    int iv[16]; float cv[16];
#pragma unroll
    for (int j = 0; j < 4; ++j) { const v4u a = *(const v4u*)(IDX + (size_t)tg * 128 + 16 * g + 4 * j); const f32x4 f = *(const f32x4*)(ACT + (size_t)tg * 128 + 16 * g + 4 * j);
        iv[4 * j] = (int)a.x; iv[4 * j + 1] = (int)a.y; iv[4 * j + 2] = (int)a.z; iv[4 * j + 3] = (int)a.w; cv[4 * j] = f.x; cv[4 * j + 1] = f.y; cv[4 * j + 2] = f.z; cv[4 * j + 3] = f.w; }
    float acc[16];
#pragma unroll
    for (int i = 0; i < 16; ++i) acc[i] = 0.f;
#pragma unroll
    for (int k0 = 0; k0 < 16; k0 += 8) {
        v4u seg[8];
#pragma unroll
        for (int k = 0; k < 8; ++k) seg[k] = *(const v4u*)(Vc + ((size_t)c * NEXP + iv[k0 + k]) * 128 + 16 * cl);
#pragma unroll
        for (int k = 0; k < 8; ++k) { float v[16]; unpack16_fp8(v, seg[k]);
#pragma unroll
            for (int i = 0; i < 16; ++i) acc[i] += v[i] * cv[k0 + k]; }
    }
#pragma unroll
    for (int o = 8; o < 64; o <<= 1) {
#pragma unroll
        for (int i = 0; i < 16; ++i) acc[i] += __shfl_xor(acc[i], o); }
    if (lane < 8) { float* xr = X + (size_t)tg * D + 128 * c + 16 * cl; const float* gg = g2 + b * 6144 + 128 * c + 16 * cl;
#pragma unroll
        for (int j = 0; j < 4; ++j) { const f32x4 g4 = *(const f32x4*)(gg + 4 * j); *(f32x4*)(xr + 4 * j) = *(const f32x4*)(xr + 4 * j) + g4 * (f32x4){acc[4 * j], acc[4 * j + 1], acc[4 * j + 2], acc[4 * j + 3]}; } }
}

__device__ __forceinline__ void phase_peer_gv_old(Frame& F, int layer) {
    KARGS;
    const int* IDX = WSP(int, WS_IDX); const float* ACT = WSP(float, WS_ACT);
    const unsigned char* Vc = WSP(unsigned char, WS_PV) + (size_t)layer * NEXP * 1024;
    const float* g2 = WSP(float, WS_MOD) + (size_t)layer * 2 * 6144 + 5120;
    float* X = OUTP; const int lane = F.lane;
    unsigned* heads = (unsigned*)F.ctl + CW_G2 + layer * 8 * 64;
    const int myx = (int)((unsigned)__builtin_amdgcn_s_getreg((3 << 11) | 20) & 7u);
    for (int k = 0; k < 8; ++k) { const int c = (myx + k) & 7;
        for (;;) { unsigned u = 0; if (lane == 0) u = atomicAdd(heads + c * 64, 1u); u = (unsigned)__builtin_amdgcn_readfirstlane((int)u);
            if (u >= (unsigned)(T / 8)) break;
#pragma unroll 1
            for (int i = 0; i < 8; ++i) gv_token(Vc, IDX, ACT, g2, X, c, (int)u * 8 + i, lane); } }
}
__device__ __forceinline__ void phase_peer_gv_l2(Frame& F, int layer) {
    KARGS;
    const int* IDX = WSP(int, WS_IDX); const float* ACT = WSP(float, WS_ACT);
    const unsigned char* Vc = WSP(unsigned char, WS_PV) + (size_t)layer * NEXP * 1024;
    const float* g2 = WSP(float, WS_MOD) + (size_t)layer * 2 * 6144 + 5120;
    float* X = OUTP;
    const int lane = F.lane, g = lane >> 3, cl = lane & 7;
    LAS unsigned* li_ = (LAS unsigned*)(F.lds + 8192 + F.wave * 8192);
    LAS float* la_ = (LAS float*)(F.lds + 8192 + F.wave * 8192 + 4096);
    unsigned* heads = (unsigned*)F.ctl + CW_G2 + layer * 8 * 64;
    const int myx = (int)((unsigned)__builtin_amdgcn_s_getreg((3 << 11) | 20) & 7u);
    for (int k = 0; k < 8; ++k) {
        const int c = (myx + k) & 7;
        for (;;) {
            unsigned u = 0; if (lane == 0) u = atomicAdd(heads + c * 64, 1u); u = (unsigned)__builtin_amdgcn_readfirstlane((int)u);
            if (u >= (unsigned)(T / 8)) break;
            const int tg = (int)u * 8 + g, b = tg >= SEQ ? 1 : 0;
#pragma unroll
            for (int j = 0; j < 4; ++j) { const v4u a = *(const v4u*)(IDX + (size_t)tg * 128 + 16 * cl + 4 * j); const f32x4 f = *(const f32x4*)(ACT + (size_t)tg * 128 + 16 * cl + 4 * j);
                *(LAS v4u*)(li_ + g * 128 + 16 * cl + 4 * j) = a; *(LAS f32x4*)(la_ + g * 128 + 16 * cl + 4 * j) = f; }
            LDS_WAIT(); asm volatile("" ::: "memory");
            f32x2 acc[8];
#pragma unroll
            for (int q = 0; q < 8; ++q) acc[q] = (f32x2){0.f, 0.f};
#pragma unroll 1
            for (int k0 = 0; k0 < 128; k0 += 16) {
                unsigned ei[16]; float ec[16]; v4u seg[16];
#pragma unroll
                for (int q4 = 0; q4 < 4; ++q4) { const v4u a = *(const LAS v4u*)(li_ + g * 128 + k0 + 4 * q4); const f32x4 f = *(const LAS f32x4*)(la_ + g * 128 + k0 + 4 * q4);
                    ei[4 * q4] = a.x; ei[4 * q4 + 1] = a.y; ei[4 * q4 + 2] = a.z; ei[4 * q4 + 3] = a.w; ec[4 * q4] = f.x; ec[4 * q4 + 1] = f.y; ec[4 * q4 + 2] = f.z; ec[4 * q4 + 3] = f.w; }
#pragma unroll
                for (int kk = 0; kk < 16; ++kk) seg[kk] = *(const v4u*)(Vc + ((size_t)c * NEXP + ei[kk]) * 128 + 16 * cl);
#pragma unroll
                for (int kk = 0; kk < 16; ++kk) { const float cf = ec[kk]; const f32x2 cf2 = (f32x2){cf, cf};
#pragma unroll
                    for (int j = 0; j < 4; ++j) { acc[2 * j] += __builtin_amdgcn_cvt_pk_f32_fp8((int)seg[kk][j], false) * cf2; acc[2 * j + 1] += __builtin_amdgcn_cvt_pk_f32_fp8((int)seg[kk][j], true) * cf2; } }
            }
            float* xr = X + (size_t)tg * D + 128 * c + 16 * cl; const float* gg = g2 + b * 6144 + 128 * c + 16 * cl;
#pragma unroll
            for (int j = 0; j < 4; ++j) { const f32x4 g4 = *(const f32x4*)(gg + 4 * j);
                *(f32x4*)(xr + 4 * j) = *(const f32x4*)(xr + 4 * j) + g4 * (f32x4){acc[2 * j].x, acc[2 * j].y, acc[2 * j + 1].x, acc[2 * j + 1].y}; }
            LDS_WAIT(); asm volatile("" ::: "memory");
        }
    }
}

__device__ __forceinline__ void phase_peer_gv(Frame& F, int layer) {
    KARGS;
    const unsigned* ACTP = WSP(unsigned, WS_ACT);
    const unsigned char* PV8 = WSP(unsigned char, WS_PV) + (size_t)layer * NEXP * 1024;
    const float* g2 = WSP(float, WS_MOD) + (size_t)layer * 2 * 6144 + 5120;
    float* X = OUTP;
    const int lane = F.lane, tid = F.tid;
    for (int u = F.bid; u < 256; u += F.G) {
        const int xq = u >> 3, c = 4 * (4 * (u & 7) + (xq >> 3)) + (xq & 3), hf = (xq >> 2) & 1;
        if (u != F.bid) __syncthreads();
        {   const v4u* src = (const v4u*)(PV8 + (size_t)c * NEXP * 8);
            v4u t[16];
#pragma unroll
            for (int i = 0; i < 16; ++i) t[i] = src[i * NTHR + tid];
#pragma unroll
            for (int i = 0; i < 16; ++i) *(LAS v4u*)(F.lds + (size_t)(i * NTHR + tid) * 16) = t[i]; }
        __syncthreads();
        const float* gg = g2 + hf * 6144 + 8 * c;
        const f32x4 ga = *(const f32x4*)gg, gb = *(const f32x4*)(gg + 4);
        const unsigned lbase = (unsigned)(size_t)F.lds; __builtin_assume(lbase == 0u);
        constexpr int NBLK = 128 / NWAVES;
        auto wptr = [&](int i, int j) { return (const v4u*)(ACTP + (((size_t)(hf * 128 + F.wave + NWAVES * i) * 32 + j * 4) * 64 + lane) * 4); };
        v4u w[4][4];
#pragma unroll
        for (int jj = 0; jj < 4; ++jj) { const v4u* wp = wptr(0, jj);
#pragma unroll
            for (int g = 0; g < 4; ++g) w[jj][g] = wp[g * 64]; }
        v2u v[2][16];
#pragma unroll
        for (int kk = 0; kk < 16; ++kk) v[0][kk] = *(const LAS v2u*)(unsigned)((w[0][kk >> 2][kk & 3] & 0x1FFF8u) + lbase);
#pragma unroll 1
        for (int i = 0; i < NBLK; ++i) {
            float* xr = X + (size_t)((hf * 128 + F.wave + NWAVES * i) * 64 + lane) * D + 8 * c;
            const f32x4 x0 = *(const f32x4*)xr, x1 = *(const f32x4*)(xr + 4);
            const int inx = i + 1 < NBLK ? i + 1 : i;
            f32x2 acc[4];
#pragma unroll
            for (int q = 0; q < 4; ++q) acc[q] = (f32x2){0.f, 0.f};
#pragma unroll
            for (int j = 0; j < 8; ++j) {
#pragma unroll
                for (int kk = 0; kk < 16; ++kk) v[(j + 1) & 1][kk] = *(const LAS v2u*)(unsigned)((w[(j + 1) & 3][kk >> 2][kk & 3] & 0x1FFF8u) + lbase);
                asm volatile("" ::: "memory");
#pragma unroll
                for (int kk = 0; kk < 16; ++kk) {
                    const v4u wq = w[j & 3][kk >> 2]; v2u pr; pr.x = (kk & 2) ? wq.z : wq.x; pr.y = (kk & 2) ? wq.w : wq.y;
                    const f32x2 f0 = __builtin_amdgcn_cvt_pk_f32_fp8((int)v[j & 1][kk].x, false), f1 = __builtin_amdgcn_cvt_pk_f32_fp8((int)v[j & 1][kk].x, true);
                    const f32x2 f2 = __builtin_amdgcn_cvt_pk_f32_fp8((int)v[j & 1][kk].y, false), f3 = __builtin_amdgcn_cvt_pk_f32_fp8((int)v[j & 1][kk].y, true);
                    if (kk & 1) {
                        asm("v_pk_fma_f32 %0, %1, %2, %0 op_sel:[1,0,0] op_sel_hi:[1,1,1]" : "+v"(acc[0]) : "v"(pr), "v"(f0)); asm("v_pk_fma_f32 %0, %1, %2, %0 op_sel:[1,0,0] op_sel_hi:[1,1,1]" : "+v"(acc[1]) : "v"(pr), "v"(f1));
                        asm("v_pk_fma_f32 %0, %1, %2, %0 op_sel:[1,0,0] op_sel_hi:[1,1,1]" : "+v"(acc[2]) : "v"(pr), "v"(f2)); asm("v_pk_fma_f32 %0, %1, %2, %0 op_sel:[1,0,0] op_sel_hi:[1,1,1]" : "+v"(acc[3]) : "v"(pr), "v"(f3));
                    } else {
                        asm("v_pk_fma_f32 %0, %1, %2, %0 op_sel_hi:[0,1,1]" : "+v"(acc[0]) : "v"(pr), "v"(f0)); asm("v_pk_fma_f32 %0, %1, %2, %0 op_sel_hi:[0,1,1]" : "+v"(acc[1]) : "v"(pr), "v"(f1));
                        asm("v_pk_fma_f32 %0, %1, %2, %0 op_sel_hi:[0,1,1]" : "+v"(acc[2]) : "v"(pr), "v"(f2)); asm("v_pk_fma_f32 %0, %1, %2, %0 op_sel_hi:[0,1,1]" : "+v"(acc[3]) : "v"(pr), "v"(f3)); } }
                asm volatile("" ::: "memory");
                { const v4u* wp = j + 4 < 8 ? wptr(i, j + 4) : wptr(inx, j - 4);
#pragma unroll
                  for (int g = 0; g < 4; ++g) w[j & 3][g] = wp[g * 64]; }
                asm volatile("" ::: "memory");
            }
            *(f32x4*)xr = x0 + ga * (f32x4){acc[0].x, acc[0].y, acc[1].x, acc[1].y};
            *(f32x4*)(xr + 4) = x1 + gb * (f32x4){acc[2].x, acc[2].y, acc[3].x, acc[3].y};
        }
    }
}

__device__ __forceinline__ void phase_final(Frame& F) {
    KARGS;
    float* X = OUTP; const float* gain = IN(31);
    const int lane = F.lane, gw = F.bid * NWAVES + F.wave, NGW = F.G * NWAVES;
    f32x4 gn[4];
#pragma unroll
    for (int j = 0; j < 4; ++j) gn[j] = *(const f32x4*)(gain + 256 * j + 4 * lane);
    for (int row = gw; row < T; row += NGW) {
        float* xr = X + (size_t)row * D + 4 * lane;
        f32x4 v[4]; float ss = 0.f;
#pragma unroll
        for (int j = 0; j < 4; ++j) { v[j] = *(const f32x4*)(xr + 256 * j); ss += (v[j].x * v[j].x + v[j].y * v[j].y) + (v[j].z * v[j].z + v[j].w * v[j].w); }
        const float rstd = rsqrtf(wave_sum(ss) * (1.f / D) + NORM_EPS);
#pragma unroll
        for (int j = 0; j < 4; ++j) *(f32x4*)(xr + 256 * j) = v[j] * rstd * gn[j];
    }
}

#ifndef TS_LMASK
#define TS_LMASK 15
#endif
#ifndef PROBE_PARTS
#define PROBE_PARTS 3
#endif
#ifndef PROBE_DUP
#define PROBE_DUP 0
#endif
#ifndef PH_MASK
#define PH_MASK 0xFFFF
#endif
#define PH_EN(k) ((PH_MASK >> (k)) & 1)
constexpr int NPH = 50;
__host__ __device__ inline bool phase_skipped(int p) { if (p == 0 || p == NPH - 1) return false; const int layer = (p - 1) / 12, step = (p - 1) % 12;
    if (step == 9) return true;
    return (layer & 1) == 0 && (step == 3 || step == 4 || step == 5); }
__global__ void __launch_bounds__(NTHR, 2) mk_fwd(Args args) {
    extern __shared__ __attribute__((aligned(16))) unsigned char lds[];
    Frame F;
    F.lds = (LAS unsigned char*)lds;
    F.MISC = (volatile LAS unsigned*)(F.lds + MISC_OFF);
    F.tid = threadIdx.x; F.lane = F.tid & 63; F.wave = __builtin_amdgcn_readfirstlane(F.tid >> 6);
    F.G = gridDim.x; F.bid = blockIdx.x;
    F.ctl = (gu32*)(args.ws + WS_CTL);
    for (int u = F.tid; u < (LDS_BYTES - MISC_OFF) / 4; u += NTHR) ((LAS unsigned*)(F.lds + MISC_OFF))[u] = 0u;
    __syncthreads();
    XcdBarrier bar; bar.bar = (unsigned*)(F.ctl + CW_BAR); bar.x = 0; bar.st = nullptr;
    const int lo = args.ph_lo, hi = args.ph_hi;
    if (hi - lo > 1) bar = xcd_barrier_post((unsigned*)(F.ctl + CW_BAR), F.MISC + 8);
    bool ran = false;
#ifdef TS_STEP
    unsigned long long ts_acc = 0ull;
#endif
    for (int p = lo; p < hi; ++p) {
        if (phase_skipped(p)) continue;
        if (ran) xcd_barrier(bar);
        ran = true;
        { int t_ = threadIdx.x; asm volatile("" : "+v"(t_)); F.tid = t_; F.lane = t_ & 63; F.wave = __builtin_amdgcn_readfirstlane(t_ >> 6);
          int b_ = blockIdx.x, g_ = gridDim.x; asm volatile("" : "+s"(b_), "+s"(g_)); F.bid = b_; F.G = g_; }
#ifdef TS_STEP
        const bool ts_sel = (p == 0) ? (TS_STEP == 100) : (((p - 1) % 12) == TS_STEP && ((TS_LMASK >> ((p - 1) / 12)) & 1));
        unsigned long long ts0 = 0ull; if (ts_sel) ts0 = __builtin_amdgcn_s_memrealtime();
#define TS_END() do { if (ts_sel) { xcd_barrier(bar); ts_acc += __builtin_amdgcn_s_memrealtime() - ts0; } } while (0)
#else
#define TS_END() do {} while (0)
#endif
        if (p == 0) { if (PH_EN(0)) {
#if (PROBE_DUP >> 0) & 1
            phase_prologue(F); __syncthreads();
#endif
            phase_prologue(F); } TS_END(); continue; }
        if (p == NPH - 1) { if (PH_EN(1)) phase_final(F); continue; }
        const int layer = (p - 1) / 12, step = (p - 1) % 12; const bool odd = layer & 1;
        KARGS;
        if (step == 0 || step == 7) { if (PH_EN(2)) {
#if (PROBE_DUP >> 2) & 1
            phase_norm(F, layer, step == 7 ? 1 : 0);
#endif
            phase_norm(F, layer, step == 7 ? 1 : 0); } }
        else if (step == 1 || step == 8) { if (PH_EN(3)) {
            const int N = step == 8 ? 2048 : (odd ? ODD_N : EVEN_IN);
            const bf16* Bt = step == 8 ? WSP(bf16, WS_WQ + (size_t)layer * 4 * MiB) : WSP(bf16, WS_WIN + (size_t)layer * 8 * MiB);
            bf16* O = step == 8 ? WSP(bf16, WS_Q) : WSP(bf16, WS_PROJ);
            pg8::Gemm g{WSP(bf16, WS_H), Bt, T, N, D}; pg8::StaticOrder S; S.init(T, N, F.G, F.bid);
            pg8::EpiBf16<0> E{O, N, nullptr, 0, 0, 1.f};
#if (PROBE_DUP >> 3) & 1
            pg8::gemm_phase<pg8::EpiBf16<0>, pg8::StaticOrder, PG8_ALIGN, PG8_SP2>(F.lds + RING_OFF, g, S, E); __syncthreads();
#endif
            pg8::gemm_phase<pg8::EpiBf16<0>, pg8::StaticOrder, PG8_ALIGN, PG8_SP2>(F.lds + RING_OFF, g, S, E);
            if (step == 8) { asm volatile("s_waitcnt vmcnt(0)" ::: "memory"); __syncthreads(); phase_peer_topk<true>(F, layer, S); }
        } }
        else if (step == 2) { if (odd) { if (PH_EN(4)) {
#if (PROBE_DUP >> 4) & 1
            phase_odd_prep(F, layer, PROBE_PARTS); xcd_barrier(bar);
#endif
            phase_odd_prep(F, layer, 7); } } else { if (PH_EN(5)) {
#if (PROBE_DUP >> 5) & 1
            phase_even_mixer(F, layer);
#endif
            phase_even_mixer(F, layer); } } }
        else if (step == 3) { if (PH_EN(11)) {
#if (PROBE_DUP >> 11) & 1
            phase_rwkv_chunk(F, layer, 2048, PROBE_PARTS); xcd_barrier(bar);
#endif
            phase_rwkv_chunk(F, layer); } }
        else if (step == 4) { if (PH_EN(6)) {
#if (PROBE_DUP >> 6) & 1
            phase_odd_main(F, layer, CW_WORK2, PROBE_PARTS); xcd_barrier(bar);
#endif
            phase_odd_main(F, layer, CW_WORK, 3); } }
        else if (step == 5) { if (PH_EN(7)) {
#if (PROBE_DUP >> 7) & 1
            phase_rwkv_post(F, layer);
#endif
            phase_rwkv_post(F, layer); } }
        else if (step == 6) { if (PH_EN(8)) {
            pg8::Gemm g{WSP(bf16, WS_MIX), WSP(bf16, WS_WOUT + (size_t)layer * 2 * MiB), T, D, D}; pg8::StaticOrder S; S.init(T, D, F.G, F.bid);
            pg8::EpiResid E{layer == 0 ? IN(0) : OUTP, OUTP, WSP(float, WS_MOD) + (size_t)layer * 2 * 6144 + 2048, 6144};
            pg8::gemm_phase<pg8::EpiResid, pg8::StaticOrder, PG8_ALIGN, PG8_SP2>(F.lds + RING_OFF, g, S, E);
        } }
        else if (step == 9) { }
        else if (step == 10) { if (PH_EN(10)) {
#ifdef GU_VALU
            phase_peer_gu_valu(F, layer);
#else
            phase_peer_gu(F, layer);
#endif
            } }
        else { if (PH_EN(12)) {
#ifdef GV_OLD
            phase_peer_gv_old(F, layer);
#else
            phase_peer_gv(F, layer);
#endif
            } }
        TS_END();
    }
#ifdef TS_STEP
    if (blockIdx.x == 0 && threadIdx.x == 0) args.out[0] = (float)ts_acc;
#endif
}

extern "C" void kernel_launch(void* const* d_in, const int* in_sizes, int n_in, void* d_out, int out_size, void* d_ws, size_t ws_size, hipStream_t stream) {
    static int grid = 0;
    if (grid == 0) {
        if (n_in != 32 || in_sizes[0] != T * D || out_size != T * D || ws_size < WS_END) { fprintf(stderr, "kernel_launch: unexpected shapes (n_in %d, in0 %d, out %d, ws %zu < %zu); nothing launched\n", n_in, n_in > 0 ? in_sizes[0] : -1, out_size, ws_size, (size_t)WS_END); grid = -1; return; }
        int dev = 0, cus = 0, per_cu = 0;
        if (hipGetDevice(&dev) != hipSuccess || hipDeviceGetAttribute(&cus, hipDeviceAttributeMultiprocessorCount, dev) != hipSuccess) { grid = -1; return; }
        if (hipFuncSetAttribute((const void*)mk_fwd, hipFuncAttributeMaxDynamicSharedMemorySize, LDS_BYTES) != hipSuccess) { fprintf(stderr, "kernel_launch: hipFuncSetAttribute failed\n"); grid = -1; return; }
        if (hipOccupancyMaxActiveBlocksPerMultiprocessor(&per_cu, (const void*)mk_fwd, NTHR, LDS_BYTES) != hipSuccess || per_cu < 1) fprintf(stderr, "kernel_launch: occupancy query reports %d workgroups per CU\n", per_cu);
        (void)hipGetLastError();
        grid = cus;
    }
    if (grid < 0) return;
    if (hipMemsetAsync((char*)d_ws + WS_CTL, 0, CTL_ZERO_BYTES, stream) != hipSuccess) { fprintf(stderr, "kernel_launch: hipMemsetAsync failed\n"); return; }
    Args a{};
    for (int i = 0; i < 32; ++i) a.in[i] = (const float*)d_in[i];
    a.out = (float*)d_out; a.ws = (unsigned char*)d_ws;
#if MK_ONE_LAUNCH
    a.ph_lo = 0; a.ph_hi = NPH;
    hipLaunchKernelGGL(mk_fwd, dim3(grid), dim3(NTHR), LDS_BYTES, stream, a);
#else
    for (int p = 0; p < NPH; ++p) { if (phase_skipped(p)) continue; a.ph_lo = p; a.ph_hi = p + 1;
        hipLaunchKernelGGL(mk_fwd, dim3(grid), dim3(NTHR), LDS_BYTES, stream, a); }
#endif
    const hipError_t le = hipPeekAtLastError();
    if (le != hipSuccess) fprintf(stderr, "kernel_launch: launch failed: %s\n", hipGetErrorName(le));
}
```

```cpp
#include <hip/hip_runtime.h>
#include <cstdio>
#include <cstdint>
namespace pg8 {
#define PG8_LAS __attribute__((address_space(3)))
typedef unsigned short bf16_t;
typedef short bf16x8 __attribute__((ext_vector_type(8)));
typedef float f32x4 __attribute__((ext_vector_type(4)));
typedef unsigned u32x4 __attribute__((ext_vector_type(4)));
constexpr int BM = 256, BK = 64, HALF = 128, HTB = HALF * BK * 2  , STAGE_BYTES = 8 * HTB, NXCD = 8, WGM = 8;

__host__ __device__ __forceinline__ int lds_byte(int r, int c) { const int st = (r >> 4) * 2 + (c >> 5), rr = r & 15, cc = c & 31, ob = rr * 64 + cc * 2; return st * 1024 + (ob ^ (((ob >> 9) & 1) << 5)); }
__host__ __device__ __forceinline__ void stage_rc(int b, int& R, int& C) { const int st = b / 1024, sb = b % 1024, swz = sb ^ (((sb >> 9) & 1) << 5); R = (st >> 1) * 16 + swz / 64; C = (st & 1) * 32 + (swz % 64) / 2; }
__host__ __device__ __forceinline__ int perm32(int rho) { const int n = rho >> 4, i = rho & 15; return 8 * (i >> 2) + 4 * n + (i & 3); }

struct Unit { int pm, pn; };
struct Gemm { const bf16_t* A; const bf16_t* Bt; int M, N, K; };

struct StaticOrder {
    int nM, nN, nwg, G, c;
    __host__ __device__ void init(int M, int N, int G_, int c_) { nM = M / BM; nN = N / BM; nwg = nM * nN; G = G_; c = c_; }
    __host__ __device__ bool next(int i, Unit& u) const {
        const long L = (long)i * G + c; if (L >= nwg) return false;
        int wgid = (int)L; { const int q = nwg / NXCD, r = nwg % NXCD, xcd = wgid % NXCD, off = wgid / NXCD; wgid = (xcd < r ? xcd * (q + 1) : r * (q + 1) + (xcd - r) * q) + off; }
        const int nig = WGM * nN, gid = wgid / nig, fm = gid * WGM, gsz = (nM - fm) < WGM ? (nM - fm) : WGM;
        u.pm = fm + ((wgid % nig) % gsz); u.pn = (wgid % nig) / gsz; return true;
    }
    __device__ __forceinline__ void a_ready(const Unit&) const {}
    __device__ __forceinline__ void done(const Unit&) const {}
};

__device__ __forceinline__ unsigned cvt_pk_bf16(float lo, float hi) { unsigned r; asm volatile("v_cvt_pk_bf16_f32 %0, %1, %2" : "=v"(r) : "v"(lo), "v"(hi)); return r; }
typedef float f32x2 __attribute__((ext_vector_type(2)));
__device__ __forceinline__ f32x2 gelu_pk(f32x2 v) {
    const f32x2 av = __builtin_elementwise_abs(v), d = av * 0.2316418882f + 1.0f;
    f32x2 t; t.x = __builtin_amdgcn_rcpf(d.x); t.y = __builtin_amdgcn_rcpf(d.y);
    f32x2 q = t * 0.5307027145f + (-0.7265760135f); q = q * t + 0.7107068705f; q = q * t + (-0.142248368f); q = q * t + 0.127414796f; q = q * t;
    const f32x2 s = (v * v) * (-0.72134752044f);
    f32x2 e; e.x = __builtin_amdgcn_exp2f(s.x); e.y = __builtin_amdgcn_exp2f(s.y);
    const f32x2 m = v * (q * e), r = v - m;
    f32x2 o; o.x = v.x < 0.f ? m.x : r.x; o.y = v.y < 0.f ? m.y : r.y; return o;
}

template <int ACT  > struct EpiBf16 {
    static constexpr bool PERM = true, AFTER_DRAIN = false; static_assert(ACT == 0 || ACT == 1, "EpiBf16: ACT is 0 (none) or 1 (gelu_pk)");
    bf16_t* O; int ldc; const float* bias; int split_cols; size_t split_stride; float scale0;
    __device__ __forceinline__ void operator()(const f32x4 (&acc)[2][2][4][2], const Unit& u, int wr, int wc, int fr, int fq) const {
        const int row0 = u.pm * BM + wr * 64 + fr; int colt = u.pn * BM; bf16_t* base = O;
        float sc = 1.f; if (split_cols) { const int t = colt / split_cols; base += (size_t)t * split_stride; colt -= t * split_cols; if (t == 0) sc = scale0; }
        const int col0 = colt + wc * 32 + 8 * fq, bcol0 = u.pn * BM + wc * 32 + 8 * fq;
        f32x4 bv[2][2];
#pragma unroll
        for (int bj = 0; bj < 2; ++bj)
#pragma unroll
            for (int n = 0; n < 2; ++n) bv[bj][n] = bias ? *(const f32x4*)(bias + bcol0 + bj * HALF + 4 * n) : (f32x4){0.f, 0.f, 0.f, 0.f};
#pragma unroll
        for (int ai = 0; ai < 2; ++ai)
#pragma unroll
            for (int m = 0; m < 4; ++m) { bf16_t* rowp = base + (size_t)(row0 + ai * HALF + m * 16) * ldc + col0;
#pragma unroll
                for (int bj = 0; bj < 2; ++bj) { f32x4 v0 = acc[ai][bj][m][0] + bv[bj][0], v1 = acc[ai][bj][m][1] + bv[bj][1];
                    if (ACT == 1) { f32x2 a = gelu_pk((f32x2){v0[0], v0[1]}), b = gelu_pk((f32x2){v0[2], v0[3]}), c = gelu_pk((f32x2){v1[0], v1[1]}), d = gelu_pk((f32x2){v1[2], v1[3]});
                        v0 = (f32x4){a.x, a.y, b.x, b.y}; v1 = (f32x4){c.x, c.y, d.x, d.y}; }
                    v0 = v0 * sc; v1 = v1 * sc; u32x4 w; w.x = cvt_pk_bf16(v0[0], v0[1]); w.y = cvt_pk_bf16(v0[2], v0[3]); w.z = cvt_pk_bf16(v1[0], v1[1]); w.w = cvt_pk_bf16(v1[2], v1[3]);
                    *(u32x4*)(rowp + bj * HALF) = w; } }
    }
};
struct EpiResid {
    static constexpr bool PERM = false, AFTER_DRAIN = false;
    const float* base; float* out; const float* gate; int gstride;
    __device__ __forceinline__ void operator()(const f32x4 (&acc)[2][2][4][2], const Unit& u, int wr, int wc, int fr, int fq) const {
        const int row0 = u.pm * BM + wr * 64 + fr; const int col0 = u.pn * BM + wc * 32 + 4 * fq;
        const float* gp = gate + ((u.pm * BM) >= 8192 ? gstride : 0);
        f32x4 gv[2][2];
#pragma unroll
        for (int bj = 0; bj < 2; ++bj)
#pragma unroll
            for (int n = 0; n < 2; ++n) gv[bj][n] = *(const f32x4*)(gp + col0 + bj * HALF + n * 16);
#pragma unroll
        for (int ai = 0; ai < 2; ++ai)
#pragma unroll
            for (int m = 0; m < 4; ++m) { const size_t off = (size_t)(row0 + ai * HALF + m * 16) * 1024 + col0;
#pragma unroll
                for (int bj = 0; bj < 2; ++bj)
#pragma unroll
                    for (int n = 0; n < 2; ++n) { const f32x4 bs = *(const f32x4*)(base + off + bj * HALF + n * 16);
                        *(f32x4*)(out + off + bj * HALF + n * 16) = bs + gv[bj][n] * acc[ai][bj][m][n]; } }
    }
};
template <class Epi, class Sched, bool ALIGN_EPI = false, bool SP2 = false>
__device__ __forceinline__ void gemm_phase(PG8_LAS unsigned char* lds, const Gemm g, const Sched& S, const Epi& E) {
    int tid_l = threadIdx.x; asm volatile("" : "+v"(tid_l));
    const int tid = tid_l, wid = __builtin_amdgcn_readfirstlane(tid >> 6), lane = tid & 63, wr = wid >> 2, wc = wid & 3, fr = lane & 15, fq = lane >> 4;
    const int K = g.K, nt = K / BK;
    unsigned voffA[2], voffB[2];
#pragma unroll
    for (int i = 0; i < 2; ++i) { int R, C; stage_rc(tid * 16 + i * 8192, R, C); const int Rb = Epi::PERM ? ((R & ~31) + perm32(R & 31)) : R;
        voffA[i] = (unsigned)(R * K + C) * 2u; voffB[i] = (unsigned)(Rb * K + C) * 2u; }
    const size_t kstep = (size_t)(BK * 2);
    const size_t hstep = (size_t)HALF * K * 2;
    const size_t tstep = 2 * hstep;
    const unsigned ldsw = (unsigned)wid * 1024u;
    const int aoff = lds_byte(wr * 64 + fr, fq * 8), boff = lds_byte(wc * 32 + fr, fq * 8);
#define PG8_SA(b, h) (((b) * 2 + (h)) * HTB)
#define PG8_SB(b, h) ((4 + (b) * 2 + (h)) * HTB)
#define PG8_STAGE(bufoff, gbase, voff) do { _Pragma("unroll") for (int _i = 0; _i < 2; ++_i) \
        __builtin_amdgcn_global_load_lds((const unsigned*)((const char*)(gbase) + (voff)[_i]), (PG8_LAS unsigned*)(lds + (bufoff) + ldsw + _i * 8192), 16, 0, 0); } while (0)
#define PG8_LDA(dst, b, h) do { _Pragma("unroll") for (int m = 0; m < 4; ++m) _Pragma("unroll") for (int k = 0; k < 2; ++k) dst[m][k] = *(const PG8_LAS bf16x8*)(lds + PG8_SA(b, h) + aoff + m * 2048 + k * 1024); } while (0)
#define PG8_LDB(dst, b, h) do { _Pragma("unroll") for (int n = 0; n < 2; ++n) _Pragma("unroll") for (int k = 0; k < 2; ++k) dst[n][k] = *(const PG8_LAS bf16x8*)(lds + PG8_SB(b, h) + boff + n * 2048 + k * 1024); } while (0)
#define PG8_MMA(ai, bj, At, Bt) do { __builtin_amdgcn_s_setprio(1); _Pragma("unroll") for (int m = 0; m < 4; ++m) _Pragma("unroll") for (int n = 0; n < 2; ++n) _Pragma("unroll") for (int k = 0; k < 2; ++k) \
        acc[ai][bj][m][n] = __builtin_amdgcn_mfma_f32_16x16x32_bf16(Bt[n][k], At[m][k], acc[ai][bj][m][n], 0, 0, 0); __builtin_amdgcn_s_setprio(0); } while (0)
#define PG8_WAIT_V(n) asm volatile("s_waitcnt vmcnt(" #n ")" ::: "memory")
#define PG8_WAIT_L(n) asm volatile("s_waitcnt lgkmcnt(" #n ")" ::: "memory")
#define PG8_BAR __builtin_amdgcn_s_barrier()
#define PG8_SCHED __builtin_amdgcn_sched_barrier(0)
    Unit cur, nxt; int ui = 0;
    if (!S.next(0, cur)) return;
    f32x4 acc[2][2][4][2];
#pragma unroll
    for (int a = 0; a < 2; ++a)
#pragma unroll
        for (int b = 0; b < 2; ++b)
#pragma unroll
            for (int m = 0; m < 4; ++m)
#pragma unroll
                for (int n = 0; n < 2; ++n) acc[a][b][m][n] = (f32x4){0.f, 0.f, 0.f, 0.f};
    bf16x8 At[4][2], B0[2][2], B1[2][2];
    const char* cA = (const char*)g.A + (size_t)cur.pm * tstep; const char* cB = (const char*)g.Bt + (size_t)cur.pn * tstep;
    S.a_ready(cur);
    if constexpr (SP2) {
        PG8_STAGE(PG8_SB(0, 0), cB, voffB); PG8_STAGE(PG8_SB(0, 1), cB + hstep, voffB); PG8_STAGE(PG8_SA(0, 0), cA, voffA); PG8_STAGE(PG8_SA(0, 1), cA + hstep, voffA);
        if (wr == 1) PG8_BAR;
        PG8_WAIT_V(2); PG8_BAR;
        PG8_STAGE(PG8_SB(1, 0), cB + kstep, voffB); PG8_STAGE(PG8_SA(1, 0), cA + kstep, voffA); PG8_STAGE(PG8_SB(1, 1), cB + hstep + kstep, voffB);
        PG8_WAIT_V(6); PG8_BAR;
    } else {
        PG8_STAGE(PG8_SB(0, 0), cB, voffB); PG8_STAGE(PG8_SA(0, 0), cA, voffA); PG8_STAGE(PG8_SB(0, 1), cB + hstep, voffB); PG8_STAGE(PG8_SA(0, 1), cA + hstep, voffA);
        if (wr == 1) PG8_BAR;
        PG8_WAIT_V(4); PG8_BAR;
        PG8_STAGE(PG8_SB(1, 0), cB + kstep, voffB); PG8_STAGE(PG8_SA(1, 0), cA + kstep, voffA); PG8_STAGE(PG8_SB(1, 1), cB + hstep + kstep, voffB);
        PG8_WAIT_V(6); PG8_BAR;
    }
    for (;;) {
        const bool has_next = S.next(ui + 1, nxt);
        const char* nA = has_next ? (const char*)g.A + (size_t)nxt.pm * tstep : cA; const char* nB = has_next ? (const char*)g.Bt + (size_t)nxt.pn * tstep : cB;
        for (int t = 0; t < nt; t += 2) {
            const bool last = (t == nt - 2);
            const char* a1 = cA + (size_t)(t + 1) * kstep;
            const char* a2 = last ? nA : cA + (size_t)(t + 2) * kstep; const char* b2 = last ? nB : cB + (size_t)(t + 2) * kstep;
            const char* a3 = a2 + kstep; const char* b3 = b2 + kstep;
            if (last && has_next) S.a_ready(nxt);
            if constexpr (SP2) {
            PG8_LDB(B0, 0, 0); PG8_LDB(B1, 0, 1); PG8_SCHED; PG8_LDA(At, 0, 0); PG8_STAGE(PG8_SA(1, 1), a1 + hstep, voffA);
            PG8_WAIT_V(8); PG8_WAIT_L(0); PG8_BAR; PG8_MMA(0, 0, At, B0); PG8_MMA(0, 1, At, B1); PG8_BAR; PG8_SCHED;
            PG8_LDA(At, 0, 1); PG8_STAGE(PG8_SB(0, 0), b2, voffB); PG8_STAGE(PG8_SB(0, 1), b2 + hstep, voffB); PG8_STAGE(PG8_SA(0, 0), a2, voffA);
            PG8_WAIT_V(8); PG8_WAIT_L(0); PG8_BAR; PG8_MMA(1, 0, At, B0); PG8_MMA(1, 1, At, B1); PG8_BAR; PG8_SCHED;
            PG8_LDB(B0, 1, 0); PG8_LDB(B1, 1, 1); PG8_SCHED; PG8_LDA(At, 1, 0); PG8_STAGE(PG8_SA(0, 1), a2 + hstep, voffA);
            PG8_WAIT_V(8); PG8_WAIT_L(0); PG8_BAR; PG8_MMA(0, 0, At, B0); PG8_MMA(0, 1, At, B1); PG8_BAR; PG8_SCHED;
            PG8_LDA(At, 1, 1); PG8_STAGE(PG8_SB(1, 0), b3, voffB); PG8_STAGE(PG8_SB(1, 1), b3 + hstep, voffB); PG8_STAGE(PG8_SA(1, 0), a3, voffA);
            PG8_WAIT_V(8); PG8_WAIT_L(0); PG8_BAR; PG8_MMA(1, 0, At, B0); PG8_MMA(1, 1, At, B1); PG8_BAR; PG8_SCHED;
            } else {
            PG8_LDB(B0, 0, 0); PG8_SCHED; PG8_LDA(At, 0, 0); PG8_STAGE(PG8_SA(1, 1), a1 + hstep, voffA);
            PG8_WAIT_L(8); PG8_BAR; PG8_WAIT_L(0); PG8_MMA(0, 0, At, B0); PG8_BAR; PG8_SCHED;
            PG8_LDB(B1, 0, 1); PG8_STAGE(PG8_SB(0, 0), b2, voffB);
            PG8_BAR; PG8_WAIT_L(0); PG8_MMA(0, 1, At, B1); PG8_BAR;
            PG8_LDA(At, 0, 1); PG8_STAGE(PG8_SA(0, 0), a2, voffA);
            PG8_BAR; PG8_WAIT_L(0); PG8_MMA(1, 0, At, B0); PG8_BAR; PG8_SCHED;
            PG8_STAGE(PG8_SB(0, 1), b2 + hstep, voffB);
            PG8_WAIT_V(6); PG8_BAR; PG8_MMA(1, 1, At, B1); PG8_BAR;
            PG8_LDB(B0, 1, 0); PG8_SCHED; PG8_LDA(At, 1, 0); PG8_STAGE(PG8_SA(0, 1), a2 + hstep, voffA);
            PG8_WAIT_L(8); PG8_BAR; PG8_WAIT_L(0); PG8_MMA(0, 0, At, B0); PG8_BAR; PG8_SCHED;
            PG8_LDB(B1, 1, 1); PG8_STAGE(PG8_SB(1, 0), b3, voffB);
            PG8_BAR; PG8_WAIT_L(0); PG8_MMA(0, 1, At, B1); PG8_BAR;
            PG8_LDA(At, 1, 1); PG8_STAGE(PG8_SA(1, 0), a3, voffA);
            PG8_BAR; PG8_WAIT_L(0); PG8_MMA(1, 0, At, B0); PG8_BAR; PG8_SCHED;
            PG8_STAGE(PG8_SB(1, 1), b3 + hstep, voffB);
            PG8_WAIT_V(6); PG8_BAR; PG8_MMA(1, 1, At, B1); PG8_BAR;
            }
        }
        if constexpr (ALIGN_EPI) { if (wr == 0) PG8_BAR; }
        if constexpr (!Epi::AFTER_DRAIN) { E(acc, cur, wr, wc, fr, fq); S.done(cur); }
        if (!has_next) break;
#pragma unroll
        for (int a = 0; a < 2; ++a)
#pragma unroll
            for (int b = 0; b < 2; ++b)
#pragma unroll
                for (int m = 0; m < 4; ++m)
#pragma unroll
                    for (int n = 0; n < 2; ++n) acc[a][b][m][n] = (f32x4){0.f, 0.f, 0.f, 0.f};
        cur = nxt; cA = nA; cB = nB; ++ui;
        if constexpr (ALIGN_EPI) { if (wr == 1) PG8_BAR; }
    }
    PG8_WAIT_V(0);
    if constexpr (!ALIGN_EPI) { if (wr == 0) PG8_BAR; }
    PG8_BAR;
    if constexpr (Epi::AFTER_DRAIN) { E.fused(acc, cur, wr, wc, fr, fq, lds, wid, lane); S.done(cur); }
#undef PG8_SA
#undef PG8_SB
#undef PG8_STAGE
#undef PG8_LDA
#undef PG8_LDB
#undef PG8_MMA
#undef PG8_WAIT_V
#undef PG8_WAIT_L
#undef PG8_BAR
#undef PG8_SCHED
}
}
#ifndef PG8_SP2
#define PG8_SP2 true
#endif
#ifndef PG8_ALIGN
#define PG8_ALIGN true
#endif
#ifndef MK_ONE_LAUNCH
#define MK_ONE_LAUNCH 1
#endif

constexpr int NWAVES = 8, NTHR = NWAVES * 64;
constexpr int BATCH = 2, SEQ = 8192, D = 1024, T = BATCH * SEQ, DEPTH = 4;
constexpr int EVEN_IN = 2048, ODD_LD = 3848, ODD_N = 3840;
constexpr int NEXP = 16384;
constexpr float NORM_EPS = 1e-6f, GN_EPS = 64e-5f;

constexpr size_t MiB = 1u << 20;
constexpr size_t WS_CTL = 0, CTL_ZERO_BYTES = 1 * MiB;
constexpr size_t WS_MOD = 1 * MiB;
constexpr size_t WS_WF = WS_MOD + 256 * 1024;
constexpr size_t WS_KEYS = WS_MOD + 512 * 1024;
constexpr size_t WS_LORA = 3 * MiB;
constexpr size_t WS_LOGF = 2 * MiB;
constexpr size_t WS_DCUM = 2 * MiB + 512 * 1024;
constexpr size_t WS_WIN = 4 * MiB;
constexpr size_t WS_WOUT = 36 * MiB;
constexpr size_t WS_WQ = 44 * MiB;
constexpr size_t WS_H = 64 * MiB;
constexpr size_t WS_MIX = 96 * MiB;
constexpr size_t WS_PROJ = 128 * MiB;
constexpr size_t WS_Q = 256 * MiB;
constexpr size_t WS_IDX = 320 * MiB;
constexpr size_t WS_GATE = 328 * MiB;
constexpr size_t WS_RW = 336 * MiB;
constexpr size_t RW_SLOT = 32 * MiB;
constexpr size_t WS_PU = WS_RW + 8 * RW_SLOT;
constexpr size_t WS_PV = WS_PU + 64 * MiB;
constexpr size_t WS_PS = WS_PV + 64 * MiB;
constexpr size_t WS_CG = WS_PS + 1 * MiB;
constexpr size_t WS_CQ = WS_CG + 16 * MiB;
constexpr size_t WS_CH = WS_CQ + 16 * MiB;
constexpr size_t WS_CY = WS_CH + 32 * MiB;
constexpr size_t WS_H8 = WS_CY + 32 * MiB;
constexpr size_t WS_HS = WS_H8 + 16 * MiB;
constexpr size_t WS_ACT = WS_HS + 1 * MiB;
constexpr size_t WS_END = WS_ACT + 8 * MiB;
constexpr int CW_WORK = 64;
constexpr int CW_WORK2 = 1024;
constexpr int CW_G1 = 24576, CW_G2 = 28672;
constexpr int CW_CHQ = 16384, CW_SCQ = 20480;
constexpr int CW_BAR = 4096;

constexpr int RING_OFF = 0, RING_BYTES = 131072;
constexpr int MISC_OFF = 159744;
constexpr int LDS_BYTES = 163840;

#define GAS __attribute__((address_space(1)))
#define LAS __attribute__((address_space(3)))
typedef unsigned short bf16;
typedef unsigned v4u __attribute__((ext_vector_type(4)));
typedef unsigned v2u __attribute__((ext_vector_type(2)));
typedef int v8i __attribute__((ext_vector_type(8)));
typedef float f32x4 __attribute__((ext_vector_type(4)));
typedef short bf16x8 __attribute__((ext_vector_type(8)));
typedef GAS unsigned gu32;
#define LDS_WAIT() asm volatile("s_waitcnt lgkmcnt(0)" ::: "memory")
#define VM_WAIT() asm volatile("s_waitcnt vmcnt(0)" ::: "memory")
#define LBAR() do { asm volatile("s_waitcnt lgkmcnt(0)" ::: "memory"); __builtin_amdgcn_s_barrier(); asm volatile("" ::: "memory"); } while (0)
typedef float f32x2_t __attribute__((ext_vector_type(2))); typedef __bf16 bf16x2_t __attribute__((ext_vector_type(2)));
__device__ __forceinline__ unsigned pk2(float lo, float hi) { const f32x2_t v = {lo, hi}; const bf16x2_t b = __builtin_convertvector(v, bf16x2_t); return __builtin_bit_cast(unsigned, b); }
__device__ __forceinline__ unsigned f2bf(float f) { return pk2(f, 0.f) & 0xffffu; }
__device__ __forceinline__ float bf2f(bf16 v) { return __builtin_bit_cast(float, (unsigned)v << 16); }
__device__ __forceinline__ float bflo(unsigned w) { return __builtin_bit_cast(float, w << 16); }
__device__ __forceinline__ float bfhi(unsigned w) { return __builtin_bit_cast(float, w & 0xffff0000u); }
__device__ __forceinline__ float wave_sum(float v) {
#pragma unroll
    for (int o = 1; o < 64; o <<= 1) v += __shfl_xor(v, o);
    return v;
}
__device__ __forceinline__ float wave_max(float v) {
#pragma unroll
    for (int o = 1; o < 64; o <<= 1) v = fmaxf(v, __shfl_xor(v, o));
    return v;
}
__device__ __forceinline__ float rl(float x, int j) { return __builtin_bit_cast(float, __builtin_amdgcn_readlane(__builtin_bit_cast(int, x), j)); }
__device__ __forceinline__ float sigmoidf_(float x) { return 1.f / (1.f + expf(-x)); }
__device__ __forceinline__ float softplusf_(float x) { return fmaxf(x, 0.f) + log1pf(expf(-fabsf(x))); }
__device__ __forceinline__ float gelu_erf(float x) { return 0.5f * x * (1.f + erff(x * 0.70710678118654752f)); }

#define XB_TMO      128
#define XB_XCNT(j)  (256  + 64 * (j))
#define XB_XSUB(j)  (1280 + 64 * (j))
#define XB_XGEN(j)  (2304 + 64 * (j))
#define XB_TOP      3328
#define XB_TOPGEN   3392
#define XCD_BAR_WORDS 3456
#define XB_SPIN_CAP (1u << 18)

__device__ __forceinline__ unsigned xb_ld(unsigned* p)              { return __hip_atomic_load(p, __ATOMIC_RELAXED, __HIP_MEMORY_SCOPE_AGENT); }
__device__ __forceinline__ unsigned xb_add(unsigned* p, unsigned v) { return __hip_atomic_fetch_add(p, v, __ATOMIC_RELAXED, __HIP_MEMORY_SCOPE_AGENT); }
__device__ __forceinline__ unsigned xb_xcc_id() { return (unsigned)__builtin_amdgcn_s_getreg((3 << 11) | 20) & 0xFu; }
#define XB_SPIN(cond, bar) do { unsigned _sp = 0; while (cond) { __builtin_amdgcn_s_sleep(1); \
    if ((++_sp & 255u) == 0u) { if (xb_ld(&(bar)[XB_TMO])) break; if (_sp > XB_SPIN_CAP) { atomicAdd(&(bar)[XB_TMO], 1u); break; } } } } while (0)

struct XcdBarrier {
    unsigned* bar; unsigned x;
    volatile LAS unsigned* st;
};

__device__ __forceinline__ XcdBarrier xcd_barrier_post(unsigned* bar, volatile LAS unsigned* st) {
    XcdBarrier b; b.bar = bar; b.x = xb_xcc_id(); b.st = st;
    if (threadIdx.x == 0) (void)xb_add(&bar[XB_XCNT(b.x)], 1u);
    return b;
}
__device__ __forceinline__ void xcd_barrier_complete(unsigned* bar, unsigned x, unsigned& nloc, unsigned& nx) {
    const unsigned G = gridDim.x * gridDim.y * gridDim.z;
    unsigned sum, cnt, mine, sp = 0u;
    for (;;) {
        sum = 0u; cnt = 0u; mine = 0u;
#pragma unroll
        for (unsigned j = 0; j < 16; ++j) { const unsigned c = xb_ld(&bar[XB_XCNT(j)]); sum += c; cnt += (c > 0u) ? 1u : 0u; mine = (j == x) ? c : mine; }
        if (sum == G) break;
        __builtin_amdgcn_s_sleep(1);
        if ((++sp & 255u) == 0u) { if (xb_ld(&bar[XB_TMO])) break; if (sp > XB_SPIN_CAP) { atomicAdd(&bar[XB_TMO], 1u); break; } }
    }
    nloc = mine > 0u ? mine : 1u; nx = cnt > 0u ? cnt : 1u;
}

__device__ __forceinline__ void xcd_barrier(const XcdBarrier& b) {
    asm volatile("s_waitcnt vmcnt(0)" ::: "memory");
    __syncthreads();
    if (threadIdx.x == 0) {
        unsigned* bar = b.bar;
        __builtin_amdgcn_s_waitcnt(0);
        unsigned nloc = b.st[0], nx = b.st[1];
        if (nloc == 0u) { xcd_barrier_complete(bar, b.x, nloc, nx); b.st[0] = nloc; b.st[1] = nx; }
        const unsigned old = xb_add(&bar[XB_XSUB(b.x)], 1u);
        const unsigned gen = old / nloc;
        if (old + 1u == (gen + 1u) * nloc) {
            __builtin_amdgcn_fence(__ATOMIC_RELEASE, "agent");
            asm volatile("s_waitcnt vmcnt(0)" ::: "memory");
            const unsigned og = xb_add(&bar[XB_TOP], 1u);
            const unsigned tg = og / nx;
            if (og + 1u == (tg + 1u) * nx) xb_add(&bar[XB_TOPGEN], 1u);
            else XB_SPIN(xb_ld(&bar[XB_TOPGEN]) == tg, bar);
            __builtin_amdgcn_fence(__ATOMIC_ACQUIRE, "agent");
            xb_add(&bar[XB_XGEN(b.x)], 1u);
            asm volatile("s_waitcnt vmcnt(0)" ::: "memory");
        } else {
            XB_SPIN(xb_ld(&bar[XB_XGEN(b.x)]) == gen, bar);
            __builtin_amdgcn_fence(__ATOMIC_ACQUIRE, "agent");
            asm volatile("s_waitcnt vmcnt(0)" ::: "memory");
        }
    }
    __syncthreads();
}


struct Frame {
    LAS unsigned char* lds;
    volatile LAS unsigned* MISC;
    gu32* ctl;
    int tid, lane, wave, G, bid;
};
struct Args { const float* in[32]; float* out; unsigned char* ws; int ph_lo, ph_hi; };
#define CAS __attribute__((address_space(4)))
#define KARGS const CAS Args* ka_; { unsigned long long kp_ = (unsigned long long)__builtin_amdgcn_kernarg_segment_ptr(); asm volatile("" : "+s"(kp_)); ka_ = (const CAS Args*)kp_; } unsigned char* const ws_ = ka_->ws
#define IN(i) (ka_->in[i])
#define OUTP (ka_->out)
#define WSP(type, off) ((type*)(ws_ + (off)))

template <int NR> __device__ __forceinline__ void conv_issue(const float* TU, const float* TV, int l, int row0, int NGW, int lane, f32x4 (&v)[NR][4]) {
#pragma unroll
    for (int q = 0; q < NR; ++q) { const int r = row0 + q * NGW; if (r < 2 * NEXP) { const int tb = r >= NEXP ? 1 : 0, e = r - tb * NEXP;
        const float* src = (tb ? TV : TU) + ((size_t)l * NEXP + e) * 1024 + 4 * lane;
#pragma unroll
        for (int j = 0; j < 4; ++j) v[q][j] = *(const f32x4*)(src + 256 * j); } }
}
template <int NR> __device__ __forceinline__ void conv_finish(unsigned char* PU, unsigned char* PV, float* PS, int l, int row0, int NGW, int lane, f32x4 (&v)[NR][4], LAS unsigned char* scr) {
#pragma unroll
    for (int q = 0; q < NR; ++q) { const int r = row0 + q * NGW; if (r < 2 * NEXP) { const int tb = r >= NEXP ? 1 : 0, e = r - tb * NEXP;
        if (tb) {
            float am = 0.f;
#pragma unroll
            for (int j = 0; j < 4; ++j) am = fmaxf(am, fmaxf(fmaxf(fabsf(v[q][j].x), fabsf(v[q][j].y)), fmaxf(fabsf(v[q][j].z), fabsf(v[q][j].w))));
            am = wave_max(am);
            const float sc = am > 0.f ? am * (1.f / 224.f) : 1.f, inv = 1.f / sc;
#pragma unroll
            for (int j = 0; j < 4; ++j) { int w = 0; w = __builtin_amdgcn_cvt_pk_fp8_f32(v[q][j].x * inv, v[q][j].y * inv, w, false); w = __builtin_amdgcn_cvt_pk_fp8_f32(v[q][j].z * inv, v[q][j].w * inv, w, true);
                const int c = 32 * j + (lane >> 1);
                *(int*)(PV + ((size_t)(l * 128 + c) * NEXP + e) * 8 + 4 * (lane & 1)) = w; }
            if (lane == 0) PS[4 * NEXP + l * NEXP + e] = sc;
        } else {
#pragma unroll
            for (int j = 0; j < 4; ++j) {
                float am = fmaxf(fmaxf(fabsf(v[q][j].x), fabsf(v[q][j].y)), fmaxf(fabsf(v[q][j].z), fabsf(v[q][j].w)));
                am = fmaxf(am, __shfl_xor(am, 1)); am = fmaxf(am, __shfl_xor(am, 2)); am = fmaxf(am, __shfl_xor(am, 4));
                int ex = 0; if (am > 0.f) { (void)frexpf(am * (1.f / 6.f), &ex); }
                ex = ex < -126 ? -126 : (ex > 126 ? 126 : ex);
                const float inv = __builtin_bit_cast(float, (unsigned)(127 - ex) << 23);
                unsigned w16 = 0u;
#pragma unroll
                for (int c = 0; c < 4; ++c) { const float y = v[q][j][c] * inv, a_ = fabsf(y);
                    float cf = a_ < 2.f ? rintf(a_ * 2.f) : (a_ < 4.f ? 4.f + rintf(a_ - 2.f) : 6.f + rintf((a_ - 4.f) * 0.5f));
                    cf = fminf(cf, 7.f);
                    const unsigned s4 = (unsigned)(int)cf | (y < 0.f ? 8u : 0u);
                    w16 |= s4 << (4 * c); }
                const int qb = 8 * j + (lane >> 3), kc_ = qb & 3, m_ = qb >> 2;
#pragma unroll
                for (int t = 0; t < 2; ++t) { const int L = 16 * m_ + 2 * (lane & 7) + t;
                    scr[64 * (L >> 4) + 16 * kc_ + (L & 15)] = (unsigned char)((w16 >> (8 * t)) & 0xFFu); }
                if ((lane & 7) == 0) scr[512 + kc_ * 8 + m_] = (unsigned char)(ex + 127);
            }
            LDS_WAIT(); asm volatile("" ::: "memory");
            if (lane < 32) *(v4u*)(PU + ((size_t)l * NEXP + e) * 512 + 16 * lane) = *(const LAS v4u*)(scr + 16 * lane);
            else if (lane < 34) *(v4u*)(PU + (size_t)48 * MiB + ((size_t)l * NEXP + e) * 32 + 16 * (lane - 32)) = *(const LAS v4u*)(scr + 512 + 16 * (lane - 32));
            LDS_WAIT(); asm volatile("" ::: "memory");
        } } }
}

__device__ __forceinline__ void transpose_item(const float* W, int ldw, bf16* WT, int row_off, LAS float* scr, int item, int nblk, int lane) {
    const int kb = item / nblk, nb = item % nblk, k0 = 64 * kb, n0 = 32 * nb;
#pragma unroll 8
    for (int i = 0; i < 32; ++i) { const int kk = 2 * i + (lane >> 5); scr[kk * 33 + (lane & 31)] = W[(size_t)(k0 + kk) * ldw + n0 + (lane & 31)]; }
    LDS_WAIT(); asm volatile("" ::: "memory");
    const int c = lane & 7;
#pragma unroll
    for (int j = 0; j < 4; ++j) { const int n = (lane >> 3) + 8 * j; const LAS float* s = scr + (8 * c) * 33 + n;
        v4u o; o.x = pk2(s[0 * 33], s[1 * 33]); o.y = pk2(s[2 * 33], s[3 * 33]); o.z = pk2(s[4 * 33], s[5 * 33]); o.w = pk2(s[6 * 33], s[7 * 33]);
        *(v4u*)(WT + (size_t)(row_off + n0 + n) * 1024 + k0 + 8 * c) = o; }
    LDS_WAIT(); asm volatile("" ::: "memory");
}

__device__ __forceinline__ void phase_prologue(Frame& F) {
    KARGS;
    LAS float* cact = (LAS float*)F.lds;
    LAS float* part = cact + 2048;
    {   const float* c = IN(1);
        for (int i = F.tid; i < 2048; i += NTHR) { const float v = c[i]; cact[i] = v / (1.f + expf(-v)); } }
    __syncthreads();
    {
        const float* ada_w = IN(2); const float* ada_b = IN(3); float* MOD = WSP(float, WS_MOD);
        for (int it = F.bid; it < 384; it += F.G) {
            const int l = it / 96, j0 = (it % 96) * 64;
            const float* wp = ada_w + ((size_t)l * 1024 + F.wave * 128) * 6144 + j0 + F.lane;
            float a0 = 0.f, a1 = 0.f;
#pragma unroll 8
            for (int k = 0; k < 128; ++k) { const float w = wp[(size_t)k * 6144]; a0 += cact[F.wave * 128 + k] * w; a1 += cact[1024 + F.wave * 128 + k] * w; }
            part[(F.wave * 2 + 0) * 64 + F.lane] = a0; part[(F.wave * 2 + 1) * 64 + F.lane] = a1;
            __syncthreads();
            if (F.tid < 128) { const int b = F.tid >> 6, col = F.tid & 63; float s = 0.f;
#pragma unroll
                for (int w = 0; w < 8; ++w) s += part[(w * 2 + b) * 64 + col];
                MOD[(l * 2 + b) * 6144 + j0 + col] = s + ada_b[l * 6144 + j0 + col]; }
            __syncthreads();
        }
    }
    {
        LAS float* scr = (LAS float*)(F.lds + 16384 + F.wave * 8448);
        const int gw = F.bid * NWAVES + F.wave, NGW = F.G * NWAVES;
        constexpr int I_A = 16 * 64, I_B = 16 * 64, I_C = 16 * 56, I_D = 16 * 32, I_E = 16 * 64;
        constexpr int NITEMS = 2 * I_A + 2 * I_B + 2 * I_C + 4 * I_D + 4 * I_E;
        for (int it = gw; it < NITEMS; it += NGW) {
            int r = it;
            if (r < 2 * I_A) { const int j = r / I_A; transpose_item(IN(6) + (size_t)j * 1024 * 2048, 2048, WSP(bf16, WS_WIN + (size_t)(2 * j) * 8 * MiB), 0, scr, r % I_A, 64, F.lane); continue; } r -= 2 * I_A;
            if (r < 2 * I_B) { const int j = r / I_B; transpose_item(IN(10) + (size_t)j * 1024 * ODD_LD, ODD_LD, WSP(bf16, WS_WIN + (size_t)(2 * j + 1) * 8 * MiB), 0, scr, r % I_B, 64, F.lane); continue; } r -= 2 * I_B;
            if (r < 2 * I_C) { const int j = r / I_C; transpose_item(IN(10) + (size_t)j * 1024 * ODD_LD + 2056, ODD_LD, WSP(bf16, WS_WIN + (size_t)(2 * j + 1) * 8 * MiB), 2048, scr, r % I_C, 56, F.lane); continue; } r -= 2 * I_C;
            if (r < 4 * I_D) { const int l = r / I_D; const int j = l >> 1; const float* src = (l & 1) ? IN(11) : IN(7);
                if ((l & 1) || (r % I_D) < 8 * 32) transpose_item(src + (size_t)j * 1024 * 1024, 1024, WSP(bf16, WS_WOUT + (size_t)l * 2 * MiB), 0, scr, r % I_D, 32, F.lane); continue; } r -= 4 * I_D;
            { const int l = r / I_E; transpose_item(IN(26) + (size_t)l * 1024 * 2048, 2048, WSP(bf16, WS_WQ + (size_t)l * 4 * MiB), 0, scr, r % I_E, 64, F.lane); }
        }
    }
    {
        const int gt = F.bid * NTHR + F.tid, NGT = F.G * NTHR;
        float* WF = WSP(float, WS_WF);
        for (int i = gt; i < 2 * 8 * 1024; i += NGT) { const int j = i >> 13, h = (i >> 10) & 7, k = i & 1023; WF[i] = IN(10)[((size_t)j * 1024 + k) * ODD_LD + 2048 + h]; }
        bf16* KEYS = WSP(bf16, WS_KEYS);
        for (int i = gt; i < 4 * 16384; i += NGT) { const int l = i >> 14, r = i & 16383;
            KEYS[(size_t)(l * 2 + 0) * 16384 + r] = (bf16)f2bf(IN(27)[i]); KEYS[(size_t)(l * 2 + 1) * 16384 + r] = (bf16)f2bf(IN(28)[i]); }
        for (int i = gt; i < 2 * 512 * 256; i += NGT) { const int j = i >> 17, ch = (i >> 8) & 511, k = i & 255; bf16* dst = WSP(bf16, WS_LORA) + (size_t)j * 131072;
            if (k < 64) dst[ch * 64 + k] = (bf16)f2bf(IN(17)[((size_t)j * 64 + k) * 512 + ch]);
            else if (k < 128) dst[32768 + ch * 64 + (k - 64)] = (bf16)f2bf(IN(19)[((size_t)j * 64 + (k - 64)) * 512 + ch]);
            else dst[65536 + ch * 128 + (k - 128)] = (bf16)f2bf(IN(20)[((size_t)j * 128 + (k - 128)) * 512 + ch]); }
        {   LAS float* pwl = (LAS float*)(F.lds + 98304);
            for (int it = (F.bid + F.G - 128 % F.G) % F.G; it < 128; it += F.G) { const int j = it >> 6, g = (it >> 4) & 3, cq = (it >> 1) & 7, nh = it & 1;
                __syncthreads();
                for (int i = F.tid; i < 2048; i += NTHR) { const int d = i >> 4, cc = i & 15; pwl[i] = IN(8)[((size_t)(j * 4 + g) * 128 + cq * 16 + cc) * 128 + d] * IN(9)[j * 512 + g * 128 + d]; }
                __syncthreads();
                const int n = nh * 512 + F.tid; const float* wo = IN(7) + ((size_t)j * 1024 + 512 + g * 128) * 1024 + n;
                float acc[16];
#pragma unroll
                for (int cc = 0; cc < 16; ++cc) acc[cc] = 0.f;
#pragma unroll 8
                for (int d = 0; d < 128; ++d) { const float wv = wo[(size_t)d * 1024];
#pragma unroll
                    for (int q4 = 0; q4 < 4; ++q4) { const f32x4 p4 = *(const LAS f32x4*)(pwl + d * 16 + 4 * q4); acc[4 * q4] += p4.x * wv; acc[4 * q4 + 1] += p4.y * wv; acc[4 * q4 + 2] += p4.z * wv; acc[4 * q4 + 3] += p4.w * wv; } }
                v4u o0, o1; o0.x = pk2(acc[0], acc[1]); o0.y = pk2(acc[2], acc[3]); o0.z = pk2(acc[4], acc[5]); o0.w = pk2(acc[6], acc[7]);
                o1.x = pk2(acc[8], acc[9]); o1.y = pk2(acc[10], acc[11]); o1.z = pk2(acc[12], acc[13]); o1.w = pk2(acc[14], acc[15]);
                bf16* dst = WSP(bf16, WS_WOUT + (size_t)(2 * j) * 2 * MiB) + (size_t)n * 1024 + 512 + g * 128 + cq * 16;
                *(v4u*)dst = o0; *(v4u*)(dst + 8) = o1; }
            __syncthreads(); }
        {
            const int gw = F.bid * NWAVES + F.wave, NGW = F.G * NWAVES, lane = F.lane;
            for (int row0 = gw; row0 < 2 * NEXP; row0 += 4 * NGW) {
                f32x4 v[4][4];
                conv_issue<4>(IN(29), IN(30), 0, row0, NGW, lane, v);
                conv_finish<4>(WSP(unsigned char, WS_PU), WSP(unsigned char, WS_PV), WSP(float, WS_PS), 0, row0, NGW, lane, v, F.lds + 135168 + F.wave * 1024);
            }
        }
    }
}

__device__ __forceinline__ void phase_norm(Frame& F, int layer, int which) {
    KARGS;
    const float* X = (layer == 0 && which == 0) ? IN(0) : OUTP;
    const float* gain = (which ? IN(5) : IN(4)) + layer * 1024;
    const float* mod = WSP(float, WS_MOD) + (size_t)layer * 2 * 6144 + (which ? 3072 : 0);
    bf16* H = WSP(bf16, WS_H);
    const bool do_f = (layer & 1) && which == 0;
    const int jj = layer >> 1;
    const float* WF = WSP(float, WS_WF) + (size_t)jj * 8 * 1024;
    float* LOGF = WSP(float, WS_LOGF);
    const int gw = F.bid * NWAVES + F.wave, NGW = F.G * NWAVES, lane = F.lane;
    f32x4 gn[4];
#pragma unroll
    for (int j = 0; j < 4; ++j) gn[j] = *(const f32x4*)(gain + 256 * j + 4 * lane);
    for (int row = gw; row < T; row += NGW) {
        const int b = row >= SEQ ? 1 : 0;
        const float* sh = mod + b * 6144; const float* sc = sh + 1024;
        const float* xr = X + (size_t)row * D + 4 * lane;
        f32x4 v[4]; float ss = 0.f;
#pragma unroll
        for (int j = 0; j < 4; ++j) { v[j] = *(const f32x4*)(xr + 256 * j); ss += (v[j].x * v[j].x + v[j].y * v[j].y) + (v[j].z * v[j].z + v[j].w * v[j].w); }
        const float rstd = rsqrtf(wave_sum(ss) * (1.f / D) + NORM_EPS);
        bf16* hr = H + (size_t)row * D + 4 * lane;
#pragma unroll
        for (int j = 0; j < 4; ++j) { const f32x4 s4 = *(const f32x4*)(sc + 256 * j + 4 * lane), h4 = *(const f32x4*)(sh + 256 * j + 4 * lane);
            v[j] = v[j] * rstd * gn[j] * (s4 + 1.f) + h4;
            v2u o; o.x = pk2(v[j].x, v[j].y); o.y = pk2(v[j].z, v[j].w); *(v2u*)(hr + 256 * j) = o; }
        if (which == 1) {
            float am = 0.f;
#pragma unroll
            for (int j = 0; j < 4; ++j) am = fmaxf(am, fmaxf(fmaxf(fabsf(v[j].x), fabsf(v[j].y)), fmaxf(fabsf(v[j].z), fabsf(v[j].w))));
            am = wave_max(am); const float s8 = am > 0.f ? am * (1.f / 224.f) : 1.f, i8 = 1.f / s8;
            unsigned char* h8 = WSP(unsigned char, WS_H8) + (size_t)row * D + 4 * lane;
#pragma unroll
            for (int j = 0; j < 4; ++j) { int w8 = 0; w8 = __builtin_amdgcn_cvt_pk_fp8_f32(v[j].x * i8, v[j].y * i8, w8, false); w8 = __builtin_amdgcn_cvt_pk_fp8_f32(v[j].z * i8, v[j].w * i8, w8, true); *(int*)(h8 + 256 * j) = w8; }
            if (lane == 0) WSP(float, WS_HS)[row] = s8;
        }
        if (do_f) {
            const float* fb = IN(14) + jj * 8;
            const int t = row - b * SEQ;
#pragma unroll
            for (int hh = 0; hh < 8; ++hh) { float d = 0.f;
#pragma unroll
                for (int j = 0; j < 4; ++j) { const f32x4 w4 = *(const f32x4*)(WF + hh * 1024 + 256 * j + 4 * lane); d += (v[j].x * w4.x + v[j].y * w4.y) + (v[j].z * w4.z + v[j].w * w4.w); }
                d = wave_sum(d) + fb[hh];
                const float lf = fminf(d, 0.f) - log1pf(expf(-fabsf(d)));
                if (lane == 0) LOGF[(size_t)(b * 8 + hh) * SEQ + t] = lf; }
        }
    }
}

__device__ __forceinline__ void load_q64(float (&q)[64], const bf16* p, float scale) {
#pragma unroll
    for (int c = 0; c < 8; ++c) { const v4u w = *(const v4u*)(p + 8 * c);
        q[8 * c + 0] = bflo(w.x) * scale; q[8 * c + 1] = bfhi(w.x) * scale; q[8 * c + 2] = bflo(w.y) * scale; q[8 * c + 3] = bfhi(w.y) * scale;
        q[8 * c + 4] = bflo(w.z) * scale; q[8 * c + 5] = bfhi(w.z) * scale; q[8 * c + 6] = bflo(w.w) * scale; q[8 * c + 7] = bfhi(w.w) * scale; }
}
__device__ __forceinline__ float dot_q64(const float (&q)[64], const bf16* p) {
    float z0 = 0.f, z1 = 0.f;
#pragma unroll
    for (int c = 0; c < 8; ++c) { const v4u w = *(const v4u*)(p + 8 * c);
        z0 += q[8 * c + 0] * bflo(w.x) + q[8 * c + 2] * bflo(w.y) + q[8 * c + 4] * bflo(w.z) + q[8 * c + 6] * bflo(w.w);
        z1 += q[8 * c + 1] * bfhi(w.x) + q[8 * c + 3] * bfhi(w.y) + q[8 * c + 5] * bfhi(w.z) + q[8 * c + 7] * bfhi(w.w); }
    return z0 + z1;
}
#ifdef MK_SIMPLE_EVEN
__device__ __forceinline__ void phase_even_mixer_simple(Frame& F, int layer) {
    KARGS;
    const bf16* P = WSP(bf16, WS_PROJ); bf16* MIX = WSP(bf16, WS_MIX);
    const int lane = F.lane;
    {
        const int gw = F.bid * NWAVES + F.wave, NGW = F.G * NWAVES;
        for (int it = gw; it < BATCH * 8 * SEQ; it += NGW) {
            const int b = it >> 16, h = (it >> 13) & 7, t = it & 8191;
            const bf16* base = P + (size_t)b * SEQ * EVEN_IN;
            float q[64]; load_q64(q, base + (size_t)t * EVEN_IN + h * 64, 0.125f);
            float acc = 0.f, carry = 0.f;
            for (int s0 = t - 1; s0 >= 0; s0 -= 64) {
                const int s = s0 - lane; const bool valid = s >= 0; const int sc = valid ? s : 0;
                const float z = dot_q64(q, base + (size_t)sc * EVEN_IN + 512 + h * 64);
                const float sp = softplusf_(z);
                const float l1m = valid ? -sp : 0.f;
                const float lb = z - sp;
                float inc = l1m;
#pragma unroll
                for (int o = 1; o < 64; o <<= 1) { const float n = __shfl_up(inc, o); if (lane >= o) inc += n; }
                const float w = valid ? expf(lb + carry + (inc - l1m)) : 0.f;
                const float tot = __shfl(inc, 63);
#pragma unroll 16
                for (int j = 0; j < 64; ++j) { const float wj = rl(w, j); int sj = s0 - j; sj = sj < 0 ? 0 : sj;
                    acc += wj * bf2f(base[(size_t)sj * EVEN_IN + 1024 + h * 64 + lane]); }
                carry += tot;
                if (carry < -104.f) break;
            }
            MIX[((size_t)b * SEQ + t) * D + h * 64 + lane] = (bf16)f2bf(acc);
        }
    }
    {
        LAS float* pl = (LAS float*)F.lds;
        const int jj = layer >> 1;
        const float* pw = IN(8) + (size_t)jj * 4 * 128 * 128; const float* ps = IN(9) + jj * 512;
        const int c = F.tid, g = c >> 7, w = 2 << g, d = c & 127;
        for (int tile = F.bid; tile < T / 32; tile += F.G) {
            const int t0 = tile * 32, b = t0 / SEQ, tl0 = t0 % SEQ;
            const bf16* base = P + (size_t)b * SEQ * EVEN_IN + 1536 + c;
            for (int tt = 0; tt < 32; ++tt) { const int tl = tl0 + tt, cend = (tl / 64 + 1) * 64;
                int lo = tl - w / 2; lo = lo < 0 ? 0 : lo; int hi = tl + w / 2; hi = hi > cend ? cend : hi;
                float s = 0.f; for (int u = lo; u < hi; ++u) s += bf2f(base[(size_t)u * EVEN_IN]);
                pl[c * 33 + tt] = s / (float)(hi - lo) - bf2f(base[(size_t)tl * EVEN_IN]); }
            __syncthreads();
            float acc[32];
#pragma unroll
            for (int tt = 0; tt < 32; ++tt) acc[tt] = 0.f;
            for (int cc = 0; cc < 128; ++cc) { const float wv = pw[((size_t)g * 128 + cc) * 128 + d]; const LAS float* pr = pl + (g * 128 + cc) * 33;
#pragma unroll
                for (int tt = 0; tt < 32; ++tt) acc[tt] += pr[tt] * wv; }
            const float sc = ps[c];
#pragma unroll
            for (int tt = 0; tt < 32; ++tt) MIX[(size_t)(t0 + tt) * D + 512 + c] = (bf16)f2bf(acc[tt] * sc);
            __syncthreads();
        }
    }
}

#endif
typedef float f32x16 __attribute__((ext_vector_type(16)));
typedef short s16x4 __attribute__((ext_vector_type(4)));
#define MAX3F(a, b, c) __builtin_fmaxf(__builtin_fmaxf((a), (b)), (c))
#define ZERO16(a) do { _Pragma("unroll") for (int r_ = 0; r_ < 16; ++r_) a[r_] = 0.f; } while (0)
constexpr int FX_KROW = 144, FX_VROW = 192;
constexpr int FX_KB = 64 * FX_KROW, FX_VB = 64 * FX_VROW, FX_BUF = FX_KB + FX_VB + 256;
template <int HW> __device__ __forceinline__ void pool_chunk(const bf16* src, bf16* dst, int tl0) {
    float ps[HW + 65 + HW]; ps[0] = 0.f;
#pragma unroll
    for (int i = 0; i < 64 + HW; ++i) { const int tl = tl0 - HW + i; const float x = tl >= 0 ? bf2f(src[(long)(i - HW) * EVEN_IN]) : 0.f; ps[i + 1] = ps[i] + x; }
#pragma unroll
    for (int tt = 0; tt < 64; ++tt) { const int tl = tl0 + tt; int lo = tl - HW; lo = lo < 0 ? 0 : lo; const int hie = tt + HW > 64 ? 64 : tt + HW;
        const float sum = ps[hie + HW] - ps[tt]; const float x = ps[tt + HW + 1] - ps[tt + HW];
        dst[(size_t)tt * D] = (bf16)f2bf(sum / (float)(tl0 + hie - lo) - x); }
}
__device__ __forceinline__ void phase_even_mixer(Frame& F, int layer) {
    KARGS;
    const bf16* P = WSP(bf16, WS_PROJ); bf16* MIX = WSP(bf16, WS_MIX);
    const int tid = F.tid, lane = F.lane, wave = F.wave, r32 = lane & 31, hh = lane >> 5;
    const float LOG2E = 1.4426950408889634f, CS = 0.125f * LOG2E;
    const int srow = tid >> 3, sch = tid & 7;
    {
        const int c = tid, g = c >> 7;
        for (int ck = F.bid; ck < T / 64; ck += F.G) {
            const int t0 = ck * 64, tl0 = t0 % SEQ;
            const bf16* src = P + (size_t)t0 * EVEN_IN + 1536 + c; bf16* dst = MIX + (size_t)t0 * D + 512 + c;
            if (g == 0) pool_chunk<1>(src, dst, tl0); else if (g == 1) pool_chunk<2>(src, dst, tl0); else if (g == 2) pool_chunk<4>(src, dst, tl0); else pool_chunk<8>(src, dst, tl0);
        }
    }
    __syncthreads();
    for (int u = F.bid; u < 256; u += F.G) {
        for (int ui = 0; ui < 2; ++ui) {
            const int bh = u >> 4, ss = u & 15, qb = ui == 0 ? ss : 31 - ss, b = bh >> 3, h = bh & 7;
            const bf16* base = P + (size_t)b * SEQ * EVEN_IN;
            const int q0 = 256 * qb + 32 * wave, myq = q0 + r32;
            bf16x8 qf[4];
#pragma unroll
            for (int d0 = 0; d0 < 4; ++d0) qf[d0] = *(const bf16x8*)(base + (size_t)myq * EVEN_IN + h * 64 + 16 * d0 + 8 * hh);
            float carry = 0.f;
            f32x16 o[2];
#pragma unroll
            for (int r = 0; r < 16; ++r) { o[0][r] = 0.f; o[1][r] = 0.f; }
            const int jtop = 4 * qb + 3;
            v4u kreg = *(const v4u*)(base + (size_t)(64 * jtop + srow) * EVEN_IN + 512 + h * 64 + sch * 8);
            v4u vreg = *(const v4u*)(base + (size_t)(64 * jtop + srow) * EVEN_IN + 1024 + h * 64 + sch * 8);
            __syncthreads();
            *(LAS v4u*)(F.lds + srow * FX_KROW + sch * 16) = kreg; *(LAS v4u*)(F.lds + FX_KB + srow * FX_VROW + sch * 16) = vreg;
            if (tid < 16) ((LAS unsigned*)(F.lds + 2 * FX_BUF))[tid] = 0u;
            __syncthreads();
            int it = 0;
            for (int j = jtop; j >= 0; --j, ++it) {
                const int cur = (it & 1) * FX_BUF, nxt = ((it + 1) & 1) * FX_BUF;
                if (j > 0) { const size_t krow = (size_t)(64 * (j - 1) + srow) * EVEN_IN;
                    kreg = *(const v4u*)(base + krow + 512 + h * 64 + sch * 8); vreg = *(const v4u*)(base + krow + 1024 + h * 64 + sch * 8); }
                const bool started = 64 * j <= q0 + 30;
                const bool wprev = __all(carry < -150.f);
                if (started && !wprev) {
                    const LAS unsigned char* Kb = F.lds + cur; const LAS unsigned char* Vb = F.lds + cur + FX_KB;
                    f32x16 p0, p1;
#pragma unroll
                    for (int r = 0; r < 16; ++r) { p0[r] = 0.f; p1[r] = 0.f; }
#pragma unroll
                    for (int d0 = 0; d0 < 4; ++d0) {
                        const bf16x8 a0 = *(const LAS bf16x8*)(Kb + r32 * FX_KROW + 32 * d0 + 16 * hh);
                        const bf16x8 a1 = *(const LAS bf16x8*)(Kb + (r32 + 32) * FX_KROW + 32 * d0 + 16 * hh);
                        p0 = __builtin_amdgcn_mfma_f32_32x32x16_bf16(a0, qf[d0], p0, 0, 0, 0);
                        p1 = __builtin_amdgcn_mfma_f32_32x32x16_bf16(a1, qf[d0], p1, 0, 0, 0);
                    }
                    f32x16 l0, l1v;
#pragma unroll
                    for (int r = 0; r < 16; ++r) {
                        const int key = 64 * j + (r & 3) + 8 * (r >> 2) + 4 * hh;
                        const float za = p0[r] * CS, zb = p1[r] * CS;
                        const float sa = fmaxf(za, 0.f) + __builtin_amdgcn_logf(1.f + __builtin_amdgcn_exp2f(-fabsf(za)));
                        const float sb = fmaxf(zb, 0.f) + __builtin_amdgcn_logf(1.f + __builtin_amdgcn_exp2f(-fabsf(zb)));
                        l0[r] = -sa; l1v[r] = -sb; p0[r] = za - sa; p1[r] = zb - sb; (void)key;
                    }
                    if (64 * j + 63 >= q0) {
                        asm volatile("" ::: "memory");
#pragma unroll
                        for (int r = 0; r < 16; ++r) { const int key = 64 * j + (r & 3) + 8 * (r >> 2) + 4 * hh;
                            if (!(key < myq)) { l0[r] = 0.f; p0[r] = -INFINITY; } if (!(key + 32 < myq)) { l1v[r] = 0.f; p1[r] = -INFINITY; } }
                    }
                    float tot[8], oth[8];
#pragma unroll
                    for (int g = 0; g < 4; ++g) { tot[g] = (l0[4 * g] + l0[4 * g + 1]) + (l0[4 * g + 2] + l0[4 * g + 3]); tot[4 + g] = (l1v[4 * g] + l1v[4 * g + 1]) + (l1v[4 * g + 2] + l1v[4 * g + 3]); }
#pragma unroll
                    for (int g = 0; g < 8; ++g) oth[g] = __shfl_xor(tot[g], 32);
                    float sfx[8]; float run = 0.f;
#pragma unroll
                    for (int x = 7; x >= 0; --x) { sfx[x] = run; run += tot[x] + oth[x]; }
#pragma unroll
                    for (int x = 0; x < 8; ++x) {
                        const float goff = carry + sfx[x] + (hh == 0 ? oth[x] : 0.f);
                        if (x < 4) { const float s3 = goff, s2 = s3 + l0[4 * x + 3], s1 = s2 + l0[4 * x + 2], s0 = s1 + l0[4 * x + 1];
                            p0[4 * x] = __builtin_amdgcn_exp2f(p0[4 * x] + s0); p0[4 * x + 1] = __builtin_amdgcn_exp2f(p0[4 * x + 1] + s1); p0[4 * x + 2] = __builtin_amdgcn_exp2f(p0[4 * x + 2] + s2); p0[4 * x + 3] = __builtin_amdgcn_exp2f(p0[4 * x + 3] + s3); }
                        else { const int y = x - 4; const float s3 = goff, s2 = s3 + l1v[4 * y + 3], s1 = s2 + l1v[4 * y + 2], s0 = s1 + l1v[4 * y + 1];
                            p1[4 * y] = __builtin_amdgcn_exp2f(p1[4 * y] + s0); p1[4 * y + 1] = __builtin_amdgcn_exp2f(p1[4 * y + 1] + s1); p1[4 * y + 2] = __builtin_amdgcn_exp2f(p1[4 * y + 2] + s2); p1[4 * y + 3] = __builtin_amdgcn_exp2f(p1[4 * y + 3] + s3); }
                    }
                    carry += run;
                    bf16x8 pf[4];
#pragma unroll
                    for (int s4 = 0; s4 < 4; ++s4) {
                        v4u w;
                        if (s4 < 2) { w.x = pk2(p0[8 * s4 + 0], p0[8 * s4 + 1]); w.y = pk2(p0[8 * s4 + 2], p0[8 * s4 + 3]); w.z = pk2(p0[8 * s4 + 4], p0[8 * s4 + 5]); w.w = pk2(p0[8 * s4 + 6], p0[8 * s4 + 7]); }
                        else { const int sp = s4 - 2; w.x = pk2(p1[8 * sp + 0], p1[8 * sp + 1]); w.y = pk2(p1[8 * sp + 2], p1[8 * sp + 3]); w.z = pk2(p1[8 * sp + 4], p1[8 * sp + 5]); w.w = pk2(p1[8 * sp + 6], p1[8 * sp + 7]); }
                        pf[s4] = __builtin_bit_cast(bf16x8, w);
                    }
                    const int gi = lane >> 4, li = lane & 15;
                    const LAS unsigned char* vbase = Vb + (4 * (gi >> 1) + (li >> 2)) * FX_VROW + (16 * (gi & 1) + 4 * (li & 3)) * 2;
#pragma unroll
                    for (int d0 = 0; d0 < 2; ++d0)
#pragma unroll
                        for (int s4 = 0; s4 < 4; ++s4) {
                            const s16x4 lo = __builtin_bit_cast(s16x4, __builtin_amdgcn_ds_read_tr16_b64_v4i16((LAS s16x4*)(vbase + (16 * s4) * FX_VROW + 64 * d0)));
                            const s16x4 hi = __builtin_bit_cast(s16x4, __builtin_amdgcn_ds_read_tr16_b64_v4i16((LAS s16x4*)(vbase + (16 * s4 + 8) * FX_VROW + 64 * d0)));
                            const bf16x8 vf = (bf16x8){lo[0], lo[1], lo[2], lo[3], hi[0], hi[1], hi[2], hi[3]};
                            o[d0] = __builtin_amdgcn_mfma_f32_32x32x16_bf16(vf, pf[s4], o[d0], 0, 0, 0);
                        }
                }
                const bool wdone = started && __all(carry < -150.f);
                if (lane == 0) ((LAS unsigned*)(F.lds + 2 * FX_BUF))[(it & 1) * 8 + wave] = wdone ? 1u : 0u;
                if (j > 0) { *(LAS v4u*)(F.lds + nxt + srow * FX_KROW + sch * 16) = kreg; *(LAS v4u*)(F.lds + nxt + FX_KB + srow * FX_VROW + sch * 16) = vreg; }
                LBAR();
                const LAS unsigned* fl = (const LAS unsigned*)(F.lds + 2 * FX_BUF) + (it & 1) * 8;
                const unsigned alld = fl[0] & fl[1] & fl[2] & fl[3] & fl[4] & fl[5] & fl[6] & fl[7];
                if (alld) break;
            }
            bf16* op = MIX + ((size_t)b * SEQ + myq) * D + h * 64;
#pragma unroll
            for (int d0 = 0; d0 < 2; ++d0)
#pragma unroll
                for (int g = 0; g < 4; ++g) { const int db = 32 * d0 + 8 * g + 4 * hh;
                    v2u ow; ow.x = pk2(o[d0][4 * g + 0], o[d0][4 * g + 1]); ow.y = pk2(o[d0][4 * g + 2], o[d0][4 * g + 3]); *(v2u*)(op + db) = ow; }
        }
    }
}

__device__ __forceinline__ void phase_odd_prep(Frame& F, int layer, int parts) {
    KARGS;
    const int jj = layer >> 1, lane = F.lane, tid = F.tid, w = F.wave, r32 = lane & 31, hh = lane >> 5;
    bf16* P = WSP(bf16, WS_PROJ);
    if (F.bid < 16 && (parts & 4)) {
        const float* lf = WSP(float, WS_LOGF) + (size_t)F.bid * SEQ + 1024 * w; float* dc = WSP(float, WS_DCUM) + (size_t)F.bid * SEQ + 1024 * w;
        float inc[16];
#pragma unroll
        for (int i = 0; i < 16; ++i) inc[i] = lf[64 * i + lane];
        double offs[16]; double carry = 0.0;
#pragma unroll
        for (int i = 0; i < 16; ++i) {
#pragma unroll
            for (int o = 1; o < 64; o <<= 1) { const float n = __shfl_up(inc[i], o); if (lane >= o) inc[i] += n; }
            offs[i] = carry; carry += (double)__shfl(inc[i], 63); }
        LAS double* wt = (LAS double*)F.lds;
        if (lane == 0) wt[w] = carry;
        __syncthreads();
        double base = 0.0;
#pragma unroll
        for (int ww = 0; ww < 8; ++ww) if (ww < w) base += wt[ww];
#pragma unroll
        for (int i = 0; i < 16; ++i) dc[64 * i + lane] = (float)(base + offs[i] + (double)inc[i]);
        __syncthreads();
    }
    constexpr int LXP = 528;
    LAS unsigned char* lx = F.lds;
    const float* mix = IN(15) + jj * 1792;
    const float* w0 = IN(16) + jj * 512; const float* a0 = IN(18) + jj * 512;
    const float* kkp = IN(21) + jj * 512; const float* kap = IN(22) + jj * 512;
    const float* qn = IN(12) + jj * 64; const float* kn = IN(13) + jj * 64;
    const bf16* LT = WSP(bf16, WS_LORA) + (size_t)jj * 131072;
    float* R = WSP(float, WS_RW); float* LWp = WSP(float, WS_RW + RW_SLOT); float* K = WSP(float, WS_RW + 2 * RW_SLOT); float* V = WSP(float, WS_RW + 3 * RW_SLOT);
    float* KK = WSP(float, WS_RW + 4 * RW_SLOT); float* A = WSP(float, WS_RW + 5 * RW_SLOT); float* Gt = WSP(float, WS_RW + 6 * RW_SLOT);
    for (int item = F.bid; item < T / 64; item += F.G) {
        const int t0 = item * 64;
        if (parts & 1) {
        for (int i = tid; i < 64 * 32; i += NTHR) { const int tt = i >> 5, j8 = 8 * (i & 31), tg = t0 + tt, tl = tg % SEQ, col = 1536 + j8;
            const v4u cw = *(const v4u*)(P + (size_t)tg * ODD_N + 2048 + col); v4u pw = (v4u){0u, 0u, 0u, 0u}; if (tl > 0) pw = *(const v4u*)(P + (size_t)(tg - 1) * ODD_N + 2048 + col);
            const f32x4 m0 = *(const f32x4*)(mix + col), m1 = *(const f32x4*)(mix + col + 4);
            v4u ow;
#pragma unroll
            for (int q = 0; q < 4; ++q) { const float c0 = bflo(cw[q]), c1 = bfhi(cw[q]), p0 = bflo(pw[q]), p1 = bfhi(pw[q]);
                const float mm0 = q < 2 ? m0[2 * q] : m1[2 * q - 4], mm1 = q < 2 ? m0[2 * q + 1] : m1[2 * q - 3];
                const float x0 = c0 + (p0 - c0) * mm0, x1 = c1 + (p1 - c1) * mm1;
                ow[q] = j8 < 64 ? pk2(tanhf(x0), tanhf(x1)) : (j8 < 128 ? pk2(x0, x1) : pk2(sigmoidf_(x0), sigmoidf_(x1))); }
            *(LAS v4u*)(lx + tt * LXP + j8 * 2) = ow; }
        __syncthreads();
#pragma unroll 1
        for (int L = 0; L < 3; ++L) {
            const int koff = L == 0 ? 0 : (L == 1 ? 64 : 128), ksteps = L == 2 ? 8 : 4, kdim = L == 2 ? 128 : 64;
            const bf16* Wt = LT + (L == 0 ? 0 : (L == 1 ? 32768 : 65536));
            float* dst = L == 0 ? LWp : (L == 1 ? A : Gt);
            f32x16 acc[2][2];
#pragma unroll
            for (int a_ = 0; a_ < 2; ++a_)
#pragma unroll
                for (int b_ = 0; b_ < 2; ++b_) ZERO16(acc[a_][b_]);
#pragma unroll 1
            for (int s4 = 0; s4 < ksteps; ++s4) {
                bf16x8 af[2], bfr[2];
#pragma unroll
                for (int tm = 0; tm < 2; ++tm) af[tm] = *(const LAS bf16x8*)(lx + (32 * tm + r32) * LXP + (koff + 16 * s4 + 8 * hh) * 2);
#pragma unroll
                for (int tn = 0; tn < 2; ++tn) bfr[tn] = *(const bf16x8*)(Wt + (size_t)(64 * w + 32 * tn + r32) * kdim + 16 * s4 + 8 * hh);
#pragma unroll
                for (int tm = 0; tm < 2; ++tm)
#pragma unroll
                    for (int tn = 0; tn < 2; ++tn) acc[tm][tn] = __builtin_amdgcn_mfma_f32_32x32x16_bf16(af[tm], bfr[tn], acc[tm][tn], 0, 0, 0);
            }
#pragma unroll
            for (int tn = 0; tn < 2; ++tn)
#pragma unroll
                for (int tm = 0; tm < 2; ++tm) { float* dp = dst + (size_t)(t0 + 32 * tm + 4 * hh) * 512 + 64 * w + 32 * tn + r32;
#pragma unroll
                    for (int r = 0; r < 16; ++r) dp[(size_t)((r & 3) + 8 * (r >> 2)) * 512] = acc[tm][tn][r]; }
        }
        asm volatile("s_waitcnt vmcnt(0)" ::: "memory");
        __syncthreads();
        }
        if (parts & 2) {
            LAS float* nrm = (LAS float*)(F.lds + 40960);
            {
                const int tt = tid >> 3, hd = tid & 7, tg = t0 + tt, tl = tg % SEQ;
                const bf16* bp = P + (size_t)tg * ODD_N + hd * 64;
                float qs = 0.f, ks = 0.f, n2 = 0.f;
#pragma unroll 2
                for (int c = 0; c < 8; ++c) {
                    const v4u wq = *(const v4u*)(bp + 8 * c), wk = *(const v4u*)(bp + 512 + 8 * c), wc = *(const v4u*)(bp + 2048 + 512 + 8 * c);
                    v4u wp = (v4u){0u, 0u, 0u, 0u}; if (tl > 0) wp = *(const v4u*)(bp - ODD_N + 2048 + 512 + 8 * c);
                    const f32x4 mk0 = *(const f32x4*)(mix + 512 + hd * 64 + 8 * c), mk1 = *(const f32x4*)(mix + 512 + hd * 64 + 8 * c + 4);
                    const f32x4 kc0 = *(const f32x4*)(kkp + hd * 64 + 8 * c), kc1 = *(const f32x4*)(kkp + hd * 64 + 8 * c + 4);
#pragma unroll
                    for (int i = 0; i < 4; ++i) {
                        const float q0 = bflo(wq[i]), q1 = bfhi(wq[i]), k0 = bflo(wk[i]), k1 = bfhi(wk[i]);
                        qs += q0 * q0 + q1 * q1; ks += k0 * k0 + k1 * k1;
                        const float c0 = bflo(wc[i]), c1 = bfhi(wc[i]), p0 = bflo(wp[i]), p1 = bfhi(wp[i]);
                        const float m0 = i < 2 ? mk0[2 * i] : mk1[2 * i - 4], m1 = i < 2 ? mk0[2 * i + 1] : mk1[2 * i - 3];
                        const float g0 = i < 2 ? kc0[2 * i] : kc1[2 * i - 4], g1 = i < 2 ? kc0[2 * i + 1] : kc1[2 * i - 3];
                        const float x0 = (c0 + (p0 - c0) * m0) * g0, x1 = (c1 + (p1 - c1) * m1) * g1;
                        n2 += x0 * x0 + x1 * x1; }
                }
                *(LAS f32x4*)(nrm + (tt * 8 + hd) * 4) = (f32x4){rsqrtf(qs * (1.f / 64.f) + NORM_EPS), rsqrtf(ks * (1.f / 64.f) + NORM_EPS), 1.f / fmaxf(sqrtf(n2), 1e-12f), 0.f};
            }
            __syncthreads();
            const int c4 = 4 * (tid & 127), hd = c4 >> 6, th = tid >> 7;
            const f32x4 mr = *(const f32x4*)(mix + c4), mk = *(const f32x4*)(mix + 512 + c4), mv = *(const f32x4*)(mix + 1024 + c4);
            const f32x4 kk4 = *(const f32x4*)(kkp + c4), ka4 = *(const f32x4*)(kap + c4), w04 = *(const f32x4*)(w0 + c4), a04 = *(const f32x4*)(a0 + c4);
            const f32x4 qn4 = *(const f32x4*)(qn + (c4 & 63)), kn4 = *(const f32x4*)(kn + (c4 & 63));
#pragma unroll 2
            for (int t2 = 0; t2 < 16; ++t2) { const int tt = 16 * th + t2, tg = t0 + tt, tl = tg % SEQ;
                const bf16* pc = P + (size_t)tg * ODD_N + 2048 + c4; const bf16* pp = pc - ODD_N;
                const size_t o = (size_t)tg * 512 + c4;
                const f32x4 wraw = *(const f32x4*)(LWp + o), araw = *(const f32x4*)(A + o);
                const v2u rc = *(const v2u*)pc, kc = *(const v2u*)(pc + 512), vc = *(const v2u*)(pc + 1024);
                v2u rp = (v2u){0u, 0u}, kp = rp, vp = rp; if (tl > 0) { rp = *(const v2u*)pp; kp = *(const v2u*)(pp + 512); vp = *(const v2u*)(pp + 1024); }
                bf16* pq = P + (size_t)tg * ODD_N + c4;
                const v2u qw = *(const v2u*)pq, kw = *(const v2u*)(pq + 512);
                const f32x4 nm = *(const LAS f32x4*)(nrm + (tt * 8 + hd) * 4);
                f32x4 R4, V4, KK4, LW4, A4, K4; float qo[4], ko[4];
#pragma unroll
                for (int e = 0; e < 4; ++e) {
                    const float rcv = (e & 1) ? bfhi(rc[e >> 1]) : bflo(rc[e >> 1]), rpv = (e & 1) ? bfhi(rp[e >> 1]) : bflo(rp[e >> 1]);
                    const float kcv = (e & 1) ? bfhi(kc[e >> 1]) : bflo(kc[e >> 1]), kpv = (e & 1) ? bfhi(kp[e >> 1]) : bflo(kp[e >> 1]);
                    const float vcv = (e & 1) ? bfhi(vc[e >> 1]) : bflo(vc[e >> 1]), vpv = (e & 1) ? bfhi(vp[e >> 1]) : bflo(vp[e >> 1]);
                    const float qv = (e & 1) ? bfhi(qw[e >> 1]) : bflo(qw[e >> 1]), kv = (e & 1) ? bfhi(kw[e >> 1]) : bflo(kw[e >> 1]);
                    const float r = rcv + (rpv - rcv) * mr[e], k = kcv + (kpv - kcv) * mk[e], v = vcv + (vpv - vcv) * mv[e];
                    const float wl = -softplusf_(-(w04[e] + wraw[e])) - 0.5f, av = sigmoidf_(a04[e] + araw[e]);
                    R4[e] = r; V4[e] = v; KK4[e] = k * kk4[e] * nm.z; LW4[e] = -expf(wl); A4[e] = av; K4[e] = k * (1.f + (av - 1.f) * ka4[e]);
                    qo[e] = qv * nm.x * qn4[e]; ko[e] = kv * nm.y * kn4[e]; }
                *(f32x4*)(R + o) = R4; *(f32x4*)(V + o) = V4; *(f32x4*)(KK + o) = KK4; *(f32x4*)(LWp + o) = LW4; *(f32x4*)(A + o) = A4; *(f32x4*)(K + o) = K4;
                v2u qv2, kv2; qv2.x = pk2(qo[0], qo[1]); qv2.y = pk2(qo[2], qo[3]); kv2.x = pk2(ko[0], ko[1]); kv2.y = pk2(ko[2], ko[3]);
                *(v2u*)pq = qv2; *(v2u*)(pq + 512) = kv2; }
        }
        __syncthreads();
    }
}

constexpr int CP = 144;
constexpr int CM = 64 * CP;
__device__ __forceinline__ void mm_nt(f32x16& acc, const LAS unsigned char* A, const LAS unsigned char* B, int m0, int n0, int r32, int hh) {
#pragma unroll
    for (int s4 = 0; s4 < 4; ++s4) { const bf16x8 a = *(const LAS bf16x8*)(A + (m0 + r32) * CP + 32 * s4 + 16 * hh); const bf16x8 b = *(const LAS bf16x8*)(B + (n0 + r32) * CP + 32 * s4 + 16 * hh);
        acc = __builtin_amdgcn_mfma_f32_32x32x16_bf16(a, b, acc, 0, 0, 0); }
}
__device__ __forceinline__ void store_t(LAS unsigned char* Dst, const f32x16& acc, int m0, int n0, int r32, int hh, float sg) {
#pragma unroll
    for (int g = 0; g < 4; ++g) { v2u w; w.x = pk2(sg * acc[4 * g], sg * acc[4 * g + 1]); w.y = pk2(sg * acc[4 * g + 2], sg * acc[4 * g + 3]); *(LAS v2u*)(Dst + (n0 + r32) * CP + (m0 + 8 * g + 4 * hh) * 2) = w; }
}
__device__ __forceinline__ void load_t(f32x16& acc, const LAS unsigned char* Src, int m0, int n0, int r32, int hh, float sg) {
#pragma unroll
    for (int g = 0; g < 4; ++g) { const v2u w = *(const LAS v2u*)(Src + (n0 + r32) * CP + (m0 + 8 * g + 4 * hh) * 2);
        acc[4 * g] = sg * bflo(w.x); acc[4 * g + 1] = sg * bfhi(w.x); acc[4 * g + 2] = sg * bflo(w.y); acc[4 * g + 3] = sg * bfhi(w.y); }
}
__device__ __forceinline__ void mask16(f32x16& acc, int m0, int n0, int r32, int hh, int mode) {
    const int n = n0 + r32;
#pragma unroll
    for (int r = 0; r < 16; ++r) { const int m = m0 + (r & 3) + 8 * (r >> 2) + 4 * hh; const bool keep = mode == 0 ? (n < m) : (mode == 1 ? (m < n) : (m <= n)); acc[r] = keep ? acc[r] : 0.f; }
}
__device__ __forceinline__ void phase_rwkv_chunk(Frame& F, int layer, int qoff = 0, int parts = 15) {
    KARGS;
    const float* R = WSP(float, WS_RW); const float* LW = WSP(float, WS_RW + RW_SLOT); const float* K = WSP(float, WS_RW + 2 * RW_SLOT); const float* V = WSP(float, WS_RW + 3 * RW_SLOT);
    const float* KK = WSP(float, WS_RW + 4 * RW_SLOT); const float* A = WSP(float, WS_RW + 5 * RW_SLOT);
    bf16* CGp = WSP(bf16, WS_CG); bf16* CQp = WSP(bf16, WS_CQ); float* CHp = WSP(float, WS_CH); float* CYp = WSP(float, WS_CY);
    const int tid = F.tid, lane = F.lane, w = F.wave, r32 = lane & 31, hh = lane >> 5;
    LAS unsigned char* L = F.lds;
    LAS unsigned char* Ab = L, *Bb = L + CM, *Kb = L + 2 * CM, *Rb = L + 3 * CM, *BtT = L + 4 * CM, *KtT = L + 5 * CM, *VT = L + 6 * CM;
    LAS unsigned char* XT0 = L + 7 * CM, *XT1 = L + 9 * CM;
    LAS unsigned char* NB = L + 11 * CM;
    LAS unsigned char* Prb = L + 15 * CM;
    LAS float* tot = (LAS float*)(L + 16 * CM);
    LAS float* gCl = tot + 512;
    const int myx = (int)((unsigned)__builtin_amdgcn_s_getreg((3 << 11) | 20) & 7u);
    unsigned* qh = (unsigned*)F.ctl + CW_CHQ + qoff + layer * 8 * 64;
    for (int dx = 0; dx < 8; ++dx) { const int xs = (myx + dx) & 7;
    for (;;) {
        LBAR();
        if (tid == 0) F.MISC[20] = atomicAdd(qh + xs * 64, 1u);
        LBAR();
        const int kq = (int)F.MISC[20];
        if (kq >= 256) break;
        const int bh = xs + 8 * (kq >> 7), c = kq & 127, b = bh >> 3, h = bh & 7;
        {
            const size_t g0 = ((size_t)b * SEQ + c * 64 + 8 * w) * 512 + h * 64 + lane;
            float lw[8], cum[8]; float run = 0.f;
#pragma unroll
            for (int i = 0; i < 8; ++i) { lw[i] = LW[g0 + (size_t)i * 512]; run += lw[i]; cum[i] = run; }
            tot[w * 64 + lane] = run;
            LBAR();
            float off = 0.f, all = 0.f;
#pragma unroll
            for (int ww = 0; ww < 8; ++ww) { const float tv = tot[ww * 64 + lane]; if (ww < w) off += tv; all += tv; }
            if (w == 0) gCl[lane] = expf(all);
#pragma unroll
            for (int i = 0; i < 8; ++i) {
                const int t = 8 * w + i; const float cm = cum[i] + off;
                const float g = expf(cm), gex = expf(cm - lw[i]), gi = expf(-cm), gcg = expf(all - cm);
                const size_t gg = g0 + (size_t)i * 512;
                const float r = R[gg], k = K[gg], v = V[gg], kk = KK[gg], a = A[gg];
                const bf16 ab = (bf16)f2bf(kk * gex), bb = (bf16)f2bf(kk * a * gi), kb = (bf16)f2bf(k * gi), rb = (bf16)f2bf(r * g), bt = (bf16)f2bf(kk * a * gcg), kt = (bf16)f2bf(k * gcg), vb = (bf16)f2bf(v);
                *(LAS bf16*)(Ab + t * CP + lane * 2) = ab; *(LAS bf16*)(Bb + t * CP + lane * 2) = bb; *(LAS bf16*)(Kb + t * CP + lane * 2) = kb; *(LAS bf16*)(Rb + t * CP + lane * 2) = rb;
                *(LAS bf16*)(XT0 + lane * CP + t * 2) = ab; *(LAS bf16*)(BtT + lane * CP + t * 2) = bt; *(LAS bf16*)(KtT + lane * CP + t * 2) = kt; *(LAS bf16*)(VT + lane * CP + t * 2) = vb;
            }
            LBAR();
        }
        if (!(parts & 2)) continue;
        int r32m = r32; asm volatile("" : "+v"(r32m));
        const int xtm = w & 1, xtn = w >> 1;
        f32x16 xacc;
        {
#pragma unroll
            for (int qq = 0; qq < 2; ++qq) {
                int q; if (w < 4) q = 2 * w + qq; else { if (qq == 1) break; q = 8 + (w - 4); }
                const int pr = q >> 2, tm = (q >> 1) & 1, tn = q & 1; f32x16 acc; ZERO16(acc);
                if (pr == 0) { mm_nt(acc, Ab, Bb, 32 * tm, 32 * tn, r32, hh); mask16(acc, 32 * tm, 32 * tn, r32m, hh, 0); store_t(NB + 1 * CM, acc, 32 * tm, 32 * tn, r32, hh, -1.f); }
                else if (pr == 1) { mm_nt(acc, Bb, Ab, 32 * tm, 32 * tn, r32, hh); mask16(acc, 32 * tm, 32 * tn, r32m, hh, 1); store_t(NB + 0 * CM, acc, 32 * tm, 32 * tn, r32, hh, -1.f); }
                else { mm_nt(acc, Bb, Rb, 32 * tm, 32 * tn, r32, hh); mask16(acc, 32 * tm, 32 * tn, r32m, hh, 2); store_t(Prb, acc, 32 * tm, 32 * tn, r32, hh, 1.f); }
            }
            if (xtn >= 2) { ZERO16(xacc); mm_nt(xacc, Ab, Kb, 32 * xtm, 32 * (xtn - 2), r32, hh); mask16(xacc, 32 * xtm, 32 * (xtn - 2), r32m, hh, 0); store_t(XT0 + 64 * CP, xacc, 32 * xtm, 32 * (xtn - 2), r32, hh, 1.f); }
            else load_t(xacc, XT0, 32 * xtm, 32 * xtn, r32, hh, 1.f);
            LBAR();
        }
        if (!(parts & 4)) continue;
        LAS unsigned char* XTc = XT0; LAS unsigned char* XTn = XT1; int nb = 0;
#pragma unroll 1
        for (int j = 0; j < 6; ++j) {
            const LAS unsigned char* Nc = NB + (2 * nb) * CM; const LAS unsigned char* NTc = NB + (2 * nb + 1) * CM;
            mm_nt(xacc, Nc, XTc, 32 * xtm, 32 * xtn, r32, hh);
            store_t(XTn, xacc, 32 * xtm, 32 * xtn, r32, hh, 1.f);
            if (j < 5) { const int tm = (w >> 1) & 1, tn = w & 1; f32x16 acc; ZERO16(acc);
                if (w < 4) { mm_nt(acc, Nc, NTc, 32 * tm, 32 * tn, r32, hh); store_t(NB + (2 * (nb ^ 1) + 1) * CM, acc, 32 * tm, 32 * tn, r32, hh, 1.f); }
                else       { mm_nt(acc, NTc, Nc, 32 * tm, 32 * tn, r32, hh); store_t(NB + (2 * (nb ^ 1)) * CM, acc, 32 * tm, 32 * tn, r32, hh, 1.f); } }
            LBAR();
            { LAS unsigned char* t_ = XTc; XTc = XTn; XTn = t_; } nb ^= 1;
        }
        if (!(parts & 8)) continue;
        const size_t cbase = (size_t)(bh * 128 + c) * 4096;
#pragma unroll
        for (int qq = 0; qq < 2; ++qq) {
            const int q = 2 * w + qq, pr = q >> 2, tm = (q >> 1) & 1, tn = q & 1, m0 = 32 * tm, n0 = 32 * tn; f32x16 acc;
            if (pr == 0) {
                load_t(acc, Rb, m0, n0, r32, hh, -1.f); mm_nt(acc, XTc, Prb, m0, n0, r32, hh);
#pragma unroll
                for (int g = 0; g < 4; ++g) { v2u o; o.x = pk2(-acc[4 * g], -acc[4 * g + 1]); o.y = pk2(-acc[4 * g + 2], -acc[4 * g + 3]);
                    *(v2u*)(CQp + cbase + (size_t)((((tn * 4 + 2 * tm + (g >> 1)) * 2 + (g & 1)) * 32 + r32) * 8 + hh * 4)) = o; }
            } else if (pr == 1) {
                ZERO16(acc); mm_nt(acc, XTc, BtT, m0, n0, r32, hh);
                const int k1 = n0 + r32; const float gc = gCl[k1];
#pragma unroll
                for (int g = 0; g < 4; ++g) { float e[4];
#pragma unroll
                    for (int i = 0; i < 4; ++i) { const int k2 = m0 + 8 * g + 4 * hh + i; e[i] = (k2 == k1 ? gc : 0.f) - acc[4 * g + i]; }
                    v2u o; o.x = pk2(e[0], e[1]); o.y = pk2(e[2], e[3]);
                    *(v2u*)(CGp + cbase + (size_t)((((tn * 4 + 2 * tm + (g >> 1)) * 2 + (g & 1)) * 32 + r32) * 8 + hh * 4)) = o; }
            } else if (pr == 2) {
                load_t(acc, KtT, m0, n0, r32, hh, -1.f); mm_nt(acc, XTc + 64 * CP, BtT, m0, n0, r32, hh); store_t(NB, acc, m0, n0, r32, hh, -1.f);
            } else {
                f32x16 a1; ZERO16(a1); mm_nt(a1, Kb, Rb, m0, n0, r32, hh); mask16(a1, m0, n0, r32m, hh, 2);
                ZERO16(acc); mm_nt(acc, XTc + 64 * CP, Prb, m0, n0, r32, hh);
#pragma unroll
                for (int r = 0; r < 16; ++r) acc[r] = a1[r] - acc[r];
                store_t(NB + CM, acc, m0, n0, r32, hh, 1.f);
            }
        }
        LBAR();
        {
            const int ww = w & 3, tm = ww >> 1, tn = ww & 1, m0 = 32 * tm, n0 = 32 * tn; f32x16 acc; ZERO16(acc);
            mm_nt(acc, w < 4 ? NB : NB + CM, VT, m0, n0, r32, hh);
            bf16* dst = (bf16*)(w < 4 ? CHp : CYp) + cbase + (size_t)((tm * 2 + tn) * 4 * 64 + lane) * 4;
#pragma unroll
            for (int g = 0; g < 4; ++g) { v2u o; o.x = pk2(acc[4 * g], acc[4 * g + 1]); o.y = pk2(acc[4 * g + 2], acc[4 * g + 3]); *(v2u*)(dst + g * 256) = o; }
        }
        LBAR();
    }
    }
}

__device__ __forceinline__ void rwkv_scan(Frame& F, int bh, const int mode = 7) {
    KARGS;
    const unsigned char* CG8 = WSP(unsigned char, WS_CG) + (size_t)bh * 128 * 8192; const unsigned char* CQ8 = WSP(unsigned char, WS_CQ) + (size_t)bh * 128 * 8192;
    const unsigned char* CH8 = WSP(unsigned char, WS_CH) + (size_t)bh * 128 * 8192; const unsigned char* CY8 = WSP(unsigned char, WS_CY) + (size_t)bh * 128 * 8192;
    float* Y = WSP(float, WS_RW + 7 * RW_SLOT);
    const int lane = F.lane, w = F.wave, r32 = lane & 31, hh = lane >> 5, b = bh >> 3, h = bh & 7;
    LAS unsigned char* S0 = F.lds; LAS unsigned char* S1 = F.lds + CM;
    LAS unsigned char* RING = F.lds + 2 * CM;
    LAS float* YR = (LAS float*)(F.lds + 2 * CM + 3 * 32768);
    for (int i = F.tid; i < 2 * CM / 4; i += NTHR) ((LAS unsigned*)F.lds)[i] = 0u;
    __syncthreads();
#define SC_DMA(gsrc, ldst) __builtin_amdgcn_global_load_lds((const unsigned*)(gsrc), (LAS unsigned*)(ldst), 16, 0, 0)
    auto issue = [&](const int c) {
        LAS unsigned char* slot = RING + (c % 3) * 32768; const size_t go = (size_t)c * 8192 + lane * 16;
        if (w < 4) {
#pragma unroll
            for (int q = 0; q < 2; ++q) { const int p = 2 * w + q; SC_DMA(CG8 + go + p * 1024, slot + p * 1024); SC_DMA(CH8 + go + p * 1024, slot + 8192 + p * 1024); } }
        else if (w < 6) {
#pragma unroll
            for (int q = 0; q < 4; ++q) { const int p = 4 * (w - 4) + q; SC_DMA(CQ8 + go + p * 1024, slot + 16384 + p * 1024); SC_DMA(CY8 + go + p * 1024, slot + 24576 + p * 1024); } }
    };
    issue(0); issue(1);
    if (w < 4) asm volatile("s_waitcnt vmcnt(4)" ::: "memory"); else asm volatile("s_waitcnt vmcnt(8)" ::: "memory");
    LBAR();
    if (w < 4) {
        const int tm = w >> 1, tn = w & 1, m0 = 32 * tm, n0 = 32 * tn;
#pragma unroll 1
        for (int c = 0; c < 128; ++c) {
            const LAS unsigned char* slot = RING + (c % 3) * 32768;
            const LAS unsigned char* Sc = (c & 1) ? S1 : S0; LAS unsigned char* Sn = (c & 1) ? S0 : S1;
            f32x16 acc;
#pragma unroll
            for (int g = 0; g < 4; ++g) { const v2u iw = *(const LAS v2u*)(slot + 8192 + (((tm * 2 + tn) * 4 + g) * 64 + lane) * 8);
                acc[4 * g] = bflo(iw.x); acc[4 * g + 1] = bfhi(iw.x); acc[4 * g + 2] = bflo(iw.y); acc[4 * g + 3] = bfhi(iw.y); }
#pragma unroll
            for (int s4 = 0; s4 < 4; ++s4) { const bf16x8 a = *(const LAS bf16x8*)(slot + ((tm * 8 + hh) * 32 + r32) * 16 + 1024 * s4);
                const bf16x8 bb = *(const LAS bf16x8*)(Sc + (n0 + r32) * CP + 32 * s4 + 16 * hh); acc = __builtin_amdgcn_mfma_f32_32x32x16_bf16(a, bb, acc, 0, 0, 0); }
            store_t(Sn, acc, m0, n0, r32, hh, 1.f);
            if (c + 2 < 128) { issue(c + 2); asm volatile("s_waitcnt vmcnt(4)" ::: "memory"); } else asm volatile("s_waitcnt vmcnt(0)" ::: "memory");
            LBAR();
        }
        LBAR();
    } else if (w < 6) {
        const int tmY = w - 4, m0 = 32 * tmY;
#pragma unroll 1
        for (int c = 0; c < 128; ++c) {
            const LAS unsigned char* slot = RING + (c % 3) * 32768;
            const LAS unsigned char* Sc = (c & 1) ? S1 : S0; LAS float* yo = YR + (c & 1) * 4096;
            f32x16 acc[2]; bf16x8 a[4];
#pragma unroll
            for (int s4 = 0; s4 < 4; ++s4) a[s4] = *(const LAS bf16x8*)(slot + 16384 + ((tmY * 8 + hh) * 32 + r32) * 16 + 1024 * s4);
#pragma unroll
            for (int tn = 0; tn < 2; ++tn) {
#pragma unroll
                for (int g = 0; g < 4; ++g) { const v2u iw = *(const LAS v2u*)(slot + 24576 + (((tmY * 2 + tn) * 4 + g) * 64 + lane) * 8);
                    acc[tn][4 * g] = bflo(iw.x); acc[tn][4 * g + 1] = bfhi(iw.x); acc[tn][4 * g + 2] = bflo(iw.y); acc[tn][4 * g + 3] = bfhi(iw.y); }
#pragma unroll
                for (int s4 = 0; s4 < 4; ++s4) { const bf16x8 bb = *(const LAS bf16x8*)(Sc + (32 * tn + r32) * CP + 32 * s4 + 16 * hh); acc[tn] = __builtin_amdgcn_mfma_f32_32x32x16_bf16(a[s4], bb, acc[tn], 0, 0, 0); }
#pragma unroll
                for (int r = 0; r < 16; ++r) yo[(m0 + (r & 3) + 8 * (r >> 2) + 4 * hh) * 64 + 32 * tn + r32] = acc[tn][r];
            }
            if (c + 2 < 128) { issue(c + 2); asm volatile("s_waitcnt vmcnt(8)" ::: "memory"); } else asm volatile("s_waitcnt vmcnt(0)" ::: "memory");
            LBAR();
        }
        LBAR();
    } else {
        const int row0 = 32 * (w - 6) + (lane >> 4), cq = (lane & 15) * 4;
        float* yg = Y + ((size_t)b * SEQ + row0) * 512 + h * 64 + cq;
        LBAR();
#pragma unroll 1
        for (int c = 1; c <= 128; ++c) {
            const LAS float* yi = YR + ((c - 1) & 1) * 4096 + row0 * 64 + cq;
            f32x4 ty[8];
#pragma unroll
            for (int i = 0; i < 8; ++i) ty[i] = *(const LAS f32x4*)(yi + 4 * i * 64);
            asm volatile("s_waitcnt lgkmcnt(0)" ::: "memory");
#pragma unroll
            for (int i = 0; i < 8; ++i) *(f32x4*)(yg + (size_t)((c - 1) * 64 + 4 * i) * 512) = ty[i];
            LBAR();
        }
    }
#undef SC_DMA
}

__device__ __forceinline__ void phase_odd_main(Frame& F, int layer, int ctr_base, int parts) {
    KARGS;
    const bf16* P = WSP(bf16, WS_PROJ); bf16* MIX = WSP(bf16, WS_MIX); const float* DC = WSP(float, WS_DCUM);
    const int tid = F.tid, lane = F.lane, wave = F.wave, r32 = lane & 31, hh = lane >> 5;
    const float LOG2E = 1.4426950408889634f, CS = 0.125f * LOG2E;
    const int srow = tid >> 3, sch = tid & 7;
    const int myx = (int)((unsigned)__builtin_amdgcn_s_getreg((3 << 11) | 20) & 7u);
    unsigned* sq = (unsigned*)F.ctl + CW_SCQ + (ctr_base == CW_WORK ? 0 : 2048) + layer * 8 * 64;
    if (parts & 1) {
        __syncthreads(); if (tid == 0) F.MISC[19] = atomicAdd(sq + myx * 64, 1u); __syncthreads();
        const int kc = (int)F.MISC[19]; if (kc < 2) rwkv_scan(F, myx + 8 * kc, parts >> 4 ? (parts >> 4) & 7 : 7); }
    if (0) for (int bhs = F.bid; bhs < 16; bhs += F.G) rwkv_scan(F, bhs);
    unsigned* ctr = (unsigned*)F.ctl + ctr_base + 64 * layer;
#ifdef NOSKIP_PROBE
    const float BND = 1e30f;
#else
    const float BND = 2.04f * 8.f * LOG2E * wave_max(fabsf(IN(12)[(layer >> 1) * 64 + lane])) * wave_max(fabsf(IN(13)[(layer >> 1) * 64 + lane]));
#endif
    for (;;) {
        {
            __syncthreads();
            if (tid == 0) F.MISC[16] = atomicAdd(ctr, 1u);
            __syncthreads();
            const int u = (int)F.MISC[16];
            if (u >= 512 || !(parts & 2)) break;
            const int bh = u & 15, qb = 31 - (u >> 4), b = bh >> 3, h = bh & 7;
            const bf16* base = P + (size_t)b * SEQ * ODD_N; const float* dc = DC + (size_t)bh * SEQ;
            const int q0 = 256 * qb + 32 * wave, myq = q0 + r32;
            bf16x8 qf[4];
#pragma unroll
            for (int d0 = 0; d0 < 4; ++d0) qf[d0] = *(const bf16x8*)(base + (size_t)myq * ODD_N + h * 64 + 16 * d0 + 8 * hh);
            const float dq = dc[myq] * LOG2E;
            float m = -INFINITY, lsum = 0.f;
            f32x16 o[2];
#pragma unroll
            for (int r = 0; r < 16; ++r) { o[0][r] = 0.f; o[1][r] = 0.f; }
            const int NT = 4 * qb + 4;
            if (wave < 2) { const int jt = tid; const bool nd = jt < NT && (BND + (dc[256 * qb] - dc[64 * (jt < NT ? jt : 0) + 63]) * LOG2E >= -150.f);
                const unsigned long long mk = __ballot(nd); if (lane == 0) F.MISC[17 + wave] = mk ? (unsigned)(64 * wave + (int)__builtin_ctzll(mk)) : 1000u; }
            __syncthreads();
            const int jstart = (int)(F.MISC[17] < F.MISC[18] ? F.MISC[17] : F.MISC[18]);
            const float dqw = __builtin_bit_cast(float, __builtin_amdgcn_readfirstlane(__builtin_bit_cast(int, dq)));
            v4u kreg = *(const v4u*)(base + (size_t)(64 * jstart + srow) * ODD_N + 512 + h * 64 + sch * 8);
            v4u vreg = *(const v4u*)(base + (size_t)(64 * jstart + srow) * ODD_N + 1024 + h * 64 + sch * 8);
            float dreg = tid < 64 ? -dc[64 * jstart + tid] * LOG2E : 0.f;
            *(LAS v4u*)(F.lds + srow * FX_KROW + sch * 16) = kreg; *(LAS v4u*)(F.lds + FX_KB + srow * FX_VROW + sch * 16) = vreg;
            if (tid < 64) *(LAS float*)(F.lds + FX_KB + FX_VB + tid * 4) = dreg;
            __syncthreads();
            v4u kA = kreg, vA = vreg, kB = kreg, vB = vreg; float dA = 0.f, dB = 0.f;
            if (jstart + 1 < NT) { const size_t krow = (size_t)(64 * (jstart + 1) + srow) * ODD_N;
                kA = *(const v4u*)(base + krow + 512 + h * 64 + sch * 8); vA = *(const v4u*)(base + krow + 1024 + h * 64 + sch * 8);
                if (tid < 64) dA = dc[64 * (jstart + 1) + tid]; }
            auto tile_step = [&](const int j, v4u& kx, v4u& vx, float& dx, v4u& ky, v4u& vy, float& dy) {
                const int cur = ((j - jstart) & 1) * FX_BUF, nxt = ((j - jstart + 1) & 1) * FX_BUF;
                if (j + 2 < NT) { const size_t krow = (size_t)(64 * (j + 2) + srow) * ODD_N;
                    ky = *(const v4u*)(base + krow + 512 + h * 64 + sch * 8); vy = *(const v4u*)(base + krow + 1024 + h * 64 + sch * 8);
                    if (tid < 64) dy = dc[64 * (j + 2) + tid]; }
                if (64 * j <= q0 + 31 && BND + dqw + *(const LAS float*)(F.lds + cur + FX_KB + FX_VB + 63 * 4) >= -150.f) {
                    const LAS unsigned char* Kb = F.lds + cur; const LAS unsigned char* Vb = F.lds + cur + FX_KB; const LAS float* dkb = (const LAS float*)(F.lds + cur + FX_KB + FX_VB);
                    f32x16 p0, p1;
#pragma unroll
                    for (int r = 0; r < 16; ++r) { p0[r] = 0.f; p1[r] = 0.f; }
#pragma unroll
                    for (int d0 = 0; d0 < 4; ++d0) {
                        const bf16x8 a0 = *(const LAS bf16x8*)(Kb + r32 * FX_KROW + 32 * d0 + 16 * hh);
                        const bf16x8 a1 = *(const LAS bf16x8*)(Kb + (r32 + 32) * FX_KROW + 32 * d0 + 16 * hh);
                        p0 = __builtin_amdgcn_mfma_f32_32x32x16_bf16(a0, qf[d0], p0, 0, 0, 0);
                        p1 = __builtin_amdgcn_mfma_f32_32x32x16_bf16(a1, qf[d0], p1, 0, 0, 0);
                    }
                    const bool diag = 64 * j + 63 > q0;
#pragma unroll
                    for (int g = 0; g < 4; ++g) {
                        const f32x4 dk0 = *(const LAS f32x4*)(dkb + 8 * g + 4 * hh), dk1 = *(const LAS f32x4*)(dkb + 32 + 8 * g + 4 * hh);
#pragma unroll
                        for (int i = 0; i < 4; ++i) { p0[4 * g + i] = p0[4 * g + i] * CS + dk0[i]; p1[4 * g + i] = p1[4 * g + i] * CS + dk1[i]; }
                    }
                    if (diag) {
                        asm volatile("" ::: "memory");
#pragma unroll
                        for (int r = 0; r < 16; ++r) { const int key = 64 * j + (r & 3) + 8 * (r >> 2) + 4 * hh; if (key > myq) p0[r] = -INFINITY; if (key + 32 > myq) p1[r] = -INFINITY; }
                    }
                    float tmax;
                    {
                        float ta = MAX3F(p0[0], p0[1], p1[0]), tb = MAX3F(p0[2], p0[3], p1[1]); ta = MAX3F(ta, p1[2], p1[3]);
#pragma unroll
                        for (int r = 4; r < 16; r += 4) { ta = MAX3F(ta, p0[r], p0[r + 1]); tb = MAX3F(tb, p0[r + 2], p0[r + 3]); ta = MAX3F(ta, p1[r], p1[r + 1]); tb = MAX3F(tb, p1[r + 2], p1[r + 3]); }
                        tmax = fmaxf(ta, tb); }
                    tmax = fmaxf(tmax, __shfl_xor(tmax, 32));
                    const float mn = fmaxf(m, tmax); const float corr = __builtin_amdgcn_exp2f(m - mn); m = mn;
                    float ps = 0.f;
#pragma unroll
                    for (int r = 0; r < 16; ++r) { p0[r] = __builtin_amdgcn_exp2f(p0[r] - mn); p1[r] = __builtin_amdgcn_exp2f(p1[r] - mn); ps += p0[r] + p1[r]; }
                    lsum = lsum * corr + ps;
                    if (__any(corr != 1.f)) {
                        asm volatile("" ::: "memory");
#pragma unroll
                        for (int r = 0; r < 16; ++r) { o[0][r] *= corr; o[1][r] *= corr; } }
                    bf16x8 pf[4];
#pragma unroll
                    for (int s4 = 0; s4 < 4; ++s4) {
                        v4u w;
                        if (s4 < 2) { w.x = pk2(p0[8 * s4 + 0], p0[8 * s4 + 1]); w.y = pk2(p0[8 * s4 + 2], p0[8 * s4 + 3]); w.z = pk2(p0[8 * s4 + 4], p0[8 * s4 + 5]); w.w = pk2(p0[8 * s4 + 6], p0[8 * s4 + 7]); }
                        else { const int sp = s4 - 2; w.x = pk2(p1[8 * sp + 0], p1[8 * sp + 1]); w.y = pk2(p1[8 * sp + 2], p1[8 * sp + 3]); w.z = pk2(p1[8 * sp + 4], p1[8 * sp + 5]); w.w = pk2(p1[8 * sp + 6], p1[8 * sp + 7]); }
                        pf[s4] = __builtin_bit_cast(bf16x8, w);
                    }
                    const int gi = lane >> 4, li = lane & 15;
                    const LAS unsigned char* vbase = Vb + (4 * (gi >> 1) + (li >> 2)) * FX_VROW + (16 * (gi & 1) + 4 * (li & 3)) * 2;
#pragma unroll
                    for (int d0 = 0; d0 < 2; ++d0)
#pragma unroll
                        for (int s4 = 0; s4 < 4; ++s4) {
                            const s16x4 lo = __builtin_bit_cast(s16x4, __builtin_amdgcn_ds_read_tr16_b64_v4i16((LAS s16x4*)(vbase + (16 * s4) * FX_VROW + 64 * d0)));
                            const s16x4 hi = __builtin_bit_cast(s16x4, __builtin_amdgcn_ds_read_tr16_b64_v4i16((LAS s16x4*)(vbase + (16 * s4 + 8) * FX_VROW + 64 * d0)));
                            const bf16x8 vf = (bf16x8){lo[0], lo[1], lo[2], lo[3], hi[0], hi[1], hi[2], hi[3]};
                            o[d0] = __builtin_amdgcn_mfma_f32_32x32x16_bf16(vf, pf[s4], o[d0], 0, 0, 0);
                        }
                }
                if (j + 1 < NT) {
                    *(LAS v4u*)(F.lds + nxt + srow * FX_KROW + sch * 16) = kx; *(LAS v4u*)(F.lds + nxt + FX_KB + srow * FX_VROW + sch * 16) = vx;
                    if (tid < 64) *(LAS float*)(F.lds + nxt + FX_KB + FX_VB + tid * 4) = -dx * LOG2E;
                }
                LBAR();
            };
            for (int j = jstart; j < NT; j += 2) {
                tile_step(j, kA, vA, dA, kB, vB, dB);
                if (j + 1 < NT) tile_step(j + 1, kB, vB, dB, kA, vA, dA);
            }
            const float l = lsum + __shfl_xor(lsum, 32); const float inv = 1.f / l;
            const bf16* gp = base + (size_t)myq * ODD_N + 1536 + h * 64; bf16* op = MIX + ((size_t)b * SEQ + myq) * D + h * 64;
#pragma unroll
            for (int d0 = 0; d0 < 2; ++d0)
#pragma unroll
                for (int g = 0; g < 4; ++g) { const int db = 32 * d0 + 8 * g + 4 * hh; const v2u gw = *(const v2u*)(gp + db);
                    const float g0 = sigmoidf_(bflo(gw.x)), g1 = sigmoidf_(bfhi(gw.x)), g2 = sigmoidf_(bflo(gw.y)), g3 = sigmoidf_(bfhi(gw.y));
                    v2u ow; ow.x = pk2(o[d0][4 * g + 0] * inv * g0, o[d0][4 * g + 1] * inv * g1); ow.y = pk2(o[d0][4 * g + 2] * inv * g2, o[d0][4 * g + 3] * inv * g3);
                    *(v2u*)(op + db) = ow; }
        }
    }
    if (parts & 1) for (int dx = 0; dx < 8; ++dx) { const int xs = (myx + dx) & 7;
        for (;;) { __syncthreads(); if (tid == 0) F.MISC[19] = atomicAdd(sq + xs * 64, 1u); __syncthreads(); const int kc = (int)F.MISC[19]; if (kc >= 2) break; rwkv_scan(F, xs + 8 * kc); } }
}

__device__ __forceinline__ void phase_rwkv_post(Frame& F, int layer) {
    KARGS;
    const int jj = layer >> 1, ch = F.tid;
    const float* R = WSP(float, WS_RW); const float* K = WSP(float, WS_RW + 2 * RW_SLOT); const float* V = WSP(float, WS_RW + 3 * RW_SLOT);
    const float* Gt = WSP(float, WS_RW + 6 * RW_SLOT); const float* Y = WSP(float, WS_RW + 7 * RW_SLOT);
    bf16* MIX = WSP(bf16, WS_MIX);
    const float lw = IN(24)[jj * 512 + ch], lb = IN(25)[jj * 512 + ch], rk = IN(23)[jj * 512 + ch];
#pragma unroll 4
    for (int tg = F.bid; tg < T; tg += F.G) {
        const size_t o = (size_t)tg * 512 + ch;
        const float y = Y[o]; const float mu = wave_sum(y) * (1.f / 64.f); const float dlt = y - mu; const float var = wave_sum(dlt * dlt) * (1.f / 64.f);
        const float yn = dlt * rsqrtf(var + GN_EPS) * lw + lb;
        const float v = V[o]; const float bonus = wave_sum(R[o] * K[o] * rk) * v;
        MIX[(size_t)tg * D + 512 + ch] = (bf16)f2bf((yn + bonus) * Gt[o]);
    }
}

__device__ __forceinline__ void sort16_desc(float (&v)[16]) {
#pragma unroll
    for (int k = 2; k <= 16; k <<= 1)
#pragma unroll
        for (int j = k >> 1; j > 0; j >>= 1)
#pragma unroll
            for (int i = 0; i < 16; ++i) { const int l = i ^ j; if (l > i) { const float a_ = v[i], b_ = v[l]; const float mx = fmaxf(a_, b_), mn = fminf(a_, b_);
                if ((i & k) == 0) { v[i] = mx; v[l] = mn; } else { v[i] = mn; v[l] = mx; } } }
}
__device__ __forceinline__ void merge16_desc(float (&A)[16], const float (&B)[16]) {
#pragma unroll
    for (int i = 0; i < 16; ++i) A[i] = fmaxf(A[i], B[15 - i]);
#pragma unroll
    for (int j = 8; j > 0; j >>= 1)
#pragma unroll
        for (int i = 0; i < 16; ++i) { const int l = i ^ j; if (l > i) { const float a_ = A[i], b_ = A[l]; A[i] = fmaxf(a_, b_); A[l] = fminf(a_, b_); } }
}
__device__ __forceinline__ float pack_low(float v, unsigned bits, unsigned mask) { return __builtin_bit_cast(float, (__builtin_bit_cast(unsigned, v) & ~mask) | bits); }
template <bool OWN> __device__ __forceinline__ void phase_peer_topk(Frame& F, int layer, const pg8::StaticOrder S) {
    KARGS;
    const bf16* Q = WSP(bf16, WS_Q); const bf16* KEYS = WSP(bf16, WS_KEYS) + (size_t)layer * 2 * 16384;
    int* IDX = WSP(int, WS_IDX); float* GATE = WSP(float, WS_GATE);
    constexpr int SCP = 132;
    LAS float* sc = (LAS float*)(F.lds + F.wave * (32 * SCP * 4));
    LAS unsigned* li = (LAS unsigned*)sc;
    const int lane = F.lane, fr = lane & 15, fq = lane >> 4, tok = lane & 31, hp = lane >> 5;
    const int gw = F.bid * NWAVES + F.wave, NGW = F.G * NWAVES;
    pg8::Unit un{0, 0};
    const bool cv = OWN && layer < 3;
    const int NRW = (2 * NEXP + NGW - 1) / NGW;
    int cr = 0;
    f32x4 cvv[2][4];
    for (int it = OWN ? 0 : gw; OWN ? S.next(it, un) : (it < (T / 32) * 8); it += OWN ? 1 : NGW) {
        const int tile = OWN ? un.pm * 8 + F.wave : (it >> 3), h = OWN ? un.pn : (it & 7), t0 = tile * 32;
        float v1[16], v2[16];
#pragma unroll
        for (int half = 0; half < 2; ++half) {
            f32x4 acc[2][8];
#pragma unroll
            for (int rt = 0; rt < 2; ++rt)
#pragma unroll
                for (int ct = 0; ct < 8; ++ct) acc[rt][ct] = (f32x4){0.f, 0.f, 0.f, 0.f};
            const bf16* kb = KEYS + (size_t)half * 16384;
#pragma unroll 1
            for (int ks = 0; ks < 4; ++ks) {
                bf16x8 a[2];
#pragma unroll
                for (int rt = 0; rt < 2; ++rt) a[rt] = *(const bf16x8*)(Q + (size_t)(t0 + rt * 16 + fr) * 2048 + h * 256 + half * 128 + ks * 32 + 8 * fq);
#pragma unroll
                for (int ct = 0; ct < 8; ++ct) { const bf16x8 bb = *(const bf16x8*)(kb + (size_t)(ct * 16 + fr) * 128 + ks * 32 + 8 * fq);
#pragma unroll
                    for (int rt = 0; rt < 2; ++rt) acc[rt][ct] = __builtin_amdgcn_mfma_f32_16x16x32_bf16(a[rt], bb, acc[rt][ct], 0, 0, 0); }
            }
            if (cv && cr < NRW) conv_issue<2>(IN(29), IN(30), layer + 1, gw + cr * NGW, NGW, lane, cvv);
#pragma unroll
            for (int rt = 0; rt < 2; ++rt)
#pragma unroll
                for (int ct = 0; ct < 8; ++ct)
#pragma unroll
                    for (int r = 0; r < 4; ++r) sc[(rt * 16 + 4 * fq + r) * SCP + ct * 16 + fr] = pack_low(acc[rt][ct][r], (unsigned)(ct * 16 + fr), 0x7Fu);
            LDS_WAIT(); asm volatile("" ::: "memory");
            float top[16];
            const LAS float* row = sc + tok * SCP + 64 * hp;
#pragma unroll 1
            for (int g = 0; g < 4; ++g) {
                float grp[16];
#pragma unroll
                for (int q4 = 0; q4 < 4; ++q4) { const f32x4 x = *(const LAS f32x4*)(row + 16 * g + 4 * q4); grp[4 * q4] = x.x; grp[4 * q4 + 1] = x.y; grp[4 * q4 + 2] = x.z; grp[4 * q4 + 3] = x.w; }
                sort16_desc(grp);
                if (g == 0) {
#pragma unroll
                    for (int p = 0; p < 16; ++p) top[p] = grp[p]; }
                else merge16_desc(top, grp);
            }
            { float oth[16];
#pragma unroll
              for (int p = 0; p < 16; ++p) oth[p] = __shfl_xor(top[p], 32);
              merge16_desc(top, oth); }
            LDS_WAIT(); asm volatile("" ::: "memory");
#pragma unroll
            for (int p = 0; p < 16; ++p) { if (half == 0) v1[p] = top[p]; else v2[p] = top[p]; }
            if (cv && cr < NRW) { conv_finish<2>(WSP(unsigned char, WS_PU), WSP(unsigned char, WS_PV), WSP(float, WS_PS), layer + 1, gw + cr * NGW, NGW, lane, cvv, F.lds + 135168 + F.wave * 1024); cr += 2; }
        }
        if (hp == 0) {
#pragma unroll
            for (int p = 0; p < 16; ++p) { li[tok * 33 + p] = __builtin_bit_cast(unsigned, v1[p]) & 0x7Fu; li[tok * 33 + 16 + p] = __builtin_bit_cast(unsigned, v2[p]) & 0x7Fu; } }
        if (cv && cr < NRW) conv_issue<2>(IN(29), IN(30), layer + 1, gw + cr * NGW, NGW, lane, cvv);
        float ts[16];
        {
            float c0[16], c1[16];
            int n = 0;
#pragma unroll
            for (int a_ = 0; a_ < 16; ++a_)
#pragma unroll
                for (int b_ = 0; b_ < 16; ++b_) if ((a_ + 1) * (b_ + 1) <= 16) {
                    const float x = pack_low(v1[a_] + v2[b_], (unsigned)(a_ * 16 + b_), 0xFFu);
                    const int slot = n >> 1; const bool mine = (n & 1) == hp;
                    if (slot < 16) { if ((n & 1) == 0) c0[slot] = mine ? x : -INFINITY; else c0[slot] = mine ? x : c0[slot]; }
                    else { if ((n & 1) == 0) c1[slot - 16] = mine ? x : -INFINITY; else c1[slot - 16] = mine ? x : c1[slot - 16]; }
                    ++n; }
#pragma unroll
            for (int sl = 9; sl < 16; ++sl) c1[sl] = -INFINITY;
            sort16_desc(c0); sort16_desc(c1); merge16_desc(c0, c1);
            float oth[16];
#pragma unroll
            for (int p = 0; p < 16; ++p) oth[p] = __shfl_xor(c0[p], 32);
            merge16_desc(c0, oth);
#pragma unroll
            for (int p = 0; p < 16; ++p) ts[p] = c0[p];
        }
        LDS_WAIT(); asm volatile("" ::: "memory");
        if (cv && cr < NRW) { conv_finish<2>(WSP(unsigned char, WS_PU), WSP(unsigned char, WS_PV), WSP(float, WS_PS), layer + 1, gw + cr * NGW, NGW, lane, cvv, F.lds + 135168 + F.wave * 1024); cr += 2; }
        if (hp == 0) {
            float e[16], sum = 0.f;
#pragma unroll
            for (int p = 0; p < 16; ++p) { e[p] = expf(ts[p] - ts[0]); sum += e[p]; }
            const float inv = 1.f / sum;
            int* ip = IDX + (size_t)(t0 + tok) * 128 + h * 16; float* gp = GATE + (size_t)(t0 + tok) * 128 + h * 16;
#pragma unroll
            for (int p = 0; p < 16; ++p) { const unsigned ab = __builtin_bit_cast(unsigned, ts[p]) & 0xFFu;
                ip[p] = (int)(li[tok * 33 + (ab >> 4)] * 128u + li[tok * 33 + 16 + (ab & 15u)]); gp[p] = e[p] * inv; }
        }
        LDS_WAIT(); asm volatile("" ::: "memory");
    }
    while (cv && cr < NRW) { f32x4 v4[4][4];
        conv_issue<4>(IN(29), IN(30), layer + 1, gw + cr * NGW, NGW, lane, v4);
        conv_finish<4>(WSP(unsigned char, WS_PU), WSP(unsigned char, WS_PV), WSP(float, WS_PS), layer + 1, gw + cr * NGW, NGW, lane, v4, F.lds + 135168 + F.wave * 1024); cr += 4; }
}

typedef float f32x2 __attribute__((ext_vector_type(2)));
__device__ __forceinline__ void unpack16_fp8(float (&o)[16], const v4u w) {
#pragma unroll
    for (int j = 0; j < 4; ++j) { const f32x2 a = __builtin_amdgcn_cvt_pk_f32_fp8((int)w[j], false), b = __builtin_amdgcn_cvt_pk_f32_fp8((int)w[j], true); o[4 * j] = a.x; o[4 * j + 1] = a.y; o[4 * j + 2] = b.x; o[4 * j + 3] = b.y; }
}
__device__ __forceinline__ void gu_token(const unsigned char* U, const float* SU, const float* SV, const bf16* H, const int* IDX, const float* GATE, float* ACT, int s, int tg, int lane) {
    float x[16];
    { const v4u w0 = *(const v4u*)(H + (size_t)tg * D + 16 * lane), w1 = *(const v4u*)(H + (size_t)tg * D + 16 * lane + 8);
      x[0] = bflo(w0.x); x[1] = bfhi(w0.x); x[2] = bflo(w0.y); x[3] = bfhi(w0.y); x[4] = bflo(w0.z); x[5] = bfhi(w0.z); x[6] = bflo(w0.w); x[7] = bfhi(w0.w);
      x[8] = bflo(w1.x); x[9] = bfhi(w1.x); x[10] = bflo(w1.y); x[11] = bfhi(w1.y); x[12] = bflo(w1.z); x[13] = bfhi(w1.z); x[14] = bflo(w1.w); x[15] = bfhi(w1.w); }
#pragma unroll
    for (int half = 0; half < 2; ++half) {
        const int id = IDX[(size_t)tg * 128 + 64 * half + lane];
        const bool sel = (id >> 11) == s;
        unsigned long long m = __ballot(sel);
        const float su = sel ? SU[id] : 0.f, cf = sel ? GATE[(size_t)tg * 128 + 64 * half + lane] * SV[id] : 0.f;
        int actb = 0;
        while (m) {
            int pos[8]; v4u ua[8]; float d[8];
#pragma unroll
            for (int q = 0; q < 8; ++q) { pos[q] = m ? (int)__builtin_ctzll(m) : -1; m = m ? (m & (m - 1)) : m;
                const int idx = pos[q] >= 0 ? __builtin_amdgcn_readlane(id, pos[q]) : (s << 11);
                ua[q] = *(const v4u*)(U + (size_t)idx * 1024 + 16 * lane); }
#pragma unroll
            for (int q = 0; q < 8; ++q) { float u[16]; unpack16_fp8(u, ua[q]); float sm = 0.f;
#pragma unroll
                for (int i = 0; i < 16; ++i) sm += u[i] * x[i];
                d[q] = sm; }
#pragma unroll
            for (int o = 1; o < 64; o <<= 1) {
#pragma unroll
                for (int q = 0; q < 8; ++q) d[q] += __shfl_xor(d[q], o); }
#pragma unroll
            for (int q = 0; q < 8; ++q) if (pos[q] >= 0) { const float val = gelu_erf(d[q] * rl(su, pos[q])) * rl(cf, pos[q]);
                actb = lane == pos[q] ? __builtin_bit_cast(int, val) : actb; }
        }
        if (sel) ACT[(size_t)tg * 128 + 64 * half + lane] = __builtin_bit_cast(float, actb);
    }
}

__device__ __forceinline__ void phase_peer_gu_valu(Frame& F, int layer) {
    KARGS;
    const bf16* H = WSP(bf16, WS_H); const int* IDX = WSP(int, WS_IDX); const float* GATE = WSP(float, WS_GATE); float* ACT = WSP(float, WS_ACT);
    const unsigned char* U = WSP(unsigned char, WS_PU) + (size_t)layer * NEXP * 1024;
    const float* SU = WSP(float, WS_PS) + (size_t)layer * NEXP; const float* SV = SU + 4 * NEXP;
    const int lane = F.lane;
    unsigned* heads = (unsigned*)F.ctl + CW_G1 + layer * 8 * 64;
    const int myx = (int)((unsigned)__builtin_amdgcn_s_getreg((3 << 11) | 20) & 7u);
    for (int k = 0; k < 8; ++k) { const int s = (myx + k) & 7;
        for (;;) { unsigned u = 0; if (lane == 0) u = atomicAdd(heads + s * 64, 1u); u = (unsigned)__builtin_amdgcn_readfirstlane((int)u);
            if (u >= (unsigned)(T / 8)) break;
#pragma unroll 1
            for (int i = 0; i < 8; ++i) gu_token(U, SU, SV, H, IDX, GATE, ACT, s, (int)u * 8 + i, lane); } }
}
__device__ __forceinline__ void phase_peer_gu(Frame& F, int layer) {
    KARGS;
    const int* IDX = WSP(int, WS_IDX); const float* GATE = WSP(float, WS_GATE); float* ACT = WSP(float, WS_ACT);
    const unsigned char* U = WSP(unsigned char, WS_PU) + (size_t)layer * NEXP * 512; const unsigned char* SC6 = WSP(unsigned char, WS_PU) + (size_t)48 * MiB + (size_t)layer * NEXP * 32;
    const unsigned char* H8 = WSP(unsigned char, WS_H8); const float* HS = WSP(float, WS_HS);
    const float* SU = WSP(float, WS_PS) + (size_t)layer * NEXP; const float* SV = SU + 4 * NEXP;
    const int lane = F.lane, row = lane & 15, kc = lane >> 4;
    LAS int* lst = (LAS int*)(F.lds + F.wave * 18432);
    LAS unsigned char* xl = F.lds + F.wave * 18432 + 8192;
    LAS float* cpatch = (LAS float*)(F.lds + F.wave * 18432 + 8192 + 8320);
    unsigned* heads = (unsigned*)F.ctl + CW_G1 + layer * 8 * 64;
    const int myx = (int)((unsigned)__builtin_amdgcn_s_getreg((3 << 11) | 20) & 7u);
    struct TSet { v4u ua[8]; v2u sc; int e, meta; float su, sv, gt, xs; bool valid; };
    for (int k = 0; k < 4; ++k) {
        const int s = (myx + k) & 3;
        for (;;) {
            unsigned u = 0; if (lane == 0) u = atomicAdd(heads + s * 64, 1u); u = (unsigned)__builtin_amdgcn_readfirstlane((int)u);
            if (u >= (unsigned)(T / 8)) break;
            const int tg0 = (int)u * 8;
            int total = 0;
            int ida[8], idb[8]; v4u hx[8];
#pragma unroll
            for (int i = 0; i < 8; ++i) { ida[i] = IDX[(size_t)(tg0 + i) * 128 + lane]; idb[i] = IDX[(size_t)(tg0 + i) * 128 + 64 + lane]; hx[i] = *(const v4u*)(H8 + (size_t)(tg0 + i) * D + 16 * lane); }
#pragma unroll
            for (int i = 0; i < 8; ++i) {
                const int id0 = ida[i], id1 = idb[i];
                *(LAS v4u*)(xl + i * 1040 + 16 * lane) = hx[i];
                const bool sel0 = (id0 >> 12) == s, sel1 = (id1 >> 12) == s;
                const unsigned long long m0 = __ballot(sel0), m1 = __ballot(sel1);
                const int n0 = __builtin_popcountll(m0), cnt = n0 + __builtin_popcountll(m1);
                const int r0 = total + (int)__builtin_amdgcn_mbcnt_hi((unsigned)(m0 >> 32), __builtin_amdgcn_mbcnt_lo((unsigned)m0, 0u));
                const int r1 = total + n0 + (int)__builtin_amdgcn_mbcnt_hi((unsigned)(m1 >> 32), __builtin_amdgcn_mbcnt_lo((unsigned)m1, 0u));
                if (sel0) { lst[r0] = id0; lst[1024 + r0] = i * 128 + lane; }
                if (sel1) { lst[r1] = id1; lst[1024 + r1] = i * 128 + 64 + lane; }
                total += cnt; }
            LDS_WAIT(); asm volatile("" ::: "memory");
            const int ntile = (total + 15) >> 4;
            auto load_tile = [&](TSet& S, const int t) { if (t < ntile) {
                const int rr = 16 * t + row; S.valid = rr < total;
                const int ri = S.valid ? rr : 16 * t;
                S.e = lst[ri]; S.meta = lst[1024 + ri];
                const int rq = 16 * t + (lane >> 2); const int eq = lst[rq < total ? rq : 16 * t];
                const unsigned char* up = U + (size_t)eq * 512 + 16 * (lane & 3);
#pragma unroll
                for (int j = 0; j < 8; ++j) S.ua[j] = *(const v4u*)(up + 64 * j);
                S.sc = *(const v2u*)(SC6 + (size_t)eq * 32 + 8 * (lane & 3));
                S.su = 0.f; S.sv = 0.f; S.gt = 0.f; S.xs = 0.f;
                if (kc == 0) { S.su = 1.f; S.sv = SV[S.e]; S.gt = GATE[(size_t)(tg0 + (S.meta >> 7)) * 128 + (S.meta & 127)]; S.xs = HS[tg0 + (S.meta >> 7)]; } } };
            const LAS unsigned char* xp = xl + (row & 7) * 1040 + 16 * kc;
            auto compute_tile = [&](TSet& S, const int t) { if (t < ntile) {
                f32x4 acc0 = (f32x4){0.f, 0.f, 0.f, 0.f}, acc1 = acc0;
                { const int psrc = 4 * (4 * (lane & 15) + (lane >> 4));
#pragma unroll
                  for (int j = 0; j < 8; ++j)
#pragma unroll
                      for (int c = 0; c < 4; ++c) S.ua[j][c] = (unsigned)__builtin_amdgcn_ds_bpermute(psrc, (int)S.ua[j][c]);
                  S.sc.x = (unsigned)__builtin_amdgcn_ds_bpermute(psrc, (int)S.sc.x); S.sc.y = (unsigned)__builtin_amdgcn_ds_bpermute(psrc, (int)S.sc.y); }
#define GU_MM(m, ACC) { const v4u xb0 = *(const LAS v4u*)(xp + 128 * (m)), xb1 = *(const LAS v4u*)(xp + 128 * (m) + 64); v8i av; \
                    _Pragma("unroll") for (int d = 0; d < 8; ++d) { av[d] = d < 4 ? (int)S.ua[(m)][d & 3] : 0; } \
                    const v8i bv = (v8i){(int)xb0.x, (int)xb0.y, (int)xb0.z, (int)xb0.w, (int)xb1.x, (int)xb1.y, (int)xb1.z, (int)xb1.w}; \
                    ACC = __builtin_amdgcn_mfma_scale_f32_16x16x128_f8f6f4(av, bv, ACC, 4, 0, (m) & 3, (int)S.sc[(m) >> 2], 0, 0x7F7F7F7F); }
                GU_MM(0, acc0) GU_MM(1, acc1) GU_MM(2, acc0) GU_MM(3, acc1) GU_MM(4, acc0) GU_MM(5, acc1) GU_MM(6, acc0) GU_MM(7, acc1)
#undef GU_MM
                acc0 += acc1;
#pragma unroll
                for (int q = 0; q < 4; ++q) cpatch[(4 * kc + q) * 17 + row] = acc0[q];
                LDS_WAIT(); asm volatile("" ::: "memory");
                const float d = cpatch[row * 17 + (S.meta >> 7)];
                if (S.valid && kc == 0) { const int tg = tg0 + (S.meta >> 7); const float av = gelu_erf(d * S.su * S.xs) * S.gt * S.sv;
                    const unsigned sl = (unsigned)(S.meta & 127);
                    const unsigned ab = __builtin_bit_cast(unsigned, av), eo = (unsigned)S.e << 3, mag = ab & 0x7FFFFFFFu;
                    const unsigned tq = mag > eo ? (mag - eo + 0x10000u) & 0xFFFE0000u : 0u;
                    ((unsigned*)ACT)[(((size_t)(tg >> 6) * 32 + (sl >> 2)) * 64 + (tg & 63)) * 4 + (sl & 3)] = (ab & 0x80000000u) | tq | eo; }
                LDS_WAIT(); asm volatile("" ::: "memory"); } };
            TSet A_, B_;
            load_tile(A_, 0);
#pragma unroll 1
            for (int t = 0; t < ntile; t += 2) { load_tile(B_, t + 1); compute_tile(A_, t); load_tile(A_, t + 2); compute_tile(B_, t + 1); }
            LDS_WAIT(); asm volatile("" ::: "memory");
        }
    }
}
__device__ __forceinline__ void gv_token(const unsigned char* Vc, const int* IDX, const float* ACT, const float* g2, float* X, int c, int tg, int lane) {
    const int g = lane >> 3, cl = lane & 7, b = tg >= SEQ ? 1 : 0;
    int iv[16]; float cv[16];
#pragma unroll
    for (int j = 0; j < 4; ++j) { const v4u a = *(const v4u*)(IDX + (size_t)tg * 128 + 16 * g + 4 * j); const f32x4 f = *(const f32x4*)(ACT + (size_t)tg * 128 + 16 * g + 4 * j);
        iv[4 * j] = (int)a.x; iv[4 * j + 1] = (int)a.y; iv[4 * j + 2] = (int)a.z; iv[4 * j + 3] = (int)a.w; cv[4 * j] = f.x; cv[4 * j + 1] = f.y; cv[4 * j + 2] = f.z; cv[4 * j + 3] = f.w; }
    float acc[16];
#pragma unroll
    for (int i = 0; i < 16; ++i) acc[i] = 0.f;
#pragma unroll
    for (int k0 = 0; k0 < 16; k0 += 8) {
        v4u seg[8];
#pragma unroll
        for (int k = 0; k < 8; ++k) seg[k] = *(const v4u*)(Vc + ((size_t)c * NEXP + iv[k0 + k]) * 128 + 16 * cl);
#pragma unroll
        for (int k = 0; k < 8; ++k) { float v[16]; unpack16_fp8(v, seg[k]);
#pragma unroll
            for (int i = 0; i < 16; ++i) acc[i] += v[i] * cv[k0 + k]; }
    }
#pragma unroll
    for (int o = 8; o < 64; o <<= 1) {
#pragma unroll
        for (int i = 0; i < 16; ++i) acc[i] += __shfl_xor(acc[i], o); }
    if (lane < 8) { float* xr = X + (size_t)tg * D + 128 * c + 16 * cl; const float* gg = g2 + b * 6144 + 128 * c + 16 * cl;
#pragma unroll
        for (int j = 0; j < 4; ++j) { const f32x4 g4 = *(const f32x4*)(gg + 4 * j); *(f32x4*)(xr + 4 * j) = *(const f32x4*)(xr + 4 * j) + g4 * (f32x4){acc[4 * j], acc[4 * j + 1], acc[4 * j + 2], acc[4 * j + 3]}; } }
}

__device__ __forceinline__ void phase_peer_gv_old(Frame& F, int layer) {
    KARGS;
    const int* IDX = WSP(int, WS_IDX); const float* ACT = WSP(float, WS_ACT);
    const unsigned char* Vc = WSP(unsigned char, WS_PV) + (size_t)layer * NEXP * 1024;
    const float* g2 = WSP(float, WS_MOD) + (size_t)layer * 2 * 6144 + 5120;
    float* X = OUTP; const int lane = F.lane;
    unsigned* heads = (unsigned*)F.ctl + CW_G2 + layer * 8 * 64;
    const int myx = (int)((unsigned)__builtin_amdgcn_s_getreg((3 << 11) | 20) & 7u);
    for (int k = 0; k < 8; ++k) { const int c = (myx + k) & 7;
        for (;;) { unsigned u = 0; if (lane == 0) u = atomicAdd(heads + c * 64, 1u); u = (unsigned)__builtin_amdgcn_readfirstlane((int)u);
            if (u >= (unsigned)(T / 8)) break;
#pragma unroll 1
            for (int i = 0; i < 8; ++i) gv_token(Vc, IDX, ACT, g2, X, c, (int)u * 8 + i, lane); } }
}
__device__ __forceinline__ void phase_peer_gv_l2(Frame& F, int layer) {
    KARGS;
    const int* IDX = WSP(int, WS_IDX); const float* ACT = WSP(float, WS_ACT);
    const unsigned char* Vc = WSP(unsigned char, WS_PV) + (size_t)layer * NEXP * 1024;
    const float* g2 = WSP(float, WS_MOD) + (size_t)layer * 2 * 6144 + 5120;
    float* X = OUTP;
    const int lane = F.lane, g = lane >> 3, cl = lane & 7;
    LAS unsigned* li_ = (LAS unsigned*)(F.lds + 8192 + F.wave * 8192);
    LAS float* la_ = (LAS float*)(F.lds + 8192 + F.wave * 8192 + 4096);
    unsigned* heads = (unsigned*)F.ctl + CW_G2 + layer * 8 * 64;
    const int myx = (int)((unsigned)__builtin_amdgcn_s_getreg((3 << 11) | 20) & 7u);
    for (int k = 0; k < 8; ++k) {
        const int c = (myx + k) & 7;
        for (;;) {
            unsigned u = 0; if (lane == 0) u = atomicAdd(heads + c * 64, 1u); u = (unsigned)__builtin_amdgcn_readfirstlane((int)u);
            if (u >= (unsigned)(T / 8)) break;
            const int tg = (int)u * 8 + g, b = tg >= SEQ ? 1 : 0;
#pragma unroll
            for (int j = 0; j < 4; ++j) { const v4u a = *(const v4u*)(IDX + (size_t)tg * 128 + 16 * cl + 4 * j); const f32x4 f = *(const f32x4*)(ACT + (size_t)tg * 128 + 16 * cl + 4 * j);
                *(LAS v4u*)(li_ + g * 128 + 16 * cl + 4 * j) = a; *(LAS f32x4*)(la_ + g * 128 + 16 * cl + 4 * j) = f; }
            LDS_WAIT(); asm volatile("" ::: "memory");
            f32x2 acc[8];
#pragma unroll
            for (int q = 0; q < 8; ++q) acc[q] = (f32x2){0.f, 0.f};
#pragma unroll 1
            for (int k0 = 0; k0 < 128; k0 += 16) {
                unsigned ei[16]; float ec[16]; v4u seg[16];
#pragma unroll
                for (int q4 = 0; q4 < 4; ++q4) { const v4u a = *(const LAS v4u*)(li_ + g * 128 + k0 + 4 * q4); const f32x4 f = *(const LAS f32x4*)(la_ + g * 128 + k0 + 4 * q4);
                    ei[4 * q4] = a.x; ei[4 * q4 + 1] = a.y; ei[4 * q4 + 2] = a.z; ei[4 * q4 + 3] = a.w; ec[4 * q4] = f.x; ec[4 * q4 + 1] = f.y; ec[4 * q4 + 2] = f.z; ec[4 * q4 + 3] = f.w; }
#pragma unroll
                for (int kk = 0; kk < 16; ++kk) seg[kk] = *(const v4u*)(Vc + ((size_t)c * NEXP + ei[kk]) * 128 + 16 * cl);
#pragma unroll
                for (int kk = 0; kk < 16; ++kk) { const float cf = ec[kk]; const f32x2 cf2 = (f32x2){cf, cf};
#pragma unroll
                    for (int j = 0; j < 4; ++j) { acc[2 * j] += __builtin_amdgcn_cvt_pk_f32_fp8((int)seg[kk][j], false) * cf2; acc[2 * j + 1] += __builtin_amdgcn_cvt_pk_f32_fp8((int)seg[kk][j], true) * cf2; } }
            }
            float* xr = X + (size_t)tg * D + 128 * c + 16 * cl; const float* gg = g2 + b * 6144 + 128 * c + 16 * cl;
#pragma unroll
            for (int j = 0; j < 4; ++j) { const f32x4 g4 = *(const f32x4*)(gg + 4 * j);
                *(f32x4*)(xr + 4 * j) = *(const f32x4*)(xr + 4 * j) + g4 * (f32x4){acc[2 * j].x, acc[2 * j].y, acc[2 * j + 1].x, acc[2 * j + 1].y}; }
            LDS_WAIT(); asm volatile("" ::: "memory");
        }
    }
}

__device__ __forceinline__ void phase_peer_gv(Frame& F, int layer) {
    KARGS;
    const unsigned* ACTP = WSP(unsigned, WS_ACT);
    const unsigned char* PV8 = WSP(unsigned char, WS_PV) + (size_t)layer * NEXP * 1024;
    const float* g2 = WSP(float, WS_MOD) + (size_t)layer * 2 * 6144 + 5120;
    float* X = OUTP;
    const int lane = F.lane, tid = F.tid;
    for (int u = F.bid; u < 256; u += F.G) {
        const int xq = u >> 3, c = 4 * (4 * (u & 7) + (xq >> 3)) + (xq & 3), hf = (xq >> 2) & 1;
        if (u != F.bid) __syncthreads();
        {   const v4u* src = (const v4u*)(PV8 + (size_t)c * NEXP * 8);
            v4u t[16];
#pragma unroll
            for (int i = 0; i < 16; ++i) t[i] = src[i * NTHR + tid];
#pragma unroll
            for (int i = 0; i < 16; ++i) *(LAS v4u*)(F.lds + (size_t)(i * NTHR + tid) * 16) = t[i]; }
        __syncthreads();
        const float* gg = g2 + hf * 6144 + 8 * c;
        const f32x4 ga = *(const f32x4*)gg, gb = *(const f32x4*)(gg + 4);
        const unsigned lbase = (unsigned)(size_t)F.lds; __builtin_assume(lbase == 0u);
        constexpr int NBLK = 128 / NWAVES;
        auto wptr = [&](int i, int j) { return (const v4u*)(ACTP + (((size_t)(hf * 128 + F.wave + NWAVES * i) * 32 + j * 4) * 64 + lane) * 4); };
        v4u w[4][4];
#pragma unroll
        for (int jj = 0; jj < 4; ++jj) { const v4u* wp = wptr(0, jj);
#pragma unroll
            for (int g = 0; g < 4; ++g) w[jj][g] = wp[g * 64]; }
        v2u v[2][16];
#pragma unroll
        for (int kk = 0; kk < 16; ++kk) v[0][kk] = *(const LAS v2u*)(unsigned)((w[0][kk >> 2][kk & 3] & 0x1FFF8u) + lbase);
#pragma unroll 1
        for (int i = 0; i < NBLK; ++i) {
            float* xr = X + (size_t)((hf * 128 + F.wave + NWAVES * i) * 64 + lane) * D + 8 * c;
            const f32x4 x0 = *(const f32x4*)xr, x1 = *(const f32x4*)(xr + 4);
            const int inx = i + 1 < NBLK ? i + 1 : i;
            f32x2 acc[4];
#pragma unroll
            for (int q = 0; q < 4; ++q) acc[q] = (f32x2){0.f, 0.f};
#pragma unroll
            for (int j = 0; j < 8; ++j) {
#pragma unroll
                for (int kk = 0; kk < 16; ++kk) v[(j + 1) & 1][kk] = *(const LAS v2u*)(unsigned)((w[(j + 1) & 3][kk >> 2][kk & 3] & 0x1FFF8u) + lbase);
                asm volatile("" ::: "memory");
#pragma unroll
                for (int kk = 0; kk < 16; ++kk) {
                    const v4u wq = w[j & 3][kk >> 2]; v2u pr; pr.x = (kk & 2) ? wq.z : wq.x; pr.y = (kk & 2) ? wq.w : wq.y;
                    const f32x2 f0 = __builtin_amdgcn_cvt_pk_f32_fp8((int)v[j & 1][kk].x, false), f1 = __builtin_amdgcn_cvt_pk_f32_fp8((int)v[j & 1][kk].x, true);
                    const f32x2 f2 = __builtin_amdgcn_cvt_pk_f32_fp8((int)v[j & 1][kk].y, false), f3 = __builtin_amdgcn_cvt_pk_f32_fp8((int)v[j & 1][kk].y, true);
                    if (kk & 1) {
                        asm("v_pk_fma_f32 %0, %1, %2, %0 op_sel:[1,0,0] op_sel_hi:[1,1,1]" : "+v"(acc[0]) : "v"(pr), "v"(f0)); asm("v_pk_fma_f32 %0, %1, %2, %0 op_sel:[1,0,0] op_sel_hi:[1,1,1]" : "+v"(acc[1]) : "v"(pr), "v"(f1));
                        asm("v_pk_fma_f32 %0, %1, %2, %0 op_sel:[1,0,0] op_sel_hi:[1,1,1]" : "+v"(acc[2]) : "v"(pr), "v"(f2)); asm("v_pk_fma_f32 %0, %1, %2, %0 op_sel:[1,0,0] op_sel_hi:[1,1,1]" : "+v"(acc[3]) : "v"(pr), "v"(f3));
                    } else {
                        asm("v_pk_fma_f32 %0, %1, %2, %0 op_sel_hi:[0,1,1]" : "+v"(acc[0]) : "v"(pr), "v"(f0)); asm("v_pk_fma_f32 %0, %1, %2, %0 op_sel_hi:[0,1,1]" : "+v"(acc[1]) : "v"(pr), "v"(f1));
                        asm("v_pk_fma_f32 %0, %1, %2, %0 op_sel_hi:[0,1,1]" : "+v"(acc[2]) : "v"(pr), "v"(f2)); asm("v_pk_fma_f32 %0, %1, %2, %0 op_sel_hi:[0,1,1]" : "+v"(acc[3]) : "v"(pr), "v"(f3)); } }
                asm volatile("" ::: "memory");
                { const v4u* wp = j + 4 < 8 ? wptr(i, j + 4) : wptr(inx, j - 4);
#pragma unroll
                  for (int g = 0; g < 4; ++g) w[j & 3][g] = wp[g * 64]; }
                asm volatile("" ::: "memory");
            }
            *(f32x4*)xr = x0 + ga * (f32x4){acc[0].x, acc[0].y, acc[1].x, acc[1].y};
            *(f32x4*)(xr + 4) = x1 + gb * (f32x4){acc[2].x, acc[2].y, acc[3].x, acc[3].y};
        }
    }
}

__device__ __forceinline__ void phase_final(Frame& F) {
    KARGS;
    float* X = OUTP; const float* gain = IN(31);
    const int lane = F.lane, gw = F.bid * NWAVES + F.wave, NGW = F.G * NWAVES;
    f32x4 gn[4];
#pragma unroll
    for (int j = 0; j < 4; ++j) gn[j] = *(const f32x4*)(gain + 256 * j + 4 * lane);
    for (int row = gw; row < T; row += NGW) {
        float* xr = X + (size_t)row * D + 4 * lane;
        f32x4 v[4]; float ss = 0.f;
#pragma unroll
        for (int j = 0; j < 4; ++j) { v[j] = *(const f32x4*)(xr + 256 * j); ss += (v[j].x * v[j].x + v[j].y * v[j].y) + (v[j].z * v[j].z + v[j].w * v[j].w); }
        const float rstd = rsqrtf(wave_sum(ss) * (1.f / D) + NORM_EPS);
#pragma unroll
        for (int j = 0; j < 4; ++j) *(f32x4*)(xr + 256 * j) = v[j] * rstd * gn[j];
    }
}

#ifndef TS_LMASK
#define TS_LMASK 15
#endif
#ifndef PROBE_PARTS
#define PROBE_PARTS 3
#endif
#ifndef PROBE_DUP
#define PROBE_DUP 0
#endif
#ifndef PH_MASK
#define PH_MASK 0xFFFF
#endif
#define PH_EN(k) ((PH_MASK >> (k)) & 1)
constexpr int NPH = 50;
__host__ __device__ inline bool phase_skipped(int p) { if (p == 0 || p == NPH - 1) return false; const int layer = (p - 1) / 12, step = (p - 1) % 12;
    if (step == 9) return true;
    return (layer & 1) == 0 && (step == 3 || step == 4 || step == 5); }
__global__ void __launch_bounds__(NTHR, 2) mk_fwd(Args args) {
    extern __shared__ __attribute__((aligned(16))) unsigned char lds[];
    Frame F;
    F.lds = (LAS unsigned char*)lds;
    F.MISC = (volatile LAS unsigned*)(F.lds + MISC_OFF);
    F.tid = threadIdx.x; F.lane = F.tid & 63; F.wave = __builtin_amdgcn_readfirstlane(F.tid >> 6);
    F.G = gridDim.x; F.bid = blockIdx.x;
    F.ctl = (gu32*)(args.ws + WS_CTL);
    for (int u = F.tid; u < (LDS_BYTES - MISC_OFF) / 4; u += NTHR) ((LAS unsigned*)(F.lds + MISC_OFF))[u] = 0u;
    __syncthreads();
    XcdBarrier bar; bar.bar = (unsigned*)(F.ctl + CW_BAR); bar.x = 0; bar.st = nullptr;
    const int lo = args.ph_lo, hi = args.ph_hi;
    if (hi - lo > 1) bar = xcd_barrier_post((unsigned*)(F.ctl + CW_BAR), F.MISC + 8);
    bool ran = false;
#ifdef TS_STEP
    unsigned long long ts_acc = 0ull;
#endif
    for (int p = lo; p < hi; ++p) {
        if (phase_skipped(p)) continue;
        if (ran) xcd_barrier(bar);
        ran = true;
        { int t_ = threadIdx.x; asm volatile("" : "+v"(t_)); F.tid = t_; F.lane = t_ & 63; F.wave = __builtin_amdgcn_readfirstlane(t_ >> 6);
          int b_ = blockIdx.x, g_ = gridDim.x; asm volatile("" : "+s"(b_), "+s"(g_)); F.bid = b_; F.G = g_; }
#ifdef TS_STEP
        const bool ts_sel = (p == 0) ? (TS_STEP == 100) : (((p - 1) % 12) == TS_STEP && ((TS_LMASK >> ((p - 1) / 12)) & 1));
        unsigned long long ts0 = 0ull; if (ts_sel) ts0 = __builtin_amdgcn_s_memrealtime();
#define TS_END() do { if (ts_sel) { xcd_barrier(bar); ts_acc += __builtin_amdgcn_s_memrealtime() - ts0; } } while (0)
#else
#define TS_END() do {} while (0)
#endif
        if (p == 0) { if (PH_EN(0)) {
#if (PROBE_DUP >> 0) & 1
            phase_prologue(F); __syncthreads();
#endif
            phase_prologue(F); } TS_END(); continue; }
        if (p == NPH - 1) { if (PH_EN(1)) phase_final(F); continue; }
        const int layer = (p - 1) / 12, step = (p - 1) % 12; const bool odd = layer & 1;
        KARGS;
        if (step == 0 || step == 7) { if (PH_EN(2)) {
#if (PROBE_DUP >> 2) & 1
            phase_norm(F, layer, step == 7 ? 1 : 0);
#endif
            phase_norm(F, layer, step == 7 ? 1 : 0); } }
        else if (step == 1 || step == 8) { if (PH_EN(3)) {
            const int N = step == 8 ? 2048 : (odd ? ODD_N : EVEN_IN);
            const bf16* Bt = step == 8 ? WSP(bf16, WS_WQ + (size_t)layer * 4 * MiB) : WSP(bf16, WS_WIN + (size_t)layer * 8 * MiB);
            bf16* O = step == 8 ? WSP(bf16, WS_Q) : WSP(bf16, WS_PROJ);
            pg8::Gemm g{WSP(bf16, WS_H), Bt, T, N, D}; pg8::StaticOrder S; S.init(T, N, F.G, F.bid);
            pg8::EpiBf16<0> E{O, N, nullptr, 0, 0, 1.f};
#if (PROBE_DUP >> 3) & 1
            pg8::gemm_phase<pg8::EpiBf16<0>, pg8::StaticOrder, PG8_ALIGN, PG8_SP2>(F.lds + RING_OFF, g, S, E); __syncthreads();
#endif
            pg8::gemm_phase<pg8::EpiBf16<0>, pg8::StaticOrder, PG8_ALIGN, PG8_SP2>(F.lds + RING_OFF, g, S, E);
            if (step == 8) { asm volatile("s_waitcnt vmcnt(0)" ::: "memory"); __syncthreads(); phase_peer_topk<true>(F, layer, S); }
        } }
        else if (step == 2) { if (odd) { if (PH_EN(4)) {
#if (PROBE_DUP >> 4) & 1
            phase_odd_prep(F, layer, PROBE_PARTS); xcd_barrier(bar);
#endif
            phase_odd_prep(F, layer, 7); } } else { if (PH_EN(5)) {
#if (PROBE_DUP >> 5) & 1
            phase_even_mixer(F, layer);
#endif
            phase_even_mixer(F, layer); } } }
        else if (step == 3) { if (PH_EN(11)) {
#if (PROBE_DUP >> 11) & 1
            phase_rwkv_chunk(F, layer, 2048, PROBE_PARTS); xcd_barrier(bar);
#endif
            phase_rwkv_chunk(F, layer); } }
        else if (step == 4) { if (PH_EN(6)) {
#if (PROBE_DUP >> 6) & 1
            phase_odd_main(F, layer, CW_WORK2, PROBE_PARTS); xcd_barrier(bar);
#endif
            phase_odd_main(F, layer, CW_WORK, 3); } }
        else if (step == 5) { if (PH_EN(7)) {
#if (PROBE_DUP >> 7) & 1
            phase_rwkv_post(F, layer);
#endif
            phase_rwkv_post(F, layer); } }
        else if (step == 6) { if (PH_EN(8)) {
            pg8::Gemm g{WSP(bf16, WS_MIX), WSP(bf16, WS_WOUT + (size_t)layer * 2 * MiB), T, D, D}; pg8::StaticOrder S; S.init(T, D, F.G, F.bid);
            pg8::EpiResid E{layer == 0 ? IN(0) : OUTP, OUTP, WSP(float, WS_MOD) + (size_t)layer * 2 * 6144 + 2048, 6144};
            pg8::gemm_phase<pg8::EpiResid, pg8::StaticOrder, PG8_ALIGN, PG8_SP2>(F.lds + RING_OFF, g, S, E);
        } }
        else if (step == 9) { }
        else if (step == 10) { if (PH_EN(10)) {
#ifdef GU_VALU
            phase_peer_gu_valu(F, layer);
#else
            phase_peer_gu(F, layer);
#endif
            } }
        else { if (PH_EN(12)) {
#ifdef GV_OLD
            phase_peer_gv_old(F, layer);
#else
            phase_peer_gv(F, layer);
#endif
            } }
        TS_END();
    }
#ifdef TS_STEP
    if (blockIdx.x == 0 && threadIdx.x == 0) args.out[0] = (float)ts_acc;
#endif
}

extern "C" void kernel_launch(void* const* d_in, const int* in_sizes, int n_in, void* d_out, int out_size, void* d_ws, size_t ws_size, hipStream_t stream) {
    static int grid = 0;
    if (grid == 0) {
        if (n_in != 32 || in_sizes[0] != T * D || out_size != T * D || ws_size < WS_END) { fprintf(stderr, "kernel_launch: unexpected shapes (n_in %d, in0 %d, out %d, ws %zu < %zu); nothing launched\n", n_in, n_in > 0 ? in_sizes[0] : -1, out_size, ws_size, (size_t)WS_END); grid = -1; return; }
        int dev = 0, cus = 0, per_cu = 0;
        if (hipGetDevice(&dev) != hipSuccess || hipDeviceGetAttribute(&cus, hipDeviceAttributeMultiprocessorCount, dev) != hipSuccess) { grid = -1; return; }
        if (hipFuncSetAttribute((const void*)mk_fwd, hipFuncAttributeMaxDynamicSharedMemorySize, LDS_BYTES) != hipSuccess) { fprintf(stderr, "kernel_launch: hipFuncSetAttribute failed\n"); grid = -1; return; }
        if (hipOccupancyMaxActiveBlocksPerMultiprocessor(&per_cu, (const void*)mk_fwd, NTHR, LDS_BYTES) != hipSuccess || per_cu < 1) fprintf(stderr, "kernel_launch: occupancy query reports %d workgroups per CU\n", per_cu);
        (void)hipGetLastError();
        grid = cus;
    }
    if (grid < 0) return;
    if (hipMemsetAsync((char*)d_ws + WS_CTL, 0, CTL_ZERO_BYTES, stream) != hipSuccess) { fprintf(stderr, "kernel_launch: hipMemsetAsync failed\n"); return; }
    Args a{};
    for (int i = 0; i < 32; ++i) a.in[i] = (const float*)d_in[i];
    a.out = (float*)d_out; a.ws = (unsigned char*)d_ws;
#if MK_ONE_LAUNCH
    a.ph_lo = 0; a.ph_hi = NPH;
    hipLaunchKernelGGL(mk_fwd, dim3(grid), dim3(NTHR), LDS_BYTES, stream, a);
#else
    for (int p = 0; p < NPH; ++p) { if (phase_skipped(p)) continue; a.ph_lo = p; a.ph_hi = p + 1;
        hipLaunchKernelGGL(mk_fwd, dim3(grid), dim3(NTHR), LDS_BYTES, stream, a); }
#endif
    const hipError_t le = hipPeekAtLastError();
    if (le != hipSuccess) fprintf(stderr, "kernel_launch: launch failed: %s\n", hipGetErrorName(le));
}
```

```cpp
#include <hip/hip_runtime.h>
#include <cstdio>
#include <cstdint>
namespace pg8 {
#define PG8_LAS __attribute__((address_space(3)))
typedef unsigned short bf16_t;
typedef short bf16x8 __attribute__((ext_vector_type(8)));
typedef float f32x4 __attribute__((ext_vector_type(4)));
typedef unsigned u32x4 __attribute__((ext_vector_type(4)));
constexpr int BM = 256, BK = 64, HALF = 128, HTB = HALF * BK * 2  , STAGE_BYTES = 8 * HTB, NXCD = 8, WGM = 8;

__host__ __device__ __forceinline__ int lds_byte(int r, int c) { const int st = (r >> 4) * 2 + (c >> 5), rr = r & 15, cc = c & 31, ob = rr * 64 + cc * 2; return st * 1024 + (ob ^ (((ob >> 9) & 1) << 5)); }
__host__ __device__ __forceinline__ void stage_rc(int b, int& R, int& C) { const int st = b / 1024, sb = b % 1024, swz = sb ^ (((sb >> 9) & 1) << 5); R = (st >> 1) * 16 + swz / 64; C = (st & 1) * 32 + (swz % 64) / 2; }
__host__ __device__ __forceinline__ int perm32(int rho) { const int n = rho >> 4, i = rho & 15; return 8 * (i >> 2) + 4 * n + (i & 3); }

struct Unit { int pm, pn; };
struct Gemm { const bf16_t* A; const bf16_t* Bt; int M, N, K; };

struct StaticOrder {
    int nM, nN, nwg, G, c;
    __host__ __device__ void init(int M, int N, int G_, int c_) { nM = M / BM; nN = N / BM; nwg = nM * nN; G = G_; c = c_; }
    __host__ __device__ bool next(int i, Unit& u) const {
        const long L = (long)i * G + c; if (L >= nwg) return false;
        int wgid = (int)L; { const int q = nwg / NXCD, r = nwg % NXCD, xcd = wgid % NXCD, off = wgid / NXCD; wgid = (xcd < r ? xcd * (q + 1) : r * (q + 1) + (xcd - r) * q) + off; }
        const int nig = WGM * nN, gid = wgid / nig, fm = gid * WGM, gsz = (nM - fm) < WGM ? (nM - fm) : WGM;
        u.pm = fm + ((wgid % nig) % gsz); u.pn = (wgid % nig) / gsz; return true;
    }
    __device__ __forceinline__ void a_ready(const Unit&) const {}
    __device__ __forceinline__ void done(const Unit&) const {}
};

__device__ __forceinline__ unsigned cvt_pk_bf16(float lo, float hi) { unsigned r; asm volatile("v_cvt_pk_bf16_f32 %0, %1, %2" : "=v"(r) : "v"(lo), "v"(hi)); return r; }
typedef float f32x2 __attribute__((ext_vector_type(2)));
__device__ __forceinline__ f32x2 gelu_pk(f32x2 v) {
    const f32x2 av = __builtin_elementwise_abs(v), d = av * 0.2316418882f + 1.0f;
    f32x2 t; t.x = __builtin_amdgcn_rcpf(d.x); t.y = __builtin_amdgcn_rcpf(d.y);
    f32x2 q = t * 0.5307027145f + (-0.7265760135f); q = q * t + 0.7107068705f; q = q * t + (-0.142248368f); q = q * t + 0.127414796f; q = q * t;
    const f32x2 s = (v * v) * (-0.72134752044f);
    f32x2 e; e.x = __builtin_amdgcn_exp2f(s.x); e.y = __builtin_amdgcn_exp2f(s.y);
    const f32x2 m = v * (q * e), r = v - m;
    f32x2 o; o.x = v.x < 0.f ? m.x : r.x; o.y = v.y < 0.f ? m.y : r.y; return o;
}

template <int ACT  > struct EpiBf16 {
    static constexpr bool PERM = true, AFTER_DRAIN = false; static_assert(ACT == 0 || ACT == 1, "EpiBf16: ACT is 0 (none) or 1 (gelu_pk)");
    bf16_t* O; int ldc; const float* bias; int split_cols; size_t split_stride; float scale0;
    __device__ __forceinline__ void operator()(const f32x4 (&acc)[2][2][4][2], const Unit& u, int wr, int wc, int fr, int fq) const {
        const int row0 = u.pm * BM + wr * 64 + fr; int colt = u.pn * BM; bf16_t* base = O;
        float sc = 1.f; if (split_cols) { const int t = colt / split_cols; base += (size_t)t * split_stride; colt -= t * split_cols; if (t == 0) sc = scale0; }
        const int col0 = colt + wc * 32 + 8 * fq, bcol0 = u.pn * BM + wc * 32 + 8 * fq;
        f32x4 bv[2][2];
#pragma unroll
        for (int bj = 0; bj < 2; ++bj)
#pragma unroll
            for (int n = 0; n < 2; ++n) bv[bj][n] = bias ? *(const f32x4*)(bias + bcol0 + bj * HALF + 4 * n) : (f32x4){0.f, 0.f, 0.f, 0.f};
#pragma unroll
        for (int ai = 0; ai < 2; ++ai)
#pragma unroll
            for (int m = 0; m < 4; ++m) { bf16_t* rowp = base + (size_t)(row0 + ai * HALF + m * 16) * ldc + col0;
#pragma unroll
                for (int bj = 0; bj < 2; ++bj) { f32x4 v0 = acc[ai][bj][m][0] + bv[bj][0], v1 = acc[ai][bj][m][1] + bv[bj][1];
                    if (ACT == 1) { f32x2 a = gelu_pk((f32x2){v0[0], v0[1]}), b = gelu_pk((f32x2){v0[2], v0[3]}), c = gelu_pk((f32x2){v1[0], v1[1]}), d = gelu_pk((f32x2){v1[2], v1[3]});
                        v0 = (f32x4){a.x, a.y, b.x, b.y}; v1 = (f32x4){c.x, c.y, d.x, d.y}; }
                    v0 = v0 * sc; v1 = v1 * sc; u32x4 w; w.x = cvt_pk_bf16(v0[0], v0[1]); w.y = cvt_pk_bf16(v0[2], v0[3]); w.z = cvt_pk_bf16(v1[0], v1[1]); w.w = cvt_pk_bf16(v1[2], v1[3]);
                    *(u32x4*)(rowp + bj * HALF) = w; } }
    }
};
struct EpiResid {
    static constexpr bool PERM = false, AFTER_DRAIN = false;
    const float* base; float* out; const float* gate; int gstride;
    __device__ __forceinline__ void operator()(const f32x4 (&acc)[2][2][4][2], const Unit& u, int wr, int wc, int fr, int fq) const {
        const int row0 = u.pm * BM + wr * 64 + fr; const int col0 = u.pn * BM + wc * 32 + 4 * fq;
        const float* gp = gate + ((u.pm * BM) >= 8192 ? gstride : 0);
        f32x4 gv[2][2];
#pragma unroll
        for (int bj = 0; bj < 2; ++bj)
#pragma unroll
            for (int n = 0; n < 2; ++n) gv[bj][n] = *(const f32x4*)(gp + col0 + bj * HALF + n * 16);
#pragma unroll
        for (int ai = 0; ai < 2; ++ai)
#pragma unroll
            for (int m = 0; m < 4; ++m) { const size_t off = (size_t)(row0 + ai * HALF + m * 16) * 1024 + col0;
#pragma unroll
                for (int bj = 0; bj < 2; ++bj)
#pragma unroll
                    for (int n = 0; n < 2; ++n) { const f32x4 bs = *(const f32x4*)(base + off + bj * HALF + n * 16);
                        *(f32x4*)(out + off + bj * HALF + n * 16) = bs + gv[bj][n] * acc[ai][bj][m][n]; } }
    }
};
template <class Epi, class Sched, bool ALIGN_EPI = false, bool SP2 = false>
__device__ __forceinline__ void gemm_phase(PG8_LAS unsigned char* lds, const Gemm g, const Sched& S, const Epi& E) {
    int tid_l = threadIdx.x; asm volatile("" : "+v"(tid_l));
    const int tid = tid_l, wid = __builtin_amdgcn_readfirstlane(tid >> 6), lane = tid & 63, wr = wid >> 2, wc = wid & 3, fr = lane & 15, fq = lane >> 4;
    const int K = g.K, nt = K / BK;
    unsigned voffA[2], voffB[2];
#pragma unroll
    for (int i = 0; i < 2; ++i) { int R, C; stage_rc(tid * 16 + i * 8192, R, C); const int Rb = Epi::PERM ? ((R & ~31) + perm32(R & 31)) : R;
        voffA[i] = (unsigned)(R * K + C) * 2u; voffB[i] = (unsigned)(Rb * K + C) * 2u; }
    const size_t kstep = (size_t)(BK * 2);
    const size_t hstep = (size_t)HALF * K * 2;
    const size_t tstep = 2 * hstep;
    const unsigned ldsw = (unsigned)wid * 1024u;
    const int aoff = lds_byte(wr * 64 + fr, fq * 8), boff = lds_byte(wc * 32 + fr, fq * 8);
#define PG8_SA(b, h) (((b) * 2 + (h)) * HTB)
#define PG8_SB(b, h) ((4 + (b) * 2 + (h)) * HTB)
#define PG8_STAGE(bufoff, gbase, voff) do { _Pragma("unroll") for (int _i = 0; _i < 2; ++_i) \
        __builtin_amdgcn_global_load_lds((const unsigned*)((const char*)(gbase) + (voff)[_i]), (PG8_LAS unsigned*)(lds + (bufoff) + ldsw + _i * 8192), 16, 0, 0); } while (0)
#define PG8_LDA(dst, b, h) do { _Pragma("unroll") for (int m = 0; m < 4; ++m) _Pragma("unroll") for (int k = 0; k < 2; ++k) dst[m][k] = *(const PG8_LAS bf16x8*)(lds + PG8_SA(b, h) + aoff + m * 2048 + k * 1024); } while (0)
#define PG8_LDB(dst, b, h) do { _Pragma("unroll") for (int n = 0; n < 2; ++n) _Pragma("unroll") for (int k = 0; k < 2; ++k) dst[n][k] = *(const PG8_LAS bf16x8*)(lds + PG8_SB(b, h) + boff + n * 2048 + k * 1024); } while (0)
#define PG8_MMA(ai, bj, At, Bt) do { __builtin_amdgcn_s_setprio(1); _Pragma("unroll") for (int m = 0; m < 4; ++m) _Pragma("unroll") for (int n = 0; n < 2; ++n) _Pragma("unroll") for (int k = 0; k < 2; ++k) \
        acc[ai][bj][m][n] = __builtin_amdgcn_mfma_f32_16x16x32_bf16(Bt[n][k], At[m][k], acc[ai][bj][m][n], 0, 0, 0); __builtin_amdgcn_s_setprio(0); } while (0)
#define PG8_WAIT_V(n) asm volatile("s_waitcnt vmcnt(" #n ")" ::: "memory")
#define PG8_WAIT_L(n) asm volatile("s_waitcnt lgkmcnt(" #n ")" ::: "memory")
#define PG8_BAR __builtin_amdgcn_s_barrier()
#define PG8_SCHED __builtin_amdgcn_sched_barrier(0)
    Unit cur, nxt; int ui = 0;
    if (!S.next(0, cur)) return;
    f32x4 acc[2][2][4][2];
#pragma unroll
    for (int a = 0; a < 2; ++a)
#pragma unroll
        for (int b = 0; b < 2; ++b)
#pragma unroll
            for (int m = 0; m < 4; ++m)
#pragma unroll
                for (int n = 0; n < 2; ++n) acc[a][b][m][n] = (f32x4){0.f, 0.f, 0.f, 0.f};
    bf16x8 At[4][2], B0[2][2], B1[2][2];
    const char* cA = (const char*)g.A + (size_t)cur.pm * tstep; const char* cB = (const char*)g.Bt + (size_t)cur.pn * tstep;
    S.a_ready(cur);
    if constexpr (SP2) {
        PG8_STAGE(PG8_SB(0, 0), cB, voffB); PG8_STAGE(PG8_SB(0, 1), cB + hstep, voffB); PG8_STAGE(PG8_SA(0, 0), cA, voffA); PG8_STAGE(PG8_SA(0, 1), cA + hstep, voffA);
        if (wr == 1) PG8_BAR;
        PG8_WAIT_V(2); PG8_BAR;
        PG8_STAGE(PG8_SB(1, 0), cB + kstep, voffB); PG8_STAGE(PG8_SA(1, 0), cA + kstep, voffA); PG8_STAGE(PG8_SB(1, 1), cB + hstep + kstep, voffB);
        PG8_WAIT_V(6); PG8_BAR;
    } else {
        PG8_STAGE(PG8_SB(0, 0), cB, voffB); PG8_STAGE(PG8_SA(0, 0), cA, voffA); PG8_STAGE(PG8_SB(0, 1), cB + hstep, voffB); PG8_STAGE(PG8_SA(0, 1), cA + hstep, voffA);
        if (wr == 1) PG8_BAR;
        PG8_WAIT_V(4); PG8_BAR;
        PG8_STAGE(PG8_SB(1, 0), cB + kstep, voffB); PG8_STAGE(PG8_SA(1, 0), cA + kstep, voffA); PG8_STAGE(PG8_SB(1, 1), cB + hstep + kstep, voffB);
        PG8_WAIT_V(6); PG8_BAR;
    }
    for (;;) {
        const bool has_next = S.next(ui + 1, nxt);
        const char* nA = has_next ? (const char*)g.A + (size_t)nxt.pm * tstep : cA; const char* nB = has_next ? (const char*)g.Bt + (size_t)nxt.pn * tstep : cB;
        for (int t = 0; t < nt; t += 2) {
            const bool last = (t == nt - 2);
            const char* a1 = cA + (size_t)(t + 1) * kstep;
            const char* a2 = last ? nA : cA + (size_t)(t + 2) * kstep; const char* b2 = last ? nB : cB + (size_t)(t + 2) * kstep;
            const char* a3 = a2 + kstep; const char* b3 = b2 + kstep;
            if (last && has_next) S.a_ready(nxt);
            if constexpr (SP2) {
            PG8_LDB(B0, 0, 0); PG8_LDB(B1, 0, 1); PG8_SCHED; PG8_LDA(At, 0, 0); PG8_STAGE(PG8_SA(1, 1), a1 + hstep, voffA);
            PG8_WAIT_V(8); PG8_WAIT_L(0); PG8_BAR; PG8_MMA(0, 0, At, B0); PG8_MMA(0, 1, At, B1); PG8_BAR; PG8_SCHED;
            PG8_LDA(At, 0, 1); PG8_STAGE(PG8_SB(0, 0), b2, voffB); PG8_STAGE(PG8_SB(0, 1), b2 + hstep, voffB); PG8_STAGE(PG8_SA(0, 0), a2, voffA);
            PG8_WAIT_V(8); PG8_WAIT_L(0); PG8_BAR; PG8_MMA(1, 0, At, B0); PG8_MMA(1, 1, At, B1); PG8_BAR; PG8_SCHED;
            PG8_LDB(B0, 1, 0); PG8_LDB(B1, 1, 1); PG8_SCHED; PG8_LDA(At, 1, 0); PG8_STAGE(PG8_SA(0, 1), a2 + hstep, voffA);
            PG8_WAIT_V(8); PG8_WAIT_L(0); PG8_BAR; PG8_MMA(0, 0, At, B0); PG8_MMA(0, 1, At, B1); PG8_BAR; PG8_SCHED;
            PG8_LDA(At, 1, 1); PG8_STAGE(PG8_SB(1, 0), b3, voffB); PG8_STAGE(PG8_SB(1, 1), b3 + hstep, voffB); PG8_STAGE(PG8_SA(1, 0), a3, voffA);
            PG8_WAIT_V(8); PG8_WAIT_L(0); PG8_BAR; PG8_MMA(1, 0, At, B0); PG8_MMA(1, 1, At, B1); PG8_BAR; PG8_SCHED;
            } else {
            PG8_LDB(B0, 0, 0); PG8_SCHED; PG8_LDA(At, 0, 0); PG8_STAGE(PG8_SA(1, 1), a1 + hstep, voffA);
            PG8_WAIT_L(8); PG8_BAR; PG8_WAIT_L(0); PG8_MMA(0, 0, At, B0); PG8_BAR; PG8_SCHED;
            PG8_LDB(B1, 0, 1); PG8_STAGE(PG8_SB(0, 0), b2, voffB);
            PG8_BAR; PG8_WAIT_L(0); PG8_MMA(0, 1, At, B1); PG8_BAR;
            PG8_LDA(At, 0, 1); PG8_STAGE(PG8_SA(0, 0), a2, voffA);
            PG8_BAR; PG8_WAIT_L(0); PG8_MMA(1, 0, At, B0); PG8_BAR; PG8_SCHED;
            PG8_STAGE(PG8_SB(0, 1), b2 + hstep, voffB);
            PG8_WAIT_V(6); PG8_BAR; PG8_MMA(1, 1, At, B1); PG8_BAR;
            PG8_LDB(B0, 1, 0); PG8_SCHED; PG8_LDA(At, 1, 0); PG8_STAGE(PG8_SA(0, 1), a2 + hstep, voffA);
            PG8_WAIT_L(8); PG8_BAR; PG8_WAIT_L(0); PG8_MMA(0, 0, At, B0); PG8_BAR; PG8_SCHED;
            PG8_LDB(B1, 1, 1); PG8_STAGE(PG8_SB(1, 0), b3, voffB);
            PG8_BAR; PG8_WAIT_L(0); PG8_MMA(0, 1, At, B1); PG8_BAR;
            PG8_LDA(At, 1, 1); PG8_STAGE(PG8_SA(1, 0), a3, voffA);
            PG8_BAR; PG8_WAIT_L(0); PG8_MMA(1, 0, At, B0); PG8_BAR; PG8_SCHED;
            PG8_STAGE(PG8_SB(1, 1), b3 + hstep, voffB);
            PG8_WAIT_V(6); PG8_BAR; PG8_MMA(1, 1, At, B1); PG8_BAR;
            }
        }
        if constexpr (ALIGN_EPI) { if (wr == 0) PG8_BAR; }
        if constexpr (!Epi::AFTER_DRAIN) { E(acc, cur, wr, wc, fr, fq); S.done(cur); }
        if (!has_next) break;
#pragma unroll
        for (int a = 0; a < 2; ++a)
#pragma unroll
            for (int b = 0; b < 2; ++b)
#pragma unroll
                for (int m = 0; m < 4; ++m)
#pragma unroll
                    for (int n = 0; n < 2; ++n) acc[a][b][m][n] = (f32x4){0.f, 0.f, 0.f, 0.f};
        cur = nxt; cA = nA; cB = nB; ++ui;
        if constexpr (ALIGN_EPI) { if (wr == 1) PG8_BAR; }
    }
    PG8_WAIT_V(0);
    if constexpr (!ALIGN_EPI) { if (wr == 0) PG8_BAR; }
    PG8_BAR;
    if constexpr (Epi::AFTER_DRAIN) { E.fused(acc, cur, wr, wc, fr, fq, lds, wid, lane); S.done(cur); }
#undef PG8_SA
#undef PG8_SB
#undef PG8_STAGE
#undef PG8_LDA
#undef PG8_LDB
#undef PG8_MMA
#undef PG8_WAIT_V
#undef PG8_WAIT_L
#undef PG8_BAR
#undef PG8_SCHED
}
}
#ifndef PG8_SP2
#define PG8_SP2 true
#endif
#ifndef PG8_ALIGN
#define PG8_ALIGN true
#endif
#ifndef MK_ONE_LAUNCH
#define MK_ONE_LAUNCH 1
#endif

constexpr int NWAVES = 8, NTHR = NWAVES * 64;
constexpr int BATCH = 2, SEQ = 8192, D = 1024, T = BATCH * SEQ, DEPTH = 4;
constexpr int EVEN_IN = 2048, ODD_LD = 3848, ODD_N = 3840;
constexpr int NEXP = 16384;
constexpr float NORM_EPS = 1e-6f, GN_EPS = 64e-5f;

constexpr size_t MiB = 1u << 20;
constexpr size_t WS_CTL = 0, CTL_ZERO_BYTES = 1 * MiB;
constexpr size_t WS_MOD = 1 * MiB;
constexpr size_t WS_WF = WS_MOD + 256 * 1024;
constexpr size_t WS_KEYS = WS_MOD + 512 * 1024;
constexpr size_t WS_LORA = 3 * MiB;
constexpr size_t WS_LOGF = 2 * MiB;
constexpr size_t WS_DCUM = 2 * MiB + 512 * 1024;
constexpr size_t WS_WIN = 4 * MiB;
constexpr size_t WS_WOUT = 36 * MiB;
constexpr size_t WS_WQ = 44 * MiB;
constexpr size_t WS_H = 64 * MiB;
constexpr size_t WS_MIX = 96 * MiB;
constexpr size_t WS_PROJ = 128 * MiB;
constexpr size_t WS_Q = 256 * MiB;
constexpr size_t WS_IDX = 320 * MiB;
constexpr size_t WS_GATE = 328 * MiB;
constexpr size_t WS_RW = 336 * MiB;
constexpr size_t RW_SLOT = 32 * MiB;
constexpr size_t WS_PU = WS_RW + 8 * RW_SLOT;
constexpr size_t WS_PV = WS_PU + 64 * MiB;
constexpr size_t WS_PS = WS_PV + 64 * MiB;
constexpr size_t WS_CG = WS_PS + 1 * MiB;
constexpr size_t WS_CQ = WS_CG + 16 * MiB;
constexpr size_t WS_CH = WS_CQ + 16 * MiB;
constexpr size_t WS_CY = WS_CH + 32 * MiB;
constexpr size_t WS_H8 = WS_CY + 32 * MiB;
constexpr size_t WS_HS = WS_H8 + 16 * MiB;
constexpr size_t WS_ACT = WS_HS + 1 * MiB;
constexpr size_t WS_END = WS_ACT + 8 * MiB;
constexpr int CW_WORK = 64;
constexpr int CW_WORK2 = 1024;
constexpr int CW_G1 = 24576, CW_G2 = 28672;
constexpr int CW_CHQ = 16384, CW_SCQ = 20480;
constexpr int CW_BAR = 4096;

constexpr int RING_OFF = 0, RING_BYTES = 131072;
constexpr int MISC_OFF = 159744;
constexpr int LDS_BYTES = 163840;

#define GAS __attribute__((address_space(1)))
#define LAS __attribute__((address_space(3)))
typedef unsigned short bf16;
typedef unsigned v4u __attribute__((ext_vector_type(4)));
typedef unsigned v2u __attribute__((ext_vector_type(2)));
typedef int v8i __attribute__((ext_vector_type(8)));
typedef float f32x4 __attribute__((ext_vector_type(4)));
typedef short bf16x8 __attribute__((ext_vector_type(8)));
typedef GAS unsigned gu32;
#define LDS_WAIT() asm volatile("s_waitcnt lgkmcnt(0)" ::: "memory")
#define VM_WAIT() asm volatile("s_waitcnt vmcnt(0)" ::: "memory")
#define LBAR() do { asm volatile("s_waitcnt lgkmcnt(0)" ::: "memory"); __builtin_amdgcn_s_barrier(); asm volatile("" ::: "memory"); } while (0)
typedef float f32x2_t __attribute__((ext_vector_type(2))); typedef __bf16 bf16x2_t __attribute__((ext_vector_type(2)));
__device__ __forceinline__ unsigned pk2(float lo, float hi) { const f32x2_t v = {lo, hi}; const bf16x2_t b = __builtin_convertvector(v, bf16x2_t); return __builtin_bit_cast(unsigned, b); }
__device__ __forceinline__ unsigned f2bf(float f) { return pk2(f, 0.f) & 0xffffu; }
__device__ __forceinline__ float bf2f(bf16 v) { return __builtin_bit_cast(float, (unsigned)v << 16); }
__device__ __forceinline__ float bflo(unsigned w) { return __builtin_bit_cast(float, w << 16); }
__device__ __forceinline__ float bfhi(unsigned w) { return __builtin_bit_cast(float, w & 0xffff0000u); }
__device__ __forceinline__ float wave_sum(float v) {
#pragma unroll
    for (int o = 1; o < 64; o <<= 1) v += __shfl_xor(v, o);
    return v;
}
__device__ __forceinline__ float wave_max(float v) {
#pragma unroll
    for (int o = 1; o < 64; o <<= 1) v = fmaxf(v, __shfl_xor(v, o));
    return v;
}
__device__ __forceinline__ float rl(float x, int j) { return __builtin_bit_cast(float, __builtin_amdgcn_readlane(__builtin_bit_cast(int, x), j)); }
__device__ __forceinline__ float sigmoidf_(float x) { return 1.f / (1.f + expf(-x)); }
__device__ __forceinline__ float softplusf_(float x) { return fmaxf(x, 0.f) + log1pf(expf(-fabsf(x))); }
__device__ __forceinline__ float gelu_erf(float x) { return 0.5f * x * (1.f + erff(x * 0.70710678118654752f)); }

#define XB_TMO      128
#define XB_XCNT(j)  (256  + 64 * (j))
#define XB_XSUB(j)  (1280 + 64 * (j))
#define XB_XGEN(j)  (2304 + 64 * (j))
#define XB_TOP      3328
#define XB_TOPGEN   3392
#define XCD_BAR_WORDS 3456
#define XB_SPIN_CAP (1u << 18)

__device__ __forceinline__ unsigned xb_ld(unsigned* p)              { return __hip_atomic_load(p, __ATOMIC_RELAXED, __HIP_MEMORY_SCOPE_AGENT); }
__device__ __forceinline__ unsigned xb_add(unsigned* p, unsigned v) { return __hip_atomic_fetch_add(p, v, __ATOMIC_RELAXED, __HIP_MEMORY_SCOPE_AGENT); }
__device__ __forceinline__ unsigned xb_xcc_id() { return (unsigned)__builtin_amdgcn_s_getreg((3 << 11) | 20) & 0xFu; }
#define XB_SPIN(cond, bar) do { unsigned _sp = 0; while (cond) { __builtin_amdgcn_s_sleep(1); \
    if ((++_sp & 255u) == 0u) { if (xb_ld(&(bar)[XB_TMO])) break; if (_sp > XB_SPIN_CAP) { atomicAdd(&(bar)[XB_TMO], 1u); break; } } } } while (0)

struct XcdBarrier {
    unsigned* bar; unsigned x;
    volatile LAS unsigned* st;
};

__device__ __forceinline__ XcdBarrier xcd_barrier_post(unsigned* bar, volatile LAS unsigned* st) {
    XcdBarrier b; b.bar = bar; b.x = xb_xcc_id(); b.st = st;
    if (threadIdx.x == 0) (void)xb_add(&bar[XB_XCNT(b.x)], 1u);
    return b;
}
__device__ __forceinline__ void xcd_barrier_complete(unsigned* bar, unsigned x, unsigned& nloc, unsigned& nx) {
    const unsigned G = gridDim.x * gridDim.y * gridDim.z;
    unsigned sum, cnt, mine, sp = 0u;
    for (;;) {
        sum = 0u; cnt = 0u; mine = 0u;
#pragma unroll
        for (unsigned j = 0; j < 16; ++j) { const unsigned c = xb_ld(&bar[XB_XCNT(j)]); sum += c; cnt += (c > 0u) ? 1u : 0u; mine = (j == x) ? c : mine; }
        if (sum == G) break;
        __builtin_amdgcn_s_sleep(1);
        if ((++sp & 255u) == 0u) { if (xb_ld(&bar[XB_TMO])) break; if (sp > XB_SPIN_CAP) { atomicAdd(&bar[XB_TMO], 1u); break; } }
    }
    nloc = mine > 0u ? mine : 1u; nx = cnt > 0u ? cnt : 1u;
}

__device__ __forceinline__ void xcd_barrier(const XcdBarrier& b) {
    asm volatile("s_waitcnt vmcnt(0)" ::: "memory");
    __syncthreads();
    if (threadIdx.x == 0) {
        unsigned* bar = b.bar;
        __builtin_amdgcn_s_waitcnt(0);
        unsigned nloc = b.st[0], nx = b.st[1];
        if (nloc == 0u) { xcd_barrier_complete(bar, b.x, nloc, nx); b.st[0] = nloc; b.st[1] = nx; }
        const unsigned old = xb_add(&bar[XB_XSUB(b.x)], 1u);
        const unsigned gen = old / nloc;
        if (old + 1u == (gen + 1u) * nloc) {
            __builtin_amdgcn_fence(__ATOMIC_RELEASE, "agent");
            asm volatile("s_waitcnt vmcnt(0)" ::: "memory");
            const unsigned og = xb_add(&bar[XB_TOP], 1u);
            const unsigned tg = og / nx;
            if (og + 1u == (tg + 1u) * nx) xb_add(&bar[XB_TOPGEN], 1u);
            else XB_SPIN(xb_ld(&bar[XB_TOPGEN]) == tg, bar);
            __builtin_amdgcn_fence(__ATOMIC_ACQUIRE, "agent");
            xb_add(&bar[XB_XGEN(b.x)], 1u);
            asm volatile("s_waitcnt vmcnt(0)" ::: "memory");
        } else {
            XB_SPIN(xb_ld(&bar[XB_XGEN(b.x)]) == gen, bar);
            __builtin_amdgcn_fence(__ATOMIC_ACQUIRE, "agent");
            asm volatile("s_waitcnt vmcnt(0)" ::: "memory");
        }
    }
    __syncthreads();
}


struct Frame {
    LAS unsigned char* lds;
    volatile LAS unsigned* MISC;
    gu32* ctl;
    int tid, lane, wave, G, bid;
};
struct Args { const float* in[32]; float* out; unsigned char* ws; int ph_lo, ph_hi; };
#define CAS __attribute__((address_space(4)))
#define KARGS const CAS Args* ka_; { unsigned long long kp_ = (unsigned long long)__builtin_amdgcn_kernarg_segment_ptr(); asm volatile("" : "+s"(kp_)); ka_ = (const CAS Args*)kp_; } unsigned char* const ws_ = ka_->ws
#define IN(i) (ka_->in[i])
#define OUTP (ka_->out)
#define WSP(type, off) ((type*)(ws_ + (off)))

template <int NR> __device__ __forceinline__ void conv_issue(const float* TU, const float* TV, int l, int row0, int NGW, int lane, f32x4 (&v)[NR][4]) {
#pragma unroll
    for (int q = 0; q < NR; ++q) { const int r = row0 + q * NGW; if (r < 2 * NEXP) { const int tb = r >= NEXP ? 1 : 0, e = r - tb * NEXP;
        const float* src = (tb ? TV : TU) + ((size_t)l * NEXP + e) * 1024 + 4 * lane;
#pragma unroll
        for (int j = 0; j < 4; ++j) v[q][j] = *(const f32x4*)(src + 256 * j); } }
}
template <int NR> __device__ __forceinline__ void conv_finish(unsigned char* PU, unsigned char* PV, float* PS, int l, int row0, int NGW, int lane, f32x4 (&v)[NR][4], LAS unsigned char* scr) {
#pragma unroll
    for (int q = 0; q < NR; ++q) { const int r = row0 + q * NGW; if (r < 2 * NEXP) { const int tb = r >= NEXP ? 1 : 0, e = r - tb * NEXP;
        if (tb) {
            float am = 0.f;
#pragma unroll
            for (int j = 0; j < 4; ++j) am = fmaxf(am, fmaxf(fmaxf(fabsf(v[q][j].x), fabsf(v[q][j].y)), fmaxf(fabsf(v[q][j].z), fabsf(v[q][j].w))));
            am = wave_max(am);
            const float sc = am > 0.f ? am * (1.f / 224.f) : 1.f, inv = 1.f / sc;
#pragma unroll
            for (int j = 0; j < 4; ++j) { int w = 0; w = __builtin_amdgcn_cvt_pk_fp8_f32(v[q][j].x * inv, v[q][j].y * inv, w, false); w = __builtin_amdgcn_cvt_pk_fp8_f32(v[q][j].z * inv, v[q][j].w * inv, w, true);
                const int c = 32 * j + (lane >> 1);
                *(int*)(PV + ((size_t)(l * 128 + c) * NEXP + e) * 8 + 4 * (lane & 1)) = w; }
            if (lane == 0) PS[4 * NEXP + l * NEXP + e] = sc;
        } else {
#pragma unroll
            for (int j = 0; j < 4; ++j) {
                float am = fmaxf(fmaxf(fabsf(v[q][j].x), fabsf(v[q][j].y)), fmaxf(fabsf(v[q][j].z), fabsf(v[q][j].w)));
                am = fmaxf(am, __shfl_xor(am, 1)); am = fmaxf(am, __shfl_xor(am, 2)); am = fmaxf(am, __shfl_xor(am, 4));
                int ex = 0; if (am > 0.f) { (void)frexpf(am * (1.f / 6.f), &ex); }
                ex = ex < -126 ? -126 : (ex > 126 ? 126 : ex);
                const float inv = __builtin_bit_cast(float, (unsigned)(127 - ex) << 23);
                unsigned w16 = 0u;
#pragma unroll
                for (int c = 0; c < 4; ++c) { const float y = v[q][j][c] * inv, a_ = fabsf(y);
                    float cf = a_ < 2.f ? rintf(a_ * 2.f) : (a_ < 4.f ? 4.f + rintf(a_ - 2.f) : 6.f + rintf((a_ - 4.f) * 0.5f));
                    cf = fminf(cf, 7.f);
                    const unsigned s4 = (unsigned)(int)cf | (y < 0.f ? 8u : 0u);
                    w16 |= s4 << (4 * c); }
                const int qb = 8 * j + (lane >> 3), kc_ = qb & 3, m_ = qb >> 2;
#pragma unroll
                for (int t = 0; t < 2; ++t) { const int L = 16 * m_ + 2 * (lane & 7) + t;
                    scr[64 * (L >> 4) + 16 * kc_ + (L & 15)] = (unsigned char)((w16 >> (8 * t)) & 0xFFu); }
                if ((lane & 7) == 0) scr[512 + kc_ * 8 + m_] = (unsigned char)(ex + 127);
            }
            LDS_WAIT(); asm volatile("" ::: "memory");
            if (lane < 32) *(v4u*)(PU + ((size_t)l * NEXP + e) * 512 + 16 * lane) = *(const LAS v4u*)(scr + 16 * lane);
            else if (lane < 34) *(v4u*)(PU + (size_t)48 * MiB + ((size_t)l * NEXP + e) * 32 + 16 * (lane - 32)) = *(const LAS v4u*)(scr + 512 + 16 * (lane - 32));
            LDS_WAIT(); asm volatile("" ::: "memory");
        } } }
}

__device__ __forceinline__ void transpose_item(const float* W, int ldw, bf16* WT, int row_off, LAS float* scr, int item, int nblk, int lane) {
    const int kb = item / nblk, nb = item % nblk, k0 = 64 * kb, n0 = 32 * nb;
#pragma unroll 8
    for (int i = 0; i < 32; ++i) { const int kk = 2 * i + (lane >> 5); scr[kk * 33 + (lane & 31)] = W[(size_t)(k0 + kk) * ldw + n0 + (lane & 31)]; }
    LDS_WAIT(); asm volatile("" ::: "memory");
    const int c = lane & 7;
#pragma unroll
    for (int j = 0; j < 4; ++j) { const int n = (lane >> 3) + 8 * j; const LAS float* s = scr + (8 * c) * 33 + n;
        v4u o; o.x = pk2(s[0 * 33], s[1 * 33]); o.y = pk2(s[2 * 33], s[3 * 33]); o.z = pk2(s[4 * 33], s[5 * 33]); o.w = pk2(s[6 * 33], s[7 * 33]);
        *(v4u*)(WT + (size_t)(row_off + n0 + n) * 1024 + k0 + 8 * c) = o; }
    LDS_WAIT(); asm volatile("" ::: "memory");
}

__device__ __forceinline__ void phase_prologue(Frame& F) {
    KARGS;
    LAS float* cact = (LAS float*)F.lds;
    LAS float* part = cact + 2048;
    {   const float* c = IN(1);
        for (int i = F.tid; i < 2048; i += NTHR) { const float v = c[i]; cact[i] = v / (1.f + expf(-v)); } }
    __syncthreads();
    {
        const float* ada_w = IN(2); const float* ada_b = IN(3); float* MOD = WSP(float, WS_MOD);
        for (int it = F.bid; it < 384; it += F.G) {
            const int l = it / 96, j0 = (it % 96) * 64;
            const float* wp = ada_w + ((size_t)l * 1024 + F.wave * 128) * 6144 + j0 + F.lane;
            float a0 = 0.f, a1 = 0.f;
#pragma unroll 8
            for (int k = 0; k < 128; ++k) { const float w = wp[(size_t)k * 6144]; a0 += cact[F.wave * 128 + k] * w; a1 += cact[1024 + F.wave * 128 + k] * w; }
            part[(F.wave * 2 + 0) * 64 + F.lane] = a0; part[(F.wave * 2 + 1) * 64 + F.lane] = a1;
            __syncthreads();
            if (F.tid < 128) { const int b = F.tid >> 6, col = F.tid & 63; float s = 0.f;
#pragma unroll
                for (int w = 0; w < 8; ++w) s += part[(w * 2 + b) * 64 + col];
                MOD[(l * 2 + b) * 6144 + j0 + col] = s + ada_b[l * 6144 + j0 + col]; }
            __syncthreads();
        }
    }
    {
        LAS float* scr = (LAS float*)(F.lds + 16384 + F.wave * 8448);
        const int gw = F.bid * NWAVES + F.wave, NGW = F.G * NWAVES;
        constexpr int I_A = 16 * 64, I_B = 16 * 64, I_C = 16 * 56, I_D = 16 * 32, I_E = 16 * 64;
        constexpr int NITEMS = 2 * I_A + 2 * I_B + 2 * I_C + 4 * I_D + 4 * I_E;
        for (int it = gw; it < NITEMS; it += NGW) {
            int r = it;
            if (r < 2 * I_A) { const int j = r / I_A; transpose_item(IN(6) + (size_t)j * 1024 * 2048, 2048, WSP(bf16, WS_WIN + (size_t)(2 * j) * 8 * MiB), 0, scr, r % I_A, 64, F.lane); continue; } r -= 2 * I_A;
            if (r < 2 * I_B) { const int j = r / I_B; transpose_item(IN(10) + (size_t)j * 1024 * ODD_LD, ODD_LD, WSP(bf16, WS_WIN + (size_t)(2 * j + 1) * 8 * MiB), 0, scr, r % I_B, 64, F.lane); continue; } r -= 2 * I_B;
            if (r < 2 * I_C) { const int j = r / I_C; transpose_item(IN(10) + (size_t)j * 1024 * ODD_LD + 2056, ODD_LD, WSP(bf16, WS_WIN + (size_t)(2 * j + 1) * 8 * MiB), 2048, scr, r % I_C, 56, F.lane); continue; } r -= 2 * I_C;
            if (r < 4 * I_D) { const int l = r / I_D; const int j = l >> 1; const float* src = (l & 1) ? IN(11) : IN(7);
                if ((l & 1) || (r % I_D) < 8 * 32) transpose_item(src + (size_t)j * 1024 * 1024, 1024, WSP(bf16, WS_WOUT + (size_t)l * 2 * MiB), 0, scr, r % I_D, 32, F.lane); continue; } r -= 4 * I_D;
            { const int l = r / I_E; transpose_item(IN(26) + (size_t)l * 1024 * 2048, 2048, WSP(bf16, WS_WQ + (size_t)l * 4 * MiB), 0, scr, r % I_E, 64, F.lane); }
        }
    }
    {
        const int gt = F.bid * NTHR + F.tid, NGT = F.G * NTHR;
        float* WF = WSP(float, WS_WF);
        for (int i = gt; i < 2 * 8 * 1024; i += NGT) { const int j = i >> 13, h = (i >> 10) & 7, k = i & 1023; WF[i] = IN(10)[((size_t)j * 1024 + k) * ODD_LD + 2048 + h]; }
        bf16* KEYS = WSP(bf16, WS_KEYS);
        for (int i = gt; i < 4 * 16384; i += NGT) { const int l = i >> 14, r = i & 16383;
            KEYS[(size_t)(l * 2 + 0) * 16384 + r] = (bf16)f2bf(IN(27)[i]); KEYS[(size_t)(l * 2 + 1) * 16384 + r] = (bf16)f2bf(IN(28)[i]); }
        for (int i = gt; i < 2 * 512 * 256; i += NGT) { const int j = i >> 17, ch = (i >> 8) & 511, k = i & 255; bf16* dst = WSP(bf16, WS_LORA) + (size_t)j * 131072;
            if (k < 64) dst[ch * 64 + k] = (bf16)f2bf(IN(17)[((size_t)j * 64 + k) * 512 + ch]);
            else if (k < 128) dst[32768 + ch * 64 + (k - 64)] = (bf16)f2bf(IN(19)[((size_t)j * 64 + (k - 64)) * 512 + ch]);
            else dst[65536 + ch * 128 + (k - 128)] = (bf16)f2bf(IN(20)[((size_t)j * 128 + (k - 128)) * 512 + ch]); }
        {   LAS float* pwl = (LAS float*)(F.lds + 98304);
            for (int it = (F.bid + F.G - 128 % F.G) % F.G; it < 128; it += F.G) { const int j = it >> 6, g = (it >> 4) & 3, cq = (it >> 1) & 7, nh = it & 1;
                __syncthreads();
                for (int i = F.tid; i < 2048; i += NTHR) { const int d = i >> 4, cc = i & 15; pwl[i] = IN(8)[((size_t)(j * 4 + g) * 128 + cq * 16 + cc) * 128 + d] * IN(9)[j * 512 + g * 128 + d]; }
                __syncthreads();
                const int n = nh * 512 + F.tid; const float* wo = IN(7) + ((size_t)j * 1024 + 512 + g * 128) * 1024 + n;
                float acc[16];
#pragma unroll
                for (int cc = 0; cc < 16; ++cc) acc[cc] = 0.f;
#pragma unroll 8
                for (int d = 0; d < 128; ++d) { const float wv = wo[(size_t)d * 1024];
#pragma unroll
                    for (int q4 = 0; q4 < 4; ++q4) { const f32x4 p4 = *(const LAS f32x4*)(pwl + d * 16 + 4 * q4); acc[4 * q4] += p4.x * wv; acc[4 * q4 + 1] += p4.y * wv; acc[4 * q4 + 2] += p4.z * wv; acc[4 * q4 + 3] += p4.w * wv; } }
                v4u o0, o1; o0.x = pk2(acc[0], acc[1]); o0.y = pk2(acc[2], acc[3]); o0.z = pk2(acc[4], acc[5]); o0.w = pk2(acc[6], acc[7]);
                o1.x = pk2(acc[8], acc[9]); o1.y = pk2(acc[10], acc[11]); o1.z = pk2(acc[12], acc[13]); o1.w = pk2(acc[14], acc[15]);
                bf16* dst = WSP(bf16, WS_WOUT + (size_t)(2 * j) * 2 * MiB) + (size_t)n * 1024 + 512 + g * 128 + cq * 16;
                *(v4u*)dst = o0; *(v4u*)(dst + 8) = o1; }
            __syncthreads(); }
        {
            const int gw = F.bid * NWAVES + F.wave, NGW = F.G * NWAVES, lane = F.lane;
            for (int row0 = gw; row0 < 2 * NEXP; row0 += 4 * NGW) {
                f32x4 v[4][4];
                conv_issue<4>(IN(29), IN(30), 0, row0, NGW, lane, v);
                conv_finish<4>(WSP(unsigned char, WS_PU), WSP(unsigned char, WS_PV), WSP(float, WS_PS), 0, row0, NGW, lane, v, F.lds + 135168 + F.wave * 1024);
            }
        }
    }
}

__device__ __forceinline__ void phase_norm(Frame& F, int layer, int which) {
    KARGS;
    const float* X = (layer == 0 && which == 0) ? IN(0) : OUTP;
    const float* gain = (which ? IN(5) : IN(4)) + layer * 1024;
    const float* mod = WSP(float, WS_MOD) + (size_t)layer * 2 * 6144 + (which ? 3072 : 0);
    bf16* H = WSP(bf16, WS_H);
    const bool do_f = (layer & 1) && which == 0;
    const int jj = layer >> 1;
    const float* WF = WSP(float, WS_WF) + (size_t)jj * 8 * 1024;
    float* LOGF = WSP(float, WS_LOGF);
    const int gw = F.bid * NWAVES + F.wave, NGW = F.G * NWAVES, lane = F.lane;
    f32x4 gn[4];
#pragma unroll
    for (int j = 0; j < 4; ++j) gn[j] = *(const f32x4*)(gain + 256 * j + 4 * lane);
    for (int row = gw; row < T; row += NGW) {
        const int b = row >= SEQ ? 1 : 0;
        const float* sh = mod + b * 6144; const float* sc = sh + 1024;
        const float* xr = X + (size_t)row * D + 4 * lane;
        f32x4 v[4]; float ss = 0.f;
#pragma unroll
        for (int j = 0; j < 4; ++j) { v[j] = *(const f32x4*)(xr + 256 * j); ss += (v[j].x * v[j].x + v[j].y * v[j].y) + (v[j].z * v[j].z + v[j].w * v[j].w); }
        const float rstd = rsqrtf(wave_sum(ss) * (1.f / D) + NORM_EPS);
        bf16* hr = H + (size_t)row * D + 4 * lane;
#pragma unroll
        for (int j = 0; j < 4; ++j) { const f32x4 s4 = *(const f32x4*)(sc + 256 * j + 4 * lane), h4 = *(const f32x4*)(sh + 256 * j + 4 * lane);
            v[j] = v[j] * rstd * gn[j] * (s4 + 1.f) + h4;
            v2u o; o.x = pk2(v[j].x, v[j].y); o.y = pk2(v[j].z, v[j].w); *(v2u*)(hr + 256 * j) = o; }
        if (which == 1) {
            float am = 0.f;
#pragma unroll
            for (int j = 0; j < 4; ++j) am = fmaxf(am, fmaxf(fmaxf(fabsf(v[j].x), fabsf(v[j].y)), fmaxf(fabsf(v[j].z), fabsf(v[j].w))));
            am = wave_max(am); const float s8 = am > 0.f ? am * (1.f / 224.f) : 1.f, i8 = 1.f / s8;
            unsigned char* h8 = WSP(unsigned char, WS_H8) + (size_t)row * D + 4 * lane;
#pragma unroll
            for (int j = 0; j < 4; ++j) { int w8 = 0; w8 = __builtin_amdgcn_cvt_pk_fp8_f32(v[j].x * i8, v[j].y * i8, w8, false); w8 = __builtin_amdgcn_cvt_pk_fp8_f32(v[j].z * i8, v[j].w * i8, w8, true); *(int*)(h8 + 256 * j) = w8; }
            if (lane == 0) WSP(float, WS_HS)[row] = s8;
        }
        if (do_f) {
            const float* fb = IN(14) + jj * 8;
            const int t = row - b * SEQ;
#pragma unroll
            for (int hh = 0; hh < 8; ++hh) { float d = 0.f;
#pragma unroll
                for (int j = 0; j < 4; ++j) { const f32x4 w4 = *(const f32x4*)(WF + hh * 1024 + 256 * j + 4 * lane); d += (v[j].x * w4.x + v[j].y * w4.y) + (v[j].z * w4.z + v[j].w * w4.w); }
                d = wave_sum(d) + fb[hh];
                const float lf = fminf(d, 0.f) - log1pf(expf(-fabsf(d)));
                if (lane == 0) LOGF[(size_t)(b * 8 + hh) * SEQ + t] = lf; }
        }
    }
}

__device__ __forceinline__ void load_q64(float (&q)[64], const bf16* p, float scale) {
#pragma unroll
    for (int c = 0; c < 8; ++c) { const v4u w = *(const v4u*)(p + 8 * c);
        q[8 * c + 0] = bflo(w.x) * scale; q[8 * c + 1] = bfhi(w.x) * scale; q[8 * c + 2] = bflo(w.y) * scale; q[8 * c + 3] = bfhi(w.y) * scale;
        q[8 * c + 4] = bflo(w.z) * scale; q[8 * c + 5] = bfhi(w.z) * scale; q[8 * c + 6] = bflo(w.w) * scale; q[8 * c + 7] = bfhi(w.w) * scale; }
}
__device__ __forceinline__ float dot_q64(const float (&q)[64], const bf16* p) {
    float z0 = 0.f, z1 = 0.f;
#pragma unroll
    for (int c = 0; c < 8; ++c) { const v4u w = *(const v4u*)(p + 8 * c);
        z0 += q[8 * c + 0] * bflo(w.x) + q[8 * c + 2] * bflo(w.y) + q[8 * c + 4] * bflo(w.z) + q[8 * c + 6] * bflo(w.w);
        z1 += q[8 * c + 1] * bfhi(w.x) + q[8 * c + 3] * bfhi(w.y) + q[8 * c + 5] * bfhi(w.z) + q[8 * c + 7] * bfhi(w.w); }
    return z0 + z1;
}
#ifdef MK_SIMPLE_EVEN
__device__ __forceinline__ void phase_even_mixer_simple(Frame& F, int layer) {
    KARGS;
    const bf16* P = WSP(bf16, WS_PROJ); bf16* MIX = WSP(bf16, WS_MIX);
    const int lane = F.lane;
    {
        const int gw = F.bid * NWAVES + F.wave, NGW = F.G * NWAVES;
        for (int it = gw; it < BATCH * 8 * SEQ; it += NGW) {
            const int b = it >> 16, h = (it >> 13) & 7, t = it & 8191;
            const bf16* base = P + (size_t)b * SEQ * EVEN_IN;
            float q[64]; load_q64(q, base + (size_t)t * EVEN_IN + h * 64, 0.125f);
            float acc = 0.f, carry = 0.f;
            for (int s0 = t - 1; s0 >= 0; s0 -= 64) {
                const int s = s0 - lane; const bool valid = s >= 0; const int sc = valid ? s : 0;
                const float z = dot_q64(q, base + (size_t)sc * EVEN_IN + 512 + h * 64);
                const float sp = softplusf_(z);
                const float l1m = valid ? -sp : 0.f;
                const float lb = z - sp;
                float inc = l1m;
#pragma unroll
                for (int o = 1; o < 64; o <<= 1) { const float n = __shfl_up(inc, o); if (lane >= o) inc += n; }
                const float w = valid ? expf(lb + carry + (inc - l1m)) : 0.f;
                const float tot = __shfl(inc, 63);
#pragma unroll 16
                for (int j = 0; j < 64; ++j) { const float wj = rl(w, j); int sj = s0 - j; sj = sj < 0 ? 0 : sj;
                    acc += wj * bf2f(base[(size_t)sj * EVEN_IN + 1024 + h * 64 + lane]); }
                carry += tot;
                if (carry < -104.f) break;
            }
            MIX[((size_t)b * SEQ + t) * D + h * 64 + lane] = (bf16)f2bf(acc);
        }
    }
    {
        LAS float* pl = (LAS float*)F.lds;
        const int jj = layer >> 1;
        const float* pw = IN(8) + (size_t)jj * 4 * 128 * 128; const float* ps = IN(9) + jj * 512;
        const int c = F.tid, g = c >> 7, w = 2 << g, d = c & 127;
        for (int tile = F.bid; tile < T / 32; tile += F.G) {
            const int t0 = tile * 32, b = t0 / SEQ, tl0 = t0 % SEQ;
            const bf16* base = P + (size_t)b * SEQ * EVEN_IN + 1536 + c;
            for (int tt = 0; tt < 32; ++tt) { const int tl = tl0 + tt, cend = (tl / 64 + 1) * 64;
                int lo = tl - w / 2; lo = lo < 0 ? 0 : lo; int hi = tl + w / 2; hi = hi > cend ? cend : hi;
                float s = 0.f; for (int u = lo; u < hi; ++u) s += bf2f(base[(size_t)u * EVEN_IN]);
                pl[c * 33 + tt] = s / (float)(hi - lo) - bf2f(base[(size_t)tl * EVEN_IN]); }
            __syncthreads();
            float acc[32];
#pragma unroll
            for (int tt = 0; tt < 32; ++tt) acc[tt] = 0.f;
            for (int cc = 0; cc < 128; ++cc) { const float wv = pw[((size_t)g * 128 + cc) * 128 + d]; const LAS float* pr = pl + (g * 128 + cc) * 33;
#pragma unroll
                for (int tt = 0; tt < 32; ++tt) acc[tt] += pr[tt] * wv; }
            const float sc = ps[c];
#pragma unroll
            for (int tt = 0; tt < 32; ++tt) MIX[(size_t)(t0 + tt) * D + 512 + c] = (bf16)f2bf(acc[tt] * sc);
            __syncthreads();
        }
    }
}

#endif
typedef float f32x16 __attribute__((ext_vector_type(16)));
typedef short s16x4 __attribute__((ext_vector_type(4)));
#define MAX3F(a, b, c) __builtin_fmaxf(__builtin_fmaxf((a), (b)), (c))
#define ZERO16(a) do { _Pragma("unroll") for (int r_ = 0; r_ < 16; ++r_) a[r_] = 0.f; } while (0)
constexpr int FX_KROW = 144, FX_VROW = 192;
constexpr int FX_KB = 64 * FX_KROW, FX_VB = 64 * FX_VROW, FX_BUF = FX_KB + FX_VB + 256;
template <int HW> __device__ __forceinline__ void pool_chunk(const bf16* src, bf16* dst, int tl0) {
    float ps[HW + 65 + HW]; ps[0] = 0.f;
#pragma unroll
    for (int i = 0; i < 64 + HW; ++i) { const int tl = tl0 - HW + i; const float x = tl >= 0 ? bf2f(src[(long)(i - HW) * EVEN_IN]) : 0.f; ps[i + 1] = ps[i] + x; }
#pragma unroll
    for (int tt = 0; tt < 64; ++tt) { const int tl = tl0 + tt; int lo = tl - HW; lo = lo < 0 ? 0 : lo; const int hie = tt + HW > 64 ? 64 : tt + HW;
        const float sum = ps[hie + HW] - ps[tt]; const float x = ps[tt + HW + 1] - ps[tt + HW];
        dst[(size_t)tt * D] = (bf16)f2bf(sum / (float)(tl0 + hie - lo) - x); }
}
__device__ __forceinline__ void phase_even_mixer(Frame& F, int layer) {
    KARGS;
    const bf16* P = WSP(bf16, WS_PROJ); bf16* MIX = WSP(bf16, WS_MIX);
    const int tid = F.tid, lane = F.lane, wave = F.wave, r32 = lane & 31, hh = lane >> 5;
    const float LOG2E = 1.4426950408889634f, CS = 0.125f * LOG2E;
    const int srow = tid >> 3, sch = tid & 7;
    {
        const int c = tid, g = c >> 7;
        for (int ck = F.bid; ck < T / 64; ck += F.G) {
            const int t0 = ck * 64, tl0 = t0 % SEQ;
            const bf16* src = P + (size_t)t0 * EVEN_IN + 1536 + c; bf16* dst = MIX + (size_t)t0 * D + 512 + c;
            if (g == 0) pool_chunk<1>(src, dst, tl0); else if (g == 1) pool_chunk<2>(src, dst, tl0); else if (g == 2) pool_chunk<4>(src, dst, tl0); else pool_chunk<8>(src, dst, tl0);
        }
    }
    __syncthreads();
    for (int u = F.bid; u < 256; u += F.G) {
        for (int ui = 0; ui < 2; ++ui) {
            const int bh = u >> 4, ss = u & 15, qb = ui == 0 ? ss : 31 - ss, b = bh >> 3, h = bh & 7;
            const bf16* base = P + (size_t)b * SEQ * EVEN_IN;
            const int q0 = 256 * qb + 32 * wave, myq = q0 + r32;
            bf16x8 qf[4];
#pragma unroll
            for (int d0 = 0; d0 < 4; ++d0) qf[d0] = *(const bf16x8*)(base + (size_t)myq * EVEN_IN + h * 64 + 16 * d0 + 8 * hh);
            float carry = 0.f;
            f32x16 o[2];
#pragma unroll
            for (int r = 0; r < 16; ++r) { o[0][r] = 0.f; o[1][r] = 0.f; }
            const int jtop = 4 * qb + 3;
            v4u kreg = *(const v4u*)(base + (size_t)(64 * jtop + srow) * EVEN_IN + 512 + h * 64 + sch * 8);
            v4u vreg = *(const v4u*)(base + (size_t)(64 * jtop + srow) * EVEN_IN + 1024 + h * 64 + sch * 8);
            __syncthreads();
            *(LAS v4u*)(F.lds + srow * FX_KROW + sch * 16) = kreg; *(LAS v4u*)(F.lds + FX_KB + srow * FX_VROW + sch * 16) = vreg;
            if (tid < 16) ((LAS unsigned*)(F.lds + 2 * FX_BUF))[tid] = 0u;
            __syncthreads();
            int it = 0;
            for (int j = jtop; j >= 0; --j, ++it) {
                const int cur = (it & 1) * FX_BUF, nxt = ((it + 1) & 1) * FX_BUF;
                if (j > 0) { const size_t krow = (size_t)(64 * (j - 1) + srow) * EVEN_IN;
                    kreg = *(const v4u*)(base + krow + 512 + h * 64 + sch * 8); vreg = *(const v4u*)(base + krow + 1024 + h * 64 + sch * 8); }
                const bool started = 64 * j <= q0 + 30;
                const bool wprev = __all(carry < -150.f);
                if (started && !wprev) {
                    const LAS unsigned char* Kb = F.lds + cur; const LAS unsigned char* Vb = F.lds + cur + FX_KB;
                    f32x16 p0, p1;
#pragma unroll
                    for (int r = 0; r < 16; ++r) { p0[r] = 0.f; p1[r] = 0.f; }
#pragma unroll
                    for (int d0 = 0; d0 < 4; ++d0) {
                        const bf16x8 a0 = *(const LAS bf16x8*)(Kb + r32 * FX_KROW + 32 * d0 + 16 * hh);
                        const bf16x8 a1 = *(const LAS bf16x8*)(Kb + (r32 + 32) * FX_KROW + 32 * d0 + 16 * hh);
                        p0 = __builtin_amdgcn_mfma_f32_32x32x16_bf16(a0, qf[d0], p0, 0, 0, 0);
                        p1 = __builtin_amdgcn_mfma_f32_32x32x16_bf16(a1, qf[d0], p1, 0, 0, 0);
                    }
                    f32x16 l0, l1v;
#pragma unroll
                    for (int r = 0; r < 16; ++r) {
                        const int key = 64 * j + (r & 3) + 8 * (r >> 2) + 4 * hh;
                        const float za = p0[r] * CS, zb = p1[r] * CS;
                        const float sa = fmaxf(za, 0.f) + __builtin_amdgcn_logf(1.f + __builtin_amdgcn_exp2f(-fabsf(za)));
                        const float sb = fmaxf(zb, 0.f) + __builtin_amdgcn_logf(1.f + __builtin_amdgcn_exp2f(-fabsf(zb)));
                        l0[r] = -sa; l1v[r] = -sb; p0[r] = za - sa; p1[r] = zb - sb; (void)key;
                    }
                    if (64 * j + 63 >= q0) {
                        asm volatile("" ::: "memory");
#pragma unroll
                        for (int r = 0; r < 16; ++r) { const int key = 64 * j + (r & 3) + 8 * (r >> 2) + 4 * hh;
                            if (!(key < myq)) { l0[r] = 0.f; p0[r] = -INFINITY; } if (!(key + 32 < myq)) { l1v[r] = 0.f; p1[r] = -INFINITY; } }
                    }
                    float tot[8], oth[8];
#pragma unroll
                    for (int g = 0; g < 4; ++g) { tot[g] = (l0[4 * g] + l0[4 * g + 1]) + (l0[4 * g + 2] + l0[4 * g + 3]); tot[4 + g] = (l1v[4 * g] + l1v[4 * g + 1]) + (l1v[4 * g + 2] + l1v[4 * g + 3]); }
#pragma unroll
                    for (int g = 0; g < 8; ++g) oth[g] = __shfl_xor(tot[g], 32);
                    float sfx[8]; float run = 0.f;
#pragma unroll
                    for (int x = 7; x >= 0; --x) { sfx[x] = run; run += tot[x] + oth[x]; }
#pragma unroll
                    for (int x = 0; x < 8; ++x) {
                        const float goff = carry + sfx[x] + (hh == 0 ? oth[x] : 0.f);
                        if (x < 4) { const float s3 = goff, s2 = s3 + l0[4 * x + 3], s1 = s2 + l0[4 * x + 2], s0 = s1 + l0[4 * x + 1];
                            p0[4 * x] = __builtin_amdgcn_exp2f(p0[4 * x] + s0); p0[4 * x + 1] = __builtin_amdgcn_exp2f(p0[4 * x + 1] + s1); p0[4 * x + 2] = __builtin_amdgcn_exp2f(p0[4 * x + 2] + s2); p0[4 * x + 3] = __builtin_amdgcn_exp2f(p0[4 * x + 3] + s3); }
                        else { const int y = x - 4; const float s3 = goff, s2 = s3 + l1v[4 * y + 3], s1 = s2 + l1v[4 * y + 2], s0 = s1 + l1v[4 * y + 1];
                            p1[4 * y] = __builtin_amdgcn_exp2f(p1[4 * y] + s0); p1[4 * y + 1] = __builtin_amdgcn_exp2f(p1[4 * y + 1] + s1); p1[4 * y + 2] = __builtin_amdgcn_exp2f(p1[4 * y + 2] + s2); p1[4 * y + 3] = __builtin_amdgcn_exp2f(p1[4 * y + 3] + s3); }
                    }
                    carry += run;
                    bf16x8 pf[4];
#pragma unroll
                    for (int s4 = 0; s4 < 4; ++s4) {
                        v4u w;
                        if (s4 < 2) { w.x = pk2(p0[8 * s4 + 0], p0[8 * s4 + 1]); w.y = pk2(p0[8 * s4 + 2], p0[8 * s4 + 3]); w.z = pk2(p0[8 * s4 + 4], p0[8 * s4 + 5]); w.w = pk2(p0[8 * s4 + 6], p0[8 * s4 + 7]); }
                        else { const int sp = s4 - 2; w.x = pk2(p1[8 * sp + 0], p1[8 * sp + 1]); w.y = pk2(p1[8 * sp + 2], p1[8 * sp + 3]); w.z = pk2(p1[8 * sp + 4], p1[8 * sp + 5]); w.w = pk2(p1[8 * sp + 6], p1[8 * sp + 7]); }
                        pf[s4] = __builtin_bit_cast(bf16x8, w);
                    }
                    const int gi = lane >> 4, li = lane & 15;
                    const LAS unsigned char* vbase = Vb + (4 * (gi >> 1) + (li >> 2)) * FX_VROW + (16 * (gi & 1) + 4 * (li & 3)) * 2;
#pragma unroll
                    for (int d0 = 0; d0 < 2; ++d0)
#pragma unroll
                        for (int s4 = 0; s4 < 4; ++s4) {
                            const s16x4 lo = __builtin_bit_cast(s16x4, __builtin_amdgcn_ds_read_tr16_b64_v4i16((LAS s16x4*)(vbase + (16 * s4) * FX_VROW + 64 * d0)));
                            const s16x4 hi = __builtin_bit_cast(s16x4, __builtin_amdgcn_ds_read_tr16_b64_v4i16((LAS s16x4*)(vbase + (16 * s4 + 8) * FX_VROW + 64 * d0)));
                            const bf16x8 vf = (bf16x8){lo[0], lo[1], lo[2], lo[3], hi[0], hi[1], hi[2], hi[3]};
                            o[d0] = __builtin_amdgcn_mfma_f32_32x32x16_bf16(vf, pf[s4], o[d0], 0, 0, 0);
                        }
                }
                const bool wdone = started && __all(carry < -150.f);
                if (lane == 0) ((LAS unsigned*)(F.lds + 2 * FX_BUF))[(it & 1) * 8 + wave] = wdone ? 1u : 0u;
                if (j > 0) { *(LAS v4u*)(F.lds + nxt + srow * FX_KROW + sch * 16) = kreg; *(LAS v4u*)(F.lds + nxt + FX_KB + srow * FX_VROW + sch * 16) = vreg; }
                LBAR();
                const LAS unsigned* fl = (const LAS unsigned*)(F.lds + 2 * FX_BUF) + (it & 1) * 8;
                const unsigned alld = fl[0] & fl[1] & fl[2] & fl[3] & fl[4] & fl[5] & fl[6] & fl[7];
                if (alld) break;
            }
            bf16* op = MIX + ((size_t)b * SEQ + myq) * D + h * 64;
#pragma unroll
            for (int d0 = 0; d0 < 2; ++d0)
#pragma unroll
                for (int g = 0; g < 4; ++g) { const int db = 32 * d0 + 8 * g + 4 * hh;
                    v2u ow; ow.x = pk2(o[d0][4 * g + 0], o[d0][4 * g + 1]); ow.y = pk2(o[d0][4 * g + 2], o[d0][4 * g + 3]); *(v2u*)(op + db) = ow; }
        }
    }
}

__device__ __forceinline__ void phase_odd_prep(Frame& F, int layer, int parts) {
    KARGS;
    const int jj = layer >> 1, lane = F.lane, tid = F.tid, w = F.wave, r32 = lane & 31, hh = lane >> 5;
    bf16* P = WSP(bf16, WS_PROJ);
    if (F.bid < 16 && (parts & 4)) {
        const float* lf = WSP(float, WS_LOGF) + (size_t)F.bid * SEQ + 1024 * w; float* dc = WSP(float, WS_DCUM) + (size_t)F.bid * SEQ + 1024 * w;
        float inc[16];
#pragma unroll
        for (int i = 0; i < 16; ++i) inc[i] = lf[64 * i + lane];
        double offs[16]; double carry = 0.0;
#pragma unroll
        for (int i = 0; i < 16; ++i) {
#pragma unroll
            for (int o = 1; o < 64; o <<= 1) { const float n = __shfl_up(inc[i], o); if (lane >= o) inc[i] += n; }
            offs[i] = carry; carry += (double)__shfl(inc[i], 63); }
        LAS double* wt = (LAS double*)F.lds;
        if (lane == 0) wt[w] = carry;
        __syncthreads();
        double base = 0.0;
#pragma unroll
        for (int ww = 0; ww < 8; ++ww) if (ww < w) base += wt[ww];
#pragma unroll
        for (int i = 0; i < 16; ++i) dc[64 * i + lane] = (float)(base + offs[i] + (double)inc[i]);
        __syncthreads();
    }
    constexpr int LXP = 528;
    LAS unsigned char* lx = F.lds;
    const float* mix = IN(15) + jj * 1792;
    const float* w0 = IN(16) + jj * 512; const float* a0 = IN(18) + jj * 512;
    const float* kkp = IN(21) + jj * 512; const float* kap = IN(22) + jj * 512;
    const float* qn = IN(12) + jj * 64; const float* kn = IN(13) + jj * 64;
    const bf16* LT = WSP(bf16, WS_LORA) + (size_t)jj * 131072;
    float* R = WSP(float, WS_RW); float* LWp = WSP(float, WS_RW + RW_SLOT); float* K = WSP(float, WS_RW + 2 * RW_SLOT); float* V = WSP(float, WS_RW + 3 * RW_SLOT);
    float* KK = WSP(float, WS_RW + 4 * RW_SLOT); float* A = WSP(float, WS_RW + 5 * RW_SLOT); float* Gt = WSP(float, WS_RW + 6 * RW_SLOT);
    for (int item = F.bid; item < T / 64; item += F.G) {
        const int t0 = item * 64;
        if (parts & 1) {
        for (int i = tid; i < 64 * 32; i += NTHR) { const int tt = i >> 5, j8 = 8 * (i & 31), tg = t0 + tt, tl = tg % SEQ, col = 1536 + j8;
            const v4u cw = *(const v4u*)(P + (size_t)tg * ODD_N + 2048 + col); v4u pw = (v4u){0u, 0u, 0u, 0u}; if (tl > 0) pw = *(const v4u*)(P + (size_t)(tg - 1) * ODD_N + 2048 + col);
            const f32x4 m0 = *(const f32x4*)(mix + col), m1 = *(const f32x4*)(mix + col + 4);
            v4u ow;
#pragma unroll
            for (int q = 0; q < 4; ++q) { const float c0 = bflo(cw[q]), c1 = bfhi(cw[q]), p0 = bflo(pw[q]), p1 = bfhi(pw[q]);
                const float mm0 = q < 2 ? m0[2 * q] : m1[2 * q - 4], mm1 = q < 2 ? m0[2 * q + 1] : m1[2 * q - 3];
                const float x0 = c0 + (p0 - c0) * mm0, x1 = c1 + (p1 - c1) * mm1;
                ow[q] = j8 < 64 ? pk2(tanhf(x0), tanhf(x1)) : (j8 < 128 ? pk2(x0, x1) : pk2(sigmoidf_(x0), sigmoidf_(x1))); }
            *(LAS v4u*)(lx + tt * LXP + j8 * 2) = ow; }
        __syncthreads();
#pragma unroll 1
        for (int L = 0; L < 3; ++L) {
            const int koff = L == 0 ? 0 : (L == 1 ? 64 : 128), ksteps = L == 2 ? 8 : 4, kdim = L == 2 ? 128 : 64;
            const bf16* Wt = LT + (L == 0 ? 0 : (L == 1 ? 32768 : 65536));
            float* dst = L == 0 ? LWp : (L == 1 ? A : Gt);
            f32x16 acc[2][2];
#pragma unroll
            for (int a_ = 0; a_ < 2; ++a_)
#pragma unroll
                for (int b_ = 0; b_ < 2; ++b_) ZERO16(acc[a_][b_]);
#pragma unroll 1
            for (int s4 = 0; s4 < ksteps; ++s4) {
                bf16x8 af[2], bfr[2];
#pragma unroll
                for (int tm = 0; tm < 2; ++tm) af[tm] = *(const LAS bf16x8*)(lx + (32 * tm + r32) * LXP + (koff + 16 * s4 + 8 * hh) * 2);
#pragma unroll
                for (int tn = 0; tn < 2; ++tn) bfr[tn] = *(const bf16x8*)(Wt + (size_t)(64 * w + 32 * tn + r32) * kdim + 16 * s4 + 8 * hh);
#pragma unroll
                for (int tm = 0; tm < 2; ++tm)
#pragma unroll
                    for (int tn = 0; tn < 2; ++tn) acc[tm][tn] = __builtin_amdgcn_mfma_f32_32x32x16_bf16(af[tm], bfr[tn], acc[tm][tn], 0, 0, 0);
            }
#pragma unroll
            for (int tn = 0; tn < 2; ++tn)
#pragma unroll
                for (int tm = 0; tm < 2; ++tm) { float* dp = dst + (size_t)(t0 + 32 * tm + 4 * hh) * 512 + 64 * w + 32 * tn + r32;
#pragma unroll
                    for (int r = 0; r < 16; ++r) dp[(size_t)((r & 3) + 8 * (r >> 2)) * 512] = acc[tm][tn][r]; }
        }
        asm volatile("s_waitcnt vmcnt(0)" ::: "memory");
        __syncthreads();
        }
        if (parts & 2) {
            LAS float* nrm = (LAS float*)(F.lds + 40960);
            {
                const int tt = tid >> 3, hd = tid & 7, tg = t0 + tt, tl = tg % SEQ;
                const bf16* bp = P + (size_t)tg * ODD_N + hd * 64;
                float qs = 0.f, ks = 0.f, n2 = 0.f;
#pragma unroll 2
                for (int c = 0; c < 8; ++c) {
                    const v4u wq = *(const v4u*)(bp + 8 * c), wk = *(const v4u*)(bp + 512 + 8 * c), wc = *(const v4u*)(bp + 2048 + 512 + 8 * c);
                    v4u wp = (v4u){0u, 0u, 0u, 0u}; if (tl > 0) wp = *(const v4u*)(bp - ODD_N + 2048 + 512 + 8 * c);
                    const f32x4 mk0 = *(const f32x4*)(mix + 512 + hd * 64 + 8 * c), mk1 = *(const f32x4*)(mix + 512 + hd * 64 + 8 * c + 4);
                    const f32x4 kc0 = *(const f32x4*)(kkp + hd * 64 + 8 * c), kc1 = *(const f32x4*)(kkp + hd * 64 + 8 * c + 4);
#pragma unroll
                    for (int i = 0; i < 4; ++i) {
                        const float q0 = bflo(wq[i]), q1 = bfhi(wq[i]), k0 = bflo(wk[i]), k1 = bfhi(wk[i]);
                        qs += q0 * q0 + q1 * q1; ks += k0 * k0 + k1 * k1;
                        const float c0 = bflo(wc[i]), c1 = bfhi(wc[i]), p0 = bflo(wp[i]), p1 = bfhi(wp[i]);
                        const float m0 = i < 2 ? mk0[2 * i] : mk1[2 * i - 4], m1 = i < 2 ? mk0[2 * i + 1] : mk1[2 * i - 3];
                        const float g0 = i < 2 ? kc0[2 * i] : kc1[2 * i - 4], g1 = i < 2 ? kc0[2 * i + 1] : kc1[2 * i - 3];
                        const float x0 = (c0 + (p0 - c0) * m0) * g0, x1 = (c1 + (p1 - c1) * m1) * g1;
                        n2 += x0 * x0 + x1 * x1; }
                }
                *(LAS f32x4*)(nrm + (tt * 8 + hd) * 4) = (f32x4){rsqrtf(qs * (1.f / 64.f) + NORM_EPS), rsqrtf(ks * (1.f / 64.f) + NORM_EPS), 1.f / fmaxf(sqrtf(n2), 1e-12f), 0.f};
            }
            __syncthreads();
            const int c4 = 4 * (tid & 127), hd = c4 >> 6, th = tid >> 7;
            const f32x4 mr = *(const f32x4*)(mix + c4), mk = *(const f32x4*)(mix + 512 + c4), mv = *(const f32x4*)(mix + 1024 + c4);
            const f32x4 kk4 = *(const f32x4*)(kkp + c4), ka4 = *(const f32x4*)(kap + c4), w04 = *(const f32x4*)(w0 + c4), a04 = *(const f32x4*)(a0 + c4);
            const f32x4 qn4 = *(const f32x4*)(qn + (c4 & 63)), kn4 = *(const f32x4*)(kn + (c4 & 63));
#pragma unroll 2
            for (int t2 = 0; t2 < 16; ++t2) { const int tt = 16 * th + t2, tg = t0 + tt, tl = tg % SEQ;
                const bf16* pc = P + (size_t)tg * ODD_N + 2048 + c4; const bf16* pp = pc - ODD_N;
                const size_t o = (size_t)tg * 512 + c4;
                const f32x4 wraw = *(const f32x4*)(LWp + o), araw = *(const f32x4*)(A + o);
                const v2u rc = *(const v2u*)pc, kc = *(const v2u*)(pc + 512), vc = *(const v2u*)(pc + 1024);
                v2u rp = (v2u){0u, 0u}, kp = rp, vp = rp; if (tl > 0) { rp = *(const v2u*)pp; kp = *(const v2u*)(pp + 512); vp = *(const v2u*)(pp + 1024); }
                bf16* pq = P + (size_t)tg * ODD_N + c4;
                const v2u qw = *(const v2u*)pq, kw = *(const v2u*)(pq + 512);
                const f32x4 nm = *(const LAS f32x4*)(nrm + (tt * 8 + hd) * 4);
                f32x4 R4, V4, KK4, LW4, A4, K4; float qo[4], ko[4];
#pragma unroll
                for (int e = 0; e < 4; ++e) {
                    const float rcv = (e & 1) ? bfhi(rc[e >> 1]) : bflo(rc[e >> 1]), rpv = (e & 1) ? bfhi(rp[e >> 1]) : bflo(rp[e >> 1]);
                    const float kcv = (e & 1) ? bfhi(kc[e >> 1]) : bflo(kc[e >> 1]), kpv = (e & 1) ? bfhi(kp[e >> 1]) : bflo(kp[e >> 1]);
                    const float vcv = (e & 1) ? bfhi(vc[e >> 1]) : bflo(vc[e >> 1]), vpv = (e & 1) ? bfhi(vp[e >> 1]) : bflo(vp[e >> 1]);
                    const float qv = (e & 1) ? bfhi(qw[e >> 1]) : bflo(qw[e >> 1]), kv = (e & 1) ? bfhi(kw[e >> 1]) : bflo(kw[e >> 1]);
                    const float r = rcv + (rpv - rcv) * mr[e], k = kcv + (kpv - kcv) * mk[e], v = vcv + (vpv - vcv) * mv[e];
                    const float wl = -softplusf_(-(w04[e] + wraw[e])) - 0.5f, av = sigmoidf_(a04[e] + araw[e]);
                    R4[e] = r; V4[e] = v; KK4[e] = k * kk4[e] * nm.z; LW4[e] = -expf(wl); A4[e] = av; K4[e] = k * (1.f + (av - 1.f) * ka4[e]);
                    qo[e] = qv * nm.x * qn4[e]; ko[e] = kv * nm.y * kn4[e]; }
                *(f32x4*)(R + o) = R4; *(f32x4*)(V + o) = V4; *(f32x4*)(KK + o) = KK4; *(f32x4*)(LWp + o) = LW4; *(f32x4*)(A + o) = A4; *(f32x4*)(K + o) = K4;
                v2u qv2, kv2; qv2.x = pk2(qo[0], qo[1]); qv2.y = pk2(qo[2], qo[3]); kv2.x = pk2(ko[0], ko[1]); kv2.y = pk2(ko[2], ko[3]);
                *(v2u*)pq = qv2; *(v2u*)(pq + 512) = kv2; }
        }
        __syncthreads();
    }
}

constexpr int CP = 144;
constexpr int CM = 64 * CP;
__device__ __forceinline__ void mm_nt(f32x16& acc, const LAS unsigned char* A, const LAS unsigned char* B, int m0, int n0, int r32, int hh) {
#pragma unroll
    for (int s4 = 0; s4 < 4; ++s4) { const bf16x8 a = *(const LAS bf16x8*)(A + (m0 + r32) * CP + 32 * s4 + 16 * hh); const bf16x8 b = *(const LAS bf16x8*)(B + (n0 + r32) * CP + 32 * s4 + 16 * hh);
        acc = __builtin_amdgcn_mfma_f32_32x32x16_bf16(a, b, acc, 0, 0, 0); }
}
__device__ __forceinline__ void store_t(LAS unsigned char* Dst, const f32x16& acc, int m0, int n0, int r32, int hh, float sg) {
#pragma unroll
    for (int g = 0; g < 4; ++g) { v2u w; w.x = pk2(sg * acc[4 * g], sg * acc[4 * g + 1]); w.y = pk2(sg * acc[4 * g + 2], sg * acc[4 * g + 3]); *(LAS v2u*)(Dst + (n0 + r32) * CP + (m0 + 8 * g + 4 * hh) * 2) = w; }
}
__device__ __forceinline__ void load_t(f32x16& acc, const LAS unsigned char* Src, int m0, int n0, int r32, int hh, float sg) {
#pragma unroll
    for (int g = 0; g < 4; ++g) { const v2u w = *(const LAS v2u*)(Src + (n0 + r32) * CP + (m0 + 8 * g + 4 * hh) * 2);
        acc[4 * g] = sg * bflo(w.x); acc[4 * g + 1] = sg * bfhi(w.x); acc[4 * g + 2] = sg * bflo(w.y); acc[4 * g + 3] = sg * bfhi(w.y); }
}
__device__ __forceinline__ void mask16(f32x16& acc, int m0, int n0, int r32, int hh, int mode) {
    const int n = n0 + r32;
#pragma unroll
    for (int r = 0; r < 16; ++r) { const int m = m0 + (r & 3) + 8 * (r >> 2) + 4 * hh; const bool keep = mode == 0 ? (n < m) : (mode == 1 ? (m < n) : (m <= n)); acc[r] = keep ? acc[r] : 0.f; }
}
__device__ __forceinline__ void phase_rwkv_chunk(Frame& F, int layer, int qoff = 0, int parts = 15) {
    KARGS;
    const float* R = WSP(float, WS_RW); const float* LW = WSP(float, WS_RW + RW_SLOT); const float* K = WSP(float, WS_RW + 2 * RW_SLOT); const float* V = WSP(float, WS_RW + 3 * RW_SLOT);
    const float* KK = WSP(float, WS_RW + 4 * RW_SLOT); const float* A = WSP(float, WS_RW + 5 * RW_SLOT);
    bf16* CGp = WSP(bf16, WS_CG); bf16* CQp = WSP(bf16, WS_CQ); float* CHp = WSP(float, WS_CH); float* CYp = WSP(float, WS_CY);
    const int tid = F.tid, lane = F.lane, w = F.wave, r32 = lane & 31, hh = lane >> 5;
    LAS unsigned char* L = F.lds;
    LAS unsigned char* Ab = L, *Bb = L + CM, *Kb = L + 2 * CM, *Rb = L + 3 * CM, *BtT = L + 4 * CM, *KtT = L + 5 * CM, *VT = L + 6 * CM;
    LAS unsigned char* XT0 = L + 7 * CM, *XT1 = L + 9 * CM;
    LAS unsigned char* NB = L + 11 * CM;
    LAS unsigned char* Prb = L + 15 * CM;
    LAS float* tot = (LAS float*)(L + 16 * CM);
    LAS float* gCl = tot + 512;
    const int myx = (int)((unsigned)__builtin_amdgcn_s_getreg((3 << 11) | 20) & 7u);
    unsigned* qh = (unsigned*)F.ctl + CW_CHQ + qoff + layer * 8 * 64;
    for (int dx = 0; dx < 8; ++dx) { const int xs = (myx + dx) & 7;
    for (;;) {
        LBAR();
        if (tid == 0) F.MISC[20] = atomicAdd(qh + xs * 64, 1u);
        LBAR();
        const int kq = (int)F.MISC[20];
        if (kq >= 256) break;
        const int bh = xs + 8 * (kq >> 7), c = kq & 127, b = bh >> 3, h = bh & 7;
        {
            const size_t g0 = ((size_t)b * SEQ + c * 64 + 8 * w) * 512 + h * 64 + lane;
            float lw[8], cum[8]; float run = 0.f;
#pragma unroll
            for (int i = 0; i < 8; ++i) { lw[i] = LW[g0 + (size_t)i * 512]; run += lw[i]; cum[i] = run; }
            tot[w * 64 + lane] = run;
            LBAR();
            float off = 0.f, all = 0.f;
#pragma unroll
            for (int ww = 0; ww < 8; ++ww) { const float tv = tot[ww * 64 + lane]; if (ww < w) off += tv; all += tv; }
            if (w == 0) gCl[lane] = expf(all);
#pragma unroll
            for (int i = 0; i < 8; ++i) {
                const int t = 8 * w + i; const float cm = cum[i] + off;
                const float g = expf(cm), gex = expf(cm - lw[i]), gi = expf(-cm), gcg = expf(all - cm);
                const size_t gg = g0 + (size_t)i * 512;
                const float r = R[gg], k = K[gg], v = V[gg], kk = KK[gg], a = A[gg];
                const bf16 ab = (bf16)f2bf(kk * gex), bb = (bf16)f2bf(kk * a * gi), kb = (bf16)f2bf(k * gi), rb = (bf16)f2bf(r * g), bt = (bf16)f2bf(kk * a * gcg), kt = (bf16)f2bf(k * gcg), vb = (bf16)f2bf(v);
                *(LAS bf16*)(Ab + t * CP + lane * 2) = ab; *(LAS bf16*)(Bb + t * CP + lane * 2) = bb; *(LAS bf16*)(Kb + t * CP + lane * 2) = kb; *(LAS bf16*)(Rb + t * CP + lane * 2) = rb;
                *(LAS bf16*)(XT0 + lane * CP + t * 2) = ab; *(LAS bf16*)(BtT + lane * CP + t * 2) = bt; *(LAS bf16*)(KtT + lane * CP + t * 2) = kt; *(LAS bf16*)(VT + lane * CP + t * 2) = vb;
            }
            LBAR();
        }
        if (!(parts & 2)) continue;
        int r32m = r32; asm volatile("" : "+v"(r32m));
        const int xtm = w & 1, xtn = w >> 1;
        f32x16 xacc;
        {
#pragma unroll
            for (int qq = 0; qq < 2; ++qq) {
                int q; if (w < 4) q = 2 * w + qq; else { if (qq == 1) break; q = 8 + (w - 4); }
                const int pr = q >> 2, tm = (q >> 1) & 1, tn = q & 1; f32x16 acc; ZERO16(acc);
                if (pr == 0) { mm_nt(acc, Ab, Bb, 32 * tm, 32 * tn, r32, hh); mask16(acc, 32 * tm, 32 * tn, r32m, hh, 0); store_t(NB + 1 * CM, acc, 32 * tm, 32 * tn, r32, hh, -1.f); }
                else if (pr == 1) { mm_nt(acc, Bb, Ab, 32 * tm, 32 * tn, r32, hh); mask16(acc, 32 * tm, 32 * tn, r32m, hh, 1); store_t(NB + 0 * CM, acc, 32 * tm, 32 * tn, r32, hh, -1.f); }
                else { mm_nt(acc, Bb, Rb, 32 * tm, 32 * tn, r32, hh); mask16(acc, 32 * tm, 32 * tn, r32m, hh, 2); store_t(Prb, acc, 32 * tm, 32 * tn, r32, hh, 1.f); }
            }
            if (xtn >= 2) { ZERO16(xacc); mm_nt(xacc, Ab, Kb, 32 * xtm, 32 * (xtn - 2), r32, hh); mask16(xacc, 32 * xtm, 32 * (xtn - 2), r32m, hh, 0); store_t(XT0 + 64 * CP, xacc, 32 * xtm, 32 * (xtn - 2), r32, hh, 1.f); }
            else load_t(xacc, XT0, 32 * xtm, 32 * xtn, r32, hh, 1.f);
            LBAR();
        }
        if (!(parts & 4)) continue;
        LAS unsigned char* XTc = XT0; LAS unsigned char* XTn = XT1; int nb = 0;
#pragma unroll 1
        for (int j = 0; j < 6; ++j) {
            const LAS unsigned char* Nc = NB + (2 * nb) * CM; const LAS unsigned char* NTc = NB + (2 * nb + 1) * CM;
            mm_nt(xacc, Nc, XTc, 32 * xtm, 32 * xtn, r32, hh);
            store_t(XTn, xacc, 32 * xtm, 32 * xtn, r32, hh, 1.f);
            if (j < 5) { const int tm = (w >> 1) & 1, tn = w & 1; f32x16 acc; ZERO16(acc);
                if (w < 4) { mm_nt(acc, Nc, NTc, 32 * tm, 32 * tn, r32, hh); store_t(NB + (2 * (nb ^ 1) + 1) * CM, acc, 32 * tm, 32 * tn, r32, hh, 1.f); }
                else       { mm_nt(acc, NTc, Nc, 32 * tm, 32 * tn, r32, hh); store_t(NB + (2 * (nb ^ 1)) * CM, acc, 32 * tm, 32 * tn, r32, hh, 1.f); } }
            LBAR();
            { LAS unsigned char* t_ = XTc; XTc = XTn; XTn = t_; } nb ^= 1;
        }
        if (!(parts & 8)) continue;
        const size_t cbase = (size_t)(bh * 128 + c) * 4096;
#pragma unroll
        for (int qq = 0; qq < 2; ++qq) {
            const int q = 2 * w + qq, pr = q >> 2, tm = (q >> 1) & 1, tn = q & 1, m0 = 32 * tm, n0 = 32 * tn; f32x16 acc;
            if (pr == 0) {
                load_t(acc, Rb, m0, n0, r32, hh, -1.f); mm_nt(acc, XTc, Prb, m0, n0, r32, hh);
#pragma unroll
                for (int g = 0; g < 4; ++g) { v2u o; o.x = pk2(-acc[4 * g], -acc[4 * g + 1]); o.y = pk2(-acc[4 * g + 2], -acc[4 * g + 3]);
                    *(v2u*)(CQp + cbase + (size_t)((((tn * 4 + 2 * tm + (g >> 1)) * 2 + (g & 1)) * 32 + r32) * 8 + hh * 4)) = o; }
            } else if (pr == 1) {
                ZERO16(acc); mm_nt(acc, XTc, BtT, m0, n0, r32, hh);
                const int k1 = n0 + r32; const float gc = gCl[k1];
#pragma unroll
                for (int g = 0; g < 4; ++g) { float e[4];
#pragma unroll
                    for (int i = 0; i < 4; ++i) { const int k2 = m0 + 8 * g + 4 * hh + i; e[i] = (k2 == k1 ? gc : 0.f) - acc[4 * g + i]; }
                    v2u o; o.x = pk2(e[0], e[1]); o.y = pk2(e[2], e[3]);
                    *(v2u*)(CGp + cbase + (size_t)((((tn * 4 + 2 * tm + (g >> 1)) * 2 + (g & 1)) * 32 + r32) * 8 + hh * 4)) = o; }
            } else if (pr == 2) {
                load_t(acc, KtT, m0, n0, r32, hh, -1.f); mm_nt(acc, XTc + 64 * CP, BtT, m0, n0, r32, hh); store_t(NB, acc, m0, n0, r32, hh, -1.f);
            } else {
                f32x16 a1; ZERO16(a1); mm_nt(a1, Kb, Rb, m0, n0, r32, hh); mask16(a1, m0, n0, r32m, hh, 2);
                ZERO16(acc); mm_nt(acc, XTc + 64 * CP, Prb, m0, n0, r32, hh);
#pragma unroll
                for (int r = 0; r < 16; ++r) acc[r] = a1[r] - acc[r];
                store_t(NB + CM, acc, m0, n0, r32, hh, 1.f);
            }
        }
        LBAR();
        {
            const int ww = w & 3, tm = ww >> 1, tn = ww & 1, m0 = 32 * tm, n0 = 32 * tn; f32x16 acc; ZERO16(acc);
            mm_nt(acc, w < 4 ? NB : NB + CM, VT, m0, n0, r32, hh);
            bf16* dst = (bf16*)(w < 4 ? CHp : CYp) + cbase + (size_t)((tm * 2 + tn) * 4 * 64 + lane) * 4;
#pragma unroll
            for (int g = 0; g < 4; ++g) { v2u o; o.x = pk2(acc[4 * g], acc[4 * g + 1]); o.y = pk2(acc[4 * g + 2], acc[4 * g + 3]); *(v2u*)(dst + g * 256) = o; }
        }
        LBAR();
    }
    }
}

__device__ __forceinline__ void rwkv_scan(Frame& F, int bh, const int mode = 7) {
    KARGS;
    const unsigned char* CG8 = WSP(unsigned char, WS_CG) + (size_t)bh * 128 * 8192; const unsigned char* CQ8 = WSP(unsigned char, WS_CQ) + (size_t)bh * 128 * 8192;
    const unsigned char* CH8 = WSP(unsigned char, WS_CH) + (size_t)bh * 128 * 8192; const unsigned char* CY8 = WSP(unsigned char, WS_CY) + (size_t)bh * 128 * 8192;
    float* Y = WSP(float, WS_RW + 7 * RW_SLOT);
    const int lane = F.lane, w = F.wave, r32 = lane & 31, hh = lane >> 5, b = bh >> 3, h = bh & 7;
    LAS unsigned char* S0 = F.lds; LAS unsigned char* S1 = F.lds + CM;
    LAS unsigned char* RING = F.lds + 2 * CM;
    LAS float* YR = (LAS float*)(F.lds + 2 * CM + 3 * 32768);
    for (int i = F.tid; i < 2 * CM / 4; i += NTHR) ((LAS unsigned*)F.lds)[i] = 0u;
    __syncthreads();
#define SC_DMA(gsrc, ldst) __builtin_amdgcn_global_load_lds((const unsigned*)(gsrc), (LAS unsigned*)(ldst), 16, 0, 0)
    auto issue = [&](const int c) {
        LAS unsigned char* slot = RING + (c % 3) * 32768; const size_t go = (size_t)c * 8192 + lane * 16;
        if (w < 4) {
#pragma unroll
            for (int q = 0; q < 2; ++q) { const int p = 2 * w + q; SC_DMA(CG8 + go + p * 1024, slot + p * 1024); SC_DMA(CH8 + go + p * 1024, slot + 8192 + p * 1024); } }
        else if (w < 6) {
#pragma unroll
            for (int q = 0; q < 4; ++q) { const int p = 4 * (w - 4) + q; SC_DMA(CQ8 + go + p * 1024, slot + 16384 + p * 1024); SC_DMA(CY8 + go + p * 1024, slot + 24576 + p * 1024); } }
    };
    issue(0); issue(1);
    if (w < 4) asm volatile("s_waitcnt vmcnt(4)" ::: "memory"); else asm volatile("s_waitcnt vmcnt(8)" ::: "memory");
    LBAR();
    if (w < 4) {
        const int tm = w >> 1, tn = w & 1, m0 = 32 * tm, n0 = 32 * tn;
#pragma unroll 1
        for (int c = 0; c < 128; ++c) {
            const LAS unsigned char* slot = RING + (c % 3) * 32768;
            const LAS unsigned char* Sc = (c & 1) ? S1 : S0; LAS unsigned char* Sn = (c & 1) ? S0 : S1;
            f32x16 acc;
#pragma unroll
            for (int g = 0; g < 4; ++g) { const v2u iw = *(const LAS v2u*)(slot + 8192 + (((tm * 2 + tn) * 4 + g) * 64 + lane) * 8);
                acc[4 * g] = bflo(iw.x); acc[4 * g + 1] = bfhi(iw.x); acc[4 * g + 2] = bflo(iw.y); acc[4 * g + 3] = bfhi(iw.y); }
#pragma unroll
            for (int s4 = 0; s4 < 4; ++s4) { const bf16x8 a = *(const LAS bf16x8*)(slot + ((tm * 8 + hh) * 32 + r32) * 16 + 1024 * s4);
                const bf16x8 bb = *(const LAS bf16x8*)(Sc + (n0 + r32) * CP + 32 * s4 + 16 * hh); acc = __builtin_amdgcn_mfma_f32_32x32x16_bf16(a, bb, acc, 0, 0, 0); }
            store_t(Sn, acc, m0, n0, r32, hh, 1.f);
            if (c + 2 < 128) { issue(c + 2); asm volatile("s_waitcnt vmcnt(4)" ::: "memory"); } else asm volatile("s_waitcnt vmcnt(0)" ::: "memory");
            LBAR();
        }
        LBAR();
    } else if (w < 6) {
        const int tmY = w - 4, m0 = 32 * tmY;
#pragma unroll 1
        for (int c = 0; c < 128; ++c) {
            const LAS unsigned char* slot = RING + (c % 3) * 32768;
            const LAS unsigned char* Sc = (c & 1) ? S1 : S0; LAS float* yo = YR + (c & 1) * 4096;
            f32x16 acc[2]; bf16x8 a[4];
#pragma unroll
            for (int s4 = 0; s4 < 4; ++s4) a[s4] = *(const LAS bf16x8*)(slot + 16384 + ((tmY * 8 + hh) * 32 + r32) * 16 + 1024 * s4);
#pragma unroll
            for (int tn = 0; tn < 2; ++tn) {
#pragma unroll
                for (int g = 0; g < 4; ++g) { const v2u iw = *(const LAS v2u*)(slot + 24576 + (((tmY * 2 + tn) * 4 + g) * 64 + lane) * 8);
                    acc[tn][4 * g] = bflo(iw.x); acc[tn][4 * g + 1] = bfhi(iw.x); acc[tn][4 * g + 2] = bflo(iw.y); acc[tn][4 * g + 3] = bfhi(iw.y); }
#pragma unroll
                for (int s4 = 0; s4 < 4; ++s4) { const bf16x8 bb = *(const LAS bf16x8*)(Sc + (32 * tn + r32) * CP + 32 * s4 + 16 * hh); acc[tn] = __builtin_amdgcn_mfma_f32_32x32x16_bf16(a[s4], bb, acc[tn], 0, 0, 0); }
#pragma unroll
                for (int r = 0; r < 16; ++r) yo[(m0 + (r & 3) + 8 * (r >> 2) + 4 * hh) * 64 + 32 * tn + r32] = acc[tn][r];
            }
            if (c + 2 < 128) { issue(c + 2); asm volatile("s_waitcnt vmcnt(8)" ::: "memory"); } else asm volatile("s_waitcnt vmcnt(0)" ::: "memory");
            LBAR();
        }
        LBAR();
    } else {
        const int row0 = 32 * (w - 6) + (lane >> 4), cq = (lane & 15) * 4;
        float* yg = Y + ((size_t)b * SEQ + row0) * 512 + h * 64 + cq;
        LBAR();
#pragma unroll 1
        for (int c = 1; c <= 128; ++c) {
            const LAS float* yi = YR + ((c - 1) & 1) * 4096 + row0 * 64 + cq;
            f32x4 ty[8];
#pragma unroll
            for (int i = 0; i < 8; ++i) ty[i] = *(const LAS f32x4*)(yi + 4 * i * 64);
            asm volatile("s_waitcnt lgkmcnt(0)" ::: "memory");
#pragma unroll
            for (int i = 0; i < 8; ++i) *(f32x4*)(yg + (size_t)((c - 1) * 64 + 4 * i) * 512) = ty[i];
            LBAR();
        }
    }
#undef SC_DMA
}

__device__ __forceinline__ void phase_odd_main(Frame& F, int layer, int ctr_base, int parts) {
    KARGS;
    const bf16* P = WSP(bf16, WS_PROJ); bf16* MIX = WSP(bf16, WS_MIX); const float* DC = WSP(float, WS_DCUM);
    const int tid = F.tid, lane = F.lane, wave = F.wave, r32 = lane & 31, hh = lane >> 5;
    const float LOG2E = 1.4426950408889634f, CS = 0.125f * LOG2E;
    const int srow = tid >> 3, sch = tid & 7;
    const int myx = (int)((unsigned)__builtin_amdgcn_s_getreg((3 << 11) | 20) & 7u);
    unsigned* sq = (unsigned*)F.ctl + CW_SCQ + (ctr_base == CW_WORK ? 0 : 2048) + layer * 8 * 64;
    if (parts & 1) {
        __syncthreads(); if (tid == 0) F.MISC[19] = atomicAdd(sq + myx * 64, 1u); __syncthreads();
        const int kc = (int)F.MISC[19]; if (kc < 2) rwkv_scan(F, myx + 8 * kc, parts >> 4 ? (parts >> 4) & 7 : 7); }
    if (0) for (int bhs = F.bid; bhs < 16; bhs += F.G) rwkv_scan(F, bhs);
    unsigned* ctr = (unsigned*)F.ctl + ctr_base + 64 * layer;
#ifdef NOSKIP_PROBE
    const float BND = 1e30f;
#else
    const float BND = 2.04f * 8.f * LOG2E * wave_max(fabsf(IN(12)[(layer >> 1) * 64 + lane])) * wave_max(fabsf(IN(13)[(layer >> 1) * 64 + lane]));
#endif
    for (;;) {
        {
            __syncthreads();
            if (tid == 0) F.MISC[16] = atomicAdd(ctr, 1u);
            __syncthreads();
            const int u = (int)F.MISC[16];
            if (u >= 512 || !(parts & 2)) break;
            const int bh = u & 15, qb = 31 - (u >> 4), b = bh >> 3, h = bh & 7;
            const bf16* base = P + (size_t)b * SEQ * ODD_N; const float* dc = DC + (size_t)bh * SEQ;
            const int q0 = 256 * qb + 32 * wave, myq = q0 + r32;
            bf16x8 qf[4];
#pragma unroll
            for (int d0 = 0; d0 < 4; ++d0) qf[d0] = *(const bf16x8*)(base + (size_t)myq * ODD_N + h * 64 + 16 * d0 + 8 * hh);
            const float dq = dc[myq] * LOG2E;
            float m = -INFINITY, lsum = 0.f;
            f32x16 o[2];
#pragma unroll
            for (int r = 0; r < 16; ++r) { o[0][r] = 0.f; o[1][r] = 0.f; }
            const int NT = 4 * qb + 4;
            if (wave < 2) { const int jt = tid; const bool nd = jt < NT && (BND + (dc[256 * qb] - dc[64 * (jt < NT ? jt : 0) + 63]) * LOG2E >= -150.f);
                const unsigned long long mk = __ballot(nd); if (lane == 0) F.MISC[17 + wave] = mk ? (unsigned)(64 * wave + (int)__builtin_ctzll(mk)) : 1000u; }
            __syncthreads();
            const int jstart = (int)(F.MISC[17] < F.MISC[18] ? F.MISC[17] : F.MISC[18]);
            const float dqw = __builtin_bit_cast(float, __builtin_amdgcn_readfirstlane(__builtin_bit_cast(int, dq)));
            v4u kreg = *(const v4u*)(base + (size_t)(64 * jstart + srow) * ODD_N + 512 + h * 64 + sch * 8);
            v4u vreg = *(const v4u*)(base + (size_t)(64 * jstart + srow) * ODD_N + 1024 + h * 64 + sch * 8);
            float dreg = tid < 64 ? -dc[64 * jstart + tid] * LOG2E : 0.f;
            *(LAS v4u*)(F.lds + srow * FX_KROW + sch * 16) = kreg; *(LAS v4u*)(F.lds + FX_KB + srow * FX_VROW + sch * 16) = vreg;
            if (tid < 64) *(LAS float*)(F.lds + FX_KB + FX_VB + tid * 4) = dreg;
            __syncthreads();
            v4u kA = kreg, vA = vreg, kB = kreg, vB = vreg; float dA = 0.f, dB = 0.f;
            if (jstart + 1 < NT) { const size_t krow = (size_t)(64 * (jstart + 1) + srow) * ODD_N;
                kA = *(const v4u*)(base + krow + 512 + h * 64 + sch * 8); vA = *(const v4u*)(base + krow + 1024 + h * 64 + sch * 8);
                if (tid < 64) dA = dc[64 * (jstart + 1) + tid]; }
            auto tile_step = [&](const int j, v4u& kx, v4u& vx, float& dx, v4u& ky, v4u& vy, float& dy) {
                const int cur = ((j - jstart) & 1) * FX_BUF, nxt = ((j - jstart + 1) & 1) * FX_BUF;
                if (j + 2 < NT) { const size_t krow = (size_t)(64 * (j + 2) + srow) * ODD_N;
                    ky = *(const v4u*)(base + krow + 512 + h * 64 + sch * 8); vy = *(const v4u*)(base + krow + 1024 + h * 64 + sch * 8);
                    if (tid < 64) dy = dc[64 * (j + 2) + tid]; }
                if (64 * j <= q0 + 31 && BND + dqw + *(const LAS float*)(F.lds + cur + FX_KB + FX_VB + 63 * 4) >= -150.f) {
                    const LAS unsigned char* Kb = F.lds + cur; const LAS unsigned char* Vb = F.lds + cur + FX_KB; const LAS float* dkb = (const LAS float*)(F.lds + cur + FX_KB + FX_VB);
                    f32x16 p0, p1;
#pragma unroll
                    for (int r = 0; r < 16; ++r) { p0[r] = 0.f; p1[r] = 0.f; }
#pragma unroll
                    for (int d0 = 0; d0 < 4; ++d0) {
                        const bf16x8 a0 = *(const LAS bf16x8*)(Kb + r32 * FX_KROW + 32 * d0 + 16 * hh);
                        const bf16x8 a1 = *(const LAS bf16x8*)(Kb + (r32 + 32) * FX_KROW + 32 * d0 + 16 * hh);
                        p0 = __builtin_amdgcn_mfma_f32_32x32x16_bf16(a0, qf[d0], p0, 0, 0, 0);
                        p1 = __builtin_amdgcn_mfma_f32_32x32x16_bf16(a1, qf[d0], p1, 0, 0, 0);
                    }
                    const bool diag = 64 * j + 63 > q0;
#pragma unroll
                    for (int g = 0; g < 4; ++g) {
                        const f32x4 dk0 = *(const LAS f32x4*)(dkb + 8 * g + 4 * hh), dk1 = *(const LAS f32x4*)(dkb + 32 + 8 * g + 4 * hh);
#pragma unroll
                        for (int i = 0; i < 4; ++i) { p0[4 * g + i] = p0[4 * g + i] * CS + dk0[i]; p1[4 * g + i] = p1[4 * g + i] * CS + dk1[i]; }
                    }
                    if (diag) {
                        asm volatile("" ::: "memory");
#pragma unroll
                        for (int r = 0; r < 16; ++r) { const int key = 64 * j + (r & 3) + 8 * (r >> 2) + 4 * hh; if (key > myq) p0[r] = -INFINITY; if (key + 32 > myq) p1[r] = -INFINITY; }
                    }
                    float tmax;
                    {
                        float ta = MAX3F(p0[0], p0[1], p1[0]), tb = MAX3F(p0[2], p0[3], p1[1]); ta = MAX3F(ta, p1[2], p1[3]);
#pragma unroll
                        for (int r = 4; r < 16; r += 4) { ta = MAX3F(ta, p0[r], p0[r + 1]); tb = MAX3F(tb, p0[r + 2], p0[r + 3]); ta = MAX3F(ta, p1[r], p1[r + 1]); tb = MAX3F(tb, p1[r + 2], p1[r + 3]); }
                        tmax = fmaxf(ta, tb); }
                    tmax = fmaxf(tmax, __shfl_xor(tmax, 32));
                    const float mn = fmaxf(m, tmax); const float corr = __builtin_amdgcn_exp2f(m - mn); m = mn;
                    float ps = 0.f;
#pragma unroll
                    for (int r = 0; r < 16; ++r) { p0[r] = __builtin_amdgcn_exp2f(p0[r] - mn); p1[r] = __builtin_amdgcn_exp2f(p1[r] - mn); ps += p0[r] + p1[r]; }
                    lsum = lsum * corr + ps;
                    if (__any(corr != 1.f)) {
                        asm volatile("" ::: "memory");
#pragma unroll
                        for (int r = 0; r < 16; ++r) { o[0][r] *= corr; o[1][r] *= corr; } }
                    bf16x8 pf[4];
#pragma unroll
                    for (int s4 = 0; s4 < 4; ++s4) {
                        v4u w;
                        if (s4 < 2) { w.x = pk2(p0[8 * s4 + 0], p0[8 * s4 + 1]); w.y = pk2(p0[8 * s4 + 2], p0[8 * s4 + 3]); w.z = pk2(p0[8 * s4 + 4], p0[8 * s4 + 5]); w.w = pk2(p0[8 * s4 + 6], p0[8 * s4 + 7]); }
                        else { const int sp = s4 - 2; w.x = pk2(p1[8 * sp + 0], p1[8 * sp + 1]); w.y = pk2(p1[8 * sp + 2], p1[8 * sp + 3]); w.z = pk2(p1[8 * sp + 4], p1[8 * sp + 5]); w.w = pk2(p1[8 * sp + 6], p1[8 * sp + 7]); }
                        pf[s4] = __builtin_bit_cast(bf16x8, w);
                    }
                    const int gi = lane >> 4, li = lane & 15;
                    const LAS unsigned char* vbase = Vb + (4 * (gi >> 1) + (li >> 2)) * FX_VROW + (16 * (gi & 1) + 4 * (li & 3)) * 2;
#pragma unroll
                    for (int d0 = 0; d0 < 2; ++d0)
#pragma unroll
                        for (int s4 = 0; s4 < 4; ++s4) {
                            const s16x4 lo = __builtin_bit_cast(s16x4, __builtin_amdgcn_ds_read_tr16_b64_v4i16((LAS s16x4*)(vbase + (16 * s4) * FX_VROW + 64 * d0)));
                            const s16x4 hi = __builtin_bit_cast(s16x4, __builtin_amdgcn_ds_read_tr16_b64_v4i16((LAS s16x4*)(vbase + (16 * s4 + 8) * FX_VROW + 64 * d0)));
                            const bf16x8 vf = (bf16x8){lo[0], lo[1], lo[2], lo[3], hi[0], hi[1], hi[2], hi[3]};
                            o[d0] = __builtin_amdgcn_mfma_f32_32x32x16_bf16(vf, pf[s4], o[d0], 0, 0, 0);
                        }
                }
                if (j + 1 < NT) {
                    *(LAS v4u*)(F.lds + nxt + srow * FX_KROW + sch * 16) = kx; *(LAS v4u*)(F.lds + nxt + FX_KB + srow * FX_VROW + sch * 16) = vx;
                    if (tid < 64) *(LAS float*)(F.lds + nxt + FX_KB + FX_VB + tid * 4) = -dx * LOG2E;
                }
                LBAR();
            };
            for (int j = jstart; j < NT; j += 2) {
                tile_step(j, kA, vA, dA, kB, vB, dB);
                if (j + 1 < NT) tile_step(j + 1, kB, vB, dB, kA, vA, dA);
            }
            const float l = lsum + __shfl_xor(lsum, 32); const float inv = 1.f / l;
            const bf16* gp = base + (size_t)myq * ODD_N + 1536 + h * 64; bf16* op = MIX + ((size_t)b * SEQ + myq) * D + h * 64;
#pragma unroll
            for (int d0 = 0; d0 < 2; ++d0)
#pragma unroll
                for (int g = 0; g < 4; ++g) { const int db = 32 * d0 + 8 * g + 4 * hh; const v2u gw = *(const v2u*)(gp + db);
                    const float g0 = sigmoidf_(bflo(gw.x)), g1 = sigmoidf_(bfhi(gw.x)), g2 = sigmoidf_(bflo(gw.y)), g3 = sigmoidf_(bfhi(gw.y));
                    v2u ow; ow.x = pk2(o[d0][4 * g + 0] * inv * g0, o[d0][4 * g + 1] * inv * g1); ow.y = pk2(o[d0][4 * g + 2] * inv * g2, o[d0][4 * g + 3] * inv * g3);
                    *(v2u*)(op + db) = ow; }
        }
    }
    if (parts & 1) for (int dx = 0; dx < 8; ++dx) { const int xs = (myx + dx) & 7;
        for (;;) { __syncthreads(); if (tid == 0) F.MISC[19] = atomicAdd(sq + xs * 64, 1u); __syncthreads(); const int kc = (int)F.MISC[19]; if (kc >= 2) break; rwkv_scan(F, xs + 8 * kc); } }
}

__device__ __forceinline__ void phase_rwkv_post(Frame& F, int layer) {
    KARGS;
    const int jj = layer >> 1, ch = F.tid;
    const float* R = WSP(float, WS_RW); const float* K = WSP(float, WS_RW + 2 * RW_SLOT); const float* V = WSP(float, WS_RW + 3 * RW_SLOT);
    const float* Gt = WSP(float, WS_RW + 6 * RW_SLOT); const float* Y = WSP(float, WS_RW + 7 * RW_SLOT);
    bf16* MIX = WSP(bf16, WS_MIX);
    const float lw = IN(24)[jj * 512 + ch], lb = IN(25)[jj * 512 + ch], rk = IN(23)[jj * 512 + ch];
#pragma unroll 4
    for (int tg = F.bid; tg < T; tg += F.G) {
        const size_t o = (size_t)tg * 512 + ch;
        const float y = Y[o]; const float mu = wave_sum(y) * (1.f / 64.f); const float dlt = y - mu; const float var = wave_sum(dlt * dlt) * (1.f / 64.f);
        const float yn = dlt * rsqrtf(var + GN_EPS) * lw + lb;
        const float v = V[o]; const float bonus = wave_sum(R[o] * K[o] * rk) * v;
        MIX[(size_t)tg * D + 512 + ch] = (bf16)f2bf((yn + bonus) * Gt[o]);
    }
}

__device__ __forceinline__ void sort16_desc(float (&v)[16]) {
#pragma unroll
    for (int k = 2; k <= 16; k <<= 1)
#pragma unroll
        for (int j = k >> 1; j > 0; j >>= 1)
#pragma unroll
            for (int i = 0; i < 16; ++i) { const int l = i ^ j; if (l > i) { const float a_ = v[i], b_ = v[l]; const float mx = fmaxf(a_, b_), mn = fminf(a_, b_);
                if ((i & k) == 0) { v[i] = mx; v[l] = mn; } else { v[i] = mn; v[l] = mx; } } }
}
__device__ __forceinline__ void merge16_desc(float (&A)[16], const float (&B)[16]) {
#pragma unroll
    for (int i = 0; i < 16; ++i) A[i] = fmaxf(A[i], B[15 - i]);
#pragma unroll
    for (int j = 8; j > 0; j >>= 1)
#pragma unroll
        for (int i = 0; i < 16; ++i) { const int l = i ^ j; if (l > i) { const float a_ = A[i], b_ = A[l]; A[i] = fmaxf(a_, b_); A[l] = fminf(a_, b_); } }
}
__device__ __forceinline__ float pack_low(float v, unsigned bits, unsigned mask) { return __builtin_bit_cast(float, (__builtin_bit_cast(unsigned, v) & ~mask) | bits); }
template <bool OWN> __device__ __forceinline__ void phase_peer_topk(Frame& F, int layer, const pg8::StaticOrder S) {
    KARGS;
    const bf16* Q = WSP(bf16, WS_Q); const bf16* KEYS = WSP(bf16, WS_KEYS) + (size_t)layer * 2 * 16384;
    int* IDX = WSP(int, WS_IDX); float* GATE = WSP(float, WS_GATE);
    constexpr int SCP = 132;
    LAS float* sc = (LAS float*)(F.lds + F.wave * (32 * SCP * 4));
    LAS unsigned* li = (LAS unsigned*)sc;
    const int lane = F.lane, fr = lane & 15, fq = lane >> 4, tok = lane & 31, hp = lane >> 5;
    const int gw = F.bid * NWAVES + F.wave, NGW = F.G * NWAVES;
    pg8::Unit un{0, 0};
    const bool cv = OWN && layer < 3;
    const int NRW = (2 * NEXP + NGW - 1) / NGW;
    int cr = 0;
    f32x4 cvv[2][4];
    for (int it = OWN ? 0 : gw; OWN ? S.next(it, un) : (it < (T / 32) * 8); it += OWN ? 1 : NGW) {
        const int tile = OWN ? un.pm * 8 + F.wave : (it >> 3), h = OWN ? un.pn : (it & 7), t0 = tile * 32;
        float v1[16], v2[16];
#pragma unroll
        for (int half = 0; half < 2; ++half) {
            f32x4 acc[2][8];
#pragma unroll
            for (int rt = 0; rt < 2; ++rt)
#pragma unroll
                for (int ct = 0; ct < 8; ++ct) acc[rt][ct] = (f32x4){0.f, 0.f, 0.f, 0.f};
            const bf16* kb = KEYS + (size_t)half * 16384;
#pragma unroll 1
            for (int ks = 0; ks < 4; ++ks) {
                bf16x8 a[2];
#pragma unroll
                for (int rt = 0; rt < 2; ++rt) a[rt] = *(const bf16x8*)(Q + (size_t)(t0 + rt * 16 + fr) * 2048 + h * 256 + half * 128 + ks * 32 + 8 * fq);
#pragma unroll
                for (int ct = 0; ct < 8; ++ct) { const bf16x8 bb = *(const bf16x8*)(kb + (size_t)(ct * 16 + fr) * 128 + ks * 32 + 8 * fq);
#pragma unroll
                    for (int rt = 0; rt < 2; ++rt) acc[rt][ct] = __builtin_amdgcn_mfma_f32_16x16x32_bf16(a[rt], bb, acc[rt][ct], 0, 0, 0); }
            }
            if (cv && cr < NRW) conv_issue<2>(IN(29), IN(30), layer + 1, gw + cr * NGW, NGW, lane, cvv);
#pragma unroll
            for (int rt = 0; rt < 2; ++rt)
#pragma unroll
                for (int ct = 0; ct < 8; ++ct)
#pragma unroll
                    for (int r = 0; r < 4; ++r) sc[(rt * 16 + 4 * fq + r) * SCP + ct * 16 + fr] = pack_low(acc[rt][ct][r], (unsigned)(ct * 16 + fr), 0x7Fu);
            LDS_WAIT(); asm volatile("" ::: "memory");
            float top[16];
            const LAS float* row = sc + tok * SCP + 64 * hp;
#pragma unroll 1
            for (int g = 0; g < 4; ++g) {
                float grp[16];
#pragma unroll
                for (int q4 = 0; q4 < 4; ++q4) { const f32x4 x = *(const LAS f32x4*)(row + 16 * g + 4 * q4); grp[4 * q4] = x.x; grp[4 * q4 + 1] = x.y; grp[4 * q4 + 2] = x.z; grp[4 * q4 + 3] = x.w; }
                sort16_desc(grp);
                if (g == 0) {
#pragma unroll
                    for (int p = 0; p < 16; ++p) top[p] = grp[p]; }
                else merge16_desc(top, grp);
            }
            { float oth[16];
#pragma unroll
              for (int p = 0; p < 16; ++p) oth[p] = __shfl_xor(top[p], 32);
              merge16_desc(top, oth); }
            LDS_WAIT(); asm volatile("" ::: "memory");
#pragma unroll
            for (int p = 0; p < 16; ++p) { if (half == 0) v1[p] = top[p]; else v2[p] = top[p]; }
            if (cv && cr < NRW) { conv_finish<2>(WSP(unsigned char, WS_PU), WSP(unsigned char, WS_PV), WSP(float, WS_PS), layer + 1, gw + cr * NGW, NGW, lane, cvv, F.lds + 135168 + F.wave * 1024); cr += 2; }
        }
        if (hp == 0) {
#pragma unroll
            for (int p = 0; p < 16; ++p) { li[tok * 33 + p] = __builtin_bit_cast(unsigned, v1[p]) & 0x7Fu; li[tok * 33 + 16 + p] = __builtin_bit_cast(unsigned, v2[p]) & 0x7Fu; } }
        if (cv && cr < NRW) conv_issue<2>(IN(29), IN(30), layer + 1, gw + cr * NGW, NGW, lane, cvv);
        float ts[16];
        {
            float c0[16], c1[16];
            int n = 0;
#pragma unroll
            for (int a_ = 0; a_ < 16; ++a_)
#pragma unroll
                for (int b_ = 0; b_ < 16; ++b_) if ((a_ + 1) * (b_ + 1) <= 16) {
                    const float x = pack_low(v1[a_] + v2[b_], (unsigned)(a_ * 16 + b_), 0xFFu);
                    const int slot = n >> 1; const bool mine = (n & 1) == hp;
                    if (slot < 16) { if ((n & 1) == 0) c0[slot] = mine ? x : -INFINITY; else c0[slot] = mine ? x : c0[slot]; }
                    else { if ((n & 1) == 0) c1[slot - 16] = mine ? x : -INFINITY; else c1[slot - 16] = mine ? x : c1[slot - 16]; }
                    ++n; }
#pragma unroll
            for (int sl = 9; sl < 16; ++sl) c1[sl] = -INFINITY;
            sort16_desc(c0); sort16_desc(c1); merge16_desc(c0, c1);
            float oth[16];
#pragma unroll
            for (int p = 0; p < 16; ++p) oth[p] = __shfl_xor(c0[p], 32);
            merge16_desc(c0, oth);
#pragma unroll
            for (int p = 0; p < 16; ++p) ts[p] = c0[p];
        }
        LDS_WAIT(); asm volatile("" ::: "memory");
        if (cv && cr < NRW) { conv_finish<2>(WSP(unsigned char, WS_PU), WSP(unsigned char, WS_PV), WSP(float, WS_PS), layer + 1, gw + cr * NGW, NGW, lane, cvv, F.lds + 135168 + F.wave * 1024); cr += 2; }
        if (hp == 0) {
            float e[16], sum = 0.f;
#pragma unroll
            for (int p = 0; p < 16; ++p) { e[p] = expf(ts[p] - ts[0]); sum += e[p]; }
            const float inv = 1.f / sum;
            int* ip = IDX + (size_t)(t0 + tok) * 128 + h * 16; float* gp = GATE + (size_t)(t0 + tok) * 128 + h * 16;
#pragma unroll
            for (int p = 0; p < 16; ++p) { const unsigned ab = __builtin_bit_cast(unsigned, ts[p]) & 0xFFu;
                ip[p] = (int)(li[tok * 33 + (ab >> 4)] * 128u + li[tok * 33 + 16 + (ab & 15u)]); gp[p] = e[p] * inv; }
        }
        LDS_WAIT(); asm volatile("" ::: "memory");
    }
    while (cv && cr < NRW) { f32x4 v4[4][4];
        conv_issue<4>(IN(29), IN(30), layer + 1, gw + cr * NGW, NGW, lane, v4);
        conv_finish<4>(WSP(unsigned char, WS_PU), WSP(unsigned char, WS_PV), WSP(float, WS_PS), layer + 1, gw + cr * NGW, NGW, lane, v4, F.lds + 135168 + F.wave * 1024); cr += 4; }
}

typedef float f32x2 __attribute__((ext_vector_type(2)));
__device__ __forceinline__ void unpack16_fp8(float (&o)[16], const v4u w) {
#pragma unroll
    for (int j = 0; j < 4; ++j) { const f32x2 a = __builtin_amdgcn_cvt_pk_f32_fp8((int)w[j], false), b = __builtin_amdgcn_cvt_pk_f32_fp8((int)w[j], true); o[4 * j] = a.x; o[4 * j + 1] = a.y; o[4 * j + 2] = b.x; o[4 * j + 3] = b.y; }
}
__device__ __forceinline__ void gu_token(const unsigned char* U, const float* SU, const float* SV, const bf16* H, const int* IDX, const float* GATE, float* ACT, int s, int tg, int lane) {
    float x[16];
    { const v4u w0 = *(const v4u*)(H + (size_t)tg * D + 16 * lane), w1 = *(const v4u*)(H + (size_t)tg * D + 16 * lane + 8);
      x[0] = bflo(w0.x); x[1] = bfhi(w0.x); x[2] = bflo(w0.y); x[3] = bfhi(w0.y); x[4] = bflo(w0.z); x[5] = bfhi(w0.z); x[6] = bflo(w0.w); x[7] = bfhi(w0.w);
      x[8] = bflo(w1.x); x[9] = bfhi(w1.x); x[10] = bflo(w1.y); x[11] = bfhi(w1.y); x[12] = bflo(w1.z); x[13] = bfhi(w1.z); x[14] = bflo(w1.w); x[15] = bfhi(w1.w); }
#pragma unroll
    for (int half = 0; half < 2; ++half) {
        const int id = IDX[(size_t)tg * 128 + 64 * half + lane];
        const bool sel = (id >> 11) == s;
        unsigned long long m = __ballot(sel);
        const float su = sel ? SU[id] : 0.f, cf = sel ? GATE[(size_t)tg * 128 + 64 * half + lane] * SV[id] : 0.f;
        int actb = 0;
        while (m) {
            int pos[8]; v4u ua[8]; float d[8];
#pragma unroll
            for (int q = 0; q < 8; ++q) { pos[q] = m ? (int)__builtin_ctzll(m) : -1; m = m ? (m & (m - 1)) : m;
                const int idx = pos[q] >= 0 ? __builtin_amdgcn_readlane(id, pos[q]) : (s << 11);
                ua[q] = *(const v4u*)(U + (size_t)idx * 1024 + 16 * lane); }
#pragma unroll
            for (int q = 0; q < 8; ++q) { float u[16]; unpack16_fp8(u, ua[q]); float sm = 0.f;
#pragma unroll
                for (int i = 0; i < 16; ++i) sm += u[i] * x[i];
                d[q] = sm; }
#pragma unroll
            for (int o = 1; o < 64; o <<= 1) {
#pragma unroll
                for (int q = 0; q < 8; ++q) d[q] += __shfl_xor(d[q], o); }
#pragma unroll
            for (int q = 0; q < 8; ++q) if (pos[q] >= 0) { const float val = gelu_erf(d[q] * rl(su, pos[q])) * rl(cf, pos[q]);
                actb = lane == pos[q] ? __builtin_bit_cast(int, val) : actb; }
        }
        if (sel) ACT[(size_t)tg * 128 + 64 * half + lane] = __builtin_bit_cast(float, actb);
    }
}

__device__ __forceinline__ void phase_peer_gu_valu(Frame& F, int layer) {
    KARGS;
    const bf16* H = WSP(bf16, WS_H); const int* IDX = WSP(int, WS_IDX); const float* GATE = WSP(float, WS_GATE); float* ACT = WSP(float, WS_ACT);
    const unsigned char* U = WSP(unsigned char, WS_PU) + (size_t)layer * NEXP * 1024;
    const float* SU = WSP(float, WS_PS) + (size_t)layer * NEXP; const float* SV = SU + 4 * NEXP;
    const int lane = F.lane;
    unsigned* heads = (unsigned*)F.ctl + CW_G1 + layer * 8 * 64;
    const int myx = (int)((unsigned)__builtin_amdgcn_s_getreg((3 << 11) | 20) & 7u);
    for (int k = 0; k < 8; ++k) { const int s = (myx + k) & 7;
        for (;;) { unsigned u = 0; if (lane == 0) u = atomicAdd(heads + s * 64, 1u); u = (unsigned)__builtin_amdgcn_readfirstlane((int)u);
            if (u >= (unsigned)(T / 8)) break;
#pragma unroll 1
            for (int i = 0; i < 8; ++i) gu_token(U, SU, SV, H, IDX, GATE, ACT, s, (int)u * 8 + i, lane); } }
}
__device__ __forceinline__ void phase_peer_gu(Frame& F, int layer) {
    KARGS;
    const int* IDX = WSP(int, WS_IDX); const float* GATE = WSP(float, WS_GATE); float* ACT = WSP(float, WS_ACT);
    const unsigned char* U = WSP(unsigned char, WS_PU) + (size_t)layer * NEXP * 512; const unsigned char* SC6 = WSP(unsigned char, WS_PU) + (size_t)48 * MiB + (size_t)layer * NEXP * 32;
    const unsigned char* H8 = WSP(unsigned char, WS_H8); const float* HS = WSP(float, WS_HS);
    const float* SU = WSP(float, WS_PS) + (size_t)layer * NEXP; const float* SV = SU + 4 * NEXP;
    const int lane = F.lane, row = lane & 15, kc = lane >> 4;
    LAS int* lst = (LAS int*)(F.lds + F.wave * 18432);
    LAS unsigned char* xl = F.lds + F.wave * 18432 + 8192;
    LAS float* cpatch = (LAS float*)(F.lds + F.wave * 18432 + 8192 + 8320);
    unsigned* heads = (unsigned*)F.ctl + CW_G1 + layer * 8 * 64;
    const int myx = (int)((unsigned)__builtin_amdgcn_s_getreg((3 << 11) | 20) & 7u);
    struct TSet { v4u ua[8]; v2u sc; int e, meta; float su, sv, gt, xs; bool valid; };
    for (int k = 0; k < 4; ++k) {
        const int s = (myx + k) & 3;
        for (;;) {
            unsigned u = 0; if (lane == 0) u = atomicAdd(heads + s * 64, 1u); u = (unsigned)__builtin_amdgcn_readfirstlane((int)u);
            if (u >= (unsigned)(T / 8)) break;
            const int tg0 = (int)u * 8;
            int total = 0;
            int ida[8], idb[8]; v4u hx[8];
#pragma unroll
            for (int i = 0; i < 8; ++i) { ida[i] = IDX[(size_t)(tg0 + i) * 128 + lane]; idb[i] = IDX[(size_t)(tg0 + i) * 128 + 64 + lane]; hx[i] = *(const v4u*)(H8 + (size_t)(tg0 + i) * D + 16 * lane); }
#pragma unroll
            for (int i = 0; i < 8; ++i) {
                const int id0 = ida[i], id1 = idb[i];
                *(LAS v4u*)(xl + i * 1040 + 16 * lane) = hx[i];
                const bool sel0 = (id0 >> 12) == s, sel1 = (id1 >> 12) == s;
                const unsigned long long m0 = __ballot(sel0), m1 = __ballot(sel1);
                const int n0 = __builtin_popcountll(m0), cnt = n0 + __builtin_popcountll(m1);
                const int r0 = total + (int)__builtin_amdgcn_mbcnt_hi((unsigned)(m0 >> 32), __builtin_amdgcn_mbcnt_lo((unsigned)m0, 0u));
                const int r1 = total + n0 + (int)__builtin_amdgcn_mbcnt_hi((unsigned)(m1 >> 32), __builtin_amdgcn_mbcnt_lo((unsigned)m1, 0u));
                if (sel0) { lst[r0] = id0; lst[1024 + r0] = i * 128 + lane; }
                if (sel1) { lst[r1] = id1; lst[1024 + r1] = i * 128 + 64 + lane; }
                total += cnt; }
            LDS_WAIT(); asm volatile("" ::: "memory");
            const int ntile = (total + 15) >> 4;
            auto load_tile = [&](TSet& S, const int t) { if (t < ntile) {
                const int rr = 16 * t + row; S.valid = rr < total;
                const int ri = S.valid ? rr : 16 * t;
                S.e = lst[ri]; S.meta = lst[1024 + ri];
                const int rq = 16 * t + (lane >> 2); const int eq = lst[rq < total ? rq : 16 * t];
                const unsigned char* up = U + (size_t)eq * 512 + 16 * (lane & 3);
#pragma unroll
                for (int j = 0; j < 8; ++j) S.ua[j] = *(const v4u*)(up + 64 * j);
                S.sc = *(const v2u*)(SC6 + (size_t)eq * 32 + 8 * (lane & 3));
                S.su = 0.f; S.sv = 0.f; S.gt = 0.f; S.xs = 0.f;
                if (kc == 0) { S.su = 1.f; S.sv = SV[S.e]; S.gt = GATE[(size_t)(tg0 + (S.meta >> 7)) * 128 + (S.meta & 127)]; S.xs = HS[tg0 + (S.meta >> 7)]; } } };
            const LAS unsigned char* xp = xl + (row & 7) * 1040 + 16 * kc;
            v8i bq[8];
#pragma unroll
            for (int m = 0; m < 8; ++m) { const v4u xb0 = *(const LAS v4u*)(xp + 128 * m), xb1 = *(const LAS v4u*)(xp + 128 * m + 64);
                bq[m] = (v8i){(int)xb0.x, (int)xb0.y, (int)xb0.z, (int)xb0.w, (int)xb1.x, (int)xb1.y, (int)xb1.z, (int)xb1.w}; }
            auto compute_tile = [&](TSet& S, const int t) { if (t < ntile) {
                f32x4 acc0 = (f32x4){0.f, 0.f, 0.f, 0.f}, acc1 = acc0;
                { const int psrc = 4 * (4 * (lane & 15) + (lane >> 4));
#pragma unroll
                  for (int j = 0; j < 8; ++j)
#pragma unroll
                      for (int c = 0; c < 4; ++c) S.ua[j][c] = (unsigned)__builtin_amdgcn_ds_bpermute(psrc, (int)S.ua[j][c]);
                  S.sc.x = (unsigned)__builtin_amdgcn_ds_bpermute(psrc, (int)S.sc.x); S.sc.y = (unsigned)__builtin_amdgcn_ds_bpermute(psrc, (int)S.sc.y); }
#define GU_MM(m, ACC) { v8i av; \
                    _Pragma("unroll") for (int d = 0; d < 8; ++d) { av[d] = d < 4 ? (int)S.ua[(m)][d & 3] : 0; } \
                    const v8i bv = bq[(m)]; \
                    ACC = __builtin_amdgcn_mfma_scale_f32_16x16x128_f8f6f4(av, bv, ACC, 4, 0, (m) & 3, (int)S.sc[(m) >> 2], 0, 0x7F7F7F7F); }
                GU_MM(0, acc0) GU_MM(1, acc1) GU_MM(2, acc0) GU_MM(3, acc1) GU_MM(4, acc0) GU_MM(5, acc1) GU_MM(6, acc0) GU_MM(7, acc1)
#undef GU_MM
                acc0 += acc1;
#pragma unroll
                for (int q = 0; q < 4; ++q) cpatch[(4 * kc + q) * 17 + row] = acc0[q];
                LDS_WAIT(); asm volatile("" ::: "memory");
                const float d = cpatch[row * 17 + (S.meta >> 7)];
                if (S.valid && kc == 0) { const int tg = tg0 + (S.meta >> 7); const float av = gelu_erf(d * S.su * S.xs) * S.gt * S.sv;
                    const unsigned sl = (unsigned)(S.meta & 127);
                    const unsigned ab = __builtin_bit_cast(unsigned, av), eo = (unsigned)S.e << 3, mag = ab & 0x7FFFFFFFu;
                    const unsigned tq = mag > eo ? (mag - eo + 0x10000u) & 0xFFFE0000u : 0u;
                    ((unsigned*)ACT)[(((size_t)(tg >> 6) * 32 + (sl >> 2)) * 64 + (tg & 63)) * 4 + (sl & 3)] = (ab & 0x80000000u) | tq | eo; }
                LDS_WAIT(); asm volatile("" ::: "memory"); } };
            TSet A_, B_;
            load_tile(A_, 0);
#pragma unroll 1
            for (int t = 0; t < ntile; t += 2) { load_tile(B_, t + 1); compute_tile(A_, t); load_tile(A_, t + 2); compute_tile(B_, t + 1); }
            LDS_WAIT(); asm volatile("" ::: "memory");
        }
    }
}
__device__ __forceinline__ void gv_token(const unsigned char* Vc, const int* IDX, const float* ACT, const float* g2, float* X, int c, int tg, int lane) {
    const int g = lane >> 3, cl = lane & 7, b = tg >= SEQ ? 1 : 0;
    int iv[16]; float cv[16];
#pragma unroll
    for (int j = 0; j < 4; ++j) { const v4u a = *(const v4u*)(IDX + (size_t)tg * 128 + 16 * g + 4 * j); const f32x4 f = *(const f32x4*)(ACT + (size_t)tg * 128 + 16 * g + 4 * j);
        iv[4 * j] = (int)a.x; iv[4 * j + 1] = (int)a.y; iv[4 * j + 2] = (int)a.z; iv[4 * j + 3] = (int)a.w; cv[4 * j] = f.x; cv[4 * j + 1] = f.y; cv[4 * j + 2] = f.z; cv[4 * j + 3] = f.w; }
    float acc[16];
#pragma unroll
    for (int i = 0; i < 16; ++i) acc[i] = 0.f;
#pragma unroll
    for (int k0 = 0; k0 < 16; k0 += 8) {
        v4u seg[8];
#pragma unroll
        for (int k = 0; k < 8; ++k) seg[k] = *(const v4u*)(Vc + ((size_t)c * NEXP + iv[k0 + k]) * 128 + 16 * cl);
#pragma unroll
        for (int k = 0; k < 8; ++k) { float v[16]; unpack16_fp8(v, seg[k]);
#pragma unroll
            for (int i = 0; i < 16; ++i) acc[i] += v[i] * cv[k0 + k]; }
    }
#pragma unroll
    for (int o = 8; o < 64; o <<= 1) {
#pragma unroll
        for (int i = 0; i < 16; ++i) acc[i] += __shfl_xor(acc[i], o); }
    if (lane < 8) { float* xr = X + (size_t)tg * D + 128 * c + 16 * cl; const float* gg = g2 + b * 6144 + 128 * c + 16 * cl;
#pragma unroll
        for (int j = 0; j < 4; ++j) { const f32x4 g4 = *(const f32x4*)(gg + 4 * j); *(f32x4*)(xr + 4 * j) = *(const f32x4*)(xr + 4 * j) + g4 * (f32x4){acc[4 * j], acc[4 * j + 1], acc[4 * j + 2], acc[4 * j + 3]}; } }
}

__device__ __forceinline__ void phase_peer_gv_old(Frame& F, int layer) {
    KARGS;
    const int* IDX = WSP(int, WS_IDX); const float* ACT = WSP(float, WS_ACT);
    const unsigned char* Vc = WSP(unsigned char, WS_PV) + (size_t)layer * NEXP * 1024;
    const float* g2 = WSP(float, WS_MOD) + (size_t)layer * 2 * 6144 + 5120;
    float* X = OUTP; const int lane = F.lane;
    unsigned* heads = (unsigned*)F.ctl + CW_G2 + layer * 8 * 64;
    const int myx = (int)((unsigned)__builtin_amdgcn_s_getreg((3 << 11) | 20) & 7u);
    for (int k = 0; k < 8; ++k) { const int c = (myx + k) & 7;
        for (;;) { unsigned u = 0; if (lane == 0) u = atomicAdd(heads + c * 64, 1u); u = (unsigned)__builtin_amdgcn_readfirstlane((int)u);
            if (u >= (unsigned)(T / 8)) break;
#pragma unroll 1
            for (int i = 0; i < 8; ++i) gv_token(Vc, IDX, ACT, g2, X, c, (int)u * 8 + i, lane); } }
}
__device__ __forceinline__ void phase_peer_gv_l2(Frame& F, int layer) {
    KARGS;
    const int* IDX = WSP(int, WS_IDX); const float* ACT = WSP(float, WS_ACT);
    const unsigned char* Vc = WSP(unsigned char, WS_PV) + (size_t)layer * NEXP * 1024;
    const float* g2 = WSP(float, WS_MOD) + (size_t)layer * 2 * 6144 + 5120;
    float* X = OUTP;
    const int lane = F.lane, g = lane >> 3, cl = lane & 7;
    LAS unsigned* li_ = (LAS unsigned*)(F.lds + 8192 + F.wave * 8192);
    LAS float* la_ = (LAS float*)(F.lds + 8192 + F.wave * 8192 + 4096);
    unsigned* heads = (unsigned*)F.ctl + CW_G2 + layer * 8 * 64;
    const int myx = (int)((unsigned)__builtin_amdgcn_s_getreg((3 << 11) | 20) & 7u);
    for (int k = 0; k < 8; ++k) {
        const int c = (myx + k) & 7;
        for (;;) {
            unsigned u = 0; if (lane == 0) u = atomicAdd(heads + c * 64, 1u); u = (unsigned)__builtin_amdgcn_readfirstlane((int)u);
            if (u >= (unsigned)(T / 8)) break;
            const int tg = (int)u * 8 + g, b = tg >= SEQ ? 1 : 0;
#pragma unroll
            for (int j = 0; j < 4; ++j) { const v4u a = *(const v4u*)(IDX + (size_t)tg * 128 + 16 * cl + 4 * j); const f32x4 f = *(const f32x4*)(ACT + (size_t)tg * 128 + 16 * cl + 4 * j);
                *(LAS v4u*)(li_ + g * 128 + 16 * cl + 4 * j) = a; *(LAS f32x4*)(la_ + g * 128 + 16 * cl + 4 * j) = f; }
            LDS_WAIT(); asm volatile("" ::: "memory");
            f32x2 acc[8];
#pragma unroll
            for (int q = 0; q < 8; ++q) acc[q] = (f32x2){0.f, 0.f};
#pragma unroll 1
            for (int k0 = 0; k0 < 128; k0 += 16) {
                unsigned ei[16]; float ec[16]; v4u seg[16];
#pragma unroll
                for (int q4 = 0; q4 < 4; ++q4) { const v4u a = *(const LAS v4u*)(li_ + g * 128 + k0 + 4 * q4); const f32x4 f = *(const LAS f32x4*)(la_ + g * 128 + k0 + 4 * q4);
                    ei[4 * q4] = a.x; ei[4 * q4 + 1] = a.y; ei[4 * q4 + 2] = a.z; ei[4 * q4 + 3] = a.w; ec[4 * q4] = f.x; ec[4 * q4 + 1] = f.y; ec[4 * q4 + 2] = f.z; ec[4 * q4 + 3] = f.w; }
#pragma unroll
                for (int kk = 0; kk < 16; ++kk) seg[kk] = *(const v4u*)(Vc + ((size_t)c * NEXP + ei[kk]) * 128 + 16 * cl);
#pragma unroll
                for (int kk = 0; kk < 16; ++kk) { const float cf = ec[kk]; const f32x2 cf2 = (f32x2){cf, cf};
#pragma unroll
                    for (int j = 0; j < 4; ++j) { acc[2 * j] += __builtin_amdgcn_cvt_pk_f32_fp8((int)seg[kk][j], false) * cf2; acc[2 * j + 1] += __builtin_amdgcn_cvt_pk_f32_fp8((int)seg[kk][j], true) * cf2; } }
            }
            float* xr = X + (size_t)tg * D + 128 * c + 16 * cl; const float* gg = g2 + b * 6144 + 128 * c + 16 * cl;
#pragma unroll
            for (int j = 0; j < 4; ++j) { const f32x4 g4 = *(const f32x4*)(gg + 4 * j);
                *(f32x4*)(xr + 4 * j) = *(const f32x4*)(xr + 4 * j) + g4 * (f32x4){acc[2 * j].x, acc[2 * j].y, acc[2 * j + 1].x, acc[2 * j + 1].y}; }
            LDS_WAIT(); asm volatile("" ::: "memory");
        }
    }
}

__device__ __forceinline__ void phase_peer_gv(Frame& F, int layer) {
    KARGS;
    const unsigned* ACTP = WSP(unsigned, WS_ACT);
    const unsigned char* PV8 = WSP(unsigned char, WS_PV) + (size_t)layer * NEXP * 1024;
    const float* g2 = WSP(float, WS_MOD) + (size_t)layer * 2 * 6144 + 5120;
    float* X = OUTP;
    const int lane = F.lane, tid = F.tid;
    for (int u = F.bid; u < 256; u += F.G) {
        const int xq = u >> 3, c = 4 * (4 * (u & 7) + (xq >> 3)) + (xq & 3), hf = (xq >> 2) & 1;
        if (u != F.bid) __syncthreads();
        {   const v4u* src = (const v4u*)(PV8 + (size_t)c * NEXP * 8);
            v4u t[16];
#pragma unroll
            for (int i = 0; i < 16; ++i) t[i] = src[i * NTHR + tid];
#pragma unroll
            for (int i = 0; i < 16; ++i) *(LAS v4u*)(F.lds + (size_t)(i * NTHR + tid) * 16) = t[i]; }
        __syncthreads();
        const float* gg = g2 + hf * 6144 + 8 * c;
        const f32x4 ga = *(const f32x4*)gg, gb = *(const f32x4*)(gg + 4);
        const unsigned lbase = (unsigned)(size_t)F.lds; __builtin_assume(lbase == 0u);
        constexpr int NBLK = 128 / NWAVES;
        auto wptr = [&](int i, int j) { return (const v4u*)(ACTP + (((size_t)(hf * 128 + F.wave + NWAVES * i) * 32 + j * 4) * 64 + lane) * 4); };
        v4u w[4][4];
#pragma unroll
        for (int jj = 0; jj < 4; ++jj) { const v4u* wp = wptr(0, jj);
#pragma unroll
            for (int g = 0; g < 4; ++g) w[jj][g] = wp[g * 64]; }
        v2u v[2][16];
#pragma unroll
        for (int kk = 0; kk < 16; ++kk) v[0][kk] = *(const LAS v2u*)(unsigned)((w[0][kk >> 2][kk & 3] & 0x1FFF8u) + lbase);
#pragma unroll 1
        for (int i = 0; i < NBLK; ++i) {
            float* xr = X + (size_t)((hf * 128 + F.wave + NWAVES * i) * 64 + lane) * D + 8 * c;
            const f32x4 x0 = *(const f32x4*)xr, x1 = *(const f32x4*)(xr + 4);
            const int inx = i + 1 < NBLK ? i + 1 : i;
            f32x2 acc[4];
#pragma unroll
            for (int q = 0; q < 4; ++q) acc[q] = (f32x2){0.f, 0.f};
#pragma unroll
            for (int j = 0; j < 8; ++j) {
#pragma unroll
                for (int kk = 0; kk < 16; ++kk) v[(j + 1) & 1][kk] = *(const LAS v2u*)(unsigned)((w[(j + 1) & 3][kk >> 2][kk & 3] & 0x1FFF8u) + lbase);
                asm volatile("" ::: "memory");
#pragma unroll
                for (int kk = 0; kk < 16; ++kk) {
                    const v4u wq = w[j & 3][kk >> 2]; v2u pr; pr.x = (kk & 2) ? wq.z : wq.x; pr.y = (kk & 2) ? wq.w : wq.y;
                    const f32x2 f0 = __builtin_amdgcn_cvt_pk_f32_fp8((int)v[j & 1][kk].x, false), f1 = __builtin_amdgcn_cvt_pk_f32_fp8((int)v[j & 1][kk].x, true);
                    const f32x2 f2 = __builtin_amdgcn_cvt_pk_f32_fp8((int)v[j & 1][kk].y, false), f3 = __builtin_amdgcn_cvt_pk_f32_fp8((int)v[j & 1][kk].y, true);
                    if (kk & 1) {
                        asm("v_pk_fma_f32 %0, %1, %2, %0 op_sel:[1,0,0] op_sel_hi:[1,1,1]" : "+v"(acc[0]) : "v"(pr), "v"(f0)); asm("v_pk_fma_f32 %0, %1, %2, %0 op_sel:[1,0,0] op_sel_hi:[1,1,1]" : "+v"(acc[1]) : "v"(pr), "v"(f1));
                        asm("v_pk_fma_f32 %0, %1, %2, %0 op_sel:[1,0,0] op_sel_hi:[1,1,1]" : "+v"(acc[2]) : "v"(pr), "v"(f2)); asm("v_pk_fma_f32 %0, %1, %2, %0 op_sel:[1,0,0] op_sel_hi:[1,1,1]" : "+v"(acc[3]) : "v"(pr), "v"(f3));
                    } else {
                        asm("v_pk_fma_f32 %0, %1, %2, %0 op_sel_hi:[0,1,1]" : "+v"(acc[0]) : "v"(pr), "v"(f0)); asm("v_pk_fma_f32 %0, %1, %2, %0 op_sel_hi:[0,1,1]" : "+v"(acc[1]) : "v"(pr), "v"(f1));
                        asm("v_pk_fma_f32 %0, %1, %2, %0 op_sel_hi:[0,1,1]" : "+v"(acc[2]) : "v"(pr), "v"(f2)); asm("v_pk_fma_f32 %0, %1, %2, %0 op_sel_hi:[0,1,1]" : "+v"(acc[3]) : "v"(pr), "v"(f3)); } }
                asm volatile("" ::: "memory");
                { const v4u* wp = j + 4 < 8 ? wptr(i, j + 4) : wptr(inx, j - 4);
#pragma unroll
                  for (int g = 0; g < 4; ++g) w[j & 3][g] = wp[g * 64]; }
                asm volatile("" ::: "memory");
            }
            *(f32x4*)xr = x0 + ga * (f32x4){acc[0].x, acc[0].y, acc[1].x, acc[1].y};
            *(f32x4*)(xr + 4) = x1 + gb * (f32x4){acc[2].x, acc[2].y, acc[3].x, acc[3].y};
        }
    }
}

__device__ __forceinline__ void phase_final(Frame& F) {
    KARGS;
    float* X = OUTP; const float* gain = IN(31);
    const int lane = F.lane, gw = F.bid * NWAVES + F.wave, NGW = F.G * NWAVES;
    f32x4 gn[4];
#pragma unroll
    for (int j = 0; j < 4; ++j) gn[j] = *(const f32x4*)(gain + 256 * j + 4 * lane);
    for (int row = gw; row < T; row += NGW) {
        float* xr = X + (size_t)row * D + 4 * lane;
        f32x4 v[4]; float ss = 0.f;
#pragma unroll
        for (int j = 0; j < 4; ++j) { v[j] = *(const f32x4*)(xr + 256 * j); ss += (v[j].x * v[j].x + v[j].y * v[j].y) + (v[j].z * v[j].z + v[j].w * v[j].w); }
        const float rstd = rsqrtf(wave_sum(ss) * (1.f / D) + NORM_EPS);
#pragma unroll
        for (int j = 0; j < 4; ++j) *(f32x4*)(xr + 256 * j) = v[j] * rstd * gn[j];
    }
}

#ifndef TS_LMASK
#define TS_LMASK 15
#endif
#ifndef PROBE_PARTS
#define PROBE_PARTS 3
#endif
#ifndef PROBE_DUP
#define PROBE_DUP 0
#endif
#ifndef PH_MASK
#define PH_MASK 0xFFFF
#endif
#define PH_EN(k) ((PH_MASK >> (k)) & 1)
constexpr int NPH = 50;
__host__ __device__ inline bool phase_skipped(int p) { if (p == 0 || p == NPH - 1) return false; const int layer = (p - 1) / 12, step = (p - 1) % 12;
    if (step == 9) return true;
    return (layer & 1) == 0 && (step == 3 || step == 4 || step == 5); }
__global__ void __launch_bounds__(NTHR, 2) mk_fwd(Args args) {
    extern __shared__ __attribute__((aligned(16))) unsigned char lds[];
    Frame F;
    F.lds = (LAS unsigned char*)lds;
    F.MISC = (volatile LAS unsigned*)(F.lds + MISC_OFF);
    F.tid = threadIdx.x; F.lane = F.tid & 63; F.wave = __builtin_amdgcn_readfirstlane(F.tid >> 6);
    F.G = gridDim.x; F.bid = blockIdx.x;
    F.ctl = (gu32*)(args.ws + WS_CTL);
    for (int u = F.tid; u < (LDS_BYTES - MISC_OFF) / 4; u += NTHR) ((LAS unsigned*)(F.lds + MISC_OFF))[u] = 0u;
    __syncthreads();
    XcdBarrier bar; bar.bar = (unsigned*)(F.ctl + CW_BAR); bar.x = 0; bar.st = nullptr;
    const int lo = args.ph_lo, hi = args.ph_hi;
    if (hi - lo > 1) bar = xcd_barrier_post((unsigned*)(F.ctl + CW_BAR), F.MISC + 8);
    bool ran = false;
#ifdef TS_STEP
    unsigned long long ts_acc = 0ull;
#endif
    for (int p = lo; p < hi; ++p) {
        if (phase_skipped(p)) continue;
        if (ran) xcd_barrier(bar);
        ran = true;
        { int t_ = threadIdx.x; asm volatile("" : "+v"(t_)); F.tid = t_; F.lane = t_ & 63; F.wave = __builtin_amdgcn_readfirstlane(t_ >> 6);
          int b_ = blockIdx.x, g_ = gridDim.x; asm volatile("" : "+s"(b_), "+s"(g_)); F.bid = b_; F.G = g_; }
#ifdef TS_STEP
        const bool ts_sel = (p == 0) ? (TS_STEP == 100) : (((p - 1) % 12) == TS_STEP && ((TS_LMASK >> ((p - 1) / 12)) & 1));
        unsigned long long ts0 = 0ull; if (ts_sel) ts0 = __builtin_amdgcn_s_memrealtime();
#define TS_END() do { if (ts_sel) { xcd_barrier(bar); ts_acc += __builtin_amdgcn_s_memrealtime() - ts0; } } while (0)
#else
#define TS_END() do {} while (0)
#endif
        if (p == 0) { if (PH_EN(0)) {
#if (PROBE_DUP >> 0) & 1
            phase_prologue(F); __syncthreads();
#endif
            phase_prologue(F); } TS_END(); continue; }
        if (p == NPH - 1) { if (PH_EN(1)) phase_final(F); continue; }
        const int layer = (p - 1) / 12, step = (p - 1) % 12; const bool odd = layer & 1;
        KARGS;
        if (step == 0 || step == 7) { if (PH_EN(2)) {
#if (PROBE_DUP >> 2) & 1
            phase_norm(F, layer, step == 7 ? 1 : 0);
#endif
            phase_norm(F, layer, step == 7 ? 1 : 0); } }
        else if (step == 1 || step == 8) { if (PH_EN(3)) {
            const int N = step == 8 ? 2048 : (odd ? ODD_N : EVEN_IN);
            const bf16* Bt = step == 8 ? WSP(bf16, WS_WQ + (size_t)layer * 4 * MiB) : WSP(bf16, WS_WIN + (size_t)layer * 8 * MiB);
            bf16* O = step == 8 ? WSP(bf16, WS_Q) : WSP(bf16, WS_PROJ);
            pg8::Gemm g{WSP(bf16, WS_H), Bt, T, N, D}; pg8::StaticOrder S; S.init(T, N, F.G, F.bid);
            pg8::EpiBf16<0> E{O, N, nullptr, 0, 0, 1.f};
#if (PROBE_DUP >> 3) & 1
            pg8::gemm_phase<pg8::EpiBf16<0>, pg8::StaticOrder, PG8_ALIGN, PG8_SP2>(F.lds + RING_OFF, g, S, E); __syncthreads();
#endif
            pg8::gemm_phase<pg8::EpiBf16<0>, pg8::StaticOrder, PG8_ALIGN, PG8_SP2>(F.lds + RING_OFF, g, S, E);
            if (step == 8) { asm volatile("s_waitcnt vmcnt(0)" ::: "memory"); __syncthreads(); phase_peer_topk<true>(F, layer, S); }
        } }
        else if (step == 2) { if (odd) { if (PH_EN(4)) {
#if (PROBE_DUP >> 4) & 1
            phase_odd_prep(F, layer, PROBE_PARTS); xcd_barrier(bar);
#endif
            phase_odd_prep(F, layer, 7); } } else { if (PH_EN(5)) {
#if (PROBE_DUP >> 5) & 1
            phase_even_mixer(F, layer);
#endif
            phase_even_mixer(F, layer); } } }
        else if (step == 3) { if (PH_EN(11)) {
#if (PROBE_DUP >> 11) & 1
            phase_rwkv_chunk(F, layer, 2048, PROBE_PARTS); xcd_barrier(bar);
#endif
            phase_rwkv_chunk(F, layer); } }
        else if (step == 4) { if (PH_EN(6)) {
#if (PROBE_DUP >> 6) & 1
            phase_odd_main(F, layer, CW_WORK2, PROBE_PARTS); xcd_barrier(bar);
#endif
            phase_odd_main(F, layer, CW_WORK, 3); } }
        else if (step == 5) { if (PH_EN(7)) {
#if (PROBE_DUP >> 7) & 1
            phase_rwkv_post(F, layer);
#endif
            phase_rwkv_post(F, layer); } }
        else if (step == 6) { if (PH_EN(8)) {
            pg8::Gemm g{WSP(bf16, WS_MIX), WSP(bf16, WS_WOUT + (size_t)layer * 2 * MiB), T, D, D}; pg8::StaticOrder S; S.init(T, D, F.G, F.bid);
            pg8::EpiResid E{layer == 0 ? IN(0) : OUTP, OUTP, WSP(float, WS_MOD) + (size_t)layer * 2 * 6144 + 2048, 6144};
            pg8::gemm_phase<pg8::EpiResid, pg8::StaticOrder, PG8_ALIGN, PG8_SP2>(F.lds + RING_OFF, g, S, E);
        } }
        else if (step == 9) { }
        else if (step == 10) { if (PH_EN(10)) {
#ifdef GU_VALU
            phase_peer_gu_valu(F, layer);
#else
            phase_peer_gu(F, layer);
#endif
            } }
        else { if (PH_EN(12)) {
#ifdef GV_OLD
            phase_peer_gv_old(F, layer);
#else
            phase_peer_gv(F, layer);
#endif
            } }
        TS_END();
    }
#ifdef TS_STEP
    if (blockIdx.x == 0 && threadIdx.x == 0) args.out[0] = (float)ts_acc;
#endif
}

extern "C" void kernel_launch(void* const* d_in, const int* in_sizes, int n_in, void* d_out, int out_size, void* d_ws, size_t ws_size, hipStream_t stream) {
    static int grid = 0;
    if (grid == 0) {
        if (n_in != 32 || in_sizes[0] != T * D || out_size != T * D || ws_size < WS_END) { fprintf(stderr, "kernel_launch: unexpected shapes (n_in %d, in0 %d, out %d, ws %zu < %zu); nothing launched\n", n_in, n_in > 0 ? in_sizes[0] : -1, out_size, ws_size, (size_t)WS_END); grid = -1; return; }
        int dev = 0, cus = 0, per_cu = 0;
        if (hipGetDevice(&dev) != hipSuccess || hipDeviceGetAttribute(&cus, hipDeviceAttributeMultiprocessorCount, dev) != hipSuccess) { grid = -1; return; }
        if (hipFuncSetAttribute((const void*)mk_fwd, hipFuncAttributeMaxDynamicSharedMemorySize, LDS_BYTES) != hipSuccess) { fprintf(stderr, "kernel_launch: hipFuncSetAttribute failed\n"); grid = -1; return; }
        if (hipOccupancyMaxActiveBlocksPerMultiprocessor(&per_cu, (const void*)mk_fwd, NTHR, LDS_BYTES) != hipSuccess || per_cu < 1) fprintf(stderr, "kernel_launch: occupancy query reports %d workgroups per CU\n", per_cu);
        (void)hipGetLastError();
        grid = cus;
    }
    if (grid < 0) return;
    if (hipMemsetAsync((char*)d_ws + WS_CTL, 0, CTL_ZERO_BYTES, stream) != hipSuccess) { fprintf(stderr, "kernel_launch: hipMemsetAsync failed\n"); return; }
    Args a{};
    for (int i = 0; i < 32; ++i) a.in[i] = (const float*)d_in[i];
    a.out = (float*)d_out; a.ws = (unsigned char*)d_ws;
#if MK_ONE_LAUNCH
    a.ph_lo = 0; a.ph_hi = NPH;
    hipLaunchKernelGGL(mk_fwd, dim3(grid), dim3(NTHR), LDS_BYTES, stream, a);
#else
    for (int p = 0; p < NPH; ++p) { if (phase_skipped(p)) continue; a.ph_lo = p; a.ph_hi = p + 1;
        hipLaunchKernelGGL(mk_fwd, dim3(grid), dim3(NTHR), LDS_BYTES, stream, a); }
#endif
    const hipError_t le = hipPeekAtLastError();
    if (le != hipSuccess) fprintf(stderr, "kernel_launch: launch failed: %s\n", hipGetErrorName(le));
}
```
